# Optimizing an MI355X kernel written in HIP

```python
import jax, jax.numpy as jnp
from jax import lax
import numpy as np

D_MODEL = 1024
BATCH = 2
SEQ = 8192
DEPTH = 2

N_MEM = 256
MLSTM_HEADS = 4
MLSTM_HEAD_DIM = D_MODEL // 16
MLSTM_WIDTH = MLSTM_HEADS * MLSTM_HEAD_DIM
MLSTM_CHUNK = 64
MLSTM_CONV = 4
CONF_CHANNELS = D_MODEL // 4
CONF_KERNEL = 31
FOX_HEADS = 8
FOX_HEAD_DIM = D_MODEL // 16
FOX_WIDTH = FOX_HEADS * FOX_HEAD_DIM
FOX_BLOCK = 128
MIX_WIDTH = MLSTM_WIDTH + CONF_CHANNELS + FOX_WIDTH
XATTN_HEADS = 4
XATTN_HEAD_DIM = D_MODEL // 8
XATTN_WIDTH = XATTN_HEADS * XATTN_HEAD_DIM
D_FF = ((8 * D_MODEL // 3) + 255) // 256 * 256
N_EXPERTS = 8
TOP_K = 2
EXPERT_FF = D_FF
N_DENSE_LAYERS = (DEPTH + 1) // 2
N_MOE_LAYERS = DEPTH // 2
EPS = 1e-6

IN_SPLITS = (2 * MLSTM_WIDTH, MLSTM_WIDTH, MLSTM_WIDTH, MLSTM_HEADS, MLSTM_HEADS,
             2 * CONF_CHANNELS, FOX_WIDTH, FOX_WIDTH, FOX_WIDTH, FOX_HEADS)
IN_WIDTH = sum(IN_SPLITS)
IN_SPLIT_IDX = tuple(int(i) for i in np.cumsum(IN_SPLITS)[:-1])

kernel_name = "hybrid_mlstm_conformer_fox_moe_block"


def rmsnorm(x, w):
    xf = x.astype(jnp.float32)
    y = xf * lax.rsqrt(jnp.mean(xf * xf, axis=-1, keepdims=True) + EPS)
    return (y * w.astype(jnp.float32)).astype(x.dtype)


def layernorm_f32(x, w, b):
    mu = jnp.mean(x, axis=-1, keepdims=True)
    xc = x - mu
    var = jnp.mean(xc * xc, axis=-1, keepdims=True)
    return xc * lax.rsqrt(var + EPS) * w.astype(jnp.float32) + b.astype(jnp.float32)


def causal_dwconv(x, w, b):
    K, C = w.shape
    y = lax.conv_general_dilated(
        x, w.astype(jnp.float32)[:, None, :], window_strides=(1,), padding=[(K - 1, 0)],
        dimension_numbers=("NWC", "WIO", "NWC"), feature_group_count=C)
    return y + b.astype(jnp.float32)


def mlstm_chunkwise(q, k, v, i_pre, f_pre):
    B, S, H, Dh = q.shape
    L = MLSTM_CHUNK
    nc = S // L
    log_f = jax.nn.log_sigmoid(f_pre)
    log_i = i_pre

    def chunks(t):
        return t.reshape(B, nc, L, H, Dh).transpose(1, 0, 3, 2, 4)

    def gchunks(t):
        return t.reshape(B, nc, L, H).transpose(1, 0, 3, 2)

    causal = jnp.tril(jnp.ones((L, L), dtype=bool))

    def step(carry, xs):
        C, n, m = carry
        qc, kc, vc, lic, lfc = xs
        b = jnp.cumsum(lfc, axis=-1)
        d_log = b[..., :, None] - b[..., None, :] + lic[..., None, :]
        d_log = jnp.where(causal, d_log, -jnp.inf)
        inter = b + m[..., None]
        m_t = jnp.maximum(jnp.max(d_log, axis=-1), inter)
        s = jnp.einsum("bhtd,bhsd->bhts", qc, kc) * jnp.exp(d_log - m_t[..., None])
        w_inter = jnp.exp(inter - m_t)
        num = (jnp.einsum("bhts,bhsd->bhtd", s, vc)
               + w_inter[..., None] * jnp.einsum("bhtk,bhkv->bhtv", qc, C))
        den = jnp.sum(s, axis=-1) + w_inter * jnp.einsum("bhtk,bhk->bht", qc, n)
        h = num / jnp.maximum(jnp.abs(den), jnp.exp(-m_t))[..., None]
        b_tot = b[..., -1]
        g = b_tot[..., None] - b + lic
        m_new = jnp.maximum(b_tot + m, jnp.max(g, axis=-1))
        wg = jnp.exp(g - m_new[..., None])
        decay = jnp.exp(b_tot + m - m_new)
        C_new = decay[..., None, None] * C + jnp.einsum("bhsk,bhsv->bhkv", kc * wg[..., None], vc)
        n_new = decay[..., None] * n + jnp.einsum("bhs,bhsk->bhk", wg, kc)
        return (C_new, n_new, m_new), h

    init = (jnp.zeros((B, H, Dh, Dh), jnp.float32), jnp.zeros((B, H, Dh), jnp.float32),
            jnp.zeros((B, H), jnp.float32))
    _, hs = lax.scan(step, init, (chunks(q), chunks(k), chunks(v), gchunks(log_i), gchunks(log_f)))
    return hs.transpose(1, 0, 3, 2, 4).reshape(B, S, H, Dh)


def forgetting_attention(q, k, v, log_f):
    B, S, H, Dh = q.shape
    nb = S // FOX_BLOCK
    c = jnp.cumsum(log_f, axis=1).transpose(0, 2, 1)
    kh = k.transpose(0, 2, 1, 3)
    vh = v.transpose(0, 2, 1, 3)
    qb = (q * (Dh ** -0.5)).reshape(B, nb, FOX_BLOCK, H, Dh).transpose(1, 0, 3, 2, 4)
    cb = c.reshape(B, H, nb, FOX_BLOCK).transpose(2, 0, 1, 3)
    qpos = jnp.arange(S).reshape(nb, FOX_BLOCK)
    kpos = jnp.arange(S)

    def one_block(args):
        qi, ci, pi = args
        logits = jnp.einsum("bhqd,bhkd->bhqk", qi, kh) + ci[..., None] - c[:, :, None, :]
        logits = jnp.where(pi[:, None] >= kpos[None, :], logits, -jnp.inf)
        p = jax.nn.softmax(logits, axis=-1)
        return jnp.einsum("bhqk,bhkd->bhqd", p, vh)

    o = lax.map(one_block, (qb, cb, qpos))
    return o.transpose(1, 0, 3, 2, 4).reshape(B, S, H * Dh)


def hybrid_mixer(h, w_in, mlstm_conv_w, mlstm_conv_b, mlstm_b_i, mlstm_b_f, mlstm_norm_w,
                 conf_conv_w, conf_conv_b, conf_ln_w, conf_ln_b, fox_b_f, w_out):
    B, S, _ = h.shape
    z = jnp.einsum("bsd,de->bse", h, w_in).astype(jnp.float32)
    m_qk, m_v, m_o, m_i, m_f, c_glu, f_q, f_k, f_v, f_f = jnp.split(z, IN_SPLIT_IDX, axis=-1)

    qk = jax.nn.silu(causal_dwconv(m_qk, mlstm_conv_w, mlstm_conv_b))
    mq, mk = jnp.split(qk, 2, axis=-1)
    hd = (B, S, MLSTM_HEADS, MLSTM_HEAD_DIM)
    hm = mlstm_chunkwise(mq.reshape(hd), mk.reshape(hd) * (MLSTM_HEAD_DIM ** -0.5), m_v.reshape(hd),
                         m_i + mlstm_b_i.astype(jnp.float32), m_f + mlstm_b_f.astype(jnp.float32))
    hm = hm * lax.rsqrt(jnp.mean(hm * hm, axis=-1, keepdims=True) + EPS)
    hm = hm.reshape(B, S, MLSTM_WIDTH) * mlstm_norm_w.astype(jnp.float32) * jax.nn.sigmoid(m_o)

    a, g = jnp.split(c_glu, 2, axis=-1)
    hc = causal_dwconv(a * jax.nn.sigmoid(g), conf_conv_w, conf_conv_b)
    hc = jax.nn.silu(layernorm_f32(hc, conf_ln_w, conf_ln_b))

    fd = (B, S, FOX_HEADS, FOX_HEAD_DIM)
    log_f = jax.nn.log_sigmoid(f_f + fox_b_f.astype(jnp.float32))
    hf = forgetting_attention(f_q.reshape(fd), f_k.reshape(fd), f_v.reshape(fd), log_f)

    cat = jnp.concatenate([hm, hc, hf], axis=-1).astype(h.dtype)
    return jnp.einsum("bse,ed->bsd", cat, w_out)


def memory_cross_attention(h, mem_n, w_q, w_kv, w_o):
    B, S, _ = h.shape
    q = jnp.einsum("bsd,de->bse", h, w_q).reshape(B, S, XATTN_HEADS, XATTN_HEAD_DIM)
    kv = jnp.einsum("bmd,de->bme", mem_n, w_kv)
    k, v = jnp.split(kv, 2, axis=-1)
    k = k.reshape(B, N_MEM, XATTN_HEADS, XATTN_HEAD_DIM)
    v = v.reshape(B, N_MEM, XATTN_HEADS, XATTN_HEAD_DIM)
    logits = jnp.einsum("bshd,bmhd->bhsm", q.astype(jnp.float32), k.astype(jnp.float32))
    p = jax.nn.softmax(logits * (XATTN_HEAD_DIM ** -0.5), axis=-1)
    o = jnp.einsum("bhsm,bmhd->bshd", p, v.astype(jnp.float32)).reshape(B, S, XATTN_WIDTH)
    return jnp.einsum("bse,ed->bsd", o.astype(h.dtype), w_o)


def swiglu(h, w_gate, w_up, w_down):
    a = jnp.einsum("bsd,df->bsf", h, w_gate)
    u = jnp.einsum("bsd,df->bsf", h, w_up)
    return jnp.einsum("bsf,fd->bsd", jax.nn.silu(a) * u, w_down)


def moe_swiglu(h, router_w, w_gate, w_up, w_down):
    logits = jnp.einsum("bsd,de->bse", h, router_w).astype(jnp.float32)
    top_v, top_i = lax.top_k(logits, TOP_K)
    top_w = jax.nn.softmax(top_v, axis=-1)
    gates = jnp.sum(jax.nn.one_hot(top_i, N_EXPERTS, dtype=jnp.float32) * top_w[..., None], axis=-2)
    y = jnp.zeros(h.shape, jnp.float32)
    for e in range(N_EXPERTS):
        y = y + gates[..., e:e + 1] * swiglu(h, w_gate[e], w_up[e], w_down[e]).astype(jnp.float32)
    return y.astype(h.dtype)


def setup_inputs(seed: int = 0) -> dict:
    key = jax.random.key(seed)
    ks = jax.random.split(key, 32)

    def nrm(k, shape, scale):
        return jax.random.normal(k, shape, jnp.float32) * scale

    D, L = D_MODEL, DEPTH
    return {
        "x": nrm(ks[0], (BATCH, SEQ, D), 1.0),
        "mem": nrm(ks[1], (BATCH, N_MEM, D), 1.0),
        "norm_mix_w": 1.0 + nrm(ks[2], (L, D), 0.02),
        "w_in": nrm(ks[3], (L, D, IN_WIDTH), D ** -0.5),
        "mlstm_conv_w": nrm(ks[4], (L, MLSTM_CONV, 2 * MLSTM_WIDTH), MLSTM_CONV ** -0.5),
        "mlstm_conv_b": nrm(ks[5], (L, 2 * MLSTM_WIDTH), 0.02),
        "mlstm_b_i": nrm(ks[6], (L, MLSTM_HEADS), 0.1),
        "mlstm_b_f": 3.0 + nrm(ks[7], (L, MLSTM_HEADS), 0.5),
        "mlstm_norm_w": 1.0 + nrm(ks[8], (L, MLSTM_WIDTH), 0.02),
        "conf_conv_w": nrm(ks[9], (L, CONF_KERNEL, CONF_CHANNELS), CONF_KERNEL ** -0.5),
        "conf_conv_b": nrm(ks[10], (L, CONF_CHANNELS), 0.02),
        "conf_ln_w": 1.0 + nrm(ks[11], (L, CONF_CHANNELS), 0.02),
        "conf_ln_b": nrm(ks[12], (L, CONF_CHANNELS), 0.02),
        "fox_b_f": 2.0 + nrm(ks[13], (L, FOX_HEADS), 0.5),
        "w_out": nrm(ks[14], (L, MIX_WIDTH, D), MIX_WIDTH ** -0.5),
        "norm_xattn_w": 1.0 + nrm(ks[15], (L, D), 0.02),
        "norm_mem_w": 1.0 + nrm(ks[16], (L, D), 0.02),
        "xattn_w_q": nrm(ks[17], (L, D, XATTN_WIDTH), D ** -0.5),
        "xattn_w_kv": nrm(ks[18], (L, D, 2 * XATTN_WIDTH), D ** -0.5),
        "xattn_w_o": nrm(ks[19], (L, XATTN_WIDTH, D), XATTN_WIDTH ** -0.5),
        "norm_ffn_w": 1.0 + nrm(ks[20], (L, D), 0.02),
        "ffn_w_gate": nrm(ks[21], (N_DENSE_LAYERS, D, D_FF), D ** -0.5),
        "ffn_w_up": nrm(ks[22], (N_DENSE_LAYERS, D, D_FF), D ** -0.5),
        "ffn_w_down": nrm(ks[23], (N_DENSE_LAYERS, D_FF, D), D_FF ** -0.5),
        "router_w": nrm(ks[24], (N_MOE_LAYERS, D, N_EXPERTS), D ** -0.5),
        "moe_w_gate": nrm(ks[25], (N_MOE_LAYERS, N_EXPERTS, D, EXPERT_FF), D ** -0.5),
        "moe_w_up": nrm(ks[26], (N_MOE_LAYERS, N_EXPERTS, D, EXPERT_FF), D ** -0.5),
        "moe_w_down": nrm(ks[27], (N_MOE_LAYERS, N_EXPERTS, EXPERT_FF, D), EXPERT_FF ** -0.5),
        "norm_final_w": 1.0 + nrm(ks[28], (D,), 0.02),
    }


def reference(x, mem, norm_mix_w, w_in, mlstm_conv_w, mlstm_conv_b, mlstm_b_i, mlstm_b_f,
              mlstm_norm_w, conf_conv_w, conf_conv_b, conf_ln_w, conf_ln_b, fox_b_f, w_out,
              norm_xattn_w, norm_mem_w, xattn_w_q, xattn_w_kv, xattn_w_o, norm_ffn_w,
              ffn_w_gate, ffn_w_up, ffn_w_down, router_w, moe_w_gate, moe_w_up, moe_w_down,
              norm_final_w):
    for l in range(DEPTH):
        h = rmsnorm(x, norm_mix_w[l])
        x = x + hybrid_mixer(h, w_in[l], mlstm_conv_w[l], mlstm_conv_b[l], mlstm_b_i[l], mlstm_b_f[l],
                             mlstm_norm_w[l], conf_conv_w[l], conf_conv_b[l], conf_ln_w[l],
                             conf_ln_b[l], fox_b_f[l], w_out[l])
        h = rmsnorm(x, norm_xattn_w[l])
        mem_n = rmsnorm(mem, norm_mem_w[l])
        x = x + memory_cross_attention(h, mem_n, xattn_w_q[l], xattn_w_kv[l], xattn_w_o[l])
        h = rmsnorm(x, norm_ffn_w[l])
        if l % 2 == 0:
            j = l // 2
            x = x + swiglu(h, ffn_w_gate[j], ffn_w_up[j], ffn_w_down[j])
        else:
            j = l // 2
            x = x + moe_swiglu(h, router_w[j], moe_w_gate[j], moe_w_up[j], moe_w_down[j])
    return rmsnorm(x, norm_final_w)
```

```cpp
#if defined(HOST_EMU)
#include <cmath>
#include <cstring>
#include <cstdint>
#include <cstddef>
#define DEVFN static inline
#define PHFN static inline
#else
#include <hip/hip_runtime.h>
#include <cstdio>
#include <cstdint>
#include <cstring>
#define DEVFN __device__ __forceinline__
#define PHFN __device__ __forceinline__
#endif

#ifndef CFG_SEQ
#define CFG_SEQ 8192
#endif
constexpr int BATCH = 2, SEQ = CFG_SEQ, D = 1024, M = BATCH * SEQ;
constexpr int MH = 4, MCH = 64, NCH = SEQ / MCH;
constexpr int CK = 31;
constexpr int FH = 8;
constexpr int XH = 4, XD = 128, NMEM = 256;
constexpr int DFF = 2816, NE = 8, INW = 3088;
constexpr int NZ = 3072;
constexpr int SLOTS_MAX = 2 * M + NE * 256;
constexpr float EPS = 1e-6f;
constexpr float LOG2E = 1.4426950408889634f;
constexpr float FOX_QS = 0.125f * LOG2E;
constexpr float XAT_QS = 0.08838834764831845f * LOG2E;

enum { I_X = 0, I_MEM, I_NMIX, I_WIN, I_MCW, I_MCB, I_MBI, I_MBF, I_MNW, I_CCW, I_CCB, I_CLW, I_CLB, I_FBF, I_WOUT, I_NXA, I_NMEM, I_WQ, I_WKV, I_WO, I_NFFN,
       I_FG, I_FU, I_FD, I_RW, I_MG, I_MU, I_MD, I_NFIN, N_IN };

typedef unsigned short bf16;
constexpr size_t al4k(size_t x) { return (x + 4095) & ~(size_t)4095; }
constexpr size_t MiB = (size_t)1 << 20;
constexpr size_t WS_CTL = 0, CTL_ZERO_BYTES = 1 * MiB;
constexpr size_t WS_GATE = 1 * MiB;
constexpr size_t WS_CF = WS_GATE + al4k((size_t)M * 16 * 4);
constexpr size_t WS_BL = WS_CF + al4k((size_t)16 * SEQ * 4);
constexpr size_t WS_BT = WS_BL + al4k((size_t)8 * SEQ * 4);
constexpr size_t WS_AK = WS_BT + al4k((size_t)8 * NCH * 4);
constexpr size_t WS_MS = WS_AK + al4k((size_t)8 * NCH * 4);
constexpr size_t WS_DEC = WS_MS + al4k((size_t)8 * (NCH + 1) * 4);
constexpr size_t WS_KN2 = WS_DEC + al4k((size_t)8 * NCH * 4);
constexpr size_t WS_J0 = WS_KN2 + al4k((size_t)16 * (SEQ / 64) * 4);
constexpr size_t WS_BH = WS_J0 + al4k((size_t)16 * (SEQ / 256) * 4);
constexpr size_t WS_NST = WS_BH + al4k((size_t)1024 * 8 * 4);
constexpr size_t WS_TOK = WS_NST + al4k((size_t)8 * NCH * 64 * 4);
constexpr size_t WS_RSTD = WS_TOK + al4k((size_t)M * 32);
constexpr size_t WS_RSTDS = WS_RSTD + al4k((size_t)M * 8);
constexpr size_t WS_SLOTG = WS_RSTDS + al4k((size_t)SLOTS_MAX * 8);
constexpr size_t WS_GW = WS_SLOTG + al4k((size_t)SLOTS_MAX * 4);
constexpr size_t WS_MEMN = WS_GW + 3 * 65536;
constexpr size_t WS_KVX = WS_MEMN + al4k((size_t)512 * 1024 * 2);
constexpr size_t WS_WMGU = WS_KVX + al4k((size_t)2 * 512 * 1024 * 2);
constexpr size_t WS_WMD = WS_WMGU + (size_t)NE * 5632 * 1024 * 2;
constexpr size_t WS_R = al4k(WS_WMD + (size_t)NE * 1024 * 2816 * 2);
constexpr size_t WL_IN = 0, WL_OUT = WL_IN + (size_t)NZ * 1024 * 2, WL_Q = WL_OUT + (size_t)1024 * 1024 * 2, WL_KV = WL_Q + (size_t)512 * 1024 * 2,
                 WL_O = WL_KV + (size_t)1024 * 1024 * 2, WL_SIZE = WL_O + (size_t)1024 * 512 * 2;
constexpr size_t R_WL = WS_R;
constexpr size_t R_WGU = R_WL + 2 * WL_SIZE;
constexpr size_t R_WDN = R_WGU + (size_t)5632 * 1024 * 2;
constexpr size_t R_XN = al4k(R_WDN + (size_t)1024 * 2816 * 2);
constexpr size_t SZ_T = (size_t)M * 512 * 2;
constexpr size_t R_T0 = R_XN + 2 * SZ_T;
constexpr size_t R_MQK = R_T0 + 6 * SZ_T;
constexpr size_t R_CAT = R_MQK + SZ_T;
constexpr size_t R_CST = R_CAT + 2 * SZ_T;
constexpr size_t R_GL = R_CST + (size_t)8 * NCH * 4096 * 4;
constexpr size_t R_HC = R_GL + (size_t)M * 256 * 2;
constexpr size_t R_END1 = R_HC + (size_t)M * 256 * 4;
constexpr size_t R_QX = R_T0, R_OX = R_T0 + SZ_T;
constexpr size_t R_HD = R_T0;
constexpr size_t R_HM = WS_R;
constexpr size_t R_XNS = R_HM + (size_t)SLOTS_MAX * 2816 * 2;
constexpr size_t R_END2 = R_XNS + (size_t)SLOTS_MAX * 1024 * 2;
constexpr size_t WS_END = R_END1 > R_END2 ? R_END1 : R_END2;
static_assert((size_t)M * 2816 * 2 <= 6 * SZ_T, "dense hidden fits T0..T5");
static_assert(R_XN + 2 * SZ_T <= R_XNS, "XN must not overlap the gathered rows");
constexpr int CW_TMO = 0, CW_CNT = 64  , CW_FOXQ = 128  , CW_BAR = 4096;
constexpr size_t WS_RSS = 65536;
static_assert(WS_RSS + (size_t)5 * M * 4 <= CTL_ZERO_BYTES, "RSS arrays inside the zeroed region");

#if defined(HOST_EMU)
struct Ptrs { const float* in[N_IN]; float* xres; unsigned char* ws; };
#else
struct Ptrs { const float* const __attribute__((address_space(3)))* in; float* xres; unsigned char* ws; };
#endif
#define WSP(type, off) ((type*)(P.ws + (off)))

DEVFN float bf2f(bf16 v) { unsigned u = (unsigned)v << 16; float f; memcpy(&f, &u, 4); return f; }
DEVFN bf16 f2bf(float f) { unsigned u; memcpy(&u, &f, 4); return (bf16)((u + 0x7fffu + ((u >> 16) & 1u)) >> 16); }
DEVFN float sigmoidf_(float x) { return 1.f / (1.f + expf(-x)); }
#if defined(HOST_EMU)
DEVFN float logsigmoidf_(float x) { return fminf(x, 0.f) - log1pf(expf(-fabsf(x))); }
#else
DEVFN float logsigmoidf_(float x) { return fminf(x, 0.f) - __logf(1.f + __expf(-fabsf(x))); }
#endif

DEVFN void wmap(int kind, int nb, int& which, int& col0, float& cs) {
    which = 0; cs = 1.f; const int n0 = nb * 32;
    if (kind == 0) { col0 = n0; }
    else if (kind == 1) { col0 = n0 < 1024 ? n0 : n0 + 8; if (n0 >= 1536 && n0 < 2048) cs = FOX_QS; }
    else { const int tile = nb >> 3, w = nb & 7; which = w >> 2; col0 = tile * 128 + (w & 3) * 32; }
}

#if !defined(HOST_EMU)
namespace pg8 {
#define PG8_LAS __attribute__((address_space(3)))
typedef unsigned short bf16_t;
typedef short bf16x8 __attribute__((ext_vector_type(8)));
typedef float f32x4 __attribute__((ext_vector_type(4)));
typedef unsigned u32x4 __attribute__((ext_vector_type(4)));
constexpr int BM = 256, BK = 64, HALF = 128, HTB = HALF * BK * 2, STAGE_BYTES = 8 * HTB, NXCD = 8, WGM = 8;
__host__ __device__ __forceinline__ int lds_byte(int r, int c) { const int st = (r >> 4) * 2 + (c >> 5), rr = r & 15, cc = c & 31, ob = rr * 64 + cc * 2; return st * 1024 + (ob ^ (((ob >> 9) & 1) << 5)); }
__host__ __device__ __forceinline__ void stage_rc(int b, int& R, int& C) { const int st = b / 1024, sb = b % 1024, swz = sb ^ (((sb >> 9) & 1) << 5); R = (st >> 1) * 16 + swz / 64; C = (st & 1) * 32 + (swz % 64) / 2; }
__host__ __device__ __forceinline__ int perm32(int rho) { const int n = rho >> 4, i = rho & 15; return 8 * (i >> 2) + 4 * n + (i & 3); }

struct Unit { int pm, pn; size_t bofs; };
struct Gemm { const bf16_t* A; const bf16_t* Bt; int M, N, K; };

struct StaticOrder {
    int nM, nN, nwg, G, c;
    __device__ void init(int M_, int N_, int G_, int c_) { nM = M_ / BM; nN = N_ / BM; nwg = nM * nN; G = G_; c = c_; }
    __device__ bool next(int i, Unit& u) const {
        const long L = (long)i * G + c; if (L >= nwg) return false;
        int wgid = (int)L; { const int q = nwg / NXCD, r = nwg % NXCD, xcd = wgid % NXCD, off = wgid / NXCD; wgid = (xcd < r ? xcd * (q + 1) : r * (q + 1) + (xcd - r) * q) + off; }
        const int nig = WGM * nN, gid = wgid / nig, fm = gid * WGM, gsz = (nM - fm) < WGM ? (nM - fm) : WGM;
        u.pm = fm + ((wgid % nig) % gsz); u.pn = (wgid % nig) / gsz; u.bofs = 0; return true;
    }
    __device__ __forceinline__ void a_ready(const Unit&) const {}
    __device__ __forceinline__ void done(const Unit&) const {}
};
struct GroupedOrder {
    int nM, nN, nwg, G, c; int off[9]; size_t estride;
    __device__ void init(int N_, int G_, int c_, const unsigned* cnt, size_t estride_) {
        int o = 0;
#pragma unroll
        for (int e = 0; e < 8; ++e) { off[e] = o; o += ((int)cnt[e] + 255) & ~255; }
        off[8] = o; nM = o / BM; nN = N_ / BM; nwg = nM * nN; G = G_; c = c_; estride = estride_;
    }
    __device__ bool next(int i, Unit& u) const {
        const long L = (long)i * G + c; if (L >= nwg) return false;
        int wgid = (int)L; { const int q = nwg / NXCD, r = nwg % NXCD, xcd = wgid % NXCD, o2 = wgid / NXCD; wgid = (xcd < r ? xcd * (q + 1) : r * (q + 1) + (xcd - r) * q) + o2; }
        const int nig = WGM * nN, gid = wgid / nig, fm = gid * WGM, gsz = (nM - fm) < WGM ? (nM - fm) : WGM;
        u.pm = fm + ((wgid % nig) % gsz); u.pn = (wgid % nig) / gsz;
        int e = 0;
#pragma unroll
        for (int j = 1; j < 8; ++j) e += (off[j] <= u.pm * BM) ? 1 : 0;
        u.bofs = (size_t)e * estride; return true;
    }
    __device__ __forceinline__ void a_ready(const Unit&) const {}
    __device__ __forceinline__ void done(const Unit&) const {}
};

__device__ __forceinline__ unsigned cvt_pk_bf16(float lo, float hi) { unsigned r; asm volatile("v_cvt_pk_bf16_f32 %0, %1, %2" : "=v"(r) : "v"(lo), "v"(hi)); return r; }

struct EpiBf16 {
    static constexpr bool PERM = true, AFTER_DRAIN = false, HAS_PRE = true;
    __device__ __forceinline__ void preload(unsigned (&q)[8], const Unit& u, int wr, int fr) const {
        if (rs) { const __attribute__((address_space(1))) unsigned* rp = (const __attribute__((address_space(1))) unsigned*)rs + u.pm * BM + wr * 64 + fr;
#pragma unroll
            for (int i = 0; i < 8; ++i) q[i] = rp[(i >> 2) * HALF + (i & 3) * 16]; } }
    bf16_t* O; int ldc; int split_cols; size_t split_stride; const unsigned* rs;
    __device__ __forceinline__ void operator()(const f32x4 (&acc)[2][2][4][2], const Unit& u, int wr, int wc, int fr, int fq, const unsigned (&q)[8]) const {
        const int row0 = u.pm * BM + wr * 64 + fr; int colt = u.pn * BM; bf16_t* base = O;
        if (split_cols) { const int t = colt / split_cols; base += (size_t)t * split_stride; colt -= t * split_cols; }
        const int col0 = colt + wc * 32 + 8 * fq;
        float sc[2][4];
#pragma unroll
        for (int ai = 0; ai < 2; ++ai)
#pragma unroll
            for (int m = 0; m < 4; ++m) sc[ai][m] = rs ? rsqrtf((float)q[ai * 4 + m] * (1.f / (16.f * 1024.f)) + 1e-6f) : 1.f;
#pragma unroll
        for (int ai = 0; ai < 2; ++ai)
#pragma unroll
            for (int m = 0; m < 4; ++m) { bf16_t* rowp = base + (size_t)(row0 + ai * HALF + m * 16) * ldc + col0;
#pragma unroll
                for (int bj = 0; bj < 2; ++bj) { const f32x4 v0 = acc[ai][bj][m][0] * sc[ai][m], v1 = acc[ai][bj][m][1] * sc[ai][m];
                    u32x4 w; w.x = cvt_pk_bf16(v0[0], v0[1]); w.y = cvt_pk_bf16(v0[2], v0[3]); w.z = cvt_pk_bf16(v1[0], v1[1]); w.w = cvt_pk_bf16(v1[2], v1[3]);
                    *(u32x4*)(rowp + bj * HALF) = w; } }
    }
};
struct EpiRes {
    static constexpr bool PERM = true, AFTER_DRAIN = false, HAS_PRE = false;
    bf16_t* X; int ldc; unsigned* rss;
    __device__ __forceinline__ void operator()(const f32x4 (&acc)[2][2][4][2], const Unit& u, int wr, int wc, int fr, int fq) const {
        const int row0 = u.pm * BM + wr * 64 + fr, col0 = u.pn * BM + wc * 32 + 8 * fq;
        typedef __attribute__((address_space(1))) u32x4 gu32x4;
        u32x4 b[2][4][2];
#pragma unroll
        for (int ai = 0; ai < 2; ++ai)
#pragma unroll
            for (int m = 0; m < 4; ++m)
#pragma unroll
                for (int bj = 0; bj < 2; ++bj) b[ai][m][bj] = *(const gu32x4*)(X + (size_t)(row0 + ai * HALF + m * 16) * ldc + col0 + bj * HALF);
#pragma unroll
        for (int ai = 0; ai < 2; ++ai)
#pragma unroll
            for (int m = 0; m < 4; ++m) { bf16_t* rowp = X + (size_t)(row0 + ai * HALF + m * 16) * ldc + col0; float ss = 0.f;
#pragma unroll
                for (int bj = 0; bj < 2; ++bj) { float v[8];
#pragma unroll
                    for (int i = 0; i < 4; ++i) { v[2 * i] = __uint_as_float(b[ai][m][bj][i] << 16) + acc[ai][bj][m][i >> 1][(2 * i) & 3]; v[2 * i + 1] = __uint_as_float(b[ai][m][bj][i] & 0xffff0000u) + acc[ai][bj][m][i >> 1][(2 * i + 1) & 3]; }
                    u32x4 w; w.x = cvt_pk_bf16(v[0], v[1]); w.y = cvt_pk_bf16(v[2], v[3]); w.z = cvt_pk_bf16(v[4], v[5]); w.w = cvt_pk_bf16(v[6], v[7]);
                    *(gu32x4*)(rowp + bj * HALF) = w;
#pragma unroll
                    for (int i = 0; i < 8; ++i) ss += v[i] * v[i]; }
                ss += __shfl_xor(ss, 16); ss += __shfl_xor(ss, 32);
                if (fq == 0) __hip_atomic_fetch_add(rss + row0 + ai * HALF + m * 16, (unsigned)(ss * 16.f + 0.5f), __ATOMIC_RELAXED, __HIP_MEMORY_SCOPE_AGENT); }
    }
};
struct EpiMoeOut {
    static constexpr bool PERM = true, AFTER_DRAIN = false, HAS_PRE = false;
    bf16_t* Y; int ldc; const float* sg;
    __device__ __forceinline__ void operator()(const f32x4 (&acc)[2][2][4][2], const Unit& u, int wr, int wc, int fr, int fq) const {
        const int row0 = u.pm * BM + wr * 64 + fr, col0 = u.pn * BM + wc * 32 + 8 * fq;
        typedef __attribute__((address_space(1))) u32x4 gu32x4;
        float g[2][4];
        { const __attribute__((address_space(1))) float* gp = (const __attribute__((address_space(1))) float*)sg + row0;
#pragma unroll
          for (int ai = 0; ai < 2; ++ai)
#pragma unroll
              for (int m = 0; m < 4; ++m) g[ai][m] = gp[ai * HALF + m * 16]; }
        u32x4 b[2][4][2];
#pragma unroll
        for (int ai = 0; ai < 2; ++ai)
#pragma unroll
            for (int m = 0; m < 4; ++m)
#pragma unroll
                for (int bj = 0; bj < 2; ++bj) { b[ai][m][bj] = (u32x4){0u, 0u, 0u, 0u}; if (g[ai][m] > 0.f) b[ai][m][bj] = *(const gu32x4*)(Y + (size_t)(row0 + ai * HALF + m * 16) * ldc + col0 + bj * HALF); }
#pragma unroll
        for (int ai = 0; ai < 2; ++ai)
#pragma unroll
            for (int m = 0; m < 4; ++m) { bf16_t* rowp = Y + (size_t)(row0 + ai * HALF + m * 16) * ldc + col0; const float ga = fabsf(g[ai][m]);
#pragma unroll
                for (int bj = 0; bj < 2; ++bj) { float v[8];
#pragma unroll
                    for (int i = 0; i < 4; ++i) { v[2 * i] = __uint_as_float(b[ai][m][bj][i] << 16) + ga * acc[ai][bj][m][i >> 1][(2 * i) & 3]; v[2 * i + 1] = __uint_as_float(b[ai][m][bj][i] & 0xffff0000u) + ga * acc[ai][bj][m][i >> 1][(2 * i + 1) & 3]; }
                    u32x4 w; w.x = cvt_pk_bf16(v[0], v[1]); w.y = cvt_pk_bf16(v[2], v[3]); w.z = cvt_pk_bf16(v[4], v[5]); w.w = cvt_pk_bf16(v[6], v[7]);
                    *(gu32x4*)(rowp + bj * HALF) = w; } }
    }
};
struct EpiSwiGLU {
    static constexpr bool PERM = true, AFTER_DRAIN = false, HAS_PRE = true;
    __device__ __forceinline__ void preload(unsigned (&q)[8], const Unit& u, int wr, int fr) const {
        const __attribute__((address_space(1))) unsigned* rp = (const __attribute__((address_space(1))) unsigned*)rs + u.pm * BM + wr * 64 + fr;
#pragma unroll
        for (int i = 0; i < 8; ++i) q[i] = rp[(i >> 2) * HALF + (i & 3) * 16]; }
    bf16_t* H; int ldc; const unsigned* rs;
    __device__ __forceinline__ void operator()(const f32x4 (&acc)[2][2][4][2], const Unit& u, int wr, int wc, int fr, int fq, const unsigned (&q)[8]) const {
        const int row0 = u.pm * BM + wr * 64 + fr, col0 = u.pn * HALF + wc * 32 + 8 * fq;
        float sc[2][4];
#pragma unroll
        for (int ai = 0; ai < 2; ++ai)
#pragma unroll
            for (int m = 0; m < 4; ++m) sc[ai][m] = rsqrtf((float)q[ai * 4 + m] * (1.f / (16.f * 1024.f)) + 1e-6f);
#pragma unroll
        for (int ai = 0; ai < 2; ++ai)
#pragma unroll
            for (int m = 0; m < 4; ++m) { bf16_t* rowp = H + (size_t)(row0 + ai * HALF + m * 16) * ldc + col0; float hv[8];
#pragma unroll
                for (int n = 0; n < 2; ++n)
#pragma unroll
                    for (int i = 0; i < 4; ++i) { const float g = acc[ai][0][m][n][i] * sc[ai][m], up = acc[ai][1][m][n][i] * sc[ai][m];
                        hv[n * 4 + i] = g * __builtin_amdgcn_rcpf(1.f + __builtin_amdgcn_exp2f(-g * 1.4426950408889634f)) * up; }
                u32x4 w; w.x = cvt_pk_bf16(hv[0], hv[1]); w.y = cvt_pk_bf16(hv[2], hv[3]); w.z = cvt_pk_bf16(hv[4], hv[5]); w.w = cvt_pk_bf16(hv[6], hv[7]);
                *(u32x4*)rowp = w; }
    }
};

template <class Epi, class Sched, bool ALIGN_EPI = false, bool SP2 = false>
__device__ __forceinline__ void gemm_phase(PG8_LAS unsigned char* lds, const Gemm g, const Sched& S, const Epi& E) {
    int tid = threadIdx.x; asm volatile("" : "+v"(tid));
    const int wid = __builtin_amdgcn_readfirstlane(tid >> 6), lane = tid & 63, wr = wid >> 2, wc = wid & 3, fr = lane & 15, fq = lane >> 4;
    const int K = g.K, nt = K / BK;
    unsigned voffA[2], voffB[2];
#pragma unroll
    for (int i = 0; i < 2; ++i) { int R, C; stage_rc(tid * 16 + i * 8192, R, C); const int Rb = Epi::PERM ? ((R & ~31) + perm32(R & 31)) : R;
        voffA[i] = (unsigned)(R * K + C) * 2u; voffB[i] = (unsigned)(Rb * K + C) * 2u; }
    const size_t kstep = (size_t)(BK * 2);
    const size_t hstep = (size_t)HALF * K * 2;
    const size_t tstep = 2 * hstep;
    const unsigned ldsw = (unsigned)wid * 1024u;
    const int aoff = lds_byte(wr * 64 + fr, fq * 8), boff = lds_byte(wc * 32 + fr, fq * 8);
#define PG8_SA(b, h) (((b) * 2 + (h)) * HTB)
#define PG8_SB(b, h) ((4 + (b) * 2 + (h)) * HTB)
#define PG8_STAGE(bufoff, gbase, voff) do { _Pragma("unroll") for (int _i = 0; _i < 2; ++_i) \
        __builtin_amdgcn_global_load_lds((const unsigned*)((const char*)(gbase) + (voff)[_i]), (PG8_LAS unsigned*)(lds + (bufoff) + ldsw + _i * 8192), 16, 0, 0); } while (0)
#define PG8_LDA(dst, b, h) do { _Pragma("unroll") for (int m = 0; m < 4; ++m) _Pragma("unroll") for (int k = 0; k < 2; ++k) dst[m][k] = *(const PG8_LAS bf16x8*)(lds + PG8_SA(b, h) + aoff + m * 2048 + k * 1024); } while (0)
#define PG8_LDB(dst, b, h) do { _Pragma("unroll") for (int n = 0; n < 2; ++n) _Pragma("unroll") for (int k = 0; k < 2; ++k) dst[n][k] = *(const PG8_LAS bf16x8*)(lds + PG8_SB(b, h) + boff + n * 2048 + k * 1024); } while (0)
#define PG8_MMA(ai, bj, At, Bt) do { __builtin_amdgcn_s_setprio(1); _Pragma("unroll") for (int m = 0; m < 4; ++m) _Pragma("unroll") for (int n = 0; n < 2; ++n) _Pragma("unroll") for (int k = 0; k < 2; ++k) \
        acc[ai][bj][m][n] = __builtin_amdgcn_mfma_f32_16x16x32_bf16(Bt[n][k], At[m][k], acc[ai][bj][m][n], 0, 0, 0); __builtin_amdgcn_s_setprio(0); } while (0)
#define PG8_WAIT_V(n) asm volatile("s_waitcnt vmcnt(" #n ")" ::: "memory")
#define PG8_WAIT_L(n) asm volatile("s_waitcnt lgkmcnt(" #n ")" ::: "memory")
#define PG8_BAR __builtin_amdgcn_s_barrier()
#define PG8_SCHED __builtin_amdgcn_sched_barrier(0)
    Unit cur, nxt; int ui = 0;
    if (!S.next(0, cur)) return;
    f32x4 acc[2][2][4][2];
#pragma unroll
    for (int a = 0; a < 2; ++a)
#pragma unroll
        for (int b = 0; b < 2; ++b)
#pragma unroll
            for (int m = 0; m < 4; ++m)
#pragma unroll
                for (int n = 0; n < 2; ++n) acc[a][b][m][n] = (f32x4){0.f, 0.f, 0.f, 0.f};
    bf16x8 At[4][2], B0[2][2], B1[2][2];
    const char* cA = (const char*)g.A + (size_t)cur.pm * tstep; const char* cB = (const char*)g.Bt + cur.bofs + (size_t)cur.pn * tstep;
    S.a_ready(cur);
    if constexpr (SP2) {
        PG8_STAGE(PG8_SB(0, 0), cB, voffB); PG8_STAGE(PG8_SB(0, 1), cB + hstep, voffB); PG8_STAGE(PG8_SA(0, 0), cA, voffA); PG8_STAGE(PG8_SA(0, 1), cA + hstep, voffA);
        if (wr == 1) PG8_BAR;
        PG8_WAIT_V(2); PG8_BAR;
        PG8_STAGE(PG8_SB(1, 0), cB + kstep, voffB); PG8_STAGE(PG8_SA(1, 0), cA + kstep, voffA); PG8_STAGE(PG8_SB(1, 1), cB + hstep + kstep, voffB);
        PG8_WAIT_V(6); PG8_BAR;
    } else {
        PG8_STAGE(PG8_SB(0, 0), cB, voffB); PG8_STAGE(PG8_SA(0, 0), cA, voffA); PG8_STAGE(PG8_SB(0, 1), cB + hstep, voffB); PG8_STAGE(PG8_SA(0, 1), cA + hstep, voffA);
        if (wr == 1) PG8_BAR;
        PG8_WAIT_V(4); PG8_BAR;
        PG8_STAGE(PG8_SB(1, 0), cB + kstep, voffB); PG8_STAGE(PG8_SA(1, 0), cA + kstep, voffA); PG8_STAGE(PG8_SB(1, 1), cB + hstep + kstep, voffB);
        PG8_WAIT_V(6); PG8_BAR;
    }
    for (;;) {
        unsigned preq[8];
        if constexpr (Epi::HAS_PRE) E.preload(preq, cur, wr, fr);
        const bool has_next = S.next(ui + 1, nxt);
        const char* nA = has_next ? (const char*)g.A + (size_t)nxt.pm * tstep : cA; const char* nB = has_next ? (const char*)g.Bt + nxt.bofs + (size_t)nxt.pn * tstep : cB;
        for (int t = 0; t < nt; t += 2) {
            const bool last = (t == nt - 2);
            const char* a1 = cA + (size_t)(t + 1) * kstep;
            const char* a2 = last ? nA : cA + (size_t)(t + 2) * kstep; const char* b2 = last ? nB : cB + (size_t)(t + 2) * kstep;
            const char* a3 = a2 + kstep; const char* b3 = b2 + kstep;
            if (last && has_next) S.a_ready(nxt);
            if constexpr (SP2) {
            PG8_LDB(B0, 0, 0); PG8_LDB(B1, 0, 1); PG8_SCHED; PG8_LDA(At, 0, 0); PG8_STAGE(PG8_SA(1, 1), a1 + hstep, voffA);
            PG8_WAIT_V(8); PG8_WAIT_L(0); PG8_BAR; PG8_MMA(0, 0, At, B0); PG8_MMA(0, 1, At, B1); PG8_BAR; PG8_SCHED;
            PG8_LDA(At, 0, 1); PG8_STAGE(PG8_SB(0, 0), b2, voffB); PG8_STAGE(PG8_SB(0, 1), b2 + hstep, voffB); PG8_STAGE(PG8_SA(0, 0), a2, voffA);
            PG8_WAIT_V(8); PG8_WAIT_L(0); PG8_BAR; PG8_MMA(1, 0, At, B0); PG8_MMA(1, 1, At, B1); PG8_BAR; PG8_SCHED;
            PG8_LDB(B0, 1, 0); PG8_LDB(B1, 1, 1); PG8_SCHED; PG8_LDA(At, 1, 0); PG8_STAGE(PG8_SA(0, 1), a2 + hstep, voffA);
            PG8_WAIT_V(8); PG8_WAIT_L(0); PG8_BAR; PG8_MMA(0, 0, At, B0); PG8_MMA(0, 1, At, B1); PG8_BAR; PG8_SCHED;
            PG8_LDA(At, 1, 1); PG8_STAGE(PG8_SB(1, 0), b3, voffB); PG8_STAGE(PG8_SB(1, 1), b3 + hstep, voffB); PG8_STAGE(PG8_SA(1, 0), a3, voffA);
            PG8_WAIT_V(8); PG8_WAIT_L(0); PG8_BAR; PG8_MMA(1, 0, At, B0); PG8_MMA(1, 1, At, B1); PG8_BAR; PG8_SCHED;
            } else {
            PG8_LDB(B0, 0, 0); PG8_SCHED; PG8_LDA(At, 0, 0); PG8_STAGE(PG8_SA(1, 1), a1 + hstep, voffA);
            PG8_WAIT_L(8); PG8_BAR; PG8_WAIT_L(0); PG8_MMA(0, 0, At, B0); PG8_BAR; PG8_SCHED;
            PG8_LDB(B1, 0, 1); PG8_STAGE(PG8_SB(0, 0), b2, voffB);
            PG8_BAR; PG8_WAIT_L(0); PG8_MMA(0, 1, At, B1); PG8_BAR;
            PG8_LDA(At, 0, 1); PG8_STAGE(PG8_SA(0, 0), a2, voffA);
            PG8_BAR; PG8_WAIT_L(0); PG8_MMA(1, 0, At, B0); PG8_BAR; PG8_SCHED;
            PG8_STAGE(PG8_SB(0, 1), b2 + hstep, voffB);
            PG8_WAIT_V(6); PG8_BAR; PG8_MMA(1, 1, At, B1); PG8_BAR;
            PG8_LDB(B0, 1, 0); PG8_SCHED; PG8_LDA(At, 1, 0); PG8_STAGE(PG8_SA(0, 1), a2 + hstep, voffA);
            PG8_WAIT_L(8); PG8_BAR; PG8_WAIT_L(0); PG8_MMA(0, 0, At, B0); PG8_BAR; PG8_SCHED;
            PG8_LDB(B1, 1, 1); PG8_STAGE(PG8_SB(1, 0), b3, voffB);
            PG8_BAR; PG8_WAIT_L(0); PG8_MMA(0, 1, At, B1); PG8_BAR;
            PG8_LDA(At, 1, 1); PG8_STAGE(PG8_SA(1, 0), a3, voffA);
            PG8_BAR; PG8_WAIT_L(0); PG8_MMA(1, 0, At, B0); PG8_BAR; PG8_SCHED;
            PG8_STAGE(PG8_SB(1, 1), b3 + hstep, voffB);
            PG8_WAIT_V(6); PG8_BAR; PG8_MMA(1, 1, At, B1); PG8_BAR;
            }
        }
        if constexpr (ALIGN_EPI) { if (wr == 0) PG8_BAR; }
        if constexpr (!Epi::AFTER_DRAIN) { if constexpr (Epi::HAS_PRE) E(acc, cur, wr, wc, fr, fq, preq); else E(acc, cur, wr, wc, fr, fq); S.done(cur); }
        if (!has_next) break;
#pragma unroll
        for (int a = 0; a < 2; ++a)
#pragma unroll
            for (int b = 0; b < 2; ++b)
#pragma unroll
                for (int m = 0; m < 4; ++m)
#pragma unroll
                    for (int n = 0; n < 2; ++n) acc[a][b][m][n] = (f32x4){0.f, 0.f, 0.f, 0.f};
        cur = nxt; cA = nA; cB = nB; ++ui;
        if constexpr (ALIGN_EPI) { if (wr == 1) PG8_BAR; }
    }
    PG8_WAIT_V(0);
    if constexpr (!ALIGN_EPI) { if (wr == 0) PG8_BAR; }
    PG8_BAR;
#undef PG8_SA
#undef PG8_SB
#undef PG8_STAGE
#undef PG8_LDA
#undef PG8_LDB
#undef PG8_MMA
#undef PG8_WAIT_V
#undef PG8_WAIT_L
#undef PG8_BAR
#undef PG8_SCHED
}
}


#include <hip/hip_bf16.h>
namespace fox {
using bf16h=__hip_bfloat16;
using bf16x8=__attribute__((ext_vector_type(8)))short;
using s16x4=__attribute__((ext_vector_type(4)))short;
using f32x16=__attribute__((ext_vector_type(16)))float;
using f32x4=__attribute__((ext_vector_type(4)))float;
using u32x4=__attribute__((ext_vector_type(4)))unsigned;
constexpr int NHEAD=FH,D=64,DMI=512,DMO=1024;
constexpr int NW=8,QBLK=32,QB=QBLK*NW,KVBLK=64,NQB=SEQ/QB;
__device__ __forceinline__ int crow(int r,int hi){return (r&3)+8*(r>>2)+4*hi;}
#define SBAR() __builtin_amdgcn_sched_barrier(0)
__device__ __forceinline__ void cmask(f32x16&p0,f32x16&p1,int jb,int qrel,int hi){
  const float NEG=-INFINITY; int kb=64*jb+4*hi;
  #pragma unroll
  for(int r=0;r<16;++r){int kv=kb+(r&3)+8*(r>>2); if(kv>qrel)p0[r]=NEG; if(kv+32>qrel)p1[r]=NEG;}
}
constexpr int NSLOT=3, SLOTB=8192;
constexpr int LDS_K=0, LDS_V=NSLOT*SLOTB, LDS_WS=2*NSLOT*SLOTB, LDS_OST=LDS_WS+NW*64*4, LDS_NB=LDS_OST+NW*4096, LDS_BYTES=LDS_NB+SEQ*4;
__device__ __forceinline__ void glds16(const void*gsrc,unsigned lds_dst){unsigned keep;
  asm volatile("s_mov_b32 %0, m0\n\ts_mov_b32 m0, %2\n\ts_nop 0\n\tglobal_load_lds_dwordx4 %1, off\n\ts_mov_b32 m0, %0":"=&s"(keep):"v"(gsrc),"s"(lds_dst):"memory");}
__device__ __forceinline__ float max3f(float a,float b,float c){float r;asm("v_max3_f32 %0, %1, %2, %3":"=v"(r):"v"(a),"v"(b),"v"(c));return r;}
__device__ __forceinline__ float max2f(float a,float b){float r;asm("v_max_f32_e32 %0, %1, %2":"=v"(r):"v"(a),"v"(b));return r;}
__device__ __forceinline__ float fadd_s(float a,float b){float r;asm("v_add_f32_e32 %0, %1, %2":"=v"(r):"v"(a),"v"(b));return r;}
__device__ __forceinline__ float fsub_s(float a,float b){float r;asm("v_sub_f32_e32 %0, %1, %2":"=v"(r):"v"(a),"v"(b));return r;}
typedef float f32x2_t __attribute__((ext_vector_type(2))); typedef __bf16 bf16x2_t __attribute__((ext_vector_type(2)));
__device__ __forceinline__ unsigned cvtpk_s(float lo,float hi){f32x2_t v={lo,hi};bf16x2_t b=__builtin_convertvector(v,bf16x2_t);return __builtin_bit_cast(unsigned,b);}
#define WAIT_BAR(N) asm volatile("s_waitcnt vmcnt(" #N ") lgkmcnt(0)\n\ts_barrier":::"memory")
__device__ __forceinline__ void qkt(f32x16&p0,f32x16&p1,const char*Kslot,const bf16x8*qr,int r32,int hi){
  const char*kb=Kslot+hi*1024+r32*16;
  #pragma unroll
  for(int d0=0;d0<4;++d0){
    const bf16x8 b0=*reinterpret_cast<const bf16x8*>(kb+d0*2048);
    const bf16x8 b1=*reinterpret_cast<const bf16x8*>(kb+d0*2048+512);
    p0=__builtin_amdgcn_mfma_f32_32x32x16_bf16(b0,qr[d0],p0,0,0,0);p1=__builtin_amdgcn_mfma_f32_32x32x16_bf16(b1,qr[d0],p1,0,0,0);}
}
typedef __attribute__((address_space(3))) const char* lds_cptr;
typedef __attribute__((address_space(3))) const float* lds_fptr;
typedef short v4i16_t __attribute__((ext_vector_type(4)));
__device__ __forceinline__ void kload8(bf16x8*kf,lds_cptr kp){
  kf[0]=*(const __attribute__((address_space(3))) bf16x8*)(kp);      kf[1]=*(const __attribute__((address_space(3))) bf16x8*)(kp+512);
  kf[2]=*(const __attribute__((address_space(3))) bf16x8*)(kp+2048); kf[3]=*(const __attribute__((address_space(3))) bf16x8*)(kp+2560);
  kf[4]=*(const __attribute__((address_space(3))) bf16x8*)(kp+4096); kf[5]=*(const __attribute__((address_space(3))) bf16x8*)(kp+4608);
  kf[6]=*(const __attribute__((address_space(3))) bf16x8*)(kp+6144); kf[7]=*(const __attribute__((address_space(3))) bf16x8*)(kp+6656);
}
__device__ __forceinline__ void kload2(bf16x8*kf,lds_cptr kp,int j){ kf[2*j]=*(const __attribute__((address_space(3))) bf16x8*)(kp+j*2048); kf[2*j+1]=*(const __attribute__((address_space(3))) bf16x8*)(kp+j*2048+512); }
__device__ __forceinline__ s16x4 vtr(lds_cptr p){ return __builtin_bit_cast(s16x4,__builtin_amdgcn_ds_read_tr16_b64_v4i16((__attribute__((address_space(3))) v4i16_t*)p)); }
__device__ __forceinline__ float rowmax(const f32x16&p0,const f32x16&p1){
  float a=max3f(p0[0],p0[1],p1[0]),b=max3f(p0[2],p0[3],p1[1]);a=max3f(a,p1[2],p1[3]);
  #pragma unroll
  for(int r=4;r<16;r+=4){a=max3f(a,p0[r],p0[r+1]);b=max3f(b,p0[r+2],p0[r+3]);a=max3f(a,p1[r],p1[r+1]);b=max3f(b,p1[r+2],p1[r+3]);}
  const float m=max2f(a,b);
  auto rr=__builtin_amdgcn_permlane32_swap(__float_as_uint(m),__float_as_uint(m),false,false);
  return max2f(__uint_as_float(rr[0]),__uint_as_float(rr[1]));
}
__device__ __forceinline__ void pv(f32x16*o,int vb,bf16x8 pa0,bf16x8 pa1,bf16x8 pa2,bf16x8 pa3){
  #pragma unroll
  for(int d0=0;d0<2;++d0){s16x4 lo[4],hi[4];
    #pragma unroll
    for(int ks=0;ks<4;++ks){
      asm volatile("ds_read_b64_tr_b16 %0,%1 offset:%c2":"=&v"(lo[ks]):"v"(vb),"i"(d0*4096+ks*1024):"memory");
      asm volatile("ds_read_b64_tr_b16 %0,%1 offset:%c2":"=&v"(hi[ks]):"v"(vb),"i"(d0*4096+ks*1024+512):"memory");}
    asm volatile("s_waitcnt lgkmcnt(0)":::"memory");SBAR();
    #define PK(k) (bf16x8){lo[k][0],lo[k][1],lo[k][2],lo[k][3],hi[k][0],hi[k][1],hi[k][2],hi[k][3]}
    o[d0]=__builtin_amdgcn_mfma_f32_32x32x16_bf16(pa0,PK(0),o[d0],0,0,0);
    o[d0]=__builtin_amdgcn_mfma_f32_32x32x16_bf16(pa1,PK(1),o[d0],0,0,0);
    o[d0]=__builtin_amdgcn_mfma_f32_32x32x16_bf16(pa2,PK(2),o[d0],0,0,0);
    o[d0]=__builtin_amdgcn_mfma_f32_32x32x16_bf16(pa3,PK(3),o[d0],0,0,0);
    #undef PK
  }
}
template<int THRL> __device__ __forceinline__ void attn_unit(int b,int h,int qb,int j0,const bf16h*Q,const bf16h*__restrict__ K,const bf16h*__restrict__ V,bf16h*O,const float*CL,char*shm){
  int tid=threadIdx.x; asm volatile("":"+v"(tid));
  const int lane=tid&63,r32=lane&31,hi=lane>>5; const int wid=__builtin_amdgcn_readfirstlane(tid>>6);
  const long rowbase=(long)b*SEQ; const int q0=qb*QB; const long kvbase=rowbase+(long)j0*KVBLK;
  const bf16h*Qw=Q+(rowbase+q0+wid*QBLK)*DMI+h*D;
  const bf16h*Kh=K+kvbase*DMI+h*D,*Vh=V+kvbase*DMI+h*D;
  const unsigned lds0=(unsigned)(uintptr_t)shm;
  float*wsf=(float*)(shm+LDS_WS)+wid*64;
  const int NT=(q0+QB)/KVBLK-j0;
  { float*nbw=(float*)(shm+LDS_NB); const float*src=CL+(long)j0*KVBLK;
    for(int i=tid*4;i<NT*KVBLK;i+=512*4){ const f32x4 v=*(const f32x4*)(src+i); *(f32x4*)(nbw+i)=(f32x4){-v[0],-v[1],-v[2],-v[3]}; } }
  const bf16h*ksrc=Kh+(long)lane*DMI+wid*8;
  const bf16h*vsrc=Vh+(long)(16*(wid&3)+(lane>>2))*DMI+(wid>>2)*32+(lane&3)*8;
  const unsigned kdst=lds0+LDS_K+wid*1024, vdst=lds0+LDS_V+wid*1024;
  #define DMA_K(t,slot) glds16(ksrc+(long)(t)*KVBLK*DMI,(unsigned)__builtin_amdgcn_readfirstlane(kdst+(slot)))
  #define DMA_V(t,slot) glds16(vsrc+(long)(t)*KVBLK*DMI,(unsigned)__builtin_amdgcn_readfirstlane(vdst+(slot)))
  const int vb0=(int)(lds0+LDS_V)+((lane>>4)&1)*32+(lane&3)*8+(4*hi+((lane&15)>>2))*64;
  const char*Kbase=shm+LDS_K; bf16x8 kf[8];
  const lds_cptr shm3=(lds_cptr)shm; const lds_cptr kp0=shm3+LDS_K+hi*1024+r32*16; const lds_cptr vp0=shm3+LDS_V+((lane>>4)&1)*32+(lane&3)*8+(4*hi+((lane&15)>>2))*64;
  const lds_fptr nb0=(lds_fptr)(shm3+LDS_NB)+4*hi;
  DMA_K(0,0);DMA_V(0,0);DMA_K(1,SLOTB);
  bf16x8 qr[4];
  #pragma unroll
  for(int d0=0;d0<4;++d0)qr[d0]=*reinterpret_cast<const bf16x8*>(&Qw[(long)r32*DMI+d0*16+hi*8]);
  float mhat=0.f,l_reg=0.f;f32x16 o[2];o[0]=f32x16{};o[1]=f32x16{};
  const int qrel=wid*QBLK+r32;
  #define CMASK(P0,P1,t) do{int jb_=(t)-(NT-4); if(jb_>=0)cmask(P0,P1,jb_,qrel,hi);}while(0)
  #define PRELOAD(P0,P1,tt) do{ const lds_fptr nbp_=nb0+(tt)*KVBLK; \
    _Pragma("unroll") for(int g_=0;g_<4;++g_){ const f32x4 a_=*(const __attribute__((address_space(3))) f32x4*)(nbp_+8*g_), b_=*(const __attribute__((address_space(3))) f32x4*)(nbp_+32+8*g_); \
      P0[4*g_]=a_[0]-mhat;P0[4*g_+1]=a_[1]-mhat;P0[4*g_+2]=a_[2]-mhat;P0[4*g_+3]=a_[3]-mhat; P1[4*g_]=b_[0]-mhat;P1[4*g_+1]=b_[1]-mhat;P1[4*g_+2]=b_[2]-mhat;P1[4*g_+3]=b_[3]-mhat; } }while(0)
  bool resc=false;
  #define START(P0,P1) do{ const float rm=rowmax(P0,P1); resc=false; \
    { const float dl=rm; mhat=fadd_s(mhat,dl); \
      _Pragma("unroll") for(int r=0;r<16;++r){P0[r]=fsub_s(P0[r],dl);P1[r]=fsub_s(P1[r],dl);} } \
    _Pragma("unroll") for(int r=0;r<16;++r)P0[r]=__builtin_amdgcn_exp2f(P0[r]); }while(0)
  #define RESC() do{ if(resc){ asm volatile("s_waitcnt lgkmcnt(0)":::"memory"); \
      _Pragma("unroll") for(int d_=0;d_<2;++d_) _Pragma("unroll") for(int r=0;r<16;++r)o[d_][r]*=wsf[crow(r,hi)]; } }while(0)
  f32x16 pA0,pA1,pB0,pB1;
  int sl_prev=0,sl_cur=0,sl_next=SLOTB;
  #define ROT() do{sl_prev=sl_cur;sl_cur=sl_next;sl_next=(sl_next==(NSLOT-1)*SLOTB)?0:sl_next+SLOTB;}while(0)
  DMA_K(2,2*SLOTB);
  WAIT_BAR(3);
  PRELOAD(pA0,pA1,0);
  qkt(pA0,pA1,Kbase,qr,r32,hi);asm volatile("s_nop 15\n\ts_nop 7":"+v"(pA0),"+v"(pA1));CMASK(pA0,pA1,0);
  START(pA0,pA1);
  _Pragma("unroll") for(int r=0;r<16;++r)pA1[r]=__builtin_amdgcn_exp2f(pA1[r]);
  WAIT_BAR(0);
  DMA_K(3,0);DMA_V(1,SLOTB);
  ROT();
  kload8(kf,kp0+sl_cur);
  PRELOAD(pB0,pB1,1);
  WAIT_BAR(2);
  s16x4 vlo[8],vhi[8]; u32x4 pw0,pw1,pw2,pw3;
  #define PKW(P,B) cvtpk_s(P[B],P[B+1])
  #define PAF(k) __builtin_bit_cast(bf16x8,pw##k)
  #define VFR(i) (bf16x8){vlo[i][0],vlo[i][1],vlo[i][2],vlo[i][3],vhi[i][0],vhi[i][1],vhi[i][2],vhi[i][3]}
  #define PIN(x) asm volatile("":"+v"(x))
  #define MX3(a,b,c) __builtin_fmaxf(__builtin_fmaxf((a),(b)),(c))
  #define GAPA(MF,A0,A1,A2,A3,W0,W1,PW) do{ MF; sacc+=A0; sacc+=A1; sacc+=A2; sacc+=A3; PIN(sacc); W0; W1; PIN(PW); SBAR(); }while(0)
  #define EX(v) __builtin_amdgcn_exp2f(v)
  #define GAPB(MF,X,B) do{ MF; X[B]=EX(X[B]); X[B+1]=EX(X[B+1]); X[B+2]=EX(X[B+2]); X[B+3]=EX(X[B+3]); PIN(X); SBAR(); }while(0)
  #define VRD(i) do{ vlo[i]=vtr(vp_+(((i)>>2)*4096+((i)&3)*1024)); vhi[i]=vtr(vp_+(((i)>>2)*4096+((i)&3)*1024+512)); }while(0)
  #define KRD(G,j) do{ if(G){ kload2(kf,kp0+sl_next,j); SBAR(); } }while(0)
  #define STEP(C0,C1,P0,P1,t,GK,GV,GL) do{ SBAR(); \
    const lds_cptr vp_=vp0+sl_prev; \
    VRD(0); SBAR(); float sacc=(P0[0]+P0[1]); \
    GAPA(C0=__builtin_amdgcn_mfma_f32_32x32x16_bf16(kf[0],qr[0],C0,0,0,0), P0[2],P0[3],P0[4],P0[5],     pw0[0]=PKW(P0,0), pw0[1]=PKW(P0,2), pw0); \
    VRD(4); SBAR(); GAPA(C1=__builtin_amdgcn_mfma_f32_32x32x16_bf16(kf[1],qr[0],C1,0,0,0), P0[6],P0[7],P0[8],P0[9],     pw0[2]=PKW(P0,4), pw0[3]=PKW(P0,6), pw0); \
    VRD(1); SBAR(); GAPA(C0=__builtin_amdgcn_mfma_f32_32x32x16_bf16(kf[2],qr[1],C0,0,0,0),   P0[10],P0[11],P0[12],P0[13], pw1[0]=PKW(P0,8), pw1[1]=PKW(P0,10), pw1); \
    VRD(5); SBAR(); GAPA(C1=__builtin_amdgcn_mfma_f32_32x32x16_bf16(kf[3],qr[1],C1,0,0,0),   P0[14],P0[15],P1[0],P1[1],   pw1[2]=PKW(P0,12),pw1[3]=PKW(P0,14), pw1); \
    VRD(2); SBAR(); GAPA(C0=__builtin_amdgcn_mfma_f32_32x32x16_bf16(kf[4],qr[2],C0,0,0,0),   P1[2],P1[3],P1[4],P1[5],     pw2[0]=PKW(P1,0), pw2[1]=PKW(P1,2), pw2); \
    VRD(6); SBAR(); GAPA(C1=__builtin_amdgcn_mfma_f32_32x32x16_bf16(kf[5],qr[2],C1,0,0,0),   P1[6],P1[7],P1[8],P1[9],     pw2[2]=PKW(P1,4), pw2[3]=PKW(P1,6), pw2); \
    VRD(3); SBAR(); GAPA(C0=__builtin_amdgcn_mfma_f32_32x32x16_bf16(kf[6],qr[3],C0,0,0,0),   P1[10],P1[11],P1[12],P1[13], pw3[0]=PKW(P1,8), pw3[1]=PKW(P1,10), pw3); \
    VRD(7); SBAR(); GAPA(C1=__builtin_amdgcn_mfma_f32_32x32x16_bf16(kf[7],qr[3],C1,0,0,0),   P1[14],P1[15],0.f,0.f,       pw3[2]=PKW(P1,12),pw3[3]=PKW(P1,14), pw3); \
    l_reg+=sacc; \
    if(GK){DMA_K((t)+3,sl_cur);} if(GV){DMA_V((t)+1,sl_next);} \
    CMASK(C0,C1,t); \
    { float a=MX3(C0[0],C0[1],C1[0]),b=MX3(C0[2],C0[3],C1[1]); a=MX3(a,C1[2],C1[3]); \
      _Pragma("unroll") for(int r=4;r<16;r+=4){a=MX3(a,C0[r],C0[r+1]);b=MX3(b,C0[r+2],C0[r+3]);a=MX3(a,C1[r],C1[r+1]);b=MX3(b,C1[r+2],C1[r+3]);} \
      float rm=__builtin_fmaxf(a,b); { auto rr=__builtin_amdgcn_permlane32_swap(__float_as_uint(rm),__float_as_uint(rm),false,false); rm=__builtin_fmaxf(__uint_as_float(rr[0]),__uint_as_float(rr[1])); } \
      resc=false; \
      if(__builtin_expect(__any(rm>(float)THRL),0)){ const float dl=__builtin_fmaxf(rm,0.f); mhat+=dl; \
        _Pragma("unroll") for(int r=0;r<16;++r){C0[r]-=dl;C1[r]-=dl;} \
        const float f=__builtin_amdgcn_exp2f(-dl); l_reg*=f; if(hi==0)wsf[r32]=f; resc=true; } } \
    SBAR(); \
    GAPB(o[0]=__builtin_amdgcn_mfma_f32_32x32x16_bf16(PAF(0),VFR(0),o[0],0,0,0), C0,0); \
    GAPB(o[1]=__builtin_amdgcn_mfma_f32_32x32x16_bf16(PAF(0),VFR(4),o[1],0,0,0), C0,4); \
    KRD(GL,0); GAPB(o[0]=__builtin_amdgcn_mfma_f32_32x32x16_bf16(PAF(1),VFR(1),o[0],0,0,0), C0,8); \
    KRD(GL,1); GAPB(o[1]=__builtin_amdgcn_mfma_f32_32x32x16_bf16(PAF(1),VFR(5),o[1],0,0,0), C0,12); \
    KRD(GL,2); GAPB(o[0]=__builtin_amdgcn_mfma_f32_32x32x16_bf16(PAF(2),VFR(2),o[0],0,0,0), C1,0); \
    KRD(GL,3); GAPB(o[1]=__builtin_amdgcn_mfma_f32_32x32x16_bf16(PAF(2),VFR(6),o[1],0,0,0), C1,4); \
    GAPB(o[0]=__builtin_amdgcn_mfma_f32_32x32x16_bf16(PAF(3),VFR(3),o[0],0,0,0), C1,8); \
    GAPB(o[1]=__builtin_amdgcn_mfma_f32_32x32x16_bf16(PAF(3),VFR(7),o[1],0,0,0), C1,12); \
    if(GL){ PRELOAD(P0,P1,(t)+1); } \
    }while(0)
  int t=1;
  #undef CMASK
  #define CMASK(P0,P1,t) do{}while(0)
  for(;t+5<NT;t+=2){
    STEP(pB0,pB1,pA0,pA1,t,true,true,true);     WAIT_BAR(2); RESC(); ROT();
    STEP(pA0,pA1,pB0,pB1,t+1,true,true,true);   WAIT_BAR(2); RESC(); ROT();
  }
  #undef CMASK
  #define CMASK(P0,P1,t) do{int jb_=(t)-(NT-4); if(jb_>=0)cmask(P0,P1,jb_,qrel,hi);}while(0)
  #define ENDW(tt) do{ if((tt)+3<NT){WAIT_BAR(2);} else if((tt)+2<NT){WAIT_BAR(1);} else {WAIT_BAR(0);} }while(0)
  for(;t+1<NT;t+=2){
    STEP(pB0,pB1,pA0,pA1,t,(t+3<NT),(t+1<NT),(t+1<NT));       ENDW(t);   RESC(); ROT();
    STEP(pA0,pA1,pB0,pB1,t+1,(t+4<NT),(t+2<NT),(t+2<NT));     ENDW(t+1); RESC(); ROT();
  }
  STEP(pB0,pB1,pA0,pA1,NT-1,false,false,false); RESC();
  { float sacc=pB0[0]+pB0[1]; _Pragma("unroll") for(int r=2;r<16;++r)sacc+=pB0[r]; _Pragma("unroll") for(int r=0;r<16;++r)sacc+=pB1[r]; l_reg+=sacc;
    pw0=(u32x4){PKW(pB0,0),PKW(pB0,2),PKW(pB0,4),PKW(pB0,6)};pw1=(u32x4){PKW(pB0,8),PKW(pB0,10),PKW(pB0,12),PKW(pB0,14)};pw2=(u32x4){PKW(pB1,0),PKW(pB1,2),PKW(pB1,4),PKW(pB1,6)};pw3=(u32x4){PKW(pB1,8),PKW(pB1,10),PKW(pB1,12),PKW(pB1,14)};
    SBAR(); pv(o,vb0+sl_cur,PAF(0),PAF(1),PAF(2),PAF(3)); }
  #undef PKW
  #undef PAF
  #undef VFR
  #undef PIN
  #undef MX3
  #undef GAPA
  #undef GAPB
  #undef EX
  #undef VRD
  #undef KRD
  #undef STEP
  #undef ENDW
  {auto rr=__builtin_amdgcn_permlane32_swap(__float_as_uint(l_reg),__float_as_uint(l_reg),false,false);l_reg=__uint_as_float(rr[0])+__uint_as_float(rr[1]);}
  if(hi==0)wsf[32+r32]=l_reg;asm volatile("s_waitcnt lgkmcnt(0)":::"memory");
  float rli[16];
  #pragma unroll
  for(int r=0;r<16;++r)rli[r]=__builtin_amdgcn_rcpf(wsf[32+crow(r,hi)]);
  bf16h*Ow=O+(rowbase+q0+wid*QBLK)*DMO+h*D;
  { bf16h*stg=(bf16h*)(shm+LDS_OST)+wid*2048;
    #pragma unroll
    for(int r=0;r<16;++r){const int orow=crow(r,hi);
      #pragma unroll
      for(int d0=0;d0<2;++d0)stg[orow*64+d0*32+r32]=__float2bfloat16(o[d0][r]*rli[r]);}
    asm volatile("s_waitcnt lgkmcnt(0)":::"memory");
    #pragma unroll
    for(int i=0;i<4;++i){const int row=i*8+(lane>>3),ch=lane&7; const u32x4 v=*(const u32x4*)(stg+row*64+ch*8); *(u32x4*)(Ow+(long)row*DMO+ch*8)=v;} }
  asm volatile("s_waitcnt lgkmcnt(0)\n\ts_barrier":::"memory");
  #undef DMA_K
  #undef DMA_V
  #undef CMASK
  #undef PRELOAD
  #undef START
  #undef RESC
  #undef ROT
}

__device__ __forceinline__ int unit_j0_wave(int bh,int qb,const bf16h*Q,const float*KN2,const float*CL,int lane){
  const int b=bh/NHEAD,h=bh%NHEAD; constexpr int NTT=SEQ/KVBLK;
  float mx=0.f;
  #pragma unroll
  for(int rr=0;rr<QB/64;++rr){ const bf16h*Qw=Q+((long)b*SEQ+qb*QB+rr*64+lane)*DMI+h*D; float ss=0.f;
    #pragma unroll
    for(int c=0;c<8;++c){ const u32x4 v=*reinterpret_cast<const u32x4*>(&Qw[c*8]);
      #pragma unroll
      for(int e=0;e<4;++e){ const float f0=__uint_as_float(v[e]<<16),f1=__uint_as_float(v[e]&0xffff0000u); ss+=f0*f0+f1*f1; } }
    mx=fmaxf(mx,ss); }
  #pragma unroll
  for(int o=1;o<64;o<<=1) mx=fmaxf(mx,__shfl_xor(mx,o));
  const int nt=4*qb; const float*kn=KN2+bh*NTT;
  const float Qn=sqrtf(mx),KNd=sqrtf(fmaxf(fmaxf(kn[nt],kn[nt+1]),fmaxf(kn[nt+2],kn[nt+3])));
  const float clt0=CL[qb*QB];
  int first=nt;
  #pragma unroll
  for(int part=1;part>=0;--part){ const int i=lane+64*part; bool need=false;
    if(i<nt){ const float bound=Qn*(sqrtf(kn[i])+KNd)+clt0-CL[KVBLK*i+KVBLK-1]; need=!(bound<-40.f); }
    const unsigned long long bal=__ballot(need); if(bal) first=__ffsll((long long)bal)-1+64*part; }
  return (first<nt?first:nt)&~1;
}
#undef SBAR
#undef WAIT_BAR
}

#define GAS __attribute__((address_space(1)))
#define LAS __attribute__((address_space(3)))
typedef unsigned v4u __attribute__((ext_vector_type(4)));
typedef float f32x4 __attribute__((ext_vector_type(4)));
typedef GAS unsigned gu32;
#define RLX_AGENT __ATOMIC_RELAXED, __HIP_MEMORY_SCOPE_AGENT
#define LDS_WAIT() asm volatile("s_waitcnt lgkmcnt(0)" ::: "memory")
#define VM_WAIT() asm volatile("s_waitcnt vmcnt(0)" ::: "memory")
__device__ __forceinline__ unsigned pk2(float lo, float hi) { return (unsigned)f2bf(lo) | ((unsigned)f2bf(hi) << 16); }
__device__ __forceinline__ void unpack8(const v4u w, float* f) {
#pragma unroll
    for (int i = 0; i < 4; ++i) { f[2 * i] = __uint_as_float(w[i] << 16); f[2 * i + 1] = __uint_as_float(w[i] & 0xffff0000u); }
}

#define XB_TMO      128
#define XB_XCNT(j)  (256  + 64 * (j))
#define XB_XSUB(j)  (1280 + 64 * (j))
#define XB_XGEN(j)  (2304 + 64 * (j))
#define XB_TOP      3328
#define XB_TOPGEN   3392
#define XCD_BAR_WORDS 3456
#define XB_SPIN_CAP (1u << 18)
__device__ __forceinline__ unsigned xb_ld(unsigned* p)              { return __hip_atomic_load(p, __ATOMIC_RELAXED, __HIP_MEMORY_SCOPE_AGENT); }
__device__ __forceinline__ unsigned xb_add(unsigned* p, unsigned v) { return __hip_atomic_fetch_add(p, v, __ATOMIC_RELAXED, __HIP_MEMORY_SCOPE_AGENT); }
__device__ __forceinline__ unsigned xb_xcc_id() { return (unsigned)__builtin_amdgcn_s_getreg((3 << 11) | 20) & 0xFu; }
#define XB_SPIN(cond, bar) do { unsigned _sp = 0; while (cond) { __builtin_amdgcn_s_sleep(1); \
    if ((++_sp & 255u) == 0u) { if (xb_ld(&(bar)[XB_TMO])) break; if (_sp > XB_SPIN_CAP) { atomicAdd(&(bar)[XB_TMO], 1u); break; } } } } while (0)
struct XcdBarrier { unsigned* bar; unsigned x; volatile LAS unsigned* st; };
__device__ __forceinline__ XcdBarrier xcd_barrier_post(unsigned* bar, volatile LAS unsigned* st) {
    XcdBarrier b; b.bar = bar; b.x = xb_xcc_id(); b.st = st;
    if (threadIdx.x == 0) (void)xb_add(&bar[XB_XCNT(b.x)], 1u);
    return b;
}
__device__ __forceinline__ void xcd_barrier_complete(unsigned* bar, unsigned x, unsigned& nloc, unsigned& nx) {
    const unsigned G = gridDim.x * gridDim.y * gridDim.z;
    unsigned sum, cnt, mine, sp = 0u;
    for (;;) {
        sum = 0u; cnt = 0u; mine = 0u;
#pragma unroll
        for (unsigned j = 0; j < 16; ++j) { const unsigned c = xb_ld(&bar[XB_XCNT(j)]); sum += c; cnt += (c > 0u) ? 1u : 0u; mine = (j == x) ? c : mine; }
        if (sum == G) break;
        __builtin_amdgcn_s_sleep(1);
        if ((++sp & 255u) == 0u) { if (xb_ld(&bar[XB_TMO])) break; if (sp > XB_SPIN_CAP) { atomicAdd(&bar[XB_TMO], 1u); break; } }
    }
    nloc = mine > 0u ? mine : 1u; nx = cnt > 0u ? cnt : 1u;
}
__device__ __forceinline__ void xcd_barrier(const XcdBarrier& b) {
    asm volatile("s_waitcnt vmcnt(0)" ::: "memory");
    __syncthreads();
    if (threadIdx.x == 0) {
        unsigned* bar = b.bar;
        __builtin_amdgcn_s_waitcnt(0);
        unsigned nloc = b.st[0], nx = b.st[1];
        if (nloc == 0u) { xcd_barrier_complete(bar, b.x, nloc, nx); b.st[0] = nloc; b.st[1] = nx; }
        const unsigned old = xb_add(&bar[XB_XSUB(b.x)], 1u);
        const unsigned gen = old / nloc;
        if (old + 1u == (gen + 1u) * nloc) {
            __builtin_amdgcn_fence(__ATOMIC_RELEASE, "agent");
            asm volatile("s_waitcnt vmcnt(0)" ::: "memory");
            const unsigned og = xb_add(&bar[XB_TOP], 1u);
            const unsigned tg = og / nx;
            if (og + 1u == (tg + 1u) * nx) xb_add(&bar[XB_TOPGEN], 1u);
            else XB_SPIN(xb_ld(&bar[XB_TOPGEN]) == tg, bar);
            __builtin_amdgcn_fence(__ATOMIC_ACQUIRE, "agent");
            xb_add(&bar[XB_XGEN(b.x)], 1u);
            asm volatile("s_waitcnt vmcnt(0)" ::: "memory");
        } else {
            XB_SPIN(xb_ld(&bar[XB_XGEN(b.x)]) == gen, bar);
            __builtin_amdgcn_fence(__ATOMIC_ACQUIRE, "agent");
            asm volatile("s_waitcnt vmcnt(0)" ::: "memory");
        }
    }
    __syncthreads();
}


namespace xat {
typedef short bf16x8 __attribute__((ext_vector_type(8)));
typedef short s16x4 __attribute__((ext_vector_type(4)));
typedef float f32x16 __attribute__((ext_vector_type(16)));
constexpr int RB = 272;
constexpr int KIMG = 0, VIMG = 128 * RB, LDS_BYTES = 2 * 128 * RB;
__device__ __forceinline__ unsigned cvtpk(float lo, float hi) { typedef float f2 __attribute__((ext_vector_type(2))); typedef __bf16 b2 __attribute__((ext_vector_type(2))); f2 v = {lo, hi}; b2 b = __builtin_convertvector(v, b2); return __builtin_bit_cast(unsigned, b); }
__device__ __forceinline__ float swapmax(float m) { auto rr = __builtin_amdgcn_permlane32_swap(__float_as_uint(m), __float_as_uint(m), false, false); return fmaxf(__uint_as_float(rr[0]), __uint_as_float(rr[1])); }
__device__ __forceinline__ float swapadd(float m) { auto rr = __builtin_amdgcn_permlane32_swap(__float_as_uint(m), __float_as_uint(m), false, false); return __uint_as_float(rr[0]) + __uint_as_float(rr[1]); }
__device__ __forceinline__ void unit(int b, int head, int qb, const bf16* QX, const bf16* KX, const bf16* VT, bf16* OX, LAS unsigned char* lds) {
    int tid = threadIdx.x; asm volatile("" : "+v"(tid));
    const int lane = tid & 63, r32 = lane & 31, h = lane >> 5, wid = tid >> 6;
    const size_t qrow = (size_t)b * SEQ + (size_t)qb * 256 + wid * 32 + r32;
    bf16x8 qf[8];
#pragma unroll
    for (int d0 = 0; d0 < 8; ++d0) qf[d0] = *(const bf16x8*)(QX + qrow * 512 + head * 128 + 16 * d0 + 8 * h);
    f32x16 o[4];
#pragma unroll
    for (int db = 0; db < 4; ++db) o[db] = (f32x16){};
    float mrun = -INFINITY, lsum = 0.f;
#pragma unroll 1
    for (int half = 0; half < 2; ++half) {
        __syncthreads();
#pragma unroll
        for (int i = 0; i < 4; ++i) { const int c = tid + 512 * i, row = c >> 4, ch = c & 15;
            const v4u kv = *(const GAS v4u*)(KX + ((size_t)b * NMEM + half * 128 + row) * 512 + head * 128 + ch * 8);
            const v4u vv = *(const GAS v4u*)(VT + ((size_t)head * 128 + row) * 512 + b * NMEM + half * 128 + ch * 8);
            *(LAS v4u*)(lds + KIMG + row * RB + ch * 16) = kv; *(LAS v4u*)(lds + VIMG + row * RB + ch * 16) = vv; }
        __syncthreads();
        f32x16 st[4];
#pragma unroll
        for (int kb = 0; kb < 4; ++kb) { st[kb] = (f32x16){};
#pragma unroll
            for (int d0 = 0; d0 < 8; ++d0) { const bf16x8 a = *(const LAS bf16x8*)(lds + KIMG + (32 * kb + r32) * RB + (16 * d0 + 8 * h) * 2);
                st[kb] = __builtin_amdgcn_mfma_f32_32x32x16_bf16(a, qf[d0], st[kb], 0, 0, 0); } }
        float mloc = st[0][0];
#pragma unroll
        for (int kb = 0; kb < 4; ++kb)
#pragma unroll
            for (int i = 0; i < 16; ++i) mloc = fmaxf(mloc, st[kb][i]);
        const float mnew = fmaxf(mrun, swapmax(mloc)), alpha = __builtin_amdgcn_exp2f(mrun - mnew);
        float psum = 0.f;
#pragma unroll
        for (int kb = 0; kb < 4; ++kb)
#pragma unroll
            for (int i = 0; i < 16; ++i) { st[kb][i] = __builtin_amdgcn_exp2f(st[kb][i] - mnew); psum += st[kb][i]; }
        lsum = lsum * alpha + psum; mrun = mnew;
#pragma unroll
        for (int db = 0; db < 4; ++db)
#pragma unroll
            for (int i = 0; i < 16; ++i) o[db][i] *= alpha;
#pragma unroll
        for (int kb = 0; kb < 4; ++kb)
#pragma unroll
            for (int sp = 0; sp < 2; ++sp) {
                v4u pw; pw.x = cvtpk(st[kb][8 * sp], st[kb][8 * sp + 1]); pw.y = cvtpk(st[kb][8 * sp + 2], st[kb][8 * sp + 3]); pw.z = cvtpk(st[kb][8 * sp + 4], st[kb][8 * sp + 5]); pw.w = cvtpk(st[kb][8 * sp + 6], st[kb][8 * sp + 7]);
                const bf16x8 pb = __builtin_bit_cast(bf16x8, pw);
#pragma unroll
                for (int db = 0; db < 4; ++db) { const LAS unsigned char* vp = lds + VIMG + (32 * db + r32) * RB + (32 * kb + 16 * sp + 4 * h) * 2;
                    const s16x4 lo = *(const LAS s16x4*)vp, hi = *(const LAS s16x4*)(vp + 16);
                    const bf16x8 va = {lo[0], lo[1], lo[2], lo[3], hi[0], hi[1], hi[2], hi[3]};
                    o[db] = __builtin_amdgcn_mfma_f32_32x32x16_bf16(va, pb, o[db], 0, 0, 0); } }
    }
    const float inv = 1.f / swapadd(lsum);
    bf16* orow = OX + qrow * 512 + head * 128;
#pragma unroll
    for (int db = 0; db < 4; ++db)
#pragma unroll
        for (int g = 0; g < 4; ++g) {
            const unsigned long long w = (unsigned long long)cvtpk(o[db][4 * g] * inv, o[db][4 * g + 1] * inv) | ((unsigned long long)cvtpk(o[db][4 * g + 2] * inv, o[db][4 * g + 3] * inv) << 32);
            *(GAS unsigned long long*)(orow + 32 * db + 8 * g + 4 * h) = w; }
}
}


namespace mls {
typedef short bf16x8 __attribute__((ext_vector_type(8)));
typedef short s16x4 __attribute__((ext_vector_type(4)));
typedef float f32x16 __attribute__((ext_vector_type(16)));
constexpr int RB = 128, VIMG = 0, KIMG = 8192, ATAB = 8192, NTAB = 8448;
__device__ __forceinline__ s16x4 trd(const LAS unsigned char* p) { typedef short v4i16_t __attribute__((ext_vector_type(4))); return __builtin_bit_cast(s16x4, __builtin_amdgcn_ds_read_tr16_b64_v4i16((LAS v4i16_t*)p)); }
__device__ __forceinline__ bf16x8 cat8(s16x4 lo, s16x4 hi) { return (bf16x8){lo[0], lo[1], lo[2], lo[3], hi[0], hi[1], hi[2], hi[3]}; }
__device__ __forceinline__ unsigned cvtpk(float lo, float hi) { typedef float f2 __attribute__((ext_vector_type(2))); typedef __bf16 b2 __attribute__((ext_vector_type(2))); f2 v = {lo, hi}; b2 b = __builtin_convertvector(v, b2); return __builtin_bit_cast(unsigned, b); }
__device__ __forceinline__ bf16x8 pack8(const float* f) { v4u w; w.x = cvtpk(f[0], f[1]); w.y = cvtpk(f[2], f[3]); w.z = cvtpk(f[4], f[5]); w.w = cvtpk(f[6], f[7]); return __builtin_bit_cast(bf16x8, w); }
__device__ __forceinline__ float swapadd(float m) { auto rr = __builtin_amdgcn_permlane32_swap(__float_as_uint(m), __float_as_uint(m), false, false); return __uint_as_float(rr[0]) + __uint_as_float(rr[1]); }
__device__ __forceinline__ int crow(int r, int hi) { return (r & 3) + 8 * (r >> 2) + 4 * hi; }

__device__ __forceinline__ void u_unit(const Ptrs& P, int bhk, LAS unsigned char* wl, int lane) {
    const int bh = bhk / NCH, k = bhk % NCH, b = bh / MH, hd = bh % MH; const size_t row0 = (size_t)b * SEQ + (size_t)k * 64;
    const int r32 = lane & 31, h = lane >> 5;
    const float li = WSP(const float, WS_GATE)[(size_t)hd * M + row0 + lane], bl = WSP(const float, WS_BL)[(size_t)bh * SEQ + k * 64 + lane];
    const float wg = __expf(WSP(const float, WS_BT)[bhk] - bl + li - WSP(const float, WS_MS)[bh * (NCH + 1) + k + 1]);
    const bf16* vsrc = WSP(const bf16, R_T0 + SZ_T) + row0 * 512 + hd * 64; const bf16* ksrc = WSP(const bf16, R_MQK) + row0 * 512 + 256 + hd * 64;
#pragma unroll
    for (int i = 0; i < 8; ++i) { const int row = i * 8 + (lane >> 3), ch = lane & 7;
        *(LAS v4u*)(wl + VIMG + row * RB + ch * 16) = *(const GAS v4u*)(vsrc + (size_t)row * 512 + ch * 8);
        const v4u kk = *(const GAS v4u*)(ksrc + (size_t)row * 512 + ch * 8); float f[8]; unpack8(kk, f); const float w = __shfl(wg, row);
#pragma unroll
        for (int e = 0; e < 8; ++e) f[e] *= w;
        *(LAS bf16x8*)(wl + KIMG + row * RB + ch * 16) = pack8(f); }
    f32x16 acc[2][2];
#pragma unroll
    for (int a = 0; a < 2; ++a)
#pragma unroll
        for (int c = 0; c < 2; ++c) acc[a][c] = (f32x16){};
    const unsigned toff = (unsigned)(((lane & 15) >> 2) * RB + (16 * ((lane >> 4) & 1) + 4 * (lane & 3)) * 2);
#pragma unroll
    for (int st = 0; st < 4; ++st) { bf16x8 af[2], bf_[2];
#pragma unroll
        for (int c = 0; c < 2; ++c) { const LAS unsigned char* pv = wl + VIMG + (16 * st + 8 * h) * RB + toff + 64 * c; af[c] = cat8(trd(pv), trd(pv + 4 * RB));
                                      const LAS unsigned char* pk = wl + KIMG + (16 * st + 8 * h) * RB + toff + 64 * c; bf_[c] = cat8(trd(pk), trd(pk + 4 * RB)); }
#pragma unroll
        for (int jb = 0; jb < 2; ++jb)
#pragma unroll
            for (int ib = 0; ib < 2; ++ib) acc[jb][ib] = __builtin_amdgcn_mfma_f32_32x32x16_bf16(af[jb], bf_[ib], acc[jb][ib], 0, 0, 0); }
    float* UT = WSP(float, R_CST) + (size_t)bhk * 4096;
#pragma unroll
    for (int jb = 0; jb < 2; ++jb)
#pragma unroll
        for (int ib = 0; ib < 2; ++ib)
#pragma unroll
            for (int e = 0; e < 16; ++e) UT[(32 * jb + crow(e, h)) * 64 + 32 * ib + r32] = acc[jb][ib][e];
    float sn = 0.f;
#pragma unroll 8
    for (int r = 0; r < 64; ++r) sn += bf2f(*(const LAS bf16*)(wl + KIMG + r * RB + lane * 2));
    WSP(float, WS_NST)[(size_t)bhk * 64 + lane] = sn;
}

__device__ __forceinline__ void decay_apply(f32x16& tile, int sb, int tb, const LAS float* atab, float mx, float& dsum, int r32, int h) {
#pragma unroll
    for (int g = 0; g < 4; ++g) { const f32x4 av = *(const LAS f32x4*)(atab + 32 * sb + 8 * g + 4 * h);
#pragma unroll
        for (int c = 0; c < 4; ++c) { const int sidx = 32 * sb + 8 * g + 4 * h + c, t = 32 * tb + r32;
            const float w = (sidx <= t) ? __expf(av[c] - mx) : 0.f; tile[4 * g + c] *= w; dsum += tile[4 * g + c]; } }
}
__device__ __forceinline__ bf16x8 packstep(const f32x16& x, int st) { v4u w; w.x = cvtpk(x[8 * st], x[8 * st + 1]); w.y = cvtpk(x[8 * st + 2], x[8 * st + 3]); w.z = cvtpk(x[8 * st + 4], x[8 * st + 5]); w.w = cvtpk(x[8 * st + 6], x[8 * st + 7]); return __builtin_bit_cast(bf16x8, w); }

__device__ __forceinline__ void out_unit(const Ptrs& P, int l, int bhk, LAS unsigned char* wl, int lane) {
    const int bh = bhk / NCH, k = bhk % NCH, b = bh / MH, hd = bh % MH; const size_t row0 = (size_t)b * SEQ + (size_t)k * 64;
    const int r32 = lane & 31, h = lane >> 5;
    const bf16* T1 = WSP(const bf16, R_T0 + SZ_T); const bf16* MQK = WSP(const bf16, R_MQK);
    const bf16* vsrc = T1 + row0 * 512 + hd * 64;
    v4u vreg[8];
#pragma unroll
    for (int i = 0; i < 8; ++i) { const int row = i * 8 + (lane >> 3), ch = lane & 7; vreg[i] = *(const GAS v4u*)(vsrc + (size_t)row * 512 + ch * 8); }
    bf16x8 qf[2][4], kf[2][4];
#pragma unroll
    for (int tb = 0; tb < 2; ++tb)
#pragma unroll
        for (int d0 = 0; d0 < 4; ++d0) { qf[tb][d0] = *(const bf16x8*)(MQK + (row0 + 32 * tb + r32) * 512 + hd * 64 + 16 * d0 + 8 * h);
                                         kf[tb][d0] = *(const bf16x8*)(MQK + (row0 + 32 * tb + r32) * 512 + 256 + hd * 64 + 16 * d0 + 8 * h); }
    const float li_s = WSP(const float, WS_GATE)[(size_t)hd * M + row0 + lane], bl_s = WSP(const float, WS_BL)[(size_t)bh * SEQ + k * 64 + lane];
    const float mk = WSP(const float, WS_MS)[bh * (NCH + 1) + k]; const float nst = WSP(const float, WS_NST)[(size_t)bhk * 64 + lane];
    const float a_s = li_s - bl_s; float pm = a_s;
#pragma unroll
    for (int o = 1; o < 64; o <<= 1) { const float t = __shfl_up(pm, o); if (lane >= o) pm = fmaxf(pm, t); }
    LAS float* atab = (LAS float*)(wl + ATAB); LAS float* ntab = (LAS float*)(wl + NTAB);
    atab[lane] = a_s; ntab[lane] = nst;
    float mx[2], wi[2], blt[2];
#pragma unroll
    for (int tb = 0; tb < 2; ++tb) { const int t = 32 * tb + r32; blt[tb] = __shfl(bl_s, t); mx[tb] = fmaxf(mk, __shfl(pm, t)); wi[tb] = __expf(mk - mx[tb]); }
#pragma unroll
    for (int i = 0; i < 8; ++i) { const int row = i * 8 + (lane >> 3), ch = lane & 7; *(LAS v4u*)(wl + VIMG + row * RB + ch * 16) = vreg[i]; }
    f32x16 s00 = (f32x16){}, s01 = (f32x16){}, s11 = (f32x16){};
#pragma unroll
    for (int d0 = 0; d0 < 4; ++d0) { s00 = __builtin_amdgcn_mfma_f32_32x32x16_bf16(kf[0][d0], qf[0][d0], s00, 0, 0, 0);
        s01 = __builtin_amdgcn_mfma_f32_32x32x16_bf16(kf[0][d0], qf[1][d0], s01, 0, 0, 0); s11 = __builtin_amdgcn_mfma_f32_32x32x16_bf16(kf[1][d0], qf[1][d0], s11, 0, 0, 0); }
    float dsum[2] = {0.f, 0.f};
    decay_apply(s00, 0, 0, atab, mx[0], dsum[0], r32, h); decay_apply(s01, 0, 1, atab, mx[1], dsum[1], r32, h); decay_apply(s11, 1, 1, atab, mx[1], dsum[1], r32, h);
    f32x16 nacc[2][2];
#pragma unroll
    for (int a = 0; a < 2; ++a)
#pragma unroll
        for (int c = 0; c < 2; ++c) nacc[a][c] = (f32x16){};
    const unsigned toff = (unsigned)(((lane & 15) >> 2) * RB + (16 * ((lane >> 4) & 1) + 4 * (lane & 3)) * 2);
#pragma unroll
    for (int sb = 0; sb < 2; ++sb)
#pragma unroll
        for (int st = 0; st < 2; ++st) { bf16x8 va[2];
#pragma unroll
            for (int jb = 0; jb < 2; ++jb) { const LAS unsigned char* pv = wl + VIMG + (32 * sb + 16 * st + 4 * h) * RB + toff + 64 * jb; va[jb] = cat8(trd(pv), trd(pv + 8 * RB)); }
            if (sb == 0) { const bf16x8 p0 = packstep(s00, st), p1 = packstep(s01, st);
#pragma unroll
                for (int jb = 0; jb < 2; ++jb) { nacc[jb][0] = __builtin_amdgcn_mfma_f32_32x32x16_bf16(va[jb], p0, nacc[jb][0], 0, 0, 0); nacc[jb][1] = __builtin_amdgcn_mfma_f32_32x32x16_bf16(va[jb], p1, nacc[jb][1], 0, 0, 0); }
            } else { const bf16x8 p1 = packstep(s11, st);
#pragma unroll
                for (int jb = 0; jb < 2; ++jb) nacc[jb][1] = __builtin_amdgcn_mfma_f32_32x32x16_bf16(va[jb], p1, nacc[jb][1], 0, 0, 0); } }
    const float* CT = WSP(const float, R_CST) + (size_t)bhk * 4096;
    float dint[2] = {0.f, 0.f};
#pragma unroll
    for (int st = 0; st < 4; ++st) { bf16x8 ca[2];
#pragma unroll
        for (int jb = 0; jb < 2; ++jb) { const float* cp = CT + (32 * jb + r32) * 64 + 16 * st + 8 * h; const f32x4 c0 = *(const f32x4*)cp, c1 = *(const f32x4*)(cp + 4);
            const float f[8] = {c0[0], c0[1], c0[2], c0[3], c1[0], c1[1], c1[2], c1[3]}; ca[jb] = pack8(f); }
        const f32x4 n0 = *(const LAS f32x4*)(ntab + 16 * st + 8 * h), n1 = *(const LAS f32x4*)(ntab + 16 * st + 8 * h + 4);
#pragma unroll
        for (int tb = 0; tb < 2; ++tb) { float f[8]; unpack8(__builtin_bit_cast(v4u, qf[tb][st]), f);
            dint[tb] += (f[0] * n0[0] + f[1] * n0[1]) + (f[2] * n0[2] + f[3] * n0[3]) + (f[4] * n1[0] + f[5] * n1[1]) + (f[6] * n1[2] + f[7] * n1[3]);
#pragma unroll
            for (int e = 0; e < 8; ++e) f[e] *= wi[tb];
            const bf16x8 qw = pack8(f);
#pragma unroll
            for (int jb = 0; jb < 2; ++jb) nacc[jb][tb] = __builtin_amdgcn_mfma_f32_32x32x16_bf16(ca[jb], qw, nacc[jb][tb], 0, 0, 0); } }
    const float* nw = P.in[I_MNW] + l * 256 + hd * 64; bf16* CAT = WSP(bf16, R_CAT);
#pragma unroll
    for (int tb = 0; tb < 2; ++tb) {
        const float den = swapadd(dsum[tb]) + wi[tb] * swapadd(dint[tb]);
        const float dinv = 1.f / fmaxf(fabsf(den), __expf(-(blt[tb] + mx[tb])));
        float ss = 0.f;
#pragma unroll
        for (int jb = 0; jb < 2; ++jb)
#pragma unroll
            for (int e = 0; e < 16; ++e) { const float v = nacc[jb][tb][e] * dinv; ss += v * v; }
        const float scale = dinv / sqrtf(swapadd(ss) * (1.f / 64.f) + EPS);
        const size_t row = row0 + 32 * tb + r32;
#pragma unroll
        for (int jb = 0; jb < 2; ++jb)
#pragma unroll
            for (int g = 0; g < 4; ++g) { const int j0 = 32 * jb + 8 * g + 4 * h; const f32x4 nwv = *(const f32x4*)(nw + j0);
                const unsigned long long mo = *(const GAS unsigned long long*)(T1 + row * 512 + 256 + hd * 64 + j0);
                const float m0 = __uint_as_float((unsigned)(mo << 16)), m1 = __uint_as_float((unsigned)mo & 0xffff0000u), m2 = __uint_as_float((unsigned)(mo >> 32) << 16), m3 = __uint_as_float((unsigned)(mo >> 32) & 0xffff0000u);
                const float y0 = nacc[jb][tb][4 * g] * scale * nwv[0] * __builtin_amdgcn_rcpf(1.f + __expf(-m0)), y1 = nacc[jb][tb][4 * g + 1] * scale * nwv[1] * __builtin_amdgcn_rcpf(1.f + __expf(-m1));
                const float y2 = nacc[jb][tb][4 * g + 2] * scale * nwv[2] * __builtin_amdgcn_rcpf(1.f + __expf(-m2)), y3 = nacc[jb][tb][4 * g + 3] * scale * nwv[3] * __builtin_amdgcn_rcpf(1.f + __expf(-m3));
                *(GAS unsigned long long*)(CAT + row * 1024 + hd * 64 + j0) = (unsigned long long)cvtpk(y0, y1) | ((unsigned long long)cvtpk(y2, y3) << 32); }
    }
}
__device__ __forceinline__ void state_scan(const Ptrs& P, long gtid, long gn) {
    const float* DEC = WSP(const float, WS_DEC); float* CST = WSP(float, R_CST); float* NST = WSP(float, WS_NST);
    for (long it = gtid; it < 8 * 4160; it += gn) {
        const int bh = (int)it / 4160, e = (int)it % 4160; float run = 0.f;
        float* base = e < 4096 ? CST + (size_t)bh * NCH * 4096 + e : NST + (size_t)bh * NCH * 64 + (e - 4096); const size_t stride = e < 4096 ? 4096 : 64;
        for (int k0 = 0; k0 < NCH; k0 += 16) { float u[16], d[16];
#pragma unroll
            for (int i = 0; i < 16; ++i) { u[i] = base[(size_t)(k0 + i) * stride]; d[i] = DEC[bh * NCH + k0 + i]; }
#pragma unroll
            for (int i = 0; i < 16; ++i) { base[(size_t)(k0 + i) * stride] = run; run = d[i] * run + u[i]; } }
    }
}
}

constexpr int RING_BYTES = 131072;
constexpr int MISC_OFF = RING_BYTES;
constexpr int PTR_OFF = RING_BYTES + 256;
constexpr int JOB_OFF = RING_BYTES + 512;
constexpr int LDS_BYTES = 147456;
constexpr int NWAVES = 8;

__device__ __forceinline__ float wave_sum(float v) {
#pragma unroll
    for (int o = 1; o < 64; o <<= 1) v += __shfl_xor(v, o);
    return v;
}
struct WJob { const float* W0; const float* W1; const float* rs; bf16* WT; int K, Nsrc, nblk, kind; float cs; int item0; int pad0, pad1; };
constexpr int MAX_JOBS = 32;
__device__ __forceinline__ void p0_transpose_item(const LAS WJob* jb, LAS float* scr, int item, int lane) {
    const int K = jb->K, N = jb->Nsrc, nblk = jb->nblk, kb = item / nblk, nb = item % nblk, k0 = 64 * kb;
    int which, col0; float cs; wmap(jb->kind, nb, which, col0, cs); cs *= jb->cs;
    const float* W = which ? jb->W1 : jb->W0; const float* rs = jb->rs;
    const float* src = W + (size_t)(k0 + (lane >> 5)) * N + col0 + (lane & 31);
    float v[32];
#pragma unroll
    for (int i = 0; i < 32; ++i) v[i] = __builtin_nontemporal_load(src + (size_t)(2 * i) * N);
#pragma unroll
    for (int i = 0; i < 32; ++i) scr[(2 * i + (lane >> 5)) * 33 + (lane & 31)] = v[i];
    LDS_WAIT(); asm volatile("" ::: "memory");
    const int c = lane & 7; bf16* WT = jb->WT;
    f32x4 r0 = {cs, cs, cs, cs}, r1 = r0;
    if (rs) { r0 = *(const f32x4*)(rs + k0 + 8 * c) * cs; r1 = *(const f32x4*)(rs + k0 + 8 * c + 4) * cs; }
#pragma unroll
    for (int j = 0; j < 4; ++j) { const int n = (lane >> 3) + 8 * j; const LAS float* sp = scr + (8 * c) * 33 + n;
        v4u o; o.x = pk2(sp[0 * 33] * r0[0], sp[1 * 33] * r0[1]); o.y = pk2(sp[2 * 33] * r0[2], sp[3 * 33] * r0[3]); o.z = pk2(sp[4 * 33] * r1[0], sp[5 * 33] * r1[1]); o.w = pk2(sp[6 * 33] * r1[2], sp[7 * 33] * r1[3]);
        __builtin_nontemporal_store(o, (GAS v4u*)(WT + (size_t)(nb * 32 + n) * K + k0 + 8 * c)); }
    LDS_WAIT(); asm volatile("" ::: "memory");
}
__device__ __forceinline__ void build_gw(const Ptrs& P, long gtid, long gn) {
    for (long it = gtid; it < 3 * 32 * 64; it += gn) {
        const int t = (int)(it / 2048), ks = (int)((it / 64) % 32), ln = (int)(it % 64), c = ln & 15, quad = ln >> 4;
        float hi[8], lo[8];
#pragma unroll
        for (int j = 0; j < 8; ++j) { const int k = 32 * ks + 8 * quad + j; float w;
            if (t < 2) w = P.in[I_NMIX][t * D + k] * P.in[I_WIN][(size_t)t * D * INW + (size_t)k * INW + (c < 8 ? 1024 + c : 3072 + c)];
            else w = (c < 8) ? P.in[I_NFFN][D + k] * P.in[I_RW][(size_t)k * 8 + c] : 0.f;
            const float h = bf2f(f2bf(w)); hi[j] = h; lo[j] = w - h; }
        v4u oh, ol; oh.x = pk2(hi[0], hi[1]); oh.y = pk2(hi[2], hi[3]); oh.z = pk2(hi[4], hi[5]); oh.w = pk2(hi[6], hi[7]); ol.x = pk2(lo[0], lo[1]); ol.y = pk2(lo[2], lo[3]); ol.z = pk2(lo[4], lo[5]); ol.w = pk2(lo[6], lo[7]);
        v4u* tab = (v4u*)(P.ws + WS_GW + (size_t)t * 65536); tab[(ks * 2 + 0) * 64 + ln] = oh; tab[(ks * 2 + 1) * 64 + ln] = ol;
    }
}
template <int MODE, bool PRE>
__device__ __forceinline__ void norm16(const Ptrs& P, int l, const float* src, bf16* XN, const unsigned* rss_in, int vcu, int G, int wave, int lane, LAS float* xch) {
    typedef short bf16x8 __attribute__((ext_vector_type(8)));
    const int r = lane & 15, quad = lane >> 4, kh = wave >> 2;
    const v4u* tab = (const v4u*)(P.ws + WS_GW + (size_t)(MODE == 2 ? 2 : l) * 65536) + lane;
    if constexpr (MODE == 2) { if (wave == 0 && lane < 8) ((LAS unsigned*)(xch + 2048))[64 * 4 + lane] = 0u; }
    for (int t0 = 0; t0 < M / 16; t0 += 4 * G) {
        const int task = t0 + (wave & 3) * G + vcu; const bool live = task < M / 16; const int r0 = (live ? task : 0) * 16;
        const float* xr = src + (size_t)(r0 + r) * D + 8 * quad; bf16* xo = XN + (size_t)(r0 + r) * D + 8 * quad;
        f32x4 acc = {0.f, 0.f, 0.f, 0.f}; float ss = 0.f;
#pragma unroll
        for (int kk = 0; kk < 16; ++kk) { const int ks = 16 * kh + kk;
            if constexpr (PRE) {
                const v4u h = *(const GAS v4u*)(xo + 32 * ks);
                const bf16x8 ah = __builtin_bit_cast(bf16x8, h);
                const bf16x8 bh = __builtin_bit_cast(bf16x8, tab[(ks * 2 + 0) * 64]), bl = __builtin_bit_cast(bf16x8, tab[(ks * 2 + 1) * 64]);
                acc = __builtin_amdgcn_mfma_f32_16x16x32_bf16(ah, bh, acc, 0, 0, 0); acc = __builtin_amdgcn_mfma_f32_16x16x32_bf16(ah, bl, acc, 0, 0, 0);
            } else {
            const f32x4 a = __builtin_nontemporal_load((const GAS f32x4*)(xr + 32 * ks)), b = __builtin_nontemporal_load((const GAS f32x4*)(xr + 32 * ks + 4));
            ss += (a[0] * a[0] + a[1] * a[1]) + (a[2] * a[2] + a[3] * a[3]) + (b[0] * b[0] + b[1] * b[1]) + (b[2] * b[2] + b[3] * b[3]);
            v4u h; h.x = pk2(a[0], a[1]); h.y = pk2(a[2], a[3]); h.z = pk2(b[0], b[1]); h.w = pk2(b[2], b[3]);
            if (live) *(GAS v4u*)(xo + 32 * ks) = h;
            if constexpr (MODE != 0) {
                float hf[8]; unpack8(h, hf);
                v4u lw; lw.x = pk2(a[0] - hf[0], a[1] - hf[1]); lw.y = pk2(a[2] - hf[2], a[3] - hf[3]); lw.z = pk2(b[0] - hf[4], b[1] - hf[5]); lw.w = pk2(b[2] - hf[6], b[3] - hf[7]);
                const bf16x8 ah = __builtin_bit_cast(bf16x8, h), al = __builtin_bit_cast(bf16x8, lw);
                const bf16x8 bh = __builtin_bit_cast(bf16x8, tab[(ks * 2 + 0) * 64]), bl = __builtin_bit_cast(bf16x8, tab[(ks * 2 + 1) * 64]);
                acc = __builtin_amdgcn_mfma_f32_16x16x32_bf16(ah, bh, acc, 0, 0, 0); acc = __builtin_amdgcn_mfma_f32_16x16x32_bf16(al, bh, acc, 0, 0, 0); acc = __builtin_amdgcn_mfma_f32_16x16x32_bf16(ah, bl, acc, 0, 0, 0);
            }
            }
        }
        { LAS float* xp = xch + ((wave & 3) * 64 + lane) * 5;
          if (kh == 1) { xp[0] = acc[0]; xp[1] = acc[1]; xp[2] = acc[2]; xp[3] = acc[3]; xp[4] = ss; }
          __syncthreads();
          if (kh == 0) { acc[0] += xp[0]; acc[1] += xp[1]; acc[2] += xp[2]; acc[3] += xp[3]; ss += xp[4]; }
          __syncthreads(); }
        if constexpr (MODE != 2) { if (kh == 1 || !live) continue; }
        if (MODE != 2 || (kh == 0 && live)) {
        unsigned sq;
        if constexpr (PRE) sq = rss_in[r0 + r]; else { ss += __shfl_xor(ss, 16); ss += __shfl_xor(ss, 32); sq = (unsigned)(ss * 16.f + 0.5f); if (lane < 16) WSP(unsigned, WS_RSTD)[r0 + lane] = sq; }
        ss = (float)sq * (1.f / 16.f);
        const float rstd = 1.f / sqrtf(ss * (1.f / D) + EPS);
        if constexpr (MODE != 0) {
            float z[4];
#pragma unroll
            for (int j = 0; j < 4; ++j) z[j] = acc[j] * __shfl(rstd, 4 * quad + j);
            if constexpr (MODE == 1) {
                const int g = r; f32x4 o;
#pragma unroll
                for (int j = 0; j < 4; ++j) { if (g < 4) o[j] = z[j] + P.in[I_MBI][l * 4 + g]; else if (g < 8) o[j] = logsigmoidf_(z[j] + P.in[I_MBF][l * 4 + g - 4]); else o[j] = logsigmoidf_(z[j] + P.in[I_FBF][l * 8 + g - 8]); }
                *(f32x4*)(WSP(float, WS_GATE) + (size_t)g * M + r0 + 4 * quad) = o;
            } else {
#pragma unroll
                for (int j = 0; j < 4; ++j) { float le[8];
#pragma unroll
                    for (int e = 0; e < 8; ++e) le[e] = __shfl(z[j], (lane & 48) + e);
                    int e1 = 0; float v1 = le[0];
#pragma unroll
                    for (int e = 1; e < 8; ++e) if (le[e] > v1) { v1 = le[e]; e1 = e; }
                    int e2 = -1; float v2 = -INFINITY;
#pragma unroll
                    for (int e = 0; e < 8; ++e) if (e != e1 && le[e] > v2) { v2 = le[e]; e2 = e; }
                    if (r == j) { const float g2 = 1.f / (1.f + expf(v1 - v2)), g1 = 1.f - g2;
                        LAS unsigned* sp = (LAS unsigned*)(xch + 2048) + ((wave & 3) * 16 + 4 * quad + j) * 4;
                        sp[0] = (unsigned)e1; sp[1] = (unsigned)e2; sp[2] = __float_as_uint(g1); sp[3] = __float_as_uint(g2); }
                }
            }
        }
        }
        if constexpr (MODE == 2) {
            LAS unsigned* selb = (LAS unsigned*)(xch + 2048); LAS unsigned* hacc = selb + 64 * 4;
            if (!(kh == 0 && live) && wave < 4 && r < 4) selb[((wave & 3) * 16 + 4 * quad + r) * 4] = 255u;
            __syncthreads();
            if (wave == 0) {
                const int w = lane >> 4, e1 = (int)selb[lane * 4], e2 = (int)selb[lane * 4 + 1]; const bool valid = e1 < 8;
                const unsigned long long below = (1ull << lane) - 1ull; int rank1 = 0, rank2 = 0; unsigned mynew = 0u;
#pragma unroll
                for (int e = 0; e < 8; ++e) { const unsigned old_ = hacc[e];
                    const unsigned long long m1 = __ballot(valid && e1 == e), m2 = __ballot(valid && e2 == e); const int c1 = __popcll(m1);
                    if (e1 == e) rank1 = (int)old_ + __popcll(m1 & below);
                    if (e2 == e) rank2 = (int)old_ + c1 + __popcll(m2 & below);
                    if (lane == e) mynew = old_ + (unsigned)(c1 + __popcll(m2)); }
                if (valid) { const int row = (t0 + w * G + vcu) * 16 + (lane & 15); unsigned* tk = WSP(unsigned, WS_TOK) + (size_t)row * 8;
                    tk[0] = (unsigned)e1; tk[1] = (unsigned)rank1; tk[2] = (unsigned)e2; tk[3] = (unsigned)rank2; tk[4] = selb[lane * 4 + 2]; tk[5] = selb[lane * 4 + 3]; }
                if (lane < 8) hacc[lane] = mynew;
            }
            __syncthreads();
        }
    }
    if constexpr (MODE == 2) { if (wave == 0 && lane < 8) WSP(unsigned, WS_BH)[vcu * 8 + lane] = ((LAS unsigned*)(xch + 2048))[64 * 4 + lane]; }
}
template <int MODE>
__device__ __forceinline__ void norm_rows(const Ptrs& P, int l, const float* src, bf16* XN, int nrows, int gw, int ngw, int lane) {
    for (int row = gw; row < nrows; row += ngw) {
        const GAS f32x4* xr = (const GAS f32x4*)(src + (size_t)row * D) + lane;
        f32x4 v[4]; float s2 = 0.f;
#pragma unroll
        for (int j = 0; j < 4; ++j) { v[j] = xr[64 * j]; s2 += (v[j].x * v[j].x + v[j].y * v[j].y) + (v[j].z * v[j].z + v[j].w * v[j].w); }
        const float rstd = 1.f / sqrtf(wave_sum(s2) * (1.f / D) + EPS);
        GAS unsigned long long* o8 = (GAS unsigned long long*)(XN + (size_t)row * D) + lane;
#pragma unroll
        for (int j = 0; j < 4; ++j) o8[64 * j] = (unsigned long long)pk2(v[j].x * rstd, v[j].y * rstd) | ((unsigned long long)pk2(v[j].z * rstd, v[j].w * rstd) << 32);
    }
}

__device__ __forceinline__ float wave_incl_scan(float v, int lane) {
#pragma unroll
    for (int o = 1; o < 64; o <<= 1) { const float t = __shfl_up(v, o); if (lane >= o) v += t; }
    return v;
}
__device__ __forceinline__ float wave_max(float v) {
#pragma unroll
    for (int o = 1; o < 64; o <<= 1) v = fmaxf(v, __shfl_xor(v, o));
    return v;
}
__device__ __forceinline__ void gate_scan_task(const Ptrs& P, int task, LAS float* scr, int tid) {
    const int lane = tid & 63, wave = tid >> 6; const float* GT = WSP(const float, WS_GATE);
    if (task < 16) {
        const int b = task / FH, h = task % FH; constexpr int EPT = SEQ / 512;
        const float* src = GT + (size_t)(8 + h) * M + (size_t)b * SEQ + tid * EPT; float* dst = WSP(float, WS_CF) + (size_t)task * SEQ + tid * EPT;
        float v[EPT]; float run = 0.f;
#pragma unroll
        for (int i = 0; i < EPT; i += 4) { const f32x4 x = *(const f32x4*)(src + i); run += x[0]; v[i] = run; run += x[1]; v[i + 1] = run; run += x[2]; v[i + 2] = run; run += x[3]; v[i + 3] = run; }
        const float wincl = wave_incl_scan(run, lane);
        if (lane == 63) scr[wave] = wincl;
        __syncthreads();
        float offs = wincl - run;
#pragma unroll
        for (int w = 0; w < 8; ++w) if (w < wave) offs += scr[w];
#pragma unroll
        for (int i = 0; i < EPT; i += 4) *(f32x4*)(dst + i) = (f32x4){(offs + v[i]) * LOG2E, (offs + v[i + 1]) * LOG2E, (offs + v[i + 2]) * LOG2E, (offs + v[i + 3]) * LOG2E};
        __syncthreads();
    } else {
        const int bh = task - 16, b = bh / MH, h = bh % MH;
        const float* lfp = GT + (size_t)(4 + h) * M + (size_t)b * SEQ; const float* lip = GT + (size_t)h * M + (size_t)b * SEQ;
        float* BL = WSP(float, WS_BL) + (size_t)bh * SEQ; float* BT = WSP(float, WS_BT) + bh * NCH; float* AK = WSP(float, WS_AK) + bh * NCH; float* MS = WSP(float, WS_MS) + bh * (NCH + 1);
        constexpr int CPW = NCH / 8;
        float lfv[CPW], liv[CPW];
#pragma unroll
        for (int i = 0; i < CPW; ++i) { const int k = wave + 8 * i; lfv[i] = lfp[k * 64 + lane]; liv[i] = lip[k * 64 + lane]; }
#pragma unroll
        for (int i = 0; i < CPW; ++i) { const int k = wave + 8 * i;
            const float bl = wave_incl_scan(lfv[i], lane); BL[k * 64 + lane] = bl;
            const float btot = __shfl(bl, 63); const float a = wave_max(btot - bl + liv[i]);
            if (lane == 0) { BT[k] = btot; AK[k] = a; scr[k] = btot; scr[NCH + k] = a; } }
        __syncthreads();
        if (wave == 0) { float* DEC = WSP(float, WS_DEC) + bh * NCH; constexpr int PL = NCH / 64;
            float f[PL], av[PL]; float run = 0.f;
#pragma unroll
            for (int i = 0; i < PL; ++i) { run += scr[lane * PL + i]; f[i] = run; av[i] = scr[NCH + lane * PL + i]; }
            const float offs = wave_incl_scan(run, lane) - run;
            float pm = -INFINITY; float c[PL];
#pragma unroll
            for (int i = 0; i < PL; ++i) { f[i] += offs; pm = fmaxf(pm, av[i] - f[i]); c[i] = pm; }
            float pin = pm;
#pragma unroll
            for (int o = 1; o < 64; o <<= 1) { const float t = __shfl_up(pin, o); if (lane >= o) pin = fmaxf(pin, t); }
            float pex = __shfl_up(pin, 1); if (lane == 0) pex = -INFINITY;
            float mprev = __shfl_up(fmaxf(0.f, pin) + f[PL - 1], 1); if (lane == 0) mprev = 0.f;
            if (lane == 0) MS[0] = 0.f;
#pragma unroll
            for (int i = 0; i < PL; ++i) { const int k = lane * PL + i; const float mn = f[i] + fmaxf(0.f, fmaxf(pex, c[i]));
                MS[k + 1] = mn; DEC[k] = __expf(scr[k] + mprev - mn); mprev = mn; } }
        __syncthreads();
    }
}
__device__ __forceinline__ void mconv_glu_vec(const Ptrs& P, int l, long gtid, long gn) {
    const bf16* T0 = WSP(const bf16, R_T0); bf16* MQK = WSP(bf16, R_MQK);
    const float* cw = P.in[I_MCW] + l * 4 * 512; const float* cb = P.in[I_MCB] + l * 512;
    for (long it0 = gtid; it0 < (long)M * 64; it0 += 4 * gn) {
        v4u w[4][4]; bool ok[4][4];
#pragma unroll
        for (int r = 0; r < 4; ++r) { const long it = it0 + r * gn; const int ch = (int)(it & 63); const long row = it >> 6; const int t = (int)(row % SEQ), c0 = ch * 8;
#pragma unroll
            for (int j = 0; j < 4; ++j) { ok[r][j] = it < (long)M * 64 && t - 3 + j >= 0; w[r][j] = (v4u){0u, 0u, 0u, 0u}; if (ok[r][j]) w[r][j] = *(const GAS v4u*)(T0 + (size_t)(row - 3 + j) * 512 + c0); } }
#pragma unroll
        for (int r = 0; r < 4; ++r) { const long it = it0 + r * gn; if (it >= (long)M * 64) continue; const int ch = (int)(it & 63); const long row = it >> 6; const int c0 = ch * 8;
            float acc[8];
#pragma unroll
            for (int i = 0; i < 8; ++i) acc[i] = cb[c0 + i];
#pragma unroll
            for (int j = 0; j < 4; ++j) { if (ok[r][j]) { float x[8]; unpack8(w[r][j], x);
#pragma unroll
                    for (int i = 0; i < 8; ++i) acc[i] += cw[j * 512 + c0 + i] * x[i]; } }
            const float sc = (c0 >= 256) ? 0.125f : 1.f; float y[8];
#pragma unroll
            for (int i = 0; i < 8; ++i) y[i] = acc[i] * __builtin_amdgcn_rcpf(1.f + __expf(-acc[i])) * sc;
            v4u o; o.x = pk2(y[0], y[1]); o.y = pk2(y[2], y[3]); o.z = pk2(y[4], y[5]); o.w = pk2(y[6], y[7]);
            *(GAS v4u*)(MQK + (size_t)row * 512 + c0) = o; }
    }
    const bf16* T2 = WSP(const bf16, R_T0 + 2 * SZ_T); bf16* GL = WSP(bf16, R_GL);
    for (long it0 = gtid; it0 < (long)M * 32; it0 += 4 * gn) {
        v4u wa[4], wg[4];
#pragma unroll
        for (int r = 0; r < 4; ++r) { const long it = it0 + r * gn; wa[r] = (v4u){0u, 0u, 0u, 0u}; wg[r] = wa[r];
            if (it < (long)M * 32) { const int c0 = (int)(it & 31) * 8; const long row = it >> 5; wa[r] = *(const GAS v4u*)(T2 + (size_t)row * 512 + c0); wg[r] = *(const GAS v4u*)(T2 + (size_t)row * 512 + 256 + c0); } }
#pragma unroll
        for (int r = 0; r < 4; ++r) { const long it = it0 + r * gn; if (it >= (long)M * 32) continue; const int c0 = (int)(it & 31) * 8; const long row = it >> 5;
            float a[8], g[8]; unpack8(wa[r], a); unpack8(wg[r], g); float y[8];
#pragma unroll
            for (int i = 0; i < 8; ++i) y[i] = a[i] * __builtin_amdgcn_rcpf(1.f + __expf(-g[i]));
            v4u o; o.x = pk2(y[0], y[1]); o.y = pk2(y[2], y[3]); o.z = pk2(y[4], y[5]); o.w = pk2(y[6], y[7]);
            *(GAS v4u*)(GL + (size_t)row * 256 + c0) = o; }
    }
}
__device__ __forceinline__ void cconv_ln_rows(const Ptrs& P, int l, int gw, int ngw, int lane) {
    const bf16* GL = WSP(const bf16, R_GL); bf16* CAT = WSP(bf16, R_CAT);
    const float* cw = P.in[I_CCW] + l * CK * 256 + 4 * lane; const int c0 = 4 * lane;
    const f32x4 cb = *(const f32x4*)(P.in[I_CCB] + l * 256 + c0), lw = *(const f32x4*)(P.in[I_CLW] + l * 256 + c0), lb = *(const f32x4*)(P.in[I_CLB] + l * 256 + c0);
    f32x4 w[CK];
#pragma unroll
    for (int j = 0; j < CK; ++j) w[j] = *(const f32x4*)(cw + j * 256);
    for (int task = gw; task < M / 8; task += ngw) {
        const int r0 = task * 8, t0 = r0 % SEQ;
        unsigned long long x[CK + 7];
#pragma unroll
        for (int i = 0; i < CK + 7; ++i) x[i] = (t0 - (CK - 1) + i >= 0) ? *(const GAS unsigned long long*)(GL + (size_t)(r0 - (CK - 1) + i) * 256 + c0) : 0ull;
        f32x4 acc[8];
#pragma unroll
        for (int o = 0; o < 8; ++o) acc[o] = cb;
#pragma unroll
        for (int i = 0; i < CK + 7; ++i) { const unsigned long long q = x[i];
            const f32x4 xf = {__uint_as_float((unsigned)(q << 16)), __uint_as_float((unsigned)q & 0xffff0000u), __uint_as_float((unsigned)(q >> 32) << 16), __uint_as_float((unsigned)(q >> 32) & 0xffff0000u)};
#pragma unroll
            for (int o = 0; o < 8; ++o) if (i - o >= 0 && i - o < CK) acc[o] += w[i - o] * xf; }
#pragma unroll
        for (int o = 0; o < 8; ++o) {
            const float mean = wave_sum((acc[o][0] + acc[o][1]) + (acc[o][2] + acc[o][3])) * (1.f / 256.f);
            const f32x4 d = acc[o] - mean; const float rstd = 1.f / sqrtf(wave_sum((d[0] * d[0] + d[1] * d[1]) + (d[2] * d[2] + d[3] * d[3])) * (1.f / 256.f) + EPS);
            f32x4 y = d * rstd * lw + lb;
#pragma unroll
            for (int i = 0; i < 4; ++i) y[i] = y[i] * __builtin_amdgcn_rcpf(1.f + __expf(-y[i]));
            *(GAS unsigned long long*)(CAT + (size_t)(r0 + o) * 1024 + 256 + c0) = (unsigned long long)pk2(y[0], y[1]) | ((unsigned long long)pk2(y[2], y[3]) << 32); }
    }
}
__device__ __forceinline__ void fox_keynorms(const Ptrs& P, int gw, int ngw, int lane) {
    const bf16* K = WSP(const bf16, R_T0 + 4 * SZ_T); float* KN2 = WSP(float, WS_KN2); constexpr int NTT = SEQ / 64;
    for (int u = gw; u < BATCH * FH * NTT; u += ngw) { const int bh = u / NTT, tile = u % NTT, b = bh / FH, h = bh % FH;
        const bf16* kr = K + ((size_t)b * SEQ + tile * 64 + lane) * 512 + h * 64; float ss = 0.f;
#pragma unroll
        for (int c = 0; c < 8; ++c) { const v4u v = *(const GAS v4u*)(kr + 8 * c); float f[8]; unpack8(v, f);
#pragma unroll
            for (int e = 0; e < 8; ++e) ss += f[e] * f[e]; }
        ss = wave_max(ss); if (lane == 0) KN2[u] = ss; }
}
__device__ __forceinline__ void moe_gather(const Ptrs& P, int gw, int ngw, int lane, int wave, int vcu, int G, LAS unsigned char* lds) {
    LAS unsigned* base = (LAS unsigned*)lds; LAS unsigned* tot = base + 1024 * 8;
    { const unsigned* BH = WSP(const unsigned, WS_BH); const int per = (G + 63) / 64; unsigned run = 0u;
      for (int k = 0; k < per; ++k) { const int blk = lane * per + k; if (blk < G) run += BH[blk * 8 + wave]; }
      unsigned incl = run;
#pragma unroll
      for (int o = 1; o < 64; o <<= 1) { const unsigned t = __shfl_up(incl, o); if (lane >= o) incl += t; }
      unsigned ex = incl - run;
      for (int k = 0; k < per; ++k) { const int blk = lane * per + k; if (blk < G) { base[blk * 8 + wave] = ex; ex += BH[blk * 8 + wave]; } }
      if (lane == 63) tot[wave] = incl; }
    __syncthreads();
    unsigned* cntg = WSP(unsigned, WS_CTL) + CW_CNT;
    if (vcu == 0 && wave == 0 && lane < 8) cntg[lane] = tot[lane];
    unsigned cnt[8];
#pragma unroll
    for (int e = 0; e < 8; ++e) cnt[e] = tot[e];
    int off[9]; { int o = 0;
#pragma unroll
        for (int e = 0; e < 8; ++e) { off[e] = o; o += ((int)cnt[e] + 255) & ~255; }
        off[8] = o; }
    const bf16* XN = WSP(const bf16, R_XN); bf16* XNS = WSP(bf16, R_XNS);
    for (int row0 = gw; row0 < M; row0 += 4 * ngw) {
        v4u ta[4], a[4], b[4]; unsigned rv[4];
#pragma unroll
        for (int r = 0; r < 4; ++r) { const int row = row0 + r * ngw; if (row < M) { ta[r] = *(const GAS v4u*)(WSP(unsigned, WS_TOK) + (size_t)row * 8);
                const GAS v4u* srcp = (const GAS v4u*)(XN + (size_t)row * D) + lane; a[r] = __builtin_nontemporal_load(srcp); b[r] = __builtin_nontemporal_load(srcp + 64); rv[r] = WSP(const unsigned, WS_RSS)[(size_t)4 * M + row]; } }
#pragma unroll
        for (int r = 0; r < 4; ++r) { const int row = row0 + r * ngw; if (row < M) {
                unsigned* tk = WSP(unsigned, WS_TOK) + (size_t)row * 8;
                const int e1 = (int)ta[r][0], p1 = (int)ta[r][1], e2 = (int)ta[r][2], p2 = (int)ta[r][3];
                int o1 = 0, o2 = 0;
#pragma unroll
                for (int e = 0; e < 8; ++e) { if (e == e1) o1 = off[e]; if (e == e2) o2 = off[e]; }
                const int blk = (row >> 4) % G;
                const int s1 = o1 + (int)base[blk * 8 + e1] + p1, s2 = o2 + (int)base[blk * 8 + e2] + p2;
                if (lane == 0) { tk[6] = (unsigned)s1; tk[7] = (unsigned)s2; WSP(unsigned, WS_RSTDS)[s1] = rv[r]; WSP(unsigned, WS_RSTDS)[s2] = rv[r];
                    const float g1 = __uint_as_float(tk[4]), g2 = __uint_as_float(tk[5]); WSP(float, WS_SLOTG)[s1] = g1; WSP(float, WS_SLOTG)[s2] = -g2; }
                GAS v4u* d1 = (GAS v4u*)(XNS + (size_t)s1 * D) + lane; GAS v4u* d2 = (GAS v4u*)(XNS + (size_t)s2 * D) + lane;
                d1[0] = a[r]; d1[64] = b[r]; d2[0] = a[r]; d2[64] = b[r]; } }
    }
    for (int w = gw; w < 8 * 256; w += ngw) {
        const int e = w >> 8, r = w & 255; int oe = 0, oe1 = 0, ce = 0;
#pragma unroll
        for (int j = 0; j < 8; ++j) if (j == e) { oe = off[j]; oe1 = off[j + 1]; ce = (int)cnt[j]; }
        const int slot = oe + ce + r;
        if (slot < oe1) { GAS v4u* dp = (GAS v4u*)(XNS + (size_t)slot * D) + lane; const v4u z = {0u, 0u, 0u, 0u}; dp[0] = z; dp[64] = z; if (lane == 0) { unsigned zlo = 0u; asm volatile("" : "+v"(zlo)); WSP(unsigned, WS_RSTDS)[slot] = zlo; WSP(float, WS_SLOTG)[slot] = __uint_as_float(zlo); } }
    }
}
__device__ __forceinline__ void moe_combine_final(const Ptrs& P, int gw, int ngw, int lane) {
    const bf16* Y = WSP(const bf16, R_XNS); const float* nw = P.in[I_NFIN];
    for (int row0 = gw; row0 < M; row0 += 4 * ngw) {
        int s1[4], s2[4];
#pragma unroll
        for (int r = 0; r < 4; ++r) { const int row = row0 + r * ngw; const unsigned* tk = WSP(const unsigned, WS_TOK) + (size_t)(row < M ? row : 0) * 8; s1[r] = (int)tk[6]; s2[r] = (int)tk[7]; }
        unsigned long long ya[4][4], yb[4][4];
#pragma unroll
        for (int r = 0; r < 4; ++r) { const GAS unsigned long long* y1 = (const GAS unsigned long long*)(Y + (size_t)s1[r] * D) + lane; const GAS unsigned long long* y2 = (const GAS unsigned long long*)(Y + (size_t)s2[r] * D) + lane;
#pragma unroll
            for (int j = 0; j < 4; ++j) { ya[r][j] = __builtin_nontemporal_load(y1 + 64 * j); yb[r][j] = __builtin_nontemporal_load(y2 + 64 * j); } }
#pragma unroll
        for (int r = 0; r < 4; ++r) { const int row = row0 + r * ngw; if (row < M) {
            GAS f32x4* orow = (GAS f32x4*)(P.xres + (size_t)row * D) + lane;
            f32x4 v[4]; float ssq = 0.f;
#pragma unroll
            for (int j = 0; j < 4; ++j) { const unsigned long long a = ya[r][j], b = yb[r][j];
                v[j].x = bf2f((bf16)(a & 0xffff)) + bf2f((bf16)(b & 0xffff));
                v[j].y = bf2f((bf16)((a >> 16) & 0xffff)) + bf2f((bf16)((b >> 16) & 0xffff));
                v[j].z = bf2f((bf16)((a >> 32) & 0xffff)) + bf2f((bf16)((b >> 32) & 0xffff));
                v[j].w = bf2f((bf16)((a >> 48) & 0xffff)) + bf2f((bf16)((b >> 48) & 0xffff));
                ssq += (v[j].x * v[j].x + v[j].y * v[j].y) + (v[j].z * v[j].z + v[j].w * v[j].w); }
            const float rstd = 1.f / sqrtf(wave_sum(ssq) * (1.f / D) + EPS);
#pragma unroll
            for (int j = 0; j < 4; ++j) { const f32x4 w = *((const f32x4*)nw + lane + 64 * j); __builtin_nontemporal_store(v[j] * rstd * w, orow + 64 * j); } } }
    }
}

#ifndef MK_PER_PHASE
#define MK_PER_PHASE 0
#endif
constexpr int PH_PER_LAYER = 14, N_PHASES = 1 + 2 * PH_PER_LAYER + 1;
__device__ __forceinline__ Ptrs launder(const Ptrs& a) { Ptrs p = a; asm volatile("" : "+s"(p.ws), "+s"(p.xres)); return p; }
struct Args { const float* in[N_IN]; float* xres; unsigned char* ws; int ph_lo, ph_hi; };

__global__ void __launch_bounds__(NWAVES * 64, 2) trunk_fwd(Args args) {
    extern __shared__ __attribute__((aligned(16))) unsigned char lds_raw[];
    LAS unsigned char* lds = (LAS unsigned char*)lds_raw;
    Ptrs P0; P0.in = (const float* const LAS*)(lds + PTR_OFF); P0.xres = args.xres; P0.ws = args.ws;
    const int tid = threadIdx.x, wave0 = __builtin_amdgcn_readfirstlane(tid >> 6);
    const int G0 = gridDim.x; const int bx0 = blockIdx.x; const int vcu0 = (G0 % 8 == 0) ? (bx0 % 8) * (G0 / 8) + bx0 / 8 : bx0;
    volatile LAS unsigned* MISC = (volatile LAS unsigned*)(lds + MISC_OFF);
    if (tid < 64) MISC[tid] = 0u;
    if (tid < N_IN) ((const float* LAS*)(lds + PTR_OFF))[tid] = args.in[tid];
    __syncthreads();
    unsigned* ctl = (unsigned*)(P0.ws + WS_CTL);
    XcdBarrier bar; bar.bar = ctl + CW_BAR; bar.x = 0; bar.st = nullptr;
    if (!MK_PER_PHASE) bar = xcd_barrier_post(ctl + CW_BAR, MISC + 8);
    const int lo = args.ph_lo, hi = args.ph_hi; int ph = 0;
#ifndef SITEMASK
#define SITEMASK 0xffffffffull
#endif
#define SITE(k) ((SITEMASK >> (k)) & 1ull)
#define PH_ON() (ph >= lo && ph < hi)
#define PH_IF(k) if (PH_ON() && SITE(k))
#define PH_CTX() Ptrs P = launder(P0); int tidp = threadIdx.x; asm volatile("" : "+v"(tidp)); int G = G0, bx = bx0, vcu = vcu0, wave = wave0; asm volatile("" : "+s"(G), "+s"(bx), "+s"(vcu), "+s"(wave)); const int gw = vcu * NWAVES + wave, ngw = G * NWAVES; const long gn = (long)G * (NWAVES * 64); const int lane = tidp & 63; const long gtid = (long)bx * (NWAVES * 64) + tidp; (void)lane; (void)gw; (void)gtid; (void)ngw; (void)gn
#define PH_END() do { if (PH_ON() && ph + 1 < hi) { if (!MK_PER_PHASE) { XcdBarrier b2_ = bar; asm volatile("" : "+s"(b2_.bar), "+s"(b2_.x)); xcd_barrier(b2_); } } ++ph; } while (0)

    PH_IF(0) { PH_CTX();
        LAS WJob* jobs = (LAS WJob*)(lds + JOB_OFF);
        if (tid == 0) {
            int nj = 0, item = 0;
#define ADDJOB(W0_, W1_, rs_, dst_, K_, Nsrc_, Ndst_, kind_, cs_) do { LAS WJob* j_ = jobs + nj; j_->W0 = (W0_); j_->W1 = (W1_); j_->rs = (rs_); j_->WT = WSP(bf16, (dst_)); j_->K = (K_); j_->Nsrc = (Nsrc_); \
                j_->nblk = (Ndst_) / 32; j_->kind = (kind_); j_->cs = (cs_); j_->item0 = item; item += ((K_) / 64) * ((Ndst_) / 32); ++nj; } while (0)
            for (int l = 0; l < 2; ++l) {
                const size_t wl = R_WL + (size_t)l * WL_SIZE;
                ADDJOB(P.in[I_WIN] + (size_t)l * D * INW, nullptr, P.in[I_NMIX] + l * D, wl + WL_IN, D, INW, NZ, 1, 1.f);
                ADDJOB(P.in[I_WOUT] + (size_t)l * D * D, nullptr, nullptr, wl + WL_OUT, D, D, D, 0, 1.f);
                ADDJOB(P.in[I_WQ] + (size_t)l * D * 512, nullptr, P.in[I_NXA] + l * D, wl + WL_Q, D, 512, 512, 0, XAT_QS);
                ADDJOB(P.in[I_WKV] + (size_t)l * D * 1024, nullptr, P.in[I_NMEM] + l * D, wl + WL_KV, D, 1024, 1024, 0, 1.f);
                ADDJOB(P.in[I_WO] + (size_t)l * 512 * D, nullptr, nullptr, wl + WL_O, 512, D, D, 0, 1.f);
            }
            ADDJOB(P.in[I_FG], P.in[I_FU], P.in[I_NFFN], R_WGU, D, DFF, 2 * DFF, 2, 1.f);
            ADDJOB(P.in[I_FD], nullptr, nullptr, R_WDN, DFF, D, D, 0, 1.f);
            for (int e = 0; e < NE; ++e) {
                ADDJOB(P.in[I_MG] + (size_t)e * D * DFF, P.in[I_MU] + (size_t)e * D * DFF, P.in[I_NFFN] + D, WS_WMGU + (size_t)e * 2 * DFF * D * 2, D, DFF, 2 * DFF, 2, 1.f);
                ADDJOB(P.in[I_MD] + (size_t)e * DFF * D, nullptr, nullptr, WS_WMD + (size_t)e * D * DFF * 2, DFF, D, D, 0, 1.f);
            }
#undef ADDJOB
            MISC[16] = (unsigned)nj; MISC[17] = (unsigned)item;
        }
        __syncthreads();
        const int nj = (int)MISC[16], nitems = (int)MISC[17];
        LAS float* scr = (LAS float*)(lds + wave * 16384);
        for (int it = gw; it < nitems; it += ngw) {
            int j = 0;
            for (int q = 1; q < nj; ++q) if (jobs[q].item0 <= it) j = q;
            p0_transpose_item(jobs + j, scr, it - jobs[j].item0, lane);
        }
        norm_rows<0>(P, 0, P.in[I_MEM], WSP(bf16, WS_MEMN), BATCH * NMEM, gw, ngw, lane);
        build_gw(P, gtid, gn);
    }
    PH_END();

    for (int l = 0; l < 2; ++l) {
        const size_t wl = R_WL + (size_t)l * WL_SIZE;
        PH_IF(1) { PH_CTX(); if (l == 0) norm16<1, false>(P, l, P.in[I_X], WSP(bf16, R_XN), nullptr, vcu, G, wave, lane, (LAS float*)lds);
            else norm16<1, true>(P, l, nullptr, WSP(bf16, R_XN), WSP(const unsigned, WS_RSS) + (size_t)2 * M, vcu, G, wave, lane, (LAS float*)lds); }
        PH_END();
        PH_IF(2) { PH_CTX();
            for (int task = bx; task < 24; task += G) gate_scan_task(P, task, (LAS float*)lds, tidp);
            { pg8::Gemm g{WSP(const bf16, R_XN), WSP(const bf16, wl + WL_IN), M, NZ, D}; pg8::StaticOrder S; S.init(M, NZ, G, bx);
              pg8::EpiBf16 E{WSP(bf16, R_T0), 512, 512, (size_t)M * 512, (l == 0) ? WSP(const unsigned, WS_RSTD) : WSP(const unsigned, WS_RSS) + (size_t)2 * M};
              pg8::gemm_phase<pg8::EpiBf16, pg8::StaticOrder, true, true>(lds, g, S, E); }
        }
        PH_END();
        PH_IF(3) { PH_CTX(); mconv_glu_vec(P, l, gtid, gn); fox_keynorms(P, gw, ngw, lane); }
        PH_END();
        PH_IF(4) { PH_CTX(); for (int u = wave * G + vcu; u < 8 * NCH; u += ngw) mls::u_unit(P, u, lds + wave * 16384, lane);
            for (int u = (7 - wave) * G + vcu; u < BATCH * FH * fox::NQB; u += ngw) { const int qb = fox::NQB - 1 - u / (BATCH * FH), bh = u % (BATCH * FH);
                const int j0 = fox::unit_j0_wave(bh, qb, (const fox::bf16h*)WSP(bf16, R_T0 + 3 * SZ_T), WSP(const float, WS_KN2), WSP(const float, WS_CF) + (size_t)bh * SEQ, lane); if (lane == 0) WSP(int, WS_J0)[u] = j0; }
            cconv_ln_rows(P, l, gw, ngw, lane); }
        PH_END();
        PH_IF(5) { PH_CTX(); mls::state_scan(P, gtid, gn); }
        PH_END();
        PH_IF(7) { PH_CTX();
            { pg8::Gemm g{WSP(const bf16, WS_MEMN), WSP(const bf16, wl + WL_KV), BATCH * NMEM, 512, D}; pg8::StaticOrder S; S.init(BATCH * NMEM, 512, G, bx);
              pg8::EpiBf16 E{WSP(bf16, WS_KVX) + (size_t)l * 512 * 1024, 512, 0, 0, nullptr};
              pg8::gemm_phase<pg8::EpiBf16, pg8::StaticOrder, true, true>(lds, g, S, E); }
            { pg8::Gemm g{WSP(const bf16, wl + WL_KV) + (size_t)512 * 1024, WSP(const bf16, WS_MEMN), 512, BATCH * NMEM, D}; pg8::StaticOrder S; S.init(512, BATCH * NMEM, G, (bx + G - 4) % G);
              pg8::EpiBf16 E{WSP(bf16, WS_KVX) + (size_t)l * 512 * 1024 + 512 * 512, 512, 0, 0, nullptr};
              pg8::gemm_phase<pg8::EpiBf16, pg8::StaticOrder, true, true>(lds, g, S, E); }
            { static_assert(fox::LDS_BYTES <= RING_BYTES, "fox LDS");
              const fox::bf16h* Q = (const fox::bf16h*)WSP(bf16, R_T0 + 3 * SZ_T); const fox::bf16h* Kp = (const fox::bf16h*)WSP(bf16, R_T0 + 4 * SZ_T); const fox::bf16h* Vp = (const fox::bf16h*)WSP(bf16, R_T0 + 5 * SZ_T);
              fox::bf16h* O = (fox::bf16h*)(WSP(bf16, R_CAT) + 512); const float* CF = WSP(const float, WS_CF);
              for (int it = vcu; it < 8 * NCH / 8; it += G) mls::out_unit(P, l, it * 8 + wave, lds + wave * 16384, lane);
              __syncthreads();
              const int nitems = BATCH * FH * fox::NQB; unsigned* qhead = ctl + CW_FOXQ + 64 * l;
              for (;;) {
                  if (tidp == 0) MISC[24] = __hip_atomic_fetch_add(qhead, 1u, RLX_AGENT);
                  __syncthreads();
                  const int u = (int)MISC[24];
                  __syncthreads();
                  if (u >= nitems) break;
                  const int qb = fox::NQB - 1 - u / (BATCH * FH), bh = u % (BATCH * FH);
                  const int j0 = WSP(const int, WS_J0)[u];
                  fox::attn_unit<8>(bh / FH, bh % FH, qb, j0, Q, Kp, Vp, O, CF + (size_t)bh * SEQ, (char*)lds_raw); } }

 }
        PH_END();
        PH_IF(8) { PH_CTX(); pg8::Gemm g{WSP(const bf16, R_CAT), WSP(const bf16, wl + WL_OUT), M, D, D}; pg8::StaticOrder S; S.init(M, D, G, bx);
            pg8::EpiRes E{WSP(bf16, R_XN), D, WSP(unsigned, WS_RSS) + (size_t)(l ? 3 : 0) * M};
            pg8::gemm_phase<pg8::EpiRes, pg8::StaticOrder, true, true>(lds, g, S, E); }
        PH_END();
        PH_IF(10) { PH_CTX(); pg8::Gemm g{WSP(const bf16, R_XN), WSP(const bf16, wl + WL_Q), M, 512, D}; pg8::StaticOrder S; S.init(M, 512, G, bx);
            pg8::EpiBf16 E{WSP(bf16, R_QX), 512, 0, 0, WSP(const unsigned, WS_RSS) + (size_t)(l ? 3 : 0) * M};
            pg8::gemm_phase<pg8::EpiBf16, pg8::StaticOrder, true, true>(lds, g, S, E); }
        PH_END();
        PH_IF(11) { PH_CTX(); static_assert(xat::LDS_BYTES <= RING_BYTES, "xat LDS");
            const bf16* KXp = WSP(const bf16, WS_KVX) + (size_t)l * 512 * 1024;
            for (int L = vcu; L < BATCH * XH * (SEQ / 256); L += G) { const int qb = L % (SEQ / 256), bhd = L / (SEQ / 256);
                xat::unit(bhd / XH, bhd % XH, qb, WSP(const bf16, R_QX), KXp, KXp + 512 * 512, WSP(bf16, R_OX), lds); } }
        PH_END();
        PH_IF(12) { PH_CTX(); pg8::Gemm g{WSP(const bf16, R_OX), WSP(const bf16, wl + WL_O), M, D, 512}; pg8::StaticOrder S; S.init(M, D, G, bx);
            pg8::EpiRes E{WSP(bf16, R_XN), D, WSP(unsigned, WS_RSS) + (size_t)(l ? 4 : 1) * M};
            pg8::gemm_phase<pg8::EpiRes, pg8::StaticOrder, true, true>(lds, g, S, E); }
        PH_END();
        if (l == 0) {
            PH_IF(14) { PH_CTX(); pg8::Gemm g{WSP(const bf16, R_XN), WSP(const bf16, R_WGU), M, 2 * DFF, D}; pg8::StaticOrder S; S.init(M, 2 * DFF, G, bx);
                pg8::EpiSwiGLU E{WSP(bf16, R_HD), DFF, WSP(const unsigned, WS_RSS) + (size_t)1 * M};
                pg8::gemm_phase<pg8::EpiSwiGLU, pg8::StaticOrder, true, true>(lds, g, S, E); }
            PH_END();
            PH_IF(15) { PH_CTX(); pg8::Gemm g{WSP(const bf16, R_HD), WSP(const bf16, R_WDN), M, D, DFF}; pg8::StaticOrder S; S.init(M, D, G, bx);
                pg8::EpiRes E{WSP(bf16, R_XN), D, WSP(unsigned, WS_RSS) + (size_t)2 * M};
                pg8::gemm_phase<pg8::EpiRes, pg8::StaticOrder, true, true>(lds, g, S, E); }
            PH_END();
            ph += 2;
        } else {
            PH_IF(16) { PH_CTX(); norm16<2, true>(P, l, nullptr, WSP(bf16, R_XN), WSP(const unsigned, WS_RSS) + (size_t)4 * M, vcu, G, wave, lane, (LAS float*)lds); }
            PH_END();
            PH_IF(17) { PH_CTX(); moe_gather(P, gw, ngw, lane, wave, vcu, G, lds); }
            PH_END();
            PH_IF(18) { PH_CTX(); pg8::Gemm g{WSP(const bf16, R_XNS), WSP(const bf16, WS_WMGU), 0, 2 * DFF, D}; pg8::GroupedOrder S; S.init(2 * DFF, G, bx, ctl + CW_CNT, (size_t)2 * DFF * D * 2);
                pg8::EpiSwiGLU E{WSP(bf16, R_HM), DFF, WSP(const unsigned, WS_RSTDS)};
                pg8::gemm_phase<pg8::EpiSwiGLU, pg8::GroupedOrder, true, true>(lds, g, S, E); }
            PH_END();
            PH_IF(19) { PH_CTX(); pg8::Gemm g{WSP(const bf16, R_HM), WSP(const bf16, WS_WMD), 0, D, DFF}; pg8::GroupedOrder S; S.init(D, G, bx, ctl + CW_CNT, (size_t)D * DFF * 2);
                pg8::EpiMoeOut E{WSP(bf16, R_XNS), D, WSP(const float, WS_SLOTG)};
                pg8::gemm_phase<pg8::EpiMoeOut, pg8::GroupedOrder, true, true>(lds, g, S, E); }
            PH_END();
        }
    }
    PH_IF(20) { PH_CTX(); moe_combine_final(P, gw, ngw, lane); }
#undef PH_ON
#undef PH_END
}

extern "C" void kernel_launch(void* const* d_in, const int* in_sizes, int n_in, void* d_out, int out_size, void* d_ws, size_t ws_size, hipStream_t stream) {
    static int grid = 0;
    if (grid == 0) {
        if (n_in != N_IN || out_size != M * D || ws_size < WS_END) { fprintf(stderr, "kernel_launch: unexpected shapes (n_in %d, out %d, ws %zu < %zu); nothing launched\n", n_in, out_size, ws_size, (size_t)WS_END); grid = -1; return; }
        int dev = 0, cus = 0, per_cu = 0;
        if (hipGetDevice(&dev) != hipSuccess || hipDeviceGetAttribute(&cus, hipDeviceAttributeMultiprocessorCount, dev) != hipSuccess) { grid = -1; return; }
        if (hipFuncSetAttribute((const void*)trunk_fwd, hipFuncAttributeMaxDynamicSharedMemorySize, LDS_BYTES) != hipSuccess) { fprintf(stderr, "kernel_launch: hipFuncSetAttribute failed\n"); grid = -1; return; }
        if (hipOccupancyMaxActiveBlocksPerMultiprocessor(&per_cu, (const void*)trunk_fwd, NWAVES * 64, LDS_BYTES) != hipSuccess || per_cu < 1) { fprintf(stderr, "kernel_launch: occupancy query says %d\n", per_cu); (void)hipGetLastError(); grid = -1; return; }
        grid = cus;
    }
    if (grid < 0) return;
    (void)in_sizes;
    if (hipMemsetAsync((char*)d_ws + WS_CTL, 0, CTL_ZERO_BYTES, stream) != hipSuccess) return;
    Args a; memset(&a, 0, sizeof(a));
    for (int i = 0; i < N_IN; ++i) a.in[i] = (const float*)d_in[i];
    a.xres = (float*)d_out; a.ws = (unsigned char*)d_ws;
#if MK_PER_PHASE
    for (int p = 0; p < N_PHASES; ++p) { a.ph_lo = p; a.ph_hi = p + 1; hipLaunchKernelGGL(trunk_fwd, dim3(grid), dim3(NWAVES * 64), LDS_BYTES, stream, a); }
#else
    a.ph_lo = 0; a.ph_hi = N_PHASES;
    hipLaunchKernelGGL(trunk_fwd, dim3(grid), dim3(NWAVES * 64), LDS_BYTES, stream, a);
#endif
}
#endif
```

```cpp
#if defined(HOST_EMU)
#include <cmath>
#include <cstring>
#include <cstdint>
#include <cstddef>
#define DEVFN static inline
#define PHFN static inline
#else
#include <hip/hip_runtime.h>
#include <cstdio>
#include <cstdint>
#include <cstring>
#define DEVFN __device__ __forceinline__
#define PHFN __device__ __forceinline__
#endif

#ifndef CFG_SEQ
#define CFG_SEQ 8192
#endif
constexpr int BATCH = 2, SEQ = CFG_SEQ, D = 1024, M = BATCH * SEQ;
constexpr int MH = 4, MCH = 64, NCH = SEQ / MCH;
constexpr int CK = 31;
constexpr int FH = 8;
constexpr int XH = 4, XD = 128, NMEM = 256;
constexpr int DFF = 2816, NE = 8, INW = 3088;
constexpr int NZ = 3072;
constexpr int SLOTS_MAX = 2 * M + NE * 256;
constexpr float EPS = 1e-6f;
constexpr float LOG2E = 1.4426950408889634f;
constexpr float FOX_QS = 0.125f * LOG2E;
constexpr float XAT_QS = 0.08838834764831845f * LOG2E;

enum { I_X = 0, I_MEM, I_NMIX, I_WIN, I_MCW, I_MCB, I_MBI, I_MBF, I_MNW, I_CCW, I_CCB, I_CLW, I_CLB, I_FBF, I_WOUT, I_NXA, I_NMEM, I_WQ, I_WKV, I_WO, I_NFFN,
       I_FG, I_FU, I_FD, I_RW, I_MG, I_MU, I_MD, I_NFIN, N_IN };

typedef unsigned short bf16;
constexpr size_t al4k(size_t x) { return (x + 4095) & ~(size_t)4095; }
constexpr size_t MiB = (size_t)1 << 20;
constexpr size_t WS_CTL = 0, CTL_ZERO_BYTES = 1 * MiB;
constexpr size_t WS_GATE = 1 * MiB;
constexpr size_t WS_CF = WS_GATE + al4k((size_t)M * 16 * 4);
constexpr size_t WS_BL = WS_CF + al4k((size_t)16 * SEQ * 4);
constexpr size_t WS_BT = WS_BL + al4k((size_t)8 * SEQ * 4);
constexpr size_t WS_AK = WS_BT + al4k((size_t)8 * NCH * 4);
constexpr size_t WS_MS = WS_AK + al4k((size_t)8 * NCH * 4);
constexpr size_t WS_DEC = WS_MS + al4k((size_t)8 * (NCH + 1) * 4);
constexpr size_t WS_KN2 = WS_DEC + al4k((size_t)8 * NCH * 4);
constexpr size_t WS_J0 = WS_KN2 + al4k((size_t)16 * (SEQ / 64) * 4);
constexpr size_t WS_BH = WS_J0 + al4k((size_t)16 * (SEQ / 256) * 4);
constexpr size_t WS_NST = WS_BH + al4k((size_t)1024 * 8 * 4);
constexpr size_t WS_TOK = WS_NST + al4k((size_t)8 * NCH * 64 * 4);
constexpr size_t WS_RSTD = WS_TOK + al4k((size_t)M * 32);
constexpr size_t WS_RSTDS = WS_RSTD + al4k((size_t)M * 8);
constexpr size_t WS_SLOTG = WS_RSTDS + al4k((size_t)SLOTS_MAX * 8);
constexpr size_t WS_GW = WS_SLOTG + al4k((size_t)SLOTS_MAX * 4);
constexpr size_t WS_MEMN = WS_GW + 3 * 65536;
constexpr size_t WS_KVX = WS_MEMN + al4k((size_t)512 * 1024 * 2);
constexpr size_t WS_WMGU = WS_KVX + al4k((size_t)2 * 512 * 1024 * 2);
constexpr size_t WS_WMD = WS_WMGU + (size_t)NE * 5632 * 1024 * 2;
constexpr size_t WS_R = al4k(WS_WMD + (size_t)NE * 1024 * 2816 * 2);
constexpr size_t WL_IN = 0, WL_OUT = WL_IN + (size_t)NZ * 1024 * 2, WL_Q = WL_OUT + (size_t)1024 * 1024 * 2, WL_KV = WL_Q + (size_t)512 * 1024 * 2,
                 WL_O = WL_KV + (size_t)1024 * 1024 * 2, WL_SIZE = WL_O + (size_t)1024 * 512 * 2;
constexpr size_t R_WL = WS_R;
constexpr size_t R_WGU = R_WL + 2 * WL_SIZE;
constexpr size_t R_WDN = R_WGU + (size_t)5632 * 1024 * 2;
constexpr size_t R_XN = al4k(R_WDN + (size_t)1024 * 2816 * 2);
constexpr size_t SZ_T = (size_t)M * 512 * 2;
constexpr size_t R_T0 = R_XN + 2 * SZ_T;
constexpr size_t R_MQK = R_T0 + 6 * SZ_T;
constexpr size_t R_CAT = R_MQK + SZ_T;
constexpr size_t R_CST = R_CAT + 2 * SZ_T;
constexpr size_t R_GL = R_CST + (size_t)8 * NCH * 4096 * 4;
constexpr size_t R_HC = R_GL + (size_t)M * 256 * 2;
constexpr size_t R_END1 = R_HC + (size_t)M * 256 * 4;
constexpr size_t R_QX = R_T0, R_OX = R_T0 + SZ_T;
constexpr size_t R_HD = R_T0;
constexpr size_t R_HM = WS_R;
constexpr size_t R_XNS = R_HM + (size_t)SLOTS_MAX * 2816 * 2;
constexpr size_t R_END2 = R_XNS + (size_t)SLOTS_MAX * 1024 * 2;
constexpr size_t WS_END = R_END1 > R_END2 ? R_END1 : R_END2;
static_assert((size_t)M * 2816 * 2 <= 6 * SZ_T, "dense hidden fits T0..T5");
static_assert(R_XN + 2 * SZ_T <= R_XNS, "XN must not overlap the gathered rows");
constexpr int CW_TMO = 0, CW_CNT = 64  , CW_FOXQ = 128  , CW_BAR = 4096;
constexpr size_t WS_RSS = 65536;
static_assert(WS_RSS + (size_t)5 * M * 4 <= CTL_ZERO_BYTES, "RSS arrays inside the zeroed region");

#if defined(HOST_EMU)
struct Ptrs { const float* in[N_IN]; float* xres; unsigned char* ws; };
#else
struct Ptrs { const float* const __attribute__((address_space(3)))* in; float* xres; unsigned char* ws; };
#endif
#define WSP(type, off) ((type*)(P.ws + (off)))

DEVFN float bf2f(bf16 v) { unsigned u = (unsigned)v << 16; float f; memcpy(&f, &u, 4); return f; }
DEVFN bf16 f2bf(float f) { unsigned u; memcpy(&u, &f, 4); return (bf16)((u + 0x7fffu + ((u >> 16) & 1u)) >> 16); }
DEVFN float sigmoidf_(float x) { return 1.f / (1.f + expf(-x)); }
#if defined(HOST_EMU)
DEVFN float logsigmoidf_(float x) { return fminf(x, 0.f) - log1pf(expf(-fabsf(x))); }
#else
DEVFN float logsigmoidf_(float x) { return fminf(x, 0.f) - __logf(1.f + __expf(-fabsf(x))); }
#endif

DEVFN void wmap(int kind, int nb, int& which, int& col0, float& cs) {
    which = 0; cs = 1.f; const int n0 = nb * 32;
    if (kind == 0) { col0 = n0; }
    else if (kind == 1) { col0 = n0 < 1024 ? n0 : n0 + 8; if (n0 >= 1536 && n0 < 2048) cs = FOX_QS; }
    else { const int tile = nb >> 3, w = nb & 7; which = w >> 2; col0 = tile * 128 + (w & 3) * 32; }
}

#if !defined(HOST_EMU)
namespace pg8 {
#define PG8_LAS __attribute__((address_space(3)))
typedef unsigned short bf16_t;
typedef short bf16x8 __attribute__((ext_vector_type(8)));
typedef float f32x4 __attribute__((ext_vector_type(4)));
typedef unsigned u32x4 __attribute__((ext_vector_type(4)));
constexpr int BM = 256, BK = 64, HALF = 128, HTB = HALF * BK * 2, STAGE_BYTES = 8 * HTB, NXCD = 8, WGM = 4;
__host__ __device__ __forceinline__ int lds_byte(int r, int c) { const int st = (r >> 4) * 2 + (c >> 5), rr = r & 15, cc = c & 31, ob = rr * 64 + cc * 2; return st * 1024 + (ob ^ (((ob >> 9) & 1) << 5)); }
__host__ __device__ __forceinline__ void stage_rc(int b, int& R, int& C) { const int st = b / 1024, sb = b % 1024, swz = sb ^ (((sb >> 9) & 1) << 5); R = (st >> 1) * 16 + swz / 64; C = (st & 1) * 32 + (swz % 64) / 2; }
__host__ __device__ __forceinline__ int perm32(int rho) { const int n = rho >> 4, i = rho & 15; return 8 * (i >> 2) + 4 * n + (i & 3); }

struct Unit { int pm, pn; size_t bofs; };
struct Gemm { const bf16_t* A; const bf16_t* Bt; int M, N, K; };

struct StaticOrder {
    int nM, nN, nwg, G, c;
    __device__ void init(int M_, int N_, int G_, int c_) { nM = M_ / BM; nN = N_ / BM; nwg = nM * nN; G = G_; c = c_; }
    __device__ bool next(int i, Unit& u) const {
        const long L = (long)i * G + c; if (L >= nwg) return false;
        int wgid = (int)L; { const int q = nwg / NXCD, r = nwg % NXCD, xcd = wgid % NXCD, off = wgid / NXCD; wgid = (xcd < r ? xcd * (q + 1) : r * (q + 1) + (xcd - r) * q) + off; }
        const int nig = WGM * nN, gid = wgid / nig, fm = gid * WGM, gsz = (nM - fm) < WGM ? (nM - fm) : WGM;
        u.pm = fm + ((wgid % nig) % gsz); u.pn = (wgid % nig) / gsz; u.bofs = 0; return true;
    }
    __device__ __forceinline__ void a_ready(const Unit&) const {}
    __device__ __forceinline__ void done(const Unit&) const {}
};
struct GroupedOrder {
    int nM, nN, nwg, G, c; int off[9]; size_t estride;
    __device__ void init(int N_, int G_, int c_, const unsigned* cnt, size_t estride_) {
        int o = 0;
#pragma unroll
        for (int e = 0; e < 8; ++e) { off[e] = o; o += ((int)cnt[e] + 255) & ~255; }
        off[8] = o; nM = o / BM; nN = N_ / BM; nwg = nM * nN; G = G_; c = c_; estride = estride_;
    }
    __device__ bool next(int i, Unit& u) const {
        const long L = (long)i * G + c; if (L >= nwg) return false;
        int wgid = (int)L; { const int q = nwg / NXCD, r = nwg % NXCD, xcd = wgid % NXCD, o2 = wgid / NXCD; wgid = (xcd < r ? xcd * (q + 1) : r * (q + 1) + (xcd - r) * q) + o2; }
        const int nig = WGM * nN, gid = wgid / nig, fm = gid * WGM, gsz = (nM - fm) < WGM ? (nM - fm) : WGM;
        u.pm = fm + ((wgid % nig) % gsz); u.pn = (wgid % nig) / gsz;
        int e = 0;
#pragma unroll
        for (int j = 1; j < 8; ++j) e += (off[j] <= u.pm * BM) ? 1 : 0;
        u.bofs = (size_t)e * estride; return true;
    }
    __device__ __forceinline__ void a_ready(const Unit&) const {}
    __device__ __forceinline__ void done(const Unit&) const {}
};

__device__ __forceinline__ unsigned cvt_pk_bf16(float lo, float hi) { unsigned r; asm volatile("v_cvt_pk_bf16_f32 %0, %1, %2" : "=v"(r) : "v"(lo), "v"(hi)); return r; }

struct EpiBf16 {
    static constexpr bool PERM = true, AFTER_DRAIN = false, HAS_PRE = true;
    __device__ __forceinline__ void preload(unsigned (&q)[8], const Unit& u, int wr, int fr) const {
        if (rs) { const __attribute__((address_space(1))) unsigned* rp = (const __attribute__((address_space(1))) unsigned*)rs + u.pm * BM + wr * 64 + fr;
#pragma unroll
            for (int i = 0; i < 8; ++i) q[i] = rp[(i >> 2) * HALF + (i & 3) * 16]; } }
    bf16_t* O; int ldc; int split_cols; size_t split_stride; const unsigned* rs;
    __device__ __forceinline__ void operator()(const f32x4 (&acc)[2][2][4][2], const Unit& u, int wr, int wc, int fr, int fq, const unsigned (&q)[8]) const {
        const int row0 = u.pm * BM + wr * 64 + fr; int colt = u.pn * BM; bf16_t* base = O;
        if (split_cols) { const int t = colt / split_cols; base += (size_t)t * split_stride; colt -= t * split_cols; }
        const int col0 = colt + wc * 32 + 8 * fq;
        float sc[2][4];
#pragma unroll
        for (int ai = 0; ai < 2; ++ai)
#pragma unroll
            for (int m = 0; m < 4; ++m) sc[ai][m] = rs ? rsqrtf((float)q[ai * 4 + m] * (1.f / (16.f * 1024.f)) + 1e-6f) : 1.f;
#pragma unroll
        for (int ai = 0; ai < 2; ++ai)
#pragma unroll
            for (int m = 0; m < 4; ++m) { bf16_t* rowp = base + (size_t)(row0 + ai * HALF + m * 16) * ldc + col0;
#pragma unroll
                for (int bj = 0; bj < 2; ++bj) { const f32x4 v0 = acc[ai][bj][m][0] * sc[ai][m], v1 = acc[ai][bj][m][1] * sc[ai][m];
                    u32x4 w; w.x = cvt_pk_bf16(v0[0], v0[1]); w.y = cvt_pk_bf16(v0[2], v0[3]); w.z = cvt_pk_bf16(v1[0], v1[1]); w.w = cvt_pk_bf16(v1[2], v1[3]);
                    *(u32x4*)(rowp + bj * HALF) = w; } }
    }
};
struct EpiRes {
    static constexpr bool PERM = true, AFTER_DRAIN = false, HAS_PRE = false;
    bf16_t* X; int ldc; unsigned* rss;
    __device__ __forceinline__ void operator()(const f32x4 (&acc)[2][2][4][2], const Unit& u, int wr, int wc, int fr, int fq) const {
        const int row0 = u.pm * BM + wr * 64 + fr, col0 = u.pn * BM + wc * 32 + 8 * fq;
        typedef __attribute__((address_space(1))) u32x4 gu32x4;
        u32x4 b[2][4][2];
#pragma unroll
        for (int ai = 0; ai < 2; ++ai)
#pragma unroll
            for (int m = 0; m < 4; ++m)
#pragma unroll
                for (int bj = 0; bj < 2; ++bj) b[ai][m][bj] = *(const gu32x4*)(X + (size_t)(row0 + ai * HALF + m * 16) * ldc + col0 + bj * HALF);
#pragma unroll
        for (int ai = 0; ai < 2; ++ai)
#pragma unroll
            for (int m = 0; m < 4; ++m) { bf16_t* rowp = X + (size_t)(row0 + ai * HALF + m * 16) * ldc + col0; float ss = 0.f;
#pragma unroll
                for (int bj = 0; bj < 2; ++bj) { float v[8];
#pragma unroll
                    for (int i = 0; i < 4; ++i) { v[2 * i] = __uint_as_float(b[ai][m][bj][i] << 16) + acc[ai][bj][m][i >> 1][(2 * i) & 3]; v[2 * i + 1] = __uint_as_float(b[ai][m][bj][i] & 0xffff0000u) + acc[ai][bj][m][i >> 1][(2 * i + 1) & 3]; }
                    u32x4 w; w.x = cvt_pk_bf16(v[0], v[1]); w.y = cvt_pk_bf16(v[2], v[3]); w.z = cvt_pk_bf16(v[4], v[5]); w.w = cvt_pk_bf16(v[6], v[7]);
                    *(gu32x4*)(rowp + bj * HALF) = w;
#pragma unroll
                    for (int i = 0; i < 8; ++i) ss += v[i] * v[i]; }
                ss += __shfl_xor(ss, 16); ss += __shfl_xor(ss, 32);
                if (fq == 0) __hip_atomic_fetch_add(rss + row0 + ai * HALF + m * 16, (unsigned)(ss * 16.f + 0.5f), __ATOMIC_RELAXED, __HIP_MEMORY_SCOPE_AGENT); }
    }
};
struct EpiMoeOut {
    static constexpr bool PERM = true, AFTER_DRAIN = false, HAS_PRE = false;
    bf16_t* Y; int ldc; const float* sg;
    __device__ __forceinline__ void operator()(const f32x4 (&acc)[2][2][4][2], const Unit& u, int wr, int wc, int fr, int fq) const {
        const int row0 = u.pm * BM + wr * 64 + fr, col0 = u.pn * BM + wc * 32 + 8 * fq;
        typedef __attribute__((address_space(1))) u32x4 gu32x4;
        float g[2][4];
        { const __attribute__((address_space(1))) float* gp = (const __attribute__((address_space(1))) float*)sg + row0;
#pragma unroll
          for (int ai = 0; ai < 2; ++ai)
#pragma unroll
              for (int m = 0; m < 4; ++m) g[ai][m] = gp[ai * HALF + m * 16]; }
        u32x4 b[2][4][2];
#pragma unroll
        for (int ai = 0; ai < 2; ++ai)
#pragma unroll
            for (int m = 0; m < 4; ++m)
#pragma unroll
                for (int bj = 0; bj < 2; ++bj) { b[ai][m][bj] = (u32x4){0u, 0u, 0u, 0u}; if (g[ai][m] > 0.f) b[ai][m][bj] = *(const gu32x4*)(Y + (size_t)(row0 + ai * HALF + m * 16) * ldc + col0 + bj * HALF); }
#pragma unroll
        for (int ai = 0; ai < 2; ++ai)
#pragma unroll
            for (int m = 0; m < 4; ++m) { bf16_t* rowp = Y + (size_t)(row0 + ai * HALF + m * 16) * ldc + col0; const float ga = fabsf(g[ai][m]);
#pragma unroll
                for (int bj = 0; bj < 2; ++bj) { float v[8];
#pragma unroll
                    for (int i = 0; i < 4; ++i) { v[2 * i] = __uint_as_float(b[ai][m][bj][i] << 16) + ga * acc[ai][bj][m][i >> 1][(2 * i) & 3]; v[2 * i + 1] = __uint_as_float(b[ai][m][bj][i] & 0xffff0000u) + ga * acc[ai][bj][m][i >> 1][(2 * i + 1) & 3]; }
                    u32x4 w; w.x = cvt_pk_bf16(v[0], v[1]); w.y = cvt_pk_bf16(v[2], v[3]); w.z = cvt_pk_bf16(v[4], v[5]); w.w = cvt_pk_bf16(v[6], v[7]);
                    *(gu32x4*)(rowp + bj * HALF) = w; } }
    }
};
struct EpiSwiGLU {
    static constexpr bool PERM = true, AFTER_DRAIN = false, HAS_PRE = true;
    __device__ __forceinline__ void preload(unsigned (&q)[8], const Unit& u, int wr, int fr) const {
        const __attribute__((address_space(1))) unsigned* rp = (const __attribute__((address_space(1))) unsigned*)rs + u.pm * BM + wr * 64 + fr;
#pragma unroll
        for (int i = 0; i < 8; ++i) q[i] = rp[(i >> 2) * HALF + (i & 3) * 16]; }
    bf16_t* H; int ldc; const unsigned* rs;
    __device__ __forceinline__ void operator()(const f32x4 (&acc)[2][2][4][2], const Unit& u, int wr, int wc, int fr, int fq, const unsigned (&q)[8]) const {
        const int row0 = u.pm * BM + wr * 64 + fr, col0 = u.pn * HALF + wc * 32 + 8 * fq;
        float sc[2][4];
#pragma unroll
        for (int ai = 0; ai < 2; ++ai)
#pragma unroll
            for (int m = 0; m < 4; ++m) sc[ai][m] = rsqrtf((float)q[ai * 4 + m] * (1.f / (16.f * 1024.f)) + 1e-6f);
#pragma unroll
        for (int ai = 0; ai < 2; ++ai)
#pragma unroll
            for (int m = 0; m < 4; ++m) { bf16_t* rowp = H + (size_t)(row0 + ai * HALF + m * 16) * ldc + col0; float hv[8];
#pragma unroll
                for (int n = 0; n < 2; ++n)
#pragma unroll
                    for (int i = 0; i < 4; ++i) { const float g = acc[ai][0][m][n][i] * sc[ai][m], up = acc[ai][1][m][n][i] * sc[ai][m];
                        hv[n * 4 + i] = g * __builtin_amdgcn_rcpf(1.f + __builtin_amdgcn_exp2f(-g * 1.4426950408889634f)) * up; }
                u32x4 w; w.x = cvt_pk_bf16(hv[0], hv[1]); w.y = cvt_pk_bf16(hv[2], hv[3]); w.z = cvt_pk_bf16(hv[4], hv[5]); w.w = cvt_pk_bf16(hv[6], hv[7]);
                *(u32x4*)rowp = w; }
    }
};

template <class Epi, class Sched, bool ALIGN_EPI = false, bool SP2 = false>
__device__ __forceinline__ void gemm_phase(PG8_LAS unsigned char* lds, const Gemm g, const Sched& S, const Epi& E) {
    int tid = threadIdx.x; asm volatile("" : "+v"(tid));
    const int wid = __builtin_amdgcn_readfirstlane(tid >> 6), lane = tid & 63, wr = wid >> 2, wc = wid & 3, fr = lane & 15, fq = lane >> 4;
    const int K = g.K, nt = K / BK;
    unsigned voffA[2], voffB[2];
#pragma unroll
    for (int i = 0; i < 2; ++i) { int R, C; stage_rc(tid * 16 + i * 8192, R, C); const int Rb = Epi::PERM ? ((R & ~31) + perm32(R & 31)) : R;
        voffA[i] = (unsigned)(R * K + C) * 2u; voffB[i] = (unsigned)(Rb * K + C) * 2u; }
    const size_t kstep = (size_t)(BK * 2);
    const size_t hstep = (size_t)HALF * K * 2;
    const size_t tstep = 2 * hstep;
    const unsigned ldsw = (unsigned)wid * 1024u;
    const int aoff = lds_byte(wr * 64 + fr, fq * 8), boff = lds_byte(wc * 32 + fr, fq * 8);
#define PG8_SA(b, h) (((b) * 2 + (h)) * HTB)
#define PG8_SB(b, h) ((4 + (b) * 2 + (h)) * HTB)
#define PG8_STAGE(bufoff, gbase, voff) do { _Pragma("unroll") for (int _i = 0; _i < 2; ++_i) \
        __builtin_amdgcn_global_load_lds((const unsigned*)((const char*)(gbase) + (voff)[_i]), (PG8_LAS unsigned*)(lds + (bufoff) + ldsw + _i * 8192), 16, 0, 0); } while (0)
#define PG8_LDA(dst, b, h) do { _Pragma("unroll") for (int m = 0; m < 4; ++m) _Pragma("unroll") for (int k = 0; k < 2; ++k) dst[m][k] = *(const PG8_LAS bf16x8*)(lds + PG8_SA(b, h) + aoff + m * 2048 + k * 1024); } while (0)
#define PG8_LDB(dst, b, h) do { _Pragma("unroll") for (int n = 0; n < 2; ++n) _Pragma("unroll") for (int k = 0; k < 2; ++k) dst[n][k] = *(const PG8_LAS bf16x8*)(lds + PG8_SB(b, h) + boff + n * 2048 + k * 1024); } while (0)
#define PG8_MMA(ai, bj, At, Bt) do { __builtin_amdgcn_s_setprio(1); _Pragma("unroll") for (int m = 0; m < 4; ++m) _Pragma("unroll") for (int n = 0; n < 2; ++n) _Pragma("unroll") for (int k = 0; k < 2; ++k) \
        acc[ai][bj][m][n] = __builtin_amdgcn_mfma_f32_16x16x32_bf16(Bt[n][k], At[m][k], acc[ai][bj][m][n], 0, 0, 0); __builtin_amdgcn_s_setprio(0); } while (0)
#define PG8_WAIT_V(n) asm volatile("s_waitcnt vmcnt(" #n ")" ::: "memory")
#define PG8_WAIT_L(n) asm volatile("s_waitcnt lgkmcnt(" #n ")" ::: "memory")
#define PG8_BAR __builtin_amdgcn_s_barrier()
#define PG8_SCHED __builtin_amdgcn_sched_barrier(0)
    Unit cur, nxt; int ui = 0;
    if (!S.next(0, cur)) return;
    f32x4 acc[2][2][4][2];
#pragma unroll
    for (int a = 0; a < 2; ++a)
#pragma unroll
        for (int b = 0; b < 2; ++b)
#pragma unroll
            for (int m = 0; m < 4; ++m)
#pragma unroll
                for (int n = 0; n < 2; ++n) acc[a][b][m][n] = (f32x4){0.f, 0.f, 0.f, 0.f};
    bf16x8 At[4][2], B0[2][2], B1[2][2];
    const char* cA = (const char*)g.A + (size_t)cur.pm * tstep; const char* cB = (const char*)g.Bt + cur.bofs + (size_t)cur.pn * tstep;
    S.a_ready(cur);
    if constexpr (SP2) {
        PG8_STAGE(PG8_SB(0, 0), cB, voffB); PG8_STAGE(PG8_SB(0, 1), cB + hstep, voffB); PG8_STAGE(PG8_SA(0, 0), cA, voffA); PG8_STAGE(PG8_SA(0, 1), cA + hstep, voffA);
        if (wr == 1) PG8_BAR;
        PG8_WAIT_V(2); PG8_BAR;
        PG8_STAGE(PG8_SB(1, 0), cB + kstep, voffB); PG8_STAGE(PG8_SA(1, 0), cA + kstep, voffA); PG8_STAGE(PG8_SB(1, 1), cB + hstep + kstep, voffB);
        PG8_WAIT_V(6); PG8_BAR;
    } else {
        PG8_STAGE(PG8_SB(0, 0), cB, voffB); PG8_STAGE(PG8_SA(0, 0), cA, voffA); PG8_STAGE(PG8_SB(0, 1), cB + hstep, voffB); PG8_STAGE(PG8_SA(0, 1), cA + hstep, voffA);
        if (wr == 1) PG8_BAR;
        PG8_WAIT_V(4); PG8_BAR;
        PG8_STAGE(PG8_SB(1, 0), cB + kstep, voffB); PG8_STAGE(PG8_SA(1, 0), cA + kstep, voffA); PG8_STAGE(PG8_SB(1, 1), cB + hstep + kstep, voffB);
        PG8_WAIT_V(6); PG8_BAR;
    }
    for (;;) {
        unsigned preq[8];
        if constexpr (Epi::HAS_PRE) E.preload(preq, cur, wr, fr);
        const bool has_next = S.next(ui + 1, nxt);
        const char* nA = has_next ? (const char*)g.A + (size_t)nxt.pm * tstep : cA; const char* nB = has_next ? (const char*)g.Bt + nxt.bofs + (size_t)nxt.pn * tstep : cB;
        for (int t = 0; t < nt; t += 2) {
            const bool last = (t == nt - 2);
            const char* a1 = cA + (size_t)(t + 1) * kstep;
            const char* a2 = last ? nA : cA + (size_t)(t + 2) * kstep; const char* b2 = last ? nB : cB + (size_t)(t + 2) * kstep;
            const char* a3 = a2 + kstep; const char* b3 = b2 + kstep;
            if (last && has_next) S.a_ready(nxt);
            if constexpr (SP2) {
            PG8_LDB(B0, 0, 0); PG8_LDB(B1, 0, 1); PG8_SCHED; PG8_LDA(At, 0, 0); PG8_STAGE(PG8_SA(1, 1), a1 + hstep, voffA);
            PG8_WAIT_V(8); PG8_WAIT_L(0); PG8_BAR; PG8_MMA(0, 0, At, B0); PG8_MMA(0, 1, At, B1); PG8_BAR; PG8_SCHED;
            PG8_LDA(At, 0, 1); PG8_STAGE(PG8_SB(0, 0), b2, voffB); PG8_STAGE(PG8_SB(0, 1), b2 + hstep, voffB); PG8_STAGE(PG8_SA(0, 0), a2, voffA);
            PG8_WAIT_V(8); PG8_WAIT_L(0); PG8_BAR; PG8_MMA(1, 0, At, B0); PG8_MMA(1, 1, At, B1); PG8_BAR; PG8_SCHED;
            PG8_LDB(B0, 1, 0); PG8_LDB(B1, 1, 1); PG8_SCHED; PG8_LDA(At, 1, 0); PG8_STAGE(PG8_SA(0, 1), a2 + hstep, voffA);
            PG8_WAIT_V(8); PG8_WAIT_L(0); PG8_BAR; PG8_MMA(0, 0, At, B0); PG8_MMA(0, 1, At, B1); PG8_BAR; PG8_SCHED;
            PG8_LDA(At, 1, 1); PG8_STAGE(PG8_SB(1, 0), b3, voffB); PG8_STAGE(PG8_SB(1, 1), b3 + hstep, voffB); PG8_STAGE(PG8_SA(1, 0), a3, voffA);
            PG8_WAIT_V(8); PG8_WAIT_L(0); PG8_BAR; PG8_MMA(1, 0, At, B0); PG8_MMA(1, 1, At, B1); PG8_BAR; PG8_SCHED;
            } else {
            PG8_LDB(B0, 0, 0); PG8_SCHED; PG8_LDA(At, 0, 0); PG8_STAGE(PG8_SA(1, 1), a1 + hstep, voffA);
            PG8_WAIT_L(8); PG8_BAR; PG8_WAIT_L(0); PG8_MMA(0, 0, At, B0); PG8_BAR; PG8_SCHED;
            PG8_LDB(B1, 0, 1); PG8_STAGE(PG8_SB(0, 0), b2, voffB);
            PG8_BAR; PG8_WAIT_L(0); PG8_MMA(0, 1, At, B1); PG8_BAR;
            PG8_LDA(At, 0, 1); PG8_STAGE(PG8_SA(0, 0), a2, voffA);
            PG8_BAR; PG8_WAIT_L(0); PG8_MMA(1, 0, At, B0); PG8_BAR; PG8_SCHED;
            PG8_STAGE(PG8_SB(0, 1), b2 + hstep, voffB);
            PG8_WAIT_V(6); PG8_BAR; PG8_MMA(1, 1, At, B1); PG8_BAR;
            PG8_LDB(B0, 1, 0); PG8_SCHED; PG8_LDA(At, 1, 0); PG8_STAGE(PG8_SA(0, 1), a2 + hstep, voffA);
            PG8_WAIT_L(8); PG8_BAR; PG8_WAIT_L(0); PG8_MMA(0, 0, At, B0); PG8_BAR; PG8_SCHED;
            PG8_LDB(B1, 1, 1); PG8_STAGE(PG8_SB(1, 0), b3, voffB);
            PG8_BAR; PG8_WAIT_L(0); PG8_MMA(0, 1, At, B1); PG8_BAR;
            PG8_LDA(At, 1, 1); PG8_STAGE(PG8_SA(1, 0), a3, voffA);
            PG8_BAR; PG8_WAIT_L(0); PG8_MMA(1, 0, At, B0); PG8_BAR; PG8_SCHED;
            PG8_STAGE(PG8_SB(1, 1), b3 + hstep, voffB);
            PG8_WAIT_V(6); PG8_BAR; PG8_MMA(1, 1, At, B1); PG8_BAR;
            }
        }
        if constexpr (ALIGN_EPI) { if (wr == 0) PG8_BAR; }
        if constexpr (!Epi::AFTER_DRAIN) { if constexpr (Epi::HAS_PRE) E(acc, cur, wr, wc, fr, fq, preq); else E(acc, cur, wr, wc, fr, fq); S.done(cur); }
        if (!has_next) break;
#pragma unroll
        for (int a = 0; a < 2; ++a)
#pragma unroll
            for (int b = 0; b < 2; ++b)
#pragma unroll
                for (int m = 0; m < 4; ++m)
#pragma unroll
                    for (int n = 0; n < 2; ++n) acc[a][b][m][n] = (f32x4){0.f, 0.f, 0.f, 0.f};
        cur = nxt; cA = nA; cB = nB; ++ui;
        if constexpr (ALIGN_EPI) { if (wr == 1) PG8_BAR; }
    }
    PG8_WAIT_V(0);
    if constexpr (!ALIGN_EPI) { if (wr == 0) PG8_BAR; }
    PG8_BAR;
#undef PG8_SA
#undef PG8_SB
#undef PG8_STAGE
#undef PG8_LDA
#undef PG8_LDB
#undef PG8_MMA
#undef PG8_WAIT_V
#undef PG8_WAIT_L
#undef PG8_BAR
#undef PG8_SCHED
}
}


#include <hip/hip_bf16.h>
namespace fox {
using bf16h=__hip_bfloat16;
using bf16x8=__attribute__((ext_vector_type(8)))short;
using s16x4=__attribute__((ext_vector_type(4)))short;
using f32x16=__attribute__((ext_vector_type(16)))float;
using f32x4=__attribute__((ext_vector_type(4)))float;
using u32x4=__attribute__((ext_vector_type(4)))unsigned;
constexpr int NHEAD=FH,D=64,DMI=512,DMO=1024;
constexpr int NW=8,QBLK=32,QB=QBLK*NW,KVBLK=64,NQB=SEQ/QB;
__device__ __forceinline__ int crow(int r,int hi){return (r&3)+8*(r>>2)+4*hi;}
#define SBAR() __builtin_amdgcn_sched_barrier(0)
__device__ __forceinline__ void cmask(f32x16&p0,f32x16&p1,int jb,int qrel,int hi){
  const float NEG=-INFINITY; int kb=64*jb+4*hi;
  #pragma unroll
  for(int r=0;r<16;++r){int kv=kb+(r&3)+8*(r>>2); if(kv>qrel)p0[r]=NEG; if(kv+32>qrel)p1[r]=NEG;}
}
constexpr int NSLOT=3, SLOTB=8192;
constexpr int LDS_K=0, LDS_V=NSLOT*SLOTB, LDS_WS=2*NSLOT*SLOTB, LDS_OST=LDS_WS+NW*64*4, LDS_NB=LDS_OST+NW*4096, LDS_BYTES=LDS_NB+SEQ*4;
__device__ __forceinline__ void glds16(const void*gsrc,unsigned lds_dst){unsigned keep;
  asm volatile("s_mov_b32 %0, m0\n\ts_mov_b32 m0, %2\n\ts_nop 0\n\tglobal_load_lds_dwordx4 %1, off\n\ts_mov_b32 m0, %0":"=&s"(keep):"v"(gsrc),"s"(lds_dst):"memory");}
__device__ __forceinline__ float max3f(float a,float b,float c){float r;asm("v_max3_f32 %0, %1, %2, %3":"=v"(r):"v"(a),"v"(b),"v"(c));return r;}
__device__ __forceinline__ float max2f(float a,float b){float r;asm("v_max_f32_e32 %0, %1, %2":"=v"(r):"v"(a),"v"(b));return r;}
__device__ __forceinline__ float fadd_s(float a,float b){float r;asm("v_add_f32_e32 %0, %1, %2":"=v"(r):"v"(a),"v"(b));return r;}
__device__ __forceinline__ float fsub_s(float a,float b){float r;asm("v_sub_f32_e32 %0, %1, %2":"=v"(r):"v"(a),"v"(b));return r;}
typedef float f32x2_t __attribute__((ext_vector_type(2))); typedef __bf16 bf16x2_t __attribute__((ext_vector_type(2)));
__device__ __forceinline__ unsigned cvtpk_s(float lo,float hi){f32x2_t v={lo,hi};bf16x2_t b=__builtin_convertvector(v,bf16x2_t);return __builtin_bit_cast(unsigned,b);}
#define WAIT_BAR(N) asm volatile("s_waitcnt vmcnt(" #N ") lgkmcnt(0)\n\ts_barrier":::"memory")
__device__ __forceinline__ void qkt(f32x16&p0,f32x16&p1,const char*Kslot,const bf16x8*qr,int r32,int hi){
  const char*kb=Kslot+hi*1024+r32*16;
  #pragma unroll
  for(int d0=0;d0<4;++d0){
    const bf16x8 b0=*reinterpret_cast<const bf16x8*>(kb+d0*2048);
    const bf16x8 b1=*reinterpret_cast<const bf16x8*>(kb+d0*2048+512);
    p0=__builtin_amdgcn_mfma_f32_32x32x16_bf16(b0,qr[d0],p0,0,0,0);p1=__builtin_amdgcn_mfma_f32_32x32x16_bf16(b1,qr[d0],p1,0,0,0);}
}
typedef __attribute__((address_space(3))) const char* lds_cptr;
typedef __attribute__((address_space(3))) const float* lds_fptr;
typedef short v4i16_t __attribute__((ext_vector_type(4)));
__device__ __forceinline__ void kload8(bf16x8*kf,lds_cptr kp){
  kf[0]=*(const __attribute__((address_space(3))) bf16x8*)(kp);      kf[1]=*(const __attribute__((address_space(3))) bf16x8*)(kp+512);
  kf[2]=*(const __attribute__((address_space(3))) bf16x8*)(kp+2048); kf[3]=*(const __attribute__((address_space(3))) bf16x8*)(kp+2560);
  kf[4]=*(const __attribute__((address_space(3))) bf16x8*)(kp+4096); kf[5]=*(const __attribute__((address_space(3))) bf16x8*)(kp+4608);
  kf[6]=*(const __attribute__((address_space(3))) bf16x8*)(kp+6144); kf[7]=*(const __attribute__((address_space(3))) bf16x8*)(kp+6656);
}
__device__ __forceinline__ void kload2(bf16x8*kf,lds_cptr kp,int j){ kf[2*j]=*(const __attribute__((address_space(3))) bf16x8*)(kp+j*2048); kf[2*j+1]=*(const __attribute__((address_space(3))) bf16x8*)(kp+j*2048+512); }
__device__ __forceinline__ s16x4 vtr(lds_cptr p){ return __builtin_bit_cast(s16x4,__builtin_amdgcn_ds_read_tr16_b64_v4i16((__attribute__((address_space(3))) v4i16_t*)p)); }
__device__ __forceinline__ float rowmax(const f32x16&p0,const f32x16&p1){
  float a=max3f(p0[0],p0[1],p1[0]),b=max3f(p0[2],p0[3],p1[1]);a=max3f(a,p1[2],p1[3]);
  #pragma unroll
  for(int r=4;r<16;r+=4){a=max3f(a,p0[r],p0[r+1]);b=max3f(b,p0[r+2],p0[r+3]);a=max3f(a,p1[r],p1[r+1]);b=max3f(b,p1[r+2],p1[r+3]);}
  const float m=max2f(a,b);
  auto rr=__builtin_amdgcn_permlane32_swap(__float_as_uint(m),__float_as_uint(m),false,false);
  return max2f(__uint_as_float(rr[0]),__uint_as_float(rr[1]));
}
__device__ __forceinline__ void pv(f32x16*o,int vb,bf16x8 pa0,bf16x8 pa1,bf16x8 pa2,bf16x8 pa3){
  #pragma unroll
  for(int d0=0;d0<2;++d0){s16x4 lo[4],hi[4];
    #pragma unroll
    for(int ks=0;ks<4;++ks){
      asm volatile("ds_read_b64_tr_b16 %0,%1 offset:%c2":"=&v"(lo[ks]):"v"(vb),"i"(d0*4096+ks*1024):"memory");
      asm volatile("ds_read_b64_tr_b16 %0,%1 offset:%c2":"=&v"(hi[ks]):"v"(vb),"i"(d0*4096+ks*1024+512):"memory");}
    asm volatile("s_waitcnt lgkmcnt(0)":::"memory");SBAR();
    #define PK(k) (bf16x8){lo[k][0],lo[k][1],lo[k][2],lo[k][3],hi[k][0],hi[k][1],hi[k][2],hi[k][3]}
    o[d0]=__builtin_amdgcn_mfma_f32_32x32x16_bf16(pa0,PK(0),o[d0],0,0,0);
    o[d0]=__builtin_amdgcn_mfma_f32_32x32x16_bf16(pa1,PK(1),o[d0],0,0,0);
    o[d0]=__builtin_amdgcn_mfma_f32_32x32x16_bf16(pa2,PK(2),o[d0],0,0,0);
    o[d0]=__builtin_amdgcn_mfma_f32_32x32x16_bf16(pa3,PK(3),o[d0],0,0,0);
    #undef PK
  }
}
template<int THRL> __device__ __forceinline__ void attn_unit(int b,int h,int qb,int j0,const bf16h*Q,const bf16h*__restrict__ K,const bf16h*__restrict__ V,bf16h*O,const float*CL,char*shm){
  int tid=threadIdx.x; asm volatile("":"+v"(tid));
  const int lane=tid&63,r32=lane&31,hi=lane>>5; const int wid=__builtin_amdgcn_readfirstlane(tid>>6);
  const long rowbase=(long)b*SEQ; const int q0=qb*QB; const long kvbase=rowbase+(long)j0*KVBLK;
  const bf16h*Qw=Q+(rowbase+q0+wid*QBLK)*DMI+h*D;
  const bf16h*Kh=K+kvbase*DMI+h*D,*Vh=V+kvbase*DMI+h*D;
  const unsigned lds0=(unsigned)(uintptr_t)shm;
  float*wsf=(float*)(shm+LDS_WS)+wid*64;
  const int NT=(q0+QB)/KVBLK-j0;
  { float*nbw=(float*)(shm+LDS_NB); const float*src=CL+(long)j0*KVBLK;
    for(int i=tid*4;i<NT*KVBLK;i+=512*4){ const f32x4 v=*(const f32x4*)(src+i); *(f32x4*)(nbw+i)=(f32x4){-v[0],-v[1],-v[2],-v[3]}; } }
  const bf16h*ksrc=Kh+(long)lane*DMI+wid*8;
  const bf16h*vsrc=Vh+(long)(16*(wid&3)+(lane>>2))*DMI+(wid>>2)*32+(lane&3)*8;
  const unsigned kdst=lds0+LDS_K+wid*1024, vdst=lds0+LDS_V+wid*1024;
  #define DMA_K(t,slot) glds16(ksrc+(long)(t)*KVBLK*DMI,(unsigned)__builtin_amdgcn_readfirstlane(kdst+(slot)))
  #define DMA_V(t,slot) glds16(vsrc+(long)(t)*KVBLK*DMI,(unsigned)__builtin_amdgcn_readfirstlane(vdst+(slot)))
  const int vb0=(int)(lds0+LDS_V)+((lane>>4)&1)*32+(lane&3)*8+(4*hi+((lane&15)>>2))*64;
  const char*Kbase=shm+LDS_K; bf16x8 kf[8];
  const lds_cptr shm3=(lds_cptr)shm; const lds_cptr kp0=shm3+LDS_K+hi*1024+r32*16; const lds_cptr vp0=shm3+LDS_V+((lane>>4)&1)*32+(lane&3)*8+(4*hi+((lane&15)>>2))*64;
  const lds_fptr nb0=(lds_fptr)(shm3+LDS_NB)+4*hi;
  DMA_K(0,0);DMA_V(0,0);DMA_K(1,SLOTB);
  bf16x8 qr[4];
  #pragma unroll
  for(int d0=0;d0<4;++d0)qr[d0]=*reinterpret_cast<const bf16x8*>(&Qw[(long)r32*DMI+d0*16+hi*8]);
  float mhat=0.f,l_reg=0.f;f32x16 o[2];o[0]=f32x16{};o[1]=f32x16{};
  const int qrel=wid*QBLK+r32;
  #define CMASK(P0,P1,t) do{int jb_=(t)-(NT-4); if(jb_>=0)cmask(P0,P1,jb_,qrel,hi);}while(0)
  #define PRELOAD(P0,P1,tt) do{ const lds_fptr nbp_=nb0+(tt)*KVBLK; \
    _Pragma("unroll") for(int g_=0;g_<4;++g_){ const f32x4 a_=*(const __attribute__((address_space(3))) f32x4*)(nbp_+8*g_), b_=*(const __attribute__((address_space(3))) f32x4*)(nbp_+32+8*g_); \
      P0[4*g_]=a_[0]-mhat;P0[4*g_+1]=a_[1]-mhat;P0[4*g_+2]=a_[2]-mhat;P0[4*g_+3]=a_[3]-mhat; P1[4*g_]=b_[0]-mhat;P1[4*g_+1]=b_[1]-mhat;P1[4*g_+2]=b_[2]-mhat;P1[4*g_+3]=b_[3]-mhat; } }while(0)
  bool resc=false;
  #define START(P0,P1) do{ const float rm=rowmax(P0,P1); resc=false; \
    { const float dl=rm; mhat=fadd_s(mhat,dl); \
      _Pragma("unroll") for(int r=0;r<16;++r){P0[r]=fsub_s(P0[r],dl);P1[r]=fsub_s(P1[r],dl);} } \
    _Pragma("unroll") for(int r=0;r<16;++r)P0[r]=__builtin_amdgcn_exp2f(P0[r]); }while(0)
  #define RESC() do{ if(resc){ asm volatile("s_waitcnt lgkmcnt(0)":::"memory"); \
      _Pragma("unroll") for(int d_=0;d_<2;++d_) _Pragma("unroll") for(int r=0;r<16;++r)o[d_][r]*=wsf[crow(r,hi)]; } }while(0)
  f32x16 pA0,pA1,pB0,pB1;
  int sl_prev=0,sl_cur=0,sl_next=SLOTB;
  #define ROT() do{sl_prev=sl_cur;sl_cur=sl_next;sl_next=(sl_next==(NSLOT-1)*SLOTB)?0:sl_next+SLOTB;}while(0)
  DMA_K(2,2*SLOTB);
  WAIT_BAR(3);
  PRELOAD(pA0,pA1,0);
  qkt(pA0,pA1,Kbase,qr,r32,hi);asm volatile("s_nop 15\n\ts_nop 7":"+v"(pA0),"+v"(pA1));CMASK(pA0,pA1,0);
  START(pA0,pA1);
  _Pragma("unroll") for(int r=0;r<16;++r)pA1[r]=__builtin_amdgcn_exp2f(pA1[r]);
  WAIT_BAR(0);
  DMA_K(3,0);DMA_V(1,SLOTB);
  ROT();
  kload8(kf,kp0+sl_cur);
  PRELOAD(pB0,pB1,1);
  WAIT_BAR(2);
  s16x4 vlo[8],vhi[8]; u32x4 pw0,pw1,pw2,pw3;
  #define PKW(P,B) cvtpk_s(P[B],P[B+1])
  #define PAF(k) __builtin_bit_cast(bf16x8,pw##k)
  #define VFR(i) (bf16x8){vlo[i][0],vlo[i][1],vlo[i][2],vlo[i][3],vhi[i][0],vhi[i][1],vhi[i][2],vhi[i][3]}
  #define PIN(x) asm volatile("":"+v"(x))
  #define MX3(a,b,c) __builtin_fmaxf(__builtin_fmaxf((a),(b)),(c))
  #define GAPA(MF,A0,A1,A2,A3,W0,W1,PW) do{ MF; sacc+=A0; sacc+=A1; sacc+=A2; sacc+=A3; PIN(sacc); W0; W1; PIN(PW); SBAR(); }while(0)
  #define EX(v) __builtin_amdgcn_exp2f(v)
  #define GAPB(MF,X,B) do{ MF; X[B]=EX(X[B]); X[B+1]=EX(X[B+1]); X[B+2]=EX(X[B+2]); X[B+3]=EX(X[B+3]); PIN(X); SBAR(); }while(0)
  #define VRD(i) do{ vlo[i]=vtr(vp_+(((i)>>2)*4096+((i)&3)*1024)); vhi[i]=vtr(vp_+(((i)>>2)*4096+((i)&3)*1024+512)); }while(0)
  #define KRD(G,j) do{ if(G){ kload2(kf,kp0+sl_next,j); SBAR(); } }while(0)
  #define STEP(C0,C1,P0,P1,t,GK,GV,GL) do{ SBAR(); \
    const lds_cptr vp_=vp0+sl_prev; \
    VRD(0); SBAR(); float sacc=(P0[0]+P0[1]); \
    GAPA(C0=__builtin_amdgcn_mfma_f32_32x32x16_bf16(kf[0],qr[0],C0,0,0,0), P0[2],P0[3],P0[4],P0[5],     pw0[0]=PKW(P0,0), pw0[1]=PKW(P0,2), pw0); \
    VRD(4); SBAR(); GAPA(C1=__builtin_amdgcn_mfma_f32_32x32x16_bf16(kf[1],qr[0],C1,0,0,0), P0[6],P0[7],P0[8],P0[9],     pw0[2]=PKW(P0,4), pw0[3]=PKW(P0,6), pw0); \
    VRD(1); SBAR(); GAPA(C0=__builtin_amdgcn_mfma_f32_32x32x16_bf16(kf[2],qr[1],C0,0,0,0),   P0[10],P0[11],P0[12],P0[13], pw1[0]=PKW(P0,8), pw1[1]=PKW(P0,10), pw1); \
    VRD(5); SBAR(); GAPA(C1=__builtin_amdgcn_mfma_f32_32x32x16_bf16(kf[3],qr[1],C1,0,0,0),   P0[14],P0[15],P1[0],P1[1],   pw1[2]=PKW(P0,12),pw1[3]=PKW(P0,14), pw1); \
    VRD(2); SBAR(); GAPA(C0=__builtin_amdgcn_mfma_f32_32x32x16_bf16(kf[4],qr[2],C0,0,0,0),   P1[2],P1[3],P1[4],P1[5],     pw2[0]=PKW(P1,0), pw2[1]=PKW(P1,2), pw2); \
    VRD(6); SBAR(); GAPA(C1=__builtin_amdgcn_mfma_f32_32x32x16_bf16(kf[5],qr[2],C1,0,0,0),   P1[6],P1[7],P1[8],P1[9],     pw2[2]=PKW(P1,4), pw2[3]=PKW(P1,6), pw2); \
    VRD(3); SBAR(); GAPA(C0=__builtin_amdgcn_mfma_f32_32x32x16_bf16(kf[6],qr[3],C0,0,0,0),   P1[10],P1[11],P1[12],P1[13], pw3[0]=PKW(P1,8), pw3[1]=PKW(P1,10), pw3); \
    VRD(7); SBAR(); GAPA(C1=__builtin_amdgcn_mfma_f32_32x32x16_bf16(kf[7],qr[3],C1,0,0,0),   P1[14],P1[15],0.f,0.f,       pw3[2]=PKW(P1,12),pw3[3]=PKW(P1,14), pw3); \
    l_reg+=sacc; \
    if(GK){DMA_K((t)+3,sl_cur);} if(GV){DMA_V((t)+1,sl_next);} \
    CMASK(C0,C1,t); \
    { float a=MX3(C0[0],C0[1],C1[0]),b=MX3(C0[2],C0[3],C1[1]); a=MX3(a,C1[2],C1[3]); \
      _Pragma("unroll") for(int r=4;r<16;r+=4){a=MX3(a,C0[r],C0[r+1]);b=MX3(b,C0[r+2],C0[r+3]);a=MX3(a,C1[r],C1[r+1]);b=MX3(b,C1[r+2],C1[r+3]);} \
      float rm=__builtin_fmaxf(a,b); { auto rr=__builtin_amdgcn_permlane32_swap(__float_as_uint(rm),__float_as_uint(rm),false,false); rm=__builtin_fmaxf(__uint_as_float(rr[0]),__uint_as_float(rr[1])); } \
      resc=false; \
      if(__builtin_expect(__any(rm>(float)THRL),0)){ const float dl=__builtin_fmaxf(rm,0.f); mhat+=dl; \
        _Pragma("unroll") for(int r=0;r<16;++r){C0[r]-=dl;C1[r]-=dl;} \
        const float f=__builtin_amdgcn_exp2f(-dl); l_reg*=f; if(hi==0)wsf[r32]=f; resc=true; } } \
    SBAR(); \
    GAPB(o[0]=__builtin_amdgcn_mfma_f32_32x32x16_bf16(PAF(0),VFR(0),o[0],0,0,0), C0,0); \
    GAPB(o[1]=__builtin_amdgcn_mfma_f32_32x32x16_bf16(PAF(0),VFR(4),o[1],0,0,0), C0,4); \
    KRD(GL,0); GAPB(o[0]=__builtin_amdgcn_mfma_f32_32x32x16_bf16(PAF(1),VFR(1),o[0],0,0,0), C0,8); \
    KRD(GL,1); GAPB(o[1]=__builtin_amdgcn_mfma_f32_32x32x16_bf16(PAF(1),VFR(5),o[1],0,0,0), C0,12); \
    KRD(GL,2); GAPB(o[0]=__builtin_amdgcn_mfma_f32_32x32x16_bf16(PAF(2),VFR(2),o[0],0,0,0), C1,0); \
    KRD(GL,3); GAPB(o[1]=__builtin_amdgcn_mfma_f32_32x32x16_bf16(PAF(2),VFR(6),o[1],0,0,0), C1,4); \
    GAPB(o[0]=__builtin_amdgcn_mfma_f32_32x32x16_bf16(PAF(3),VFR(3),o[0],0,0,0), C1,8); \
    GAPB(o[1]=__builtin_amdgcn_mfma_f32_32x32x16_bf16(PAF(3),VFR(7),o[1],0,0,0), C1,12); \
    if(GL){ PRELOAD(P0,P1,(t)+1); } \
    }while(0)
  int t=1;
  #undef CMASK
  #define CMASK(P0,P1,t) do{}while(0)
  for(;t+5<NT;t+=2){
    STEP(pB0,pB1,pA0,pA1,t,true,true,true);     WAIT_BAR(2); RESC(); ROT();
    STEP(pA0,pA1,pB0,pB1,t+1,true,true,true);   WAIT_BAR(2); RESC(); ROT();
  }
  #undef CMASK
  #define CMASK(P0,P1,t) do{int jb_=(t)-(NT-4); if(jb_>=0)cmask(P0,P1,jb_,qrel,hi);}while(0)
  #define ENDW(tt) do{ if((tt)+3<NT){WAIT_BAR(2);} else if((tt)+2<NT){WAIT_BAR(1);} else {WAIT_BAR(0);} }while(0)
  for(;t+1<NT;t+=2){
    STEP(pB0,pB1,pA0,pA1,t,(t+3<NT),(t+1<NT),(t+1<NT));       ENDW(t);   RESC(); ROT();
    STEP(pA0,pA1,pB0,pB1,t+1,(t+4<NT),(t+2<NT),(t+2<NT));     ENDW(t+1); RESC(); ROT();
  }
  STEP(pB0,pB1,pA0,pA1,NT-1,false,false,false); RESC();
  { float sacc=pB0[0]+pB0[1]; _Pragma("unroll") for(int r=2;r<16;++r)sacc+=pB0[r]; _Pragma("unroll") for(int r=0;r<16;++r)sacc+=pB1[r]; l_reg+=sacc;
    pw0=(u32x4){PKW(pB0,0),PKW(pB0,2),PKW(pB0,4),PKW(pB0,6)};pw1=(u32x4){PKW(pB0,8),PKW(pB0,10),PKW(pB0,12),PKW(pB0,14)};pw2=(u32x4){PKW(pB1,0),PKW(pB1,2),PKW(pB1,4),PKW(pB1,6)};pw3=(u32x4){PKW(pB1,8),PKW(pB1,10),PKW(pB1,12),PKW(pB1,14)};
    SBAR(); pv(o,vb0+sl_cur,PAF(0),PAF(1),PAF(2),PAF(3)); }
  #undef PKW
  #undef PAF
  #undef VFR
  #undef PIN
  #undef MX3
  #undef GAPA
  #undef GAPB
  #undef EX
  #undef VRD
  #undef KRD
  #undef STEP
  #undef ENDW
  {auto rr=__builtin_amdgcn_permlane32_swap(__float_as_uint(l_reg),__float_as_uint(l_reg),false,false);l_reg=__uint_as_float(rr[0])+__uint_as_float(rr[1]);}
  if(hi==0)wsf[32+r32]=l_reg;asm volatile("s_waitcnt lgkmcnt(0)":::"memory");
  float rli[16];
  #pragma unroll
  for(int r=0;r<16;++r)rli[r]=__builtin_amdgcn_rcpf(wsf[32+crow(r,hi)]);
  bf16h*Ow=O+(rowbase+q0+wid*QBLK)*DMO+h*D;
  { bf16h*stg=(bf16h*)(shm+LDS_OST)+wid*2048;
    #pragma unroll
    for(int r=0;r<16;++r){const int orow=crow(r,hi);
      #pragma unroll
      for(int d0=0;d0<2;++d0)stg[orow*64+d0*32+r32]=__float2bfloat16(o[d0][r]*rli[r]);}
    asm volatile("s_waitcnt lgkmcnt(0)":::"memory");
    #pragma unroll
    for(int i=0;i<4;++i){const int row=i*8+(lane>>3),ch=lane&7; const u32x4 v=*(const u32x4*)(stg+row*64+ch*8); *(u32x4*)(Ow+(long)row*DMO+ch*8)=v;} }
  asm volatile("s_waitcnt lgkmcnt(0)\n\ts_barrier":::"memory");
  #undef DMA_K
  #undef DMA_V
  #undef CMASK
  #undef PRELOAD
  #undef START
  #undef RESC
  #undef ROT
}

__device__ __forceinline__ int unit_j0_wave(int bh,int qb,const bf16h*Q,const float*KN2,const float*CL,int lane){
  const int b=bh/NHEAD,h=bh%NHEAD; constexpr int NTT=SEQ/KVBLK;
  float mx=0.f;
  #pragma unroll
  for(int rr=0;rr<QB/64;++rr){ const bf16h*Qw=Q+((long)b*SEQ+qb*QB+rr*64+lane)*DMI+h*D; float ss=0.f;
    #pragma unroll
    for(int c=0;c<8;++c){ const u32x4 v=*reinterpret_cast<const u32x4*>(&Qw[c*8]);
      #pragma unroll
      for(int e=0;e<4;++e){ const float f0=__uint_as_float(v[e]<<16),f1=__uint_as_float(v[e]&0xffff0000u); ss+=f0*f0+f1*f1; } }
    mx=fmaxf(mx,ss); }
  #pragma unroll
  for(int o=1;o<64;o<<=1) mx=fmaxf(mx,__shfl_xor(mx,o));
  const int nt=4*qb; const float*kn=KN2+bh*NTT;
  const float Qn=sqrtf(mx),KNd=sqrtf(fmaxf(fmaxf(kn[nt],kn[nt+1]),fmaxf(kn[nt+2],kn[nt+3])));
  const float clt0=CL[qb*QB];
  int first=nt;
  #pragma unroll
  for(int part=1;part>=0;--part){ const int i=lane+64*part; bool need=false;
    if(i<nt){ const float bound=Qn*(sqrtf(kn[i])+KNd)+clt0-CL[KVBLK*i+KVBLK-1]; need=!(bound<-40.f); }
    const unsigned long long bal=__ballot(need); if(bal) first=__ffsll((long long)bal)-1+64*part; }
  return (first<nt?first:nt)&~1;
}
#undef SBAR
#undef WAIT_BAR
}

#define GAS __attribute__((address_space(1)))
#define LAS __attribute__((address_space(3)))
typedef unsigned v4u __attribute__((ext_vector_type(4)));
typedef float f32x4 __attribute__((ext_vector_type(4)));
typedef GAS unsigned gu32;
#define RLX_AGENT __ATOMIC_RELAXED, __HIP_MEMORY_SCOPE_AGENT
#define LDS_WAIT() asm volatile("s_waitcnt lgkmcnt(0)" ::: "memory")
#define VM_WAIT() asm volatile("s_waitcnt vmcnt(0)" ::: "memory")
__device__ __forceinline__ unsigned pk2(float lo, float hi) { return (unsigned)f2bf(lo) | ((unsigned)f2bf(hi) << 16); }
__device__ __forceinline__ void unpack8(const v4u w, float* f) {
#pragma unroll
    for (int i = 0; i < 4; ++i) { f[2 * i] = __uint_as_float(w[i] << 16); f[2 * i + 1] = __uint_as_float(w[i] & 0xffff0000u); }
}

#define XB_TMO      128
#define XB_XCNT(j)  (256  + 64 * (j))
#define XB_XSUB(j)  (1280 + 64 * (j))
#define XB_XGEN(j)  (2304 + 64 * (j))
#define XB_TOP      3328
#define XB_TOPGEN   3392
#define XCD_BAR_WORDS 3456
#define XB_SPIN_CAP (1u << 18)
__device__ __forceinline__ unsigned xb_ld(unsigned* p)              { return __hip_atomic_load(p, __ATOMIC_RELAXED, __HIP_MEMORY_SCOPE_AGENT); }
__device__ __forceinline__ unsigned xb_add(unsigned* p, unsigned v) { return __hip_atomic_fetch_add(p, v, __ATOMIC_RELAXED, __HIP_MEMORY_SCOPE_AGENT); }
__device__ __forceinline__ unsigned xb_xcc_id() { return (unsigned)__builtin_amdgcn_s_getreg((3 << 11) | 20) & 0xFu; }
#define XB_SPIN(cond, bar) do { unsigned _sp = 0; while (cond) { __builtin_amdgcn_s_sleep(1); \
    if ((++_sp & 255u) == 0u) { if (xb_ld(&(bar)[XB_TMO])) break; if (_sp > XB_SPIN_CAP) { atomicAdd(&(bar)[XB_TMO], 1u); break; } } } } while (0)
struct XcdBarrier { unsigned* bar; unsigned x; volatile LAS unsigned* st; };
__device__ __forceinline__ XcdBarrier xcd_barrier_post(unsigned* bar, volatile LAS unsigned* st) {
    XcdBarrier b; b.bar = bar; b.x = xb_xcc_id(); b.st = st;
    if (threadIdx.x == 0) (void)xb_add(&bar[XB_XCNT(b.x)], 1u);
    return b;
}
__device__ __forceinline__ void xcd_barrier_complete(unsigned* bar, unsigned x, unsigned& nloc, unsigned& nx) {
    const unsigned G = gridDim.x * gridDim.y * gridDim.z;
    unsigned sum, cnt, mine, sp = 0u;
    for (;;) {
        sum = 0u; cnt = 0u; mine = 0u;
#pragma unroll
        for (unsigned j = 0; j < 16; ++j) { const unsigned c = xb_ld(&bar[XB_XCNT(j)]); sum += c; cnt += (c > 0u) ? 1u : 0u; mine = (j == x) ? c : mine; }
        if (sum == G) break;
        __builtin_amdgcn_s_sleep(1);
        if ((++sp & 255u) == 0u) { if (xb_ld(&bar[XB_TMO])) break; if (sp > XB_SPIN_CAP) { atomicAdd(&bar[XB_TMO], 1u); break; } }
    }
    nloc = mine > 0u ? mine : 1u; nx = cnt > 0u ? cnt : 1u;
}
__device__ __forceinline__ void xcd_barrier(const XcdBarrier& b) {
    asm volatile("s_waitcnt vmcnt(0)" ::: "memory");
    __syncthreads();
    if (threadIdx.x == 0) {
        unsigned* bar = b.bar;
        __builtin_amdgcn_s_waitcnt(0);
        unsigned nloc = b.st[0], nx = b.st[1];
        if (nloc == 0u) { xcd_barrier_complete(bar, b.x, nloc, nx); b.st[0] = nloc; b.st[1] = nx; }
        const unsigned old = xb_add(&bar[XB_XSUB(b.x)], 1u);
        const unsigned gen = old / nloc;
        if (old + 1u == (gen + 1u) * nloc) {
            __builtin_amdgcn_fence(__ATOMIC_RELEASE, "agent");
            asm volatile("s_waitcnt vmcnt(0)" ::: "memory");
            const unsigned og = xb_add(&bar[XB_TOP], 1u);
            const unsigned tg = og / nx;
            if (og + 1u == (tg + 1u) * nx) xb_add(&bar[XB_TOPGEN], 1u);
            else XB_SPIN(xb_ld(&bar[XB_TOPGEN]) == tg, bar);
            __builtin_amdgcn_fence(__ATOMIC_ACQUIRE, "agent");
            xb_add(&bar[XB_XGEN(b.x)], 1u);
            asm volatile("s_waitcnt vmcnt(0)" ::: "memory");
        } else {
            XB_SPIN(xb_ld(&bar[XB_XGEN(b.x)]) == gen, bar);
            __builtin_amdgcn_fence(__ATOMIC_ACQUIRE, "agent");
            asm volatile("s_waitcnt vmcnt(0)" ::: "memory");
        }
    }
    __syncthreads();
}


namespace xat {
typedef short bf16x8 __attribute__((ext_vector_type(8)));
typedef short s16x4 __attribute__((ext_vector_type(4)));
typedef float f32x16 __attribute__((ext_vector_type(16)));
constexpr int RB = 272;
constexpr int KIMG = 0, VIMG = 128 * RB, LDS_BYTES = 2 * 128 * RB;
__device__ __forceinline__ unsigned cvtpk(float lo, float hi) { typedef float f2 __attribute__((ext_vector_type(2))); typedef __bf16 b2 __attribute__((ext_vector_type(2))); f2 v = {lo, hi}; b2 b = __builtin_convertvector(v, b2); return __builtin_bit_cast(unsigned, b); }
__device__ __forceinline__ float swapmax(float m) { auto rr = __builtin_amdgcn_permlane32_swap(__float_as_uint(m), __float_as_uint(m), false, false); return fmaxf(__uint_as_float(rr[0]), __uint_as_float(rr[1])); }
__device__ __forceinline__ float swapadd(float m) { auto rr = __builtin_amdgcn_permlane32_swap(__float_as_uint(m), __float_as_uint(m), false, false); return __uint_as_float(rr[0]) + __uint_as_float(rr[1]); }
__device__ __forceinline__ void unit(int b, int head, int qb, const bf16* QX, const bf16* KX, const bf16* VT, bf16* OX, LAS unsigned char* lds) {
    int tid = threadIdx.x; asm volatile("" : "+v"(tid));
    const int lane = tid & 63, r32 = lane & 31, h = lane >> 5, wid = tid >> 6;
    const size_t qrow = (size_t)b * SEQ + (size_t)qb * 256 + wid * 32 + r32;
    bf16x8 qf[8];
#pragma unroll
    for (int d0 = 0; d0 < 8; ++d0) qf[d0] = *(const bf16x8*)(QX + qrow * 512 + head * 128 + 16 * d0 + 8 * h);
    f32x16 o[4];
#pragma unroll
    for (int db = 0; db < 4; ++db) o[db] = (f32x16){};
    float mrun = -INFINITY, lsum = 0.f;
#pragma unroll 1
    for (int half = 0; half < 2; ++half) {
        __syncthreads();
#pragma unroll
        for (int i = 0; i < 4; ++i) { const int c = tid + 512 * i, row = c >> 4, ch = c & 15;
            const v4u kv = *(const GAS v4u*)(KX + ((size_t)b * NMEM + half * 128 + row) * 512 + head * 128 + ch * 8);
            const v4u vv = *(const GAS v4u*)(VT + ((size_t)head * 128 + row) * 512 + b * NMEM + half * 128 + ch * 8);
            *(LAS v4u*)(lds + KIMG + row * RB + ch * 16) = kv; *(LAS v4u*)(lds + VIMG + row * RB + ch * 16) = vv; }
        __syncthreads();
        f32x16 st[4];
#pragma unroll
        for (int kb = 0; kb < 4; ++kb) { st[kb] = (f32x16){};
#pragma unroll
            for (int d0 = 0; d0 < 8; ++d0) { const bf16x8 a = *(const LAS bf16x8*)(lds + KIMG + (32 * kb + r32) * RB + (16 * d0 + 8 * h) * 2);
                st[kb] = __builtin_amdgcn_mfma_f32_32x32x16_bf16(a, qf[d0], st[kb], 0, 0, 0); } }
        float mloc = st[0][0];
#pragma unroll
        for (int kb = 0; kb < 4; ++kb)
#pragma unroll
            for (int i = 0; i < 16; ++i) mloc = fmaxf(mloc, st[kb][i]);
        const float mnew = fmaxf(mrun, swapmax(mloc)), alpha = __builtin_amdgcn_exp2f(mrun - mnew);
        float psum = 0.f;
#pragma unroll
        for (int kb = 0; kb < 4; ++kb)
#pragma unroll
            for (int i = 0; i < 16; ++i) { st[kb][i] = __builtin_amdgcn_exp2f(st[kb][i] - mnew); psum += st[kb][i]; }
        lsum = lsum * alpha + psum; mrun = mnew;
#pragma unroll
        for (int db = 0; db < 4; ++db)
#pragma unroll
            for (int i = 0; i < 16; ++i) o[db][i] *= alpha;
#pragma unroll
        for (int kb = 0; kb < 4; ++kb)
#pragma unroll
            for (int sp = 0; sp < 2; ++sp) {
                v4u pw; pw.x = cvtpk(st[kb][8 * sp], st[kb][8 * sp + 1]); pw.y = cvtpk(st[kb][8 * sp + 2], st[kb][8 * sp + 3]); pw.z = cvtpk(st[kb][8 * sp + 4], st[kb][8 * sp + 5]); pw.w = cvtpk(st[kb][8 * sp + 6], st[kb][8 * sp + 7]);
                const bf16x8 pb = __builtin_bit_cast(bf16x8, pw);
#pragma unroll
                for (int db = 0; db < 4; ++db) { const LAS unsigned char* vp = lds + VIMG + (32 * db + r32) * RB + (32 * kb + 16 * sp + 4 * h) * 2;
                    const s16x4 lo = *(const LAS s16x4*)vp, hi = *(const LAS s16x4*)(vp + 16);
                    const bf16x8 va = {lo[0], lo[1], lo[2], lo[3], hi[0], hi[1], hi[2], hi[3]};
                    o[db] = __builtin_amdgcn_mfma_f32_32x32x16_bf16(va, pb, o[db], 0, 0, 0); } }
    }
    const float inv = 1.f / swapadd(lsum);
    bf16* orow = OX + qrow * 512 + head * 128;
#pragma unroll
    for (int db = 0; db < 4; ++db)
#pragma unroll
        for (int g = 0; g < 4; ++g) {
            const unsigned long long w = (unsigned long long)cvtpk(o[db][4 * g] * inv, o[db][4 * g + 1] * inv) | ((unsigned long long)cvtpk(o[db][4 * g + 2] * inv, o[db][4 * g + 3] * inv) << 32);
            *(GAS unsigned long long*)(orow + 32 * db + 8 * g + 4 * h) = w; }
}
}


namespace mls {
typedef short bf16x8 __attribute__((ext_vector_type(8)));
typedef short s16x4 __attribute__((ext_vector_type(4)));
typedef float f32x16 __attribute__((ext_vector_type(16)));
constexpr int RB = 128, VIMG = 0, KIMG = 8192, ATAB = 8192, NTAB = 8448;
__device__ __forceinline__ s16x4 trd(const LAS unsigned char* p) { typedef short v4i16_t __attribute__((ext_vector_type(4))); return __builtin_bit_cast(s16x4, __builtin_amdgcn_ds_read_tr16_b64_v4i16((LAS v4i16_t*)p)); }
__device__ __forceinline__ bf16x8 cat8(s16x4 lo, s16x4 hi) { return (bf16x8){lo[0], lo[1], lo[2], lo[3], hi[0], hi[1], hi[2], hi[3]}; }
__device__ __forceinline__ unsigned cvtpk(float lo, float hi) { typedef float f2 __attribute__((ext_vector_type(2))); typedef __bf16 b2 __attribute__((ext_vector_type(2))); f2 v = {lo, hi}; b2 b = __builtin_convertvector(v, b2); return __builtin_bit_cast(unsigned, b); }
__device__ __forceinline__ bf16x8 pack8(const float* f) { v4u w; w.x = cvtpk(f[0], f[1]); w.y = cvtpk(f[2], f[3]); w.z = cvtpk(f[4], f[5]); w.w = cvtpk(f[6], f[7]); return __builtin_bit_cast(bf16x8, w); }
__device__ __forceinline__ float swapadd(float m) { auto rr = __builtin_amdgcn_permlane32_swap(__float_as_uint(m), __float_as_uint(m), false, false); return __uint_as_float(rr[0]) + __uint_as_float(rr[1]); }
__device__ __forceinline__ int crow(int r, int hi) { return (r & 3) + 8 * (r >> 2) + 4 * hi; }

__device__ __forceinline__ void u_unit(const Ptrs& P, int bhk, LAS unsigned char* wl, int lane) {
    const int bh = bhk / NCH, k = bhk % NCH, b = bh / MH, hd = bh % MH; const size_t row0 = (size_t)b * SEQ + (size_t)k * 64;
    const int r32 = lane & 31, h = lane >> 5;
    const float li = WSP(const float, WS_GATE)[(size_t)hd * M + row0 + lane], bl = WSP(const float, WS_BL)[(size_t)bh * SEQ + k * 64 + lane];
    const float wg = __expf(WSP(const float, WS_BT)[bhk] - bl + li - WSP(const float, WS_MS)[bh * (NCH + 1) + k + 1]);
    const bf16* vsrc = WSP(const bf16, R_T0 + SZ_T) + row0 * 512 + hd * 64; const bf16* ksrc = WSP(const bf16, R_MQK) + row0 * 512 + 256 + hd * 64;
#pragma unroll
    for (int i = 0; i < 8; ++i) { const int row = i * 8 + (lane >> 3), ch = lane & 7;
        *(LAS v4u*)(wl + VIMG + row * RB + ch * 16) = *(const GAS v4u*)(vsrc + (size_t)row * 512 + ch * 8);
        const v4u kk = *(const GAS v4u*)(ksrc + (size_t)row * 512 + ch * 8); float f[8]; unpack8(kk, f); const float w = __shfl(wg, row);
#pragma unroll
        for (int e = 0; e < 8; ++e) f[e] *= w;
        *(LAS bf16x8*)(wl + KIMG + row * RB + ch * 16) = pack8(f); }
    f32x16 acc[2][2];
#pragma unroll
    for (int a = 0; a < 2; ++a)
#pragma unroll
        for (int c = 0; c < 2; ++c) acc[a][c] = (f32x16){};
    const unsigned toff = (unsigned)(((lane & 15) >> 2) * RB + (16 * ((lane >> 4) & 1) + 4 * (lane & 3)) * 2);
#pragma unroll
    for (int st = 0; st < 4; ++st) { bf16x8 af[2], bf_[2];
#pragma unroll
        for (int c = 0; c < 2; ++c) { const LAS unsigned char* pv = wl + VIMG + (16 * st + 8 * h) * RB + toff + 64 * c; af[c] = cat8(trd(pv), trd(pv + 4 * RB));
                                      const LAS unsigned char* pk = wl + KIMG + (16 * st + 8 * h) * RB + toff + 64 * c; bf_[c] = cat8(trd(pk), trd(pk + 4 * RB)); }
#pragma unroll
        for (int jb = 0; jb < 2; ++jb)
#pragma unroll
            for (int ib = 0; ib < 2; ++ib) acc[jb][ib] = __builtin_amdgcn_mfma_f32_32x32x16_bf16(af[jb], bf_[ib], acc[jb][ib], 0, 0, 0); }
    float* UT = WSP(float, R_CST) + (size_t)bhk * 4096;
#pragma unroll
    for (int jb = 0; jb < 2; ++jb)
#pragma unroll
        for (int ib = 0; ib < 2; ++ib)
#pragma unroll
            for (int e = 0; e < 16; ++e) UT[(32 * jb + crow(e, h)) * 64 + 32 * ib + r32] = acc[jb][ib][e];
    float sn = 0.f;
#pragma unroll 8
    for (int r = 0; r < 64; ++r) sn += bf2f(*(const LAS bf16*)(wl + KIMG + r * RB + lane * 2));
    WSP(float, WS_NST)[(size_t)bhk * 64 + lane] = sn;
}

__device__ __forceinline__ void decay_apply(f32x16& tile, int sb, int tb, const LAS float* atab, float mx, float& dsum, int r32, int h) {
#pragma unroll
    for (int g = 0; g < 4; ++g) { const f32x4 av = *(const LAS f32x4*)(atab + 32 * sb + 8 * g + 4 * h);
#pragma unroll
        for (int c = 0; c < 4; ++c) { const int sidx = 32 * sb + 8 * g + 4 * h + c, t = 32 * tb + r32;
            const float w = (sidx <= t) ? __expf(av[c] - mx) : 0.f; tile[4 * g + c] *= w; dsum += tile[4 * g + c]; } }
}
__device__ __forceinline__ bf16x8 packstep(const f32x16& x, int st) { v4u w; w.x = cvtpk(x[8 * st], x[8 * st + 1]); w.y = cvtpk(x[8 * st + 2], x[8 * st + 3]); w.z = cvtpk(x[8 * st + 4], x[8 * st + 5]); w.w = cvtpk(x[8 * st + 6], x[8 * st + 7]); return __builtin_bit_cast(bf16x8, w); }

__device__ __forceinline__ void out_unit(const Ptrs& P, int l, int bhk, LAS unsigned char* wl, int lane) {
    const int bh = bhk / NCH, k = bhk % NCH, b = bh / MH, hd = bh % MH; const size_t row0 = (size_t)b * SEQ + (size_t)k * 64;
    const int r32 = lane & 31, h = lane >> 5;
    const bf16* T1 = WSP(const bf16, R_T0 + SZ_T); const bf16* MQK = WSP(const bf16, R_MQK);
    const bf16* vsrc = T1 + row0 * 512 + hd * 64;
    v4u vreg[8];
#pragma unroll
    for (int i = 0; i < 8; ++i) { const int row = i * 8 + (lane >> 3), ch = lane & 7; vreg[i] = *(const GAS v4u*)(vsrc + (size_t)row * 512 + ch * 8); }
    bf16x8 qf[2][4], kf[2][4];
#pragma unroll
    for (int tb = 0; tb < 2; ++tb)
#pragma unroll
        for (int d0 = 0; d0 < 4; ++d0) { qf[tb][d0] = *(const bf16x8*)(MQK + (row0 + 32 * tb + r32) * 512 + hd * 64 + 16 * d0 + 8 * h);
                                         kf[tb][d0] = *(const bf16x8*)(MQK + (row0 + 32 * tb + r32) * 512 + 256 + hd * 64 + 16 * d0 + 8 * h); }
    const float li_s = WSP(const float, WS_GATE)[(size_t)hd * M + row0 + lane], bl_s = WSP(const float, WS_BL)[(size_t)bh * SEQ + k * 64 + lane];
    const float mk = WSP(const float, WS_MS)[bh * (NCH + 1) + k]; const float nst = WSP(const float, WS_NST)[(size_t)bhk * 64 + lane];
    const float a_s = li_s - bl_s; float pm = a_s;
#pragma unroll
    for (int o = 1; o < 64; o <<= 1) { const float t = __shfl_up(pm, o); if (lane >= o) pm = fmaxf(pm, t); }
    LAS float* atab = (LAS float*)(wl + ATAB); LAS float* ntab = (LAS float*)(wl + NTAB);
    atab[lane] = a_s; ntab[lane] = nst;
    float mx[2], wi[2], blt[2];
#pragma unroll
    for (int tb = 0; tb < 2; ++tb) { const int t = 32 * tb + r32; blt[tb] = __shfl(bl_s, t); mx[tb] = fmaxf(mk, __shfl(pm, t)); wi[tb] = __expf(mk - mx[tb]); }
#pragma unroll
    for (int i = 0; i < 8; ++i) { const int row = i * 8 + (lane >> 3), ch = lane & 7; *(LAS v4u*)(wl + VIMG + row * RB + ch * 16) = vreg[i]; }
    f32x16 s00 = (f32x16){}, s01 = (f32x16){}, s11 = (f32x16){};
#pragma unroll
    for (int d0 = 0; d0 < 4; ++d0) { s00 = __builtin_amdgcn_mfma_f32_32x32x16_bf16(kf[0][d0], qf[0][d0], s00, 0, 0, 0);
        s01 = __builtin_amdgcn_mfma_f32_32x32x16_bf16(kf[0][d0], qf[1][d0], s01, 0, 0, 0); s11 = __builtin_amdgcn_mfma_f32_32x32x16_bf16(kf[1][d0], qf[1][d0], s11, 0, 0, 0); }
    float dsum[2] = {0.f, 0.f};
    decay_apply(s00, 0, 0, atab, mx[0], dsum[0], r32, h); decay_apply(s01, 0, 1, atab, mx[1], dsum[1], r32, h); decay_apply(s11, 1, 1, atab, mx[1], dsum[1], r32, h);
    f32x16 nacc[2][2];
#pragma unroll
    for (int a = 0; a < 2; ++a)
#pragma unroll
        for (int c = 0; c < 2; ++c) nacc[a][c] = (f32x16){};
    const unsigned toff = (unsigned)(((lane & 15) >> 2) * RB + (16 * ((lane >> 4) & 1) + 4 * (lane & 3)) * 2);
#pragma unroll
    for (int sb = 0; sb < 2; ++sb)
#pragma unroll
        for (int st = 0; st < 2; ++st) { bf16x8 va[2];
#pragma unroll
            for (int jb = 0; jb < 2; ++jb) { const LAS unsigned char* pv = wl + VIMG + (32 * sb + 16 * st + 4 * h) * RB + toff + 64 * jb; va[jb] = cat8(trd(pv), trd(pv + 8 * RB)); }
            if (sb == 0) { const bf16x8 p0 = packstep(s00, st), p1 = packstep(s01, st);
#pragma unroll
                for (int jb = 0; jb < 2; ++jb) { nacc[jb][0] = __builtin_amdgcn_mfma_f32_32x32x16_bf16(va[jb], p0, nacc[jb][0], 0, 0, 0); nacc[jb][1] = __builtin_amdgcn_mfma_f32_32x32x16_bf16(va[jb], p1, nacc[jb][1], 0, 0, 0); }
            } else { const bf16x8 p1 = packstep(s11, st);
#pragma unroll
                for (int jb = 0; jb < 2; ++jb) nacc[jb][1] = __builtin_amdgcn_mfma_f32_32x32x16_bf16(va[jb], p1, nacc[jb][1], 0, 0, 0); } }
    const float* CT = WSP(const float, R_CST) + (size_t)bhk * 4096;
    float dint[2] = {0.f, 0.f};
#pragma unroll
    for (int st = 0; st < 4; ++st) { bf16x8 ca[2];
#pragma unroll
        for (int jb = 0; jb < 2; ++jb) { const float* cp = CT + (32 * jb + r32) * 64 + 16 * st + 8 * h; const f32x4 c0 = *(const f32x4*)cp, c1 = *(const f32x4*)(cp + 4);
            const float f[8] = {c0[0], c0[1], c0[2], c0[3], c1[0], c1[1], c1[2], c1[3]}; ca[jb] = pack8(f); }
        const f32x4 n0 = *(const LAS f32x4*)(ntab + 16 * st + 8 * h), n1 = *(const LAS f32x4*)(ntab + 16 * st + 8 * h + 4);
#pragma unroll
        for (int tb = 0; tb < 2; ++tb) { float f[8]; unpack8(__builtin_bit_cast(v4u, qf[tb][st]), f);
            dint[tb] += (f[0] * n0[0] + f[1] * n0[1]) + (f[2] * n0[2] + f[3] * n0[3]) + (f[4] * n1[0] + f[5] * n1[1]) + (f[6] * n1[2] + f[7] * n1[3]);
#pragma unroll
            for (int e = 0; e < 8; ++e) f[e] *= wi[tb];
            const bf16x8 qw = pack8(f);
#pragma unroll
            for (int jb = 0; jb < 2; ++jb) nacc[jb][tb] = __builtin_amdgcn_mfma_f32_32x32x16_bf16(ca[jb], qw, nacc[jb][tb], 0, 0, 0); } }
    const float* nw = P.in[I_MNW] + l * 256 + hd * 64; bf16* CAT = WSP(bf16, R_CAT);
#pragma unroll
    for (int tb = 0; tb < 2; ++tb) {
        const float den = swapadd(dsum[tb]) + wi[tb] * swapadd(dint[tb]);
        const float dinv = 1.f / fmaxf(fabsf(den), __expf(-(blt[tb] + mx[tb])));
        float ss = 0.f;
#pragma unroll
        for (int jb = 0; jb < 2; ++jb)
#pragma unroll
            for (int e = 0; e < 16; ++e) { const float v = nacc[jb][tb][e] * dinv; ss += v * v; }
        const float scale = dinv / sqrtf(swapadd(ss) * (1.f / 64.f) + EPS);
        const size_t row = row0 + 32 * tb + r32;
#pragma unroll
        for (int jb = 0; jb < 2; ++jb)
#pragma unroll
            for (int g = 0; g < 4; ++g) { const int j0 = 32 * jb + 8 * g + 4 * h; const f32x4 nwv = *(const f32x4*)(nw + j0);
                const unsigned long long mo = *(const GAS unsigned long long*)(T1 + row * 512 + 256 + hd * 64 + j0);
                const float m0 = __uint_as_float((unsigned)(mo << 16)), m1 = __uint_as_float((unsigned)mo & 0xffff0000u), m2 = __uint_as_float((unsigned)(mo >> 32) << 16), m3 = __uint_as_float((unsigned)(mo >> 32) & 0xffff0000u);
                const float y0 = nacc[jb][tb][4 * g] * scale * nwv[0] * __builtin_amdgcn_rcpf(1.f + __expf(-m0)), y1 = nacc[jb][tb][4 * g + 1] * scale * nwv[1] * __builtin_amdgcn_rcpf(1.f + __expf(-m1));
                const float y2 = nacc[jb][tb][4 * g + 2] * scale * nwv[2] * __builtin_amdgcn_rcpf(1.f + __expf(-m2)), y3 = nacc[jb][tb][4 * g + 3] * scale * nwv[3] * __builtin_amdgcn_rcpf(1.f + __expf(-m3));
                *(GAS unsigned long long*)(CAT + row * 1024 + hd * 64 + j0) = (unsigned long long)cvtpk(y0, y1) | ((unsigned long long)cvtpk(y2, y3) << 32); }
    }
}
__device__ __forceinline__ void state_scan(const Ptrs& P, long gtid, long gn) {
    const float* DEC = WSP(const float, WS_DEC); float* CST = WSP(float, R_CST); float* NST = WSP(float, WS_NST);
    for (long it = gtid; it < 8 * 4160; it += gn) {
        const int bh = (int)it / 4160, e = (int)it % 4160; float run = 0.f;
        float* base = e < 4096 ? CST + (size_t)bh * NCH * 4096 + e : NST + (size_t)bh * NCH * 64 + (e - 4096); const size_t stride = e < 4096 ? 4096 : 64;
        for (int k0 = 0; k0 < NCH; k0 += 16) { float u[16], d[16];
#pragma unroll
            for (int i = 0; i < 16; ++i) { u[i] = base[(size_t)(k0 + i) * stride]; d[i] = DEC[bh * NCH + k0 + i]; }
#pragma unroll
            for (int i = 0; i < 16; ++i) { base[(size_t)(k0 + i) * stride] = run; run = d[i] * run + u[i]; } }
    }
}
}

constexpr int RING_BYTES = 131072;
constexpr int MISC_OFF = RING_BYTES;
constexpr int PTR_OFF = RING_BYTES + 256;
constexpr int JOB_OFF = RING_BYTES + 512;
constexpr int LDS_BYTES = 147456;
constexpr int NWAVES = 8;

__device__ __forceinline__ float wave_sum(float v) {
#pragma unroll
    for (int o = 1; o < 64; o <<= 1) v += __shfl_xor(v, o);
    return v;
}
struct WJob { const float* W0; const float* W1; const float* rs; bf16* WT; int K, Nsrc, nblk, kind; float cs; int item0; int pad0, pad1; };
constexpr int MAX_JOBS = 32;
__device__ __forceinline__ void p0_transpose_item(const LAS WJob* jb, LAS float* scr, int item, int lane) {
    const int K = jb->K, N = jb->Nsrc, nblk = jb->nblk, kb = item / nblk, nb = item % nblk, k0 = 64 * kb;
    int which, col0; float cs; wmap(jb->kind, nb, which, col0, cs); cs *= jb->cs;
    const float* W = which ? jb->W1 : jb->W0; const float* rs = jb->rs;
    const float* src = W + (size_t)(k0 + (lane >> 5)) * N + col0 + (lane & 31);
    float v[32];
#pragma unroll
    for (int i = 0; i < 32; ++i) v[i] = __builtin_nontemporal_load(src + (size_t)(2 * i) * N);
#pragma unroll
    for (int i = 0; i < 32; ++i) scr[(2 * i + (lane >> 5)) * 33 + (lane & 31)] = v[i];
    LDS_WAIT(); asm volatile("" ::: "memory");
    const int c = lane & 7; bf16* WT = jb->WT;
    f32x4 r0 = {cs, cs, cs, cs}, r1 = r0;
    if (rs) { r0 = *(const f32x4*)(rs + k0 + 8 * c) * cs; r1 = *(const f32x4*)(rs + k0 + 8 * c + 4) * cs; }
#pragma unroll
    for (int j = 0; j < 4; ++j) { const int n = (lane >> 3) + 8 * j; const LAS float* sp = scr + (8 * c) * 33 + n;
        v4u o; o.x = pk2(sp[0 * 33] * r0[0], sp[1 * 33] * r0[1]); o.y = pk2(sp[2 * 33] * r0[2], sp[3 * 33] * r0[3]); o.z = pk2(sp[4 * 33] * r1[0], sp[5 * 33] * r1[1]); o.w = pk2(sp[6 * 33] * r1[2], sp[7 * 33] * r1[3]);
        __builtin_nontemporal_store(o, (GAS v4u*)(WT + (size_t)(nb * 32 + n) * K + k0 + 8 * c)); }
    LDS_WAIT(); asm volatile("" ::: "memory");
}
__device__ __forceinline__ void build_gw(const Ptrs& P, long gtid, long gn) {
    for (long it = gtid; it < 3 * 32 * 64; it += gn) {
        const int t = (int)(it / 2048), ks = (int)((it / 64) % 32), ln = (int)(it % 64), c = ln & 15, quad = ln >> 4;
        float hi[8], lo[8];
#pragma unroll
        for (int j = 0; j < 8; ++j) { const int k = 32 * ks + 8 * quad + j; float w;
            if (t < 2) w = P.in[I_NMIX][t * D + k] * P.in[I_WIN][(size_t)t * D * INW + (size_t)k * INW + (c < 8 ? 1024 + c : 3072 + c)];
            else w = (c < 8) ? P.in[I_NFFN][D + k] * P.in[I_RW][(size_t)k * 8 + c] : 0.f;
            const float h = bf2f(f2bf(w)); hi[j] = h; lo[j] = w - h; }
        v4u oh, ol; oh.x = pk2(hi[0], hi[1]); oh.y = pk2(hi[2], hi[3]); oh.z = pk2(hi[4], hi[5]); oh.w = pk2(hi[6], hi[7]); ol.x = pk2(lo[0], lo[1]); ol.y = pk2(lo[2], lo[3]); ol.z = pk2(lo[4], lo[5]); ol.w = pk2(lo[6], lo[7]);
        v4u* tab = (v4u*)(P.ws + WS_GW + (size_t)t * 65536); tab[(ks * 2 + 0) * 64 + ln] = oh; tab[(ks * 2 + 1) * 64 + ln] = ol;
    }
}
template <int MODE, bool PRE>
__device__ __forceinline__ void norm16(const Ptrs& P, int l, const float* src, bf16* XN, const unsigned* rss_in, int vcu, int G, int wave, int lane, LAS float* xch) {
    typedef short bf16x8 __attribute__((ext_vector_type(8)));
    const int r = lane & 15, quad = lane >> 4, kh = wave >> 2;
    const v4u* tab = (const v4u*)(P.ws + WS_GW + (size_t)(MODE == 2 ? 2 : l) * 65536) + lane;
    if constexpr (MODE == 2) { if (wave == 0 && lane < 8) ((LAS unsigned*)(xch + 2048))[64 * 4 + lane] = 0u; }
    for (int t0 = 0; t0 < M / 16; t0 += 4 * G) {
        const int task = t0 + (wave & 3) * G + vcu; const bool live = task < M / 16; const int r0 = (live ? task : 0) * 16;
        const float* xr = src + (size_t)(r0 + r) * D + 8 * quad; bf16* xo = XN + (size_t)(r0 + r) * D + 8 * quad;
        f32x4 acc = {0.f, 0.f, 0.f, 0.f}; float ss = 0.f;
#pragma unroll
        for (int kk = 0; kk < 16; ++kk) { const int ks = 16 * kh + kk;
            if constexpr (PRE) {
                const v4u h = *(const GAS v4u*)(xo + 32 * ks);
                const bf16x8 ah = __builtin_bit_cast(bf16x8, h);
                const bf16x8 bh = __builtin_bit_cast(bf16x8, tab[(ks * 2 + 0) * 64]), bl = __builtin_bit_cast(bf16x8, tab[(ks * 2 + 1) * 64]);
                acc = __builtin_amdgcn_mfma_f32_16x16x32_bf16(ah, bh, acc, 0, 0, 0); acc = __builtin_amdgcn_mfma_f32_16x16x32_bf16(ah, bl, acc, 0, 0, 0);
            } else {
            const f32x4 a = __builtin_nontemporal_load((const GAS f32x4*)(xr + 32 * ks)), b = __builtin_nontemporal_load((const GAS f32x4*)(xr + 32 * ks + 4));
            ss += (a[0] * a[0] + a[1] * a[1]) + (a[2] * a[2] + a[3] * a[3]) + (b[0] * b[0] + b[1] * b[1]) + (b[2] * b[2] + b[3] * b[3]);
            v4u h; h.x = pk2(a[0], a[1]); h.y = pk2(a[2], a[3]); h.z = pk2(b[0], b[1]); h.w = pk2(b[2], b[3]);
            if (live) *(GAS v4u*)(xo + 32 * ks) = h;
            if constexpr (MODE != 0) {
                float hf[8]; unpack8(h, hf);
                v4u lw; lw.x = pk2(a[0] - hf[0], a[1] - hf[1]); lw.y = pk2(a[2] - hf[2], a[3] - hf[3]); lw.z = pk2(b[0] - hf[4], b[1] - hf[5]); lw.w = pk2(b[2] - hf[6], b[3] - hf[7]);
                const bf16x8 ah = __builtin_bit_cast(bf16x8, h), al = __builtin_bit_cast(bf16x8, lw);
                const bf16x8 bh = __builtin_bit_cast(bf16x8, tab[(ks * 2 + 0) * 64]), bl = __builtin_bit_cast(bf16x8, tab[(ks * 2 + 1) * 64]);
                acc = __builtin_amdgcn_mfma_f32_16x16x32_bf16(ah, bh, acc, 0, 0, 0); acc = __builtin_amdgcn_mfma_f32_16x16x32_bf16(al, bh, acc, 0, 0, 0); acc = __builtin_amdgcn_mfma_f32_16x16x32_bf16(ah, bl, acc, 0, 0, 0);
            }
            }
        }
        { LAS float* xp = xch + ((wave & 3) * 64 + lane) * 5;
          if (kh == 1) { xp[0] = acc[0]; xp[1] = acc[1]; xp[2] = acc[2]; xp[3] = acc[3]; xp[4] = ss; }
          __syncthreads();
          if (kh == 0) { acc[0] += xp[0]; acc[1] += xp[1]; acc[2] += xp[2]; acc[3] += xp[3]; ss += xp[4]; }
          __syncthreads(); }
        if constexpr (MODE != 2) { if (kh == 1 || !live) continue; }
        if (MODE != 2 || (kh == 0 && live)) {
        unsigned sq;
        if constexpr (PRE) sq = rss_in[r0 + r]; else { ss += __shfl_xor(ss, 16); ss += __shfl_xor(ss, 32); sq = (unsigned)(ss * 16.f + 0.5f); if (lane < 16) WSP(unsigned, WS_RSTD)[r0 + lane] = sq; }
        ss = (float)sq * (1.f / 16.f);
        const float rstd = 1.f / sqrtf(ss * (1.f / D) + EPS);
        if constexpr (MODE != 0) {
            float z[4];
#pragma unroll
            for (int j = 0; j < 4; ++j) z[j] = acc[j] * __shfl(rstd, 4 * quad + j);
            if constexpr (MODE == 1) {
                const int g = r; f32x4 o;
#pragma unroll
                for (int j = 0; j < 4; ++j) { if (g < 4) o[j] = z[j] + P.in[I_MBI][l * 4 + g]; else if (g < 8) o[j] = logsigmoidf_(z[j] + P.in[I_MBF][l * 4 + g - 4]); else o[j] = logsigmoidf_(z[j] + P.in[I_FBF][l * 8 + g - 8]); }
                *(f32x4*)(WSP(float, WS_GATE) + (size_t)g * M + r0 + 4 * quad) = o;
            } else {
#pragma unroll
                for (int j = 0; j < 4; ++j) { float le[8];
#pragma unroll
                    for (int e = 0; e < 8; ++e) le[e] = __shfl(z[j], (lane & 48) + e);
                    int e1 = 0; float v1 = le[0];
#pragma unroll
                    for (int e = 1; e < 8; ++e) if (le[e] > v1) { v1 = le[e]; e1 = e; }
                    int e2 = -1; float v2 = -INFINITY;
#pragma unroll
                    for (int e = 0; e < 8; ++e) if (e != e1 && le[e] > v2) { v2 = le[e]; e2 = e; }
                    if (r == j) { const float g2 = 1.f / (1.f + expf(v1 - v2)), g1 = 1.f - g2;
                        LAS unsigned* sp = (LAS unsigned*)(xch + 2048) + ((wave & 3) * 16 + 4 * quad + j) * 4;
                        sp[0] = (unsigned)e1; sp[1] = (unsigned)e2; sp[2] = __float_as_uint(g1); sp[3] = __float_as_uint(g2); }
                }
            }
        }
        }
        if constexpr (MODE == 2) {
            LAS unsigned* selb = (LAS unsigned*)(xch + 2048); LAS unsigned* hacc = selb + 64 * 4;
            if (!(kh == 0 && live) && wave < 4 && r < 4) selb[((wave & 3) * 16 + 4 * quad + r) * 4] = 255u;
            __syncthreads();
            if (wave == 0) {
                const int w = lane >> 4, e1 = (int)selb[lane * 4], e2 = (int)selb[lane * 4 + 1]; const bool valid = e1 < 8;
                const unsigned long long below = (1ull << lane) - 1ull; int rank1 = 0, rank2 = 0; unsigned mynew = 0u;
#pragma unroll
                for (int e = 0; e < 8; ++e) { const unsigned old_ = hacc[e];
                    const unsigned long long m1 = __ballot(valid && e1 == e), m2 = __ballot(valid && e2 == e); const int c1 = __popcll(m1);
                    if (e1 == e) rank1 = (int)old_ + __popcll(m1 & below);
                    if (e2 == e) rank2 = (int)old_ + c1 + __popcll(m2 & below);
                    if (lane == e) mynew = old_ + (unsigned)(c1 + __popcll(m2)); }
                if (valid) { const int row = (t0 + w * G + vcu) * 16 + (lane & 15); unsigned* tk = WSP(unsigned, WS_TOK) + (size_t)row * 8;
                    tk[0] = (unsigned)e1; tk[1] = (unsigned)rank1; tk[2] = (unsigned)e2; tk[3] = (unsigned)rank2; tk[4] = selb[lane * 4 + 2]; tk[5] = selb[lane * 4 + 3]; }
                if (lane < 8) hacc[lane] = mynew;
            }
            __syncthreads();
        }
    }
    if constexpr (MODE == 2) { if (wave == 0 && lane < 8) WSP(unsigned, WS_BH)[vcu * 8 + lane] = ((LAS unsigned*)(xch + 2048))[64 * 4 + lane]; }
}
template <int MODE>
__device__ __forceinline__ void norm_rows(const Ptrs& P, int l, const float* src, bf16* XN, int nrows, int gw, int ngw, int lane) {
    for (int row = gw; row < nrows; row += ngw) {
        const GAS f32x4* xr = (const GAS f32x4*)(src + (size_t)row * D) + lane;
        f32x4 v[4]; float s2 = 0.f;
#pragma unroll
        for (int j = 0; j < 4; ++j) { v[j] = xr[64 * j]; s2 += (v[j].x * v[j].x + v[j].y * v[j].y) + (v[j].z * v[j].z + v[j].w * v[j].w); }
        const float rstd = 1.f / sqrtf(wave_sum(s2) * (1.f / D) + EPS);
        GAS unsigned long long* o8 = (GAS unsigned long long*)(XN + (size_t)row * D) + lane;
#pragma unroll
        for (int j = 0; j < 4; ++j) o8[64 * j] = (unsigned long long)pk2(v[j].x * rstd, v[j].y * rstd) | ((unsigned long long)pk2(v[j].z * rstd, v[j].w * rstd) << 32);
    }
}

__device__ __forceinline__ float wave_incl_scan(float v, int lane) {
#pragma unroll
    for (int o = 1; o < 64; o <<= 1) { const float t = __shfl_up(v, o); if (lane >= o) v += t; }
    return v;
}
__device__ __forceinline__ float wave_max(float v) {
#pragma unroll
    for (int o = 1; o < 64; o <<= 1) v = fmaxf(v, __shfl_xor(v, o));
    return v;
}
__device__ __forceinline__ void gate_scan_task(const Ptrs& P, int task, LAS float* scr, int tid) {
    const int lane = tid & 63, wave = tid >> 6; const float* GT = WSP(const float, WS_GATE);
    if (task < 16) {
        const int b = task / FH, h = task % FH; constexpr int EPT = SEQ / 512;
        const float* src = GT + (size_t)(8 + h) * M + (size_t)b * SEQ + tid * EPT; float* dst = WSP(float, WS_CF) + (size_t)task * SEQ + tid * EPT;
        float v[EPT]; float run = 0.f;
#pragma unroll
        for (int i = 0; i < EPT; i += 4) { const f32x4 x = *(const f32x4*)(src + i); run += x[0]; v[i] = run; run += x[1]; v[i + 1] = run; run += x[2]; v[i + 2] = run; run += x[3]; v[i + 3] = run; }
        const float wincl = wave_incl_scan(run, lane);
        if (lane == 63) scr[wave] = wincl;
        __syncthreads();
        float offs = wincl - run;
#pragma unroll
        for (int w = 0; w < 8; ++w) if (w < wave) offs += scr[w];
#pragma unroll
        for (int i = 0; i < EPT; i += 4) *(f32x4*)(dst + i) = (f32x4){(offs + v[i]) * LOG2E, (offs + v[i + 1]) * LOG2E, (offs + v[i + 2]) * LOG2E, (offs + v[i + 3]) * LOG2E};
        __syncthreads();
    } else {
        const int bh = task - 16, b = bh / MH, h = bh % MH;
        const float* lfp = GT + (size_t)(4 + h) * M + (size_t)b * SEQ; const float* lip = GT + (size_t)h * M + (size_t)b * SEQ;
        float* BL = WSP(float, WS_BL) + (size_t)bh * SEQ; float* BT = WSP(float, WS_BT) + bh * NCH; float* AK = WSP(float, WS_AK) + bh * NCH; float* MS = WSP(float, WS_MS) + bh * (NCH + 1);
        constexpr int CPW = NCH / 8;
        float lfv[CPW], liv[CPW];
#pragma unroll
        for (int i = 0; i < CPW; ++i) { const int k = wave + 8 * i; lfv[i] = lfp[k * 64 + lane]; liv[i] = lip[k * 64 + lane]; }
#pragma unroll
        for (int i = 0; i < CPW; ++i) { const int k = wave + 8 * i;
            const float bl = wave_incl_scan(lfv[i], lane); BL[k * 64 + lane] = bl;
            const float btot = __shfl(bl, 63); const float a = wave_max(btot - bl + liv[i]);
            if (lane == 0) { BT[k] = btot; AK[k] = a; scr[k] = btot; scr[NCH + k] = a; } }
        __syncthreads();
        if (wave == 0) { float* DEC = WSP(float, WS_DEC) + bh * NCH; constexpr int PL = NCH / 64;
            float f[PL], av[PL]; float run = 0.f;
#pragma unroll
            for (int i = 0; i < PL; ++i) { run += scr[lane * PL + i]; f[i] = run; av[i] = scr[NCH + lane * PL + i]; }
            const float offs = wave_incl_scan(run, lane) - run;
            float pm = -INFINITY; float c[PL];
#pragma unroll
            for (int i = 0; i < PL; ++i) { f[i] += offs; pm = fmaxf(pm, av[i] - f[i]); c[i] = pm; }
            float pin = pm;
#pragma unroll
            for (int o = 1; o < 64; o <<= 1) { const float t = __shfl_up(pin, o); if (lane >= o) pin = fmaxf(pin, t); }
            float pex = __shfl_up(pin, 1); if (lane == 0) pex = -INFINITY;
            float mprev = __shfl_up(fmaxf(0.f, pin) + f[PL - 1], 1); if (lane == 0) mprev = 0.f;
            if (lane == 0) MS[0] = 0.f;
#pragma unroll
            for (int i = 0; i < PL; ++i) { const int k = lane * PL + i; const float mn = f[i] + fmaxf(0.f, fmaxf(pex, c[i]));
                MS[k + 1] = mn; DEC[k] = __expf(scr[k] + mprev - mn); mprev = mn; } }
        __syncthreads();
    }
}
__device__ __forceinline__ void mconv_glu_vec(const Ptrs& P, int l, long gtid, long gn) {
    const bf16* T0 = WSP(const bf16, R_T0); bf16* MQK = WSP(bf16, R_MQK);
    const float* cw = P.in[I_MCW] + l * 4 * 512; const float* cb = P.in[I_MCB] + l * 512;
    for (long it0 = gtid; it0 < (long)M * 64; it0 += 4 * gn) {
        v4u w[4][4]; bool ok[4][4];
#pragma unroll
        for (int r = 0; r < 4; ++r) { const long it = it0 + r * gn; const int ch = (int)(it & 63); const long row = it >> 6; const int t = (int)(row % SEQ), c0 = ch * 8;
#pragma unroll
            for (int j = 0; j < 4; ++j) { ok[r][j] = it < (long)M * 64 && t - 3 + j >= 0; w[r][j] = (v4u){0u, 0u, 0u, 0u}; if (ok[r][j]) w[r][j] = *(const GAS v4u*)(T0 + (size_t)(row - 3 + j) * 512 + c0); } }
#pragma unroll
        for (int r = 0; r < 4; ++r) { const long it = it0 + r * gn; if (it >= (long)M * 64) continue; const int ch = (int)(it & 63); const long row = it >> 6; const int c0 = ch * 8;
            float acc[8];
#pragma unroll
            for (int i = 0; i < 8; ++i) acc[i] = cb[c0 + i];
#pragma unroll
            for (int j = 0; j < 4; ++j) { if (ok[r][j]) { float x[8]; unpack8(w[r][j], x);
#pragma unroll
                    for (int i = 0; i < 8; ++i) acc[i] += cw[j * 512 + c0 + i] * x[i]; } }
            const float sc = (c0 >= 256) ? 0.125f : 1.f; float y[8];
#pragma unroll
            for (int i = 0; i < 8; ++i) y[i] = acc[i] * __builtin_amdgcn_rcpf(1.f + __expf(-acc[i])) * sc;
            v4u o; o.x = pk2(y[0], y[1]); o.y = pk2(y[2], y[3]); o.z = pk2(y[4], y[5]); o.w = pk2(y[6], y[7]);
            *(GAS v4u*)(MQK + (size_t)row * 512 + c0) = o; }
    }
    const bf16* T2 = WSP(const bf16, R_T0 + 2 * SZ_T); bf16* GL = WSP(bf16, R_GL);
    for (long it0 = gtid; it0 < (long)M * 32; it0 += 4 * gn) {
        v4u wa[4], wg[4];
#pragma unroll
        for (int r = 0; r < 4; ++r) { const long it = it0 + r * gn; wa[r] = (v4u){0u, 0u, 0u, 0u}; wg[r] = wa[r];
            if (it < (long)M * 32) { const int c0 = (int)(it & 31) * 8; const long row = it >> 5; wa[r] = *(const GAS v4u*)(T2 + (size_t)row * 512 + c0); wg[r] = *(const GAS v4u*)(T2 + (size_t)row * 512 + 256 + c0); } }
#pragma unroll
        for (int r = 0; r < 4; ++r) { const long it = it0 + r * gn; if (it >= (long)M * 32) continue; const int c0 = (int)(it & 31) * 8; const long row = it >> 5;
            float a[8], g[8]; unpack8(wa[r], a); unpack8(wg[r], g); float y[8];
#pragma unroll
            for (int i = 0; i < 8; ++i) y[i] = a[i] * __builtin_amdgcn_rcpf(1.f + __expf(-g[i]));
            v4u o; o.x = pk2(y[0], y[1]); o.y = pk2(y[2], y[3]); o.z = pk2(y[4], y[5]); o.w = pk2(y[6], y[7]);
            *(GAS v4u*)(GL + (size_t)row * 256 + c0) = o; }
    }
}
__device__ __forceinline__ void cconv_ln_rows(const Ptrs& P, int l, int gw, int ngw, int lane) {
    const bf16* GL = WSP(const bf16, R_GL); bf16* CAT = WSP(bf16, R_CAT);
    const float* cw = P.in[I_CCW] + l * CK * 256 + 4 * lane; const int c0 = 4 * lane;
    const f32x4 cb = *(const f32x4*)(P.in[I_CCB] + l * 256 + c0), lw = *(const f32x4*)(P.in[I_CLW] + l * 256 + c0), lb = *(const f32x4*)(P.in[I_CLB] + l * 256 + c0);
    f32x4 w[CK];
#pragma unroll
    for (int j = 0; j < CK; ++j) w[j] = *(const f32x4*)(cw + j * 256);
    for (int task = gw; task < M / 8; task += ngw) {
        const int r0 = task * 8, t0 = r0 % SEQ;
        unsigned long long x[CK + 7];
#pragma unroll
        for (int i = 0; i < CK + 7; ++i) x[i] = (t0 - (CK - 1) + i >= 0) ? *(const GAS unsigned long long*)(GL + (size_t)(r0 - (CK - 1) + i) * 256 + c0) : 0ull;
        f32x4 acc[8];
#pragma unroll
        for (int o = 0; o < 8; ++o) acc[o] = cb;
#pragma unroll
        for (int i = 0; i < CK + 7; ++i) { const unsigned long long q = x[i];
            const f32x4 xf = {__uint_as_float((unsigned)(q << 16)), __uint_as_float((unsigned)q & 0xffff0000u), __uint_as_float((unsigned)(q >> 32) << 16), __uint_as_float((unsigned)(q >> 32) & 0xffff0000u)};
#pragma unroll
            for (int o = 0; o < 8; ++o) if (i - o >= 0 && i - o < CK) acc[o] += w[i - o] * xf; }
#pragma unroll
        for (int o = 0; o < 8; ++o) {
            const float mean = wave_sum((acc[o][0] + acc[o][1]) + (acc[o][2] + acc[o][3])) * (1.f / 256.f);
            const f32x4 d = acc[o] - mean; const float rstd = 1.f / sqrtf(wave_sum((d[0] * d[0] + d[1] * d[1]) + (d[2] * d[2] + d[3] * d[3])) * (1.f / 256.f) + EPS);
            f32x4 y = d * rstd * lw + lb;
#pragma unroll
            for (int i = 0; i < 4; ++i) y[i] = y[i] * __builtin_amdgcn_rcpf(1.f + __expf(-y[i]));
            *(GAS unsigned long long*)(CAT + (size_t)(r0 + o) * 1024 + 256 + c0) = (unsigned long long)pk2(y[0], y[1]) | ((unsigned long long)pk2(y[2], y[3]) << 32); }
    }
}
__device__ __forceinline__ void fox_keynorms(const Ptrs& P, int gw, int ngw, int lane) {
    const bf16* K = WSP(const bf16, R_T0 + 4 * SZ_T); float* KN2 = WSP(float, WS_KN2); constexpr int NTT = SEQ / 64;
    for (int u = gw; u < BATCH * FH * NTT; u += ngw) { const int bh = u / NTT, tile = u % NTT, b = bh / FH, h = bh % FH;
        const bf16* kr = K + ((size_t)b * SEQ + tile * 64 + lane) * 512 + h * 64; float ss = 0.f;
#pragma unroll
        for (int c = 0; c < 8; ++c) { const v4u v = *(const GAS v4u*)(kr + 8 * c); float f[8]; unpack8(v, f);
#pragma unroll
            for (int e = 0; e < 8; ++e) ss += f[e] * f[e]; }
        ss = wave_max(ss); if (lane == 0) KN2[u] = ss; }
}
__device__ __forceinline__ void moe_gather(const Ptrs& P, int gw, int ngw, int lane, int wave, int vcu, int G, LAS unsigned char* lds) {
    LAS unsigned* base = (LAS unsigned*)lds; LAS unsigned* tot = base + 1024 * 8;
    { const unsigned* BH = WSP(const unsigned, WS_BH); const int per = (G + 63) / 64; unsigned run = 0u;
      for (int k = 0; k < per; ++k) { const int blk = lane * per + k; if (blk < G) run += BH[blk * 8 + wave]; }
      unsigned incl = run;
#pragma unroll
      for (int o = 1; o < 64; o <<= 1) { const unsigned t = __shfl_up(incl, o); if (lane >= o) incl += t; }
      unsigned ex = incl - run;
      for (int k = 0; k < per; ++k) { const int blk = lane * per + k; if (blk < G) { base[blk * 8 + wave] = ex; ex += BH[blk * 8 + wave]; } }
      if (lane == 63) tot[wave] = incl; }
    __syncthreads();
    unsigned* cntg = WSP(unsigned, WS_CTL) + CW_CNT;
    if (vcu == 0 && wave == 0 && lane < 8) cntg[lane] = tot[lane];
    unsigned cnt[8];
#pragma unroll
    for (int e = 0; e < 8; ++e) cnt[e] = tot[e];
    int off[9]; { int o = 0;
#pragma unroll
        for (int e = 0; e < 8; ++e) { off[e] = o; o += ((int)cnt[e] + 255) & ~255; }
        off[8] = o; }
    const bf16* XN = WSP(const bf16, R_XN); bf16* XNS = WSP(bf16, R_XNS);
    for (int row0 = gw; row0 < M; row0 += 4 * ngw) {
        v4u ta[4], a[4], b[4]; unsigned rv[4];
#pragma unroll
        for (int r = 0; r < 4; ++r) { const int row = row0 + r * ngw; if (row < M) { ta[r] = *(const GAS v4u*)(WSP(unsigned, WS_TOK) + (size_t)row * 8);
                const GAS v4u* srcp = (const GAS v4u*)(XN + (size_t)row * D) + lane; a[r] = __builtin_nontemporal_load(srcp); b[r] = __builtin_nontemporal_load(srcp + 64); rv[r] = WSP(const unsigned, WS_RSS)[(size_t)4 * M + row]; } }
#pragma unroll
        for (int r = 0; r < 4; ++r) { const int row = row0 + r * ngw; if (row < M) {
                unsigned* tk = WSP(unsigned, WS_TOK) + (size_t)row * 8;
                const int e1 = (int)ta[r][0], p1 = (int)ta[r][1], e2 = (int)ta[r][2], p2 = (int)ta[r][3];
                int o1 = 0, o2 = 0;
#pragma unroll
                for (int e = 0; e < 8; ++e) { if (e == e1) o1 = off[e]; if (e == e2) o2 = off[e]; }
                const int blk = (row >> 4) % G;
                const int s1 = o1 + (int)base[blk * 8 + e1] + p1, s2 = o2 + (int)base[blk * 8 + e2] + p2;
                if (lane == 0) { tk[6] = (unsigned)s1; tk[7] = (unsigned)s2; WSP(unsigned, WS_RSTDS)[s1] = rv[r]; WSP(unsigned, WS_RSTDS)[s2] = rv[r];
                    const float g1 = __uint_as_float(tk[4]), g2 = __uint_as_float(tk[5]); WSP(float, WS_SLOTG)[s1] = g1; WSP(float, WS_SLOTG)[s2] = -g2; }
                GAS v4u* d1 = (GAS v4u*)(XNS + (size_t)s1 * D) + lane; GAS v4u* d2 = (GAS v4u*)(XNS + (size_t)s2 * D) + lane;
                d1[0] = a[r]; d1[64] = b[r]; d2[0] = a[r]; d2[64] = b[r]; } }
    }
    for (int w = gw; w < 8 * 256; w += ngw) {
        const int e = w >> 8, r = w & 255; int oe = 0, oe1 = 0, ce = 0;
#pragma unroll
        for (int j = 0; j < 8; ++j) if (j == e) { oe = off[j]; oe1 = off[j + 1]; ce = (int)cnt[j]; }
        const int slot = oe + ce + r;
        if (slot < oe1) { GAS v4u* dp = (GAS v4u*)(XNS + (size_t)slot * D) + lane; const v4u z = {0u, 0u, 0u, 0u}; dp[0] = z; dp[64] = z; if (lane == 0) { unsigned zlo = 0u; asm volatile("" : "+v"(zlo)); WSP(unsigned, WS_RSTDS)[slot] = zlo; WSP(float, WS_SLOTG)[slot] = __uint_as_float(zlo); } }
    }
}
__device__ __forceinline__ void moe_combine_final(const Ptrs& P, int gw, int ngw, int lane) {
    const bf16* Y = WSP(const bf16, R_XNS); const float* nw = P.in[I_NFIN];
    for (int row0 = gw; row0 < M; row0 += 4 * ngw) {
        int s1[4], s2[4];
#pragma unroll
        for (int r = 0; r < 4; ++r) { const int row = row0 + r * ngw; const unsigned* tk = WSP(const unsigned, WS_TOK) + (size_t)(row < M ? row : 0) * 8; s1[r] = (int)tk[6]; s2[r] = (int)tk[7]; }
        unsigned long long ya[4][4], yb[4][4];
#pragma unroll
        for (int r = 0; r < 4; ++r) { const GAS unsigned long long* y1 = (const GAS unsigned long long*)(Y + (size_t)s1[r] * D) + lane; const GAS unsigned long long* y2 = (const GAS unsigned long long*)(Y + (size_t)s2[r] * D) + lane;
#pragma unroll
            for (int j = 0; j < 4; ++j) { ya[r][j] = __builtin_nontemporal_load(y1 + 64 * j); yb[r][j] = __builtin_nontemporal_load(y2 + 64 * j); } }
#pragma unroll
        for (int r = 0; r < 4; ++r) { const int row = row0 + r * ngw; if (row < M) {
            GAS f32x4* orow = (GAS f32x4*)(P.xres + (size_t)row * D) + lane;
            f32x4 v[4]; float ssq = 0.f;
#pragma unroll
            for (int j = 0; j < 4; ++j) { const unsigned long long a = ya[r][j], b = yb[r][j];
                v[j].x = bf2f((bf16)(a & 0xffff)) + bf2f((bf16)(b & 0xffff));
                v[j].y = bf2f((bf16)((a >> 16) & 0xffff)) + bf2f((bf16)((b >> 16) & 0xffff));
                v[j].z = bf2f((bf16)((a >> 32) & 0xffff)) + bf2f((bf16)((b >> 32) & 0xffff));
                v[j].w = bf2f((bf16)((a >> 48) & 0xffff)) + bf2f((bf16)((b >> 48) & 0xffff));
                ssq += (v[j].x * v[j].x + v[j].y * v[j].y) + (v[j].z * v[j].z + v[j].w * v[j].w); }
            const float rstd = 1.f / sqrtf(wave_sum(ssq) * (1.f / D) + EPS);
#pragma unroll
            for (int j = 0; j < 4; ++j) { const f32x4 w = *((const f32x4*)nw + lane + 64 * j); __builtin_nontemporal_store(v[j] * rstd * w, orow + 64 * j); } } }
    }
}

#ifndef MK_PER_PHASE
#define MK_PER_PHASE 0
#endif
constexpr int PH_PER_LAYER = 14, N_PHASES = 1 + 2 * PH_PER_LAYER + 1;
__device__ __forceinline__ Ptrs launder(const Ptrs& a) { Ptrs p = a; asm volatile("" : "+s"(p.ws), "+s"(p.xres)); return p; }
struct Args { const float* in[N_IN]; float* xres; unsigned char* ws; int ph_lo, ph_hi; };

__global__ void __launch_bounds__(NWAVES * 64, 2) trunk_fwd(Args args) {
    extern __shared__ __attribute__((aligned(16))) unsigned char lds_raw[];
    LAS unsigned char* lds = (LAS unsigned char*)lds_raw;
    Ptrs P0; P0.in = (const float* const LAS*)(lds + PTR_OFF); P0.xres = args.xres; P0.ws = args.ws;
    const int tid = threadIdx.x, wave0 = __builtin_amdgcn_readfirstlane(tid >> 6);
    const int G0 = gridDim.x; const int bx0 = blockIdx.x; const int vcu0 = (G0 % 8 == 0) ? (bx0 % 8) * (G0 / 8) + bx0 / 8 : bx0;
    volatile LAS unsigned* MISC = (volatile LAS unsigned*)(lds + MISC_OFF);
    if (tid < 64) MISC[tid] = 0u;
    if (tid < N_IN) ((const float* LAS*)(lds + PTR_OFF))[tid] = args.in[tid];
    __syncthreads();
    unsigned* ctl = (unsigned*)(P0.ws + WS_CTL);
    XcdBarrier bar; bar.bar = ctl + CW_BAR; bar.x = 0; bar.st = nullptr;
    if (!MK_PER_PHASE) bar = xcd_barrier_post(ctl + CW_BAR, MISC + 8);
    const int lo = args.ph_lo, hi = args.ph_hi; int ph = 0;
#ifndef SITEMASK
#define SITEMASK 0xffffffffull
#endif
#define SITE(k) ((SITEMASK >> (k)) & 1ull)
#define PH_ON() (ph >= lo && ph < hi)
#define PH_IF(k) if (PH_ON() && SITE(k))
#define PH_CTX() Ptrs P = launder(P0); int tidp = threadIdx.x; asm volatile("" : "+v"(tidp)); int G = G0, bx = bx0, vcu = vcu0, wave = wave0; asm volatile("" : "+s"(G), "+s"(bx), "+s"(vcu), "+s"(wave)); const int gw = vcu * NWAVES + wave, ngw = G * NWAVES; const long gn = (long)G * (NWAVES * 64); const int lane = tidp & 63; const long gtid = (long)bx * (NWAVES * 64) + tidp; (void)lane; (void)gw; (void)gtid; (void)ngw; (void)gn
#define PH_END() do { if (PH_ON() && ph + 1 < hi) { if (!MK_PER_PHASE) { XcdBarrier b2_ = bar; asm volatile("" : "+s"(b2_.bar), "+s"(b2_.x)); xcd_barrier(b2_); } } ++ph; } while (0)

    PH_IF(0) { PH_CTX();
        LAS WJob* jobs = (LAS WJob*)(lds + JOB_OFF);
        if (tid == 0) {
            int nj = 0, item = 0;
#define ADDJOB(W0_, W1_, rs_, dst_, K_, Nsrc_, Ndst_, kind_, cs_) do { LAS WJob* j_ = jobs + nj; j_->W0 = (W0_); j_->W1 = (W1_); j_->rs = (rs_); j_->WT = WSP(bf16, (dst_)); j_->K = (K_); j_->Nsrc = (Nsrc_); \
                j_->nblk = (Ndst_) / 32; j_->kind = (kind_); j_->cs = (cs_); j_->item0 = item; item += ((K_) / 64) * ((Ndst_) / 32); ++nj; } while (0)
            for (int l = 0; l < 2; ++l) {
                const size_t wl = R_WL + (size_t)l * WL_SIZE;
                ADDJOB(P.in[I_WIN] + (size_t)l * D * INW, nullptr, P.in[I_NMIX] + l * D, wl + WL_IN, D, INW, NZ, 1, 1.f);
                ADDJOB(P.in[I_WOUT] + (size_t)l * D * D, nullptr, nullptr, wl + WL_OUT, D, D, D, 0, 1.f);
                ADDJOB(P.in[I_WQ] + (size_t)l * D * 512, nullptr, P.in[I_NXA] + l * D, wl + WL_Q, D, 512, 512, 0, XAT_QS);
                ADDJOB(P.in[I_WKV] + (size_t)l * D * 1024, nullptr, P.in[I_NMEM] + l * D, wl + WL_KV, D, 1024, 1024, 0, 1.f);
                ADDJOB(P.in[I_WO] + (size_t)l * 512 * D, nullptr, nullptr, wl + WL_O, 512, D, D, 0, 1.f);
            }
            ADDJOB(P.in[I_FG], P.in[I_FU], P.in[I_NFFN], R_WGU, D, DFF, 2 * DFF, 2, 1.f);
            ADDJOB(P.in[I_FD], nullptr, nullptr, R_WDN, DFF, D, D, 0, 1.f);
            for (int e = 0; e < NE; ++e) {
                ADDJOB(P.in[I_MG] + (size_t)e * D * DFF, P.in[I_MU] + (size_t)e * D * DFF, P.in[I_NFFN] + D, WS_WMGU + (size_t)e * 2 * DFF * D * 2, D, DFF, 2 * DFF, 2, 1.f);
                ADDJOB(P.in[I_MD] + (size_t)e * DFF * D, nullptr, nullptr, WS_WMD + (size_t)e * D * DFF * 2, DFF, D, D, 0, 1.f);
            }
#undef ADDJOB
            MISC[16] = (unsigned)nj; MISC[17] = (unsigned)item;
        }
        __syncthreads();
        const int nj = (int)MISC[16], nitems = (int)MISC[17];
        LAS float* scr = (LAS float*)(lds + wave * 16384);
        for (int it = gw; it < nitems; it += ngw) {
            int j = 0;
            for (int q = 1; q < nj; ++q) if (jobs[q].item0 <= it) j = q;
            p0_transpose_item(jobs + j, scr, it - jobs[j].item0, lane);
        }
        norm_rows<0>(P, 0, P.in[I_MEM], WSP(bf16, WS_MEMN), BATCH * NMEM, gw, ngw, lane);
        build_gw(P, gtid, gn);
    }
    PH_END();

    for (int l = 0; l < 2; ++l) {
        const size_t wl = R_WL + (size_t)l * WL_SIZE;
        PH_IF(1) { PH_CTX(); if (l == 0) norm16<1, false>(P, l, P.in[I_X], WSP(bf16, R_XN), nullptr, vcu, G, wave, lane, (LAS float*)lds);
            else norm16<1, true>(P, l, nullptr, WSP(bf16, R_XN), WSP(const unsigned, WS_RSS) + (size_t)2 * M, vcu, G, wave, lane, (LAS float*)lds); }
        PH_END();
        PH_IF(2) { PH_CTX();
            for (int task = bx; task < 24; task += G) gate_scan_task(P, task, (LAS float*)lds, tidp);
            { pg8::Gemm g{WSP(const bf16, R_XN), WSP(const bf16, wl + WL_IN), M, NZ, D}; pg8::StaticOrder S; S.init(M, NZ, G, bx);
              pg8::EpiBf16 E{WSP(bf16, R_T0), 512, 512, (size_t)M * 512, (l == 0) ? WSP(const unsigned, WS_RSTD) : WSP(const unsigned, WS_RSS) + (size_t)2 * M};
              pg8::gemm_phase<pg8::EpiBf16, pg8::StaticOrder, true, true>(lds, g, S, E); }
        }
        PH_END();
        PH_IF(3) { PH_CTX(); mconv_glu_vec(P, l, gtid, gn); fox_keynorms(P, gw, ngw, lane); }
        PH_END();
        PH_IF(4) { PH_CTX(); for (int u = wave * G + vcu; u < 8 * NCH; u += ngw) mls::u_unit(P, u, lds + wave * 16384, lane);
            for (int u = (7 - wave) * G + vcu; u < BATCH * FH * fox::NQB; u += ngw) { const int qb = fox::NQB - 1 - u / (BATCH * FH), bh = u % (BATCH * FH);
                const int j0 = fox::unit_j0_wave(bh, qb, (const fox::bf16h*)WSP(bf16, R_T0 + 3 * SZ_T), WSP(const float, WS_KN2), WSP(const float, WS_CF) + (size_t)bh * SEQ, lane); if (lane == 0) WSP(int, WS_J0)[u] = j0; }
            cconv_ln_rows(P, l, gw, ngw, lane); }
        PH_END();
        PH_IF(5) { PH_CTX(); mls::state_scan(P, gtid, gn); }
        PH_END();
        PH_IF(7) { PH_CTX();
            { pg8::Gemm g{WSP(const bf16, WS_MEMN), WSP(const bf16, wl + WL_KV), BATCH * NMEM, 512, D}; pg8::StaticOrder S; S.init(BATCH * NMEM, 512, G, bx);
              pg8::EpiBf16 E{WSP(bf16, WS_KVX) + (size_t)l * 512 * 1024, 512, 0, 0, nullptr};
              pg8::gemm_phase<pg8::EpiBf16, pg8::StaticOrder, true, true>(lds, g, S, E); }
            { pg8::Gemm g{WSP(const bf16, wl + WL_KV) + (size_t)512 * 1024, WSP(const bf16, WS_MEMN), 512, BATCH * NMEM, D}; pg8::StaticOrder S; S.init(512, BATCH * NMEM, G, (bx + G - 4) % G);
              pg8::EpiBf16 E{WSP(bf16, WS_KVX) + (size_t)l * 512 * 1024 + 512 * 512, 512, 0, 0, nullptr};
              pg8::gemm_phase<pg8::EpiBf16, pg8::StaticOrder, true, true>(lds, g, S, E); }
            { static_assert(fox::LDS_BYTES <= RING_BYTES, "fox LDS");
              const fox::bf16h* Q = (const fox::bf16h*)WSP(bf16, R_T0 + 3 * SZ_T); const fox::bf16h* Kp = (const fox::bf16h*)WSP(bf16, R_T0 + 4 * SZ_T); const fox::bf16h* Vp = (const fox::bf16h*)WSP(bf16, R_T0 + 5 * SZ_T);
              fox::bf16h* O = (fox::bf16h*)(WSP(bf16, R_CAT) + 512); const float* CF = WSP(const float, WS_CF);
              for (int it = vcu; it < 8 * NCH / 8; it += G) mls::out_unit(P, l, it * 8 + wave, lds + wave * 16384, lane);
              __syncthreads();
              const int nitems = BATCH * FH * fox::NQB; unsigned* qhead = ctl + CW_FOXQ + 64 * l;
              for (;;) {
                  if (tidp == 0) MISC[24] = __hip_atomic_fetch_add(qhead, 1u, RLX_AGENT);
                  __syncthreads();
                  const int u = (int)MISC[24];
                  __syncthreads();
                  if (u >= nitems) break;
                  const int qb = fox::NQB - 1 - u / (BATCH * FH), bh = u % (BATCH * FH);
                  const int j0 = WSP(const int, WS_J0)[u];
                  fox::attn_unit<8>(bh / FH, bh % FH, qb, j0, Q, Kp, Vp, O, CF + (size_t)bh * SEQ, (char*)lds_raw); } }

 }
        PH_END();
        PH_IF(8) { PH_CTX(); pg8::Gemm g{WSP(const bf16, R_CAT), WSP(const bf16, wl + WL_OUT), M, D, D}; pg8::StaticOrder S; S.init(M, D, G, bx);
            pg8::EpiRes E{WSP(bf16, R_XN), D, WSP(unsigned, WS_RSS) + (size_t)(l ? 3 : 0) * M};
            pg8::gemm_phase<pg8::EpiRes, pg8::StaticOrder, true, true>(lds, g, S, E); }
        PH_END();
        PH_IF(10) { PH_CTX(); pg8::Gemm g{WSP(const bf16, R_XN), WSP(const bf16, wl + WL_Q), M, 512, D}; pg8::StaticOrder S; S.init(M, 512, G, bx);
            pg8::EpiBf16 E{WSP(bf16, R_QX), 512, 0, 0, WSP(const unsigned, WS_RSS) + (size_t)(l ? 3 : 0) * M};
            pg8::gemm_phase<pg8::EpiBf16, pg8::StaticOrder, true, true>(lds, g, S, E); }
        PH_END();
        PH_IF(11) { PH_CTX(); static_assert(xat::LDS_BYTES <= RING_BYTES, "xat LDS");
            const bf16* KXp = WSP(const bf16, WS_KVX) + (size_t)l * 512 * 1024;
            for (int L = vcu; L < BATCH * XH * (SEQ / 256); L += G) { const int qb = L % (SEQ / 256), bhd = L / (SEQ / 256);
                xat::unit(bhd / XH, bhd % XH, qb, WSP(const bf16, R_QX), KXp, KXp + 512 * 512, WSP(bf16, R_OX), lds); } }
        PH_END();
        PH_IF(12) { PH_CTX(); pg8::Gemm g{WSP(const bf16, R_OX), WSP(const bf16, wl + WL_O), M, D, 512}; pg8::StaticOrder S; S.init(M, D, G, bx);
            pg8::EpiRes E{WSP(bf16, R_XN), D, WSP(unsigned, WS_RSS) + (size_t)(l ? 4 : 1) * M};
            pg8::gemm_phase<pg8::EpiRes, pg8::StaticOrder, true, true>(lds, g, S, E); }
        PH_END();
        if (l == 0) {
            PH_IF(14) { PH_CTX(); pg8::Gemm g{WSP(const bf16, R_XN), WSP(const bf16, R_WGU), M, 2 * DFF, D}; pg8::StaticOrder S; S.init(M, 2 * DFF, G, bx);
                pg8::EpiSwiGLU E{WSP(bf16, R_HD), DFF, WSP(const unsigned, WS_RSS) + (size_t)1 * M};
                pg8::gemm_phase<pg8::EpiSwiGLU, pg8::StaticOrder, true, true>(lds, g, S, E); }
            PH_END();
            PH_IF(15) { PH_CTX(); pg8::Gemm g{WSP(const bf16, R_HD), WSP(const bf16, R_WDN), M, D, DFF}; pg8::StaticOrder S; S.init(M, D, G, bx);
                pg8::EpiRes E{WSP(bf16, R_XN), D, WSP(unsigned, WS_RSS) + (size_t)2 * M};
                pg8::gemm_phase<pg8::EpiRes, pg8::StaticOrder, true, true>(lds, g, S, E); }
            PH_END();
            ph += 2;
        } else {
            PH_IF(16) { PH_CTX(); norm16<2, true>(P, l, nullptr, WSP(bf16, R_XN), WSP(const unsigned, WS_RSS) + (size_t)4 * M, vcu, G, wave, lane, (LAS float*)lds); }
            PH_END();
            PH_IF(17) { PH_CTX(); moe_gather(P, gw, ngw, lane, wave, vcu, G, lds); }
            PH_END();
            PH_IF(18) { PH_CTX(); pg8::Gemm g{WSP(const bf16, R_XNS), WSP(const bf16, WS_WMGU), 0, 2 * DFF, D}; pg8::GroupedOrder S; S.init(2 * DFF, G, bx, ctl + CW_CNT, (size_t)2 * DFF * D * 2);
                pg8::EpiSwiGLU E{WSP(bf16, R_HM), DFF, WSP(const unsigned, WS_RSTDS)};
                pg8::gemm_phase<pg8::EpiSwiGLU, pg8::GroupedOrder, true, true>(lds, g, S, E); }
            PH_END();
            PH_IF(19) { PH_CTX(); pg8::Gemm g{WSP(const bf16, R_HM), WSP(const bf16, WS_WMD), 0, D, DFF}; pg8::GroupedOrder S; S.init(D, G, bx, ctl + CW_CNT, (size_t)D * DFF * 2);
                pg8::EpiMoeOut E{WSP(bf16, R_XNS), D, WSP(const float, WS_SLOTG)};
                pg8::gemm_phase<pg8::EpiMoeOut, pg8::GroupedOrder, true, true>(lds, g, S, E); }
            PH_END();
        }
    }
    PH_IF(20) { PH_CTX(); moe_combine_final(P, gw, ngw, lane); }
#undef PH_ON
#undef PH_END
}

extern "C" void kernel_launch(void* const* d_in, const int* in_sizes, int n_in, void* d_out, int out_size, void* d_ws, size_t ws_size, hipStream_t stream) {
    static int grid = 0;
    if (grid == 0) {
        if (n_in != N_IN || out_size != M * D || ws_size < WS_END) { fprintf(stderr, "kernel_launch: unexpected shapes (n_in %d, out %d, ws %zu < %zu); nothing launched\n", n_in, out_size, ws_size, (size_t)WS_END); grid = -1; return; }
        int dev = 0, cus = 0, per_cu = 0;
        if (hipGetDevice(&dev) != hipSuccess || hipDeviceGetAttribute(&cus, hipDeviceAttributeMultiprocessorCount, dev) != hipSuccess) { grid = -1; return; }
        if (hipFuncSetAttribute((const void*)trunk_fwd, hipFuncAttributeMaxDynamicSharedMemorySize, LDS_BYTES) != hipSuccess) { fprintf(stderr, "kernel_launch: hipFuncSetAttribute failed\n"); grid = -1; return; }
        if (hipOccupancyMaxActiveBlocksPerMultiprocessor(&per_cu, (const void*)trunk_fwd, NWAVES * 64, LDS_BYTES) != hipSuccess || per_cu < 1) { fprintf(stderr, "kernel_launch: occupancy query says %d\n", per_cu); (void)hipGetLastError(); grid = -1; return; }
        grid = cus;
    }
    if (grid < 0) return;
    (void)in_sizes;
    if (hipMemsetAsync((char*)d_ws + WS_CTL, 0, CTL_ZERO_BYTES, stream) != hipSuccess) return;
    Args a; memset(&a, 0, sizeof(a));
    for (int i = 0; i < N_IN; ++i) a.in[i] = (const float*)d_in[i];
    a.xres = (float*)d_out; a.ws = (unsigned char*)d_ws;
#if MK_PER_PHASE
    for (int p = 0; p < N_PHASES; ++p) { a.ph_lo = p; a.ph_hi = p + 1; hipLaunchKernelGGL(trunk_fwd, dim3(grid), dim3(NWAVES * 64), LDS_BYTES, stream, a); }
#else
    a.ph_lo = 0; a.ph_hi = N_PHASES;
    hipLaunchKernelGGL(trunk_fwd, dim3(grid), dim3(NWAVES * 64), LDS_BYTES, stream, a);
#endif
}
#endif
```

```cpp
#if defined(HOST_EMU)
#include <cmath>
#include <cstring>
#include <cstdint>
#include <cstddef>
#define DEVFN static inline
#define PHFN static inline
#else
#include <hip/hip_runtime.h>
#include <cstdio>
#include <cstdint>
#include <cstring>
#define DEVFN __device__ __forceinline__
#define PHFN __device__ __forceinline__
#endif

#ifndef CFG_SEQ
#define CFG_SEQ 8192
#endif
constexpr int BATCH = 2, SEQ = CFG_SEQ, D = 1024, M = BATCH * SEQ;
constexpr int MH = 4, MCH = 64, NCH = SEQ / MCH;
constexpr int CK = 31;
constexpr int FH = 8;
constexpr int XH = 4, XD = 128, NMEM = 256;
constexpr int DFF = 2816, NE = 8, INW = 3088;
constexpr int NZ = 3072;
constexpr int SLOTS_MAX = 2 * M + NE * 256;
constexpr float EPS = 1e-6f;
constexpr float LOG2E = 1.4426950408889634f;
constexpr float FOX_QS = 0.125f * LOG2E;
constexpr float XAT_QS = 0.08838834764831845f * LOG2E;

enum { I_X = 0, I_MEM, I_NMIX, I_WIN, I_MCW, I_MCB, I_MBI, I_MBF, I_MNW, I_CCW, I_CCB, I_CLW, I_CLB, I_FBF, I_WOUT, I_NXA, I_NMEM, I_WQ, I_WKV, I_WO, I_NFFN,
       I_FG, I_FU, I_FD, I_RW, I_MG, I_MU, I_MD, I_NFIN, N_IN };

typedef unsigned short bf16;
constexpr size_t al4k(size_t x) { return (x + 4095) & ~(size_t)4095; }
constexpr size_t MiB = (size_t)1 << 20;
constexpr size_t WS_CTL = 0, CTL_ZERO_BYTES = 1 * MiB;
constexpr size_t WS_GATE = 1 * MiB;
constexpr size_t WS_CF = WS_GATE + al4k((size_t)M * 16 * 4);
constexpr size_t WS_BL = WS_CF + al4k((size_t)16 * SEQ * 4);
constexpr size_t WS_BT = WS_BL + al4k((size_t)8 * SEQ * 4);
constexpr size_t WS_AK = WS_BT + al4k((size_t)8 * NCH * 4);
constexpr size_t WS_MS = WS_AK + al4k((size_t)8 * NCH * 4);
constexpr size_t WS_DEC = WS_MS + al4k((size_t)8 * (NCH + 1) * 4);
constexpr size_t WS_KN2 = WS_DEC + al4k((size_t)8 * NCH * 4);
constexpr size_t WS_J0 = WS_KN2 + al4k((size_t)16 * (SEQ / 64) * 4);
constexpr size_t WS_BH = WS_J0 + al4k((size_t)16 * (SEQ / 256) * 4);
constexpr size_t WS_NST = WS_BH + al4k((size_t)1024 * 8 * 4);
constexpr size_t WS_TOK = WS_NST + al4k((size_t)8 * NCH * 64 * 4);
constexpr size_t WS_RSTD = WS_TOK + al4k((size_t)M * 32);
constexpr size_t WS_RSTDS = WS_RSTD + al4k((size_t)M * 8);
constexpr size_t WS_SLOTG = WS_RSTDS + al4k((size_t)SLOTS_MAX * 8);
constexpr size_t WS_GW = WS_SLOTG + al4k((size_t)SLOTS_MAX * 4);
constexpr size_t WS_MEMN = WS_GW + 3 * 65536;
constexpr size_t WS_KVX = WS_MEMN + al4k((size_t)512 * 1024 * 2);
constexpr size_t WS_WMGU = WS_KVX + al4k((size_t)2 * 512 * 1024 * 2);
constexpr size_t WS_WMD = WS_WMGU + (size_t)NE * 5632 * 1024 * 2;
constexpr size_t WS_R = al4k(WS_WMD + (size_t)NE * 1024 * 2816 * 2);
constexpr size_t WL_IN = 0, WL_OUT = WL_IN + (size_t)NZ * 1024 * 2, WL_Q = WL_OUT + (size_t)1024 * 1024 * 2, WL_KV = WL_Q + (size_t)512 * 1024 * 2,
                 WL_O = WL_KV + (size_t)1024 * 1024 * 2, WL_SIZE = WL_O + (size_t)1024 * 512 * 2;
constexpr size_t R_WL = WS_R;
constexpr size_t R_WGU = R_WL + 2 * WL_SIZE;
constexpr size_t R_WDN = R_WGU + (size_t)5632 * 1024 * 2;
constexpr size_t R_XN = al4k(R_WDN + (size_t)1024 * 2816 * 2);
constexpr size_t SZ_T = (size_t)M * 512 * 2;
constexpr size_t R_T0 = R_XN + 2 * SZ_T;
constexpr size_t R_MQK = R_T0 + 6 * SZ_T;
constexpr size_t R_CAT = R_MQK + SZ_T;
constexpr size_t R_CST = R_CAT + 2 * SZ_T;
constexpr size_t R_GL = R_CST + (size_t)8 * NCH * 4096 * 4;
constexpr size_t R_HC = R_GL + (size_t)M * 256 * 2;
constexpr size_t R_END1 = R_HC + (size_t)M * 256 * 4;
constexpr size_t R_QX = R_T0, R_OX = R_T0 + SZ_T;
constexpr size_t R_HD = R_T0;
constexpr size_t R_HM = WS_R;
constexpr size_t R_XNS = R_HM + (size_t)SLOTS_MAX * 2816 * 2;
constexpr size_t R_END2 = R_XNS + (size_t)SLOTS_MAX * 1024 * 2;
constexpr size_t WS_END = R_END1 > R_END2 ? R_END1 : R_END2;
static_assert((size_t)M * 2816 * 2 <= 6 * SZ_T, "dense hidden fits T0..T5");
static_assert(R_XN + 2 * SZ_T <= R_XNS, "XN must not overlap the gathered rows");
constexpr int CW_TMO = 0, CW_CNT = 64  , CW_TAIL = 512  , CW_FOXQ = 128  , CW_BAR = 4096;
constexpr size_t WS_RSS = 65536;
static_assert(WS_RSS + (size_t)5 * M * 4 <= CTL_ZERO_BYTES, "RSS arrays inside the zeroed region");

#if defined(HOST_EMU)
struct Ptrs { const float* in[N_IN]; float* xres; unsigned char* ws; };
#else
struct Ptrs { const float* const __attribute__((address_space(3)))* in; float* xres; unsigned char* ws; };
#endif
#define WSP(type, off) ((type*)(P.ws + (off)))

DEVFN float bf2f(bf16 v) { unsigned u = (unsigned)v << 16; float f; memcpy(&f, &u, 4); return f; }
DEVFN bf16 f2bf(float f) { unsigned u; memcpy(&u, &f, 4); return (bf16)((u + 0x7fffu + ((u >> 16) & 1u)) >> 16); }
DEVFN float sigmoidf_(float x) { return 1.f / (1.f + expf(-x)); }
#if defined(HOST_EMU)
DEVFN float logsigmoidf_(float x) { return fminf(x, 0.f) - log1pf(expf(-fabsf(x))); }
#else
DEVFN float logsigmoidf_(float x) { return fminf(x, 0.f) - __logf(1.f + __expf(-fabsf(x))); }
#endif

DEVFN void wmap(int kind, int nb, int& which, int& col0, float& cs) {
    which = 0; cs = 1.f; const int n0 = nb * 32;
    if (kind == 0) { col0 = n0; }
    else if (kind == 1) { col0 = n0 < 1024 ? n0 : n0 + 8; if (n0 >= 1536 && n0 < 2048) cs = FOX_QS; }
    else { const int tile = nb >> 3, w = nb & 7; which = w >> 2; col0 = tile * 128 + (w & 3) * 32; }
}

#if !defined(HOST_EMU)
namespace pg8 {
#define PG8_LAS __attribute__((address_space(3)))
typedef unsigned short bf16_t;
typedef short bf16x8 __attribute__((ext_vector_type(8)));
typedef float f32x4 __attribute__((ext_vector_type(4)));
typedef unsigned u32x4 __attribute__((ext_vector_type(4)));
constexpr int BM = 256, BK = 64, HALF = 128, HTB = HALF * BK * 2, STAGE_BYTES = 8 * HTB, NXCD = 8, WGM = 4;
__host__ __device__ __forceinline__ int lds_byte(int r, int c) { const int st = (r >> 4) * 2 + (c >> 5), rr = r & 15, cc = c & 31, ob = rr * 64 + cc * 2; return st * 1024 + (ob ^ (((ob >> 9) & 1) << 5)); }
__host__ __device__ __forceinline__ void stage_rc(int b, int& R, int& C) { const int st = b / 1024, sb = b % 1024, swz = sb ^ (((sb >> 9) & 1) << 5); R = (st >> 1) * 16 + swz / 64; C = (st & 1) * 32 + (swz % 64) / 2; }
__host__ __device__ __forceinline__ int perm32(int rho) { const int n = rho >> 4, i = rho & 15; return 8 * (i >> 2) + 4 * n + (i & 3); }

struct Unit { int pm, pn; size_t bofs; int nt, ks, ti, s; size_t aofs; };
struct Gemm { const bf16_t* A; const bf16_t* Bt; int M, N, K; };

struct StaticOrder {
    static constexpr bool VAR_K = false;
    int nM, nN, nwg, G, c;
    __device__ void init(int M_, int N_, int G_, int c_) { nM = M_ / BM; nN = N_ / BM; nwg = nM * nN; G = G_; c = c_; }
    __device__ bool next(int i, Unit& u) const {
        const long L = (long)i * G + c; if (L >= nwg) return false;
        int wgid = (int)L; { const int q = nwg / NXCD, r = nwg % NXCD, xcd = wgid % NXCD, off = wgid / NXCD; wgid = (xcd < r ? xcd * (q + 1) : r * (q + 1) + (xcd - r) * q) + off; }
        const int nig = WGM * nN, gid = wgid / nig, fm = gid * WGM, gsz = (nM - fm) < WGM ? (nM - fm) : WGM;
        u.pm = fm + ((wgid % nig) % gsz); u.pn = (wgid % nig) / gsz; u.bofs = 0; return true;
    }
    __device__ __forceinline__ void a_ready(const Unit&) const {}
    __device__ __forceinline__ void done(const Unit&) const {}
};
struct GroupedOrder {
    static constexpr bool VAR_K = false;
    int nM, nN, nwg, G, c; int off[9]; size_t estride;
    __device__ void init(int N_, int G_, int c_, const unsigned* cnt, size_t estride_) {
        int o = 0;
#pragma unroll
        for (int e = 0; e < 8; ++e) { off[e] = o; o += ((int)cnt[e] + 255) & ~255; }
        off[8] = o; nM = o / BM; nN = N_ / BM; nwg = nM * nN; G = G_; c = c_; estride = estride_;
    }
    __device__ bool next(int i, Unit& u) const {
        const long L = (long)i * G + c; if (L >= nwg) return false;
        int wgid = (int)L; { const int q = nwg / NXCD, r = nwg % NXCD, xcd = wgid % NXCD, o2 = wgid / NXCD; wgid = (xcd < r ? xcd * (q + 1) : r * (q + 1) + (xcd - r) * q) + o2; }
        const int nig = WGM * nN, gid = wgid / nig, fm = gid * WGM, gsz = (nM - fm) < WGM ? (nM - fm) : WGM;
        u.pm = fm + ((wgid % nig) % gsz); u.pn = (wgid % nig) / gsz;
        int e = 0;
#pragma unroll
        for (int j = 1; j < 8; ++j) e += (off[j] <= u.pm * BM) ? 1 : 0;
        u.bofs = (size_t)e * estride; return true;
    }
    __device__ __forceinline__ void a_ready(const Unit&) const {}
    __device__ __forceinline__ void done(const Unit&) const {}
};

struct GroupedTailOrder {
    static constexpr bool VAR_K = true;
    int nM, nN, nwg, G, c, nfull, T, s, sh, ntot, NT; int off[9]; size_t estride;
    __device__ __forceinline__ void init(int N_, int G_, int c_, const unsigned* cnt, size_t estride_, int NT_) {
        int o = 0;
#pragma unroll
        for (int e = 0; e < 8; ++e) { off[e] = o; o += ((int)cnt[e] + 255) & ~255; }
        off[8] = o; nM = o / BM; nN = N_ / BM; nwg = nM * nN; G = G_; c = c_; estride = estride_; NT = NT_;
        const int rounds = nwg / G; T = nwg - rounds * G;
        s = (T == 0) ? 1 : (T * 4 <= G ? 4 : (T * 2 <= G ? 2 : 1)); sh = s >> 1;
        if (s == 1) { nfull = nwg; T = 0; } else nfull = rounds * G;
        ntot = nfull + T * s;
    }
    __device__ __forceinline__ bool next(int i, Unit& u) const {
        const long L = (long)i * G + c; if (L >= ntot) return false;
        int wgid = (int)L, ks = 0, ti = -1;
        if (wgid >= nfull) { const int mu = wgid - nfull; ti = mu >> sh; ks = mu - (ti << sh); wgid = nfull + ti; }
        { const int q = nwg / NXCD, r = nwg % NXCD, xcd = wgid % NXCD, o2 = wgid / NXCD; wgid = (xcd < r ? xcd * (q + 1) : r * (q + 1) + (xcd - r) * q) + o2; }
        const int nig = WGM * nN, gid = wgid / nig, fm = gid * WGM, gsz = (nM - fm) < WGM ? (nM - fm) : WGM;
        u.pm = fm + ((wgid % nig) % gsz); u.pn = (wgid % nig) / gsz;
        int e = 0;
#pragma unroll
        for (int j = 1; j < 8; ++j) e += (off[j] <= u.pm * BM) ? 1 : 0;
        int kt0 = 0, ntu = NT;
        if (ti >= 0) { const int base = (NT >> sh) & ~1, ex = (NT - (base << sh)) >> 1;
            ntu = base + (ks < ex ? 2 : 0); kt0 = ks * base + 2 * (ks < ex ? ks : ex); }
        u.aofs = (size_t)kt0 * BK * 2; u.bofs = (size_t)e * estride + u.aofs; u.nt = ntu; u.ks = ks; u.ti = ti; u.s = s; return true;
    }
    __device__ __forceinline__ void a_ready(const Unit&) const {}
    __device__ __forceinline__ void done(const Unit&) const {}
};

__device__ __forceinline__ unsigned cvt_pk_bf16(float lo, float hi) { unsigned r; asm volatile("v_cvt_pk_bf16_f32 %0, %1, %2" : "=v"(r) : "v"(lo), "v"(hi)); return r; }

struct EpiBf16 {
    static constexpr bool PERM = true, AFTER_DRAIN = false, HAS_PRE = true;
    __device__ __forceinline__ void preload(unsigned (&q)[8], const Unit& u, int wr, int fr) const {
        if (rs) { const __attribute__((address_space(1))) unsigned* rp = (const __attribute__((address_space(1))) unsigned*)rs + u.pm * BM + wr * 64 + fr;
#pragma unroll
            for (int i = 0; i < 8; ++i) q[i] = rp[(i >> 2) * HALF + (i & 3) * 16]; } }
    bf16_t* O; int ldc; int split_cols; size_t split_stride; const unsigned* rs;
    __device__ __forceinline__ void operator()(const f32x4 (&acc)[2][2][4][2], const Unit& u, int wr, int wc, int fr, int fq, const unsigned (&q)[8]) const {
        const int row0 = u.pm * BM + wr * 64 + fr; int colt = u.pn * BM; bf16_t* base = O;
        if (split_cols) { const int t = colt / split_cols; base += (size_t)t * split_stride; colt -= t * split_cols; }
        const int col0 = colt + wc * 32 + 8 * fq;
        float sc[2][4];
#pragma unroll
        for (int ai = 0; ai < 2; ++ai)
#pragma unroll
            for (int m = 0; m < 4; ++m) sc[ai][m] = rs ? rsqrtf((float)q[ai * 4 + m] * (1.f / (16.f * 1024.f)) + 1e-6f) : 1.f;
#pragma unroll
        for (int ai = 0; ai < 2; ++ai)
#pragma unroll
            for (int m = 0; m < 4; ++m) { bf16_t* rowp = base + (size_t)(row0 + ai * HALF + m * 16) * ldc + col0;
#pragma unroll
                for (int bj = 0; bj < 2; ++bj) { const f32x4 v0 = acc[ai][bj][m][0] * sc[ai][m], v1 = acc[ai][bj][m][1] * sc[ai][m];
                    u32x4 w; w.x = cvt_pk_bf16(v0[0], v0[1]); w.y = cvt_pk_bf16(v0[2], v0[3]); w.z = cvt_pk_bf16(v1[0], v1[1]); w.w = cvt_pk_bf16(v1[2], v1[3]);
                    *(u32x4*)(rowp + bj * HALF) = w; } }
    }
};
struct EpiRes {
    static constexpr bool PERM = true, AFTER_DRAIN = false, HAS_PRE = false;
    bf16_t* X; int ldc; unsigned* rss;
    __device__ __forceinline__ void operator()(const f32x4 (&acc)[2][2][4][2], const Unit& u, int wr, int wc, int fr, int fq) const {
        const int row0 = u.pm * BM + wr * 64 + fr, col0 = u.pn * BM + wc * 32 + 8 * fq;
        typedef __attribute__((address_space(1))) u32x4 gu32x4;
        u32x4 b[2][4][2];
#pragma unroll
        for (int ai = 0; ai < 2; ++ai)
#pragma unroll
            for (int m = 0; m < 4; ++m)
#pragma unroll
                for (int bj = 0; bj < 2; ++bj) b[ai][m][bj] = *(const gu32x4*)(X + (size_t)(row0 + ai * HALF + m * 16) * ldc + col0 + bj * HALF);
#pragma unroll
        for (int ai = 0; ai < 2; ++ai)
#pragma unroll
            for (int m = 0; m < 4; ++m) { bf16_t* rowp = X + (size_t)(row0 + ai * HALF + m * 16) * ldc + col0; float ss = 0.f;
#pragma unroll
                for (int bj = 0; bj < 2; ++bj) { float v[8];
#pragma unroll
                    for (int i = 0; i < 4; ++i) { v[2 * i] = __uint_as_float(b[ai][m][bj][i] << 16) + acc[ai][bj][m][i >> 1][(2 * i) & 3]; v[2 * i + 1] = __uint_as_float(b[ai][m][bj][i] & 0xffff0000u) + acc[ai][bj][m][i >> 1][(2 * i + 1) & 3]; }
                    u32x4 w; w.x = cvt_pk_bf16(v[0], v[1]); w.y = cvt_pk_bf16(v[2], v[3]); w.z = cvt_pk_bf16(v[4], v[5]); w.w = cvt_pk_bf16(v[6], v[7]);
                    *(gu32x4*)(rowp + bj * HALF) = w;
#pragma unroll
                    for (int i = 0; i < 8; ++i) ss += v[i] * v[i]; }
                ss += __shfl_xor(ss, 16); ss += __shfl_xor(ss, 32);
                if (fq == 0) __hip_atomic_fetch_add(rss + row0 + ai * HALF + m * 16, (unsigned)(ss * 16.f + 0.5f), __ATOMIC_RELAXED, __HIP_MEMORY_SCOPE_AGENT); }
    }
};
struct EpiMoeOut {
    static constexpr bool PERM = true, AFTER_DRAIN = false, HAS_PRE = false;
    bf16_t* Y; int ldc; const float* sg;
    __device__ __forceinline__ void operator()(const f32x4 (&acc)[2][2][4][2], const Unit& u, int wr, int wc, int fr, int fq) const {
        const int row0 = u.pm * BM + wr * 64 + fr, col0 = u.pn * BM + wc * 32 + 8 * fq;
        typedef __attribute__((address_space(1))) u32x4 gu32x4;
        float g[2][4];
        { const __attribute__((address_space(1))) float* gp = (const __attribute__((address_space(1))) float*)sg + row0;
#pragma unroll
          for (int ai = 0; ai < 2; ++ai)
#pragma unroll
              for (int m = 0; m < 4; ++m) g[ai][m] = gp[ai * HALF + m * 16]; }
        u32x4 b[2][4][2];
#pragma unroll
        for (int ai = 0; ai < 2; ++ai)
#pragma unroll
            for (int m = 0; m < 4; ++m)
#pragma unroll
                for (int bj = 0; bj < 2; ++bj) { b[ai][m][bj] = (u32x4){0u, 0u, 0u, 0u}; if (g[ai][m] > 0.f) b[ai][m][bj] = *(const gu32x4*)(Y + (size_t)(row0 + ai * HALF + m * 16) * ldc + col0 + bj * HALF); }
#pragma unroll
        for (int ai = 0; ai < 2; ++ai)
#pragma unroll
            for (int m = 0; m < 4; ++m) { bf16_t* rowp = Y + (size_t)(row0 + ai * HALF + m * 16) * ldc + col0; const float ga = fabsf(g[ai][m]);
#pragma unroll
                for (int bj = 0; bj < 2; ++bj) { float v[8];
#pragma unroll
                    for (int i = 0; i < 4; ++i) { v[2 * i] = __uint_as_float(b[ai][m][bj][i] << 16) + ga * acc[ai][bj][m][i >> 1][(2 * i) & 3]; v[2 * i + 1] = __uint_as_float(b[ai][m][bj][i] & 0xffff0000u) + ga * acc[ai][bj][m][i >> 1][(2 * i + 1) & 3]; }
                    u32x4 w; w.x = cvt_pk_bf16(v[0], v[1]); w.y = cvt_pk_bf16(v[2], v[3]); w.z = cvt_pk_bf16(v[4], v[5]); w.w = cvt_pk_bf16(v[6], v[7]);
                    *(gu32x4*)(rowp + bj * HALF) = w; } }
    }
};
struct EpiMoeOutT {
    static constexpr bool PERM = true, AFTER_DRAIN = false, HAS_PRE = false;
    bf16_t* Y; int ldc; const float* sg; float* part; unsigned* cnt;
    __device__ __forceinline__ void operator()(const f32x4 (&acc_)[2][2][4][2], const Unit& u, int wr, int wc, int fr, int fq) const {
        f32x4 (&acc)[2][2][4][2] = const_cast<f32x4 (&)[2][2][4][2]>(acc_);
        typedef __attribute__((address_space(1))) f32x4 gf32x4;
        typedef __attribute__((address_space(1))) u32x4 gu32x4;
        if (u.ti >= 0) {
            const int wid = wr * 4 + wc; int lane = fq * 16 + fr; asm volatile("" : "+v"(lane));
            if (u.ks > 0) {
                gf32x4* p = (gf32x4*)part + ((size_t)(u.ti * 3 + u.ks - 1) * 8 + wid) * 2048 + lane;
#pragma unroll
                for (int j = 0; j < 32; ++j) p[j * 64] = acc[j >> 4][(j >> 3) & 1][(j >> 1) & 3][j & 1];
                __builtin_amdgcn_fence(__ATOMIC_RELEASE, "agent");
                if (lane == 0) __hip_atomic_fetch_add(cnt + u.ti, 1u, __ATOMIC_RELAXED, __HIP_MEMORY_SCOPE_AGENT);
                return;
            }
            const unsigned target = 8u * (unsigned)(u.s - 1);
            while (__hip_atomic_load(cnt + u.ti, __ATOMIC_RELAXED, __HIP_MEMORY_SCOPE_AGENT) < target) __builtin_amdgcn_s_sleep(2);
            __builtin_amdgcn_fence(__ATOMIC_ACQUIRE, "agent");
            for (int pz = 0; pz < u.s - 1; ++pz) {
                const gf32x4* q = (const gf32x4*)part + ((size_t)(u.ti * 3 + pz) * 8 + wid) * 2048 + lane;
#pragma unroll
                for (int h = 0; h < 4; ++h) { f32x4 t[8];
#pragma unroll
                    for (int j = 0; j < 8; ++j) t[j] = q[(h * 8 + j) * 64];
#pragma unroll
                    for (int j = 0; j < 8; ++j) acc[h >> 1][h & 1][(j >> 1) & 3][j & 1] += t[j]; }
            }
        }
        const int row0 = u.pm * BM + wr * 64 + fr, col0 = u.pn * BM + wc * 32 + 8 * fq;
        float g[2][4];
        { const __attribute__((address_space(1))) float* gp = (const __attribute__((address_space(1))) float*)sg + row0;
#pragma unroll
          for (int ai = 0; ai < 2; ++ai)
#pragma unroll
              for (int m = 0; m < 4; ++m) g[ai][m] = gp[ai * HALF + m * 16]; }
        u32x4 b[2][4][2];
#pragma unroll
        for (int ai = 0; ai < 2; ++ai)
#pragma unroll
            for (int m = 0; m < 4; ++m)
#pragma unroll
                for (int bj = 0; bj < 2; ++bj) { b[ai][m][bj] = (u32x4){0u, 0u, 0u, 0u}; if (g[ai][m] > 0.f) b[ai][m][bj] = *(const gu32x4*)(Y + (size_t)(row0 + ai * HALF + m * 16) * ldc + col0 + bj * HALF); }
#pragma unroll
        for (int ai = 0; ai < 2; ++ai)
#pragma unroll
            for (int m = 0; m < 4; ++m) { bf16_t* rowp = Y + (size_t)(row0 + ai * HALF + m * 16) * ldc + col0; const float ga = fabsf(g[ai][m]);
#pragma unroll
                for (int bj = 0; bj < 2; ++bj) { float v[8];
#pragma unroll
                    for (int i = 0; i < 4; ++i) { v[2 * i] = __uint_as_float(b[ai][m][bj][i] << 16) + ga * acc[ai][bj][m][i >> 1][(2 * i) & 3]; v[2 * i + 1] = __uint_as_float(b[ai][m][bj][i] & 0xffff0000u) + ga * acc[ai][bj][m][i >> 1][(2 * i + 1) & 3]; }
                    u32x4 w; w.x = cvt_pk_bf16(v[0], v[1]); w.y = cvt_pk_bf16(v[2], v[3]); w.z = cvt_pk_bf16(v[4], v[5]); w.w = cvt_pk_bf16(v[6], v[7]);
                    *(gu32x4*)(rowp + bj * HALF) = w; } }
    }
};
struct EpiSwiGLU {
    static constexpr bool PERM = true, AFTER_DRAIN = false, HAS_PRE = true;
    __device__ __forceinline__ void preload(unsigned (&q)[8], const Unit& u, int wr, int fr) const {
        const __attribute__((address_space(1))) unsigned* rp = (const __attribute__((address_space(1))) unsigned*)rs + u.pm * BM + wr * 64 + fr;
#pragma unroll
        for (int i = 0; i < 8; ++i) q[i] = rp[(i >> 2) * HALF + (i & 3) * 16]; }
    bf16_t* H; int ldc; const unsigned* rs;
    __device__ __forceinline__ void operator()(const f32x4 (&acc)[2][2][4][2], const Unit& u, int wr, int wc, int fr, int fq, const unsigned (&q)[8]) const {
        const int row0 = u.pm * BM + wr * 64 + fr, col0 = u.pn * HALF + wc * 32 + 8 * fq;
        float sc[2][4];
#pragma unroll
        for (int ai = 0; ai < 2; ++ai)
#pragma unroll
            for (int m = 0; m < 4; ++m) sc[ai][m] = rsqrtf((float)q[ai * 4 + m] * (1.f / (16.f * 1024.f)) + 1e-6f);
#pragma unroll
        for (int ai = 0; ai < 2; ++ai)
#pragma unroll
            for (int m = 0; m < 4; ++m) { bf16_t* rowp = H + (size_t)(row0 + ai * HALF + m * 16) * ldc + col0; float hv[8];
#pragma unroll
                for (int n = 0; n < 2; ++n)
#pragma unroll
                    for (int i = 0; i < 4; ++i) { const float g = acc[ai][0][m][n][i] * sc[ai][m], up = acc[ai][1][m][n][i] * sc[ai][m];
                        hv[n * 4 + i] = g * __builtin_amdgcn_rcpf(1.f + __builtin_amdgcn_exp2f(-g * 1.4426950408889634f)) * up; }
                u32x4 w; w.x = cvt_pk_bf16(hv[0], hv[1]); w.y = cvt_pk_bf16(hv[2], hv[3]); w.z = cvt_pk_bf16(hv[4], hv[5]); w.w = cvt_pk_bf16(hv[6], hv[7]);
                *(u32x4*)rowp = w; }
    }
};

template <class Epi, class Sched, bool ALIGN_EPI = false, bool SP2 = false>
__device__ __forceinline__ void gemm_phase(PG8_LAS unsigned char* lds, const Gemm g, const Sched& S, const Epi& E) {
    int tid = threadIdx.x; asm volatile("" : "+v"(tid));
    const int wid = __builtin_amdgcn_readfirstlane(tid >> 6), lane = tid & 63, wr = wid >> 2, wc = wid & 3, fr = lane & 15, fq = lane >> 4;
    const int K = g.K, nt = K / BK;
    unsigned voffA[2], voffB[2];
#pragma unroll
    for (int i = 0; i < 2; ++i) { int R, C; stage_rc(tid * 16 + i * 8192, R, C); const int Rb = Epi::PERM ? ((R & ~31) + perm32(R & 31)) : R;
        voffA[i] = (unsigned)(R * K + C) * 2u; voffB[i] = (unsigned)(Rb * K + C) * 2u; }
    const size_t kstep = (size_t)(BK * 2);
    const size_t hstep = (size_t)HALF * K * 2;
    const size_t tstep = 2 * hstep;
    const unsigned ldsw = (unsigned)wid * 1024u;
    const int aoff = lds_byte(wr * 64 + fr, fq * 8), boff = lds_byte(wc * 32 + fr, fq * 8);
#define PG8_SA(b, h) (((b) * 2 + (h)) * HTB)
#define PG8_SB(b, h) ((4 + (b) * 2 + (h)) * HTB)
#define PG8_STAGE(bufoff, gbase, voff) do { _Pragma("unroll") for (int _i = 0; _i < 2; ++_i) \
        __builtin_amdgcn_global_load_lds((const unsigned*)((const char*)(gbase) + (voff)[_i]), (PG8_LAS unsigned*)(lds + (bufoff) + ldsw + _i * 8192), 16, 0, 0); } while (0)
#define PG8_LDA(dst, b, h) do { _Pragma("unroll") for (int m = 0; m < 4; ++m) _Pragma("unroll") for (int k = 0; k < 2; ++k) dst[m][k] = *(const PG8_LAS bf16x8*)(lds + PG8_SA(b, h) + aoff + m * 2048 + k * 1024); } while (0)
#define PG8_LDB(dst, b, h) do { _Pragma("unroll") for (int n = 0; n < 2; ++n) _Pragma("unroll") for (int k = 0; k < 2; ++k) dst[n][k] = *(const PG8_LAS bf16x8*)(lds + PG8_SB(b, h) + boff + n * 2048 + k * 1024); } while (0)
#define PG8_MMA(ai, bj, At, Bt) do { __builtin_amdgcn_s_setprio(1); _Pragma("unroll") for (int m = 0; m < 4; ++m) _Pragma("unroll") for (int n = 0; n < 2; ++n) _Pragma("unroll") for (int k = 0; k < 2; ++k) \
        acc[ai][bj][m][n] = __builtin_amdgcn_mfma_f32_16x16x32_bf16(Bt[n][k], At[m][k], acc[ai][bj][m][n], 0, 0, 0); __builtin_amdgcn_s_setprio(0); } while (0)
#define PG8_WAIT_V(n) asm volatile("s_waitcnt vmcnt(" #n ")" ::: "memory")
#define PG8_WAIT_L(n) asm volatile("s_waitcnt lgkmcnt(" #n ")" ::: "memory")
#define PG8_BAR __builtin_amdgcn_s_barrier()
#define PG8_SCHED __builtin_amdgcn_sched_barrier(0)
    Unit cur, nxt; int ui = 0;
    if (!S.next(0, cur)) return;
    f32x4 acc[2][2][4][2];
#pragma unroll
    for (int a = 0; a < 2; ++a)
#pragma unroll
        for (int b = 0; b < 2; ++b)
#pragma unroll
            for (int m = 0; m < 4; ++m)
#pragma unroll
                for (int n = 0; n < 2; ++n) acc[a][b][m][n] = (f32x4){0.f, 0.f, 0.f, 0.f};
    bf16x8 At[4][2], B0[2][2], B1[2][2];
    const char* cA = (const char*)g.A + (size_t)cur.pm * tstep; const char* cB = (const char*)g.Bt + cur.bofs + (size_t)cur.pn * tstep;
    if constexpr (Sched::VAR_K) cA += cur.aofs;
    S.a_ready(cur);
    if constexpr (SP2) {
        PG8_STAGE(PG8_SB(0, 0), cB, voffB); PG8_STAGE(PG8_SB(0, 1), cB + hstep, voffB); PG8_STAGE(PG8_SA(0, 0), cA, voffA); PG8_STAGE(PG8_SA(0, 1), cA + hstep, voffA);
        if (wr == 1) PG8_BAR;
        PG8_WAIT_V(2); PG8_BAR;
        PG8_STAGE(PG8_SB(1, 0), cB + kstep, voffB); PG8_STAGE(PG8_SA(1, 0), cA + kstep, voffA); PG8_STAGE(PG8_SB(1, 1), cB + hstep + kstep, voffB);
        PG8_WAIT_V(6); PG8_BAR;
    } else {
        PG8_STAGE(PG8_SB(0, 0), cB, voffB); PG8_STAGE(PG8_SA(0, 0), cA, voffA); PG8_STAGE(PG8_SB(0, 1), cB + hstep, voffB); PG8_STAGE(PG8_SA(0, 1), cA + hstep, voffA);
        if (wr == 1) PG8_BAR;
        PG8_WAIT_V(4); PG8_BAR;
        PG8_STAGE(PG8_SB(1, 0), cB + kstep, voffB); PG8_STAGE(PG8_SA(1, 0), cA + kstep, voffA); PG8_STAGE(PG8_SB(1, 1), cB + hstep + kstep, voffB);
        PG8_WAIT_V(6); PG8_BAR;
    }
    for (;;) {
        unsigned preq[8];
        if constexpr (Epi::HAS_PRE) E.preload(preq, cur, wr, fr);
        const bool has_next = S.next(ui + 1, nxt);
        const char* nA = has_next ? (const char*)g.A + (size_t)nxt.pm * tstep : cA; const char* nB = has_next ? (const char*)g.Bt + nxt.bofs + (size_t)nxt.pn * tstep : cB;
        if constexpr (Sched::VAR_K) { if (has_next) nA += nxt.aofs; }
        int ntu = nt; if constexpr (Sched::VAR_K) ntu = cur.nt;
        for (int t = 0; t < ntu; t += 2) {
            const bool last = (t == ntu - 2);
            const char* a1 = cA + (size_t)(t + 1) * kstep;
            const char* a2 = last ? nA : cA + (size_t)(t + 2) * kstep; const char* b2 = last ? nB : cB + (size_t)(t + 2) * kstep;
            const char* a3 = a2 + kstep; const char* b3 = b2 + kstep;
            if (last && has_next) S.a_ready(nxt);
            if constexpr (SP2) {
            PG8_LDB(B0, 0, 0); PG8_LDB(B1, 0, 1); PG8_SCHED; PG8_LDA(At, 0, 0); PG8_STAGE(PG8_SA(1, 1), a1 + hstep, voffA);
            PG8_WAIT_V(8); PG8_WAIT_L(0); PG8_BAR; PG8_MMA(0, 0, At, B0); PG8_MMA(0, 1, At, B1); PG8_BAR; PG8_SCHED;
            PG8_LDA(At, 0, 1); PG8_STAGE(PG8_SB(0, 0), b2, voffB); PG8_STAGE(PG8_SB(0, 1), b2 + hstep, voffB); PG8_STAGE(PG8_SA(0, 0), a2, voffA);
            PG8_WAIT_V(8); PG8_WAIT_L(0); PG8_BAR; PG8_MMA(1, 0, At, B0); PG8_MMA(1, 1, At, B1); PG8_BAR; PG8_SCHED;
            PG8_LDB(B0, 1, 0); PG8_LDB(B1, 1, 1); PG8_SCHED; PG8_LDA(At, 1, 0); PG8_STAGE(PG8_SA(0, 1), a2 + hstep, voffA);
            PG8_WAIT_V(8); PG8_WAIT_L(0); PG8_BAR; PG8_MMA(0, 0, At, B0); PG8_MMA(0, 1, At, B1); PG8_BAR; PG8_SCHED;
            PG8_LDA(At, 1, 1); PG8_STAGE(PG8_SB(1, 0), b3, voffB); PG8_STAGE(PG8_SB(1, 1), b3 + hstep, voffB); PG8_STAGE(PG8_SA(1, 0), a3, voffA);
            PG8_WAIT_V(8); PG8_WAIT_L(0); PG8_BAR; PG8_MMA(1, 0, At, B0); PG8_MMA(1, 1, At, B1); PG8_BAR; PG8_SCHED;
            } else {
            PG8_LDB(B0, 0, 0); PG8_SCHED; PG8_LDA(At, 0, 0); PG8_STAGE(PG8_SA(1, 1), a1 + hstep, voffA);
            PG8_WAIT_L(8); PG8_BAR; PG8_WAIT_L(0); PG8_MMA(0, 0, At, B0); PG8_BAR; PG8_SCHED;
            PG8_LDB(B1, 0, 1); PG8_STAGE(PG8_SB(0, 0), b2, voffB);
            PG8_BAR; PG8_WAIT_L(0); PG8_MMA(0, 1, At, B1); PG8_BAR;
            PG8_LDA(At, 0, 1); PG8_STAGE(PG8_SA(0, 0), a2, voffA);
            PG8_BAR; PG8_WAIT_L(0); PG8_MMA(1, 0, At, B0); PG8_BAR; PG8_SCHED;
            PG8_STAGE(PG8_SB(0, 1), b2 + hstep, voffB);
            PG8_WAIT_V(6); PG8_BAR; PG8_MMA(1, 1, At, B1); PG8_BAR;
            PG8_LDB(B0, 1, 0); PG8_SCHED; PG8_LDA(At, 1, 0); PG8_STAGE(PG8_SA(0, 1), a2 + hstep, voffA);
            PG8_WAIT_L(8); PG8_BAR; PG8_WAIT_L(0); PG8_MMA(0, 0, At, B0); PG8_BAR; PG8_SCHED;
            PG8_LDB(B1, 1, 1); PG8_STAGE(PG8_SB(1, 0), b3, voffB);
            PG8_BAR; PG8_WAIT_L(0); PG8_MMA(0, 1, At, B1); PG8_BAR;
            PG8_LDA(At, 1, 1); PG8_STAGE(PG8_SA(1, 0), a3, voffA);
            PG8_BAR; PG8_WAIT_L(0); PG8_MMA(1, 0, At, B0); PG8_BAR; PG8_SCHED;
            PG8_STAGE(PG8_SB(1, 1), b3 + hstep, voffB);
            PG8_WAIT_V(6); PG8_BAR; PG8_MMA(1, 1, At, B1); PG8_BAR;
            }
        }
        if constexpr (ALIGN_EPI) { if (wr == 0) PG8_BAR; }
        if constexpr (!Epi::AFTER_DRAIN) { if constexpr (Epi::HAS_PRE) E(acc, cur, wr, wc, fr, fq, preq); else E(acc, cur, wr, wc, fr, fq); S.done(cur); }
        if (!has_next) break;
#pragma unroll
        for (int a = 0; a < 2; ++a)
#pragma unroll
            for (int b = 0; b < 2; ++b)
#pragma unroll
                for (int m = 0; m < 4; ++m)
#pragma unroll
                    for (int n = 0; n < 2; ++n) acc[a][b][m][n] = (f32x4){0.f, 0.f, 0.f, 0.f};
        cur = nxt; cA = nA; cB = nB; ++ui;
        if constexpr (ALIGN_EPI) { if (wr == 1) PG8_BAR; }
    }
    PG8_WAIT_V(0);
    if constexpr (!ALIGN_EPI) { if (wr == 0) PG8_BAR; }
    PG8_BAR;
#undef PG8_SA
#undef PG8_SB
#undef PG8_STAGE
#undef PG8_LDA
#undef PG8_LDB
#undef PG8_MMA
#undef PG8_WAIT_V
#undef PG8_WAIT_L
#undef PG8_BAR
#undef PG8_SCHED
}
}


#include <hip/hip_bf16.h>
namespace fox {
using bf16h=__hip_bfloat16;
using bf16x8=__attribute__((ext_vector_type(8)))short;
using s16x4=__attribute__((ext_vector_type(4)))short;
using f32x16=__attribute__((ext_vector_type(16)))float;
using f32x4=__attribute__((ext_vector_type(4)))float;
using u32x4=__attribute__((ext_vector_type(4)))unsigned;
constexpr int NHEAD=FH,D=64,DMI=512,DMO=1024;
constexpr int NW=8,QBLK=32,QB=QBLK*NW,KVBLK=64,NQB=SEQ/QB;
__device__ __forceinline__ int crow(int r,int hi){return (r&3)+8*(r>>2)+4*hi;}
#define SBAR() __builtin_amdgcn_sched_barrier(0)
__device__ __forceinline__ void cmask(f32x16&p0,f32x16&p1,int jb,int qrel,int hi){
  const float NEG=-INFINITY; int kb=64*jb+4*hi;
  #pragma unroll
  for(int r=0;r<16;++r){int kv=kb+(r&3)+8*(r>>2); if(kv>qrel)p0[r]=NEG; if(kv+32>qrel)p1[r]=NEG;}
}
constexpr int NSLOT=3, SLOTB=8192;
constexpr int LDS_K=0, LDS_V=NSLOT*SLOTB, LDS_WS=2*NSLOT*SLOTB, LDS_OST=LDS_WS+NW*64*4, LDS_NB=LDS_OST+NW*4096, LDS_BYTES=LDS_NB+SEQ*4;
__device__ __forceinline__ void glds16(const void*gsrc,unsigned lds_dst){unsigned keep;
  asm volatile("s_mov_b32 %0, m0\n\ts_mov_b32 m0, %2\n\ts_nop 0\n\tglobal_load_lds_dwordx4 %1, off\n\ts_mov_b32 m0, %0":"=&s"(keep):"v"(gsrc),"s"(lds_dst):"memory");}
__device__ __forceinline__ float max3f(float a,float b,float c){float r;asm("v_max3_f32 %0, %1, %2, %3":"=v"(r):"v"(a),"v"(b),"v"(c));return r;}
__device__ __forceinline__ float max2f(float a,float b){float r;asm("v_max_f32_e32 %0, %1, %2":"=v"(r):"v"(a),"v"(b));return r;}
__device__ __forceinline__ float fadd_s(float a,float b){float r;asm("v_add_f32_e32 %0, %1, %2":"=v"(r):"v"(a),"v"(b));return r;}
__device__ __forceinline__ float fsub_s(float a,float b){float r;asm("v_sub_f32_e32 %0, %1, %2":"=v"(r):"v"(a),"v"(b));return r;}
typedef float f32x2_t __attribute__((ext_vector_type(2))); typedef __bf16 bf16x2_t __attribute__((ext_vector_type(2)));
__device__ __forceinline__ unsigned cvtpk_s(float lo,float hi){f32x2_t v={lo,hi};bf16x2_t b=__builtin_convertvector(v,bf16x2_t);return __builtin_bit_cast(unsigned,b);}
#define WAIT_BAR(N) asm volatile("s_waitcnt vmcnt(" #N ") lgkmcnt(0)\n\ts_barrier":::"memory")
__device__ __forceinline__ void qkt(f32x16&p0,f32x16&p1,const char*Kslot,const bf16x8*qr,int r32,int hi){
  const char*kb=Kslot+hi*1024+r32*16;
  #pragma unroll
  for(int d0=0;d0<4;++d0){
    const bf16x8 b0=*reinterpret_cast<const bf16x8*>(kb+d0*2048);
    const bf16x8 b1=*reinterpret_cast<const bf16x8*>(kb+d0*2048+512);
    p0=__builtin_amdgcn_mfma_f32_32x32x16_bf16(b0,qr[d0],p0,0,0,0);p1=__builtin_amdgcn_mfma_f32_32x32x16_bf16(b1,qr[d0],p1,0,0,0);}
}
typedef __attribute__((address_space(3))) const char* lds_cptr;
typedef __attribute__((address_space(3))) const float* lds_fptr;
typedef short v4i16_t __attribute__((ext_vector_type(4)));
__device__ __forceinline__ void kload8(bf16x8*kf,lds_cptr kp){
  kf[0]=*(const __attribute__((address_space(3))) bf16x8*)(kp);      kf[1]=*(const __attribute__((address_space(3))) bf16x8*)(kp+512);
  kf[2]=*(const __attribute__((address_space(3))) bf16x8*)(kp+2048); kf[3]=*(const __attribute__((address_space(3))) bf16x8*)(kp+2560);
  kf[4]=*(const __attribute__((address_space(3))) bf16x8*)(kp+4096); kf[5]=*(const __attribute__((address_space(3))) bf16x8*)(kp+4608);
  kf[6]=*(const __attribute__((address_space(3))) bf16x8*)(kp+6144); kf[7]=*(const __attribute__((address_space(3))) bf16x8*)(kp+6656);
}
__device__ __forceinline__ void kload2(bf16x8*kf,lds_cptr kp,int j){ kf[2*j]=*(const __attribute__((address_space(3))) bf16x8*)(kp+j*2048); kf[2*j+1]=*(const __attribute__((address_space(3))) bf16x8*)(kp+j*2048+512); }
__device__ __forceinline__ s16x4 vtr(lds_cptr p){ return __builtin_bit_cast(s16x4,__builtin_amdgcn_ds_read_tr16_b64_v4i16((__attribute__((address_space(3))) v4i16_t*)p)); }
__device__ __forceinline__ float rowmax(const f32x16&p0,const f32x16&p1){
  float a=max3f(p0[0],p0[1],p1[0]),b=max3f(p0[2],p0[3],p1[1]);a=max3f(a,p1[2],p1[3]);
  #pragma unroll
  for(int r=4;r<16;r+=4){a=max3f(a,p0[r],p0[r+1]);b=max3f(b,p0[r+2],p0[r+3]);a=max3f(a,p1[r],p1[r+1]);b=max3f(b,p1[r+2],p1[r+3]);}
  const float m=max2f(a,b);
  auto rr=__builtin_amdgcn_permlane32_swap(__float_as_uint(m),__float_as_uint(m),false,false);
  return max2f(__uint_as_float(rr[0]),__uint_as_float(rr[1]));
}
__device__ __forceinline__ void pv(f32x16*o,int vb,bf16x8 pa0,bf16x8 pa1,bf16x8 pa2,bf16x8 pa3){
  #pragma unroll
  for(int d0=0;d0<2;++d0){s16x4 lo[4],hi[4];
    #pragma unroll
    for(int ks=0;ks<4;++ks){
      asm volatile("ds_read_b64_tr_b16 %0,%1 offset:%c2":"=&v"(lo[ks]):"v"(vb),"i"(d0*4096+ks*1024):"memory");
      asm volatile("ds_read_b64_tr_b16 %0,%1 offset:%c2":"=&v"(hi[ks]):"v"(vb),"i"(d0*4096+ks*1024+512):"memory");}
    asm volatile("s_waitcnt lgkmcnt(0)":::"memory");SBAR();
    #define PK(k) (bf16x8){lo[k][0],lo[k][1],lo[k][2],lo[k][3],hi[k][0],hi[k][1],hi[k][2],hi[k][3]}
    o[d0]=__builtin_amdgcn_mfma_f32_32x32x16_bf16(pa0,PK(0),o[d0],0,0,0);
    o[d0]=__builtin_amdgcn_mfma_f32_32x32x16_bf16(pa1,PK(1),o[d0],0,0,0);
    o[d0]=__builtin_amdgcn_mfma_f32_32x32x16_bf16(pa2,PK(2),o[d0],0,0,0);
    o[d0]=__builtin_amdgcn_mfma_f32_32x32x16_bf16(pa3,PK(3),o[d0],0,0,0);
    #undef PK
  }
}
template<int THRL> __device__ __forceinline__ void attn_unit(int b,int h,int qb,int j0,const bf16h*Q,const bf16h*__restrict__ K,const bf16h*__restrict__ V,bf16h*O,const float*CL,char*shm){
  int tid=threadIdx.x; asm volatile("":"+v"(tid));
  const int lane=tid&63,r32=lane&31,hi=lane>>5; const int wid=__builtin_amdgcn_readfirstlane(tid>>6);
  const long rowbase=(long)b*SEQ; const int q0=qb*QB; const long kvbase=rowbase+(long)j0*KVBLK;
  const bf16h*Qw=Q+(rowbase+q0+wid*QBLK)*DMI+h*D;
  const bf16h*Kh=K+kvbase*DMI+h*D,*Vh=V+kvbase*DMI+h*D;
  const unsigned lds0=(unsigned)(uintptr_t)shm;
  float*wsf=(float*)(shm+LDS_WS)+wid*64;
  const int NT=(q0+QB)/KVBLK-j0;
  { float*nbw=(float*)(shm+LDS_NB); const float*src=CL+(long)j0*KVBLK;
    for(int i=tid*4;i<NT*KVBLK;i+=512*4){ const f32x4 v=*(const f32x4*)(src+i); *(f32x4*)(nbw+i)=(f32x4){-v[0],-v[1],-v[2],-v[3]}; } }
  const bf16h*ksrc=Kh+(long)lane*DMI+wid*8;
  const bf16h*vsrc=Vh+(long)(16*(wid&3)+(lane>>2))*DMI+(wid>>2)*32+(lane&3)*8;
  const unsigned kdst=lds0+LDS_K+wid*1024, vdst=lds0+LDS_V+wid*1024;
  #define DMA_K(t,slot) glds16(ksrc+(long)(t)*KVBLK*DMI,(unsigned)__builtin_amdgcn_readfirstlane(kdst+(slot)))
  #define DMA_V(t,slot) glds16(vsrc+(long)(t)*KVBLK*DMI,(unsigned)__builtin_amdgcn_readfirstlane(vdst+(slot)))
  const int vb0=(int)(lds0+LDS_V)+((lane>>4)&1)*32+(lane&3)*8+(4*hi+((lane&15)>>2))*64;
  const char*Kbase=shm+LDS_K; bf16x8 kf[8];
  const lds_cptr shm3=(lds_cptr)shm; const lds_cptr kp0=shm3+LDS_K+hi*1024+r32*16; const lds_cptr vp0=shm3+LDS_V+((lane>>4)&1)*32+(lane&3)*8+(4*hi+((lane&15)>>2))*64;
  const lds_fptr nb0=(lds_fptr)(shm3+LDS_NB)+4*hi;
  DMA_K(0,0);DMA_V(0,0);DMA_K(1,SLOTB);
  bf16x8 qr[4];
  #pragma unroll
  for(int d0=0;d0<4;++d0)qr[d0]=*reinterpret_cast<const bf16x8*>(&Qw[(long)r32*DMI+d0*16+hi*8]);
  float mhat=0.f,l_reg=0.f;f32x16 o[2];o[0]=f32x16{};o[1]=f32x16{};
  const int qrel=wid*QBLK+r32;
  #define CMASK(P0,P1,t) do{int jb_=(t)-(NT-4); if(jb_>=0)cmask(P0,P1,jb_,qrel,hi);}while(0)
  #define PRELOAD(P0,P1,tt) do{ const lds_fptr nbp_=nb0+(tt)*KVBLK; \
    _Pragma("unroll") for(int g_=0;g_<4;++g_){ const f32x4 a_=*(const __attribute__((address_space(3))) f32x4*)(nbp_+8*g_), b_=*(const __attribute__((address_space(3))) f32x4*)(nbp_+32+8*g_); \
      P0[4*g_]=a_[0]-mhat;P0[4*g_+1]=a_[1]-mhat;P0[4*g_+2]=a_[2]-mhat;P0[4*g_+3]=a_[3]-mhat; P1[4*g_]=b_[0]-mhat;P1[4*g_+1]=b_[1]-mhat;P1[4*g_+2]=b_[2]-mhat;P1[4*g_+3]=b_[3]-mhat; } }while(0)
  bool resc=false;
  #define START(P0,P1) do{ const float rm=rowmax(P0,P1); resc=false; \
    { const float dl=rm; mhat=fadd_s(mhat,dl); \
      _Pragma("unroll") for(int r=0;r<16;++r){P0[r]=fsub_s(P0[r],dl);P1[r]=fsub_s(P1[r],dl);} } \
    _Pragma("unroll") for(int r=0;r<16;++r)P0[r]=__builtin_amdgcn_exp2f(P0[r]); }while(0)
  #define RESC() do{ if(resc){ asm volatile("s_waitcnt lgkmcnt(0)":::"memory"); \
      _Pragma("unroll") for(int d_=0;d_<2;++d_) _Pragma("unroll") for(int r=0;r<16;++r)o[d_][r]*=wsf[crow(r,hi)]; } }while(0)
  f32x16 pA0,pA1,pB0,pB1;
  int sl_prev=0,sl_cur=0,sl_next=SLOTB;
  #define ROT() do{sl_prev=sl_cur;sl_cur=sl_next;sl_next=(sl_next==(NSLOT-1)*SLOTB)?0:sl_next+SLOTB;}while(0)
  DMA_K(2,2*SLOTB);
  WAIT_BAR(3);
  PRELOAD(pA0,pA1,0);
  qkt(pA0,pA1,Kbase,qr,r32,hi);asm volatile("s_nop 15\n\ts_nop 7":"+v"(pA0),"+v"(pA1));CMASK(pA0,pA1,0);
  START(pA0,pA1);
  _Pragma("unroll") for(int r=0;r<16;++r)pA1[r]=__builtin_amdgcn_exp2f(pA1[r]);
  WAIT_BAR(0);
  DMA_K(3,0);DMA_V(1,SLOTB);
  ROT();
  kload8(kf,kp0+sl_cur);
  PRELOAD(pB0,pB1,1);
  WAIT_BAR(2);
  s16x4 vlo[8],vhi[8]; u32x4 pw0,pw1,pw2,pw3;
  #define PKW(P,B) cvtpk_s(P[B],P[B+1])
  #define PAF(k) __builtin_bit_cast(bf16x8,pw##k)
  #define VFR(i) (bf16x8){vlo[i][0],vlo[i][1],vlo[i][2],vlo[i][3],vhi[i][0],vhi[i][1],vhi[i][2],vhi[i][3]}
  #define PIN(x) asm volatile("":"+v"(x))
  #define MX3(a,b,c) __builtin_fmaxf(__builtin_fmaxf((a),(b)),(c))
  #define GAPA(MF,A0,A1,A2,A3,W0,W1,PW) do{ MF; sacc+=A0; sacc+=A1; sacc+=A2; sacc+=A3; PIN(sacc); W0; W1; PIN(PW); SBAR(); }while(0)
  #define EX(v) __builtin_amdgcn_exp2f(v)
  #define GAPB(MF,X,B) do{ MF; X[B]=EX(X[B]); X[B+1]=EX(X[B+1]); X[B+2]=EX(X[B+2]); X[B+3]=EX(X[B+3]); PIN(X); SBAR(); }while(0)
  #define VRD(i) do{ vlo[i]=vtr(vp_+(((i)>>2)*4096+((i)&3)*1024)); vhi[i]=vtr(vp_+(((i)>>2)*4096+((i)&3)*1024+512)); }while(0)
  #define KRD(G,j) do{ if(G){ kload2(kf,kp0+sl_next,j); SBAR(); } }while(0)
  #define STEP(C0,C1,P0,P1,t,GK,GV,GL) do{ SBAR(); \
    const lds_cptr vp_=vp0+sl_prev; \
    VRD(0); SBAR(); float sacc=(P0[0]+P0[1]); \
    GAPA(C0=__builtin_amdgcn_mfma_f32_32x32x16_bf16(kf[0],qr[0],C0,0,0,0), P0[2],P0[3],P0[4],P0[5],     pw0[0]=PKW(P0,0), pw0[1]=PKW(P0,2), pw0); \
    VRD(4); SBAR(); GAPA(C1=__builtin_amdgcn_mfma_f32_32x32x16_bf16(kf[1],qr[0],C1,0,0,0), P0[6],P0[7],P0[8],P0[9],     pw0[2]=PKW(P0,4), pw0[3]=PKW(P0,6), pw0); \
    VRD(1); SBAR(); GAPA(C0=__builtin_amdgcn_mfma_f32_32x32x16_bf16(kf[2],qr[1],C0,0,0,0),   P0[10],P0[11],P0[12],P0[13], pw1[0]=PKW(P0,8), pw1[1]=PKW(P0,10), pw1); \
    VRD(5); SBAR(); GAPA(C1=__builtin_amdgcn_mfma_f32_32x32x16_bf16(kf[3],qr[1],C1,0,0,0),   P0[14],P0[15],P1[0],P1[1],   pw1[2]=PKW(P0,12),pw1[3]=PKW(P0,14), pw1); \
    VRD(2); SBAR(); GAPA(C0=__builtin_amdgcn_mfma_f32_32x32x16_bf16(kf[4],qr[2],C0,0,0,0),   P1[2],P1[3],P1[4],P1[5],     pw2[0]=PKW(P1,0), pw2[1]=PKW(P1,2), pw2); \
    VRD(6); SBAR(); GAPA(C1=__builtin_amdgcn_mfma_f32_32x32x16_bf16(kf[5],qr[2],C1,0,0,0),   P1[6],P1[7],P1[8],P1[9],     pw2[2]=PKW(P1,4), pw2[3]=PKW(P1,6), pw2); \
    VRD(3); SBAR(); GAPA(C0=__builtin_amdgcn_mfma_f32_32x32x16_bf16(kf[6],qr[3],C0,0,0,0),   P1[10],P1[11],P1[12],P1[13], pw3[0]=PKW(P1,8), pw3[1]=PKW(P1,10), pw3); \
    VRD(7); SBAR(); GAPA(C1=__builtin_amdgcn_mfma_f32_32x32x16_bf16(kf[7],qr[3],C1,0,0,0),   P1[14],P1[15],0.f,0.f,       pw3[2]=PKW(P1,12),pw3[3]=PKW(P1,14), pw3); \
    l_reg+=sacc; \
    if(GK){DMA_K((t)+3,sl_cur);} if(GV){DMA_V((t)+1,sl_next);} \
    CMASK(C0,C1,t); \
    { float a=MX3(C0[0],C0[1],C1[0]),b=MX3(C0[2],C0[3],C1[1]); a=MX3(a,C1[2],C1[3]); \
      _Pragma("unroll") for(int r=4;r<16;r+=4){a=MX3(a,C0[r],C0[r+1]);b=MX3(b,C0[r+2],C0[r+3]);a=MX3(a,C1[r],C1[r+1]);b=MX3(b,C1[r+2],C1[r+3]);} \
      float rm=__builtin_fmaxf(a,b); { auto rr=__builtin_amdgcn_permlane32_swap(__float_as_uint(rm),__float_as_uint(rm),false,false); rm=__builtin_fmaxf(__uint_as_float(rr[0]),__uint_as_float(rr[1])); } \
      resc=false; \
      if(__builtin_expect(__any(rm>(float)THRL),0)){ const float dl=__builtin_fmaxf(rm,0.f); mhat+=dl; \
        _Pragma("unroll") for(int r=0;r<16;++r){C0[r]-=dl;C1[r]-=dl;} \
        const float f=__builtin_amdgcn_exp2f(-dl); l_reg*=f; if(hi==0)wsf[r32]=f; resc=true; } } \
    SBAR(); \
    GAPB(o[0]=__builtin_amdgcn_mfma_f32_32x32x16_bf16(PAF(0),VFR(0),o[0],0,0,0), C0,0); \
    GAPB(o[1]=__builtin_amdgcn_mfma_f32_32x32x16_bf16(PAF(0),VFR(4),o[1],0,0,0), C0,4); \
    KRD(GL,0); GAPB(o[0]=__builtin_amdgcn_mfma_f32_32x32x16_bf16(PAF(1),VFR(1),o[0],0,0,0), C0,8); \
    KRD(GL,1); GAPB(o[1]=__builtin_amdgcn_mfma_f32_32x32x16_bf16(PAF(1),VFR(5),o[1],0,0,0), C0,12); \
    KRD(GL,2); GAPB(o[0]=__builtin_amdgcn_mfma_f32_32x32x16_bf16(PAF(2),VFR(2),o[0],0,0,0), C1,0); \
    KRD(GL,3); GAPB(o[1]=__builtin_amdgcn_mfma_f32_32x32x16_bf16(PAF(2),VFR(6),o[1],0,0,0), C1,4); \
    GAPB(o[0]=__builtin_amdgcn_mfma_f32_32x32x16_bf16(PAF(3),VFR(3),o[0],0,0,0), C1,8); \
    GAPB(o[1]=__builtin_amdgcn_mfma_f32_32x32x16_bf16(PAF(3),VFR(7),o[1],0,0,0), C1,12); \
    if(GL){ PRELOAD(P0,P1,(t)+1); } \
    }while(0)
  int t=1;
  #undef CMASK
  #define CMASK(P0,P1,t) do{}while(0)
  for(;t+5<NT;t+=2){
    STEP(pB0,pB1,pA0,pA1,t,true,true,true);     WAIT_BAR(2); RESC(); ROT();
    STEP(pA0,pA1,pB0,pB1,t+1,true,true,true);   WAIT_BAR(2); RESC(); ROT();
  }
  #undef CMASK
  #define CMASK(P0,P1,t) do{int jb_=(t)-(NT-4); if(jb_>=0)cmask(P0,P1,jb_,qrel,hi);}while(0)
  #define ENDW(tt) do{ if((tt)+3<NT){WAIT_BAR(2);} else if((tt)+2<NT){WAIT_BAR(1);} else {WAIT_BAR(0);} }while(0)
  for(;t+1<NT;t+=2){
    STEP(pB0,pB1,pA0,pA1,t,(t+3<NT),(t+1<NT),(t+1<NT));       ENDW(t);   RESC(); ROT();
    STEP(pA0,pA1,pB0,pB1,t+1,(t+4<NT),(t+2<NT),(t+2<NT));     ENDW(t+1); RESC(); ROT();
  }
  STEP(pB0,pB1,pA0,pA1,NT-1,false,false,false); RESC();
  { float sacc=pB0[0]+pB0[1]; _Pragma("unroll") for(int r=2;r<16;++r)sacc+=pB0[r]; _Pragma("unroll") for(int r=0;r<16;++r)sacc+=pB1[r]; l_reg+=sacc;
    pw0=(u32x4){PKW(pB0,0),PKW(pB0,2),PKW(pB0,4),PKW(pB0,6)};pw1=(u32x4){PKW(pB0,8),PKW(pB0,10),PKW(pB0,12),PKW(pB0,14)};pw2=(u32x4){PKW(pB1,0),PKW(pB1,2),PKW(pB1,4),PKW(pB1,6)};pw3=(u32x4){PKW(pB1,8),PKW(pB1,10),PKW(pB1,12),PKW(pB1,14)};
    SBAR(); pv(o,vb0+sl_cur,PAF(0),PAF(1),PAF(2),PAF(3)); }
  #undef PKW
  #undef PAF
  #undef VFR
  #undef PIN
  #undef MX3
  #undef GAPA
  #undef GAPB
  #undef EX
  #undef VRD
  #undef KRD
  #undef STEP
  #undef ENDW
  {auto rr=__builtin_amdgcn_permlane32_swap(__float_as_uint(l_reg),__float_as_uint(l_reg),false,false);l_reg=__uint_as_float(rr[0])+__uint_as_float(rr[1]);}
  if(hi==0)wsf[32+r32]=l_reg;asm volatile("s_waitcnt lgkmcnt(0)":::"memory");
  float rli[16];
  #pragma unroll
  for(int r=0;r<16;++r)rli[r]=__builtin_amdgcn_rcpf(wsf[32+crow(r,hi)]);
  bf16h*Ow=O+(rowbase+q0+wid*QBLK)*DMO+h*D;
  { bf16h*stg=(bf16h*)(shm+LDS_OST)+wid*2048;
    #pragma unroll
    for(int r=0;r<16;++r){const int orow=crow(r,hi);
      #pragma unroll
      for(int d0=0;d0<2;++d0)stg[orow*64+d0*32+r32]=__float2bfloat16(o[d0][r]*rli[r]);}
    asm volatile("s_waitcnt lgkmcnt(0)":::"memory");
    #pragma unroll
    for(int i=0;i<4;++i){const int row=i*8+(lane>>3),ch=lane&7; const u32x4 v=*(const u32x4*)(stg+row*64+ch*8); *(u32x4*)(Ow+(long)row*DMO+ch*8)=v;} }
  asm volatile("s_waitcnt lgkmcnt(0)\n\ts_barrier":::"memory");
  #undef DMA_K
  #undef DMA_V
  #undef CMASK
  #undef PRELOAD
  #undef START
  #undef RESC
  #undef ROT
}

__device__ __forceinline__ int unit_j0_wave(int bh,int qb,const bf16h*Q,const float*KN2,const float*CL,int lane){
  const int b=bh/NHEAD,h=bh%NHEAD; constexpr int NTT=SEQ/KVBLK;
  float mx=0.f;
  #pragma unroll
  for(int rr=0;rr<QB/64;++rr){ const bf16h*Qw=Q+((long)b*SEQ+qb*QB+rr*64+lane)*DMI+h*D; float ss=0.f;
    #pragma unroll
    for(int c=0;c<8;++c){ const u32x4 v=*reinterpret_cast<const u32x4*>(&Qw[c*8]);
      #pragma unroll
      for(int e=0;e<4;++e){ const float f0=__uint_as_float(v[e]<<16),f1=__uint_as_float(v[e]&0xffff0000u); ss+=f0*f0+f1*f1; } }
    mx=fmaxf(mx,ss); }
  #pragma unroll
  for(int o=1;o<64;o<<=1) mx=fmaxf(mx,__shfl_xor(mx,o));
  const int nt=4*qb; const float*kn=KN2+bh*NTT;
  const float Qn=sqrtf(mx),KNd=sqrtf(fmaxf(fmaxf(kn[nt],kn[nt+1]),fmaxf(kn[nt+2],kn[nt+3])));
  const float clt0=CL[qb*QB];
  int first=nt;
  #pragma unroll
  for(int part=1;part>=0;--part){ const int i=lane+64*part; bool need=false;
    if(i<nt){ const float bound=Qn*(sqrtf(kn[i])+KNd)+clt0-CL[KVBLK*i+KVBLK-1]; need=!(bound<-40.f); }
    const unsigned long long bal=__ballot(need); if(bal) first=__ffsll((long long)bal)-1+64*part; }
  return (first<nt?first:nt)&~1;
}
#undef SBAR
#undef WAIT_BAR
}

#define GAS __attribute__((address_space(1)))
#define LAS __attribute__((address_space(3)))
typedef unsigned v4u __attribute__((ext_vector_type(4)));
typedef float f32x4 __attribute__((ext_vector_type(4)));
typedef GAS unsigned gu32;
#define RLX_AGENT __ATOMIC_RELAXED, __HIP_MEMORY_SCOPE_AGENT
#define LDS_WAIT() asm volatile("s_waitcnt lgkmcnt(0)" ::: "memory")
#define VM_WAIT() asm volatile("s_waitcnt vmcnt(0)" ::: "memory")
__device__ __forceinline__ unsigned pk2(float lo, float hi) { return (unsigned)f2bf(lo) | ((unsigned)f2bf(hi) << 16); }
__device__ __forceinline__ void unpack8(const v4u w, float* f) {
#pragma unroll
    for (int i = 0; i < 4; ++i) { f[2 * i] = __uint_as_float(w[i] << 16); f[2 * i + 1] = __uint_as_float(w[i] & 0xffff0000u); }
}

#define XB_TMO      128
#define XB_XCNT(j)  (256  + 64 * (j))
#define XB_XSUB(j)  (1280 + 64 * (j))
#define XB_XGEN(j)  (2304 + 64 * (j))
#define XB_TOP      3328
#define XB_TOPGEN   3392
#define XCD_BAR_WORDS 3456
#define XB_SPIN_CAP (1u << 18)
__device__ __forceinline__ unsigned xb_ld(unsigned* p)              { return __hip_atomic_load(p, __ATOMIC_RELAXED, __HIP_MEMORY_SCOPE_AGENT); }
__device__ __forceinline__ unsigned xb_add(unsigned* p, unsigned v) { return __hip_atomic_fetch_add(p, v, __ATOMIC_RELAXED, __HIP_MEMORY_SCOPE_AGENT); }
__device__ __forceinline__ unsigned xb_xcc_id() { return (unsigned)__builtin_amdgcn_s_getreg((3 << 11) | 20) & 0xFu; }
#define XB_SPIN(cond, bar) do { unsigned _sp = 0; while (cond) { __builtin_amdgcn_s_sleep(1); \
    if ((++_sp & 255u) == 0u) { if (xb_ld(&(bar)[XB_TMO])) break; if (_sp > XB_SPIN_CAP) { atomicAdd(&(bar)[XB_TMO], 1u); break; } } } } while (0)
struct XcdBarrier { unsigned* bar; unsigned x; volatile LAS unsigned* st; };
__device__ __forceinline__ XcdBarrier xcd_barrier_post(unsigned* bar, volatile LAS unsigned* st) {
    XcdBarrier b; b.bar = bar; b.x = xb_xcc_id(); b.st = st;
    if (threadIdx.x == 0) (void)xb_add(&bar[XB_XCNT(b.x)], 1u);
    return b;
}
__device__ __forceinline__ void xcd_barrier_complete(unsigned* bar, unsigned x, unsigned& nloc, unsigned& nx) {
    const unsigned G = gridDim.x * gridDim.y * gridDim.z;
    unsigned sum, cnt, mine, sp = 0u;
    for (;;) {
        sum = 0u; cnt = 0u; mine = 0u;
#pragma unroll
        for (unsigned j = 0; j < 16; ++j) { const unsigned c = xb_ld(&bar[XB_XCNT(j)]); sum += c; cnt += (c > 0u) ? 1u : 0u; mine = (j == x) ? c : mine; }
        if (sum == G) break;
        __builtin_amdgcn_s_sleep(1);
        if ((++sp & 255u) == 0u) { if (xb_ld(&bar[XB_TMO])) break; if (sp > XB_SPIN_CAP) { atomicAdd(&bar[XB_TMO], 1u); break; } }
    }
    nloc = mine > 0u ? mine : 1u; nx = cnt > 0u ? cnt : 1u;
}
__device__ __forceinline__ void xcd_barrier(const XcdBarrier& b) {
    asm volatile("s_waitcnt vmcnt(0)" ::: "memory");
    __syncthreads();
    if (threadIdx.x == 0) {
        unsigned* bar = b.bar;
        __builtin_amdgcn_s_waitcnt(0);
        unsigned nloc = b.st[0], nx = b.st[1];
        if (nloc == 0u) { xcd_barrier_complete(bar, b.x, nloc, nx); b.st[0] = nloc; b.st[1] = nx; }
        const unsigned old = xb_add(&bar[XB_XSUB(b.x)], 1u);
        const unsigned gen = old / nloc;
        if (old + 1u == (gen + 1u) * nloc) {
            __builtin_amdgcn_fence(__ATOMIC_RELEASE, "agent");
            asm volatile("s_waitcnt vmcnt(0)" ::: "memory");
            const unsigned og = xb_add(&bar[XB_TOP], 1u);
            const unsigned tg = og / nx;
            if (og + 1u == (tg + 1u) * nx) xb_add(&bar[XB_TOPGEN], 1u);
            else XB_SPIN(xb_ld(&bar[XB_TOPGEN]) == tg, bar);
            __builtin_amdgcn_fence(__ATOMIC_ACQUIRE, "agent");
            xb_add(&bar[XB_XGEN(b.x)], 1u);
            asm volatile("s_waitcnt vmcnt(0)" ::: "memory");
        } else {
            XB_SPIN(xb_ld(&bar[XB_XGEN(b.x)]) == gen, bar);
            __builtin_amdgcn_fence(__ATOMIC_ACQUIRE, "agent");
            asm volatile("s_waitcnt vmcnt(0)" ::: "memory");
        }
    }
    __syncthreads();
}


namespace xat {
typedef short bf16x8 __attribute__((ext_vector_type(8)));
typedef short s16x4 __attribute__((ext_vector_type(4)));
typedef float f32x16 __attribute__((ext_vector_type(16)));
constexpr int RB = 272;
constexpr int KIMG = 0, VIMG = 128 * RB, LDS_BYTES = 2 * 128 * RB;
__device__ __forceinline__ unsigned cvtpk(float lo, float hi) { typedef float f2 __attribute__((ext_vector_type(2))); typedef __bf16 b2 __attribute__((ext_vector_type(2))); f2 v = {lo, hi}; b2 b = __builtin_convertvector(v, b2); return __builtin_bit_cast(unsigned, b); }
__device__ __forceinline__ float swapmax(float m) { auto rr = __builtin_amdgcn_permlane32_swap(__float_as_uint(m), __float_as_uint(m), false, false); return fmaxf(__uint_as_float(rr[0]), __uint_as_float(rr[1])); }
__device__ __forceinline__ float swapadd(float m) { auto rr = __builtin_amdgcn_permlane32_swap(__float_as_uint(m), __float_as_uint(m), false, false); return __uint_as_float(rr[0]) + __uint_as_float(rr[1]); }
__device__ __forceinline__ void unit(int b, int head, int qb, const bf16* QX, const bf16* KX, const bf16* VT, bf16* OX, LAS unsigned char* lds) {
    int tid = threadIdx.x; asm volatile("" : "+v"(tid));
    const int lane = tid & 63, r32 = lane & 31, h = lane >> 5, wid = tid >> 6;
    const size_t qrow = (size_t)b * SEQ + (size_t)qb * 256 + wid * 32 + r32;
    bf16x8 qf[8];
#pragma unroll
    for (int d0 = 0; d0 < 8; ++d0) qf[d0] = *(const bf16x8*)(QX + qrow * 512 + head * 128 + 16 * d0 + 8 * h);
    f32x16 o[4];
#pragma unroll
    for (int db = 0; db < 4; ++db) o[db] = (f32x16){};
    float mrun = -INFINITY, lsum = 0.f;
#pragma unroll 1
    for (int half = 0; half < 2; ++half) {
        __syncthreads();
#pragma unroll
        for (int i = 0; i < 4; ++i) { const int c = tid + 512 * i, row = c >> 4, ch = c & 15;
            const v4u kv = *(const GAS v4u*)(KX + ((size_t)b * NMEM + half * 128 + row) * 512 + head * 128 + ch * 8);
            const v4u vv = *(const GAS v4u*)(VT + ((size_t)head * 128 + row) * 512 + b * NMEM + half * 128 + ch * 8);
            *(LAS v4u*)(lds + KIMG + row * RB + ch * 16) = kv; *(LAS v4u*)(lds + VIMG + row * RB + ch * 16) = vv; }
        __syncthreads();
        f32x16 st[4];
#pragma unroll
        for (int kb = 0; kb < 4; ++kb) { st[kb] = (f32x16){};
#pragma unroll
            for (int d0 = 0; d0 < 8; ++d0) { const bf16x8 a = *(const LAS bf16x8*)(lds + KIMG + (32 * kb + r32) * RB + (16 * d0 + 8 * h) * 2);
                st[kb] = __builtin_amdgcn_mfma_f32_32x32x16_bf16(a, qf[d0], st[kb], 0, 0, 0); } }
        float mloc = st[0][0];
#pragma unroll
        for (int kb = 0; kb < 4; ++kb)
#pragma unroll
            for (int i = 0; i < 16; ++i) mloc = fmaxf(mloc, st[kb][i]);
        const float mnew = fmaxf(mrun, swapmax(mloc)), alpha = __builtin_amdgcn_exp2f(mrun - mnew);
        float psum = 0.f;
#pragma unroll
        for (int kb = 0; kb < 4; ++kb)
#pragma unroll
            for (int i = 0; i < 16; ++i) { st[kb][i] = __builtin_amdgcn_exp2f(st[kb][i] - mnew); psum += st[kb][i]; }
        lsum = lsum * alpha + psum; mrun = mnew;
#pragma unroll
        for (int db = 0; db < 4; ++db)
#pragma unroll
            for (int i = 0; i < 16; ++i) o[db][i] *= alpha;
#pragma unroll
        for (int kb = 0; kb < 4; ++kb)
#pragma unroll
            for (int sp = 0; sp < 2; ++sp) {
                v4u pw; pw.x = cvtpk(st[kb][8 * sp], st[kb][8 * sp + 1]); pw.y = cvtpk(st[kb][8 * sp + 2], st[kb][8 * sp + 3]); pw.z = cvtpk(st[kb][8 * sp + 4], st[kb][8 * sp + 5]); pw.w = cvtpk(st[kb][8 * sp + 6], st[kb][8 * sp + 7]);
                const bf16x8 pb = __builtin_bit_cast(bf16x8, pw);
#pragma unroll
                for (int db = 0; db < 4; ++db) { const LAS unsigned char* vp = lds + VIMG + (32 * db + r32) * RB + (32 * kb + 16 * sp + 4 * h) * 2;
                    const s16x4 lo = *(const LAS s16x4*)vp, hi = *(const LAS s16x4*)(vp + 16);
                    const bf16x8 va = {lo[0], lo[1], lo[2], lo[3], hi[0], hi[1], hi[2], hi[3]};
                    o[db] = __builtin_amdgcn_mfma_f32_32x32x16_bf16(va, pb, o[db], 0, 0, 0); } }
    }
    const float inv = 1.f / swapadd(lsum);
    bf16* orow = OX + qrow * 512 + head * 128;
#pragma unroll
    for (int db = 0; db < 4; ++db)
#pragma unroll
        for (int g = 0; g < 4; ++g) {
            const unsigned long long w = (unsigned long long)cvtpk(o[db][4 * g] * inv, o[db][4 * g + 1] * inv) | ((unsigned long long)cvtpk(o[db][4 * g + 2] * inv, o[db][4 * g + 3] * inv) << 32);
            *(GAS unsigned long long*)(orow + 32 * db + 8 * g + 4 * h) = w; }
}
}


namespace mls {
typedef short bf16x8 __attribute__((ext_vector_type(8)));
typedef short s16x4 __attribute__((ext_vector_type(4)));
typedef float f32x16 __attribute__((ext_vector_type(16)));
constexpr int RB = 128, VIMG = 0, KIMG = 8192, ATAB = 8192, NTAB = 8448;
__device__ __forceinline__ s16x4 trd(const LAS unsigned char* p) { typedef short v4i16_t __attribute__((ext_vector_type(4))); return __builtin_bit_cast(s16x4, __builtin_amdgcn_ds_read_tr16_b64_v4i16((LAS v4i16_t*)p)); }
__device__ __forceinline__ bf16x8 cat8(s16x4 lo, s16x4 hi) { return (bf16x8){lo[0], lo[1], lo[2], lo[3], hi[0], hi[1], hi[2], hi[3]}; }
__device__ __forceinline__ unsigned cvtpk(float lo, float hi) { typedef float f2 __attribute__((ext_vector_type(2))); typedef __bf16 b2 __attribute__((ext_vector_type(2))); f2 v = {lo, hi}; b2 b = __builtin_convertvector(v, b2); return __builtin_bit_cast(unsigned, b); }
__device__ __forceinline__ bf16x8 pack8(const float* f) { v4u w; w.x = cvtpk(f[0], f[1]); w.y = cvtpk(f[2], f[3]); w.z = cvtpk(f[4], f[5]); w.w = cvtpk(f[6], f[7]); return __builtin_bit_cast(bf16x8, w); }
__device__ __forceinline__ float swapadd(float m) { auto rr = __builtin_amdgcn_permlane32_swap(__float_as_uint(m), __float_as_uint(m), false, false); return __uint_as_float(rr[0]) + __uint_as_float(rr[1]); }
__device__ __forceinline__ int crow(int r, int hi) { return (r & 3) + 8 * (r >> 2) + 4 * hi; }

__device__ __forceinline__ void u_unit(const Ptrs& P, int bhk, LAS unsigned char* wl, int lane) {
    const int bh = bhk / NCH, k = bhk % NCH, b = bh / MH, hd = bh % MH; const size_t row0 = (size_t)b * SEQ + (size_t)k * 64;
    const int r32 = lane & 31, h = lane >> 5;
    const float li = WSP(const float, WS_GATE)[(size_t)hd * M + row0 + lane], bl = WSP(const float, WS_BL)[(size_t)bh * SEQ + k * 64 + lane];
    const float wg = __expf(WSP(const float, WS_BT)[bhk] - bl + li - WSP(const float, WS_MS)[bh * (NCH + 1) + k + 1]);
    const bf16* vsrc = WSP(const bf16, R_T0 + SZ_T) + row0 * 512 + hd * 64; const bf16* ksrc = WSP(const bf16, R_MQK) + row0 * 512 + 256 + hd * 64;
#pragma unroll
    for (int i = 0; i < 8; ++i) { const int row = i * 8 + (lane >> 3), ch = lane & 7;
        *(LAS v4u*)(wl + VIMG + row * RB + ch * 16) = *(const GAS v4u*)(vsrc + (size_t)row * 512 + ch * 8);
        const v4u kk = *(const GAS v4u*)(ksrc + (size_t)row * 512 + ch * 8); float f[8]; unpack8(kk, f); const float w = __shfl(wg, row);
#pragma unroll
        for (int e = 0; e < 8; ++e) f[e] *= w;
        *(LAS bf16x8*)(wl + KIMG + row * RB + ch * 16) = pack8(f); }
    f32x16 acc[2][2];
#pragma unroll
    for (int a = 0; a < 2; ++a)
#pragma unroll
        for (int c = 0; c < 2; ++c) acc[a][c] = (f32x16){};
    const unsigned toff = (unsigned)(((lane & 15) >> 2) * RB + (16 * ((lane >> 4) & 1) + 4 * (lane & 3)) * 2);
#pragma unroll
    for (int st = 0; st < 4; ++st) { bf16x8 af[2], bf_[2];
#pragma unroll
        for (int c = 0; c < 2; ++c) { const LAS unsigned char* pv = wl + VIMG + (16 * st + 8 * h) * RB + toff + 64 * c; af[c] = cat8(trd(pv), trd(pv + 4 * RB));
                                      const LAS unsigned char* pk = wl + KIMG + (16 * st + 8 * h) * RB + toff + 64 * c; bf_[c] = cat8(trd(pk), trd(pk + 4 * RB)); }
#pragma unroll
        for (int jb = 0; jb < 2; ++jb)
#pragma unroll
            for (int ib = 0; ib < 2; ++ib) acc[jb][ib] = __builtin_amdgcn_mfma_f32_32x32x16_bf16(af[jb], bf_[ib], acc[jb][ib], 0, 0, 0); }
    float* UT = WSP(float, R_CST) + (size_t)bhk * 4096;
#pragma unroll
    for (int jb = 0; jb < 2; ++jb)
#pragma unroll
        for (int ib = 0; ib < 2; ++ib)
#pragma unroll
            for (int e = 0; e < 16; ++e) UT[(32 * jb + crow(e, h)) * 64 + 32 * ib + r32] = acc[jb][ib][e];
    float sn = 0.f;
#pragma unroll 8
    for (int r = 0; r < 64; ++r) sn += bf2f(*(const LAS bf16*)(wl + KIMG + r * RB + lane * 2));
    WSP(float, WS_NST)[(size_t)bhk * 64 + lane] = sn;
}

__device__ __forceinline__ void decay_apply(f32x16& tile, int sb, int tb, const LAS float* atab, float mx, float& dsum, int r32, int h) {
#pragma unroll
    for (int g = 0; g < 4; ++g) { const f32x4 av = *(const LAS f32x4*)(atab + 32 * sb + 8 * g + 4 * h);
#pragma unroll
        for (int c = 0; c < 4; ++c) { const int sidx = 32 * sb + 8 * g + 4 * h + c, t = 32 * tb + r32;
            const float w = (sidx <= t) ? __expf(av[c] - mx) : 0.f; tile[4 * g + c] *= w; dsum += tile[4 * g + c]; } }
}
__device__ __forceinline__ bf16x8 packstep(const f32x16& x, int st) { v4u w; w.x = cvtpk(x[8 * st], x[8 * st + 1]); w.y = cvtpk(x[8 * st + 2], x[8 * st + 3]); w.z = cvtpk(x[8 * st + 4], x[8 * st + 5]); w.w = cvtpk(x[8 * st + 6], x[8 * st + 7]); return __builtin_bit_cast(bf16x8, w); }

__device__ __forceinline__ void out_unit(const Ptrs& P, int l, int bhk, LAS unsigned char* wl, int lane) {
    const int bh = bhk / NCH, k = bhk % NCH, b = bh / MH, hd = bh % MH; const size_t row0 = (size_t)b * SEQ + (size_t)k * 64;
    const int r32 = lane & 31, h = lane >> 5;
    const bf16* T1 = WSP(const bf16, R_T0 + SZ_T); const bf16* MQK = WSP(const bf16, R_MQK);
    const bf16* vsrc = T1 + row0 * 512 + hd * 64;
    v4u vreg[8];
#pragma unroll
    for (int i = 0; i < 8; ++i) { const int row = i * 8 + (lane >> 3), ch = lane & 7; vreg[i] = *(const GAS v4u*)(vsrc + (size_t)row * 512 + ch * 8); }
    bf16x8 qf[2][4], kf[2][4];
#pragma unroll
    for (int tb = 0; tb < 2; ++tb)
#pragma unroll
        for (int d0 = 0; d0 < 4; ++d0) { qf[tb][d0] = *(const bf16x8*)(MQK + (row0 + 32 * tb + r32) * 512 + hd * 64 + 16 * d0 + 8 * h);
                                         kf[tb][d0] = *(const bf16x8*)(MQK + (row0 + 32 * tb + r32) * 512 + 256 + hd * 64 + 16 * d0 + 8 * h); }
    const float li_s = WSP(const float, WS_GATE)[(size_t)hd * M + row0 + lane], bl_s = WSP(const float, WS_BL)[(size_t)bh * SEQ + k * 64 + lane];
    const float mk = WSP(const float, WS_MS)[bh * (NCH + 1) + k]; const float nst = WSP(const float, WS_NST)[(size_t)bhk * 64 + lane];
    const float a_s = li_s - bl_s; float pm = a_s;
#pragma unroll
    for (int o = 1; o < 64; o <<= 1) { const float t = __shfl_up(pm, o); if (lane >= o) pm = fmaxf(pm, t); }
    LAS float* atab = (LAS float*)(wl + ATAB); LAS float* ntab = (LAS float*)(wl + NTAB);
    atab[lane] = a_s; ntab[lane] = nst;
    float mx[2], wi[2], blt[2];
#pragma unroll
    for (int tb = 0; tb < 2; ++tb) { const int t = 32 * tb + r32; blt[tb] = __shfl(bl_s, t); mx[tb] = fmaxf(mk, __shfl(pm, t)); wi[tb] = __expf(mk - mx[tb]); }
#pragma unroll
    for (int i = 0; i < 8; ++i) { const int row = i * 8 + (lane >> 3), ch = lane & 7; *(LAS v4u*)(wl + VIMG + row * RB + ch * 16) = vreg[i]; }
    f32x16 s00 = (f32x16){}, s01 = (f32x16){}, s11 = (f32x16){};
#pragma unroll
    for (int d0 = 0; d0 < 4; ++d0) { s00 = __builtin_amdgcn_mfma_f32_32x32x16_bf16(kf[0][d0], qf[0][d0], s00, 0, 0, 0);
        s01 = __builtin_amdgcn_mfma_f32_32x32x16_bf16(kf[0][d0], qf[1][d0], s01, 0, 0, 0); s11 = __builtin_amdgcn_mfma_f32_32x32x16_bf16(kf[1][d0], qf[1][d0], s11, 0, 0, 0); }
    float dsum[2] = {0.f, 0.f};
    decay_apply(s00, 0, 0, atab, mx[0], dsum[0], r32, h); decay_apply(s01, 0, 1, atab, mx[1], dsum[1], r32, h); decay_apply(s11, 1, 1, atab, mx[1], dsum[1], r32, h);
    f32x16 nacc[2][2];
#pragma unroll
    for (int a = 0; a < 2; ++a)
#pragma unroll
        for (int c = 0; c < 2; ++c) nacc[a][c] = (f32x16){};
    const unsigned toff = (unsigned)(((lane & 15) >> 2) * RB + (16 * ((lane >> 4) & 1) + 4 * (lane & 3)) * 2);
#pragma unroll
    for (int sb = 0; sb < 2; ++sb)
#pragma unroll
        for (int st = 0; st < 2; ++st) { bf16x8 va[2];
#pragma unroll
            for (int jb = 0; jb < 2; ++jb) { const LAS unsigned char* pv = wl + VIMG + (32 * sb + 16 * st + 4 * h) * RB + toff + 64 * jb; va[jb] = cat8(trd(pv), trd(pv + 8 * RB)); }
            if (sb == 0) { const bf16x8 p0 = packstep(s00, st), p1 = packstep(s01, st);
#pragma unroll
                for (int jb = 0; jb < 2; ++jb) { nacc[jb][0] = __builtin_amdgcn_mfma_f32_32x32x16_bf16(va[jb], p0, nacc[jb][0], 0, 0, 0); nacc[jb][1] = __builtin_amdgcn_mfma_f32_32x32x16_bf16(va[jb], p1, nacc[jb][1], 0, 0, 0); }
            } else { const bf16x8 p1 = packstep(s11, st);
#pragma unroll
                for (int jb = 0; jb < 2; ++jb) nacc[jb][1] = __builtin_amdgcn_mfma_f32_32x32x16_bf16(va[jb], p1, nacc[jb][1], 0, 0, 0); } }
    const float* CT = WSP(const float, R_CST) + (size_t)bhk * 4096;
    float dint[2] = {0.f, 0.f};
#pragma unroll
    for (int st = 0; st < 4; ++st) { bf16x8 ca[2];
#pragma unroll
        for (int jb = 0; jb < 2; ++jb) { const float* cp = CT + (32 * jb + r32) * 64 + 16 * st + 8 * h; const f32x4 c0 = *(const f32x4*)cp, c1 = *(const f32x4*)(cp + 4);
            const float f[8] = {c0[0], c0[1], c0[2], c0[3], c1[0], c1[1], c1[2], c1[3]}; ca[jb] = pack8(f); }
        const f32x4 n0 = *(const LAS f32x4*)(ntab + 16 * st + 8 * h), n1 = *(const LAS f32x4*)(ntab + 16 * st + 8 * h + 4);
#pragma unroll
        for (int tb = 0; tb < 2; ++tb) { float f[8]; unpack8(__builtin_bit_cast(v4u, qf[tb][st]), f);
            dint[tb] += (f[0] * n0[0] + f[1] * n0[1]) + (f[2] * n0[2] + f[3] * n0[3]) + (f[4] * n1[0] + f[5] * n1[1]) + (f[6] * n1[2] + f[7] * n1[3]);
#pragma unroll
            for (int e = 0; e < 8; ++e) f[e] *= wi[tb];
            const bf16x8 qw = pack8(f);
#pragma unroll
            for (int jb = 0; jb < 2; ++jb) nacc[jb][tb] = __builtin_amdgcn_mfma_f32_32x32x16_bf16(ca[jb], qw, nacc[jb][tb], 0, 0, 0); } }
    const float* nw = P.in[I_MNW] + l * 256 + hd * 64; bf16* CAT = WSP(bf16, R_CAT);
#pragma unroll
    for (int tb = 0; tb < 2; ++tb) {
        const float den = swapadd(dsum[tb]) + wi[tb] * swapadd(dint[tb]);
        const float dinv = 1.f / fmaxf(fabsf(den), __expf(-(blt[tb] + mx[tb])));
        float ss = 0.f;
#pragma unroll
        for (int jb = 0; jb < 2; ++jb)
#pragma unroll
            for (int e = 0; e < 16; ++e) { const float v = nacc[jb][tb][e] * dinv; ss += v * v; }
        const float scale = dinv / sqrtf(swapadd(ss) * (1.f / 64.f) + EPS);
        const size_t row = row0 + 32 * tb + r32;
#pragma unroll
        for (int jb = 0; jb < 2; ++jb)
#pragma unroll
            for (int g = 0; g < 4; ++g) { const int j0 = 32 * jb + 8 * g + 4 * h; const f32x4 nwv = *(const f32x4*)(nw + j0);
                const unsigned long long mo = *(const GAS unsigned long long*)(T1 + row * 512 + 256 + hd * 64 + j0);
                const float m0 = __uint_as_float((unsigned)(mo << 16)), m1 = __uint_as_float((unsigned)mo & 0xffff0000u), m2 = __uint_as_float((unsigned)(mo >> 32) << 16), m3 = __uint_as_float((unsigned)(mo >> 32) & 0xffff0000u);
                const float y0 = nacc[jb][tb][4 * g] * scale * nwv[0] * __builtin_amdgcn_rcpf(1.f + __expf(-m0)), y1 = nacc[jb][tb][4 * g + 1] * scale * nwv[1] * __builtin_amdgcn_rcpf(1.f + __expf(-m1));
                const float y2 = nacc[jb][tb][4 * g + 2] * scale * nwv[2] * __builtin_amdgcn_rcpf(1.f + __expf(-m2)), y3 = nacc[jb][tb][4 * g + 3] * scale * nwv[3] * __builtin_amdgcn_rcpf(1.f + __expf(-m3));
                *(GAS unsigned long long*)(CAT + row * 1024 + hd * 64 + j0) = (unsigned long long)cvtpk(y0, y1) | ((unsigned long long)cvtpk(y2, y3) << 32); }
    }
}
__device__ __forceinline__ void state_scan(const Ptrs& P, long gtid, long gn) {
    const float* DEC = WSP(const float, WS_DEC); float* CST = WSP(float, R_CST); float* NST = WSP(float, WS_NST);
    for (long it = gtid; it < 8 * 4160; it += gn) {
        const int bh = (int)it / 4160, e = (int)it % 4160; float run = 0.f;
        float* base = e < 4096 ? CST + (size_t)bh * NCH * 4096 + e : NST + (size_t)bh * NCH * 64 + (e - 4096); const size_t stride = e < 4096 ? 4096 : 64;
        for (int k0 = 0; k0 < NCH; k0 += 16) { float u[16], d[16];
#pragma unroll
            for (int i = 0; i < 16; ++i) { u[i] = base[(size_t)(k0 + i) * stride]; d[i] = DEC[bh * NCH + k0 + i]; }
#pragma unroll
            for (int i = 0; i < 16; ++i) { base[(size_t)(k0 + i) * stride] = run; run = d[i] * run + u[i]; } }
    }
}
}

constexpr int RING_BYTES = 131072;
constexpr int MISC_OFF = RING_BYTES;
constexpr int PTR_OFF = RING_BYTES + 256;
constexpr int JOB_OFF = RING_BYTES + 512;
constexpr int LDS_BYTES = 147456;
constexpr int NWAVES = 8;

__device__ __forceinline__ float wave_sum(float v) {
#pragma unroll
    for (int o = 1; o < 64; o <<= 1) v += __shfl_xor(v, o);
    return v;
}
struct WJob { const float* W0; const float* W1; const float* rs; bf16* WT; int K, Nsrc, nblk, kind; float cs; int item0; int pad0, pad1; };
constexpr int MAX_JOBS = 32;
__device__ __forceinline__ void p0_transpose_item(const LAS WJob* jb, LAS float* scr, int item, int lane) {
    const int K = jb->K, N = jb->Nsrc, nblk = jb->nblk, kb = item / nblk, nb = item % nblk, k0 = 64 * kb;
    int which, col0; float cs; wmap(jb->kind, nb, which, col0, cs); cs *= jb->cs;
    const float* W = which ? jb->W1 : jb->W0; const float* rs = jb->rs;
    const float* src = W + (size_t)(k0 + (lane >> 5)) * N + col0 + (lane & 31);
    float v[32];
#pragma unroll
    for (int i = 0; i < 32; ++i) v[i] = __builtin_nontemporal_load(src + (size_t)(2 * i) * N);
#pragma unroll
    for (int i = 0; i < 32; ++i) scr[(2 * i + (lane >> 5)) * 33 + (lane & 31)] = v[i];
    LDS_WAIT(); asm volatile("" ::: "memory");
    const int c = lane & 7; bf16* WT = jb->WT;
    f32x4 r0 = {cs, cs, cs, cs}, r1 = r0;
    if (rs) { r0 = *(const f32x4*)(rs + k0 + 8 * c) * cs; r1 = *(const f32x4*)(rs + k0 + 8 * c + 4) * cs; }
#pragma unroll
    for (int j = 0; j < 4; ++j) { const int n = (lane >> 3) + 8 * j; const LAS float* sp = scr + (8 * c) * 33 + n;
        v4u o; o.x = pk2(sp[0 * 33] * r0[0], sp[1 * 33] * r0[1]); o.y = pk2(sp[2 * 33] * r0[2], sp[3 * 33] * r0[3]); o.z = pk2(sp[4 * 33] * r1[0], sp[5 * 33] * r1[1]); o.w = pk2(sp[6 * 33] * r1[2], sp[7 * 33] * r1[3]);
        __builtin_nontemporal_store(o, (GAS v4u*)(WT + (size_t)(nb * 32 + n) * K + k0 + 8 * c)); }
    LDS_WAIT(); asm volatile("" ::: "memory");
}
__device__ __forceinline__ void build_gw(const Ptrs& P, long gtid, long gn) {
    for (long it = gtid; it < 3 * 32 * 64; it += gn) {
        const int t = (int)(it / 2048), ks = (int)((it / 64) % 32), ln = (int)(it % 64), c = ln & 15, quad = ln >> 4;
        float hi[8], lo[8];
#pragma unroll
        for (int j = 0; j < 8; ++j) { const int k = 32 * ks + 8 * quad + j; float w;
            if (t < 2) w = P.in[I_NMIX][t * D + k] * P.in[I_WIN][(size_t)t * D * INW + (size_t)k * INW + (c < 8 ? 1024 + c : 3072 + c)];
            else w = (c < 8) ? P.in[I_NFFN][D + k] * P.in[I_RW][(size_t)k * 8 + c] : 0.f;
            const float h = bf2f(f2bf(w)); hi[j] = h; lo[j] = w - h; }
        v4u oh, ol; oh.x = pk2(hi[0], hi[1]); oh.y = pk2(hi[2], hi[3]); oh.z = pk2(hi[4], hi[5]); oh.w = pk2(hi[6], hi[7]); ol.x = pk2(lo[0], lo[1]); ol.y = pk2(lo[2], lo[3]); ol.z = pk2(lo[4], lo[5]); ol.w = pk2(lo[6], lo[7]);
        v4u* tab = (v4u*)(P.ws + WS_GW + (size_t)t * 65536); tab[(ks * 2 + 0) * 64 + ln] = oh; tab[(ks * 2 + 1) * 64 + ln] = ol;
    }
}
template <int MODE, bool PRE>
__device__ __forceinline__ void norm16(const Ptrs& P, int l, const float* src, bf16* XN, const unsigned* rss_in, int vcu, int G, int wave, int lane, LAS float* xch) {
    typedef short bf16x8 __attribute__((ext_vector_type(8)));
    const int r = lane & 15, quad = lane >> 4, kh = wave >> 2;
    const v4u* tab = (const v4u*)(P.ws + WS_GW + (size_t)(MODE == 2 ? 2 : l) * 65536) + lane;
    if constexpr (MODE == 2) { if (wave == 0 && lane < 8) ((LAS unsigned*)(xch + 2048))[64 * 4 + lane] = 0u; }
    for (int t0 = 0; t0 < M / 16; t0 += 4 * G) {
        const int task = t0 + (wave & 3) * G + vcu; const bool live = task < M / 16; const int r0 = (live ? task : 0) * 16;
        const float* xr = src + (size_t)(r0 + r) * D + 8 * quad; bf16* xo = XN + (size_t)(r0 + r) * D + 8 * quad;
        f32x4 acc = {0.f, 0.f, 0.f, 0.f}; float ss = 0.f;
#pragma unroll
        for (int kk = 0; kk < 16; ++kk) { const int ks = 16 * kh + kk;
            if constexpr (PRE) {
                const v4u h = *(const GAS v4u*)(xo + 32 * ks);
                const bf16x8 ah = __builtin_bit_cast(bf16x8, h);
                const bf16x8 bh = __builtin_bit_cast(bf16x8, tab[(ks * 2 + 0) * 64]), bl = __builtin_bit_cast(bf16x8, tab[(ks * 2 + 1) * 64]);
                acc = __builtin_amdgcn_mfma_f32_16x16x32_bf16(ah, bh, acc, 0, 0, 0); acc = __builtin_amdgcn_mfma_f32_16x16x32_bf16(ah, bl, acc, 0, 0, 0);
            } else {
            const f32x4 a = __builtin_nontemporal_load((const GAS f32x4*)(xr + 32 * ks)), b = __builtin_nontemporal_load((const GAS f32x4*)(xr + 32 * ks + 4));
            ss += (a[0] * a[0] + a[1] * a[1]) + (a[2] * a[2] + a[3] * a[3]) + (b[0] * b[0] + b[1] * b[1]) + (b[2] * b[2] + b[3] * b[3]);
            v4u h; h.x = pk2(a[0], a[1]); h.y = pk2(a[2], a[3]); h.z = pk2(b[0], b[1]); h.w = pk2(b[2], b[3]);
            if (live) *(GAS v4u*)(xo + 32 * ks) = h;
            if constexpr (MODE != 0) {
                float hf[8]; unpack8(h, hf);
                v4u lw; lw.x = pk2(a[0] - hf[0], a[1] - hf[1]); lw.y = pk2(a[2] - hf[2], a[3] - hf[3]); lw.z = pk2(b[0] - hf[4], b[1] - hf[5]); lw.w = pk2(b[2] - hf[6], b[3] - hf[7]);
                const bf16x8 ah = __builtin_bit_cast(bf16x8, h), al = __builtin_bit_cast(bf16x8, lw);
                const bf16x8 bh = __builtin_bit_cast(bf16x8, tab[(ks * 2 + 0) * 64]), bl = __builtin_bit_cast(bf16x8, tab[(ks * 2 + 1) * 64]);
                acc = __builtin_amdgcn_mfma_f32_16x16x32_bf16(ah, bh, acc, 0, 0, 0); acc = __builtin_amdgcn_mfma_f32_16x16x32_bf16(al, bh, acc, 0, 0, 0); acc = __builtin_amdgcn_mfma_f32_16x16x32_bf16(ah, bl, acc, 0, 0, 0);
            }
            }
        }
        { LAS float* xp = xch + ((wave & 3) * 64 + lane) * 5;
          if (kh == 1) { xp[0] = acc[0]; xp[1] = acc[1]; xp[2] = acc[2]; xp[3] = acc[3]; xp[4] = ss; }
          __syncthreads();
          if (kh == 0) { acc[0] += xp[0]; acc[1] += xp[1]; acc[2] += xp[2]; acc[3] += xp[3]; ss += xp[4]; }
          __syncthreads(); }
        if constexpr (MODE != 2) { if (kh == 1 || !live) continue; }
        if (MODE != 2 || (kh == 0 && live)) {
        unsigned sq;
        if constexpr (PRE) sq = rss_in[r0 + r]; else { ss += __shfl_xor(ss, 16); ss += __shfl_xor(ss, 32); sq = (unsigned)(ss * 16.f + 0.5f); if (lane < 16) WSP(unsigned, WS_RSTD)[r0 + lane] = sq; }
        ss = (float)sq * (1.f / 16.f);
        const float rstd = 1.f / sqrtf(ss * (1.f / D) + EPS);
        if constexpr (MODE != 0) {
            float z[4];
#pragma unroll
            for (int j = 0; j < 4; ++j) z[j] = acc[j] * __shfl(rstd, 4 * quad + j);
            if constexpr (MODE == 1) {
                const int g = r; f32x4 o;
#pragma unroll
                for (int j = 0; j < 4; ++j) { if (g < 4) o[j] = z[j] + P.in[I_MBI][l * 4 + g]; else if (g < 8) o[j] = logsigmoidf_(z[j] + P.in[I_MBF][l * 4 + g - 4]); else o[j] = logsigmoidf_(z[j] + P.in[I_FBF][l * 8 + g - 8]); }
                *(f32x4*)(WSP(float, WS_GATE) + (size_t)g * M + r0 + 4 * quad) = o;
            } else {
#pragma unroll
                for (int j = 0; j < 4; ++j) { float le[8];
#pragma unroll
                    for (int e = 0; e < 8; ++e) le[e] = __shfl(z[j], (lane & 48) + e);
                    int e1 = 0; float v1 = le[0];
#pragma unroll
                    for (int e = 1; e < 8; ++e) if (le[e] > v1) { v1 = le[e]; e1 = e; }
                    int e2 = -1; float v2 = -INFINITY;
#pragma unroll
                    for (int e = 0; e < 8; ++e) if (e != e1 && le[e] > v2) { v2 = le[e]; e2 = e; }
                    if (r == j) { const float g2 = 1.f / (1.f + expf(v1 - v2)), g1 = 1.f - g2;
                        LAS unsigned* sp = (LAS unsigned*)(xch + 2048) + ((wave & 3) * 16 + 4 * quad + j) * 4;
                        sp[0] = (unsigned)e1; sp[1] = (unsigned)e2; sp[2] = __float_as_uint(g1); sp[3] = __float_as_uint(g2); }
                }
            }
        }
        }
        if constexpr (MODE == 2) {
            LAS unsigned* selb = (LAS unsigned*)(xch + 2048); LAS unsigned* hacc = selb + 64 * 4;
            if (!(kh == 0 && live) && wave < 4 && r < 4) selb[((wave & 3) * 16 + 4 * quad + r) * 4] = 255u;
            __syncthreads();
            if (wave == 0) {
                const int w = lane >> 4, e1 = (int)selb[lane * 4], e2 = (int)selb[lane * 4 + 1]; const bool valid = e1 < 8;
                const unsigned long long below = (1ull << lane) - 1ull; int rank1 = 0, rank2 = 0; unsigned mynew = 0u;
#pragma unroll
                for (int e = 0; e < 8; ++e) { const unsigned old_ = hacc[e];
                    const unsigned long long m1 = __ballot(valid && e1 == e), m2 = __ballot(valid && e2 == e); const int c1 = __popcll(m1);
                    if (e1 == e) rank1 = (int)old_ + __popcll(m1 & below);
                    if (e2 == e) rank2 = (int)old_ + c1 + __popcll(m2 & below);
                    if (lane == e) mynew = old_ + (unsigned)(c1 + __popcll(m2)); }
                if (valid) { const int row = (t0 + w * G + vcu) * 16 + (lane & 15); unsigned* tk = WSP(unsigned, WS_TOK) + (size_t)row * 8;
                    tk[0] = (unsigned)e1; tk[1] = (unsigned)rank1; tk[2] = (unsigned)e2; tk[3] = (unsigned)rank2; tk[4] = selb[lane * 4 + 2]; tk[5] = selb[lane * 4 + 3]; }
                if (lane < 8) hacc[lane] = mynew;
            }
            __syncthreads();
        }
    }
    if constexpr (MODE == 2) { if (wave == 0 && lane < 8) WSP(unsigned, WS_BH)[vcu * 8 + lane] = ((LAS unsigned*)(xch + 2048))[64 * 4 + lane]; }
}
template <int MODE>
__device__ __forceinline__ void norm_rows(const Ptrs& P, int l, const float* src, bf16* XN, int nrows, int gw, int ngw, int lane) {
    for (int row = gw; row < nrows; row += ngw) {
        const GAS f32x4* xr = (const GAS f32x4*)(src + (size_t)row * D) + lane;
        f32x4 v[4]; float s2 = 0.f;
#pragma unroll
        for (int j = 0; j < 4; ++j) { v[j] = xr[64 * j]; s2 += (v[j].x * v[j].x + v[j].y * v[j].y) + (v[j].z * v[j].z + v[j].w * v[j].w); }
        const float rstd = 1.f / sqrtf(wave_sum(s2) * (1.f / D) + EPS);
        GAS unsigned long long* o8 = (GAS unsigned long long*)(XN + (size_t)row * D) + lane;
#pragma unroll
        for (int j = 0; j < 4; ++j) o8[64 * j] = (unsigned long long)pk2(v[j].x * rstd, v[j].y * rstd) | ((unsigned long long)pk2(v[j].z * rstd, v[j].w * rstd) << 32);
    }
}

__device__ __forceinline__ float wave_incl_scan(float v, int lane) {
#pragma unroll
    for (int o = 1; o < 64; o <<= 1) { const float t = __shfl_up(v, o); if (lane >= o) v += t; }
    return v;
}
__device__ __forceinline__ float wave_max(float v) {
#pragma unroll
    for (int o = 1; o < 64; o <<= 1) v = fmaxf(v, __shfl_xor(v, o));
    return v;
}
__device__ __forceinline__ void gate_scan_task(const Ptrs& P, int task, LAS float* scr, int tid) {
    const int lane = tid & 63, wave = tid >> 6; const float* GT = WSP(const float, WS_GATE);
    if (task < 16) {
        const int b = task / FH, h = task % FH; constexpr int EPT = SEQ / 512;
        const float* src = GT + (size_t)(8 + h) * M + (size_t)b * SEQ + tid * EPT; float* dst = WSP(float, WS_CF) + (size_t)task * SEQ + tid * EPT;
        float v[EPT]; float run = 0.f;
#pragma unroll
        for (int i = 0; i < EPT; i += 4) { const f32x4 x = *(const f32x4*)(src + i); run += x[0]; v[i] = run; run += x[1]; v[i + 1] = run; run += x[2]; v[i + 2] = run; run += x[3]; v[i + 3] = run; }
        const float wincl = wave_incl_scan(run, lane);
        if (lane == 63) scr[wave] = wincl;
        __syncthreads();
        float offs = wincl - run;
#pragma unroll
        for (int w = 0; w < 8; ++w) if (w < wave) offs += scr[w];
#pragma unroll
        for (int i = 0; i < EPT; i += 4) *(f32x4*)(dst + i) = (f32x4){(offs + v[i]) * LOG2E, (offs + v[i + 1]) * LOG2E, (offs + v[i + 2]) * LOG2E, (offs + v[i + 3]) * LOG2E};
        __syncthreads();
    } else {
        const int bh = task - 16, b = bh / MH, h = bh % MH;
        const float* lfp = GT + (size_t)(4 + h) * M + (size_t)b * SEQ; const float* lip = GT + (size_t)h * M + (size_t)b * SEQ;
        float* BL = WSP(float, WS_BL) + (size_t)bh * SEQ; float* BT = WSP(float, WS_BT) + bh * NCH; float* AK = WSP(float, WS_AK) + bh * NCH; float* MS = WSP(float, WS_MS) + bh * (NCH + 1);
        constexpr int CPW = NCH / 8;
        float lfv[CPW], liv[CPW];
#pragma unroll
        for (int i = 0; i < CPW; ++i) { const int k = wave + 8 * i; lfv[i] = lfp[k * 64 + lane]; liv[i] = lip[k * 64 + lane]; }
#pragma unroll
        for (int i = 0; i < CPW; ++i) { const int k = wave + 8 * i;
            const float bl = wave_incl_scan(lfv[i], lane); BL[k * 64 + lane] = bl;
            const float btot = __shfl(bl, 63); const float a = wave_max(btot - bl + liv[i]);
            if (lane == 0) { BT[k] = btot; AK[k] = a; scr[k] = btot; scr[NCH + k] = a; } }
        __syncthreads();
        if (wave == 0) { float* DEC = WSP(float, WS_DEC) + bh * NCH; constexpr int PL = NCH / 64;
            float f[PL], av[PL]; float run = 0.f;
#pragma unroll
            for (int i = 0; i < PL; ++i) { run += scr[lane * PL + i]; f[i] = run; av[i] = scr[NCH + lane * PL + i]; }
            const float offs = wave_incl_scan(run, lane) - run;
            float pm = -INFINITY; float c[PL];
#pragma unroll
            for (int i = 0; i < PL; ++i) { f[i] += offs; pm = fmaxf(pm, av[i] - f[i]); c[i] = pm; }
            float pin = pm;
#pragma unroll
            for (int o = 1; o < 64; o <<= 1) { const float t = __shfl_up(pin, o); if (lane >= o) pin = fmaxf(pin, t); }
            float pex = __shfl_up(pin, 1); if (lane == 0) pex = -INFINITY;
            float mprev = __shfl_up(fmaxf(0.f, pin) + f[PL - 1], 1); if (lane == 0) mprev = 0.f;
            if (lane == 0) MS[0] = 0.f;
#pragma unroll
            for (int i = 0; i < PL; ++i) { const int k = lane * PL + i; const float mn = f[i] + fmaxf(0.f, fmaxf(pex, c[i]));
                MS[k + 1] = mn; DEC[k] = __expf(scr[k] + mprev - mn); mprev = mn; } }
        __syncthreads();
    }
}
__device__ __forceinline__ void mconv_glu_vec(const Ptrs& P, int l, long gtid, long gn) {
    const bf16* T0 = WSP(const bf16, R_T0); bf16* MQK = WSP(bf16, R_MQK);
    const float* cw = P.in[I_MCW] + l * 4 * 512; const float* cb = P.in[I_MCB] + l * 512;
    for (long it0 = gtid; it0 < (long)M * 64; it0 += 4 * gn) {
        v4u w[4][4]; bool ok[4][4];
#pragma unroll
        for (int r = 0; r < 4; ++r) { const long it = it0 + r * gn; const int ch = (int)(it & 63); const long row = it >> 6; const int t = (int)(row % SEQ), c0 = ch * 8;
#pragma unroll
            for (int j = 0; j < 4; ++j) { ok[r][j] = it < (long)M * 64 && t - 3 + j >= 0; w[r][j] = (v4u){0u, 0u, 0u, 0u}; if (ok[r][j]) w[r][j] = *(const GAS v4u*)(T0 + (size_t)(row - 3 + j) * 512 + c0); } }
#pragma unroll
        for (int r = 0; r < 4; ++r) { const long it = it0 + r * gn; if (it >= (long)M * 64) continue; const int ch = (int)(it & 63); const long row = it >> 6; const int c0 = ch * 8;
            float acc[8];
#pragma unroll
            for (int i = 0; i < 8; ++i) acc[i] = cb[c0 + i];
#pragma unroll
            for (int j = 0; j < 4; ++j) { if (ok[r][j]) { float x[8]; unpack8(w[r][j], x);
#pragma unroll
                    for (int i = 0; i < 8; ++i) acc[i] += cw[j * 512 + c0 + i] * x[i]; } }
            const float sc = (c0 >= 256) ? 0.125f : 1.f; float y[8];
#pragma unroll
            for (int i = 0; i < 8; ++i) y[i] = acc[i] * __builtin_amdgcn_rcpf(1.f + __expf(-acc[i])) * sc;
            v4u o; o.x = pk2(y[0], y[1]); o.y = pk2(y[2], y[3]); o.z = pk2(y[4], y[5]); o.w = pk2(y[6], y[7]);
            *(GAS v4u*)(MQK + (size_t)row * 512 + c0) = o; }
    }
    const bf16* T2 = WSP(const bf16, R_T0 + 2 * SZ_T); bf16* GL = WSP(bf16, R_GL);
    for (long it0 = gtid; it0 < (long)M * 32; it0 += 4 * gn) {
        v4u wa[4], wg[4];
#pragma unroll
        for (int r = 0; r < 4; ++r) { const long it = it0 + r * gn; wa[r] = (v4u){0u, 0u, 0u, 0u}; wg[r] = wa[r];
            if (it < (long)M * 32) { const int c0 = (int)(it & 31) * 8; const long row = it >> 5; wa[r] = *(const GAS v4u*)(T2 + (size_t)row * 512 + c0); wg[r] = *(const GAS v4u*)(T2 + (size_t)row * 512 + 256 + c0); } }
#pragma unroll
        for (int r = 0; r < 4; ++r) { const long it = it0 + r * gn; if (it >= (long)M * 32) continue; const int c0 = (int)(it & 31) * 8; const long row = it >> 5;
            float a[8], g[8]; unpack8(wa[r], a); unpack8(wg[r], g); float y[8];
#pragma unroll
            for (int i = 0; i < 8; ++i) y[i] = a[i] * __builtin_amdgcn_rcpf(1.f + __expf(-g[i]));
            v4u o; o.x = pk2(y[0], y[1]); o.y = pk2(y[2], y[3]); o.z = pk2(y[4], y[5]); o.w = pk2(y[6], y[7]);
            *(GAS v4u*)(GL + (size_t)row * 256 + c0) = o; }
    }
}
__device__ __forceinline__ void cconv_ln_rows(const Ptrs& P, int l, int gw, int ngw, int lane) {
    const bf16* GL = WSP(const bf16, R_GL); bf16* CAT = WSP(bf16, R_CAT);
    const float* cw = P.in[I_CCW] + l * CK * 256 + 4 * lane; const int c0 = 4 * lane;
    const f32x4 cb = *(const f32x4*)(P.in[I_CCB] + l * 256 + c0), lw = *(const f32x4*)(P.in[I_CLW] + l * 256 + c0), lb = *(const f32x4*)(P.in[I_CLB] + l * 256 + c0);
    f32x4 w[CK];
#pragma unroll
    for (int j = 0; j < CK; ++j) w[j] = *(const f32x4*)(cw + j * 256);
    for (int task = gw; task < M / 8; task += ngw) {
        const int r0 = task * 8, t0 = r0 % SEQ;
        unsigned long long x[CK + 7];
#pragma unroll
        for (int i = 0; i < CK + 7; ++i) x[i] = (t0 - (CK - 1) + i >= 0) ? *(const GAS unsigned long long*)(GL + (size_t)(r0 - (CK - 1) + i) * 256 + c0) : 0ull;
        f32x4 acc[8];
#pragma unroll
        for (int o = 0; o < 8; ++o) acc[o] = cb;
#pragma unroll
        for (int i = 0; i < CK + 7; ++i) { const unsigned long long q = x[i];
            const f32x4 xf = {__uint_as_float((unsigned)(q << 16)), __uint_as_float((unsigned)q & 0xffff0000u), __uint_as_float((unsigned)(q >> 32) << 16), __uint_as_float((unsigned)(q >> 32) & 0xffff0000u)};
#pragma unroll
            for (int o = 0; o < 8; ++o) if (i - o >= 0 && i - o < CK) acc[o] += w[i - o] * xf; }
#pragma unroll
        for (int o = 0; o < 8; ++o) {
            const float mean = wave_sum((acc[o][0] + acc[o][1]) + (acc[o][2] + acc[o][3])) * (1.f / 256.f);
            const f32x4 d = acc[o] - mean; const float rstd = 1.f / sqrtf(wave_sum((d[0] * d[0] + d[1] * d[1]) + (d[2] * d[2] + d[3] * d[3])) * (1.f / 256.f) + EPS);
            f32x4 y = d * rstd * lw + lb;
#pragma unroll
            for (int i = 0; i < 4; ++i) y[i] = y[i] * __builtin_amdgcn_rcpf(1.f + __expf(-y[i]));
            *(GAS unsigned long long*)(CAT + (size_t)(r0 + o) * 1024 + 256 + c0) = (unsigned long long)pk2(y[0], y[1]) | ((unsigned long long)pk2(y[2], y[3]) << 32); }
    }
}
__device__ __forceinline__ void fox_keynorms(const Ptrs& P, int gw, int ngw, int lane) {
    const bf16* K = WSP(const bf16, R_T0 + 4 * SZ_T); float* KN2 = WSP(float, WS_KN2); constexpr int NTT = SEQ / 64;
    for (int u = gw; u < BATCH * FH * NTT; u += ngw) { const int bh = u / NTT, tile = u % NTT, b = bh / FH, h = bh % FH;
        const bf16* kr = K + ((size_t)b * SEQ + tile * 64 + lane) * 512 + h * 64; float ss = 0.f;
#pragma unroll
        for (int c = 0; c < 8; ++c) { const v4u v = *(const GAS v4u*)(kr + 8 * c); float f[8]; unpack8(v, f);
#pragma unroll
            for (int e = 0; e < 8; ++e) ss += f[e] * f[e]; }
        ss = wave_max(ss); if (lane == 0) KN2[u] = ss; }
}
__device__ __forceinline__ void moe_gather(const Ptrs& P, int gw, int ngw, int lane, int wave, int vcu, int G, LAS unsigned char* lds) {
    LAS unsigned* base = (LAS unsigned*)lds; LAS unsigned* tot = base + 1024 * 8;
    { const unsigned* BH = WSP(const unsigned, WS_BH); const int per = (G + 63) / 64; unsigned run = 0u;
      for (int k = 0; k < per; ++k) { const int blk = lane * per + k; if (blk < G) run += BH[blk * 8 + wave]; }
      unsigned incl = run;
#pragma unroll
      for (int o = 1; o < 64; o <<= 1) { const unsigned t = __shfl_up(incl, o); if (lane >= o) incl += t; }
      unsigned ex = incl - run;
      for (int k = 0; k < per; ++k) { const int blk = lane * per + k; if (blk < G) { base[blk * 8 + wave] = ex; ex += BH[blk * 8 + wave]; } }
      if (lane == 63) tot[wave] = incl; }
    __syncthreads();
    unsigned* cntg = WSP(unsigned, WS_CTL) + CW_CNT;
    if (vcu == 0 && wave == 0 && lane < 8) cntg[lane] = tot[lane];
    unsigned cnt[8];
#pragma unroll
    for (int e = 0; e < 8; ++e) cnt[e] = tot[e];
    int off[9]; { int o = 0;
#pragma unroll
        for (int e = 0; e < 8; ++e) { off[e] = o; o += ((int)cnt[e] + 255) & ~255; }
        off[8] = o; }
    const bf16* XN = WSP(const bf16, R_XN); bf16* XNS = WSP(bf16, R_XNS);
    for (int row0 = gw; row0 < M; row0 += 4 * ngw) {
        v4u ta[4], a[4], b[4]; unsigned rv[4];
#pragma unroll
        for (int r = 0; r < 4; ++r) { const int row = row0 + r * ngw; if (row < M) { ta[r] = *(const GAS v4u*)(WSP(unsigned, WS_TOK) + (size_t)row * 8);
                const GAS v4u* srcp = (const GAS v4u*)(XN + (size_t)row * D) + lane; a[r] = __builtin_nontemporal_load(srcp); b[r] = __builtin_nontemporal_load(srcp + 64); rv[r] = WSP(const unsigned, WS_RSS)[(size_t)4 * M + row]; } }
#pragma unroll
        for (int r = 0; r < 4; ++r) { const int row = row0 + r * ngw; if (row < M) {
                unsigned* tk = WSP(unsigned, WS_TOK) + (size_t)row * 8;
                const int e1 = (int)ta[r][0], p1 = (int)ta[r][1], e2 = (int)ta[r][2], p2 = (int)ta[r][3];
                int o1 = 0, o2 = 0;
#pragma unroll
                for (int e = 0; e < 8; ++e) { if (e == e1) o1 = off[e]; if (e == e2) o2 = off[e]; }
                const int blk = (row >> 4) % G;
                const int s1 = o1 + (int)base[blk * 8 + e1] + p1, s2 = o2 + (int)base[blk * 8 + e2] + p2;
                if (lane == 0) { tk[6] = (unsigned)s1; tk[7] = (unsigned)s2; WSP(unsigned, WS_RSTDS)[s1] = rv[r]; WSP(unsigned, WS_RSTDS)[s2] = rv[r];
                    const float g1 = __uint_as_float(tk[4]), g2 = __uint_as_float(tk[5]); WSP(float, WS_SLOTG)[s1] = g1; WSP(float, WS_SLOTG)[s2] = -g2; }
                GAS v4u* d1 = (GAS v4u*)(XNS + (size_t)s1 * D) + lane; GAS v4u* d2 = (GAS v4u*)(XNS + (size_t)s2 * D) + lane;
                d1[0] = a[r]; d1[64] = b[r]; d2[0] = a[r]; d2[64] = b[r]; } }
    }
    for (int w = gw; w < 8 * 256; w += ngw) {
        const int e = w >> 8, r = w & 255; int oe = 0, oe1 = 0, ce = 0;
#pragma unroll
        for (int j = 0; j < 8; ++j) if (j == e) { oe = off[j]; oe1 = off[j + 1]; ce = (int)cnt[j]; }
        const int slot = oe + ce + r;
        if (slot < oe1) { GAS v4u* dp = (GAS v4u*)(XNS + (size_t)slot * D) + lane; const v4u z = {0u, 0u, 0u, 0u}; dp[0] = z; dp[64] = z; if (lane == 0) { unsigned zlo = 0u; asm volatile("" : "+v"(zlo)); WSP(unsigned, WS_RSTDS)[slot] = zlo; WSP(float, WS_SLOTG)[slot] = __uint_as_float(zlo); } }
    }
}
__device__ __forceinline__ void moe_combine_final(const Ptrs& P, int gw, int ngw, int lane) {
    const bf16* Y = WSP(const bf16, R_XNS); const float* nw = P.in[I_NFIN];
    for (int row0 = gw; row0 < M; row0 += 4 * ngw) {
        int s1[4], s2[4];
#pragma unroll
        for (int r = 0; r < 4; ++r) { const int row = row0 + r * ngw; const unsigned* tk = WSP(const unsigned, WS_TOK) + (size_t)(row < M ? row : 0) * 8; s1[r] = (int)tk[6]; s2[r] = (int)tk[7]; }
        unsigned long long ya[4][4], yb[4][4];
#pragma unroll
        for (int r = 0; r < 4; ++r) { const GAS unsigned long long* y1 = (const GAS unsigned long long*)(Y + (size_t)s1[r] * D) + lane; const GAS unsigned long long* y2 = (const GAS unsigned long long*)(Y + (size_t)s2[r] * D) + lane;
#pragma unroll
            for (int j = 0; j < 4; ++j) { ya[r][j] = __builtin_nontemporal_load(y1 + 64 * j); yb[r][j] = __builtin_nontemporal_load(y2 + 64 * j); } }
#pragma unroll
        for (int r = 0; r < 4; ++r) { const int row = row0 + r * ngw; if (row < M) {
            GAS f32x4* orow = (GAS f32x4*)(P.xres + (size_t)row * D) + lane;
            f32x4 v[4]; float ssq = 0.f;
#pragma unroll
            for (int j = 0; j < 4; ++j) { const unsigned long long a = ya[r][j], b = yb[r][j];
                v[j].x = bf2f((bf16)(a & 0xffff)) + bf2f((bf16)(b & 0xffff));
                v[j].y = bf2f((bf16)((a >> 16) & 0xffff)) + bf2f((bf16)((b >> 16) & 0xffff));
                v[j].z = bf2f((bf16)((a >> 32) & 0xffff)) + bf2f((bf16)((b >> 32) & 0xffff));
                v[j].w = bf2f((bf16)((a >> 48) & 0xffff)) + bf2f((bf16)((b >> 48) & 0xffff));
                ssq += (v[j].x * v[j].x + v[j].y * v[j].y) + (v[j].z * v[j].z + v[j].w * v[j].w); }
            const float rstd = 1.f / sqrtf(wave_sum(ssq) * (1.f / D) + EPS);
#pragma unroll
            for (int j = 0; j < 4; ++j) { const f32x4 w = *((const f32x4*)nw + lane + 64 * j); __builtin_nontemporal_store(v[j] * rstd * w, orow + 64 * j); } } }
    }
}

#ifndef MK_PER_PHASE
#define MK_PER_PHASE 0
#endif
constexpr int PH_PER_LAYER = 14, N_PHASES = 1 + 2 * PH_PER_LAYER + 1;
__device__ __forceinline__ Ptrs launder(const Ptrs& a) { Ptrs p = a; asm volatile("" : "+s"(p.ws), "+s"(p.xres)); return p; }
struct Args { const float* in[N_IN]; float* xres; unsigned char* ws; int ph_lo, ph_hi; };

__global__ void __launch_bounds__(NWAVES * 64, 2) trunk_fwd(Args args) {
    extern __shared__ __attribute__((aligned(16))) unsigned char lds_raw[];
    LAS unsigned char* lds = (LAS unsigned char*)lds_raw;
    Ptrs P0; P0.in = (const float* const LAS*)(lds + PTR_OFF); P0.xres = args.xres; P0.ws = args.ws;
    const int tid = threadIdx.x, wave0 = __builtin_amdgcn_readfirstlane(tid >> 6);
    const int G0 = gridDim.x; const int bx0 = blockIdx.x; const int vcu0 = (G0 % 8 == 0) ? (bx0 % 8) * (G0 / 8) + bx0 / 8 : bx0;
    volatile LAS unsigned* MISC = (volatile LAS unsigned*)(lds + MISC_OFF);
    if (tid < 64) MISC[tid] = 0u;
    if (tid < N_IN) ((const float* LAS*)(lds + PTR_OFF))[tid] = args.in[tid];
    __syncthreads();
    unsigned* ctl = (unsigned*)(P0.ws + WS_CTL);
    XcdBarrier bar; bar.bar = ctl + CW_BAR; bar.x = 0; bar.st = nullptr;
    if (!MK_PER_PHASE) bar = xcd_barrier_post(ctl + CW_BAR, MISC + 8);
    const int lo = args.ph_lo, hi = args.ph_hi; int ph = 0;
#ifndef SITEMASK
#define SITEMASK 0xffffffffull
#endif
#define SITE(k) ((SITEMASK >> (k)) & 1ull)
#define PH_ON() (ph >= lo && ph < hi)
#define PH_IF(k) if (PH_ON() && SITE(k))
#define PH_CTX() Ptrs P = launder(P0); int tidp = threadIdx.x; asm volatile("" : "+v"(tidp)); int G = G0, bx = bx0, vcu = vcu0, wave = wave0; asm volatile("" : "+s"(G), "+s"(bx), "+s"(vcu), "+s"(wave)); const int gw = vcu * NWAVES + wave, ngw = G * NWAVES; const long gn = (long)G * (NWAVES * 64); const int lane = tidp & 63; const long gtid = (long)bx * (NWAVES * 64) + tidp; (void)lane; (void)gw; (void)gtid; (void)ngw; (void)gn
#define PH_END() do { if (PH_ON() && ph + 1 < hi) { if (!MK_PER_PHASE) { XcdBarrier b2_ = bar; asm volatile("" : "+s"(b2_.bar), "+s"(b2_.x)); xcd_barrier(b2_); } } ++ph; } while (0)

    PH_IF(0) { PH_CTX();
        LAS WJob* jobs = (LAS WJob*)(lds + JOB_OFF);
        if (tid == 0) {
            int nj = 0, item = 0;
#define ADDJOB(W0_, W1_, rs_, dst_, K_, Nsrc_, Ndst_, kind_, cs_) do { LAS WJob* j_ = jobs + nj; j_->W0 = (W0_); j_->W1 = (W1_); j_->rs = (rs_); j_->WT = WSP(bf16, (dst_)); j_->K = (K_); j_->Nsrc = (Nsrc_); \
                j_->nblk = (Ndst_) / 32; j_->kind = (kind_); j_->cs = (cs_); j_->item0 = item; item += ((K_) / 64) * ((Ndst_) / 32); ++nj; } while (0)
            for (int l = 0; l < 2; ++l) {
                const size_t wl = R_WL + (size_t)l * WL_SIZE;
                ADDJOB(P.in[I_WIN] + (size_t)l * D * INW, nullptr, P.in[I_NMIX] + l * D, wl + WL_IN, D, INW, NZ, 1, 1.f);
                ADDJOB(P.in[I_WOUT] + (size_t)l * D * D, nullptr, nullptr, wl + WL_OUT, D, D, D, 0, 1.f);
                ADDJOB(P.in[I_WQ] + (size_t)l * D * 512, nullptr, P.in[I_NXA] + l * D, wl + WL_Q, D, 512, 512, 0, XAT_QS);
                ADDJOB(P.in[I_WKV] + (size_t)l * D * 1024, nullptr, P.in[I_NMEM] + l * D, wl + WL_KV, D, 1024, 1024, 0, 1.f);
                ADDJOB(P.in[I_WO] + (size_t)l * 512 * D, nullptr, nullptr, wl + WL_O, 512, D, D, 0, 1.f);
            }
            ADDJOB(P.in[I_FG], P.in[I_FU], P.in[I_NFFN], R_WGU, D, DFF, 2 * DFF, 2, 1.f);
            ADDJOB(P.in[I_FD], nullptr, nullptr, R_WDN, DFF, D, D, 0, 1.f);
            for (int e = 0; e < NE; ++e) {
                ADDJOB(P.in[I_MG] + (size_t)e * D * DFF, P.in[I_MU] + (size_t)e * D * DFF, P.in[I_NFFN] + D, WS_WMGU + (size_t)e * 2 * DFF * D * 2, D, DFF, 2 * DFF, 2, 1.f);
                ADDJOB(P.in[I_MD] + (size_t)e * DFF * D, nullptr, nullptr, WS_WMD + (size_t)e * D * DFF * 2, DFF, D, D, 0, 1.f);
            }
#undef ADDJOB
            MISC[16] = (unsigned)nj; MISC[17] = (unsigned)item;
        }
        __syncthreads();
        const int nj = (int)MISC[16], nitems = (int)MISC[17];
        LAS float* scr = (LAS float*)(lds + wave * 16384);
        for (int it = gw; it < nitems; it += ngw) {
            int j = 0;
            for (int q = 1; q < nj; ++q) if (jobs[q].item0 <= it) j = q;
            p0_transpose_item(jobs + j, scr, it - jobs[j].item0, lane);
        }
        norm_rows<0>(P, 0, P.in[I_MEM], WSP(bf16, WS_MEMN), BATCH * NMEM, gw, ngw, lane);
        build_gw(P, gtid, gn);
    }
    PH_END();

    for (int l = 0; l < 2; ++l) {
        const size_t wl = R_WL + (size_t)l * WL_SIZE;
        PH_IF(1) { PH_CTX(); if (l == 0) norm16<1, false>(P, l, P.in[I_X], WSP(bf16, R_XN), nullptr, vcu, G, wave, lane, (LAS float*)lds);
            else norm16<1, true>(P, l, nullptr, WSP(bf16, R_XN), WSP(const unsigned, WS_RSS) + (size_t)2 * M, vcu, G, wave, lane, (LAS float*)lds); }
        PH_END();
        PH_IF(2) { PH_CTX();
            for (int task = bx; task < 24; task += G) gate_scan_task(P, task, (LAS float*)lds, tidp);
            { pg8::Gemm g{WSP(const bf16, R_XN), WSP(const bf16, wl + WL_IN), M, NZ, D}; pg8::StaticOrder S; S.init(M, NZ, G, bx);
              pg8::EpiBf16 E{WSP(bf16, R_T0), 512, 512, (size_t)M * 512, (l == 0) ? WSP(const unsigned, WS_RSTD) : WSP(const unsigned, WS_RSS) + (size_t)2 * M};
              pg8::gemm_phase<pg8::EpiBf16, pg8::StaticOrder, true, true>(lds, g, S, E); }
        }
        PH_END();
        PH_IF(3) { PH_CTX(); mconv_glu_vec(P, l, gtid, gn); fox_keynorms(P, gw, ngw, lane); }
        PH_END();
        PH_IF(4) { PH_CTX(); for (int u = wave * G + vcu; u < 8 * NCH; u += ngw) mls::u_unit(P, u, lds + wave * 16384, lane);
            for (int u = (7 - wave) * G + vcu; u < BATCH * FH * fox::NQB; u += ngw) { const int qb = fox::NQB - 1 - u / (BATCH * FH), bh = u % (BATCH * FH);
                const int j0 = fox::unit_j0_wave(bh, qb, (const fox::bf16h*)WSP(bf16, R_T0 + 3 * SZ_T), WSP(const float, WS_KN2), WSP(const float, WS_CF) + (size_t)bh * SEQ, lane); if (lane == 0) WSP(int, WS_J0)[u] = j0; }
            cconv_ln_rows(P, l, gw, ngw, lane); }
        PH_END();
        PH_IF(5) { PH_CTX(); mls::state_scan(P, gtid, gn); }
        PH_END();
        PH_IF(7) { PH_CTX();
            { pg8::Gemm g{WSP(const bf16, WS_MEMN), WSP(const bf16, wl + WL_KV), BATCH * NMEM, 512, D}; pg8::StaticOrder S; S.init(BATCH * NMEM, 512, G, bx);
              pg8::EpiBf16 E{WSP(bf16, WS_KVX) + (size_t)l * 512 * 1024, 512, 0, 0, nullptr};
              pg8::gemm_phase<pg8::EpiBf16, pg8::StaticOrder, true, true>(lds, g, S, E); }
            { pg8::Gemm g{WSP(const bf16, wl + WL_KV) + (size_t)512 * 1024, WSP(const bf16, WS_MEMN), 512, BATCH * NMEM, D}; pg8::StaticOrder S; S.init(512, BATCH * NMEM, G, (bx + G - 4) % G);
              pg8::EpiBf16 E{WSP(bf16, WS_KVX) + (size_t)l * 512 * 1024 + 512 * 512, 512, 0, 0, nullptr};
              pg8::gemm_phase<pg8::EpiBf16, pg8::StaticOrder, true, true>(lds, g, S, E); }
            { static_assert(fox::LDS_BYTES <= RING_BYTES, "fox LDS");
              const fox::bf16h* Q = (const fox::bf16h*)WSP(bf16, R_T0 + 3 * SZ_T); const fox::bf16h* Kp = (const fox::bf16h*)WSP(bf16, R_T0 + 4 * SZ_T); const fox::bf16h* Vp = (const fox::bf16h*)WSP(bf16, R_T0 + 5 * SZ_T);
              fox::bf16h* O = (fox::bf16h*)(WSP(bf16, R_CAT) + 512); const float* CF = WSP(const float, WS_CF);
              for (int it = vcu; it < 8 * NCH / 8; it += G) mls::out_unit(P, l, it * 8 + wave, lds + wave * 16384, lane);
              __syncthreads();
              const int nitems = BATCH * FH * fox::NQB; unsigned* qhead = ctl + CW_FOXQ + 64 * l;
              for (;;) {
                  if (tidp == 0) MISC[24] = __hip_atomic_fetch_add(qhead, 1u, RLX_AGENT);
                  __syncthreads();
                  const int u = (int)MISC[24];
                  __syncthreads();
                  if (u >= nitems) break;
                  const int qb = fox::NQB - 1 - u / (BATCH * FH), bh = u % (BATCH * FH);
                  const int j0 = WSP(const int, WS_J0)[u];
                  fox::attn_unit<8>(bh / FH, bh % FH, qb, j0, Q, Kp, Vp, O, CF + (size_t)bh * SEQ, (char*)lds_raw); } }

 }
        PH_END();
        PH_IF(8) { PH_CTX(); pg8::Gemm g{WSP(const bf16, R_CAT), WSP(const bf16, wl + WL_OUT), M, D, D}; pg8::StaticOrder S; S.init(M, D, G, bx);
            pg8::EpiRes E{WSP(bf16, R_XN), D, WSP(unsigned, WS_RSS) + (size_t)(l ? 3 : 0) * M};
            pg8::gemm_phase<pg8::EpiRes, pg8::StaticOrder, true, true>(lds, g, S, E); }
        PH_END();
        PH_IF(10) { PH_CTX(); pg8::Gemm g{WSP(const bf16, R_XN), WSP(const bf16, wl + WL_Q), M, 512, D}; pg8::StaticOrder S; S.init(M, 512, G, bx);
            pg8::EpiBf16 E{WSP(bf16, R_QX), 512, 0, 0, WSP(const unsigned, WS_RSS) + (size_t)(l ? 3 : 0) * M};
            pg8::gemm_phase<pg8::EpiBf16, pg8::StaticOrder, true, true>(lds, g, S, E); }
        PH_END();
        PH_IF(11) { PH_CTX(); static_assert(xat::LDS_BYTES <= RING_BYTES, "xat LDS");
            const bf16* KXp = WSP(const bf16, WS_KVX) + (size_t)l * 512 * 1024;
            for (int L = vcu; L < BATCH * XH * (SEQ / 256); L += G) { const int qb = L % (SEQ / 256), bhd = L / (SEQ / 256);
                xat::unit(bhd / XH, bhd % XH, qb, WSP(const bf16, R_QX), KXp, KXp + 512 * 512, WSP(bf16, R_OX), lds); } }
        PH_END();
        PH_IF(12) { PH_CTX(); pg8::Gemm g{WSP(const bf16, R_OX), WSP(const bf16, wl + WL_O), M, D, 512}; pg8::StaticOrder S; S.init(M, D, G, bx);
            pg8::EpiRes E{WSP(bf16, R_XN), D, WSP(unsigned, WS_RSS) + (size_t)(l ? 4 : 1) * M};
            pg8::gemm_phase<pg8::EpiRes, pg8::StaticOrder, true, true>(lds, g, S, E); }
        PH_END();
        if (l == 0) {
            PH_IF(14) { PH_CTX(); pg8::Gemm g{WSP(const bf16, R_XN), WSP(const bf16, R_WGU), M, 2 * DFF, D}; pg8::StaticOrder S; S.init(M, 2 * DFF, G, bx);
                pg8::EpiSwiGLU E{WSP(bf16, R_HD), DFF, WSP(const unsigned, WS_RSS) + (size_t)1 * M};
                pg8::gemm_phase<pg8::EpiSwiGLU, pg8::StaticOrder, true, true>(lds, g, S, E); }
            PH_END();
            PH_IF(15) { PH_CTX(); pg8::Gemm g{WSP(const bf16, R_HD), WSP(const bf16, R_WDN), M, D, DFF}; pg8::StaticOrder S; S.init(M, D, G, bx);
                pg8::EpiRes E{WSP(bf16, R_XN), D, WSP(unsigned, WS_RSS) + (size_t)2 * M};
                pg8::gemm_phase<pg8::EpiRes, pg8::StaticOrder, true, true>(lds, g, S, E); }
            PH_END();
            ph += 2;
        } else {
            PH_IF(16) { PH_CTX(); norm16<2, true>(P, l, nullptr, WSP(bf16, R_XN), WSP(const unsigned, WS_RSS) + (size_t)4 * M, vcu, G, wave, lane, (LAS float*)lds); }
            PH_END();
            PH_IF(17) { PH_CTX(); moe_gather(P, gw, ngw, lane, wave, vcu, G, lds); }
            PH_END();
            PH_IF(18) { PH_CTX(); pg8::Gemm g{WSP(const bf16, R_XNS), WSP(const bf16, WS_WMGU), 0, 2 * DFF, D}; pg8::GroupedOrder S; S.init(2 * DFF, G, bx, ctl + CW_CNT, (size_t)2 * DFF * D * 2);
                pg8::EpiSwiGLU E{WSP(bf16, R_HM), DFF, WSP(const unsigned, WS_RSTDS)};
                pg8::gemm_phase<pg8::EpiSwiGLU, pg8::GroupedOrder, true, true>(lds, g, S, E); }
            PH_END();
            PH_IF(19) { PH_CTX(); pg8::Gemm g{WSP(const bf16, R_HM), WSP(const bf16, WS_WMD), 0, D, DFF}; pg8::GroupedTailOrder S; S.init(D, G, bx, ctl + CW_CNT, (size_t)D * DFF * 2, DFF / pg8::BK);
                pg8::EpiMoeOutT E{WSP(bf16, R_XNS), D, WSP(const float, WS_SLOTG), WSP(float, WS_WMGU)  , ctl + CW_TAIL};
                pg8::gemm_phase<pg8::EpiMoeOutT, pg8::GroupedTailOrder, true, true>(lds, g, S, E); }
            PH_END();
        }
    }
    PH_IF(20) { PH_CTX(); moe_combine_final(P, gw, ngw, lane); }
#undef PH_ON
#undef PH_END
}

extern "C" void kernel_launch(void* const* d_in, const int* in_sizes, int n_in, void* d_out, int out_size, void* d_ws, size_t ws_size, hipStream_t stream) {
    static int grid = 0;
    if (grid == 0) {
        if (n_in != N_IN || out_size != M * D || ws_size < WS_END) { fprintf(stderr, "kernel_launch: unexpected shapes (n_in %d, out %d, ws %zu < %zu); nothing launched\n", n_in, out_size, ws_size, (size_t)WS_END); grid = -1; return; }
        int dev = 0, cus = 0, per_cu = 0;
        if (hipGetDevice(&dev) != hipSuccess || hipDeviceGetAttribute(&cus, hipDeviceAttributeMultiprocessorCount, dev) != hipSuccess) { grid = -1; return; }
        if (hipFuncSetAttribute((const void*)trunk_fwd, hipFuncAttributeMaxDynamicSharedMemorySize, LDS_BYTES) != hipSuccess) { fprintf(stderr, "kernel_launch: hipFuncSetAttribute failed\n"); grid = -1; return; }
        if (hipOccupancyMaxActiveBlocksPerMultiprocessor(&per_cu, (const void*)trunk_fwd, NWAVES * 64, LDS_BYTES) != hipSuccess || per_cu < 1) { fprintf(stderr, "kernel_launch: occupancy query says %d\n", per_cu); (void)hipGetLastError(); grid = -1; return; }
        grid = cus;
    }
    if (grid < 0) return;
    (void)in_sizes;
    if (hipMemsetAsync((char*)d_ws + WS_CTL, 0, CTL_ZERO_BYTES, stream) != hipSuccess) return;
    Args a; memset(&a, 0, sizeof(a));
    for (int i = 0; i < N_IN; ++i) a.in[i] = (const float*)d_in[i];
    a.xres = (float*)d_out; a.ws = (unsigned char*)d_ws;
#if MK_PER_PHASE
    for (int p = 0; p < N_PHASES; ++p) { a.ph_lo = p; a.ph_hi = p + 1; hipLaunchKernelGGL(trunk_fwd, dim3(grid), dim3(NWAVES * 64), LDS_BYTES, stream, a); }
#else
    a.ph_lo = 0; a.ph_hi = N_PHASES;
    hipLaunchKernelGGL(trunk_fwd, dim3(grid), dim3(NWAVES * 64), LDS_BYTES, stream, a);
#endif
}
#endif
```

```cpp
#if defined(HOST_EMU)
#include <cmath>
#include <cstring>
#include <cstdint>
#include <cstddef>
#define DEVFN static inline
#define PHFN static inline
#else
#include <hip/hip_runtime.h>
#include <cstdio>
#include <cstdint>
#include <cstring>
#define DEVFN __device__ __forceinline__
#define PHFN __device__ __forceinline__
#endif

#ifndef CFG_SEQ
#define CFG_SEQ 8192
#endif
constexpr int BATCH = 2, SEQ = CFG_SEQ, D = 1024, M = BATCH * SEQ;
constexpr int MH = 4, MCH = 64, NCH = SEQ / MCH;
constexpr int CK = 31;
constexpr int FH = 8;
constexpr int XH = 4, XD = 128, NMEM = 256;
constexpr int DFF = 2816, NE = 8, INW = 3088;
constexpr int NZ = 3072;
constexpr int SLOTS_MAX = 2 * M + NE * 256;
constexpr float EPS = 1e-6f;
constexpr float LOG2E = 1.4426950408889634f;
constexpr float FOX_QS = 0.125f * LOG2E;
constexpr float XAT_QS = 0.08838834764831845f * LOG2E;

enum { I_X = 0, I_MEM, I_NMIX, I_WIN, I_MCW, I_MCB, I_MBI, I_MBF, I_MNW, I_CCW, I_CCB, I_CLW, I_CLB, I_FBF, I_WOUT, I_NXA, I_NMEM, I_WQ, I_WKV, I_WO, I_NFFN,
       I_FG, I_FU, I_FD, I_RW, I_MG, I_MU, I_MD, I_NFIN, N_IN };

typedef unsigned short bf16;
constexpr size_t al4k(size_t x) { return (x + 4095) & ~(size_t)4095; }
constexpr size_t MiB = (size_t)1 << 20;
constexpr size_t WS_CTL = 0, CTL_ZERO_BYTES = 1 * MiB;
constexpr size_t WS_GATE = 1 * MiB;
constexpr size_t WS_CF = WS_GATE + al4k((size_t)M * 16 * 4);
constexpr size_t WS_BL = WS_CF + al4k((size_t)16 * SEQ * 4);
constexpr size_t WS_BT = WS_BL + al4k((size_t)8 * SEQ * 4);
constexpr size_t WS_AK = WS_BT + al4k((size_t)8 * NCH * 4);
constexpr size_t WS_MS = WS_AK + al4k((size_t)8 * NCH * 4);
constexpr size_t WS_DEC = WS_MS + al4k((size_t)8 * (NCH + 1) * 4);
constexpr size_t WS_KN2 = WS_DEC + al4k((size_t)8 * NCH * 4);
constexpr size_t WS_J0 = WS_KN2 + al4k((size_t)16 * (SEQ / 64) * 4);
constexpr size_t WS_BH = WS_J0 + al4k((size_t)16 * (SEQ / 256) * 4);
constexpr size_t WS_NST = WS_BH + al4k((size_t)1024 * 8 * 4);
constexpr size_t WS_TOK = WS_NST + al4k((size_t)8 * NCH * 64 * 4);
constexpr size_t WS_RSTD = WS_TOK + al4k((size_t)M * 32);
constexpr size_t WS_RSTDS = WS_RSTD + al4k((size_t)M * 8);
constexpr size_t WS_SLOTG = WS_RSTDS + al4k((size_t)SLOTS_MAX * 8);
constexpr size_t WS_GW = WS_SLOTG + al4k((size_t)SLOTS_MAX * 4);
constexpr size_t WS_MEMN = WS_GW + 3 * 65536;
constexpr size_t WS_KVX = WS_MEMN + al4k((size_t)512 * 1024 * 2);
constexpr size_t WS_WMGU = WS_KVX + al4k((size_t)2 * 512 * 1024 * 2);
constexpr size_t WS_WMD = WS_WMGU + (size_t)NE * 5632 * 1024 * 2;
constexpr size_t WS_R = al4k(WS_WMD + (size_t)NE * 1024 * 2816 * 2);
constexpr size_t WL_IN = 0, WL_OUT = WL_IN + (size_t)NZ * 1024 * 2, WL_Q = WL_OUT + (size_t)1024 * 1024 * 2, WL_KV = WL_Q + (size_t)512 * 1024 * 2,
                 WL_O = WL_KV + (size_t)1024 * 1024 * 2, WL_SIZE = WL_O + (size_t)1024 * 512 * 2;
constexpr size_t R_WL = WS_R;
constexpr size_t R_WGU = R_WL + 2 * WL_SIZE;
constexpr size_t R_WDN = R_WGU + (size_t)5632 * 1024 * 2;
constexpr size_t R_XN = al4k(R_WDN + (size_t)1024 * 2816 * 2);
constexpr size_t SZ_T = (size_t)M * 512 * 2;
constexpr size_t R_T0 = R_XN + 2 * SZ_T;
constexpr size_t R_MQK = R_T0 + 6 * SZ_T;
constexpr size_t R_CAT = R_MQK + SZ_T;
constexpr size_t R_CST = R_CAT + 2 * SZ_T;
constexpr size_t R_GL = R_CST + (size_t)8 * NCH * 4096 * 4;
constexpr size_t R_HC = R_GL + (size_t)M * 256 * 2;
constexpr size_t R_END1 = R_HC + (size_t)M * 256 * 4;
constexpr size_t R_QX = R_T0, R_OX = R_T0 + SZ_T;
constexpr size_t R_HD = R_T0;
constexpr size_t R_HM = WS_R;
constexpr size_t R_XNS = R_HM + (size_t)SLOTS_MAX * 2816 * 2;
constexpr size_t R_END2 = R_XNS + (size_t)SLOTS_MAX * 1024 * 2;
constexpr size_t WS_END = R_END1 > R_END2 ? R_END1 : R_END2;
static_assert((size_t)M * 2816 * 2 <= 6 * SZ_T, "dense hidden fits T0..T5");
static_assert(R_XN + 2 * SZ_T <= R_XNS, "XN must not overlap the gathered rows");
constexpr int CW_TMO = 0, CW_CNT = 64  , CW_TAIL = 512  , CW_FOXQ = 128  , CW_BAR = 4096;
constexpr size_t WS_RSS = 65536;
static_assert(WS_RSS + (size_t)5 * M * 4 <= CTL_ZERO_BYTES, "RSS arrays inside the zeroed region");

#if defined(HOST_EMU)
struct Ptrs { const float* in[N_IN]; float* xres; unsigned char* ws; };
#else
struct Ptrs { const float* const __attribute__((address_space(3)))* in; float* xres; unsigned char* ws; };
#endif
#define WSP(type, off) ((type*)(P.ws + (off)))

DEVFN float bf2f(bf16 v) { unsigned u = (unsigned)v << 16; float f; memcpy(&f, &u, 4); return f; }
DEVFN bf16 f2bf(float f) { unsigned u; memcpy(&u, &f, 4); return (bf16)((u + 0x7fffu + ((u >> 16) & 1u)) >> 16); }
DEVFN float sigmoidf_(float x) { return 1.f / (1.f + expf(-x)); }
#if defined(HOST_EMU)
DEVFN float logsigmoidf_(float x) { return fminf(x, 0.f) - log1pf(expf(-fabsf(x))); }
#else
DEVFN float logsigmoidf_(float x) { return fminf(x, 0.f) - __logf(1.f + __expf(-fabsf(x))); }
#endif

DEVFN void wmap(int kind, int nb, int& which, int& col0, float& cs) {
    which = 0; cs = 1.f; const int n0 = nb * 32;
    if (kind == 0) { col0 = n0; }
    else if (kind == 1) { col0 = n0 < 1024 ? n0 : n0 + 8; if (n0 >= 1536 && n0 < 2048) cs = FOX_QS; }
    else { const int tile = nb >> 3, w = nb & 7; which = w >> 2; col0 = tile * 128 + (w & 3) * 32; }
}

#if !defined(HOST_EMU)
namespace pg8 {
#define PG8_LAS __attribute__((address_space(3)))
typedef unsigned short bf16_t;
typedef short bf16x8 __attribute__((ext_vector_type(8)));
typedef float f32x4 __attribute__((ext_vector_type(4)));
typedef unsigned u32x4 __attribute__((ext_vector_type(4)));
constexpr int BM = 256, BK = 64, HALF = 128, HTB = HALF * BK * 2, STAGE_BYTES = 8 * HTB, NXCD = 8, WGM = 4;
__host__ __device__ __forceinline__ int lds_byte(int r, int c) { const int st = (r >> 4) * 2 + (c >> 5), rr = r & 15, cc = c & 31, ob = rr * 64 + cc * 2; return st * 1024 + (ob ^ (((ob >> 9) & 1) << 5)); }
__host__ __device__ __forceinline__ void stage_rc(int b, int& R, int& C) { const int st = b / 1024, sb = b % 1024, swz = sb ^ (((sb >> 9) & 1) << 5); R = (st >> 1) * 16 + swz / 64; C = (st & 1) * 32 + (swz % 64) / 2; }
__host__ __device__ __forceinline__ int perm32(int rho) { const int n = rho >> 4, i = rho & 15; return 8 * (i >> 2) + 4 * n + (i & 3); }

struct Unit { int pm, pn; size_t bofs; int nt, ks, ti, s; size_t aofs; };
struct Gemm { const bf16_t* A; const bf16_t* Bt; int M, N, K; };

struct StaticOrder {
    static constexpr bool VAR_K = false;
    int nM, nN, nwg, G, c;
    __device__ void init(int M_, int N_, int G_, int c_) { nM = M_ / BM; nN = N_ / BM; nwg = nM * nN; G = G_; c = c_; }
    __device__ bool next(int i, Unit& u) const {
        const long L = (long)i * G + c; if (L >= nwg) return false;
        int wgid = (int)L; { const int q = nwg / NXCD, r = nwg % NXCD, xcd = wgid % NXCD, off = wgid / NXCD; wgid = (xcd < r ? xcd * (q + 1) : r * (q + 1) + (xcd - r) * q) + off; }
        const int nig = WGM * nN, gid = wgid / nig, fm = gid * WGM, gsz = (nM - fm) < WGM ? (nM - fm) : WGM;
        u.pm = fm + ((wgid % nig) % gsz); u.pn = (wgid % nig) / gsz; u.bofs = 0; return true;
    }
    __device__ __forceinline__ void a_ready(const Unit&) const {}
    __device__ __forceinline__ void done(const Unit&) const {}
};
struct GroupedOrder {
    static constexpr bool VAR_K = false;
    int nM, nN, nwg, G, c; int off[9]; size_t estride;
    __device__ void init(int N_, int G_, int c_, const unsigned* cnt, size_t estride_) {
        int o = 0;
#pragma unroll
        for (int e = 0; e < 8; ++e) { off[e] = o; o += ((int)cnt[e] + 255) & ~255; }
        off[8] = o; nM = o / BM; nN = N_ / BM; nwg = nM * nN; G = G_; c = c_; estride = estride_;
    }
    __device__ bool next(int i, Unit& u) const {
        const long L = (long)i * G + c; if (L >= nwg) return false;
        int wgid = (int)L; { const int q = nwg / NXCD, r = nwg % NXCD, xcd = wgid % NXCD, o2 = wgid / NXCD; wgid = (xcd < r ? xcd * (q + 1) : r * (q + 1) + (xcd - r) * q) + o2; }
        const int nig = WGM * nN, gid = wgid / nig, fm = gid * WGM, gsz = (nM - fm) < WGM ? (nM - fm) : WGM;
        u.pm = fm + ((wgid % nig) % gsz); u.pn = (wgid % nig) / gsz;
        int e = 0;
#pragma unroll
        for (int j = 1; j < 8; ++j) e += (off[j] <= u.pm * BM) ? 1 : 0;
        u.bofs = (size_t)e * estride; return true;
    }
    __device__ __forceinline__ void a_ready(const Unit&) const {}
    __device__ __forceinline__ void done(const Unit&) const {}
};

struct GroupedTailOrder {
    static constexpr bool VAR_K = true;
    int nM, nN, nwg, G, c, nfull, T, s, sh, ntot, NT; int off[9]; size_t estride;
    __device__ __forceinline__ void init(int N_, int G_, int c_, const unsigned* cnt, size_t estride_, int NT_) {
        int o = 0;
#pragma unroll
        for (int e = 0; e < 8; ++e) { off[e] = o; o += ((int)cnt[e] + 255) & ~255; }
        off[8] = o; nM = o / BM; nN = N_ / BM; nwg = nM * nN; G = G_; c = c_; estride = estride_; NT = NT_;
        const int rounds = nwg / G; T = nwg - rounds * G;
        s = (T == 0) ? 1 : (T * 8 <= G ? 8 : (T * 4 <= G ? 4 : (T * 2 <= G ? 2 : 1))); sh = (s == 8) ? 3 : (s >> 1);
        if (s == 1) { nfull = nwg; T = 0; } else nfull = rounds * G;
        ntot = nfull + T * s;
    }
    __device__ __forceinline__ bool next(int i, Unit& u) const {
        const long L = (long)i * G + c; if (L >= ntot) return false;
        int wgid = (int)L, ks = 0, ti = -1;
        if (wgid >= nfull) { const int mu = wgid - nfull; ti = mu >> sh; ks = mu - (ti << sh); wgid = nfull + ti; }
        { const int q = nwg / NXCD, r = nwg % NXCD, xcd = wgid % NXCD, o2 = wgid / NXCD; wgid = (xcd < r ? xcd * (q + 1) : r * (q + 1) + (xcd - r) * q) + o2; }
        const int nig = WGM * nN, gid = wgid / nig, fm = gid * WGM, gsz = (nM - fm) < WGM ? (nM - fm) : WGM;
        u.pm = fm + ((wgid % nig) % gsz); u.pn = (wgid % nig) / gsz;
        int e = 0;
#pragma unroll
        for (int j = 1; j < 8; ++j) e += (off[j] <= u.pm * BM) ? 1 : 0;
        int kt0 = 0, ntu = NT;
        if (ti >= 0) { const int base = (NT >> sh) & ~1, ex = (NT - (base << sh)) >> 1;
            ntu = base + (ks < ex ? 2 : 0); kt0 = ks * base + 2 * (ks < ex ? ks : ex); }
        u.aofs = (size_t)kt0 * BK * 2; u.bofs = (size_t)e * estride + u.aofs; u.nt = ntu; u.ks = ks; u.ti = ti; u.s = s; return true;
    }
    __device__ __forceinline__ void a_ready(const Unit&) const {}
    __device__ __forceinline__ void done(const Unit&) const {}
};

__device__ __forceinline__ unsigned cvt_pk_bf16(float lo, float hi) { unsigned r; asm volatile("v_cvt_pk_bf16_f32 %0, %1, %2" : "=v"(r) : "v"(lo), "v"(hi)); return r; }

struct EpiBf16 {
    static constexpr bool PERM = true, AFTER_DRAIN = false, HAS_PRE = true;
    __device__ __forceinline__ void preload(unsigned (&q)[8], const Unit& u, int wr, int fr) const {
        if (rs) { const __attribute__((address_space(1))) unsigned* rp = (const __attribute__((address_space(1))) unsigned*)rs + u.pm * BM + wr * 64 + fr;
#pragma unroll
            for (int i = 0; i < 8; ++i) q[i] = rp[(i >> 2) * HALF + (i & 3) * 16]; } }
    bf16_t* O; int ldc; int split_cols; size_t split_stride; const unsigned* rs;
    __device__ __forceinline__ void operator()(const f32x4 (&acc)[2][2][4][2], const Unit& u, int wr, int wc, int fr, int fq, const unsigned (&q)[8]) const {
        const int row0 = u.pm * BM + wr * 64 + fr; int colt = u.pn * BM; bf16_t* base = O;
        if (split_cols) { const int t = colt / split_cols; base += (size_t)t * split_stride; colt -= t * split_cols; }
        const int col0 = colt + wc * 32 + 8 * fq;
        float sc[2][4];
#pragma unroll
        for (int ai = 0; ai < 2; ++ai)
#pragma unroll
            for (int m = 0; m < 4; ++m) sc[ai][m] = rs ? rsqrtf((float)q[ai * 4 + m] * (1.f / (16.f * 1024.f)) + 1e-6f) : 1.f;
#pragma unroll
        for (int ai = 0; ai < 2; ++ai)
#pragma unroll
            for (int m = 0; m < 4; ++m) { bf16_t* rowp = base + (size_t)(row0 + ai * HALF + m * 16) * ldc + col0;
#pragma unroll
                for (int bj = 0; bj < 2; ++bj) { const f32x4 v0 = acc[ai][bj][m][0] * sc[ai][m], v1 = acc[ai][bj][m][1] * sc[ai][m];
                    u32x4 w; w.x = cvt_pk_bf16(v0[0], v0[1]); w.y = cvt_pk_bf16(v0[2], v0[3]); w.z = cvt_pk_bf16(v1[0], v1[1]); w.w = cvt_pk_bf16(v1[2], v1[3]);
                    *(u32x4*)(rowp + bj * HALF) = w; } }
    }
};
struct EpiRes {
    static constexpr bool PERM = true, AFTER_DRAIN = false, HAS_PRE = false;
    bf16_t* X; int ldc; unsigned* rss;
    __device__ __forceinline__ void operator()(const f32x4 (&acc)[2][2][4][2], const Unit& u, int wr, int wc, int fr, int fq) const {
        const int row0 = u.pm * BM + wr * 64 + fr, col0 = u.pn * BM + wc * 32 + 8 * fq;
        typedef __attribute__((address_space(1))) u32x4 gu32x4;
        u32x4 b[2][4][2];
#pragma unroll
        for (int ai = 0; ai < 2; ++ai)
#pragma unroll
            for (int m = 0; m < 4; ++m)
#pragma unroll
                for (int bj = 0; bj < 2; ++bj) b[ai][m][bj] = *(const gu32x4*)(X + (size_t)(row0 + ai * HALF + m * 16) * ldc + col0 + bj * HALF);
#pragma unroll
        for (int ai = 0; ai < 2; ++ai)
#pragma unroll
            for (int m = 0; m < 4; ++m) { bf16_t* rowp = X + (size_t)(row0 + ai * HALF + m * 16) * ldc + col0; float ss = 0.f;
#pragma unroll
                for (int bj = 0; bj < 2; ++bj) { float v[8];
#pragma unroll
                    for (int i = 0; i < 4; ++i) { v[2 * i] = __uint_as_float(b[ai][m][bj][i] << 16) + acc[ai][bj][m][i >> 1][(2 * i) & 3]; v[2 * i + 1] = __uint_as_float(b[ai][m][bj][i] & 0xffff0000u) + acc[ai][bj][m][i >> 1][(2 * i + 1) & 3]; }
                    u32x4 w; w.x = cvt_pk_bf16(v[0], v[1]); w.y = cvt_pk_bf16(v[2], v[3]); w.z = cvt_pk_bf16(v[4], v[5]); w.w = cvt_pk_bf16(v[6], v[7]);
                    *(gu32x4*)(rowp + bj * HALF) = w;
#pragma unroll
                    for (int i = 0; i < 8; ++i) ss += v[i] * v[i]; }
                ss += __shfl_xor(ss, 16); ss += __shfl_xor(ss, 32);
                if (fq == 0) __hip_atomic_fetch_add(rss + row0 + ai * HALF + m * 16, (unsigned)(ss * 16.f + 0.5f), __ATOMIC_RELAXED, __HIP_MEMORY_SCOPE_AGENT); }
    }
};
struct EpiMoeOut {
    static constexpr bool PERM = true, AFTER_DRAIN = false, HAS_PRE = false;
    bf16_t* Y; int ldc; const float* sg;
    __device__ __forceinline__ void operator()(const f32x4 (&acc)[2][2][4][2], const Unit& u, int wr, int wc, int fr, int fq) const {
        const int row0 = u.pm * BM + wr * 64 + fr, col0 = u.pn * BM + wc * 32 + 8 * fq;
        typedef __attribute__((address_space(1))) u32x4 gu32x4;
        float g[2][4];
        { const __attribute__((address_space(1))) float* gp = (const __attribute__((address_space(1))) float*)sg + row0;
#pragma unroll
          for (int ai = 0; ai < 2; ++ai)
#pragma unroll
              for (int m = 0; m < 4; ++m) g[ai][m] = gp[ai * HALF + m * 16]; }
        u32x4 b[2][4][2];
#pragma unroll
        for (int ai = 0; ai < 2; ++ai)
#pragma unroll
            for (int m = 0; m < 4; ++m)
#pragma unroll
                for (int bj = 0; bj < 2; ++bj) { b[ai][m][bj] = (u32x4){0u, 0u, 0u, 0u}; if (g[ai][m] > 0.f) b[ai][m][bj] = *(const gu32x4*)(Y + (size_t)(row0 + ai * HALF + m * 16) * ldc + col0 + bj * HALF); }
#pragma unroll
        for (int ai = 0; ai < 2; ++ai)
#pragma unroll
            for (int m = 0; m < 4; ++m) { bf16_t* rowp = Y + (size_t)(row0 + ai * HALF + m * 16) * ldc + col0; const float ga = fabsf(g[ai][m]);
#pragma unroll
                for (int bj = 0; bj < 2; ++bj) { float v[8];
#pragma unroll
                    for (int i = 0; i < 4; ++i) { v[2 * i] = __uint_as_float(b[ai][m][bj][i] << 16) + ga * acc[ai][bj][m][i >> 1][(2 * i) & 3]; v[2 * i + 1] = __uint_as_float(b[ai][m][bj][i] & 0xffff0000u) + ga * acc[ai][bj][m][i >> 1][(2 * i + 1) & 3]; }
                    u32x4 w; w.x = cvt_pk_bf16(v[0], v[1]); w.y = cvt_pk_bf16(v[2], v[3]); w.z = cvt_pk_bf16(v[4], v[5]); w.w = cvt_pk_bf16(v[6], v[7]);
                    *(gu32x4*)(rowp + bj * HALF) = w; } }
    }
};
struct EpiMoeOutT {
    static constexpr bool PERM = true, AFTER_DRAIN = false, HAS_PRE = false;
    bf16_t* Y; int ldc; const float* sg; float* part; unsigned* cnt;
    template <int S> __device__ __forceinline__ void tail_reduce(const Unit& u, int wr, int wc, int fr, int fq, int wid, int lane) const {
        typedef __attribute__((address_space(1))) f32x4 gf32x4;
        typedef __attribute__((address_space(1))) u32x4 gu32x4;
        constexpr int CPS = 8 / S;
        const gf32x4* base = (const gf32x4*)part + ((size_t)(u.ti * S) * 8 + wid) * 2048 + lane;
        const int row0 = u.pm * BM + wr * 64 + fr, col0 = u.pn * BM + wc * 32 + 8 * fq;
#pragma unroll
        for (int cc = 0; cc < CPS; ++cc) {
            const int c8 = u.ks * CPS + cc, ai = c8 >> 2, bj = (c8 >> 1) & 1, mh = c8 & 1;
            f32x4 t[S][4];
#pragma unroll
            for (int o = 0; o < S; ++o)
#pragma unroll
                for (int jj = 0; jj < 4; ++jj) t[o][jj] = base[(size_t)o * 16384 + (c8 * 4 + jj) * 64];
            const int r0 = row0 + ai * HALF + mh * 32;
            float g[2]; u32x4 b[2];
#pragma unroll
            for (int mm = 0; mm < 2; ++mm) g[mm] = ((const __attribute__((address_space(1))) float*)sg)[r0 + mm * 16];
#pragma unroll
            for (int mm = 0; mm < 2; ++mm) { b[mm] = (u32x4){0u, 0u, 0u, 0u}; if (g[mm] > 0.f) b[mm] = *(const gu32x4*)(Y + (size_t)(r0 + mm * 16) * ldc + col0 + bj * HALF); }
#pragma unroll
            for (int jj = 0; jj < 4; ++jj)
#pragma unroll
                for (int o = 1; o < S; ++o) t[0][jj] += t[o][jj];
#pragma unroll
            for (int mm = 0; mm < 2; ++mm) { const float ga = fabsf(g[mm]); float v[8];
#pragma unroll
                for (int i = 0; i < 4; ++i) { v[2 * i] = __uint_as_float(b[mm][i] << 16) + ga * t[0][mm * 2 + (i >> 1)][(2 * i) & 3]; v[2 * i + 1] = __uint_as_float(b[mm][i] & 0xffff0000u) + ga * t[0][mm * 2 + (i >> 1)][(2 * i + 1) & 3]; }
                u32x4 w; w.x = cvt_pk_bf16(v[0], v[1]); w.y = cvt_pk_bf16(v[2], v[3]); w.z = cvt_pk_bf16(v[4], v[5]); w.w = cvt_pk_bf16(v[6], v[7]);
                *(gu32x4*)(Y + (size_t)(r0 + mm * 16) * ldc + col0 + bj * HALF) = w; }
        }
    }
    __device__ __forceinline__ void operator()(const f32x4 (&acc)[2][2][4][2], const Unit& u, int wr, int wc, int fr, int fq) const {
        typedef __attribute__((address_space(1))) f32x4 gf32x4;
        typedef __attribute__((address_space(1))) u32x4 gu32x4;
        if (u.ti >= 0) {
            const int wid = wr * 4 + wc; int lane = fq * 16 + fr; asm volatile("" : "+v"(lane));
            gf32x4* p = (gf32x4*)part + ((size_t)(u.ti * u.s + u.ks) * 8 + wid) * 2048 + lane;
#pragma unroll
            for (int j = 0; j < 32; ++j) p[j * 64] = acc[j >> 4][(j >> 3) & 1][(j >> 1) & 3][j & 1];
            asm volatile("s_waitcnt vmcnt(0)" ::: "memory"); __builtin_amdgcn_s_barrier();
            if (wid == 0) {
                __builtin_amdgcn_fence(__ATOMIC_RELEASE, "agent");
                if (lane == 0) __hip_atomic_fetch_add(cnt + u.ti, 1u, __ATOMIC_RELAXED, __HIP_MEMORY_SCOPE_AGENT);
                while (__hip_atomic_load(cnt + u.ti, __ATOMIC_RELAXED, __HIP_MEMORY_SCOPE_AGENT) < (unsigned)u.s) __builtin_amdgcn_s_sleep(2);
                __builtin_amdgcn_fence(__ATOMIC_ACQUIRE, "agent");
            }
            __builtin_amdgcn_s_barrier();
            if (u.s == 8) tail_reduce<8>(u, wr, wc, fr, fq, wid, lane); else if (u.s == 4) tail_reduce<4>(u, wr, wc, fr, fq, wid, lane); else tail_reduce<2>(u, wr, wc, fr, fq, wid, lane);
            return;
        }
        const int row0 = u.pm * BM + wr * 64 + fr, col0 = u.pn * BM + wc * 32 + 8 * fq;
        float g[2][4];
        { const __attribute__((address_space(1))) float* gp = (const __attribute__((address_space(1))) float*)sg + row0;
#pragma unroll
          for (int ai = 0; ai < 2; ++ai)
#pragma unroll
              for (int m = 0; m < 4; ++m) g[ai][m] = gp[ai * HALF + m * 16]; }
        u32x4 b[2][4][2];
#pragma unroll
        for (int ai = 0; ai < 2; ++ai)
#pragma unroll
            for (int m = 0; m < 4; ++m)
#pragma unroll
                for (int bj = 0; bj < 2; ++bj) { b[ai][m][bj] = (u32x4){0u, 0u, 0u, 0u}; if (g[ai][m] > 0.f) b[ai][m][bj] = *(const gu32x4*)(Y + (size_t)(row0 + ai * HALF + m * 16) * ldc + col0 + bj * HALF); }
#pragma unroll
        for (int ai = 0; ai < 2; ++ai)
#pragma unroll
            for (int m = 0; m < 4; ++m) { bf16_t* rowp = Y + (size_t)(row0 + ai * HALF + m * 16) * ldc + col0; const float ga = fabsf(g[ai][m]);
#pragma unroll
                for (int bj = 0; bj < 2; ++bj) { float v[8];
#pragma unroll
                    for (int i = 0; i < 4; ++i) { v[2 * i] = __uint_as_float(b[ai][m][bj][i] << 16) + ga * acc[ai][bj][m][i >> 1][(2 * i) & 3]; v[2 * i + 1] = __uint_as_float(b[ai][m][bj][i] & 0xffff0000u) + ga * acc[ai][bj][m][i >> 1][(2 * i + 1) & 3]; }
                    u32x4 w; w.x = cvt_pk_bf16(v[0], v[1]); w.y = cvt_pk_bf16(v[2], v[3]); w.z = cvt_pk_bf16(v[4], v[5]); w.w = cvt_pk_bf16(v[6], v[7]);
                    *(gu32x4*)(rowp + bj * HALF) = w; } }
    }
};
struct EpiSwiGLU {
    static constexpr bool PERM = true, AFTER_DRAIN = false, HAS_PRE = true;
    __device__ __forceinline__ void preload(unsigned (&q)[8], const Unit& u, int wr, int fr) const {
        const __attribute__((address_space(1))) unsigned* rp = (const __attribute__((address_space(1))) unsigned*)rs + u.pm * BM + wr * 64 + fr;
#pragma unroll
        for (int i = 0; i < 8; ++i) q[i] = rp[(i >> 2) * HALF + (i & 3) * 16]; }
    bf16_t* H; int ldc; const unsigned* rs;
    __device__ __forceinline__ void operator()(const f32x4 (&acc)[2][2][4][2], const Unit& u, int wr, int wc, int fr, int fq, const unsigned (&q)[8]) const {
        const int row0 = u.pm * BM + wr * 64 + fr, col0 = u.pn * HALF + wc * 32 + 8 * fq;
        float sc[2][4];
#pragma unroll
        for (int ai = 0; ai < 2; ++ai)
#pragma unroll
            for (int m = 0; m < 4; ++m) sc[ai][m] = rsqrtf((float)q[ai * 4 + m] * (1.f / (16.f * 1024.f)) + 1e-6f);
#pragma unroll
        for (int ai = 0; ai < 2; ++ai)
#pragma unroll
            for (int m = 0; m < 4; ++m) { bf16_t* rowp = H + (size_t)(row0 + ai * HALF + m * 16) * ldc + col0; float hv[8];
#pragma unroll
                for (int n = 0; n < 2; ++n)
#pragma unroll
                    for (int i = 0; i < 4; ++i) { const float g = acc[ai][0][m][n][i] * sc[ai][m], up = acc[ai][1][m][n][i] * sc[ai][m];
                        hv[n * 4 + i] = g * __builtin_amdgcn_rcpf(1.f + __builtin_amdgcn_exp2f(-g * 1.4426950408889634f)) * up; }
                u32x4 w; w.x = cvt_pk_bf16(hv[0], hv[1]); w.y = cvt_pk_bf16(hv[2], hv[3]); w.z = cvt_pk_bf16(hv[4], hv[5]); w.w = cvt_pk_bf16(hv[6], hv[7]);
                *(u32x4*)rowp = w; }
    }
};

template <class Epi, class Sched, bool ALIGN_EPI = false, bool SP2 = false>
__device__ __forceinline__ void gemm_phase(PG8_LAS unsigned char* lds, const Gemm g, const Sched& S, const Epi& E) {
    int tid = threadIdx.x; asm volatile("" : "+v"(tid));
    const int wid = __builtin_amdgcn_readfirstlane(tid >> 6), lane = tid & 63, wr = wid >> 2, wc = wid & 3, fr = lane & 15, fq = lane >> 4;
    const int K = g.K, nt = K / BK;
    unsigned voffA[2], voffB[2];
#pragma unroll
    for (int i = 0; i < 2; ++i) { int R, C; stage_rc(tid * 16 + i * 8192, R, C); const int Rb = Epi::PERM ? ((R & ~31) + perm32(R & 31)) : R;
        voffA[i] = (unsigned)(R * K + C) * 2u; voffB[i] = (unsigned)(Rb * K + C) * 2u; }
    const size_t kstep = (size_t)(BK * 2);
    const size_t hstep = (size_t)HALF * K * 2;
    const size_t tstep = 2 * hstep;
    const unsigned ldsw = (unsigned)wid * 1024u;
    const int aoff = lds_byte(wr * 64 + fr, fq * 8), boff = lds_byte(wc * 32 + fr, fq * 8);
#define PG8_SA(b, h) (((b) * 2 + (h)) * HTB)
#define PG8_SB(b, h) ((4 + (b) * 2 + (h)) * HTB)
#define PG8_STAGE(bufoff, gbase, voff) do { _Pragma("unroll") for (int _i = 0; _i < 2; ++_i) \
        __builtin_amdgcn_global_load_lds((const unsigned*)((const char*)(gbase) + (voff)[_i]), (PG8_LAS unsigned*)(lds + (bufoff) + ldsw + _i * 8192), 16, 0, 0); } while (0)
#define PG8_LDA(dst, b, h) do { _Pragma("unroll") for (int m = 0; m < 4; ++m) _Pragma("unroll") for (int k = 0; k < 2; ++k) dst[m][k] = *(const PG8_LAS bf16x8*)(lds + PG8_SA(b, h) + aoff + m * 2048 + k * 1024); } while (0)
#define PG8_LDB(dst, b, h) do { _Pragma("unroll") for (int n = 0; n < 2; ++n) _Pragma("unroll") for (int k = 0; k < 2; ++k) dst[n][k] = *(const PG8_LAS bf16x8*)(lds + PG8_SB(b, h) + boff + n * 2048 + k * 1024); } while (0)
#define PG8_MMA(ai, bj, At, Bt) do { __builtin_amdgcn_s_setprio(1); _Pragma("unroll") for (int m = 0; m < 4; ++m) _Pragma("unroll") for (int n = 0; n < 2; ++n) _Pragma("unroll") for (int k = 0; k < 2; ++k) \
        acc[ai][bj][m][n] = __builtin_amdgcn_mfma_f32_16x16x32_bf16(Bt[n][k], At[m][k], acc[ai][bj][m][n], 0, 0, 0); __builtin_amdgcn_s_setprio(0); } while (0)
#define PG8_WAIT_V(n) asm volatile("s_waitcnt vmcnt(" #n ")" ::: "memory")
#define PG8_WAIT_L(n) asm volatile("s_waitcnt lgkmcnt(" #n ")" ::: "memory")
#define PG8_BAR __builtin_amdgcn_s_barrier()
#define PG8_SCHED __builtin_amdgcn_sched_barrier(0)
    Unit cur, nxt; int ui = 0;
    if (!S.next(0, cur)) return;
    f32x4 acc[2][2][4][2];
#pragma unroll
    for (int a = 0; a < 2; ++a)
#pragma unroll
        for (int b = 0; b < 2; ++b)
#pragma unroll
            for (int m = 0; m < 4; ++m)
#pragma unroll
                for (int n = 0; n < 2; ++n) acc[a][b][m][n] = (f32x4){0.f, 0.f, 0.f, 0.f};
    bf16x8 At[4][2], B0[2][2], B1[2][2];
    const char* cA = (const char*)g.A + (size_t)cur.pm * tstep; const char* cB = (const char*)g.Bt + cur.bofs + (size_t)cur.pn * tstep;
    if constexpr (Sched::VAR_K) cA += cur.aofs;
    S.a_ready(cur);
    if constexpr (SP2) {
        PG8_STAGE(PG8_SB(0, 0), cB, voffB); PG8_STAGE(PG8_SB(0, 1), cB + hstep, voffB); PG8_STAGE(PG8_SA(0, 0), cA, voffA); PG8_STAGE(PG8_SA(0, 1), cA + hstep, voffA);
        if (wr == 1) PG8_BAR;
        PG8_WAIT_V(2); PG8_BAR;
        PG8_STAGE(PG8_SB(1, 0), cB + kstep, voffB); PG8_STAGE(PG8_SA(1, 0), cA + kstep, voffA); PG8_STAGE(PG8_SB(1, 1), cB + hstep + kstep, voffB);
        PG8_WAIT_V(6); PG8_BAR;
    } else {
        PG8_STAGE(PG8_SB(0, 0), cB, voffB); PG8_STAGE(PG8_SA(0, 0), cA, voffA); PG8_STAGE(PG8_SB(0, 1), cB + hstep, voffB); PG8_STAGE(PG8_SA(0, 1), cA + hstep, voffA);
        if (wr == 1) PG8_BAR;
        PG8_WAIT_V(4); PG8_BAR;
        PG8_STAGE(PG8_SB(1, 0), cB + kstep, voffB); PG8_STAGE(PG8_SA(1, 0), cA + kstep, voffA); PG8_STAGE(PG8_SB(1, 1), cB + hstep + kstep, voffB);
        PG8_WAIT_V(6); PG8_BAR;
    }
    for (;;) {
        unsigned preq[8];
        if constexpr (Epi::HAS_PRE) E.preload(preq, cur, wr, fr);
        const bool has_next = S.next(ui + 1, nxt);
        const char* nA = has_next ? (const char*)g.A + (size_t)nxt.pm * tstep : cA; const char* nB = has_next ? (const char*)g.Bt + nxt.bofs + (size_t)nxt.pn * tstep : cB;
        if constexpr (Sched::VAR_K) { if (has_next) nA += nxt.aofs; }
        int ntu = nt; if constexpr (Sched::VAR_K) ntu = cur.nt;
        for (int t = 0; t < ntu; t += 2) {
            const bool last = (t == ntu - 2);
            const char* a1 = cA + (size_t)(t + 1) * kstep;
            const char* a2 = last ? nA : cA + (size_t)(t + 2) * kstep; const char* b2 = last ? nB : cB + (size_t)(t + 2) * kstep;
            const char* a3 = a2 + kstep; const char* b3 = b2 + kstep;
            if (last && has_next) S.a_ready(nxt);
            if constexpr (SP2) {
            PG8_LDB(B0, 0, 0); PG8_LDB(B1, 0, 1); PG8_SCHED; PG8_LDA(At, 0, 0); PG8_STAGE(PG8_SA(1, 1), a1 + hstep, voffA);
            PG8_WAIT_V(8); PG8_WAIT_L(0); PG8_BAR; PG8_MMA(0, 0, At, B0); PG8_MMA(0, 1, At, B1); PG8_BAR; PG8_SCHED;
            PG8_LDA(At, 0, 1); PG8_STAGE(PG8_SB(0, 0), b2, voffB); PG8_STAGE(PG8_SB(0, 1), b2 + hstep, voffB); PG8_STAGE(PG8_SA(0, 0), a2, voffA);
            PG8_WAIT_V(8); PG8_WAIT_L(0); PG8_BAR; PG8_MMA(1, 0, At, B0); PG8_MMA(1, 1, At, B1); PG8_BAR; PG8_SCHED;
            PG8_LDB(B0, 1, 0); PG8_LDB(B1, 1, 1); PG8_SCHED; PG8_LDA(At, 1, 0); PG8_STAGE(PG8_SA(0, 1), a2 + hstep, voffA);
            PG8_WAIT_V(8); PG8_WAIT_L(0); PG8_BAR; PG8_MMA(0, 0, At, B0); PG8_MMA(0, 1, At, B1); PG8_BAR; PG8_SCHED;
            PG8_LDA(At, 1, 1); PG8_STAGE(PG8_SB(1, 0), b3, voffB); PG8_STAGE(PG8_SB(1, 1), b3 + hstep, voffB); PG8_STAGE(PG8_SA(1, 0), a3, voffA);
            PG8_WAIT_V(8); PG8_WAIT_L(0); PG8_BAR; PG8_MMA(1, 0, At, B0); PG8_MMA(1, 1, At, B1); PG8_BAR; PG8_SCHED;
            } else {
            PG8_LDB(B0, 0, 0); PG8_SCHED; PG8_LDA(At, 0, 0); PG8_STAGE(PG8_SA(1, 1), a1 + hstep, voffA);
            PG8_WAIT_L(8); PG8_BAR; PG8_WAIT_L(0); PG8_MMA(0, 0, At, B0); PG8_BAR; PG8_SCHED;
            PG8_LDB(B1, 0, 1); PG8_STAGE(PG8_SB(0, 0), b2, voffB);
            PG8_BAR; PG8_WAIT_L(0); PG8_MMA(0, 1, At, B1); PG8_BAR;
            PG8_LDA(At, 0, 1); PG8_STAGE(PG8_SA(0, 0), a2, voffA);
            PG8_BAR; PG8_WAIT_L(0); PG8_MMA(1, 0, At, B0); PG8_BAR; PG8_SCHED;
            PG8_STAGE(PG8_SB(0, 1), b2 + hstep, voffB);
            PG8_WAIT_V(6); PG8_BAR; PG8_MMA(1, 1, At, B1); PG8_BAR;
            PG8_LDB(B0, 1, 0); PG8_SCHED; PG8_LDA(At, 1, 0); PG8_STAGE(PG8_SA(0, 1), a2 + hstep, voffA);
            PG8_WAIT_L(8); PG8_BAR; PG8_WAIT_L(0); PG8_MMA(0, 0, At, B0); PG8_BAR; PG8_SCHED;
            PG8_LDB(B1, 1, 1); PG8_STAGE(PG8_SB(1, 0), b3, voffB);
            PG8_BAR; PG8_WAIT_L(0); PG8_MMA(0, 1, At, B1); PG8_BAR;
            PG8_LDA(At, 1, 1); PG8_STAGE(PG8_SA(1, 0), a3, voffA);
            PG8_BAR; PG8_WAIT_L(0); PG8_MMA(1, 0, At, B0); PG8_BAR; PG8_SCHED;
            PG8_STAGE(PG8_SB(1, 1), b3 + hstep, voffB);
            PG8_WAIT_V(6); PG8_BAR; PG8_MMA(1, 1, At, B1); PG8_BAR;
            }
        }
        if constexpr (ALIGN_EPI) { if (wr == 0) PG8_BAR; }
        if constexpr (!Epi::AFTER_DRAIN) { if constexpr (Epi::HAS_PRE) E(acc, cur, wr, wc, fr, fq, preq); else E(acc, cur, wr, wc, fr, fq); S.done(cur); }
        if (!has_next) break;
#pragma unroll
        for (int a = 0; a < 2; ++a)
#pragma unroll
            for (int b = 0; b < 2; ++b)
#pragma unroll
                for (int m = 0; m < 4; ++m)
#pragma unroll
                    for (int n = 0; n < 2; ++n) acc[a][b][m][n] = (f32x4){0.f, 0.f, 0.f, 0.f};
        cur = nxt; cA = nA; cB = nB; ++ui;
        if constexpr (ALIGN_EPI) { if (wr == 1) PG8_BAR; }
    }
    PG8_WAIT_V(0);
    if constexpr (!ALIGN_EPI) { if (wr == 0) PG8_BAR; }
    PG8_BAR;
#undef PG8_SA
#undef PG8_SB
#undef PG8_STAGE
#undef PG8_LDA
#undef PG8_LDB
#undef PG8_MMA
#undef PG8_WAIT_V
#undef PG8_WAIT_L
#undef PG8_BAR
#undef PG8_SCHED
}
}


#include <hip/hip_bf16.h>
namespace fox {
using bf16h=__hip_bfloat16;
using bf16x8=__attribute__((ext_vector_type(8)))short;
using s16x4=__attribute__((ext_vector_type(4)))short;
using f32x16=__attribute__((ext_vector_type(16)))float;
using f32x4=__attribute__((ext_vector_type(4)))float;
using u32x4=__attribute__((ext_vector_type(4)))unsigned;
constexpr int NHEAD=FH,D=64,DMI=512,DMO=1024;
constexpr int NW=8,QBLK=32,QB=QBLK*NW,KVBLK=64,NQB=SEQ/QB;
__device__ __forceinline__ int crow(int r,int hi){return (r&3)+8*(r>>2)+4*hi;}
#define SBAR() __builtin_amdgcn_sched_barrier(0)
__device__ __forceinline__ void cmask(f32x16&p0,f32x16&p1,int jb,int qrel,int hi){
  const float NEG=-INFINITY; int kb=64*jb+4*hi;
  #pragma unroll
  for(int r=0;r<16;++r){int kv=kb+(r&3)+8*(r>>2); if(kv>qrel)p0[r]=NEG; if(kv+32>qrel)p1[r]=NEG;}
}
constexpr int NSLOT=3, SLOTB=8192;
constexpr int LDS_K=0, LDS_V=NSLOT*SLOTB, LDS_WS=2*NSLOT*SLOTB, LDS_OST=LDS_WS+NW*64*4, LDS_NB=LDS_OST+NW*4096, LDS_BYTES=LDS_NB+SEQ*4;
__device__ __forceinline__ void glds16(const void*gsrc,unsigned lds_dst){unsigned keep;
  asm volatile("s_mov_b32 %0, m0\n\ts_mov_b32 m0, %2\n\ts_nop 0\n\tglobal_load_lds_dwordx4 %1, off\n\ts_mov_b32 m0, %0":"=&s"(keep):"v"(gsrc),"s"(lds_dst):"memory");}
__device__ __forceinline__ float max3f(float a,float b,float c){float r;asm("v_max3_f32 %0, %1, %2, %3":"=v"(r):"v"(a),"v"(b),"v"(c));return r;}
__device__ __forceinline__ float max2f(float a,float b){float r;asm("v_max_f32_e32 %0, %1, %2":"=v"(r):"v"(a),"v"(b));return r;}
__device__ __forceinline__ float fadd_s(float a,float b){float r;asm("v_add_f32_e32 %0, %1, %2":"=v"(r):"v"(a),"v"(b));return r;}
__device__ __forceinline__ float fsub_s(float a,float b){float r;asm("v_sub_f32_e32 %0, %1, %2":"=v"(r):"v"(a),"v"(b));return r;}
typedef float f32x2_t __attribute__((ext_vector_type(2))); typedef __bf16 bf16x2_t __attribute__((ext_vector_type(2)));
__device__ __forceinline__ unsigned cvtpk_s(float lo,float hi){f32x2_t v={lo,hi};bf16x2_t b=__builtin_convertvector(v,bf16x2_t);return __builtin_bit_cast(unsigned,b);}
#define WAIT_BAR(N) asm volatile("s_waitcnt vmcnt(" #N ") lgkmcnt(0)\n\ts_barrier":::"memory")
__device__ __forceinline__ void qkt(f32x16&p0,f32x16&p1,const char*Kslot,const bf16x8*qr,int r32,int hi){
  const char*kb=Kslot+hi*1024+r32*16;
  #pragma unroll
  for(int d0=0;d0<4;++d0){
    const bf16x8 b0=*reinterpret_cast<const bf16x8*>(kb+d0*2048);
    const bf16x8 b1=*reinterpret_cast<const bf16x8*>(kb+d0*2048+512);
    p0=__builtin_amdgcn_mfma_f32_32x32x16_bf16(b0,qr[d0],p0,0,0,0);p1=__builtin_amdgcn_mfma_f32_32x32x16_bf16(b1,qr[d0],p1,0,0,0);}
}
typedef __attribute__((address_space(3))) const char* lds_cptr;
typedef __attribute__((address_space(3))) const float* lds_fptr;
typedef short v4i16_t __attribute__((ext_vector_type(4)));
__device__ __forceinline__ void kload8(bf16x8*kf,lds_cptr kp){
  kf[0]=*(const __attribute__((address_space(3))) bf16x8*)(kp);      kf[1]=*(const __attribute__((address_space(3))) bf16x8*)(kp+512);
  kf[2]=*(const __attribute__((address_space(3))) bf16x8*)(kp+2048); kf[3]=*(const __attribute__((address_space(3))) bf16x8*)(kp+2560);
  kf[4]=*(const __attribute__((address_space(3))) bf16x8*)(kp+4096); kf[5]=*(const __attribute__((address_space(3))) bf16x8*)(kp+4608);
  kf[6]=*(const __attribute__((address_space(3))) bf16x8*)(kp+6144); kf[7]=*(const __attribute__((address_space(3))) bf16x8*)(kp+6656);
}
__device__ __forceinline__ void kload2(bf16x8*kf,lds_cptr kp,int j){ kf[2*j]=*(const __attribute__((address_space(3))) bf16x8*)(kp+j*2048); kf[2*j+1]=*(const __attribute__((address_space(3))) bf16x8*)(kp+j*2048+512); }
__device__ __forceinline__ s16x4 vtr(lds_cptr p){ return __builtin_bit_cast(s16x4,__builtin_amdgcn_ds_read_tr16_b64_v4i16((__attribute__((address_space(3))) v4i16_t*)p)); }
__device__ __forceinline__ float rowmax(const f32x16&p0,const f32x16&p1){
  float a=max3f(p0[0],p0[1],p1[0]),b=max3f(p0[2],p0[3],p1[1]);a=max3f(a,p1[2],p1[3]);
  #pragma unroll
  for(int r=4;r<16;r+=4){a=max3f(a,p0[r],p0[r+1]);b=max3f(b,p0[r+2],p0[r+3]);a=max3f(a,p1[r],p1[r+1]);b=max3f(b,p1[r+2],p1[r+3]);}
  const float m=max2f(a,b);
  auto rr=__builtin_amdgcn_permlane32_swap(__float_as_uint(m),__float_as_uint(m),false,false);
  return max2f(__uint_as_float(rr[0]),__uint_as_float(rr[1]));
}
__device__ __forceinline__ void pv(f32x16*o,int vb,bf16x8 pa0,bf16x8 pa1,bf16x8 pa2,bf16x8 pa3){
  #pragma unroll
  for(int d0=0;d0<2;++d0){s16x4 lo[4],hi[4];
    #pragma unroll
    for(int ks=0;ks<4;++ks){
      asm volatile("ds_read_b64_tr_b16 %0,%1 offset:%c2":"=&v"(lo[ks]):"v"(vb),"i"(d0*4096+ks*1024):"memory");
      asm volatile("ds_read_b64_tr_b16 %0,%1 offset:%c2":"=&v"(hi[ks]):"v"(vb),"i"(d0*4096+ks*1024+512):"memory");}
    asm volatile("s_waitcnt lgkmcnt(0)":::"memory");SBAR();
    #define PK(k) (bf16x8){lo[k][0],lo[k][1],lo[k][2],lo[k][3],hi[k][0],hi[k][1],hi[k][2],hi[k][3]}
    o[d0]=__builtin_amdgcn_mfma_f32_32x32x16_bf16(pa0,PK(0),o[d0],0,0,0);
    o[d0]=__builtin_amdgcn_mfma_f32_32x32x16_bf16(pa1,PK(1),o[d0],0,0,0);
    o[d0]=__builtin_amdgcn_mfma_f32_32x32x16_bf16(pa2,PK(2),o[d0],0,0,0);
    o[d0]=__builtin_amdgcn_mfma_f32_32x32x16_bf16(pa3,PK(3),o[d0],0,0,0);
    #undef PK
  }
}
template<int THRL> __device__ __forceinline__ void attn_unit(int b,int h,int qb,int j0,const bf16h*Q,const bf16h*__restrict__ K,const bf16h*__restrict__ V,bf16h*O,const float*CL,char*shm){
  int tid=threadIdx.x; asm volatile("":"+v"(tid));
  const int lane=tid&63,r32=lane&31,hi=lane>>5; const int wid=__builtin_amdgcn_readfirstlane(tid>>6);
  const long rowbase=(long)b*SEQ; const int q0=qb*QB; const long kvbase=rowbase+(long)j0*KVBLK;
  const bf16h*Qw=Q+(rowbase+q0+wid*QBLK)*DMI+h*D;
  const bf16h*Kh=K+kvbase*DMI+h*D,*Vh=V+kvbase*DMI+h*D;
  const unsigned lds0=(unsigned)(uintptr_t)shm;
  float*wsf=(float*)(shm+LDS_WS)+wid*64;
  const int NT=(q0+QB)/KVBLK-j0;
  { float*nbw=(float*)(shm+LDS_NB); const float*src=CL+(long)j0*KVBLK;
    for(int i=tid*4;i<NT*KVBLK;i+=512*4){ const f32x4 v=*(const f32x4*)(src+i); *(f32x4*)(nbw+i)=(f32x4){-v[0],-v[1],-v[2],-v[3]}; } }
  const bf16h*ksrc=Kh+(long)lane*DMI+wid*8;
  const bf16h*vsrc=Vh+(long)(16*(wid&3)+(lane>>2))*DMI+(wid>>2)*32+(lane&3)*8;
  const unsigned kdst=lds0+LDS_K+wid*1024, vdst=lds0+LDS_V+wid*1024;
  #define DMA_K(t,slot) glds16(ksrc+(long)(t)*KVBLK*DMI,(unsigned)__builtin_amdgcn_readfirstlane(kdst+(slot)))
  #define DMA_V(t,slot) glds16(vsrc+(long)(t)*KVBLK*DMI,(unsigned)__builtin_amdgcn_readfirstlane(vdst+(slot)))
  const int vb0=(int)(lds0+LDS_V)+((lane>>4)&1)*32+(lane&3)*8+(4*hi+((lane&15)>>2))*64;
  const char*Kbase=shm+LDS_K; bf16x8 kf[8];
  const lds_cptr shm3=(lds_cptr)shm; const lds_cptr kp0=shm3+LDS_K+hi*1024+r32*16; const lds_cptr vp0=shm3+LDS_V+((lane>>4)&1)*32+(lane&3)*8+(4*hi+((lane&15)>>2))*64;
  const lds_fptr nb0=(lds_fptr)(shm3+LDS_NB)+4*hi;
  DMA_K(0,0);DMA_V(0,0);DMA_K(1,SLOTB);
  bf16x8 qr[4];
  #pragma unroll
  for(int d0=0;d0<4;++d0)qr[d0]=*reinterpret_cast<const bf16x8*>(&Qw[(long)r32*DMI+d0*16+hi*8]);
  float mhat=0.f,l_reg=0.f;f32x16 o[2];o[0]=f32x16{};o[1]=f32x16{};
  const int qrel=wid*QBLK+r32;
  #define CMASK(P0,P1,t) do{int jb_=(t)-(NT-4); if(jb_>=0)cmask(P0,P1,jb_,qrel,hi);}while(0)
  #define PRELOAD(P0,P1,tt) do{ const lds_fptr nbp_=nb0+(tt)*KVBLK; \
    _Pragma("unroll") for(int g_=0;g_<4;++g_){ const f32x4 a_=*(const __attribute__((address_space(3))) f32x4*)(nbp_+8*g_), b_=*(const __attribute__((address_space(3))) f32x4*)(nbp_+32+8*g_); \
      P0[4*g_]=a_[0]-mhat;P0[4*g_+1]=a_[1]-mhat;P0[4*g_+2]=a_[2]-mhat;P0[4*g_+3]=a_[3]-mhat; P1[4*g_]=b_[0]-mhat;P1[4*g_+1]=b_[1]-mhat;P1[4*g_+2]=b_[2]-mhat;P1[4*g_+3]=b_[3]-mhat; } }while(0)
  bool resc=false;
  #define START(P0,P1) do{ const float rm=rowmax(P0,P1); resc=false; \
    { const float dl=rm; mhat=fadd_s(mhat,dl); \
      _Pragma("unroll") for(int r=0;r<16;++r){P0[r]=fsub_s(P0[r],dl);P1[r]=fsub_s(P1[r],dl);} } \
    _Pragma("unroll") for(int r=0;r<16;++r)P0[r]=__builtin_amdgcn_exp2f(P0[r]); }while(0)
  #define RESC() do{ if(resc){ asm volatile("s_waitcnt lgkmcnt(0)":::"memory"); \
      _Pragma("unroll") for(int d_=0;d_<2;++d_) _Pragma("unroll") for(int r=0;r<16;++r)o[d_][r]*=wsf[crow(r,hi)]; } }while(0)
  f32x16 pA0,pA1,pB0,pB1;
  int sl_prev=0,sl_cur=0,sl_next=SLOTB;
  #define ROT() do{sl_prev=sl_cur;sl_cur=sl_next;sl_next=(sl_next==(NSLOT-1)*SLOTB)?0:sl_next+SLOTB;}while(0)
  DMA_K(2,2*SLOTB);
  WAIT_BAR(3);
  PRELOAD(pA0,pA1,0);
  qkt(pA0,pA1,Kbase,qr,r32,hi);asm volatile("s_nop 15\n\ts_nop 7":"+v"(pA0),"+v"(pA1));CMASK(pA0,pA1,0);
  START(pA0,pA1);
  _Pragma("unroll") for(int r=0;r<16;++r)pA1[r]=__builtin_amdgcn_exp2f(pA1[r]);
  WAIT_BAR(0);
  DMA_K(3,0);DMA_V(1,SLOTB);
  ROT();
  kload8(kf,kp0+sl_cur);
  PRELOAD(pB0,pB1,1);
  WAIT_BAR(2);
  s16x4 vlo[8],vhi[8]; u32x4 pw0,pw1,pw2,pw3;
  #define PKW(P,B) cvtpk_s(P[B],P[B+1])
  #define PAF(k) __builtin_bit_cast(bf16x8,pw##k)
  #define VFR(i) (bf16x8){vlo[i][0],vlo[i][1],vlo[i][2],vlo[i][3],vhi[i][0],vhi[i][1],vhi[i][2],vhi[i][3]}
  #define PIN(x) asm volatile("":"+v"(x))
  #define MX3(a,b,c) __builtin_fmaxf(__builtin_fmaxf((a),(b)),(c))
  #define GAPA(MF,A0,A1,A2,A3,W0,W1,PW) do{ MF; sacc+=A0; sacc+=A1; sacc+=A2; sacc+=A3; PIN(sacc); W0; W1; PIN(PW); SBAR(); }while(0)
  #define EX(v) __builtin_amdgcn_exp2f(v)
  #define GAPB(MF,X,B) do{ MF; X[B]=EX(X[B]); X[B+1]=EX(X[B+1]); X[B+2]=EX(X[B+2]); X[B+3]=EX(X[B+3]); PIN(X); SBAR(); }while(0)
  #define VRD(i) do{ vlo[i]=vtr(vp_+(((i)>>2)*4096+((i)&3)*1024)); vhi[i]=vtr(vp_+(((i)>>2)*4096+((i)&3)*1024+512)); }while(0)
  #define KRD(G,j) do{ if(G){ kload2(kf,kp0+sl_next,j); SBAR(); } }while(0)
  #define STEP(C0,C1,P0,P1,t,GK,GV,GL) do{ SBAR(); \
    const lds_cptr vp_=vp0+sl_prev; \
    VRD(0); SBAR(); float sacc=(P0[0]+P0[1]); \
    GAPA(C0=__builtin_amdgcn_mfma_f32_32x32x16_bf16(kf[0],qr[0],C0,0,0,0), P0[2],P0[3],P0[4],P0[5],     pw0[0]=PKW(P0,0), pw0[1]=PKW(P0,2), pw0); \
    VRD(4); SBAR(); GAPA(C1=__builtin_amdgcn_mfma_f32_32x32x16_bf16(kf[1],qr[0],C1,0,0,0), P0[6],P0[7],P0[8],P0[9],     pw0[2]=PKW(P0,4), pw0[3]=PKW(P0,6), pw0); \
    VRD(1); SBAR(); GAPA(C0=__builtin_amdgcn_mfma_f32_32x32x16_bf16(kf[2],qr[1],C0,0,0,0),   P0[10],P0[11],P0[12],P0[13], pw1[0]=PKW(P0,8), pw1[1]=PKW(P0,10), pw1); \
    VRD(5); SBAR(); GAPA(C1=__builtin_amdgcn_mfma_f32_32x32x16_bf16(kf[3],qr[1],C1,0,0,0),   P0[14],P0[15],P1[0],P1[1],   pw1[2]=PKW(P0,12),pw1[3]=PKW(P0,14), pw1); \
    VRD(2); SBAR(); GAPA(C0=__builtin_amdgcn_mfma_f32_32x32x16_bf16(kf[4],qr[2],C0,0,0,0),   P1[2],P1[3],P1[4],P1[5],     pw2[0]=PKW(P1,0), pw2[1]=PKW(P1,2), pw2); \
    VRD(6); SBAR(); GAPA(C1=__builtin_amdgcn_mfma_f32_32x32x16_bf16(kf[5],qr[2],C1,0,0,0),   P1[6],P1[7],P1[8],P1[9],     pw2[2]=PKW(P1,4), pw2[3]=PKW(P1,6), pw2); \
    VRD(3); SBAR(); GAPA(C0=__builtin_amdgcn_mfma_f32_32x32x16_bf16(kf[6],qr[3],C0,0,0,0),   P1[10],P1[11],P1[12],P1[13], pw3[0]=PKW(P1,8), pw3[1]=PKW(P1,10), pw3); \
    VRD(7); SBAR(); GAPA(C1=__builtin_amdgcn_mfma_f32_32x32x16_bf16(kf[7],qr[3],C1,0,0,0),   P1[14],P1[15],0.f,0.f,       pw3[2]=PKW(P1,12),pw3[3]=PKW(P1,14), pw3); \
    l_reg+=sacc; \
    if(GK){DMA_K((t)+3,sl_cur);} if(GV){DMA_V((t)+1,sl_next);} \
    CMASK(C0,C1,t); \
    { float a=MX3(C0[0],C0[1],C1[0]),b=MX3(C0[2],C0[3],C1[1]); a=MX3(a,C1[2],C1[3]); \
      _Pragma("unroll") for(int r=4;r<16;r+=4){a=MX3(a,C0[r],C0[r+1]);b=MX3(b,C0[r+2],C0[r+3]);a=MX3(a,C1[r],C1[r+1]);b=MX3(b,C1[r+2],C1[r+3]);} \
      float rm=__builtin_fmaxf(a,b); { auto rr=__builtin_amdgcn_permlane32_swap(__float_as_uint(rm),__float_as_uint(rm),false,false); rm=__builtin_fmaxf(__uint_as_float(rr[0]),__uint_as_float(rr[1])); } \
      resc=false; \
      if(__builtin_expect(__any(rm>(float)THRL),0)){ const float dl=__builtin_fmaxf(rm,0.f); mhat+=dl; \
        _Pragma("unroll") for(int r=0;r<16;++r){C0[r]-=dl;C1[r]-=dl;} \
        const float f=__builtin_amdgcn_exp2f(-dl); l_reg*=f; if(hi==0)wsf[r32]=f; resc=true; } } \
    SBAR(); \
    GAPB(o[0]=__builtin_amdgcn_mfma_f32_32x32x16_bf16(PAF(0),VFR(0),o[0],0,0,0), C0,0); \
    GAPB(o[1]=__builtin_amdgcn_mfma_f32_32x32x16_bf16(PAF(0),VFR(4),o[1],0,0,0), C0,4); \
    KRD(GL,0); GAPB(o[0]=__builtin_amdgcn_mfma_f32_32x32x16_bf16(PAF(1),VFR(1),o[0],0,0,0), C0,8); \
    KRD(GL,1); GAPB(o[1]=__builtin_amdgcn_mfma_f32_32x32x16_bf16(PAF(1),VFR(5),o[1],0,0,0), C0,12); \
    KRD(GL,2); GAPB(o[0]=__builtin_amdgcn_mfma_f32_32x32x16_bf16(PAF(2),VFR(2),o[0],0,0,0), C1,0); \
    KRD(GL,3); GAPB(o[1]=__builtin_amdgcn_mfma_f32_32x32x16_bf16(PAF(2),VFR(6),o[1],0,0,0), C1,4); \
    GAPB(o[0]=__builtin_amdgcn_mfma_f32_32x32x16_bf16(PAF(3),VFR(3),o[0],0,0,0), C1,8); \
    GAPB(o[1]=__builtin_amdgcn_mfma_f32_32x32x16_bf16(PAF(3),VFR(7),o[1],0,0,0), C1,12); \
    if(GL){ PRELOAD(P0,P1,(t)+1); } \
    }while(0)
  int t=1;
  #undef CMASK
  #define CMASK(P0,P1,t) do{}while(0)
  for(;t+5<NT;t+=2){
    STEP(pB0,pB1,pA0,pA1,t,true,true,true);     WAIT_BAR(2); RESC(); ROT();
    STEP(pA0,pA1,pB0,pB1,t+1,true,true,true);   WAIT_BAR(2); RESC(); ROT();
  }
  #undef CMASK
  #define CMASK(P0,P1,t) do{int jb_=(t)-(NT-4); if(jb_>=0)cmask(P0,P1,jb_,qrel,hi);}while(0)
  #define ENDW(tt) do{ if((tt)+3<NT){WAIT_BAR(2);} else if((tt)+2<NT){WAIT_BAR(1);} else {WAIT_BAR(0);} }while(0)
  for(;t+1<NT;t+=2){
    STEP(pB0,pB1,pA0,pA1,t,(t+3<NT),(t+1<NT),(t+1<NT));       ENDW(t);   RESC(); ROT();
    STEP(pA0,pA1,pB0,pB1,t+1,(t+4<NT),(t+2<NT),(t+2<NT));     ENDW(t+1); RESC(); ROT();
  }
  STEP(pB0,pB1,pA0,pA1,NT-1,false,false,false); RESC();
  { float sacc=pB0[0]+pB0[1]; _Pragma("unroll") for(int r=2;r<16;++r)sacc+=pB0[r]; _Pragma("unroll") for(int r=0;r<16;++r)sacc+=pB1[r]; l_reg+=sacc;
    pw0=(u32x4){PKW(pB0,0),PKW(pB0,2),PKW(pB0,4),PKW(pB0,6)};pw1=(u32x4){PKW(pB0,8),PKW(pB0,10),PKW(pB0,12),PKW(pB0,14)};pw2=(u32x4){PKW(pB1,0),PKW(pB1,2),PKW(pB1,4),PKW(pB1,6)};pw3=(u32x4){PKW(pB1,8),PKW(pB1,10),PKW(pB1,12),PKW(pB1,14)};
    SBAR(); pv(o,vb0+sl_cur,PAF(0),PAF(1),PAF(2),PAF(3)); }
  #undef PKW
  #undef PAF
  #undef VFR
  #undef PIN
  #undef MX3
  #undef GAPA
  #undef GAPB
  #undef EX
  #undef VRD
  #undef KRD
  #undef STEP
  #undef ENDW
  {auto rr=__builtin_amdgcn_permlane32_swap(__float_as_uint(l_reg),__float_as_uint(l_reg),false,false);l_reg=__uint_as_float(rr[0])+__uint_as_float(rr[1]);}
  if(hi==0)wsf[32+r32]=l_reg;asm volatile("s_waitcnt lgkmcnt(0)":::"memory");
  float rli[16];
  #pragma unroll
  for(int r=0;r<16;++r)rli[r]=__builtin_amdgcn_rcpf(wsf[32+crow(r,hi)]);
  bf16h*Ow=O+(rowbase+q0+wid*QBLK)*DMO+h*D;
  { bf16h*stg=(bf16h*)(shm+LDS_OST)+wid*2048;
    #pragma unroll
    for(int r=0;r<16;++r){const int orow=crow(r,hi);
      #pragma unroll
      for(int d0=0;d0<2;++d0)stg[orow*64+d0*32+r32]=__float2bfloat16(o[d0][r]*rli[r]);}
    asm volatile("s_waitcnt lgkmcnt(0)":::"memory");
    #pragma unroll
    for(int i=0;i<4;++i){const int row=i*8+(lane>>3),ch=lane&7; const u32x4 v=*(const u32x4*)(stg+row*64+ch*8); *(u32x4*)(Ow+(long)row*DMO+ch*8)=v;} }
  asm volatile("s_waitcnt lgkmcnt(0)\n\ts_barrier":::"memory");
  #undef DMA_K
  #undef DMA_V
  #undef CMASK
  #undef PRELOAD
  #undef START
  #undef RESC
  #undef ROT
}

__device__ __forceinline__ int unit_j0_wave(int bh,int qb,const bf16h*Q,const float*KN2,const float*CL,int lane){
  const int b=bh/NHEAD,h=bh%NHEAD; constexpr int NTT=SEQ/KVBLK;
  float mx=0.f;
  #pragma unroll
  for(int rr=0;rr<QB/64;++rr){ const bf16h*Qw=Q+((long)b*SEQ+qb*QB+rr*64+lane)*DMI+h*D; float ss=0.f;
    #pragma unroll
    for(int c=0;c<8;++c){ const u32x4 v=*reinterpret_cast<const u32x4*>(&Qw[c*8]);
      #pragma unroll
      for(int e=0;e<4;++e){ const float f0=__uint_as_float(v[e]<<16),f1=__uint_as_float(v[e]&0xffff0000u); ss+=f0*f0+f1*f1; } }
    mx=fmaxf(mx,ss); }
  #pragma unroll
  for(int o=1;o<64;o<<=1) mx=fmaxf(mx,__shfl_xor(mx,o));
  const int nt=4*qb; const float*kn=KN2+bh*NTT;
  const float Qn=sqrtf(mx),KNd=sqrtf(fmaxf(fmaxf(kn[nt],kn[nt+1]),fmaxf(kn[nt+2],kn[nt+3])));
  const float clt0=CL[qb*QB];
  int first=nt;
  #pragma unroll
  for(int part=1;part>=0;--part){ const int i=lane+64*part; bool need=false;
    if(i<nt){ const float bound=Qn*(sqrtf(kn[i])+KNd)+clt0-CL[KVBLK*i+KVBLK-1]; need=!(bound<-40.f); }
    const unsigned long long bal=__ballot(need); if(bal) first=__ffsll((long long)bal)-1+64*part; }
  return (first<nt?first:nt)&~1;
}
#undef SBAR
#undef WAIT_BAR
}

#define GAS __attribute__((address_space(1)))
#define LAS __attribute__((address_space(3)))
typedef unsigned v4u __attribute__((ext_vector_type(4)));
typedef float f32x4 __attribute__((ext_vector_type(4)));
typedef GAS unsigned gu32;
#define RLX_AGENT __ATOMIC_RELAXED, __HIP_MEMORY_SCOPE_AGENT
#define LDS_WAIT() asm volatile("s_waitcnt lgkmcnt(0)" ::: "memory")
#define VM_WAIT() asm volatile("s_waitcnt vmcnt(0)" ::: "memory")
__device__ __forceinline__ unsigned pk2(float lo, float hi) { return (unsigned)f2bf(lo) | ((unsigned)f2bf(hi) << 16); }
__device__ __forceinline__ void unpack8(const v4u w, float* f) {
#pragma unroll
    for (int i = 0; i < 4; ++i) { f[2 * i] = __uint_as_float(w[i] << 16); f[2 * i + 1] = __uint_as_float(w[i] & 0xffff0000u); }
}

#define XB_TMO      128
#define XB_XCNT(j)  (256  + 64 * (j))
#define XB_XSUB(j)  (1280 + 64 * (j))
#define XB_XGEN(j)  (2304 + 64 * (j))
#define XB_TOP      3328
#define XB_TOPGEN   3392
#define XCD_BAR_WORDS 3456
#define XB_SPIN_CAP (1u << 18)
__device__ __forceinline__ unsigned xb_ld(unsigned* p)              { return __hip_atomic_load(p, __ATOMIC_RELAXED, __HIP_MEMORY_SCOPE_AGENT); }
__device__ __forceinline__ unsigned xb_add(unsigned* p, unsigned v) { return __hip_atomic_fetch_add(p, v, __ATOMIC_RELAXED, __HIP_MEMORY_SCOPE_AGENT); }
__device__ __forceinline__ unsigned xb_xcc_id() { return (unsigned)__builtin_amdgcn_s_getreg((3 << 11) | 20) & 0xFu; }
#define XB_SPIN(cond, bar) do { unsigned _sp = 0; while (cond) { __builtin_amdgcn_s_sleep(1); \
    if ((++_sp & 255u) == 0u) { if (xb_ld(&(bar)[XB_TMO])) break; if (_sp > XB_SPIN_CAP) { atomicAdd(&(bar)[XB_TMO], 1u); break; } } } } while (0)
struct XcdBarrier { unsigned* bar; unsigned x; volatile LAS unsigned* st; };
__device__ __forceinline__ XcdBarrier xcd_barrier_post(unsigned* bar, volatile LAS unsigned* st) {
    XcdBarrier b; b.bar = bar; b.x = xb_xcc_id(); b.st = st;
    if (threadIdx.x == 0) (void)xb_add(&bar[XB_XCNT(b.x)], 1u);
    return b;
}
__device__ __forceinline__ void xcd_barrier_complete(unsigned* bar, unsigned x, unsigned& nloc, unsigned& nx) {
    const unsigned G = gridDim.x * gridDim.y * gridDim.z;
    unsigned sum, cnt, mine, sp = 0u;
    for (;;) {
        sum = 0u; cnt = 0u; mine = 0u;
#pragma unroll
        for (unsigned j = 0; j < 16; ++j) { const unsigned c = xb_ld(&bar[XB_XCNT(j)]); sum += c; cnt += (c > 0u) ? 1u : 0u; mine = (j == x) ? c : mine; }
        if (sum == G) break;
        __builtin_amdgcn_s_sleep(1);
        if ((++sp & 255u) == 0u) { if (xb_ld(&bar[XB_TMO])) break; if (sp > XB_SPIN_CAP) { atomicAdd(&bar[XB_TMO], 1u); break; } }
    }
    nloc = mine > 0u ? mine : 1u; nx = cnt > 0u ? cnt : 1u;
}
__device__ __forceinline__ void xcd_barrier(const XcdBarrier& b) {
    asm volatile("s_waitcnt vmcnt(0)" ::: "memory");
    __syncthreads();
    if (threadIdx.x == 0) {
        unsigned* bar = b.bar;
        __builtin_amdgcn_s_waitcnt(0);
        unsigned nloc = b.st[0], nx = b.st[1];
        if (nloc == 0u) { xcd_barrier_complete(bar, b.x, nloc, nx); b.st[0] = nloc; b.st[1] = nx; }
        const unsigned old = xb_add(&bar[XB_XSUB(b.x)], 1u);
        const unsigned gen = old / nloc;
        if (old + 1u == (gen + 1u) * nloc) {
            __builtin_amdgcn_fence(__ATOMIC_RELEASE, "agent");
            asm volatile("s_waitcnt vmcnt(0)" ::: "memory");
            const unsigned og = xb_add(&bar[XB_TOP], 1u);
            const unsigned tg = og / nx;
            if (og + 1u == (tg + 1u) * nx) xb_add(&bar[XB_TOPGEN], 1u);
            else XB_SPIN(xb_ld(&bar[XB_TOPGEN]) == tg, bar);
            __builtin_amdgcn_fence(__ATOMIC_ACQUIRE, "agent");
            xb_add(&bar[XB_XGEN(b.x)], 1u);
            asm volatile("s_waitcnt vmcnt(0)" ::: "memory");
        } else {
            XB_SPIN(xb_ld(&bar[XB_XGEN(b.x)]) == gen, bar);
            __builtin_amdgcn_fence(__ATOMIC_ACQUIRE, "agent");
            asm volatile("s_waitcnt vmcnt(0)" ::: "memory");
        }
    }
    __syncthreads();
}


namespace xat {
typedef short bf16x8 __attribute__((ext_vector_type(8)));
typedef short s16x4 __attribute__((ext_vector_type(4)));
typedef float f32x16 __attribute__((ext_vector_type(16)));
constexpr int RB = 272;
constexpr int KIMG = 0, VIMG = 128 * RB, LDS_BYTES = 2 * 128 * RB;
__device__ __forceinline__ unsigned cvtpk(float lo, float hi) { typedef float f2 __attribute__((ext_vector_type(2))); typedef __bf16 b2 __attribute__((ext_vector_type(2))); f2 v = {lo, hi}; b2 b = __builtin_convertvector(v, b2); return __builtin_bit_cast(unsigned, b); }
__device__ __forceinline__ float swapmax(float m) { auto rr = __builtin_amdgcn_permlane32_swap(__float_as_uint(m), __float_as_uint(m), false, false); return fmaxf(__uint_as_float(rr[0]), __uint_as_float(rr[1])); }
__device__ __forceinline__ float swapadd(float m) { auto rr = __builtin_amdgcn_permlane32_swap(__float_as_uint(m), __float_as_uint(m), false, false); return __uint_as_float(rr[0]) + __uint_as_float(rr[1]); }
__device__ __forceinline__ void unit(int b, int head, int qb, const bf16* QX, const bf16* KX, const bf16* VT, bf16* OX, LAS unsigned char* lds) {
    int tid = threadIdx.x; asm volatile("" : "+v"(tid));
    const int lane = tid & 63, r32 = lane & 31, h = lane >> 5, wid = tid >> 6;
    const size_t qrow = (size_t)b * SEQ + (size_t)qb * 256 + wid * 32 + r32;
    bf16x8 qf[8];
#pragma unroll
    for (int d0 = 0; d0 < 8; ++d0) qf[d0] = *(const bf16x8*)(QX + qrow * 512 + head * 128 + 16 * d0 + 8 * h);
    f32x16 o[4];
#pragma unroll
    for (int db = 0; db < 4; ++db) o[db] = (f32x16){};
    float mrun = -INFINITY, lsum = 0.f;
#pragma unroll 1
    for (int half = 0; half < 2; ++half) {
        __syncthreads();
#pragma unroll
        for (int i = 0; i < 4; ++i) { const int c = tid + 512 * i, row = c >> 4, ch = c & 15;
            const v4u kv = *(const GAS v4u*)(KX + ((size_t)b * NMEM + half * 128 + row) * 512 + head * 128 + ch * 8);
            const v4u vv = *(const GAS v4u*)(VT + ((size_t)head * 128 + row) * 512 + b * NMEM + half * 128 + ch * 8);
            *(LAS v4u*)(lds + KIMG + row * RB + ch * 16) = kv; *(LAS v4u*)(lds + VIMG + row * RB + ch * 16) = vv; }
        __syncthreads();
        f32x16 st[4];
#pragma unroll
        for (int kb = 0; kb < 4; ++kb) { st[kb] = (f32x16){};
#pragma unroll
            for (int d0 = 0; d0 < 8; ++d0) { const bf16x8 a = *(const LAS bf16x8*)(lds + KIMG + (32 * kb + r32) * RB + (16 * d0 + 8 * h) * 2);
                st[kb] = __builtin_amdgcn_mfma_f32_32x32x16_bf16(a, qf[d0], st[kb], 0, 0, 0); } }
        float mloc = st[0][0];
#pragma unroll
        for (int kb = 0; kb < 4; ++kb)
#pragma unroll
            for (int i = 0; i < 16; ++i) mloc = fmaxf(mloc, st[kb][i]);
        const float mnew = fmaxf(mrun, swapmax(mloc)), alpha = __builtin_amdgcn_exp2f(mrun - mnew);
        float psum = 0.f;
#pragma unroll
        for (int kb = 0; kb < 4; ++kb)
#pragma unroll
            for (int i = 0; i < 16; ++i) { st[kb][i] = __builtin_amdgcn_exp2f(st[kb][i] - mnew); psum += st[kb][i]; }
        lsum = lsum * alpha + psum; mrun = mnew;
#pragma unroll
        for (int db = 0; db < 4; ++db)
#pragma unroll
            for (int i = 0; i < 16; ++i) o[db][i] *= alpha;
#pragma unroll
        for (int kb = 0; kb < 4; ++kb)
#pragma unroll
            for (int sp = 0; sp < 2; ++sp) {
                v4u pw; pw.x = cvtpk(st[kb][8 * sp], st[kb][8 * sp + 1]); pw.y = cvtpk(st[kb][8 * sp + 2], st[kb][8 * sp + 3]); pw.z = cvtpk(st[kb][8 * sp + 4], st[kb][8 * sp + 5]); pw.w = cvtpk(st[kb][8 * sp + 6], st[kb][8 * sp + 7]);
                const bf16x8 pb = __builtin_bit_cast(bf16x8, pw);
#pragma unroll
                for (int db = 0; db < 4; ++db) { const LAS unsigned char* vp = lds + VIMG + (32 * db + r32) * RB + (32 * kb + 16 * sp + 4 * h) * 2;
                    const s16x4 lo = *(const LAS s16x4*)vp, hi = *(const LAS s16x4*)(vp + 16);
                    const bf16x8 va = {lo[0], lo[1], lo[2], lo[3], hi[0], hi[1], hi[2], hi[3]};
                    o[db] = __builtin_amdgcn_mfma_f32_32x32x16_bf16(va, pb, o[db], 0, 0, 0); } }
    }
    const float inv = 1.f / swapadd(lsum);
    bf16* orow = OX + qrow * 512 + head * 128;
#pragma unroll
    for (int db = 0; db < 4; ++db)
#pragma unroll
        for (int g = 0; g < 4; ++g) {
            const unsigned long long w = (unsigned long long)cvtpk(o[db][4 * g] * inv, o[db][4 * g + 1] * inv) | ((unsigned long long)cvtpk(o[db][4 * g + 2] * inv, o[db][4 * g + 3] * inv) << 32);
            *(GAS unsigned long long*)(orow + 32 * db + 8 * g + 4 * h) = w; }
}
}


namespace mls {
typedef short bf16x8 __attribute__((ext_vector_type(8)));
typedef short s16x4 __attribute__((ext_vector_type(4)));
typedef float f32x16 __attribute__((ext_vector_type(16)));
constexpr int RB = 128, VIMG = 0, KIMG = 8192, ATAB = 8192, NTAB = 8448;
__device__ __forceinline__ s16x4 trd(const LAS unsigned char* p) { typedef short v4i16_t __attribute__((ext_vector_type(4))); return __builtin_bit_cast(s16x4, __builtin_amdgcn_ds_read_tr16_b64_v4i16((LAS v4i16_t*)p)); }
__device__ __forceinline__ bf16x8 cat8(s16x4 lo, s16x4 hi) { return (bf16x8){lo[0], lo[1], lo[2], lo[3], hi[0], hi[1], hi[2], hi[3]}; }
__device__ __forceinline__ unsigned cvtpk(float lo, float hi) { typedef float f2 __attribute__((ext_vector_type(2))); typedef __bf16 b2 __attribute__((ext_vector_type(2))); f2 v = {lo, hi}; b2 b = __builtin_convertvector(v, b2); return __builtin_bit_cast(unsigned, b); }
__device__ __forceinline__ bf16x8 pack8(const float* f) { v4u w; w.x = cvtpk(f[0], f[1]); w.y = cvtpk(f[2], f[3]); w.z = cvtpk(f[4], f[5]); w.w = cvtpk(f[6], f[7]); return __builtin_bit_cast(bf16x8, w); }
__device__ __forceinline__ float swapadd(float m) { auto rr = __builtin_amdgcn_permlane32_swap(__float_as_uint(m), __float_as_uint(m), false, false); return __uint_as_float(rr[0]) + __uint_as_float(rr[1]); }
__device__ __forceinline__ int crow(int r, int hi) { return (r & 3) + 8 * (r >> 2) + 4 * hi; }

__device__ __forceinline__ void u_unit(const Ptrs& P, int bhk, LAS unsigned char* wl, int lane) {
    const int bh = bhk / NCH, k = bhk % NCH, b = bh / MH, hd = bh % MH; const size_t row0 = (size_t)b * SEQ + (size_t)k * 64;
    const int r32 = lane & 31, h = lane >> 5;
    const float li = WSP(const float, WS_GATE)[(size_t)hd * M + row0 + lane], bl = WSP(const float, WS_BL)[(size_t)bh * SEQ + k * 64 + lane];
    const float wg = __expf(WSP(const float, WS_BT)[bhk] - bl + li - WSP(const float, WS_MS)[bh * (NCH + 1) + k + 1]);
    const bf16* vsrc = WSP(const bf16, R_T0 + SZ_T) + row0 * 512 + hd * 64; const bf16* ksrc = WSP(const bf16, R_MQK) + row0 * 512 + 256 + hd * 64;
#pragma unroll
    for (int i = 0; i < 8; ++i) { const int row = i * 8 + (lane >> 3), ch = lane & 7;
        *(LAS v4u*)(wl + VIMG + row * RB + ch * 16) = *(const GAS v4u*)(vsrc + (size_t)row * 512 + ch * 8);
        const v4u kk = *(const GAS v4u*)(ksrc + (size_t)row * 512 + ch * 8); float f[8]; unpack8(kk, f); const float w = __shfl(wg, row);
#pragma unroll
        for (int e = 0; e < 8; ++e) f[e] *= w;
        *(LAS bf16x8*)(wl + KIMG + row * RB + ch * 16) = pack8(f); }
    f32x16 acc[2][2];
#pragma unroll
    for (int a = 0; a < 2; ++a)
#pragma unroll
        for (int c = 0; c < 2; ++c) acc[a][c] = (f32x16){};
    const unsigned toff = (unsigned)(((lane & 15) >> 2) * RB + (16 * ((lane >> 4) & 1) + 4 * (lane & 3)) * 2);
#pragma unroll
    for (int st = 0; st < 4; ++st) { bf16x8 af[2], bf_[2];
#pragma unroll
        for (int c = 0; c < 2; ++c) { const LAS unsigned char* pv = wl + VIMG + (16 * st + 8 * h) * RB + toff + 64 * c; af[c] = cat8(trd(pv), trd(pv + 4 * RB));
                                      const LAS unsigned char* pk = wl + KIMG + (16 * st + 8 * h) * RB + toff + 64 * c; bf_[c] = cat8(trd(pk), trd(pk + 4 * RB)); }
#pragma unroll
        for (int jb = 0; jb < 2; ++jb)
#pragma unroll
            for (int ib = 0; ib < 2; ++ib) acc[jb][ib] = __builtin_amdgcn_mfma_f32_32x32x16_bf16(af[jb], bf_[ib], acc[jb][ib], 0, 0, 0); }
    float* UT = WSP(float, R_CST) + (size_t)bhk * 4096;
#pragma unroll
    for (int jb = 0; jb < 2; ++jb)
#pragma unroll
        for (int ib = 0; ib < 2; ++ib)
#pragma unroll
            for (int e = 0; e < 16; ++e) UT[(32 * jb + crow(e, h)) * 64 + 32 * ib + r32] = acc[jb][ib][e];
    float sn = 0.f;
#pragma unroll 8
    for (int r = 0; r < 64; ++r) sn += bf2f(*(const LAS bf16*)(wl + KIMG + r * RB + lane * 2));
    WSP(float, WS_NST)[(size_t)bhk * 64 + lane] = sn;
}

__device__ __forceinline__ void decay_apply(f32x16& tile, int sb, int tb, const LAS float* atab, float mx, float& dsum, int r32, int h) {
#pragma unroll
    for (int g = 0; g < 4; ++g) { const f32x4 av = *(const LAS f32x4*)(atab + 32 * sb + 8 * g + 4 * h);
#pragma unroll
        for (int c = 0; c < 4; ++c) { const int sidx = 32 * sb + 8 * g + 4 * h + c, t = 32 * tb + r32;
            const float w = (sidx <= t) ? __expf(av[c] - mx) : 0.f; tile[4 * g + c] *= w; dsum += tile[4 * g + c]; } }
}
__device__ __forceinline__ bf16x8 packstep(const f32x16& x, int st) { v4u w; w.x = cvtpk(x[8 * st], x[8 * st + 1]); w.y = cvtpk(x[8 * st + 2], x[8 * st + 3]); w.z = cvtpk(x[8 * st + 4], x[8 * st + 5]); w.w = cvtpk(x[8 * st + 6], x[8 * st + 7]); return __builtin_bit_cast(bf16x8, w); }

__device__ __forceinline__ void out_unit(const Ptrs& P, int l, int bhk, LAS unsigned char* wl, int lane) {
    const int bh = bhk / NCH, k = bhk % NCH, b = bh / MH, hd = bh % MH; const size_t row0 = (size_t)b * SEQ + (size_t)k * 64;
    const int r32 = lane & 31, h = lane >> 5;
    const bf16* T1 = WSP(const bf16, R_T0 + SZ_T); const bf16* MQK = WSP(const bf16, R_MQK);
    const bf16* vsrc = T1 + row0 * 512 + hd * 64;
    v4u vreg[8];
#pragma unroll
    for (int i = 0; i < 8; ++i) { const int row = i * 8 + (lane >> 3), ch = lane & 7; vreg[i] = *(const GAS v4u*)(vsrc + (size_t)row * 512 + ch * 8); }
    bf16x8 qf[2][4], kf[2][4];
#pragma unroll
    for (int tb = 0; tb < 2; ++tb)
#pragma unroll
        for (int d0 = 0; d0 < 4; ++d0) { qf[tb][d0] = *(const bf16x8*)(MQK + (row0 + 32 * tb + r32) * 512 + hd * 64 + 16 * d0 + 8 * h);
                                         kf[tb][d0] = *(const bf16x8*)(MQK + (row0 + 32 * tb + r32) * 512 + 256 + hd * 64 + 16 * d0 + 8 * h); }
    const float li_s = WSP(const float, WS_GATE)[(size_t)hd * M + row0 + lane], bl_s = WSP(const float, WS_BL)[(size_t)bh * SEQ + k * 64 + lane];
    const float mk = WSP(const float, WS_MS)[bh * (NCH + 1) + k]; const float nst = WSP(const float, WS_NST)[(size_t)bhk * 64 + lane];
    const float a_s = li_s - bl_s; float pm = a_s;
#pragma unroll
    for (int o = 1; o < 64; o <<= 1) { const float t = __shfl_up(pm, o); if (lane >= o) pm = fmaxf(pm, t); }
    LAS float* atab = (LAS float*)(wl + ATAB); LAS float* ntab = (LAS float*)(wl + NTAB);
    atab[lane] = a_s; ntab[lane] = nst;
    float mx[2], wi[2], blt[2];
#pragma unroll
    for (int tb = 0; tb < 2; ++tb) { const int t = 32 * tb + r32; blt[tb] = __shfl(bl_s, t); mx[tb] = fmaxf(mk, __shfl(pm, t)); wi[tb] = __expf(mk - mx[tb]); }
#pragma unroll
    for (int i = 0; i < 8; ++i) { const int row = i * 8 + (lane >> 3), ch = lane & 7; *(LAS v4u*)(wl + VIMG + row * RB + ch * 16) = vreg[i]; }
    f32x16 s00 = (f32x16){}, s01 = (f32x16){}, s11 = (f32x16){};
#pragma unroll
    for (int d0 = 0; d0 < 4; ++d0) { s00 = __builtin_amdgcn_mfma_f32_32x32x16_bf16(kf[0][d0], qf[0][d0], s00, 0, 0, 0);
        s01 = __builtin_amdgcn_mfma_f32_32x32x16_bf16(kf[0][d0], qf[1][d0], s01, 0, 0, 0); s11 = __builtin_amdgcn_mfma_f32_32x32x16_bf16(kf[1][d0], qf[1][d0], s11, 0, 0, 0); }
    float dsum[2] = {0.f, 0.f};
    decay_apply(s00, 0, 0, atab, mx[0], dsum[0], r32, h); decay_apply(s01, 0, 1, atab, mx[1], dsum[1], r32, h); decay_apply(s11, 1, 1, atab, mx[1], dsum[1], r32, h);
    f32x16 nacc[2][2];
#pragma unroll
    for (int a = 0; a < 2; ++a)
#pragma unroll
        for (int c = 0; c < 2; ++c) nacc[a][c] = (f32x16){};
    const unsigned toff = (unsigned)(((lane & 15) >> 2) * RB + (16 * ((lane >> 4) & 1) + 4 * (lane & 3)) * 2);
#pragma unroll
    for (int sb = 0; sb < 2; ++sb)
#pragma unroll
        for (int st = 0; st < 2; ++st) { bf16x8 va[2];
#pragma unroll
            for (int jb = 0; jb < 2; ++jb) { const LAS unsigned char* pv = wl + VIMG + (32 * sb + 16 * st + 4 * h) * RB + toff + 64 * jb; va[jb] = cat8(trd(pv), trd(pv + 8 * RB)); }
            if (sb == 0) { const bf16x8 p0 = packstep(s00, st), p1 = packstep(s01, st);
#pragma unroll
                for (int jb = 0; jb < 2; ++jb) { nacc[jb][0] = __builtin_amdgcn_mfma_f32_32x32x16_bf16(va[jb], p0, nacc[jb][0], 0, 0, 0); nacc[jb][1] = __builtin_amdgcn_mfma_f32_32x32x16_bf16(va[jb], p1, nacc[jb][1], 0, 0, 0); }
            } else { const bf16x8 p1 = packstep(s11, st);
#pragma unroll
                for (int jb = 0; jb < 2; ++jb) nacc[jb][1] = __builtin_amdgcn_mfma_f32_32x32x16_bf16(va[jb], p1, nacc[jb][1], 0, 0, 0); } }
    const float* CT = WSP(const float, R_CST) + (size_t)bhk * 4096;
    float dint[2] = {0.f, 0.f};
#pragma unroll
    for (int st = 0; st < 4; ++st) { bf16x8 ca[2];
#pragma unroll
        for (int jb = 0; jb < 2; ++jb) { const float* cp = CT + (32 * jb + r32) * 64 + 16 * st + 8 * h; const f32x4 c0 = *(const f32x4*)cp, c1 = *(const f32x4*)(cp + 4);
            const float f[8] = {c0[0], c0[1], c0[2], c0[3], c1[0], c1[1], c1[2], c1[3]}; ca[jb] = pack8(f); }
        const f32x4 n0 = *(const LAS f32x4*)(ntab + 16 * st + 8 * h), n1 = *(const LAS f32x4*)(ntab + 16 * st + 8 * h + 4);
#pragma unroll
        for (int tb = 0; tb < 2; ++tb) { float f[8]; unpack8(__builtin_bit_cast(v4u, qf[tb][st]), f);
            dint[tb] += (f[0] * n0[0] + f[1] * n0[1]) + (f[2] * n0[2] + f[3] * n0[3]) + (f[4] * n1[0] + f[5] * n1[1]) + (f[6] * n1[2] + f[7] * n1[3]);
#pragma unroll
            for (int e = 0; e < 8; ++e) f[e] *= wi[tb];
            const bf16x8 qw = pack8(f);
#pragma unroll
            for (int jb = 0; jb < 2; ++jb) nacc[jb][tb] = __builtin_amdgcn_mfma_f32_32x32x16_bf16(ca[jb], qw, nacc[jb][tb], 0, 0, 0); } }
    const float* nw = P.in[I_MNW] + l * 256 + hd * 64; bf16* CAT = WSP(bf16, R_CAT);
#pragma unroll
    for (int tb = 0; tb < 2; ++tb) {
        const float den = swapadd(dsum[tb]) + wi[tb] * swapadd(dint[tb]);
        const float dinv = 1.f / fmaxf(fabsf(den), __expf(-(blt[tb] + mx[tb])));
        float ss = 0.f;
#pragma unroll
        for (int jb = 0; jb < 2; ++jb)
#pragma unroll
            for (int e = 0; e < 16; ++e) { const float v = nacc[jb][tb][e] * dinv; ss += v * v; }
        const float scale = dinv / sqrtf(swapadd(ss) * (1.f / 64.f) + EPS);
        const size_t row = row0 + 32 * tb + r32;
#pragma unroll
        for (int jb = 0; jb < 2; ++jb)
#pragma unroll
            for (int g = 0; g < 4; ++g) { const int j0 = 32 * jb + 8 * g + 4 * h; const f32x4 nwv = *(const f32x4*)(nw + j0);
                const unsigned long long mo = *(const GAS unsigned long long*)(T1 + row * 512 + 256 + hd * 64 + j0);
                const float m0 = __uint_as_float((unsigned)(mo << 16)), m1 = __uint_as_float((unsigned)mo & 0xffff0000u), m2 = __uint_as_float((unsigned)(mo >> 32) << 16), m3 = __uint_as_float((unsigned)(mo >> 32) & 0xffff0000u);
                const float y0 = nacc[jb][tb][4 * g] * scale * nwv[0] * __builtin_amdgcn_rcpf(1.f + __expf(-m0)), y1 = nacc[jb][tb][4 * g + 1] * scale * nwv[1] * __builtin_amdgcn_rcpf(1.f + __expf(-m1));
                const float y2 = nacc[jb][tb][4 * g + 2] * scale * nwv[2] * __builtin_amdgcn_rcpf(1.f + __expf(-m2)), y3 = nacc[jb][tb][4 * g + 3] * scale * nwv[3] * __builtin_amdgcn_rcpf(1.f + __expf(-m3));
                *(GAS unsigned long long*)(CAT + row * 1024 + hd * 64 + j0) = (unsigned long long)cvtpk(y0, y1) | ((unsigned long long)cvtpk(y2, y3) << 32); }
    }
}
__device__ __forceinline__ void state_scan(const Ptrs& P, long gtid, long gn) {
    const float* DEC = WSP(const float, WS_DEC); float* CST = WSP(float, R_CST); float* NST = WSP(float, WS_NST);
    for (long it = gtid; it < 8 * 4160; it += gn) {
        const int bh = (int)it / 4160, e = (int)it % 4160; float run = 0.f;
        float* base = e < 4096 ? CST + (size_t)bh * NCH * 4096 + e : NST + (size_t)bh * NCH * 64 + (e - 4096); const size_t stride = e < 4096 ? 4096 : 64;
        for (int k0 = 0; k0 < NCH; k0 += 16) { float u[16], d[16];
#pragma unroll
            for (int i = 0; i < 16; ++i) { u[i] = base[(size_t)(k0 + i) * stride]; d[i] = DEC[bh * NCH + k0 + i]; }
#pragma unroll
            for (int i = 0; i < 16; ++i) { base[(size_t)(k0 + i) * stride] = run; run = d[i] * run + u[i]; } }
    }
}
}

constexpr int RING_BYTES = 131072;
constexpr int MISC_OFF = RING_BYTES;
constexpr int PTR_OFF = RING_BYTES + 256;
constexpr int JOB_OFF = RING_BYTES + 512;
constexpr int LDS_BYTES = 147456;
constexpr int NWAVES = 8;

__device__ __forceinline__ float wave_sum(float v) {
#pragma unroll
    for (int o = 1; o < 64; o <<= 1) v += __shfl_xor(v, o);
    return v;
}
struct WJob { const float* W0; const float* W1; const float* rs; bf16* WT; int K, Nsrc, nblk, kind; float cs; int item0; int pad0, pad1; };
constexpr int MAX_JOBS = 32;
__device__ __forceinline__ void p0_transpose_item(const LAS WJob* jb, LAS float* scr, int item, int lane) {
    const int K = jb->K, N = jb->Nsrc, nblk = jb->nblk, kb = item / nblk, nb = item % nblk, k0 = 64 * kb;
    int which, col0; float cs; wmap(jb->kind, nb, which, col0, cs); cs *= jb->cs;
    const float* W = which ? jb->W1 : jb->W0; const float* rs = jb->rs;
    const float* src = W + (size_t)(k0 + (lane >> 5)) * N + col0 + (lane & 31);
    float v[32];
#pragma unroll
    for (int i = 0; i < 32; ++i) v[i] = __builtin_nontemporal_load(src + (size_t)(2 * i) * N);
#pragma unroll
    for (int i = 0; i < 32; ++i) scr[(2 * i + (lane >> 5)) * 33 + (lane & 31)] = v[i];
    LDS_WAIT(); asm volatile("" ::: "memory");
    const int c = lane & 7; bf16* WT = jb->WT;
    f32x4 r0 = {cs, cs, cs, cs}, r1 = r0;
    if (rs) { r0 = *(const f32x4*)(rs + k0 + 8 * c) * cs; r1 = *(const f32x4*)(rs + k0 + 8 * c + 4) * cs; }
#pragma unroll
    for (int j = 0; j < 4; ++j) { const int n = (lane >> 3) + 8 * j; const LAS float* sp = scr + (8 * c) * 33 + n;
        v4u o; o.x = pk2(sp[0 * 33] * r0[0], sp[1 * 33] * r0[1]); o.y = pk2(sp[2 * 33] * r0[2], sp[3 * 33] * r0[3]); o.z = pk2(sp[4 * 33] * r1[0], sp[5 * 33] * r1[1]); o.w = pk2(sp[6 * 33] * r1[2], sp[7 * 33] * r1[3]);
        __builtin_nontemporal_store(o, (GAS v4u*)(WT + (size_t)(nb * 32 + n) * K + k0 + 8 * c)); }
    LDS_WAIT(); asm volatile("" ::: "memory");
}
__device__ __forceinline__ void build_gw(const Ptrs& P, long gtid, long gn) {
    for (long it = gtid; it < 3 * 32 * 64; it += gn) {
        const int t = (int)(it / 2048), ks = (int)((it / 64) % 32), ln = (int)(it % 64), c = ln & 15, quad = ln >> 4;
        float hi[8], lo[8];
#pragma unroll
        for (int j = 0; j < 8; ++j) { const int k = 32 * ks + 8 * quad + j; float w;
            if (t < 2) w = P.in[I_NMIX][t * D + k] * P.in[I_WIN][(size_t)t * D * INW + (size_t)k * INW + (c < 8 ? 1024 + c : 3072 + c)];
            else w = (c < 8) ? P.in[I_NFFN][D + k] * P.in[I_RW][(size_t)k * 8 + c] : 0.f;
            const float h = bf2f(f2bf(w)); hi[j] = h; lo[j] = w - h; }
        v4u oh, ol; oh.x = pk2(hi[0], hi[1]); oh.y = pk2(hi[2], hi[3]); oh.z = pk2(hi[4], hi[5]); oh.w = pk2(hi[6], hi[7]); ol.x = pk2(lo[0], lo[1]); ol.y = pk2(lo[2], lo[3]); ol.z = pk2(lo[4], lo[5]); ol.w = pk2(lo[6], lo[7]);
        v4u* tab = (v4u*)(P.ws + WS_GW + (size_t)t * 65536); tab[(ks * 2 + 0) * 64 + ln] = oh; tab[(ks * 2 + 1) * 64 + ln] = ol;
    }
}
template <int MODE, bool PRE>
__device__ __forceinline__ void norm16(const Ptrs& P, int l, const float* src, bf16* XN, const unsigned* rss_in, int vcu, int G, int wave, int lane, LAS float* xch) {
    typedef short bf16x8 __attribute__((ext_vector_type(8)));
    const int r = lane & 15, quad = lane >> 4, kh = wave >> 2;
    const v4u* tab = (const v4u*)(P.ws + WS_GW + (size_t)(MODE == 2 ? 2 : l) * 65536) + lane;
    if constexpr (MODE == 2) { if (wave == 0 && lane < 8) ((LAS unsigned*)(xch + 2048))[64 * 4 + lane] = 0u; }
    for (int t0 = 0; t0 < M / 16; t0 += 4 * G) {
        const int task = t0 + (wave & 3) * G + vcu; const bool live = task < M / 16; const int r0 = (live ? task : 0) * 16;
        const float* xr = src + (size_t)(r0 + r) * D + 8 * quad; bf16* xo = XN + (size_t)(r0 + r) * D + 8 * quad;
        f32x4 acc = {0.f, 0.f, 0.f, 0.f}; float ss = 0.f;
#pragma unroll
        for (int kk = 0; kk < 16; ++kk) { const int ks = 16 * kh + kk;
            if constexpr (PRE) {
                const v4u h = *(const GAS v4u*)(xo + 32 * ks);
                const bf16x8 ah = __builtin_bit_cast(bf16x8, h);
                const bf16x8 bh = __builtin_bit_cast(bf16x8, tab[(ks * 2 + 0) * 64]), bl = __builtin_bit_cast(bf16x8, tab[(ks * 2 + 1) * 64]);
                acc = __builtin_amdgcn_mfma_f32_16x16x32_bf16(ah, bh, acc, 0, 0, 0); acc = __builtin_amdgcn_mfma_f32_16x16x32_bf16(ah, bl, acc, 0, 0, 0);
            } else {
            const f32x4 a = __builtin_nontemporal_load((const GAS f32x4*)(xr + 32 * ks)), b = __builtin_nontemporal_load((const GAS f32x4*)(xr + 32 * ks + 4));
            ss += (a[0] * a[0] + a[1] * a[1]) + (a[2] * a[2] + a[3] * a[3]) + (b[0] * b[0] + b[1] * b[1]) + (b[2] * b[2] + b[3] * b[3]);
            v4u h; h.x = pk2(a[0], a[1]); h.y = pk2(a[2], a[3]); h.z = pk2(b[0], b[1]); h.w = pk2(b[2], b[3]);
            if (live) *(GAS v4u*)(xo + 32 * ks) = h;
            if constexpr (MODE != 0) {
                float hf[8]; unpack8(h, hf);
                v4u lw; lw.x = pk2(a[0] - hf[0], a[1] - hf[1]); lw.y = pk2(a[2] - hf[2], a[3] - hf[3]); lw.z = pk2(b[0] - hf[4], b[1] - hf[5]); lw.w = pk2(b[2] - hf[6], b[3] - hf[7]);
                const bf16x8 ah = __builtin_bit_cast(bf16x8, h), al = __builtin_bit_cast(bf16x8, lw);
                const bf16x8 bh = __builtin_bit_cast(bf16x8, tab[(ks * 2 + 0) * 64]), bl = __builtin_bit_cast(bf16x8, tab[(ks * 2 + 1) * 64]);
                acc = __builtin_amdgcn_mfma_f32_16x16x32_bf16(ah, bh, acc, 0, 0, 0); acc = __builtin_amdgcn_mfma_f32_16x16x32_bf16(al, bh, acc, 0, 0, 0); acc = __builtin_amdgcn_mfma_f32_16x16x32_bf16(ah, bl, acc, 0, 0, 0);
            }
            }
        }
        { LAS float* xp = xch + ((wave & 3) * 64 + lane) * 5;
          if (kh == 1) { xp[0] = acc[0]; xp[1] = acc[1]; xp[2] = acc[2]; xp[3] = acc[3]; xp[4] = ss; }
          __syncthreads();
          if (kh == 0) { acc[0] += xp[0]; acc[1] += xp[1]; acc[2] += xp[2]; acc[3] += xp[3]; ss += xp[4]; }
          __syncthreads(); }
        if constexpr (MODE != 2) { if (kh == 1 || !live) continue; }
        if (MODE != 2 || (kh == 0 && live)) {
        unsigned sq;
        if constexpr (PRE) sq = rss_in[r0 + r]; else { ss += __shfl_xor(ss, 16); ss += __shfl_xor(ss, 32); sq = (unsigned)(ss * 16.f + 0.5f); if (lane < 16) WSP(unsigned, WS_RSTD)[r0 + lane] = sq; }
        ss = (float)sq * (1.f / 16.f);
        const float rstd = 1.f / sqrtf(ss * (1.f / D) + EPS);
        if constexpr (MODE != 0) {
            float z[4];
#pragma unroll
            for (int j = 0; j < 4; ++j) z[j] = acc[j] * __shfl(rstd, 4 * quad + j);
            if constexpr (MODE == 1) {
                const int g = r; f32x4 o;
#pragma unroll
                for (int j = 0; j < 4; ++j) { if (g < 4) o[j] = z[j] + P.in[I_MBI][l * 4 + g]; else if (g < 8) o[j] = logsigmoidf_(z[j] + P.in[I_MBF][l * 4 + g - 4]); else o[j] = logsigmoidf_(z[j] + P.in[I_FBF][l * 8 + g - 8]); }
                *(f32x4*)(WSP(float, WS_GATE) + (size_t)g * M + r0 + 4 * quad) = o;
            } else {
#pragma unroll
                for (int j = 0; j < 4; ++j) { float le[8];
#pragma unroll
                    for (int e = 0; e < 8; ++e) le[e] = __shfl(z[j], (lane & 48) + e);
                    int e1 = 0; float v1 = le[0];
#pragma unroll
                    for (int e = 1; e < 8; ++e) if (le[e] > v1) { v1 = le[e]; e1 = e; }
                    int e2 = -1; float v2 = -INFINITY;
#pragma unroll
                    for (int e = 0; e < 8; ++e) if (e != e1 && le[e] > v2) { v2 = le[e]; e2 = e; }
                    if (r == j) { const float g2 = 1.f / (1.f + expf(v1 - v2)), g1 = 1.f - g2;
                        LAS unsigned* sp = (LAS unsigned*)(xch + 2048) + ((wave & 3) * 16 + 4 * quad + j) * 4;
                        sp[0] = (unsigned)e1; sp[1] = (unsigned)e2; sp[2] = __float_as_uint(g1); sp[3] = __float_as_uint(g2); }
                }
            }
        }
        }
        if constexpr (MODE == 2) {
            LAS unsigned* selb = (LAS unsigned*)(xch + 2048); LAS unsigned* hacc = selb + 64 * 4;
            if (!(kh == 0 && live) && wave < 4 && r < 4) selb[((wave & 3) * 16 + 4 * quad + r) * 4] = 255u;
            __syncthreads();
            if (wave == 0) {
                const int w = lane >> 4, e1 = (int)selb[lane * 4], e2 = (int)selb[lane * 4 + 1]; const bool valid = e1 < 8;
                const unsigned long long below = (1ull << lane) - 1ull; int rank1 = 0, rank2 = 0; unsigned mynew = 0u;
#pragma unroll
                for (int e = 0; e < 8; ++e) { const unsigned old_ = hacc[e];
                    const unsigned long long m1 = __ballot(valid && e1 == e), m2 = __ballot(valid && e2 == e); const int c1 = __popcll(m1);
                    if (e1 == e) rank1 = (int)old_ + __popcll(m1 & below);
                    if (e2 == e) rank2 = (int)old_ + c1 + __popcll(m2 & below);
                    if (lane == e) mynew = old_ + (unsigned)(c1 + __popcll(m2)); }
                if (valid) { const int row = (t0 + w * G + vcu) * 16 + (lane & 15); unsigned* tk = WSP(unsigned, WS_TOK) + (size_t)row * 8;
                    tk[0] = (unsigned)e1; tk[1] = (unsigned)rank1; tk[2] = (unsigned)e2; tk[3] = (unsigned)rank2; tk[4] = selb[lane * 4 + 2]; tk[5] = selb[lane * 4 + 3]; }
                if (lane < 8) hacc[lane] = mynew;
            }
            __syncthreads();
        }
    }
    if constexpr (MODE == 2) { if (wave == 0 && lane < 8) WSP(unsigned, WS_BH)[vcu * 8 + lane] = ((LAS unsigned*)(xch + 2048))[64 * 4 + lane]; }
}
template <int MODE>
__device__ __forceinline__ void norm_rows(const Ptrs& P, int l, const float* src, bf16* XN, int nrows, int gw, int ngw, int lane) {
    for (int row = gw; row < nrows; row += ngw) {
        const GAS f32x4* xr = (const GAS f32x4*)(src + (size_t)row * D) + lane;
        f32x4 v[4]; float s2 = 0.f;
#pragma unroll
        for (int j = 0; j < 4; ++j) { v[j] = xr[64 * j]; s2 += (v[j].x * v[j].x + v[j].y * v[j].y) + (v[j].z * v[j].z + v[j].w * v[j].w); }
        const float rstd = 1.f / sqrtf(wave_sum(s2) * (1.f / D) + EPS);
        GAS unsigned long long* o8 = (GAS unsigned long long*)(XN + (size_t)row * D) + lane;
#pragma unroll
        for (int j = 0; j < 4; ++j) o8[64 * j] = (unsigned long long)pk2(v[j].x * rstd, v[j].y * rstd) | ((unsigned long long)pk2(v[j].z * rstd, v[j].w * rstd) << 32);
    }
}

__device__ __forceinline__ float wave_incl_scan(float v, int lane) {
#pragma unroll
    for (int o = 1; o < 64; o <<= 1) { const float t = __shfl_up(v, o); if (lane >= o) v += t; }
    return v;
}
__device__ __forceinline__ float wave_max(float v) {
#pragma unroll
    for (int o = 1; o < 64; o <<= 1) v = fmaxf(v, __shfl_xor(v, o));
    return v;
}
__device__ __forceinline__ void gate_scan_task(const Ptrs& P, int task, LAS float* scr, int tid) {
    const int lane = tid & 63, wave = tid >> 6; const float* GT = WSP(const float, WS_GATE);
    if (task < 16) {
        const int b = task / FH, h = task % FH; constexpr int EPT = SEQ / 512;
        const float* src = GT + (size_t)(8 + h) * M + (size_t)b * SEQ + tid * EPT; float* dst = WSP(float, WS_CF) + (size_t)task * SEQ + tid * EPT;
        float v[EPT]; float run = 0.f;
#pragma unroll
        for (int i = 0; i < EPT; i += 4) { const f32x4 x = *(const f32x4*)(src + i); run += x[0]; v[i] = run; run += x[1]; v[i + 1] = run; run += x[2]; v[i + 2] = run; run += x[3]; v[i + 3] = run; }
        const float wincl = wave_incl_scan(run, lane);
        if (lane == 63) scr[wave] = wincl;
        __syncthreads();
        float offs = wincl - run;
#pragma unroll
        for (int w = 0; w < 8; ++w) if (w < wave) offs += scr[w];
#pragma unroll
        for (int i = 0; i < EPT; i += 4) *(f32x4*)(dst + i) = (f32x4){(offs + v[i]) * LOG2E, (offs + v[i + 1]) * LOG2E, (offs + v[i + 2]) * LOG2E, (offs + v[i + 3]) * LOG2E};
        __syncthreads();
    } else {
        const int bh = task - 16, b = bh / MH, h = bh % MH;
        const float* lfp = GT + (size_t)(4 + h) * M + (size_t)b * SEQ; const float* lip = GT + (size_t)h * M + (size_t)b * SEQ;
        float* BL = WSP(float, WS_BL) + (size_t)bh * SEQ; float* BT = WSP(float, WS_BT) + bh * NCH; float* AK = WSP(float, WS_AK) + bh * NCH; float* MS = WSP(float, WS_MS) + bh * (NCH + 1);
        constexpr int CPW = NCH / 8;
        float lfv[CPW], liv[CPW];
#pragma unroll
        for (int i = 0; i < CPW; ++i) { const int k = wave + 8 * i; lfv[i] = lfp[k * 64 + lane]; liv[i] = lip[k * 64 + lane]; }
#pragma unroll
        for (int i = 0; i < CPW; ++i) { const int k = wave + 8 * i;
            const float bl = wave_incl_scan(lfv[i], lane); BL[k * 64 + lane] = bl;
            const float btot = __shfl(bl, 63); const float a = wave_max(btot - bl + liv[i]);
            if (lane == 0) { BT[k] = btot; AK[k] = a; scr[k] = btot; scr[NCH + k] = a; } }
        __syncthreads();
        if (wave == 0) { float* DEC = WSP(float, WS_DEC) + bh * NCH; constexpr int PL = NCH / 64;
            float f[PL], av[PL]; float run = 0.f;
#pragma unroll
            for (int i = 0; i < PL; ++i) { run += scr[lane * PL + i]; f[i] = run; av[i] = scr[NCH + lane * PL + i]; }
            const float offs = wave_incl_scan(run, lane) - run;
            float pm = -INFINITY; float c[PL];
#pragma unroll
            for (int i = 0; i < PL; ++i) { f[i] += offs; pm = fmaxf(pm, av[i] - f[i]); c[i] = pm; }
            float pin = pm;
#pragma unroll
            for (int o = 1; o < 64; o <<= 1) { const float t = __shfl_up(pin, o); if (lane >= o) pin = fmaxf(pin, t); }
            float pex = __shfl_up(pin, 1); if (lane == 0) pex = -INFINITY;
            float mprev = __shfl_up(fmaxf(0.f, pin) + f[PL - 1], 1); if (lane == 0) mprev = 0.f;
            if (lane == 0) MS[0] = 0.f;
#pragma unroll
            for (int i = 0; i < PL; ++i) { const int k = lane * PL + i; const float mn = f[i] + fmaxf(0.f, fmaxf(pex, c[i]));
                MS[k + 1] = mn; DEC[k] = __expf(scr[k] + mprev - mn); mprev = mn; } }
        __syncthreads();
    }
}
__device__ __forceinline__ void mconv_glu_vec(const Ptrs& P, int l, long gtid, long gn) {
    const bf16* T0 = WSP(const bf16, R_T0); bf16* MQK = WSP(bf16, R_MQK);
    const float* cw = P.in[I_MCW] + l * 4 * 512; const float* cb = P.in[I_MCB] + l * 512;
    for (long it0 = gtid; it0 < (long)M * 64; it0 += 4 * gn) {
        v4u w[4][4]; bool ok[4][4];
#pragma unroll
        for (int r = 0; r < 4; ++r) { const long it = it0 + r * gn; const int ch = (int)(it & 63); const long row = it >> 6; const int t = (int)(row % SEQ), c0 = ch * 8;
#pragma unroll
            for (int j = 0; j < 4; ++j) { ok[r][j] = it < (long)M * 64 && t - 3 + j >= 0; w[r][j] = (v4u){0u, 0u, 0u, 0u}; if (ok[r][j]) w[r][j] = *(const GAS v4u*)(T0 + (size_t)(row - 3 + j) * 512 + c0); } }
#pragma unroll
        for (int r = 0; r < 4; ++r) { const long it = it0 + r * gn; if (it >= (long)M * 64) continue; const int ch = (int)(it & 63); const long row = it >> 6; const int c0 = ch * 8;
            float acc[8];
#pragma unroll
            for (int i = 0; i < 8; ++i) acc[i] = cb[c0 + i];
#pragma unroll
            for (int j = 0; j < 4; ++j) { if (ok[r][j]) { float x[8]; unpack8(w[r][j], x);
#pragma unroll
                    for (int i = 0; i < 8; ++i) acc[i] += cw[j * 512 + c0 + i] * x[i]; } }
            const float sc = (c0 >= 256) ? 0.125f : 1.f; float y[8];
#pragma unroll
            for (int i = 0; i < 8; ++i) y[i] = acc[i] * __builtin_amdgcn_rcpf(1.f + __expf(-acc[i])) * sc;
            v4u o; o.x = pk2(y[0], y[1]); o.y = pk2(y[2], y[3]); o.z = pk2(y[4], y[5]); o.w = pk2(y[6], y[7]);
            *(GAS v4u*)(MQK + (size_t)row * 512 + c0) = o; }
    }
    const bf16* T2 = WSP(const bf16, R_T0 + 2 * SZ_T); bf16* GL = WSP(bf16, R_GL);
    for (long it0 = gtid; it0 < (long)M * 32; it0 += 4 * gn) {
        v4u wa[4], wg[4];
#pragma unroll
        for (int r = 0; r < 4; ++r) { const long it = it0 + r * gn; wa[r] = (v4u){0u, 0u, 0u, 0u}; wg[r] = wa[r];
            if (it < (long)M * 32) { const int c0 = (int)(it & 31) * 8; const long row = it >> 5; wa[r] = *(const GAS v4u*)(T2 + (size_t)row * 512 + c0); wg[r] = *(const GAS v4u*)(T2 + (size_t)row * 512 + 256 + c0); } }
#pragma unroll
        for (int r = 0; r < 4; ++r) { const long it = it0 + r * gn; if (it >= (long)M * 32) continue; const int c0 = (int)(it & 31) * 8; const long row = it >> 5;
            float a[8], g[8]; unpack8(wa[r], a); unpack8(wg[r], g); float y[8];
#pragma unroll
            for (int i = 0; i < 8; ++i) y[i] = a[i] * __builtin_amdgcn_rcpf(1.f + __expf(-g[i]));
            v4u o; o.x = pk2(y[0], y[1]); o.y = pk2(y[2], y[3]); o.z = pk2(y[4], y[5]); o.w = pk2(y[6], y[7]);
            *(GAS v4u*)(GL + (size_t)row * 256 + c0) = o; }
    }
}
__device__ __forceinline__ void cconv_ln_rows(const Ptrs& P, int l, int gw, int ngw, int lane) {
    const bf16* GL = WSP(const bf16, R_GL); bf16* CAT = WSP(bf16, R_CAT);
    const float* cw = P.in[I_CCW] + l * CK * 256 + 4 * lane; const int c0 = 4 * lane;
    const f32x4 cb = *(const f32x4*)(P.in[I_CCB] + l * 256 + c0), lw = *(const f32x4*)(P.in[I_CLW] + l * 256 + c0), lb = *(const f32x4*)(P.in[I_CLB] + l * 256 + c0);
    f32x4 w[CK];
#pragma unroll
    for (int j = 0; j < CK; ++j) w[j] = *(const f32x4*)(cw + j * 256);
    for (int task = gw; task < M / 8; task += ngw) {
        const int r0 = task * 8, t0 = r0 % SEQ;
        unsigned long long x[CK + 7];
#pragma unroll
        for (int i = 0; i < CK + 7; ++i) x[i] = (t0 - (CK - 1) + i >= 0) ? *(const GAS unsigned long long*)(GL + (size_t)(r0 - (CK - 1) + i) * 256 + c0) : 0ull;
        f32x4 acc[8];
#pragma unroll
        for (int o = 0; o < 8; ++o) acc[o] = cb;
#pragma unroll
        for (int i = 0; i < CK + 7; ++i) { const unsigned long long q = x[i];
            const f32x4 xf = {__uint_as_float((unsigned)(q << 16)), __uint_as_float((unsigned)q & 0xffff0000u), __uint_as_float((unsigned)(q >> 32) << 16), __uint_as_float((unsigned)(q >> 32) & 0xffff0000u)};
#pragma unroll
            for (int o = 0; o < 8; ++o) if (i - o >= 0 && i - o < CK) acc[o] += w[i - o] * xf; }
#pragma unroll
        for (int o = 0; o < 8; ++o) {
            const float mean = wave_sum((acc[o][0] + acc[o][1]) + (acc[o][2] + acc[o][3])) * (1.f / 256.f);
            const f32x4 d = acc[o] - mean; const float rstd = 1.f / sqrtf(wave_sum((d[0] * d[0] + d[1] * d[1]) + (d[2] * d[2] + d[3] * d[3])) * (1.f / 256.f) + EPS);
            f32x4 y = d * rstd * lw + lb;
#pragma unroll
            for (int i = 0; i < 4; ++i) y[i] = y[i] * __builtin_amdgcn_rcpf(1.f + __expf(-y[i]));
            *(GAS unsigned long long*)(CAT + (size_t)(r0 + o) * 1024 + 256 + c0) = (unsigned long long)pk2(y[0], y[1]) | ((unsigned long long)pk2(y[2], y[3]) << 32); }
    }
}
__device__ __forceinline__ void fox_keynorms(const Ptrs& P, int gw, int ngw, int lane) {
    const bf16* K = WSP(const bf16, R_T0 + 4 * SZ_T); float* KN2 = WSP(float, WS_KN2); constexpr int NTT = SEQ / 64;
    for (int u = gw; u < BATCH * FH * NTT; u += ngw) { const int bh = u / NTT, tile = u % NTT, b = bh / FH, h = bh % FH;
        const bf16* kr = K + ((size_t)b * SEQ + tile * 64 + lane) * 512 + h * 64; float ss = 0.f;
#pragma unroll
        for (int c = 0; c < 8; ++c) { const v4u v = *(const GAS v4u*)(kr + 8 * c); float f[8]; unpack8(v, f);
#pragma unroll
            for (int e = 0; e < 8; ++e) ss += f[e] * f[e]; }
        ss = wave_max(ss); if (lane == 0) KN2[u] = ss; }
}
__device__ __forceinline__ void moe_gather(const Ptrs& P, int gw, int ngw, int lane, int wave, int vcu, int G, LAS unsigned char* lds) {
    LAS unsigned* base = (LAS unsigned*)lds; LAS unsigned* tot = base + 1024 * 8;
    { const unsigned* BH = WSP(const unsigned, WS_BH); const int per = (G + 63) / 64; unsigned run = 0u;
      for (int k = 0; k < per; ++k) { const int blk = lane * per + k; if (blk < G) run += BH[blk * 8 + wave]; }
      unsigned incl = run;
#pragma unroll
      for (int o = 1; o < 64; o <<= 1) { const unsigned t = __shfl_up(incl, o); if (lane >= o) incl += t; }
      unsigned ex = incl - run;
      for (int k = 0; k < per; ++k) { const int blk = lane * per + k; if (blk < G) { base[blk * 8 + wave] = ex; ex += BH[blk * 8 + wave]; } }
      if (lane == 63) tot[wave] = incl; }
    __syncthreads();
    unsigned* cntg = WSP(unsigned, WS_CTL) + CW_CNT;
    if (vcu == 0 && wave == 0 && lane < 8) cntg[lane] = tot[lane];
    unsigned cnt[8];
#pragma unroll
    for (int e = 0; e < 8; ++e) cnt[e] = tot[e];
    int off[9]; { int o = 0;
#pragma unroll
        for (int e = 0; e < 8; ++e) { off[e] = o; o += ((int)cnt[e] + 255) & ~255; }
        off[8] = o; }
    const bf16* XN = WSP(const bf16, R_XN); bf16* XNS = WSP(bf16, R_XNS);
    for (int row0 = gw; row0 < M; row0 += 4 * ngw) {
        v4u ta[4], a[4], b[4]; unsigned rv[4];
#pragma unroll
        for (int r = 0; r < 4; ++r) { const int row = row0 + r * ngw; if (row < M) { ta[r] = *(const GAS v4u*)(WSP(unsigned, WS_TOK) + (size_t)row * 8);
                const GAS v4u* srcp = (const GAS v4u*)(XN + (size_t)row * D) + lane; a[r] = __builtin_nontemporal_load(srcp); b[r] = __builtin_nontemporal_load(srcp + 64); rv[r] = WSP(const unsigned, WS_RSS)[(size_t)4 * M + row]; } }
#pragma unroll
        for (int r = 0; r < 4; ++r) { const int row = row0 + r * ngw; if (row < M) {
                unsigned* tk = WSP(unsigned, WS_TOK) + (size_t)row * 8;
                const int e1 = (int)ta[r][0], p1 = (int)ta[r][1], e2 = (int)ta[r][2], p2 = (int)ta[r][3];
                int o1 = 0, o2 = 0;
#pragma unroll
                for (int e = 0; e < 8; ++e) { if (e == e1) o1 = off[e]; if (e == e2) o2 = off[e]; }
                const int blk = (row >> 4) % G;
                const int s1 = o1 + (int)base[blk * 8 + e1] + p1, s2 = o2 + (int)base[blk * 8 + e2] + p2;
                if (lane == 0) { tk[6] = (unsigned)s1; tk[7] = (unsigned)s2; WSP(unsigned, WS_RSTDS)[s1] = rv[r]; WSP(unsigned, WS_RSTDS)[s2] = rv[r];
                    const float g1 = __uint_as_float(tk[4]), g2 = __uint_as_float(tk[5]); WSP(float, WS_SLOTG)[s1] = g1; WSP(float, WS_SLOTG)[s2] = -g2; }
                GAS v4u* d1 = (GAS v4u*)(XNS + (size_t)s1 * D) + lane; GAS v4u* d2 = (GAS v4u*)(XNS + (size_t)s2 * D) + lane;
                d1[0] = a[r]; d1[64] = b[r]; d2[0] = a[r]; d2[64] = b[r]; } }
    }
    for (int w = gw; w < 8 * 256; w += ngw) {
        const int e = w >> 8, r = w & 255; int oe = 0, oe1 = 0, ce = 0;
#pragma unroll
        for (int j = 0; j < 8; ++j) if (j == e) { oe = off[j]; oe1 = off[j + 1]; ce = (int)cnt[j]; }
        const int slot = oe + ce + r;
        if (slot < oe1) { GAS v4u* dp = (GAS v4u*)(XNS + (size_t)slot * D) + lane; const v4u z = {0u, 0u, 0u, 0u}; dp[0] = z; dp[64] = z; if (lane == 0) { unsigned zlo = 0u; asm volatile("" : "+v"(zlo)); WSP(unsigned, WS_RSTDS)[slot] = zlo; WSP(float, WS_SLOTG)[slot] = __uint_as_float(zlo); } }
    }
}
__device__ __forceinline__ void moe_combine_final(const Ptrs& P, int gw, int ngw, int lane) {
    const bf16* Y = WSP(const bf16, R_XNS); const float* nw = P.in[I_NFIN];
    for (int row0 = gw; row0 < M; row0 += 4 * ngw) {
        int s1[4], s2[4];
#pragma unroll
        for (int r = 0; r < 4; ++r) { const int row = row0 + r * ngw; const unsigned* tk = WSP(const unsigned, WS_TOK) + (size_t)(row < M ? row : 0) * 8; s1[r] = (int)tk[6]; s2[r] = (int)tk[7]; }
        unsigned long long ya[4][4], yb[4][4];
#pragma unroll
        for (int r = 0; r < 4; ++r) { const GAS unsigned long long* y1 = (const GAS unsigned long long*)(Y + (size_t)s1[r] * D) + lane; const GAS unsigned long long* y2 = (const GAS unsigned long long*)(Y + (size_t)s2[r] * D) + lane;
#pragma unroll
            for (int j = 0; j < 4; ++j) { ya[r][j] = __builtin_nontemporal_load(y1 + 64 * j); yb[r][j] = __builtin_nontemporal_load(y2 + 64 * j); } }
#pragma unroll
        for (int r = 0; r < 4; ++r) { const int row = row0 + r * ngw; if (row < M) {
            GAS f32x4* orow = (GAS f32x4*)(P.xres + (size_t)row * D) + lane;
            f32x4 v[4]; float ssq = 0.f;
#pragma unroll
            for (int j = 0; j < 4; ++j) { const unsigned long long a = ya[r][j], b = yb[r][j];
                v[j].x = bf2f((bf16)(a & 0xffff)) + bf2f((bf16)(b & 0xffff));
                v[j].y = bf2f((bf16)((a >> 16) & 0xffff)) + bf2f((bf16)((b >> 16) & 0xffff));
                v[j].z = bf2f((bf16)((a >> 32) & 0xffff)) + bf2f((bf16)((b >> 32) & 0xffff));
                v[j].w = bf2f((bf16)((a >> 48) & 0xffff)) + bf2f((bf16)((b >> 48) & 0xffff));
                ssq += (v[j].x * v[j].x + v[j].y * v[j].y) + (v[j].z * v[j].z + v[j].w * v[j].w); }
            const float rstd = 1.f / sqrtf(wave_sum(ssq) * (1.f / D) + EPS);
#pragma unroll
            for (int j = 0; j < 4; ++j) { const f32x4 w = *((const f32x4*)nw + lane + 64 * j); __builtin_nontemporal_store(v[j] * rstd * w, orow + 64 * j); } } }
    }
}

#ifndef MK_PER_PHASE
#define MK_PER_PHASE 0
#endif
constexpr int PH_PER_LAYER = 14, N_PHASES = 1 + 2 * PH_PER_LAYER + 1;
__device__ __forceinline__ Ptrs launder(const Ptrs& a) { Ptrs p = a; asm volatile("" : "+s"(p.ws), "+s"(p.xres)); return p; }
struct Args { const float* in[N_IN]; float* xres; unsigned char* ws; int ph_lo, ph_hi; };

__global__ void __launch_bounds__(NWAVES * 64, 2) trunk_fwd(Args args) {
    extern __shared__ __attribute__((aligned(16))) unsigned char lds_raw[];
    LAS unsigned char* lds = (LAS unsigned char*)lds_raw;
    Ptrs P0; P0.in = (const float* const LAS*)(lds + PTR_OFF); P0.xres = args.xres; P0.ws = args.ws;
    const int tid = threadIdx.x, wave0 = __builtin_amdgcn_readfirstlane(tid >> 6);
    const int G0 = gridDim.x; const int bx0 = blockIdx.x; const int vcu0 = (G0 % 8 == 0) ? (bx0 % 8) * (G0 / 8) + bx0 / 8 : bx0;
    volatile LAS unsigned* MISC = (volatile LAS unsigned*)(lds + MISC_OFF);
    if (tid < 64) MISC[tid] = 0u;
    if (tid < N_IN) ((const float* LAS*)(lds + PTR_OFF))[tid] = args.in[tid];
    __syncthreads();
    unsigned* ctl = (unsigned*)(P0.ws + WS_CTL);
    XcdBarrier bar; bar.bar = ctl + CW_BAR; bar.x = 0; bar.st = nullptr;
    if (!MK_PER_PHASE) bar = xcd_barrier_post(ctl + CW_BAR, MISC + 8);
    const int lo = args.ph_lo, hi = args.ph_hi; int ph = 0;
#ifndef SITEMASK
#define SITEMASK 0xffffffffull
#endif
#define SITE(k) ((SITEMASK >> (k)) & 1ull)
#define PH_ON() (ph >= lo && ph < hi)
#define PH_IF(k) if (PH_ON() && SITE(k))
#define PH_CTX() Ptrs P = launder(P0); int tidp = threadIdx.x; asm volatile("" : "+v"(tidp)); int G = G0, bx = bx0, vcu = vcu0, wave = wave0; asm volatile("" : "+s"(G), "+s"(bx), "+s"(vcu), "+s"(wave)); const int gw = vcu * NWAVES + wave, ngw = G * NWAVES; const long gn = (long)G * (NWAVES * 64); const int lane = tidp & 63; const long gtid = (long)bx * (NWAVES * 64) + tidp; (void)lane; (void)gw; (void)gtid; (void)ngw; (void)gn
#define PH_END() do { if (PH_ON() && ph + 1 < hi) { if (!MK_PER_PHASE) { XcdBarrier b2_ = bar; asm volatile("" : "+s"(b2_.bar), "+s"(b2_.x)); xcd_barrier(b2_); } } ++ph; } while (0)

    PH_IF(0) { PH_CTX();
        LAS WJob* jobs = (LAS WJob*)(lds + JOB_OFF);
        if (tid == 0) {
            int nj = 0, item = 0;
#define ADDJOB(W0_, W1_, rs_, dst_, K_, Nsrc_, Ndst_, kind_, cs_) do { LAS WJob* j_ = jobs + nj; j_->W0 = (W0_); j_->W1 = (W1_); j_->rs = (rs_); j_->WT = WSP(bf16, (dst_)); j_->K = (K_); j_->Nsrc = (Nsrc_); \
                j_->nblk = (Ndst_) / 32; j_->kind = (kind_); j_->cs = (cs_); j_->item0 = item; item += ((K_) / 64) * ((Ndst_) / 32); ++nj; } while (0)
            for (int l = 0; l < 2; ++l) {
                const size_t wl = R_WL + (size_t)l * WL_SIZE;
                ADDJOB(P.in[I_WIN] + (size_t)l * D * INW, nullptr, P.in[I_NMIX] + l * D, wl + WL_IN, D, INW, NZ, 1, 1.f);
                ADDJOB(P.in[I_WOUT] + (size_t)l * D * D, nullptr, nullptr, wl + WL_OUT, D, D, D, 0, 1.f);
                ADDJOB(P.in[I_WQ] + (size_t)l * D * 512, nullptr, P.in[I_NXA] + l * D, wl + WL_Q, D, 512, 512, 0, XAT_QS);
                ADDJOB(P.in[I_WKV] + (size_t)l * D * 1024, nullptr, P.in[I_NMEM] + l * D, wl + WL_KV, D, 1024, 1024, 0, 1.f);
                ADDJOB(P.in[I_WO] + (size_t)l * 512 * D, nullptr, nullptr, wl + WL_O, 512, D, D, 0, 1.f);
            }
            ADDJOB(P.in[I_FG], P.in[I_FU], P.in[I_NFFN], R_WGU, D, DFF, 2 * DFF, 2, 1.f);
            ADDJOB(P.in[I_FD], nullptr, nullptr, R_WDN, DFF, D, D, 0, 1.f);
            for (int e = 0; e < NE; ++e) {
                ADDJOB(P.in[I_MG] + (size_t)e * D * DFF, P.in[I_MU] + (size_t)e * D * DFF, P.in[I_NFFN] + D, WS_WMGU + (size_t)e * 2 * DFF * D * 2, D, DFF, 2 * DFF, 2, 1.f);
                ADDJOB(P.in[I_MD] + (size_t)e * DFF * D, nullptr, nullptr, WS_WMD + (size_t)e * D * DFF * 2, DFF, D, D, 0, 1.f);
            }
#undef ADDJOB
            MISC[16] = (unsigned)nj; MISC[17] = (unsigned)item;
        }
        __syncthreads();
        const int nj = (int)MISC[16], nitems = (int)MISC[17];
        LAS float* scr = (LAS float*)(lds + wave * 16384);
        for (int it = gw; it < nitems; it += ngw) {
            int j = 0;
            for (int q = 1; q < nj; ++q) if (jobs[q].item0 <= it) j = q;
            p0_transpose_item(jobs + j, scr, it - jobs[j].item0, lane);
        }
        norm_rows<0>(P, 0, P.in[I_MEM], WSP(bf16, WS_MEMN), BATCH * NMEM, gw, ngw, lane);
        build_gw(P, gtid, gn);
    }
    PH_END();

    for (int l = 0; l < 2; ++l) {
        const size_t wl = R_WL + (size_t)l * WL_SIZE;
        PH_IF(1) { PH_CTX(); if (l == 0) norm16<1, false>(P, l, P.in[I_X], WSP(bf16, R_XN), nullptr, vcu, G, wave, lane, (LAS float*)lds);
            else norm16<1, true>(P, l, nullptr, WSP(bf16, R_XN), WSP(const unsigned, WS_RSS) + (size_t)2 * M, vcu, G, wave, lane, (LAS float*)lds); }
        PH_END();
        PH_IF(2) { PH_CTX();
            for (int task = bx; task < 24; task += G) gate_scan_task(P, task, (LAS float*)lds, tidp);
            { pg8::Gemm g{WSP(const bf16, R_XN), WSP(const bf16, wl + WL_IN), M, NZ, D}; pg8::StaticOrder S; S.init(M, NZ, G, bx);
              pg8::EpiBf16 E{WSP(bf16, R_T0), 512, 512, (size_t)M * 512, (l == 0) ? WSP(const unsigned, WS_RSTD) : WSP(const unsigned, WS_RSS) + (size_t)2 * M};
              pg8::gemm_phase<pg8::EpiBf16, pg8::StaticOrder, true, true>(lds, g, S, E); }
        }
        PH_END();
        PH_IF(3) { PH_CTX(); mconv_glu_vec(P, l, gtid, gn); fox_keynorms(P, gw, ngw, lane); }
        PH_END();
        PH_IF(4) { PH_CTX(); for (int u = wave * G + vcu; u < 8 * NCH; u += ngw) mls::u_unit(P, u, lds + wave * 16384, lane);
            for (int u = (7 - wave) * G + vcu; u < BATCH * FH * fox::NQB; u += ngw) { const int qb = fox::NQB - 1 - u / (BATCH * FH), bh = u % (BATCH * FH);
                const int j0 = fox::unit_j0_wave(bh, qb, (const fox::bf16h*)WSP(bf16, R_T0 + 3 * SZ_T), WSP(const float, WS_KN2), WSP(const float, WS_CF) + (size_t)bh * SEQ, lane); if (lane == 0) WSP(int, WS_J0)[u] = j0; }
            cconv_ln_rows(P, l, gw, ngw, lane); }
        PH_END();
        PH_IF(5) { PH_CTX(); mls::state_scan(P, gtid, gn); }
        PH_END();
        PH_IF(7) { PH_CTX();
            { pg8::Gemm g{WSP(const bf16, WS_MEMN), WSP(const bf16, wl + WL_KV), BATCH * NMEM, 512, D}; pg8::StaticOrder S; S.init(BATCH * NMEM, 512, G, bx);
              pg8::EpiBf16 E{WSP(bf16, WS_KVX) + (size_t)l * 512 * 1024, 512, 0, 0, nullptr};
              pg8::gemm_phase<pg8::EpiBf16, pg8::StaticOrder, true, true>(lds, g, S, E); }
            { pg8::Gemm g{WSP(const bf16, wl + WL_KV) + (size_t)512 * 1024, WSP(const bf16, WS_MEMN), 512, BATCH * NMEM, D}; pg8::StaticOrder S; S.init(512, BATCH * NMEM, G, (bx + G - 4) % G);
              pg8::EpiBf16 E{WSP(bf16, WS_KVX) + (size_t)l * 512 * 1024 + 512 * 512, 512, 0, 0, nullptr};
              pg8::gemm_phase<pg8::EpiBf16, pg8::StaticOrder, true, true>(lds, g, S, E); }
            { static_assert(fox::LDS_BYTES <= RING_BYTES, "fox LDS");
              const fox::bf16h* Q = (const fox::bf16h*)WSP(bf16, R_T0 + 3 * SZ_T); const fox::bf16h* Kp = (const fox::bf16h*)WSP(bf16, R_T0 + 4 * SZ_T); const fox::bf16h* Vp = (const fox::bf16h*)WSP(bf16, R_T0 + 5 * SZ_T);
              fox::bf16h* O = (fox::bf16h*)(WSP(bf16, R_CAT) + 512); const float* CF = WSP(const float, WS_CF);
              for (int it = vcu; it < 8 * NCH / 8; it += G) mls::out_unit(P, l, it * 8 + wave, lds + wave * 16384, lane);
              __syncthreads();
              const int nitems = BATCH * FH * fox::NQB; unsigned* qhead = ctl + CW_FOXQ + 64 * l;
              for (;;) {
                  if (tidp == 0) MISC[24] = __hip_atomic_fetch_add(qhead, 1u, RLX_AGENT);
                  __syncthreads();
                  const int u = (int)MISC[24];
                  __syncthreads();
                  if (u >= nitems) break;
                  const int qb = fox::NQB - 1 - u / (BATCH * FH), bh = u % (BATCH * FH);
                  const int j0 = WSP(const int, WS_J0)[u];
                  fox::attn_unit<8>(bh / FH, bh % FH, qb, j0, Q, Kp, Vp, O, CF + (size_t)bh * SEQ, (char*)lds_raw); } }

 }
        PH_END();
        PH_IF(8) { PH_CTX(); pg8::Gemm g{WSP(const bf16, R_CAT), WSP(const bf16, wl + WL_OUT), M, D, D}; pg8::StaticOrder S; S.init(M, D, G, bx);
            pg8::EpiRes E{WSP(bf16, R_XN), D, WSP(unsigned, WS_RSS) + (size_t)(l ? 3 : 0) * M};
            pg8::gemm_phase<pg8::EpiRes, pg8::StaticOrder, true, true>(lds, g, S, E); }
        PH_END();
        PH_IF(10) { PH_CTX(); pg8::Gemm g{WSP(const bf16, R_XN), WSP(const bf16, wl + WL_Q), M, 512, D}; pg8::StaticOrder S; S.init(M, 512, G, bx);
            pg8::EpiBf16 E{WSP(bf16, R_QX), 512, 0, 0, WSP(const unsigned, WS_RSS) + (size_t)(l ? 3 : 0) * M};
            pg8::gemm_phase<pg8::EpiBf16, pg8::StaticOrder, true, true>(lds, g, S, E); }
        PH_END();
        PH_IF(11) { PH_CTX(); static_assert(xat::LDS_BYTES <= RING_BYTES, "xat LDS");
            const bf16* KXp = WSP(const bf16, WS_KVX) + (size_t)l * 512 * 1024;
            for (int L = vcu; L < BATCH * XH * (SEQ / 256); L += G) { const int qb = L % (SEQ / 256), bhd = L / (SEQ / 256);
                xat::unit(bhd / XH, bhd % XH, qb, WSP(const bf16, R_QX), KXp, KXp + 512 * 512, WSP(bf16, R_OX), lds); } }
        PH_END();
        PH_IF(12) { PH_CTX(); pg8::Gemm g{WSP(const bf16, R_OX), WSP(const bf16, wl + WL_O), M, D, 512}; pg8::StaticOrder S; S.init(M, D, G, bx);
            pg8::EpiRes E{WSP(bf16, R_XN), D, WSP(unsigned, WS_RSS) + (size_t)(l ? 4 : 1) * M};
            pg8::gemm_phase<pg8::EpiRes, pg8::StaticOrder, true, true>(lds, g, S, E); }
        PH_END();
        if (l == 0) {
            PH_IF(14) { PH_CTX(); pg8::Gemm g{WSP(const bf16, R_XN), WSP(const bf16, R_WGU), M, 2 * DFF, D}; pg8::StaticOrder S; S.init(M, 2 * DFF, G, bx);
                pg8::EpiSwiGLU E{WSP(bf16, R_HD), DFF, WSP(const unsigned, WS_RSS) + (size_t)1 * M};
                pg8::gemm_phase<pg8::EpiSwiGLU, pg8::StaticOrder, true, true>(lds, g, S, E); }
            PH_END();
            PH_IF(15) { PH_CTX(); pg8::Gemm g{WSP(const bf16, R_HD), WSP(const bf16, R_WDN), M, D, DFF}; pg8::StaticOrder S; S.init(M, D, G, bx);
                pg8::EpiRes E{WSP(bf16, R_XN), D, WSP(unsigned, WS_RSS) + (size_t)2 * M};
                pg8::gemm_phase<pg8::EpiRes, pg8::StaticOrder, true, true>(lds, g, S, E); }
            PH_END();
            ph += 2;
        } else {
            PH_IF(16) { PH_CTX(); norm16<2, true>(P, l, nullptr, WSP(bf16, R_XN), WSP(const unsigned, WS_RSS) + (size_t)4 * M, vcu, G, wave, lane, (LAS float*)lds); }
            PH_END();
            PH_IF(17) { PH_CTX(); moe_gather(P, gw, ngw, lane, wave, vcu, G, lds); }
            PH_END();
            PH_IF(18) { PH_CTX(); pg8::Gemm g{WSP(const bf16, R_XNS), WSP(const bf16, WS_WMGU), 0, 2 * DFF, D}; pg8::GroupedOrder S; S.init(2 * DFF, G, bx, ctl + CW_CNT, (size_t)2 * DFF * D * 2);
                pg8::EpiSwiGLU E{WSP(bf16, R_HM), DFF, WSP(const unsigned, WS_RSTDS)};
                pg8::gemm_phase<pg8::EpiSwiGLU, pg8::GroupedOrder, true, true>(lds, g, S, E); }
            PH_END();
            PH_IF(19) { PH_CTX(); pg8::Gemm g{WSP(const bf16, R_HM), WSP(const bf16, WS_WMD), 0, D, DFF}; pg8::GroupedTailOrder S; S.init(D, G, bx, ctl + CW_CNT, (size_t)D * DFF * 2, DFF / pg8::BK);
                pg8::EpiMoeOutT E{WSP(bf16, R_XNS), D, WSP(const float, WS_SLOTG), WSP(float, WS_WMGU)  , ctl + CW_TAIL};
                pg8::gemm_phase<pg8::EpiMoeOutT, pg8::GroupedTailOrder, true, true>(lds, g, S, E); }
            PH_END();
        }
    }
    PH_IF(20) { PH_CTX(); moe_combine_final(P, gw, ngw, lane); }
#undef PH_ON
#undef PH_END
}

extern "C" void kernel_launch(void* const* d_in, const int* in_sizes, int n_in, void* d_out, int out_size, void* d_ws, size_t ws_size, hipStream_t stream) {
    static int grid = 0;
    if (grid == 0) {
        if (n_in != N_IN || out_size != M * D || ws_size < WS_END) { fprintf(stderr, "kernel_launch: unexpected shapes (n_in %d, out %d, ws %zu < %zu); nothing launched\n", n_in, out_size, ws_size, (size_t)WS_END); grid = -1; return; }
        int dev = 0, cus = 0, per_cu = 0;
        if (hipGetDevice(&dev) != hipSuccess || hipDeviceGetAttribute(&cus, hipDeviceAttributeMultiprocessorCount, dev) != hipSuccess) { grid = -1; return; }
        if (hipFuncSetAttribute((const void*)trunk_fwd, hipFuncAttributeMaxDynamicSharedMemorySize, LDS_BYTES) != hipSuccess) { fprintf(stderr, "kernel_launch: hipFuncSetAttribute failed\n"); grid = -1; return; }
        if (hipOccupancyMaxActiveBlocksPerMultiprocessor(&per_cu, (const void*)trunk_fwd, NWAVES * 64, LDS_BYTES) != hipSuccess || per_cu < 1) { fprintf(stderr, "kernel_launch: occupancy query says %d\n", per_cu); (void)hipGetLastError(); grid = -1; return; }
        grid = cus;
    }
    if (grid < 0) return;
    (void)in_sizes;
    if (hipMemsetAsync((char*)d_ws + WS_CTL, 0, CTL_ZERO_BYTES, stream) != hipSuccess) return;
    Args a; memset(&a, 0, sizeof(a));
    for (int i = 0; i < N_IN; ++i) a.in[i] = (const float*)d_in[i];
    a.xres = (float*)d_out; a.ws = (unsigned char*)d_ws;
#if MK_PER_PHASE
    for (int p = 0; p < N_PHASES; ++p) { a.ph_lo = p; a.ph_hi = p + 1; hipLaunchKernelGGL(trunk_fwd, dim3(grid), dim3(NWAVES * 64), LDS_BYTES, stream, a); }
#else
    a.ph_lo = 0; a.ph_hi = N_PHASES;
    hipLaunchKernelGGL(trunk_fwd, dim3(grid), dim3(NWAVES * 64), LDS_BYTES, stream, a);
#endif
}
#endif
```

```cpp
#if defined(HOST_EMU)
#include <cmath>
#include <cstring>
#include <cstdint>
#include <cstddef>
#define DEVFN static inline
#define PHFN static inline
#else
#include <hip/hip_runtime.h>
#include <cstdio>
#include <cstdint>
#include <cstring>
#define DEVFN __device__ __forceinline__
#define PHFN __device__ __forceinline__
#endif

#ifndef CFG_SEQ
#define CFG_SEQ 8192
#endif
constexpr int BATCH = 2, SEQ = CFG_SEQ, D = 1024, M = BATCH * SEQ;
constexpr int MH = 4, MCH = 64, NCH = SEQ / MCH;
constexpr int CK = 31;
constexpr int FH = 8;
constexpr int XH = 4, XD = 128, NMEM = 256;
constexpr int DFF = 2816, NE = 8, INW = 3088;
constexpr int NZ = 3072;
constexpr int SLOTS_MAX = 2 * M + NE * 256;
constexpr float EPS = 1e-6f;
constexpr float LOG2E = 1.4426950408889634f;
constexpr float FOX_QS = 0.125f * LOG2E;
constexpr float XAT_QS = 0.08838834764831845f * LOG2E;

enum { I_X = 0, I_MEM, I_NMIX, I_WIN, I_MCW, I_MCB, I_MBI, I_MBF, I_MNW, I_CCW, I_CCB, I_CLW, I_CLB, I_FBF, I_WOUT, I_NXA, I_NMEM, I_WQ, I_WKV, I_WO, I_NFFN,
       I_FG, I_FU, I_FD, I_RW, I_MG, I_MU, I_MD, I_NFIN, N_IN };

typedef unsigned short bf16;
constexpr size_t al4k(size_t x) { return (x + 4095) & ~(size_t)4095; }
constexpr size_t MiB = (size_t)1 << 20;
constexpr size_t WS_CTL = 0, CTL_ZERO_BYTES = 1 * MiB;
constexpr size_t WS_GATE = 1 * MiB;
constexpr size_t WS_CF = WS_GATE + al4k((size_t)M * 16 * 4);
constexpr size_t WS_BL = WS_CF + al4k((size_t)16 * SEQ * 4);
constexpr size_t WS_BT = WS_BL + al4k((size_t)8 * SEQ * 4);
constexpr size_t WS_AK = WS_BT + al4k((size_t)8 * NCH * 4);
constexpr size_t WS_MS = WS_AK + al4k((size_t)8 * NCH * 4);
constexpr size_t WS_DEC = WS_MS + al4k((size_t)8 * (NCH + 1) * 4);
constexpr size_t WS_KN2 = WS_DEC + al4k((size_t)8 * NCH * 4);
constexpr size_t WS_J0 = WS_KN2 + al4k((size_t)16 * (SEQ / 64) * 4);
constexpr size_t WS_BH = WS_J0 + al4k((size_t)16 * (SEQ / 256) * 4);
constexpr size_t WS_NST = WS_BH + al4k((size_t)1024 * 8 * 4);
constexpr size_t WS_TOK = WS_NST + al4k((size_t)8 * NCH * 64 * 4);
constexpr size_t WS_RSTD = WS_TOK + al4k((size_t)M * 32);
constexpr size_t WS_RSTDS = WS_RSTD + al4k((size_t)M * 8);
constexpr size_t WS_SLOTG = WS_RSTDS + al4k((size_t)SLOTS_MAX * 8);
constexpr size_t WS_GW = WS_SLOTG + al4k((size_t)SLOTS_MAX * 4);
constexpr size_t WS_MEMN = WS_GW + 3 * 65536;
constexpr size_t WS_KVX = WS_MEMN + al4k((size_t)512 * 1024 * 2);
constexpr size_t WS_WMGU = WS_KVX + al4k((size_t)2 * 512 * 1024 * 2);
constexpr size_t WS_WMD = WS_WMGU + (size_t)NE * 5632 * 1024 * 2;
constexpr size_t WS_R = al4k(WS_WMD + (size_t)NE * 1024 * 2816 * 2);
constexpr size_t WL_IN = 0, WL_OUT = WL_IN + (size_t)NZ * 1024 * 2, WL_Q = WL_OUT + (size_t)1024 * 1024 * 2, WL_KV = WL_Q + (size_t)512 * 1024 * 2,
                 WL_O = WL_KV + (size_t)1024 * 1024 * 2, WL_SIZE = WL_O + (size_t)1024 * 512 * 2;
constexpr size_t R_WL = WS_R;
constexpr size_t R_WGU = R_WL + 2 * WL_SIZE;
constexpr size_t R_WDN = R_WGU + (size_t)5632 * 1024 * 2;
constexpr size_t R_XN = al4k(R_WDN + (size_t)1024 * 2816 * 2);
constexpr size_t SZ_T = (size_t)M * 512 * 2;
constexpr size_t R_T0 = R_XN + 2 * SZ_T;
constexpr size_t R_MQK = R_T0 + 6 * SZ_T;
constexpr size_t R_CAT = R_MQK + SZ_T;
constexpr size_t R_CST = R_CAT + 2 * SZ_T;
constexpr size_t R_GL = R_CST + (size_t)8 * NCH * 4096 * 4;
constexpr size_t R_HC = R_GL + (size_t)M * 256 * 2;
constexpr size_t R_END1 = R_HC + (size_t)M * 256 * 4;
constexpr size_t R_QX = R_T0, R_OX = R_T0 + SZ_T;
constexpr size_t R_HD = R_T0;
constexpr size_t R_HM = WS_R;
constexpr size_t R_XNS = R_HM + (size_t)SLOTS_MAX * 2816 * 2;
constexpr size_t R_END2 = R_XNS + (size_t)SLOTS_MAX * 1024 * 2;
constexpr size_t WS_END = R_END1 > R_END2 ? R_END1 : R_END2;
static_assert((size_t)M * 2816 * 2 <= 6 * SZ_T, "dense hidden fits T0..T5");
static_assert(R_XN + 2 * SZ_T <= R_XNS, "XN must not overlap the gathered rows");
constexpr float F8_SA = 8.f, F8_SWGU = 256.f, F8_SH = 16.f, F8_SWDN = 512.f;
constexpr size_t WS_XQ = WS_WMGU + (size_t)NE * 5632 * 1024;
constexpr int CW_TMO = 0, CW_CNT = 64  , CW_TAIL = 512  , CW_FOXQ = 128  , CW_BAR = 4096;
constexpr size_t WS_RSS = 65536;
static_assert(WS_RSS + (size_t)5 * M * 4 <= CTL_ZERO_BYTES, "RSS arrays inside the zeroed region");

#if defined(HOST_EMU)
struct Ptrs { const float* in[N_IN]; float* xres; unsigned char* ws; };
#else
struct Ptrs { const float* const __attribute__((address_space(3)))* in; float* xres; unsigned char* ws; };
#endif
#define WSP(type, off) ((type*)(P.ws + (off)))

DEVFN float bf2f(bf16 v) { unsigned u = (unsigned)v << 16; float f; memcpy(&f, &u, 4); return f; }
DEVFN bf16 f2bf(float f) { unsigned u; memcpy(&u, &f, 4); return (bf16)((u + 0x7fffu + ((u >> 16) & 1u)) >> 16); }
DEVFN float sigmoidf_(float x) { return 1.f / (1.f + expf(-x)); }
#if defined(HOST_EMU)
DEVFN float logsigmoidf_(float x) { return fminf(x, 0.f) - log1pf(expf(-fabsf(x))); }
#else
DEVFN float logsigmoidf_(float x) { return fminf(x, 0.f) - __logf(1.f + __expf(-fabsf(x))); }
#endif

DEVFN void wmap(int kind, int nb, int& which, int& col0, float& cs) {
    which = 0; cs = 1.f; const int n0 = nb * 32;
    if (kind == 0) { col0 = n0; }
    else if (kind == 1) { col0 = n0 < 1024 ? n0 : n0 + 8; if (n0 >= 1536 && n0 < 2048) cs = FOX_QS; }
    else { const int tile = nb >> 3, w = nb & 7; which = w >> 2; col0 = tile * 128 + (w & 3) * 32; }
}

#if !defined(HOST_EMU)
namespace pg8 {
#define PG8_LAS __attribute__((address_space(3)))
typedef unsigned short bf16_t;
typedef short bf16x8 __attribute__((ext_vector_type(8)));
typedef float f32x4 __attribute__((ext_vector_type(4)));
typedef unsigned u32x4 __attribute__((ext_vector_type(4)));
constexpr int BM = 256, BK = 64, HALF = 128, HTB = HALF * BK * 2, STAGE_BYTES = 8 * HTB, NXCD = 8, WGM = 4;
__host__ __device__ __forceinline__ int lds_byte(int r, int c) { const int st = (r >> 4) * 2 + (c >> 5), rr = r & 15, cc = c & 31, ob = rr * 64 + cc * 2; return st * 1024 + (ob ^ (((ob >> 9) & 1) << 5)); }
__host__ __device__ __forceinline__ void stage_rc(int b, int& R, int& C) { const int st = b / 1024, sb = b % 1024, swz = sb ^ (((sb >> 9) & 1) << 5); R = (st >> 1) * 16 + swz / 64; C = (st & 1) * 32 + (swz % 64) / 2; }
__host__ __device__ __forceinline__ int perm32(int rho) { const int n = rho >> 4, i = rho & 15; return 8 * (i >> 2) + 4 * n + (i & 3); }

struct Unit { int pm, pn; size_t bofs; int nt, ks, ti, s; size_t aofs; };
struct Gemm { const bf16_t* A; const bf16_t* Bt; int M, N, K; };

struct StaticOrder {
    static constexpr bool VAR_K = false;
    int nM, nN, nwg, G, c;
    __device__ void init(int M_, int N_, int G_, int c_) { nM = M_ / BM; nN = N_ / BM; nwg = nM * nN; G = G_; c = c_; }
    __device__ bool next(int i, Unit& u) const {
        const long L = (long)i * G + c; if (L >= nwg) return false;
        int wgid = (int)L; { const int q = nwg / NXCD, r = nwg % NXCD, xcd = wgid % NXCD, off = wgid / NXCD; wgid = (xcd < r ? xcd * (q + 1) : r * (q + 1) + (xcd - r) * q) + off; }
        const int nig = WGM * nN, gid = wgid / nig, fm = gid * WGM, gsz = (nM - fm) < WGM ? (nM - fm) : WGM;
        u.pm = fm + ((wgid % nig) % gsz); u.pn = (wgid % nig) / gsz; u.bofs = 0; return true;
    }
    __device__ __forceinline__ void a_ready(const Unit&) const {}
    __device__ __forceinline__ void done(const Unit&) const {}
};
struct GroupedOrder {
    static constexpr bool VAR_K = false;
    int nM, nN, nwg, G, c; int off[9]; size_t estride;
    __device__ void init(int N_, int G_, int c_, const unsigned* cnt, size_t estride_) {
        int o = 0;
#pragma unroll
        for (int e = 0; e < 8; ++e) { off[e] = o; o += ((int)cnt[e] + 255) & ~255; }
        off[8] = o; nM = o / BM; nN = N_ / BM; nwg = nM * nN; G = G_; c = c_; estride = estride_;
    }
    __device__ bool next(int i, Unit& u) const {
        const long L = (long)i * G + c; if (L >= nwg) return false;
        int wgid = (int)L; { const int q = nwg / NXCD, r = nwg % NXCD, xcd = wgid % NXCD, o2 = wgid / NXCD; wgid = (xcd < r ? xcd * (q + 1) : r * (q + 1) + (xcd - r) * q) + o2; }
        const int nig = WGM * nN, gid = wgid / nig, fm = gid * WGM, gsz = (nM - fm) < WGM ? (nM - fm) : WGM;
        u.pm = fm + ((wgid % nig) % gsz); u.pn = (wgid % nig) / gsz;
        int e = 0;
#pragma unroll
        for (int j = 1; j < 8; ++j) e += (off[j] <= u.pm * BM) ? 1 : 0;
        u.bofs = (size_t)e * estride; return true;
    }
    __device__ __forceinline__ void a_ready(const Unit&) const {}
    __device__ __forceinline__ void done(const Unit&) const {}
};

struct GroupedTailOrder {
    static constexpr bool VAR_K = true;
    int nM, nN, nwg, G, c, nfull, T, s, sh, ntot, NT; int off[9]; size_t estride;
    __device__ __forceinline__ void init(int N_, int G_, int c_, const unsigned* cnt, size_t estride_, int NT_) {
        int o = 0;
#pragma unroll
        for (int e = 0; e < 8; ++e) { off[e] = o; o += ((int)cnt[e] + 255) & ~255; }
        off[8] = o; nM = o / BM; nN = N_ / BM; nwg = nM * nN; G = G_; c = c_; estride = estride_; NT = NT_;
        const int rounds = nwg / G; T = nwg - rounds * G;
        s = (T == 0) ? 1 : (T * 8 <= G ? 8 : (T * 4 <= G ? 4 : (T * 2 <= G ? 2 : 1))); sh = (s == 8) ? 3 : (s >> 1);
        if (s == 1) { nfull = nwg; T = 0; } else nfull = rounds * G;
        ntot = nfull + T * s;
    }
    __device__ __forceinline__ bool next(int i, Unit& u) const {
        const long L = (long)i * G + c; if (L >= ntot) return false;
        int wgid = (int)L, ks = 0, ti = -1;
        if (wgid >= nfull) { const int mu = wgid - nfull; ti = mu >> sh; ks = mu - (ti << sh); wgid = nfull + ti; }
        { const int q = nwg / NXCD, r = nwg % NXCD, xcd = wgid % NXCD, o2 = wgid / NXCD; wgid = (xcd < r ? xcd * (q + 1) : r * (q + 1) + (xcd - r) * q) + o2; }
        const int nig = WGM * nN, gid = wgid / nig, fm = gid * WGM, gsz = (nM - fm) < WGM ? (nM - fm) : WGM;
        u.pm = fm + ((wgid % nig) % gsz); u.pn = (wgid % nig) / gsz;
        int e = 0;
#pragma unroll
        for (int j = 1; j < 8; ++j) e += (off[j] <= u.pm * BM) ? 1 : 0;
        int kt0 = 0, ntu = NT;
        if (ti >= 0) { const int base = (NT >> sh) & ~1, ex = (NT - (base << sh)) >> 1;
            ntu = base + (ks < ex ? 2 : 0); kt0 = ks * base + 2 * (ks < ex ? ks : ex); }
        u.aofs = (size_t)kt0 * BK * 2; u.bofs = (size_t)e * estride + u.aofs; u.nt = ntu; u.ks = ks; u.ti = ti; u.s = s; return true;
    }
    __device__ __forceinline__ void a_ready(const Unit&) const {}
    __device__ __forceinline__ void done(const Unit&) const {}
};

__device__ __forceinline__ unsigned cvt_pk_bf16(float lo, float hi) { unsigned r; asm volatile("v_cvt_pk_bf16_f32 %0, %1, %2" : "=v"(r) : "v"(lo), "v"(hi)); return r; }

struct EpiBf16 {
    static constexpr bool PERM = true, AFTER_DRAIN = false, HAS_PRE = true;
    __device__ __forceinline__ void preload(unsigned (&q)[8], const Unit& u, int wr, int fr) const {
        if (rs) { const __attribute__((address_space(1))) unsigned* rp = (const __attribute__((address_space(1))) unsigned*)rs + u.pm * BM + wr * 64 + fr;
#pragma unroll
            for (int i = 0; i < 8; ++i) q[i] = rp[(i >> 2) * HALF + (i & 3) * 16]; } }
    bf16_t* O; int ldc; int split_cols; size_t split_stride; const unsigned* rs;
    __device__ __forceinline__ void operator()(const f32x4 (&acc)[2][2][4][2], const Unit& u, int wr, int wc, int fr, int fq, const unsigned (&q)[8]) const {
        const int row0 = u.pm * BM + wr * 64 + fr; int colt = u.pn * BM; bf16_t* base = O;
        if (split_cols) { const int t = colt / split_cols; base += (size_t)t * split_stride; colt -= t * split_cols; }
        const int col0 = colt + wc * 32 + 8 * fq;
        float sc[2][4];
#pragma unroll
        for (int ai = 0; ai < 2; ++ai)
#pragma unroll
            for (int m = 0; m < 4; ++m) sc[ai][m] = rs ? rsqrtf((float)q[ai * 4 + m] * (1.f / (16.f * 1024.f)) + 1e-6f) : 1.f;
#pragma unroll
        for (int ai = 0; ai < 2; ++ai)
#pragma unroll
            for (int m = 0; m < 4; ++m) { bf16_t* rowp = base + (size_t)(row0 + ai * HALF + m * 16) * ldc + col0;
#pragma unroll
                for (int bj = 0; bj < 2; ++bj) { const f32x4 v0 = acc[ai][bj][m][0] * sc[ai][m], v1 = acc[ai][bj][m][1] * sc[ai][m];
                    u32x4 w; w.x = cvt_pk_bf16(v0[0], v0[1]); w.y = cvt_pk_bf16(v0[2], v0[3]); w.z = cvt_pk_bf16(v1[0], v1[1]); w.w = cvt_pk_bf16(v1[2], v1[3]);
                    *(u32x4*)(rowp + bj * HALF) = w; } }
    }
};
struct EpiRes {
    static constexpr bool PERM = true, AFTER_DRAIN = false, HAS_PRE = false;
    bf16_t* X; int ldc; unsigned* rss;
    __device__ __forceinline__ void operator()(const f32x4 (&acc)[2][2][4][2], const Unit& u, int wr, int wc, int fr, int fq) const {
        const int row0 = u.pm * BM + wr * 64 + fr, col0 = u.pn * BM + wc * 32 + 8 * fq;
        typedef __attribute__((address_space(1))) u32x4 gu32x4;
        u32x4 b[2][4][2];
#pragma unroll
        for (int ai = 0; ai < 2; ++ai)
#pragma unroll
            for (int m = 0; m < 4; ++m)
#pragma unroll
                for (int bj = 0; bj < 2; ++bj) b[ai][m][bj] = *(const gu32x4*)(X + (size_t)(row0 + ai * HALF + m * 16) * ldc + col0 + bj * HALF);
#pragma unroll
        for (int ai = 0; ai < 2; ++ai)
#pragma unroll
            for (int m = 0; m < 4; ++m) { bf16_t* rowp = X + (size_t)(row0 + ai * HALF + m * 16) * ldc + col0; float ss = 0.f;
#pragma unroll
                for (int bj = 0; bj < 2; ++bj) { float v[8];
#pragma unroll
                    for (int i = 0; i < 4; ++i) { v[2 * i] = __uint_as_float(b[ai][m][bj][i] << 16) + acc[ai][bj][m][i >> 1][(2 * i) & 3]; v[2 * i + 1] = __uint_as_float(b[ai][m][bj][i] & 0xffff0000u) + acc[ai][bj][m][i >> 1][(2 * i + 1) & 3]; }
                    u32x4 w; w.x = cvt_pk_bf16(v[0], v[1]); w.y = cvt_pk_bf16(v[2], v[3]); w.z = cvt_pk_bf16(v[4], v[5]); w.w = cvt_pk_bf16(v[6], v[7]);
                    *(gu32x4*)(rowp + bj * HALF) = w;
#pragma unroll
                    for (int i = 0; i < 8; ++i) ss += v[i] * v[i]; }
                ss += __shfl_xor(ss, 16); ss += __shfl_xor(ss, 32);
                if (fq == 0) __hip_atomic_fetch_add(rss + row0 + ai * HALF + m * 16, (unsigned)(ss * 16.f + 0.5f), __ATOMIC_RELAXED, __HIP_MEMORY_SCOPE_AGENT); }
    }
};
struct EpiMoeOut {
    static constexpr bool PERM = true, AFTER_DRAIN = false, HAS_PRE = false;
    bf16_t* Y; int ldc; const float* sg;
    __device__ __forceinline__ void operator()(const f32x4 (&acc)[2][2][4][2], const Unit& u, int wr, int wc, int fr, int fq) const {
        const int row0 = u.pm * BM + wr * 64 + fr, col0 = u.pn * BM + wc * 32 + 8 * fq;
        typedef __attribute__((address_space(1))) u32x4 gu32x4;
        float g[2][4];
        { const __attribute__((address_space(1))) float* gp = (const __attribute__((address_space(1))) float*)sg + row0;
#pragma unroll
          for (int ai = 0; ai < 2; ++ai)
#pragma unroll
              for (int m = 0; m < 4; ++m) g[ai][m] = gp[ai * HALF + m * 16]; }
        u32x4 b[2][4][2];
#pragma unroll
        for (int ai = 0; ai < 2; ++ai)
#pragma unroll
            for (int m = 0; m < 4; ++m)
#pragma unroll
                for (int bj = 0; bj < 2; ++bj) { b[ai][m][bj] = (u32x4){0u, 0u, 0u, 0u}; if (g[ai][m] > 0.f) b[ai][m][bj] = *(const gu32x4*)(Y + (size_t)(row0 + ai * HALF + m * 16) * ldc + col0 + bj * HALF); }
#pragma unroll
        for (int ai = 0; ai < 2; ++ai)
#pragma unroll
            for (int m = 0; m < 4; ++m) { bf16_t* rowp = Y + (size_t)(row0 + ai * HALF + m * 16) * ldc + col0; const float ga = fabsf(g[ai][m]);
#pragma unroll
                for (int bj = 0; bj < 2; ++bj) { float v[8];
#pragma unroll
                    for (int i = 0; i < 4; ++i) { v[2 * i] = __uint_as_float(b[ai][m][bj][i] << 16) + ga * acc[ai][bj][m][i >> 1][(2 * i) & 3]; v[2 * i + 1] = __uint_as_float(b[ai][m][bj][i] & 0xffff0000u) + ga * acc[ai][bj][m][i >> 1][(2 * i + 1) & 3]; }
                    u32x4 w; w.x = cvt_pk_bf16(v[0], v[1]); w.y = cvt_pk_bf16(v[2], v[3]); w.z = cvt_pk_bf16(v[4], v[5]); w.w = cvt_pk_bf16(v[6], v[7]);
                    *(gu32x4*)(rowp + bj * HALF) = w; } }
    }
};
struct EpiMoeOutT {
    static constexpr bool PERM = true, AFTER_DRAIN = false, HAS_PRE = false;
    bf16_t* Y; int ldc; const float* sg; float* part; unsigned* cnt; float cs;
    template <int S> __device__ __forceinline__ void tail_reduce(const Unit& u, int wr, int wc, int fr, int fq, int wid, int lane) const {
        typedef __attribute__((address_space(1))) f32x4 gf32x4;
        typedef __attribute__((address_space(1))) u32x4 gu32x4;
        constexpr int CPS = 8 / S;
        const gf32x4* base = (const gf32x4*)part + ((size_t)(u.ti * S) * 8 + wid) * 2048 + lane;
        const int row0 = u.pm * BM + wr * 64 + fr, col0 = u.pn * BM + wc * 32 + 8 * fq;
#pragma unroll
        for (int cc = 0; cc < CPS; ++cc) {
            const int c8 = u.ks * CPS + cc, ai = c8 >> 2, bj = (c8 >> 1) & 1, mh = c8 & 1;
            f32x4 t[S][4];
#pragma unroll
            for (int o = 0; o < S; ++o)
#pragma unroll
                for (int jj = 0; jj < 4; ++jj) t[o][jj] = base[(size_t)o * 16384 + (c8 * 4 + jj) * 64];
            const int r0 = row0 + ai * HALF + mh * 32;
            float g[2]; u32x4 b[2];
#pragma unroll
            for (int mm = 0; mm < 2; ++mm) g[mm] = ((const __attribute__((address_space(1))) float*)sg)[r0 + mm * 16];
#pragma unroll
            for (int mm = 0; mm < 2; ++mm) { b[mm] = (u32x4){0u, 0u, 0u, 0u}; if (g[mm] > 0.f) b[mm] = *(const gu32x4*)(Y + (size_t)(r0 + mm * 16) * ldc + col0 + bj * HALF); }
#pragma unroll
            for (int jj = 0; jj < 4; ++jj)
#pragma unroll
                for (int o = 1; o < S; ++o) t[0][jj] += t[o][jj];
#pragma unroll
            for (int mm = 0; mm < 2; ++mm) { const float ga = fabsf(g[mm]) * cs; float v[8];
#pragma unroll
                for (int i = 0; i < 4; ++i) { v[2 * i] = __uint_as_float(b[mm][i] << 16) + ga * t[0][mm * 2 + (i >> 1)][(2 * i) & 3]; v[2 * i + 1] = __uint_as_float(b[mm][i] & 0xffff0000u) + ga * t[0][mm * 2 + (i >> 1)][(2 * i + 1) & 3]; }
                u32x4 w; w.x = cvt_pk_bf16(v[0], v[1]); w.y = cvt_pk_bf16(v[2], v[3]); w.z = cvt_pk_bf16(v[4], v[5]); w.w = cvt_pk_bf16(v[6], v[7]);
                *(gu32x4*)(Y + (size_t)(r0 + mm * 16) * ldc + col0 + bj * HALF) = w; }
        }
    }
    __device__ __forceinline__ void operator()(const f32x4 (&acc)[2][2][4][2], const Unit& u, int wr, int wc, int fr, int fq) const {
        typedef __attribute__((address_space(1))) f32x4 gf32x4;
        typedef __attribute__((address_space(1))) u32x4 gu32x4;
        if (u.ti >= 0) {
            const int wid = wr * 4 + wc; int lane = fq * 16 + fr; asm volatile("" : "+v"(lane));
            gf32x4* p = (gf32x4*)part + ((size_t)(u.ti * u.s + u.ks) * 8 + wid) * 2048 + lane;
#pragma unroll
            for (int j = 0; j < 32; ++j) p[j * 64] = acc[j >> 4][(j >> 3) & 1][(j >> 1) & 3][j & 1];
            asm volatile("s_waitcnt vmcnt(0)" ::: "memory"); __builtin_amdgcn_s_barrier();
            if (wid == 0) {
                __builtin_amdgcn_fence(__ATOMIC_RELEASE, "agent");
                if (lane == 0) __hip_atomic_fetch_add(cnt + u.ti, 1u, __ATOMIC_RELAXED, __HIP_MEMORY_SCOPE_AGENT);
                while (__hip_atomic_load(cnt + u.ti, __ATOMIC_RELAXED, __HIP_MEMORY_SCOPE_AGENT) < (unsigned)u.s) __builtin_amdgcn_s_sleep(2);
                __builtin_amdgcn_fence(__ATOMIC_ACQUIRE, "agent");
            }
            __builtin_amdgcn_s_barrier();
            if (u.s == 8) tail_reduce<8>(u, wr, wc, fr, fq, wid, lane); else if (u.s == 4) tail_reduce<4>(u, wr, wc, fr, fq, wid, lane); else tail_reduce<2>(u, wr, wc, fr, fq, wid, lane);
            return;
        }
        const int row0 = u.pm * BM + wr * 64 + fr, col0 = u.pn * BM + wc * 32 + 8 * fq;
        float g[2][4];
        { const __attribute__((address_space(1))) float* gp = (const __attribute__((address_space(1))) float*)sg + row0;
#pragma unroll
          for (int ai = 0; ai < 2; ++ai)
#pragma unroll
              for (int m = 0; m < 4; ++m) g[ai][m] = gp[ai * HALF + m * 16]; }
        u32x4 b[2][4][2];
#pragma unroll
        for (int ai = 0; ai < 2; ++ai)
#pragma unroll
            for (int m = 0; m < 4; ++m)
#pragma unroll
                for (int bj = 0; bj < 2; ++bj) { b[ai][m][bj] = (u32x4){0u, 0u, 0u, 0u}; if (g[ai][m] > 0.f) b[ai][m][bj] = *(const gu32x4*)(Y + (size_t)(row0 + ai * HALF + m * 16) * ldc + col0 + bj * HALF); }
#pragma unroll
        for (int ai = 0; ai < 2; ++ai)
#pragma unroll
            for (int m = 0; m < 4; ++m) { bf16_t* rowp = Y + (size_t)(row0 + ai * HALF + m * 16) * ldc + col0; const float ga = fabsf(g[ai][m]) * cs;
#pragma unroll
                for (int bj = 0; bj < 2; ++bj) { float v[8];
#pragma unroll
                    for (int i = 0; i < 4; ++i) { v[2 * i] = __uint_as_float(b[ai][m][bj][i] << 16) + ga * acc[ai][bj][m][i >> 1][(2 * i) & 3]; v[2 * i + 1] = __uint_as_float(b[ai][m][bj][i] & 0xffff0000u) + ga * acc[ai][bj][m][i >> 1][(2 * i + 1) & 3]; }
                    u32x4 w; w.x = cvt_pk_bf16(v[0], v[1]); w.y = cvt_pk_bf16(v[2], v[3]); w.z = cvt_pk_bf16(v[4], v[5]); w.w = cvt_pk_bf16(v[6], v[7]);
                    *(gu32x4*)(rowp + bj * HALF) = w; } }
    }
};
struct EpiSwiGLU8 {
    static constexpr bool PERM = true, AFTER_DRAIN = false, HAS_PRE = false;
    unsigned char* H; int ldc; float cs;
    __device__ __forceinline__ void operator()(const f32x4 (&acc)[2][2][4][2], const Unit& u, int wr, int wc, int fr, int fq) const {
        const int row0 = u.pm * BM + wr * 64 + fr, col0 = u.pn * HALF + wc * 32 + 8 * fq;
#pragma unroll
        for (int ai = 0; ai < 2; ++ai)
#pragma unroll
            for (int m = 0; m < 4; ++m) { unsigned char* rowp = H + (size_t)(row0 + ai * HALF + m * 16) * ldc + col0; float hv[8];
#pragma unroll
                for (int n = 0; n < 2; ++n)
#pragma unroll
                    for (int i = 0; i < 4; ++i) { const float g = acc[ai][0][m][n][i] * cs, up = acc[ai][1][m][n][i] * cs;
                        hv[n * 4 + i] = __builtin_amdgcn_fmed3f(g * __builtin_amdgcn_rcpf(1.f + __builtin_amdgcn_exp2f(-g * 1.4426950408889634f)) * up * F8_SH, -448.f, 448.f); }
                int p0 = __builtin_amdgcn_cvt_pk_fp8_f32(hv[0], hv[1], 0, false); p0 = __builtin_amdgcn_cvt_pk_fp8_f32(hv[2], hv[3], p0, true);
                int p1 = __builtin_amdgcn_cvt_pk_fp8_f32(hv[4], hv[5], 0, false); p1 = __builtin_amdgcn_cvt_pk_fp8_f32(hv[6], hv[7], p1, true);
                typedef unsigned u32x2_t __attribute__((ext_vector_type(2)));
                *(u32x2_t*)rowp = (u32x2_t){(unsigned)p0, (unsigned)p1}; }
    }
};
struct EpiSwiGLU {
    static constexpr bool PERM = true, AFTER_DRAIN = false, HAS_PRE = true;
    __device__ __forceinline__ void preload(unsigned (&q)[8], const Unit& u, int wr, int fr) const {
        const __attribute__((address_space(1))) unsigned* rp = (const __attribute__((address_space(1))) unsigned*)rs + u.pm * BM + wr * 64 + fr;
#pragma unroll
        for (int i = 0; i < 8; ++i) q[i] = rp[(i >> 2) * HALF + (i & 3) * 16]; }
    bf16_t* H; int ldc; const unsigned* rs;
    __device__ __forceinline__ void operator()(const f32x4 (&acc)[2][2][4][2], const Unit& u, int wr, int wc, int fr, int fq, const unsigned (&q)[8]) const {
        const int row0 = u.pm * BM + wr * 64 + fr, col0 = u.pn * HALF + wc * 32 + 8 * fq;
        float sc[2][4];
#pragma unroll
        for (int ai = 0; ai < 2; ++ai)
#pragma unroll
            for (int m = 0; m < 4; ++m) sc[ai][m] = rsqrtf((float)q[ai * 4 + m] * (1.f / (16.f * 1024.f)) + 1e-6f);
#pragma unroll
        for (int ai = 0; ai < 2; ++ai)
#pragma unroll
            for (int m = 0; m < 4; ++m) { bf16_t* rowp = H + (size_t)(row0 + ai * HALF + m * 16) * ldc + col0; float hv[8];
#pragma unroll
                for (int n = 0; n < 2; ++n)
#pragma unroll
                    for (int i = 0; i < 4; ++i) { const float g = acc[ai][0][m][n][i] * sc[ai][m], up = acc[ai][1][m][n][i] * sc[ai][m];
                        hv[n * 4 + i] = g * __builtin_amdgcn_rcpf(1.f + __builtin_amdgcn_exp2f(-g * 1.4426950408889634f)) * up; }
                u32x4 w; w.x = cvt_pk_bf16(hv[0], hv[1]); w.y = cvt_pk_bf16(hv[2], hv[3]); w.z = cvt_pk_bf16(hv[4], hv[5]); w.w = cvt_pk_bf16(hv[6], hv[7]);
                *(u32x4*)rowp = w; }
    }
};

typedef int i32x4_t __attribute__((ext_vector_type(4)));
typedef int i32x8_t __attribute__((ext_vector_type(8)));
template <class Epi, class Sched, bool ALIGN_EPI = false, bool SP2 = false, bool F8 = false>
__device__ __forceinline__ void gemm_phase(PG8_LAS unsigned char* lds, const Gemm g, const Sched& S, const Epi& E) {
    int tid = threadIdx.x; asm volatile("" : "+v"(tid));
    const int wid = __builtin_amdgcn_readfirstlane(tid >> 6), lane = tid & 63, wr = wid >> 2, wc = wid & 3, fr = lane & 15, fq = lane >> 4;
    const int K = g.K, nt = K / BK;
    unsigned voffA[2], voffB[2];
#pragma unroll
    for (int i = 0; i < 2; ++i) { int R, C; stage_rc(tid * 16 + i * 8192, R, C); const int Rb = Epi::PERM ? ((R & ~31) + perm32(R & 31)) : R;
        voffA[i] = (unsigned)(R * K + C) * 2u; voffB[i] = (unsigned)(Rb * K + C) * 2u; }
    const size_t kstep = (size_t)(BK * 2);
    const size_t hstep = (size_t)HALF * K * 2;
    const size_t tstep = 2 * hstep;
    const unsigned ldsw = (unsigned)wid * 1024u;
    const int aoff = lds_byte(wr * 64 + fr, fq * 8), boff = lds_byte(wc * 32 + fr, fq * 8);
#define PG8_SA(b, h) (((b) * 2 + (h)) * HTB)
#define PG8_SB(b, h) ((4 + (b) * 2 + (h)) * HTB)
#define PG8_STAGE(bufoff, gbase, voff) do { _Pragma("unroll") for (int _i = 0; _i < 2; ++_i) \
        __builtin_amdgcn_global_load_lds((const unsigned*)((const char*)(gbase) + (voff)[_i]), (PG8_LAS unsigned*)(lds + (bufoff) + ldsw + _i * 8192), 16, 0, 0); } while (0)
#define PG8_LDA(dst, b, h) do { _Pragma("unroll") for (int m = 0; m < 4; ++m) _Pragma("unroll") for (int k = 0; k < 2; ++k) dst[m][k] = *(const PG8_LAS bf16x8*)(lds + PG8_SA(b, h) + aoff + m * 2048 + k * 1024); } while (0)
#define PG8_LDB(dst, b, h) do { _Pragma("unroll") for (int n = 0; n < 2; ++n) _Pragma("unroll") for (int k = 0; k < 2; ++k) dst[n][k] = *(const PG8_LAS bf16x8*)(lds + PG8_SB(b, h) + boff + n * 2048 + k * 1024); } while (0)
typedef long i64x2_t __attribute__((ext_vector_type(2)));
#define PG8_H64(x, hf) (__builtin_bit_cast(i64x2_t, x)[hf])
#define PG8_MMA(ai, bj, At, Bt) do { __builtin_amdgcn_s_setprio(1); \
        if constexpr (F8) { _Pragma("unroll") for (int k = 0; k < 2; ++k) _Pragma("unroll") for (int hf = 0; hf < 2; ++hf) _Pragma("unroll") for (int m = 0; m < 4; ++m) _Pragma("unroll") for (int n = 0; n < 2; ++n) \
            acc[ai][bj][m][n] = __builtin_amdgcn_mfma_f32_16x16x32_fp8_fp8(PG8_H64(Bt[n][k], hf), PG8_H64(At[m][k], hf), acc[ai][bj][m][n], 0, 0, 0); } \
        else { _Pragma("unroll") for (int m = 0; m < 4; ++m) _Pragma("unroll") for (int n = 0; n < 2; ++n) _Pragma("unroll") for (int k = 0; k < 2; ++k) \
            acc[ai][bj][m][n] = __builtin_amdgcn_mfma_f32_16x16x32_bf16(Bt[n][k], At[m][k], acc[ai][bj][m][n], 0, 0, 0); } \
        __builtin_amdgcn_s_setprio(0); } while (0)
#define PG8_WAIT_V(n) asm volatile("s_waitcnt vmcnt(" #n ")" ::: "memory")
#define PG8_WAIT_L(n) asm volatile("s_waitcnt lgkmcnt(" #n ")" ::: "memory")
#define PG8_BAR __builtin_amdgcn_s_barrier()
#define PG8_SCHED __builtin_amdgcn_sched_barrier(0)
    Unit cur, nxt; int ui = 0;
    if (!S.next(0, cur)) return;
    f32x4 acc[2][2][4][2];
#pragma unroll
    for (int a = 0; a < 2; ++a)
#pragma unroll
        for (int b = 0; b < 2; ++b)
#pragma unroll
            for (int m = 0; m < 4; ++m)
#pragma unroll
                for (int n = 0; n < 2; ++n) acc[a][b][m][n] = (f32x4){0.f, 0.f, 0.f, 0.f};
    bf16x8 At[4][2], B0[2][2], B1[2][2];
    const char* cA = (const char*)g.A + (size_t)cur.pm * tstep; const char* cB = (const char*)g.Bt + cur.bofs + (size_t)cur.pn * tstep;
    if constexpr (Sched::VAR_K) cA += cur.aofs;
    S.a_ready(cur);
    if constexpr (SP2) {
        PG8_STAGE(PG8_SB(0, 0), cB, voffB); PG8_STAGE(PG8_SB(0, 1), cB + hstep, voffB); PG8_STAGE(PG8_SA(0, 0), cA, voffA); PG8_STAGE(PG8_SA(0, 1), cA + hstep, voffA);
        if (wr == 1) PG8_BAR;
        PG8_WAIT_V(2); PG8_BAR;
        PG8_STAGE(PG8_SB(1, 0), cB + kstep, voffB); PG8_STAGE(PG8_SA(1, 0), cA + kstep, voffA); PG8_STAGE(PG8_SB(1, 1), cB + hstep + kstep, voffB);
        PG8_WAIT_V(6); PG8_BAR;
    } else {
        PG8_STAGE(PG8_SB(0, 0), cB, voffB); PG8_STAGE(PG8_SA(0, 0), cA, voffA); PG8_STAGE(PG8_SB(0, 1), cB + hstep, voffB); PG8_STAGE(PG8_SA(0, 1), cA + hstep, voffA);
        if (wr == 1) PG8_BAR;
        PG8_WAIT_V(4); PG8_BAR;
        PG8_STAGE(PG8_SB(1, 0), cB + kstep, voffB); PG8_STAGE(PG8_SA(1, 0), cA + kstep, voffA); PG8_STAGE(PG8_SB(1, 1), cB + hstep + kstep, voffB);
        PG8_WAIT_V(6); PG8_BAR;
    }
    for (;;) {
        unsigned preq[8];
        if constexpr (Epi::HAS_PRE) E.preload(preq, cur, wr, fr);
        const bool has_next = S.next(ui + 1, nxt);
        const char* nA = has_next ? (const char*)g.A + (size_t)nxt.pm * tstep : cA; const char* nB = has_next ? (const char*)g.Bt + nxt.bofs + (size_t)nxt.pn * tstep : cB;
        if constexpr (Sched::VAR_K) { if (has_next) nA += nxt.aofs; }
        int ntu = nt; if constexpr (Sched::VAR_K) ntu = cur.nt;
        for (int t = 0; t < ntu; t += 2) {
            const bool last = (t == ntu - 2);
            const char* a1 = cA + (size_t)(t + 1) * kstep;
            const char* a2 = last ? nA : cA + (size_t)(t + 2) * kstep; const char* b2 = last ? nB : cB + (size_t)(t + 2) * kstep;
            const char* a3 = a2 + kstep; const char* b3 = b2 + kstep;
            if (last && has_next) S.a_ready(nxt);
            if constexpr (SP2) {
            PG8_LDB(B0, 0, 0); PG8_LDB(B1, 0, 1); PG8_SCHED; PG8_LDA(At, 0, 0); PG8_STAGE(PG8_SA(1, 1), a1 + hstep, voffA);
            PG8_WAIT_V(8); PG8_WAIT_L(0); PG8_BAR; PG8_MMA(0, 0, At, B0); PG8_MMA(0, 1, At, B1); PG8_BAR; PG8_SCHED;
            PG8_LDA(At, 0, 1); PG8_STAGE(PG8_SB(0, 0), b2, voffB); PG8_STAGE(PG8_SB(0, 1), b2 + hstep, voffB); PG8_STAGE(PG8_SA(0, 0), a2, voffA);
            PG8_WAIT_V(8); PG8_WAIT_L(0); PG8_BAR; PG8_MMA(1, 0, At, B0); PG8_MMA(1, 1, At, B1); PG8_BAR; PG8_SCHED;
            PG8_LDB(B0, 1, 0); PG8_LDB(B1, 1, 1); PG8_SCHED; PG8_LDA(At, 1, 0); PG8_STAGE(PG8_SA(0, 1), a2 + hstep, voffA);
            PG8_WAIT_V(8); PG8_WAIT_L(0); PG8_BAR; PG8_MMA(0, 0, At, B0); PG8_MMA(0, 1, At, B1); PG8_BAR; PG8_SCHED;
            PG8_LDA(At, 1, 1); PG8_STAGE(PG8_SB(1, 0), b3, voffB); PG8_STAGE(PG8_SB(1, 1), b3 + hstep, voffB); PG8_STAGE(PG8_SA(1, 0), a3, voffA);
            PG8_WAIT_V(8); PG8_WAIT_L(0); PG8_BAR; PG8_MMA(1, 0, At, B0); PG8_MMA(1, 1, At, B1); PG8_BAR; PG8_SCHED;
            } else {
            PG8_LDB(B0, 0, 0); PG8_SCHED; PG8_LDA(At, 0, 0); PG8_STAGE(PG8_SA(1, 1), a1 + hstep, voffA);
            PG8_WAIT_L(8); PG8_BAR; PG8_WAIT_L(0); PG8_MMA(0, 0, At, B0); PG8_BAR; PG8_SCHED;
            PG8_LDB(B1, 0, 1); PG8_STAGE(PG8_SB(0, 0), b2, voffB);
            PG8_BAR; PG8_WAIT_L(0); PG8_MMA(0, 1, At, B1); PG8_BAR;
            PG8_LDA(At, 0, 1); PG8_STAGE(PG8_SA(0, 0), a2, voffA);
            PG8_BAR; PG8_WAIT_L(0); PG8_MMA(1, 0, At, B0); PG8_BAR; PG8_SCHED;
            PG8_STAGE(PG8_SB(0, 1), b2 + hstep, voffB);
            PG8_WAIT_V(6); PG8_BAR; PG8_MMA(1, 1, At, B1); PG8_BAR;
            PG8_LDB(B0, 1, 0); PG8_SCHED; PG8_LDA(At, 1, 0); PG8_STAGE(PG8_SA(0, 1), a2 + hstep, voffA);
            PG8_WAIT_L(8); PG8_BAR; PG8_WAIT_L(0); PG8_MMA(0, 0, At, B0); PG8_BAR; PG8_SCHED;
            PG8_LDB(B1, 1, 1); PG8_STAGE(PG8_SB(1, 0), b3, voffB);
            PG8_BAR; PG8_WAIT_L(0); PG8_MMA(0, 1, At, B1); PG8_BAR;
            PG8_LDA(At, 1, 1); PG8_STAGE(PG8_SA(1, 0), a3, voffA);
            PG8_BAR; PG8_WAIT_L(0); PG8_MMA(1, 0, At, B0); PG8_BAR; PG8_SCHED;
            PG8_STAGE(PG8_SB(1, 1), b3 + hstep, voffB);
            PG8_WAIT_V(6); PG8_BAR; PG8_MMA(1, 1, At, B1); PG8_BAR;
            }
        }
        if constexpr (ALIGN_EPI) { if (wr == 0) PG8_BAR; }
        if constexpr (!Epi::AFTER_DRAIN) { if constexpr (Epi::HAS_PRE) E(acc, cur, wr, wc, fr, fq, preq); else E(acc, cur, wr, wc, fr, fq); S.done(cur); }
        if (!has_next) break;
#pragma unroll
        for (int a = 0; a < 2; ++a)
#pragma unroll
            for (int b = 0; b < 2; ++b)
#pragma unroll
                for (int m = 0; m < 4; ++m)
#pragma unroll
                    for (int n = 0; n < 2; ++n) acc[a][b][m][n] = (f32x4){0.f, 0.f, 0.f, 0.f};
        cur = nxt; cA = nA; cB = nB; ++ui;
        if constexpr (ALIGN_EPI) { if (wr == 1) PG8_BAR; }
    }
    PG8_WAIT_V(0);
    if constexpr (!ALIGN_EPI) { if (wr == 0) PG8_BAR; }
    PG8_BAR;
#undef PG8_SA
#undef PG8_SB
#undef PG8_STAGE
#undef PG8_LDA
#undef PG8_LDB
#undef PG8_MMA
#undef PG8_WAIT_V
#undef PG8_WAIT_L
#undef PG8_BAR
#undef PG8_SCHED
}
}


#include <hip/hip_bf16.h>
namespace fox {
using bf16h=__hip_bfloat16;
using bf16x8=__attribute__((ext_vector_type(8)))short;
using s16x4=__attribute__((ext_vector_type(4)))short;
using f32x16=__attribute__((ext_vector_type(16)))float;
using f32x4=__attribute__((ext_vector_type(4)))float;
using u32x4=__attribute__((ext_vector_type(4)))unsigned;
constexpr int NHEAD=FH,D=64,DMI=512,DMO=1024;
constexpr int NW=8,QBLK=32,QB=QBLK*NW,KVBLK=64,NQB=SEQ/QB;
__device__ __forceinline__ int crow(int r,int hi){return (r&3)+8*(r>>2)+4*hi;}
#define SBAR() __builtin_amdgcn_sched_barrier(0)
__device__ __forceinline__ void cmask(f32x16&p0,f32x16&p1,int jb,int qrel,int hi){
  const float NEG=-INFINITY; int kb=64*jb+4*hi;
  #pragma unroll
  for(int r=0;r<16;++r){int kv=kb+(r&3)+8*(r>>2); if(kv>qrel)p0[r]=NEG; if(kv+32>qrel)p1[r]=NEG;}
}
constexpr int NSLOT=3, SLOTB=8192;
constexpr int LDS_K=0, LDS_V=NSLOT*SLOTB, LDS_WS=2*NSLOT*SLOTB, LDS_OST=LDS_WS+NW*64*4, LDS_NB=LDS_OST+NW*4096, LDS_BYTES=LDS_NB+SEQ*4;
__device__ __forceinline__ void glds16(const void*gsrc,unsigned lds_dst){unsigned keep;
  asm volatile("s_mov_b32 %0, m0\n\ts_mov_b32 m0, %2\n\ts_nop 0\n\tglobal_load_lds_dwordx4 %1, off\n\ts_mov_b32 m0, %0":"=&s"(keep):"v"(gsrc),"s"(lds_dst):"memory");}
__device__ __forceinline__ float max3f(float a,float b,float c){float r;asm("v_max3_f32 %0, %1, %2, %3":"=v"(r):"v"(a),"v"(b),"v"(c));return r;}
__device__ __forceinline__ float max2f(float a,float b){float r;asm("v_max_f32_e32 %0, %1, %2":"=v"(r):"v"(a),"v"(b));return r;}
__device__ __forceinline__ float fadd_s(float a,float b){float r;asm("v_add_f32_e32 %0, %1, %2":"=v"(r):"v"(a),"v"(b));return r;}
__device__ __forceinline__ float fsub_s(float a,float b){float r;asm("v_sub_f32_e32 %0, %1, %2":"=v"(r):"v"(a),"v"(b));return r;}
typedef float f32x2_t __attribute__((ext_vector_type(2))); typedef __bf16 bf16x2_t __attribute__((ext_vector_type(2)));
__device__ __forceinline__ unsigned cvtpk_s(float lo,float hi){f32x2_t v={lo,hi};bf16x2_t b=__builtin_convertvector(v,bf16x2_t);return __builtin_bit_cast(unsigned,b);}
#define WAIT_BAR(N) asm volatile("s_waitcnt vmcnt(" #N ") lgkmcnt(0)\n\ts_barrier":::"memory")
__device__ __forceinline__ void qkt(f32x16&p0,f32x16&p1,const char*Kslot,const bf16x8*qr,int r32,int hi){
  const char*kb=Kslot+hi*1024+r32*16;
  #pragma unroll
  for(int d0=0;d0<4;++d0){
    const bf16x8 b0=*reinterpret_cast<const bf16x8*>(kb+d0*2048);
    const bf16x8 b1=*reinterpret_cast<const bf16x8*>(kb+d0*2048+512);
    p0=__builtin_amdgcn_mfma_f32_32x32x16_bf16(b0,qr[d0],p0,0,0,0);p1=__builtin_amdgcn_mfma_f32_32x32x16_bf16(b1,qr[d0],p1,0,0,0);}
}
typedef __attribute__((address_space(3))) const char* lds_cptr;
typedef __attribute__((address_space(3))) const float* lds_fptr;
typedef short v4i16_t __attribute__((ext_vector_type(4)));
__device__ __forceinline__ void kload8(bf16x8*kf,lds_cptr kp){
  kf[0]=*(const __attribute__((address_space(3))) bf16x8*)(kp);      kf[1]=*(const __attribute__((address_space(3))) bf16x8*)(kp+512);
  kf[2]=*(const __attribute__((address_space(3))) bf16x8*)(kp+2048); kf[3]=*(const __attribute__((address_space(3))) bf16x8*)(kp+2560);
  kf[4]=*(const __attribute__((address_space(3))) bf16x8*)(kp+4096); kf[5]=*(const __attribute__((address_space(3))) bf16x8*)(kp+4608);
  kf[6]=*(const __attribute__((address_space(3))) bf16x8*)(kp+6144); kf[7]=*(const __attribute__((address_space(3))) bf16x8*)(kp+6656);
}
__device__ __forceinline__ void kload2(bf16x8*kf,lds_cptr kp,int j){ kf[2*j]=*(const __attribute__((address_space(3))) bf16x8*)(kp+j*2048); kf[2*j+1]=*(const __attribute__((address_space(3))) bf16x8*)(kp+j*2048+512); }
__device__ __forceinline__ s16x4 vtr(lds_cptr p){ return __builtin_bit_cast(s16x4,__builtin_amdgcn_ds_read_tr16_b64_v4i16((__attribute__((address_space(3))) v4i16_t*)p)); }
__device__ __forceinline__ float rowmax(const f32x16&p0,const f32x16&p1){
  float a=max3f(p0[0],p0[1],p1[0]),b=max3f(p0[2],p0[3],p1[1]);a=max3f(a,p1[2],p1[3]);
  #pragma unroll
  for(int r=4;r<16;r+=4){a=max3f(a,p0[r],p0[r+1]);b=max3f(b,p0[r+2],p0[r+3]);a=max3f(a,p1[r],p1[r+1]);b=max3f(b,p1[r+2],p1[r+3]);}
  const float m=max2f(a,b);
  auto rr=__builtin_amdgcn_permlane32_swap(__float_as_uint(m),__float_as_uint(m),false,false);
  return max2f(__uint_as_float(rr[0]),__uint_as_float(rr[1]));
}
__device__ __forceinline__ void pv(f32x16*o,int vb,bf16x8 pa0,bf16x8 pa1,bf16x8 pa2,bf16x8 pa3){
  #pragma unroll
  for(int d0=0;d0<2;++d0){s16x4 lo[4],hi[4];
    #pragma unroll
    for(int ks=0;ks<4;++ks){
      asm volatile("ds_read_b64_tr_b16 %0,%1 offset:%c2":"=&v"(lo[ks]):"v"(vb),"i"(d0*4096+ks*1024):"memory");
      asm volatile("ds_read_b64_tr_b16 %0,%1 offset:%c2":"=&v"(hi[ks]):"v"(vb),"i"(d0*4096+ks*1024+512):"memory");}
    asm volatile("s_waitcnt lgkmcnt(0)":::"memory");SBAR();
    #define PK(k) (bf16x8){lo[k][0],lo[k][1],lo[k][2],lo[k][3],hi[k][0],hi[k][1],hi[k][2],hi[k][3]}
    o[d0]=__builtin_amdgcn_mfma_f32_32x32x16_bf16(pa0,PK(0),o[d0],0,0,0);
    o[d0]=__builtin_amdgcn_mfma_f32_32x32x16_bf16(pa1,PK(1),o[d0],0,0,0);
    o[d0]=__builtin_amdgcn_mfma_f32_32x32x16_bf16(pa2,PK(2),o[d0],0,0,0);
    o[d0]=__builtin_amdgcn_mfma_f32_32x32x16_bf16(pa3,PK(3),o[d0],0,0,0);
    #undef PK
  }
}
template<int THRL> __device__ __forceinline__ void attn_unit(int b,int h,int qb,int j0,const bf16h*Q,const bf16h*__restrict__ K,const bf16h*__restrict__ V,bf16h*O,const float*CL,char*shm){
  int tid=threadIdx.x; asm volatile("":"+v"(tid));
  const int lane=tid&63,r32=lane&31,hi=lane>>5; const int wid=__builtin_amdgcn_readfirstlane(tid>>6);
  const long rowbase=(long)b*SEQ; const int q0=qb*QB; const long kvbase=rowbase+(long)j0*KVBLK;
  const bf16h*Qw=Q+(rowbase+q0+wid*QBLK)*DMI+h*D;
  const bf16h*Kh=K+kvbase*DMI+h*D,*Vh=V+kvbase*DMI+h*D;
  const unsigned lds0=(unsigned)(uintptr_t)shm;
  float*wsf=(float*)(shm+LDS_WS)+wid*64;
  const int NT=(q0+QB)/KVBLK-j0;
  { float*nbw=(float*)(shm+LDS_NB); const float*src=CL+(long)j0*KVBLK;
    for(int i=tid*4;i<NT*KVBLK;i+=512*4){ const f32x4 v=*(const f32x4*)(src+i); *(f32x4*)(nbw+i)=(f32x4){-v[0],-v[1],-v[2],-v[3]}; } }
  const bf16h*ksrc=Kh+(long)lane*DMI+wid*8;
  const bf16h*vsrc=Vh+(long)(16*(wid&3)+(lane>>2))*DMI+(wid>>2)*32+(lane&3)*8;
  const unsigned kdst=lds0+LDS_K+wid*1024, vdst=lds0+LDS_V+wid*1024;
  #define DMA_K(t,slot) glds16(ksrc+(long)(t)*KVBLK*DMI,(unsigned)__builtin_amdgcn_readfirstlane(kdst+(slot)))
  #define DMA_V(t,slot) glds16(vsrc+(long)(t)*KVBLK*DMI,(unsigned)__builtin_amdgcn_readfirstlane(vdst+(slot)))
  const int vb0=(int)(lds0+LDS_V)+((lane>>4)&1)*32+(lane&3)*8+(4*hi+((lane&15)>>2))*64;
  const char*Kbase=shm+LDS_K; bf16x8 kf[8];
  const lds_cptr shm3=(lds_cptr)shm; const lds_cptr kp0=shm3+LDS_K+hi*1024+r32*16; const lds_cptr vp0=shm3+LDS_V+((lane>>4)&1)*32+(lane&3)*8+(4*hi+((lane&15)>>2))*64;
  const lds_fptr nb0=(lds_fptr)(shm3+LDS_NB)+4*hi;
  DMA_K(0,0);DMA_V(0,0);DMA_K(1,SLOTB);
  bf16x8 qr[4];
  #pragma unroll
  for(int d0=0;d0<4;++d0)qr[d0]=*reinterpret_cast<const bf16x8*>(&Qw[(long)r32*DMI+d0*16+hi*8]);
  float mhat=0.f,l_reg=0.f;f32x16 o[2];o[0]=f32x16{};o[1]=f32x16{};
  const int qrel=wid*QBLK+r32;
  #define CMASK(P0,P1,t) do{int jb_=(t)-(NT-4); if(jb_>=0)cmask(P0,P1,jb_,qrel,hi);}while(0)
  #define PRELOAD(P0,P1,tt) do{ const lds_fptr nbp_=nb0+(tt)*KVBLK; \
    _Pragma("unroll") for(int g_=0;g_<4;++g_){ const f32x4 a_=*(const __attribute__((address_space(3))) f32x4*)(nbp_+8*g_), b_=*(const __attribute__((address_space(3))) f32x4*)(nbp_+32+8*g_); \
      P0[4*g_]=a_[0]-mhat;P0[4*g_+1]=a_[1]-mhat;P0[4*g_+2]=a_[2]-mhat;P0[4*g_+3]=a_[3]-mhat; P1[4*g_]=b_[0]-mhat;P1[4*g_+1]=b_[1]-mhat;P1[4*g_+2]=b_[2]-mhat;P1[4*g_+3]=b_[3]-mhat; } }while(0)
  bool resc=false;
  #define START(P0,P1) do{ const float rm=rowmax(P0,P1); resc=false; \
    { const float dl=rm; mhat=fadd_s(mhat,dl); \
      _Pragma("unroll") for(int r=0;r<16;++r){P0[r]=fsub_s(P0[r],dl);P1[r]=fsub_s(P1[r],dl);} } \
    _Pragma("unroll") for(int r=0;r<16;++r)P0[r]=__builtin_amdgcn_exp2f(P0[r]); }while(0)
  #define RESC() do{ if(resc){ asm volatile("s_waitcnt lgkmcnt(0)":::"memory"); \
      _Pragma("unroll") for(int d_=0;d_<2;++d_) _Pragma("unroll") for(int r=0;r<16;++r)o[d_][r]*=wsf[crow(r,hi)]; } }while(0)
  f32x16 pA0,pA1,pB0,pB1;
  int sl_prev=0,sl_cur=0,sl_next=SLOTB;
  #define ROT() do{sl_prev=sl_cur;sl_cur=sl_next;sl_next=(sl_next==(NSLOT-1)*SLOTB)?0:sl_next+SLOTB;}while(0)
  DMA_K(2,2*SLOTB);
  WAIT_BAR(3);
  PRELOAD(pA0,pA1,0);
  qkt(pA0,pA1,Kbase,qr,r32,hi);asm volatile("s_nop 15\n\ts_nop 7":"+v"(pA0),"+v"(pA1));CMASK(pA0,pA1,0);
  START(pA0,pA1);
  _Pragma("unroll") for(int r=0;r<16;++r)pA1[r]=__builtin_amdgcn_exp2f(pA1[r]);
  WAIT_BAR(0);
  DMA_K(3,0);DMA_V(1,SLOTB);
  ROT();
  kload8(kf,kp0+sl_cur);
  PRELOAD(pB0,pB1,1);
  WAIT_BAR(2);
  s16x4 vlo[8],vhi[8]; u32x4 pw0,pw1,pw2,pw3;
  #define PKW(P,B) cvtpk_s(P[B],P[B+1])
  #define PAF(k) __builtin_bit_cast(bf16x8,pw##k)
  #define VFR(i) (bf16x8){vlo[i][0],vlo[i][1],vlo[i][2],vlo[i][3],vhi[i][0],vhi[i][1],vhi[i][2],vhi[i][3]}
  #define PIN(x) asm volatile("":"+v"(x))
  #define MX3(a,b,c) __builtin_fmaxf(__builtin_fmaxf((a),(b)),(c))
  #define GAPA(MF,A0,A1,A2,A3,W0,W1,PW) do{ MF; sacc+=A0; sacc+=A1; sacc+=A2; sacc+=A3; PIN(sacc); W0; W1; PIN(PW); SBAR(); }while(0)
  #define EX(v) __builtin_amdgcn_exp2f(v)
  #define GAPB(MF,X,B) do{ MF; X[B]=EX(X[B]); X[B+1]=EX(X[B+1]); X[B+2]=EX(X[B+2]); X[B+3]=EX(X[B+3]); PIN(X); SBAR(); }while(0)
  #define VRD(i) do{ vlo[i]=vtr(vp_+(((i)>>2)*4096+((i)&3)*1024)); vhi[i]=vtr(vp_+(((i)>>2)*4096+((i)&3)*1024+512)); }while(0)
  #define KRD(G,j) do{ if(G){ kload2(kf,kp0+sl_next,j); SBAR(); } }while(0)
  #define STEP(C0,C1,P0,P1,t,GK,GV,GL) do{ SBAR(); \
    const lds_cptr vp_=vp0+sl_prev; \
    VRD(0); SBAR(); float sacc=(P0[0]+P0[1]); \
    GAPA(C0=__builtin_amdgcn_mfma_f32_32x32x16_bf16(kf[0],qr[0],C0,0,0,0), P0[2],P0[3],P0[4],P0[5],     pw0[0]=PKW(P0,0), pw0[1]=PKW(P0,2), pw0); \
    VRD(4); SBAR(); GAPA(C1=__builtin_amdgcn_mfma_f32_32x32x16_bf16(kf[1],qr[0],C1,0,0,0), P0[6],P0[7],P0[8],P0[9],     pw0[2]=PKW(P0,4), pw0[3]=PKW(P0,6), pw0); \
    VRD(1); SBAR(); GAPA(C0=__builtin_amdgcn_mfma_f32_32x32x16_bf16(kf[2],qr[1],C0,0,0,0),   P0[10],P0[11],P0[12],P0[13], pw1[0]=PKW(P0,8), pw1[1]=PKW(P0,10), pw1); \
    VRD(5); SBAR(); GAPA(C1=__builtin_amdgcn_mfma_f32_32x32x16_bf16(kf[3],qr[1],C1,0,0,0),   P0[14],P0[15],P1[0],P1[1],   pw1[2]=PKW(P0,12),pw1[3]=PKW(P0,14), pw1); \
    VRD(2); SBAR(); GAPA(C0=__builtin_amdgcn_mfma_f32_32x32x16_bf16(kf[4],qr[2],C0,0,0,0),   P1[2],P1[3],P1[4],P1[5],     pw2[0]=PKW(P1,0), pw2[1]=PKW(P1,2), pw2); \
    VRD(6); SBAR(); GAPA(C1=__builtin_amdgcn_mfma_f32_32x32x16_bf16(kf[5],qr[2],C1,0,0,0),   P1[6],P1[7],P1[8],P1[9],     pw2[2]=PKW(P1,4), pw2[3]=PKW(P1,6), pw2); \
    VRD(3); SBAR(); GAPA(C0=__builtin_amdgcn_mfma_f32_32x32x16_bf16(kf[6],qr[3],C0,0,0,0),   P1[10],P1[11],P1[12],P1[13], pw3[0]=PKW(P1,8), pw3[1]=PKW(P1,10), pw3); \
    VRD(7); SBAR(); GAPA(C1=__builtin_amdgcn_mfma_f32_32x32x16_bf16(kf[7],qr[3],C1,0,0,0),   P1[14],P1[15],0.f,0.f,       pw3[2]=PKW(P1,12),pw3[3]=PKW(P1,14), pw3); \
    l_reg+=sacc; \
    if(GK){DMA_K((t)+3,sl_cur);} if(GV){DMA_V((t)+1,sl_next);} \
    CMASK(C0,C1,t); \
    { float a=MX3(C0[0],C0[1],C1[0]),b=MX3(C0[2],C0[3],C1[1]); a=MX3(a,C1[2],C1[3]); \
      _Pragma("unroll") for(int r=4;r<16;r+=4){a=MX3(a,C0[r],C0[r+1]);b=MX3(b,C0[r+2],C0[r+3]);a=MX3(a,C1[r],C1[r+1]);b=MX3(b,C1[r+2],C1[r+3]);} \
      float rm=__builtin_fmaxf(a,b); { auto rr=__builtin_amdgcn_permlane32_swap(__float_as_uint(rm),__float_as_uint(rm),false,false); rm=__builtin_fmaxf(__uint_as_float(rr[0]),__uint_as_float(rr[1])); } \
      resc=false; \
      if(__builtin_expect(__any(rm>(float)THRL),0)){ const float dl=__builtin_fmaxf(rm,0.f); mhat+=dl; \
        _Pragma("unroll") for(int r=0;r<16;++r){C0[r]-=dl;C1[r]-=dl;} \
        const float f=__builtin_amdgcn_exp2f(-dl); l_reg*=f; if(hi==0)wsf[r32]=f; resc=true; } } \
    SBAR(); \
    GAPB(o[0]=__builtin_amdgcn_mfma_f32_32x32x16_bf16(PAF(0),VFR(0),o[0],0,0,0), C0,0); \
    GAPB(o[1]=__builtin_amdgcn_mfma_f32_32x32x16_bf16(PAF(0),VFR(4),o[1],0,0,0), C0,4); \
    KRD(GL,0); GAPB(o[0]=__builtin_amdgcn_mfma_f32_32x32x16_bf16(PAF(1),VFR(1),o[0],0,0,0), C0,8); \
    KRD(GL,1); GAPB(o[1]=__builtin_amdgcn_mfma_f32_32x32x16_bf16(PAF(1),VFR(5),o[1],0,0,0), C0,12); \
    KRD(GL,2); GAPB(o[0]=__builtin_amdgcn_mfma_f32_32x32x16_bf16(PAF(2),VFR(2),o[0],0,0,0), C1,0); \
    KRD(GL,3); GAPB(o[1]=__builtin_amdgcn_mfma_f32_32x32x16_bf16(PAF(2),VFR(6),o[1],0,0,0), C1,4); \
    GAPB(o[0]=__builtin_amdgcn_mfma_f32_32x32x16_bf16(PAF(3),VFR(3),o[0],0,0,0), C1,8); \
    GAPB(o[1]=__builtin_amdgcn_mfma_f32_32x32x16_bf16(PAF(3),VFR(7),o[1],0,0,0), C1,12); \
    if(GL){ PRELOAD(P0,P1,(t)+1); } \
    }while(0)
  int t=1;
  #undef CMASK
  #define CMASK(P0,P1,t) do{}while(0)
  for(;t+5<NT;t+=2){
    STEP(pB0,pB1,pA0,pA1,t,true,true,true);     WAIT_BAR(2); RESC(); ROT();
    STEP(pA0,pA1,pB0,pB1,t+1,true,true,true);   WAIT_BAR(2); RESC(); ROT();
  }
  #undef CMASK
  #define CMASK(P0,P1,t) do{int jb_=(t)-(NT-4); if(jb_>=0)cmask(P0,P1,jb_,qrel,hi);}while(0)
  #define ENDW(tt) do{ if((tt)+3<NT){WAIT_BAR(2);} else if((tt)+2<NT){WAIT_BAR(1);} else {WAIT_BAR(0);} }while(0)
  for(;t+1<NT;t+=2){
    STEP(pB0,pB1,pA0,pA1,t,(t+3<NT),(t+1<NT),(t+1<NT));       ENDW(t);   RESC(); ROT();
    STEP(pA0,pA1,pB0,pB1,t+1,(t+4<NT),(t+2<NT),(t+2<NT));     ENDW(t+1); RESC(); ROT();
  }
  STEP(pB0,pB1,pA0,pA1,NT-1,false,false,false); RESC();
  { float sacc=pB0[0]+pB0[1]; _Pragma("unroll") for(int r=2;r<16;++r)sacc+=pB0[r]; _Pragma("unroll") for(int r=0;r<16;++r)sacc+=pB1[r]; l_reg+=sacc;
    pw0=(u32x4){PKW(pB0,0),PKW(pB0,2),PKW(pB0,4),PKW(pB0,6)};pw1=(u32x4){PKW(pB0,8),PKW(pB0,10),PKW(pB0,12),PKW(pB0,14)};pw2=(u32x4){PKW(pB1,0),PKW(pB1,2),PKW(pB1,4),PKW(pB1,6)};pw3=(u32x4){PKW(pB1,8),PKW(pB1,10),PKW(pB1,12),PKW(pB1,14)};
    SBAR(); pv(o,vb0+sl_cur,PAF(0),PAF(1),PAF(2),PAF(3)); }
  #undef PKW
  #undef PAF
  #undef VFR
  #undef PIN
  #undef MX3
  #undef GAPA
  #undef GAPB
  #undef EX
  #undef VRD
  #undef KRD
  #undef STEP
  #undef ENDW
  {auto rr=__builtin_amdgcn_permlane32_swap(__float_as_uint(l_reg),__float_as_uint(l_reg),false,false);l_reg=__uint_as_float(rr[0])+__uint_as_float(rr[1]);}
  if(hi==0)wsf[32+r32]=l_reg;asm volatile("s_waitcnt lgkmcnt(0)":::"memory");
  float rli[16];
  #pragma unroll
  for(int r=0;r<16;++r)rli[r]=__builtin_amdgcn_rcpf(wsf[32+crow(r,hi)]);
  bf16h*Ow=O+(rowbase+q0+wid*QBLK)*DMO+h*D;
  { bf16h*stg=(bf16h*)(shm+LDS_OST)+wid*2048;
    #pragma unroll
    for(int r=0;r<16;++r){const int orow=crow(r,hi);
      #pragma unroll
      for(int d0=0;d0<2;++d0)stg[orow*64+d0*32+r32]=__float2bfloat16(o[d0][r]*rli[r]);}
    asm volatile("s_waitcnt lgkmcnt(0)":::"memory");
    #pragma unroll
    for(int i=0;i<4;++i){const int row=i*8+(lane>>3),ch=lane&7; const u32x4 v=*(const u32x4*)(stg+row*64+ch*8); *(u32x4*)(Ow+(long)row*DMO+ch*8)=v;} }
  asm volatile("s_waitcnt lgkmcnt(0)\n\ts_barrier":::"memory");
  #undef DMA_K
  #undef DMA_V
  #undef CMASK
  #undef PRELOAD
  #undef START
  #undef RESC
  #undef ROT
}

__device__ __forceinline__ int unit_j0_wave(int bh,int qb,const bf16h*Q,const float*KN2,const float*CL,int lane){
  const int b=bh/NHEAD,h=bh%NHEAD; constexpr int NTT=SEQ/KVBLK;
  float mx=0.f;
  #pragma unroll
  for(int rr=0;rr<QB/64;++rr){ const bf16h*Qw=Q+((long)b*SEQ+qb*QB+rr*64+lane)*DMI+h*D; float ss=0.f;
    #pragma unroll
    for(int c=0;c<8;++c){ const u32x4 v=*reinterpret_cast<const u32x4*>(&Qw[c*8]);
      #pragma unroll
      for(int e=0;e<4;++e){ const float f0=__uint_as_float(v[e]<<16),f1=__uint_as_float(v[e]&0xffff0000u); ss+=f0*f0+f1*f1; } }
    mx=fmaxf(mx,ss); }
  #pragma unroll
  for(int o=1;o<64;o<<=1) mx=fmaxf(mx,__shfl_xor(mx,o));
  const int nt=4*qb; const float*kn=KN2+bh*NTT;
  const float Qn=sqrtf(mx),KNd=sqrtf(fmaxf(fmaxf(kn[nt],kn[nt+1]),fmaxf(kn[nt+2],kn[nt+3])));
  const float clt0=CL[qb*QB];
  int first=nt;
  #pragma unroll
  for(int part=1;part>=0;--part){ const int i=lane+64*part; bool need=false;
    if(i<nt){ const float bound=Qn*(sqrtf(kn[i])+KNd)+clt0-CL[KVBLK*i+KVBLK-1]; need=!(bound<-40.f); }
    const unsigned long long bal=__ballot(need); if(bal) first=__ffsll((long long)bal)-1+64*part; }
  return (first<nt?first:nt)&~1;
}
#undef SBAR
#undef WAIT_BAR
}

#define GAS __attribute__((address_space(1)))
#define LAS __attribute__((address_space(3)))
typedef unsigned v4u __attribute__((ext_vector_type(4)));
typedef float f32x4 __attribute__((ext_vector_type(4)));
typedef GAS unsigned gu32;
#define RLX_AGENT __ATOMIC_RELAXED, __HIP_MEMORY_SCOPE_AGENT
#define LDS_WAIT() asm volatile("s_waitcnt lgkmcnt(0)" ::: "memory")
#define VM_WAIT() asm volatile("s_waitcnt vmcnt(0)" ::: "memory")
__device__ __forceinline__ unsigned pk2(float lo, float hi) { return (unsigned)f2bf(lo) | ((unsigned)f2bf(hi) << 16); }
__device__ __forceinline__ void unpack8(const v4u w, float* f) {
#pragma unroll
    for (int i = 0; i < 4; ++i) { f[2 * i] = __uint_as_float(w[i] << 16); f[2 * i + 1] = __uint_as_float(w[i] & 0xffff0000u); }
}

#define XB_TMO      128
#define XB_XCNT(j)  (256  + 64 * (j))
#define XB_XSUB(j)  (1280 + 64 * (j))
#define XB_XGEN(j)  (2304 + 64 * (j))
#define XB_TOP      3328
#define XB_TOPGEN   3392
#define XCD_BAR_WORDS 3456
#define XB_SPIN_CAP (1u << 18)
__device__ __forceinline__ unsigned xb_ld(unsigned* p)              { return __hip_atomic_load(p, __ATOMIC_RELAXED, __HIP_MEMORY_SCOPE_AGENT); }
__device__ __forceinline__ unsigned xb_add(unsigned* p, unsigned v) { return __hip_atomic_fetch_add(p, v, __ATOMIC_RELAXED, __HIP_MEMORY_SCOPE_AGENT); }
__device__ __forceinline__ unsigned xb_xcc_id() { return (unsigned)__builtin_amdgcn_s_getreg((3 << 11) | 20) & 0xFu; }
#define XB_SPIN(cond, bar) do { unsigned _sp = 0; while (cond) { __builtin_amdgcn_s_sleep(1); \
    if ((++_sp & 255u) == 0u) { if (xb_ld(&(bar)[XB_TMO])) break; if (_sp > XB_SPIN_CAP) { atomicAdd(&(bar)[XB_TMO], 1u); break; } } } } while (0)
struct XcdBarrier { unsigned* bar; unsigned x; volatile LAS unsigned* st; };
__device__ __forceinline__ XcdBarrier xcd_barrier_post(unsigned* bar, volatile LAS unsigned* st) {
    XcdBarrier b; b.bar = bar; b.x = xb_xcc_id(); b.st = st;
    if (threadIdx.x == 0) (void)xb_add(&bar[XB_XCNT(b.x)], 1u);
    return b;
}
__device__ __forceinline__ void xcd_barrier_complete(unsigned* bar, unsigned x, unsigned& nloc, unsigned& nx) {
    const unsigned G = gridDim.x * gridDim.y * gridDim.z;
    unsigned sum, cnt, mine, sp = 0u;
    for (;;) {
        sum = 0u; cnt = 0u; mine = 0u;
#pragma unroll
        for (unsigned j = 0; j < 16; ++j) { const unsigned c = xb_ld(&bar[XB_XCNT(j)]); sum += c; cnt += (c > 0u) ? 1u : 0u; mine = (j == x) ? c : mine; }
        if (sum == G) break;
        __builtin_amdgcn_s_sleep(1);
        if ((++sp & 255u) == 0u) { if (xb_ld(&bar[XB_TMO])) break; if (sp > XB_SPIN_CAP) { atomicAdd(&bar[XB_TMO], 1u); break; } }
    }
    nloc = mine > 0u ? mine : 1u; nx = cnt > 0u ? cnt : 1u;
}
__device__ __forceinline__ void xcd_barrier(const XcdBarrier& b) {
    asm volatile("s_waitcnt vmcnt(0)" ::: "memory");
    __syncthreads();
    if (threadIdx.x == 0) {
        unsigned* bar = b.bar;
        __builtin_amdgcn_s_waitcnt(0);
        unsigned nloc = b.st[0], nx = b.st[1];
        if (nloc == 0u) { xcd_barrier_complete(bar, b.x, nloc, nx); b.st[0] = nloc; b.st[1] = nx; }
        const unsigned old = xb_add(&bar[XB_XSUB(b.x)], 1u);
        const unsigned gen = old / nloc;
        if (old + 1u == (gen + 1u) * nloc) {
            __builtin_amdgcn_fence(__ATOMIC_RELEASE, "agent");
            asm volatile("s_waitcnt vmcnt(0)" ::: "memory");
            const unsigned og = xb_add(&bar[XB_TOP], 1u);
            const unsigned tg = og / nx;
            if (og + 1u == (tg + 1u) * nx) xb_add(&bar[XB_TOPGEN], 1u);
            else XB_SPIN(xb_ld(&bar[XB_TOPGEN]) == tg, bar);
            __builtin_amdgcn_fence(__ATOMIC_ACQUIRE, "agent");
            xb_add(&bar[XB_XGEN(b.x)], 1u);
            asm volatile("s_waitcnt vmcnt(0)" ::: "memory");
        } else {
            XB_SPIN(xb_ld(&bar[XB_XGEN(b.x)]) == gen, bar);
            __builtin_amdgcn_fence(__ATOMIC_ACQUIRE, "agent");
            asm volatile("s_waitcnt vmcnt(0)" ::: "memory");
        }
    }
    __syncthreads();
}


namespace xat {
typedef short bf16x8 __attribute__((ext_vector_type(8)));
typedef short s16x4 __attribute__((ext_vector_type(4)));
typedef float f32x16 __attribute__((ext_vector_type(16)));
constexpr int RB = 272;
constexpr int KIMG = 0, VIMG = 128 * RB, LDS_BYTES = 2 * 128 * RB;
__device__ __forceinline__ unsigned cvtpk(float lo, float hi) { typedef float f2 __attribute__((ext_vector_type(2))); typedef __bf16 b2 __attribute__((ext_vector_type(2))); f2 v = {lo, hi}; b2 b = __builtin_convertvector(v, b2); return __builtin_bit_cast(unsigned, b); }
__device__ __forceinline__ float swapmax(float m) { auto rr = __builtin_amdgcn_permlane32_swap(__float_as_uint(m), __float_as_uint(m), false, false); return fmaxf(__uint_as_float(rr[0]), __uint_as_float(rr[1])); }
__device__ __forceinline__ float swapadd(float m) { auto rr = __builtin_amdgcn_permlane32_swap(__float_as_uint(m), __float_as_uint(m), false, false); return __uint_as_float(rr[0]) + __uint_as_float(rr[1]); }
__device__ __forceinline__ void unit(int b, int head, int qb, const bf16* QX, const bf16* KX, const bf16* VT, bf16* OX, LAS unsigned char* lds) {
    int tid = threadIdx.x; asm volatile("" : "+v"(tid));
    const int lane = tid & 63, r32 = lane & 31, h = lane >> 5, wid = tid >> 6;
    const size_t qrow = (size_t)b * SEQ + (size_t)qb * 256 + wid * 32 + r32;
    bf16x8 qf[8];
#pragma unroll
    for (int d0 = 0; d0 < 8; ++d0) qf[d0] = *(const bf16x8*)(QX + qrow * 512 + head * 128 + 16 * d0 + 8 * h);
    f32x16 o[4];
#pragma unroll
    for (int db = 0; db < 4; ++db) o[db] = (f32x16){};
    float mrun = -INFINITY, lsum = 0.f;
#pragma unroll 1
    for (int half = 0; half < 2; ++half) {
        __syncthreads();
#pragma unroll
        for (int i = 0; i < 4; ++i) { const int c = tid + 512 * i, row = c >> 4, ch = c & 15;
            const v4u kv = *(const GAS v4u*)(KX + ((size_t)b * NMEM + half * 128 + row) * 512 + head * 128 + ch * 8);
            const v4u vv = *(const GAS v4u*)(VT + ((size_t)head * 128 + row) * 512 + b * NMEM + half * 128 + ch * 8);
            *(LAS v4u*)(lds + KIMG + row * RB + ch * 16) = kv; *(LAS v4u*)(lds + VIMG + row * RB + ch * 16) = vv; }
        __syncthreads();
        f32x16 st[4];
#pragma unroll
        for (int kb = 0; kb < 4; ++kb) { st[kb] = (f32x16){};
#pragma unroll
            for (int d0 = 0; d0 < 8; ++d0) { const bf16x8 a = *(const LAS bf16x8*)(lds + KIMG + (32 * kb + r32) * RB + (16 * d0 + 8 * h) * 2);
                st[kb] = __builtin_amdgcn_mfma_f32_32x32x16_bf16(a, qf[d0], st[kb], 0, 0, 0); } }
        float mloc = st[0][0];
#pragma unroll
        for (int kb = 0; kb < 4; ++kb)
#pragma unroll
            for (int i = 0; i < 16; ++i) mloc = fmaxf(mloc, st[kb][i]);
        const float mnew = fmaxf(mrun, swapmax(mloc)), alpha = __builtin_amdgcn_exp2f(mrun - mnew);
        float psum = 0.f;
#pragma unroll
        for (int kb = 0; kb < 4; ++kb)
#pragma unroll
            for (int i = 0; i < 16; ++i) { st[kb][i] = __builtin_amdgcn_exp2f(st[kb][i] - mnew); psum += st[kb][i]; }
        lsum = lsum * alpha + psum; mrun = mnew;
#pragma unroll
        for (int db = 0; db < 4; ++db)
#pragma unroll
            for (int i = 0; i < 16; ++i) o[db][i] *= alpha;
#pragma unroll
        for (int kb = 0; kb < 4; ++kb)
#pragma unroll
            for (int sp = 0; sp < 2; ++sp) {
                v4u pw; pw.x = cvtpk(st[kb][8 * sp], st[kb][8 * sp + 1]); pw.y = cvtpk(st[kb][8 * sp + 2], st[kb][8 * sp + 3]); pw.z = cvtpk(st[kb][8 * sp + 4], st[kb][8 * sp + 5]); pw.w = cvtpk(st[kb][8 * sp + 6], st[kb][8 * sp + 7]);
                const bf16x8 pb = __builtin_bit_cast(bf16x8, pw);
#pragma unroll
                for (int db = 0; db < 4; ++db) { const LAS unsigned char* vp = lds + VIMG + (32 * db + r32) * RB + (32 * kb + 16 * sp + 4 * h) * 2;
                    const s16x4 lo = *(const LAS s16x4*)vp, hi = *(const LAS s16x4*)(vp + 16);
                    const bf16x8 va = {lo[0], lo[1], lo[2], lo[3], hi[0], hi[1], hi[2], hi[3]};
                    o[db] = __builtin_amdgcn_mfma_f32_32x32x16_bf16(va, pb, o[db], 0, 0, 0); } }
    }
    const float inv = 1.f / swapadd(lsum);
    bf16* orow = OX + qrow * 512 + head * 128;
#pragma unroll
    for (int db = 0; db < 4; ++db)
#pragma unroll
        for (int g = 0; g < 4; ++g) {
            const unsigned long long w = (unsigned long long)cvtpk(o[db][4 * g] * inv, o[db][4 * g + 1] * inv) | ((unsigned long long)cvtpk(o[db][4 * g + 2] * inv, o[db][4 * g + 3] * inv) << 32);
            *(GAS unsigned long long*)(orow + 32 * db + 8 * g + 4 * h) = w; }
}
}


namespace mls {
typedef short bf16x8 __attribute__((ext_vector_type(8)));
typedef short s16x4 __attribute__((ext_vector_type(4)));
typedef float f32x16 __attribute__((ext_vector_type(16)));
constexpr int RB = 128, VIMG = 0, KIMG = 8192, ATAB = 8192, NTAB = 8448;
__device__ __forceinline__ s16x4 trd(const LAS unsigned char* p) { typedef short v4i16_t __attribute__((ext_vector_type(4))); return __builtin_bit_cast(s16x4, __builtin_amdgcn_ds_read_tr16_b64_v4i16((LAS v4i16_t*)p)); }
__device__ __forceinline__ bf16x8 cat8(s16x4 lo, s16x4 hi) { return (bf16x8){lo[0], lo[1], lo[2], lo[3], hi[0], hi[1], hi[2], hi[3]}; }
__device__ __forceinline__ unsigned cvtpk(float lo, float hi) { typedef float f2 __attribute__((ext_vector_type(2))); typedef __bf16 b2 __attribute__((ext_vector_type(2))); f2 v = {lo, hi}; b2 b = __builtin_convertvector(v, b2); return __builtin_bit_cast(unsigned, b); }
__device__ __forceinline__ bf16x8 pack8(const float* f) { v4u w; w.x = cvtpk(f[0], f[1]); w.y = cvtpk(f[2], f[3]); w.z = cvtpk(f[4], f[5]); w.w = cvtpk(f[6], f[7]); return __builtin_bit_cast(bf16x8, w); }
__device__ __forceinline__ float swapadd(float m) { auto rr = __builtin_amdgcn_permlane32_swap(__float_as_uint(m), __float_as_uint(m), false, false); return __uint_as_float(rr[0]) + __uint_as_float(rr[1]); }
__device__ __forceinline__ int crow(int r, int hi) { return (r & 3) + 8 * (r >> 2) + 4 * hi; }

__device__ __forceinline__ void u_unit(const Ptrs& P, int bhk, LAS unsigned char* wl, int lane) {
    const int bh = bhk / NCH, k = bhk % NCH, b = bh / MH, hd = bh % MH; const size_t row0 = (size_t)b * SEQ + (size_t)k * 64;
    const int r32 = lane & 31, h = lane >> 5;
    const float li = WSP(const float, WS_GATE)[(size_t)hd * M + row0 + lane], bl = WSP(const float, WS_BL)[(size_t)bh * SEQ + k * 64 + lane];
    const float wg = __expf(WSP(const float, WS_BT)[bhk] - bl + li - WSP(const float, WS_MS)[bh * (NCH + 1) + k + 1]);
    const bf16* vsrc = WSP(const bf16, R_T0 + SZ_T) + row0 * 512 + hd * 64; const bf16* ksrc = WSP(const bf16, R_MQK) + row0 * 512 + 256 + hd * 64;
#pragma unroll
    for (int i = 0; i < 8; ++i) { const int row = i * 8 + (lane >> 3), ch = lane & 7;
        *(LAS v4u*)(wl + VIMG + row * RB + ch * 16) = *(const GAS v4u*)(vsrc + (size_t)row * 512 + ch * 8);
        const v4u kk = *(const GAS v4u*)(ksrc + (size_t)row * 512 + ch * 8); float f[8]; unpack8(kk, f); const float w = __shfl(wg, row);
#pragma unroll
        for (int e = 0; e < 8; ++e) f[e] *= w;
        *(LAS bf16x8*)(wl + KIMG + row * RB + ch * 16) = pack8(f); }
    f32x16 acc[2][2];
#pragma unroll
    for (int a = 0; a < 2; ++a)
#pragma unroll
        for (int c = 0; c < 2; ++c) acc[a][c] = (f32x16){};
    const unsigned toff = (unsigned)(((lane & 15) >> 2) * RB + (16 * ((lane >> 4) & 1) + 4 * (lane & 3)) * 2);
#pragma unroll
    for (int st = 0; st < 4; ++st) { bf16x8 af[2], bf_[2];
#pragma unroll
        for (int c = 0; c < 2; ++c) { const LAS unsigned char* pv = wl + VIMG + (16 * st + 8 * h) * RB + toff + 64 * c; af[c] = cat8(trd(pv), trd(pv + 4 * RB));
                                      const LAS unsigned char* pk = wl + KIMG + (16 * st + 8 * h) * RB + toff + 64 * c; bf_[c] = cat8(trd(pk), trd(pk + 4 * RB)); }
#pragma unroll
        for (int jb = 0; jb < 2; ++jb)
#pragma unroll
            for (int ib = 0; ib < 2; ++ib) acc[jb][ib] = __builtin_amdgcn_mfma_f32_32x32x16_bf16(af[jb], bf_[ib], acc[jb][ib], 0, 0, 0); }
    float* UT = WSP(float, R_CST) + (size_t)bhk * 4096;
#pragma unroll
    for (int jb = 0; jb < 2; ++jb)
#pragma unroll
        for (int ib = 0; ib < 2; ++ib)
#pragma unroll
            for (int e = 0; e < 16; ++e) UT[(32 * jb + crow(e, h)) * 64 + 32 * ib + r32] = acc[jb][ib][e];
    float sn = 0.f;
#pragma unroll 8
    for (int r = 0; r < 64; ++r) sn += bf2f(*(const LAS bf16*)(wl + KIMG + r * RB + lane * 2));
    WSP(float, WS_NST)[(size_t)bhk * 64 + lane] = sn;
}

__device__ __forceinline__ void decay_apply(f32x16& tile, int sb, int tb, const LAS float* atab, float mx, float& dsum, int r32, int h) {
#pragma unroll
    for (int g = 0; g < 4; ++g) { const f32x4 av = *(const LAS f32x4*)(atab + 32 * sb + 8 * g + 4 * h);
#pragma unroll
        for (int c = 0; c < 4; ++c) { const int sidx = 32 * sb + 8 * g + 4 * h + c, t = 32 * tb + r32;
            const float w = (sidx <= t) ? __expf(av[c] - mx) : 0.f; tile[4 * g + c] *= w; dsum += tile[4 * g + c]; } }
}
__device__ __forceinline__ bf16x8 packstep(const f32x16& x, int st) { v4u w; w.x = cvtpk(x[8 * st], x[8 * st + 1]); w.y = cvtpk(x[8 * st + 2], x[8 * st + 3]); w.z = cvtpk(x[8 * st + 4], x[8 * st + 5]); w.w = cvtpk(x[8 * st + 6], x[8 * st + 7]); return __builtin_bit_cast(bf16x8, w); }

__device__ __forceinline__ void out_unit(const Ptrs& P, int l, int bhk, LAS unsigned char* wl, int lane) {
    const int bh = bhk / NCH, k = bhk % NCH, b = bh / MH, hd = bh % MH; const size_t row0 = (size_t)b * SEQ + (size_t)k * 64;
    const int r32 = lane & 31, h = lane >> 5;
    const bf16* T1 = WSP(const bf16, R_T0 + SZ_T); const bf16* MQK = WSP(const bf16, R_MQK);
    const bf16* vsrc = T1 + row0 * 512 + hd * 64;
    v4u vreg[8];
#pragma unroll
    for (int i = 0; i < 8; ++i) { const int row = i * 8 + (lane >> 3), ch = lane & 7; vreg[i] = *(const GAS v4u*)(vsrc + (size_t)row * 512 + ch * 8); }
    bf16x8 qf[2][4], kf[2][4];
#pragma unroll
    for (int tb = 0; tb < 2; ++tb)
#pragma unroll
        for (int d0 = 0; d0 < 4; ++d0) { qf[tb][d0] = *(const bf16x8*)(MQK + (row0 + 32 * tb + r32) * 512 + hd * 64 + 16 * d0 + 8 * h);
                                         kf[tb][d0] = *(const bf16x8*)(MQK + (row0 + 32 * tb + r32) * 512 + 256 + hd * 64 + 16 * d0 + 8 * h); }
    const float li_s = WSP(const float, WS_GATE)[(size_t)hd * M + row0 + lane], bl_s = WSP(const float, WS_BL)[(size_t)bh * SEQ + k * 64 + lane];
    const float mk = WSP(const float, WS_MS)[bh * (NCH + 1) + k]; const float nst = WSP(const float, WS_NST)[(size_t)bhk * 64 + lane];
    const float a_s = li_s - bl_s; float pm = a_s;
#pragma unroll
    for (int o = 1; o < 64; o <<= 1) { const float t = __shfl_up(pm, o); if (lane >= o) pm = fmaxf(pm, t); }
    LAS float* atab = (LAS float*)(wl + ATAB); LAS float* ntab = (LAS float*)(wl + NTAB);
    atab[lane] = a_s; ntab[lane] = nst;
    float mx[2], wi[2], blt[2];
#pragma unroll
    for (int tb = 0; tb < 2; ++tb) { const int t = 32 * tb + r32; blt[tb] = __shfl(bl_s, t); mx[tb] = fmaxf(mk, __shfl(pm, t)); wi[tb] = __expf(mk - mx[tb]); }
#pragma unroll
    for (int i = 0; i < 8; ++i) { const int row = i * 8 + (lane >> 3), ch = lane & 7; *(LAS v4u*)(wl + VIMG + row * RB + ch * 16) = vreg[i]; }
    f32x16 s00 = (f32x16){}, s01 = (f32x16){}, s11 = (f32x16){};
#pragma unroll
    for (int d0 = 0; d0 < 4; ++d0) { s00 = __builtin_amdgcn_mfma_f32_32x32x16_bf16(kf[0][d0], qf[0][d0], s00, 0, 0, 0);
        s01 = __builtin_amdgcn_mfma_f32_32x32x16_bf16(kf[0][d0], qf[1][d0], s01, 0, 0, 0); s11 = __builtin_amdgcn_mfma_f32_32x32x16_bf16(kf[1][d0], qf[1][d0], s11, 0, 0, 0); }
    float dsum[2] = {0.f, 0.f};
    decay_apply(s00, 0, 0, atab, mx[0], dsum[0], r32, h); decay_apply(s01, 0, 1, atab, mx[1], dsum[1], r32, h); decay_apply(s11, 1, 1, atab, mx[1], dsum[1], r32, h);
    f32x16 nacc[2][2];
#pragma unroll
    for (int a = 0; a < 2; ++a)
#pragma unroll
        for (int c = 0; c < 2; ++c) nacc[a][c] = (f32x16){};
    const unsigned toff = (unsigned)(((lane & 15) >> 2) * RB + (16 * ((lane >> 4) & 1) + 4 * (lane & 3)) * 2);
#pragma unroll
    for (int sb = 0; sb < 2; ++sb)
#pragma unroll
        for (int st = 0; st < 2; ++st) { bf16x8 va[2];
#pragma unroll
            for (int jb = 0; jb < 2; ++jb) { const LAS unsigned char* pv = wl + VIMG + (32 * sb + 16 * st + 4 * h) * RB + toff + 64 * jb; va[jb] = cat8(trd(pv), trd(pv + 8 * RB)); }
            if (sb == 0) { const bf16x8 p0 = packstep(s00, st), p1 = packstep(s01, st);
#pragma unroll
                for (int jb = 0; jb < 2; ++jb) { nacc[jb][0] = __builtin_amdgcn_mfma_f32_32x32x16_bf16(va[jb], p0, nacc[jb][0], 0, 0, 0); nacc[jb][1] = __builtin_amdgcn_mfma_f32_32x32x16_bf16(va[jb], p1, nacc[jb][1], 0, 0, 0); }
            } else { const bf16x8 p1 = packstep(s11, st);
#pragma unroll
                for (int jb = 0; jb < 2; ++jb) nacc[jb][1] = __builtin_amdgcn_mfma_f32_32x32x16_bf16(va[jb], p1, nacc[jb][1], 0, 0, 0); } }
    const float* CT = WSP(const float, R_CST) + (size_t)bhk * 4096;
    float dint[2] = {0.f, 0.f};
#pragma unroll
    for (int st = 0; st < 4; ++st) { bf16x8 ca[2];
#pragma unroll
        for (int jb = 0; jb < 2; ++jb) { const float* cp = CT + (32 * jb + r32) * 64 + 16 * st + 8 * h; const f32x4 c0 = *(const f32x4*)cp, c1 = *(const f32x4*)(cp + 4);
            const float f[8] = {c0[0], c0[1], c0[2], c0[3], c1[0], c1[1], c1[2], c1[3]}; ca[jb] = pack8(f); }
        const f32x4 n0 = *(const LAS f32x4*)(ntab + 16 * st + 8 * h), n1 = *(const LAS f32x4*)(ntab + 16 * st + 8 * h + 4);
#pragma unroll
        for (int tb = 0; tb < 2; ++tb) { float f[8]; unpack8(__builtin_bit_cast(v4u, qf[tb][st]), f);
            dint[tb] += (f[0] * n0[0] + f[1] * n0[1]) + (f[2] * n0[2] + f[3] * n0[3]) + (f[4] * n1[0] + f[5] * n1[1]) + (f[6] * n1[2] + f[7] * n1[3]);
#pragma unroll
            for (int e = 0; e < 8; ++e) f[e] *= wi[tb];
            const bf16x8 qw = pack8(f);
#pragma unroll
            for (int jb = 0; jb < 2; ++jb) nacc[jb][tb] = __builtin_amdgcn_mfma_f32_32x32x16_bf16(ca[jb], qw, nacc[jb][tb], 0, 0, 0); } }
    const float* nw = P.in[I_MNW] + l * 256 + hd * 64; bf16* CAT = WSP(bf16, R_CAT);
#pragma unroll
    for (int tb = 0; tb < 2; ++tb) {
        const float den = swapadd(dsum[tb]) + wi[tb] * swapadd(dint[tb]);
        const float dinv = 1.f / fmaxf(fabsf(den), __expf(-(blt[tb] + mx[tb])));
        float ss = 0.f;
#pragma unroll
        for (int jb = 0; jb < 2; ++jb)
#pragma unroll
            for (int e = 0; e < 16; ++e) { const float v = nacc[jb][tb][e] * dinv; ss += v * v; }
        const float scale = dinv / sqrtf(swapadd(ss) * (1.f / 64.f) + EPS);
        const size_t row = row0 + 32 * tb + r32;
#pragma unroll
        for (int jb = 0; jb < 2; ++jb)
#pragma unroll
            for (int g = 0; g < 4; ++g) { const int j0 = 32 * jb + 8 * g + 4 * h; const f32x4 nwv = *(const f32x4*)(nw + j0);
                const unsigned long long mo = *(const GAS unsigned long long*)(T1 + row * 512 + 256 + hd * 64 + j0);
                const float m0 = __uint_as_float((unsigned)(mo << 16)), m1 = __uint_as_float((unsigned)mo & 0xffff0000u), m2 = __uint_as_float((unsigned)(mo >> 32) << 16), m3 = __uint_as_float((unsigned)(mo >> 32) & 0xffff0000u);
                const float y0 = nacc[jb][tb][4 * g] * scale * nwv[0] * __builtin_amdgcn_rcpf(1.f + __expf(-m0)), y1 = nacc[jb][tb][4 * g + 1] * scale * nwv[1] * __builtin_amdgcn_rcpf(1.f + __expf(-m1));
                const float y2 = nacc[jb][tb][4 * g + 2] * scale * nwv[2] * __builtin_amdgcn_rcpf(1.f + __expf(-m2)), y3 = nacc[jb][tb][4 * g + 3] * scale * nwv[3] * __builtin_amdgcn_rcpf(1.f + __expf(-m3));
                *(GAS unsigned long long*)(CAT + row * 1024 + hd * 64 + j0) = (unsigned long long)cvtpk(y0, y1) | ((unsigned long long)cvtpk(y2, y3) << 32); }
    }
}
__device__ __forceinline__ void state_scan(const Ptrs& P, long gtid, long gn) {
    const float* DEC = WSP(const float, WS_DEC); float* CST = WSP(float, R_CST); float* NST = WSP(float, WS_NST);
    for (long it = gtid; it < 8 * 4160; it += gn) {
        const int bh = (int)it / 4160, e = (int)it % 4160; float run = 0.f;
        float* base = e < 4096 ? CST + (size_t)bh * NCH * 4096 + e : NST + (size_t)bh * NCH * 64 + (e - 4096); const size_t stride = e < 4096 ? 4096 : 64;
        for (int k0 = 0; k0 < NCH; k0 += 16) { float u[16], d[16];
#pragma unroll
            for (int i = 0; i < 16; ++i) { u[i] = base[(size_t)(k0 + i) * stride]; d[i] = DEC[bh * NCH + k0 + i]; }
#pragma unroll
            for (int i = 0; i < 16; ++i) { base[(size_t)(k0 + i) * stride] = run; run = d[i] * run + u[i]; } }
    }
}
}

constexpr int RING_BYTES = 131072;
constexpr int MISC_OFF = RING_BYTES;
constexpr int PTR_OFF = RING_BYTES + 256;
constexpr int JOB_OFF = RING_BYTES + 512;
constexpr int LDS_BYTES = 147456;
constexpr int NWAVES = 8;

__device__ __forceinline__ float wave_sum(float v) {
#pragma unroll
    for (int o = 1; o < 64; o <<= 1) v += __shfl_xor(v, o);
    return v;
}
struct WJob { const float* W0; const float* W1; const float* rs; bf16* WT; int K, Nsrc, nblk, kind; float cs; int item0; int pad0, pad1; };
constexpr int MAX_JOBS = 32;
__device__ __forceinline__ void p0_transpose_item(const LAS WJob* jb, LAS float* scr, int item, int lane) {
    const int K = jb->K, N = jb->Nsrc, nblk = jb->nblk, kb = item / nblk, nb = item % nblk, k0 = 64 * kb;
    int which, col0; float cs; wmap(jb->kind, nb, which, col0, cs); cs *= jb->cs;
    const float* W = which ? jb->W1 : jb->W0; const float* rs = jb->rs;
    const float* src = W + (size_t)(k0 + (lane >> 5)) * N + col0 + (lane & 31);
    float v[32];
#pragma unroll
    for (int i = 0; i < 32; ++i) v[i] = __builtin_nontemporal_load(src + (size_t)(2 * i) * N);
#pragma unroll
    for (int i = 0; i < 32; ++i) scr[(2 * i + (lane >> 5)) * 33 + (lane & 31)] = v[i];
    LDS_WAIT(); asm volatile("" ::: "memory");
    const int c = lane & 7; bf16* WT = jb->WT;
    f32x4 r0 = {cs, cs, cs, cs}, r1 = r0;
    if (rs) { r0 = *(const f32x4*)(rs + k0 + 8 * c) * cs; r1 = *(const f32x4*)(rs + k0 + 8 * c + 4) * cs; }
#pragma unroll
    for (int j = 0; j < 4; ++j) { const int n = (lane >> 3) + 8 * j; const LAS float* sp = scr + (8 * c) * 33 + n;
        if (jb->pad0) {
            const float q_ = (float)jb->pad0;
            int p0 = __builtin_amdgcn_cvt_pk_fp8_f32(sp[0 * 33] * r0[0] * q_, sp[1 * 33] * r0[1] * q_, 0, false); p0 = __builtin_amdgcn_cvt_pk_fp8_f32(sp[2 * 33] * r0[2] * q_, sp[3 * 33] * r0[3] * q_, p0, true);
            int p1 = __builtin_amdgcn_cvt_pk_fp8_f32(sp[4 * 33] * r1[0] * q_, sp[5 * 33] * r1[1] * q_, 0, false); p1 = __builtin_amdgcn_cvt_pk_fp8_f32(sp[6 * 33] * r1[2] * q_, sp[7 * 33] * r1[3] * q_, p1, true);
            typedef unsigned v2u_ __attribute__((ext_vector_type(2)));
            __builtin_nontemporal_store((v2u_){(unsigned)p0, (unsigned)p1}, (GAS v2u_*)((unsigned char*)WT + (size_t)(nb * 32 + n) * K + k0 + 8 * c));
            continue; }
        v4u o; o.x = pk2(sp[0 * 33] * r0[0], sp[1 * 33] * r0[1]); o.y = pk2(sp[2 * 33] * r0[2], sp[3 * 33] * r0[3]); o.z = pk2(sp[4 * 33] * r1[0], sp[5 * 33] * r1[1]); o.w = pk2(sp[6 * 33] * r1[2], sp[7 * 33] * r1[3]);
        __builtin_nontemporal_store(o, (GAS v4u*)(WT + (size_t)(nb * 32 + n) * K + k0 + 8 * c)); }
    LDS_WAIT(); asm volatile("" ::: "memory");
}
__device__ __forceinline__ void build_gw(const Ptrs& P, long gtid, long gn) {
    for (long it = gtid; it < 3 * 32 * 64; it += gn) {
        const int t = (int)(it / 2048), ks = (int)((it / 64) % 32), ln = (int)(it % 64), c = ln & 15, quad = ln >> 4;
        float hi[8], lo[8];
#pragma unroll
        for (int j = 0; j < 8; ++j) { const int k = 32 * ks + 8 * quad + j; float w;
            if (t < 2) w = P.in[I_NMIX][t * D + k] * P.in[I_WIN][(size_t)t * D * INW + (size_t)k * INW + (c < 8 ? 1024 + c : 3072 + c)];
            else w = (c < 8) ? P.in[I_NFFN][D + k] * P.in[I_RW][(size_t)k * 8 + c] : 0.f;
            const float h = bf2f(f2bf(w)); hi[j] = h; lo[j] = w - h; }
        v4u oh, ol; oh.x = pk2(hi[0], hi[1]); oh.y = pk2(hi[2], hi[3]); oh.z = pk2(hi[4], hi[5]); oh.w = pk2(hi[6], hi[7]); ol.x = pk2(lo[0], lo[1]); ol.y = pk2(lo[2], lo[3]); ol.z = pk2(lo[4], lo[5]); ol.w = pk2(lo[6], lo[7]);
        v4u* tab = (v4u*)(P.ws + WS_GW + (size_t)t * 65536); tab[(ks * 2 + 0) * 64 + ln] = oh; tab[(ks * 2 + 1) * 64 + ln] = ol;
    }
}
template <int MODE, bool PRE>
__device__ __forceinline__ void norm16(const Ptrs& P, int l, const float* src, bf16* XN, const unsigned* rss_in, int vcu, int G, int wave, int lane, LAS float* xch) {
    typedef short bf16x8 __attribute__((ext_vector_type(8)));
    const int r = lane & 15, quad = lane >> 4, kh = wave >> 2;
    const v4u* tab = (const v4u*)(P.ws + WS_GW + (size_t)(MODE == 2 ? 2 : l) * 65536) + lane;
    if constexpr (MODE == 2) { if (wave == 0 && lane < 8) ((LAS unsigned*)(xch + 2048))[64 * 4 + lane] = 0u; }
    for (int t0 = 0; t0 < M / 16; t0 += 4 * G) {
        const int task = t0 + (wave & 3) * G + vcu; const bool live = task < M / 16; const int r0 = (live ? task : 0) * 16;
        const float* xr = src + (size_t)(r0 + r) * D + 8 * quad; bf16* xo = XN + (size_t)(r0 + r) * D + 8 * quad;
        f32x4 acc = {0.f, 0.f, 0.f, 0.f}; float ss = 0.f;
#pragma unroll
        for (int kk = 0; kk < 16; ++kk) { const int ks = 16 * kh + kk;
            if constexpr (PRE) {
                const v4u h = *(const GAS v4u*)(xo + 32 * ks);
                const bf16x8 ah = __builtin_bit_cast(bf16x8, h);
                const bf16x8 bh = __builtin_bit_cast(bf16x8, tab[(ks * 2 + 0) * 64]), bl = __builtin_bit_cast(bf16x8, tab[(ks * 2 + 1) * 64]);
                acc = __builtin_amdgcn_mfma_f32_16x16x32_bf16(ah, bh, acc, 0, 0, 0); acc = __builtin_amdgcn_mfma_f32_16x16x32_bf16(ah, bl, acc, 0, 0, 0);
            } else {
            const f32x4 a = __builtin_nontemporal_load((const GAS f32x4*)(xr + 32 * ks)), b = __builtin_nontemporal_load((const GAS f32x4*)(xr + 32 * ks + 4));
            ss += (a[0] * a[0] + a[1] * a[1]) + (a[2] * a[2] + a[3] * a[3]) + (b[0] * b[0] + b[1] * b[1]) + (b[2] * b[2] + b[3] * b[3]);
            v4u h; h.x = pk2(a[0], a[1]); h.y = pk2(a[2], a[3]); h.z = pk2(b[0], b[1]); h.w = pk2(b[2], b[3]);
            if (live) *(GAS v4u*)(xo + 32 * ks) = h;
            if constexpr (MODE != 0) {
                float hf[8]; unpack8(h, hf);
                v4u lw; lw.x = pk2(a[0] - hf[0], a[1] - hf[1]); lw.y = pk2(a[2] - hf[2], a[3] - hf[3]); lw.z = pk2(b[0] - hf[4], b[1] - hf[5]); lw.w = pk2(b[2] - hf[6], b[3] - hf[7]);
                const bf16x8 ah = __builtin_bit_cast(bf16x8, h), al = __builtin_bit_cast(bf16x8, lw);
                const bf16x8 bh = __builtin_bit_cast(bf16x8, tab[(ks * 2 + 0) * 64]), bl = __builtin_bit_cast(bf16x8, tab[(ks * 2 + 1) * 64]);
                acc = __builtin_amdgcn_mfma_f32_16x16x32_bf16(ah, bh, acc, 0, 0, 0); acc = __builtin_amdgcn_mfma_f32_16x16x32_bf16(al, bh, acc, 0, 0, 0); acc = __builtin_amdgcn_mfma_f32_16x16x32_bf16(ah, bl, acc, 0, 0, 0);
            }
            }
        }
        { LAS float* xp = xch + ((wave & 3) * 64 + lane) * 5;
          if (kh == 1) { xp[0] = acc[0]; xp[1] = acc[1]; xp[2] = acc[2]; xp[3] = acc[3]; xp[4] = ss; }
          __syncthreads();
          if (kh == 0) { acc[0] += xp[0]; acc[1] += xp[1]; acc[2] += xp[2]; acc[3] += xp[3]; ss += xp[4]; }
          __syncthreads(); }
        if constexpr (MODE != 2) { if (kh == 1 || !live) continue; }
        if (MODE != 2 || (kh == 0 && live)) {
        unsigned sq;
        if constexpr (PRE) sq = rss_in[r0 + r]; else { ss += __shfl_xor(ss, 16); ss += __shfl_xor(ss, 32); sq = (unsigned)(ss * 16.f + 0.5f); if (lane < 16) WSP(unsigned, WS_RSTD)[r0 + lane] = sq; }
        ss = (float)sq * (1.f / 16.f);
        const float rstd = 1.f / sqrtf(ss * (1.f / D) + EPS);
        if constexpr (MODE != 0) {
            float z[4];
#pragma unroll
            for (int j = 0; j < 4; ++j) z[j] = acc[j] * __shfl(rstd, 4 * quad + j);
            if constexpr (MODE == 1) {
                const int g = r; f32x4 o;
#pragma unroll
                for (int j = 0; j < 4; ++j) { if (g < 4) o[j] = z[j] + P.in[I_MBI][l * 4 + g]; else if (g < 8) o[j] = logsigmoidf_(z[j] + P.in[I_MBF][l * 4 + g - 4]); else o[j] = logsigmoidf_(z[j] + P.in[I_FBF][l * 8 + g - 8]); }
                *(f32x4*)(WSP(float, WS_GATE) + (size_t)g * M + r0 + 4 * quad) = o;
            } else {
#pragma unroll
                for (int j = 0; j < 4; ++j) { float le[8];
#pragma unroll
                    for (int e = 0; e < 8; ++e) le[e] = __shfl(z[j], (lane & 48) + e);
                    int e1 = 0; float v1 = le[0];
#pragma unroll
                    for (int e = 1; e < 8; ++e) if (le[e] > v1) { v1 = le[e]; e1 = e; }
                    int e2 = -1; float v2 = -INFINITY;
#pragma unroll
                    for (int e = 0; e < 8; ++e) if (e != e1 && le[e] > v2) { v2 = le[e]; e2 = e; }
                    if (r == j) { const float g2 = 1.f / (1.f + expf(v1 - v2)), g1 = 1.f - g2;
                        LAS unsigned* sp = (LAS unsigned*)(xch + 2048) + ((wave & 3) * 16 + 4 * quad + j) * 4;
                        sp[0] = (unsigned)e1; sp[1] = (unsigned)e2; sp[2] = __float_as_uint(g1); sp[3] = __float_as_uint(g2); }
                }
            }
        }
        }
        if constexpr (MODE == 2) {
            LAS unsigned* selb = (LAS unsigned*)(xch + 2048); LAS unsigned* hacc = selb + 64 * 4;
            if (!(kh == 0 && live) && wave < 4 && r < 4) selb[((wave & 3) * 16 + 4 * quad + r) * 4] = 255u;
            __syncthreads();
            if (wave == 0) {
                const int w = lane >> 4, e1 = (int)selb[lane * 4], e2 = (int)selb[lane * 4 + 1]; const bool valid = e1 < 8;
                const unsigned long long below = (1ull << lane) - 1ull; int rank1 = 0, rank2 = 0; unsigned mynew = 0u;
#pragma unroll
                for (int e = 0; e < 8; ++e) { const unsigned old_ = hacc[e];
                    const unsigned long long m1 = __ballot(valid && e1 == e), m2 = __ballot(valid && e2 == e); const int c1 = __popcll(m1);
                    if (e1 == e) rank1 = (int)old_ + __popcll(m1 & below);
                    if (e2 == e) rank2 = (int)old_ + c1 + __popcll(m2 & below);
                    if (lane == e) mynew = old_ + (unsigned)(c1 + __popcll(m2)); }
                if (valid) { const int row = (t0 + w * G + vcu) * 16 + (lane & 15); unsigned* tk = WSP(unsigned, WS_TOK) + (size_t)row * 8;
                    tk[0] = (unsigned)e1; tk[1] = (unsigned)rank1; tk[2] = (unsigned)e2; tk[3] = (unsigned)rank2; tk[4] = selb[lane * 4 + 2]; tk[5] = selb[lane * 4 + 3]; }
                if (lane < 8) hacc[lane] = mynew;
            }
            __syncthreads();
        }
    }
    if constexpr (MODE == 2) { if (wave == 0 && lane < 8) WSP(unsigned, WS_BH)[vcu * 8 + lane] = ((LAS unsigned*)(xch + 2048))[64 * 4 + lane]; }
}
template <int MODE>
__device__ __forceinline__ void norm_rows(const Ptrs& P, int l, const float* src, bf16* XN, int nrows, int gw, int ngw, int lane) {
    for (int row = gw; row < nrows; row += ngw) {
        const GAS f32x4* xr = (const GAS f32x4*)(src + (size_t)row * D) + lane;
        f32x4 v[4]; float s2 = 0.f;
#pragma unroll
        for (int j = 0; j < 4; ++j) { v[j] = xr[64 * j]; s2 += (v[j].x * v[j].x + v[j].y * v[j].y) + (v[j].z * v[j].z + v[j].w * v[j].w); }
        const float rstd = 1.f / sqrtf(wave_sum(s2) * (1.f / D) + EPS);
        GAS unsigned long long* o8 = (GAS unsigned long long*)(XN + (size_t)row * D) + lane;
#pragma unroll
        for (int j = 0; j < 4; ++j) o8[64 * j] = (unsigned long long)pk2(v[j].x * rstd, v[j].y * rstd) | ((unsigned long long)pk2(v[j].z * rstd, v[j].w * rstd) << 32);
    }
}

__device__ __forceinline__ float wave_incl_scan(float v, int lane) {
#pragma unroll
    for (int o = 1; o < 64; o <<= 1) { const float t = __shfl_up(v, o); if (lane >= o) v += t; }
    return v;
}
__device__ __forceinline__ float wave_max(float v) {
#pragma unroll
    for (int o = 1; o < 64; o <<= 1) v = fmaxf(v, __shfl_xor(v, o));
    return v;
}
__device__ __forceinline__ void gate_scan_task(const Ptrs& P, int task, LAS float* scr, int tid) {
    const int lane = tid & 63, wave = tid >> 6; const float* GT = WSP(const float, WS_GATE);
    if (task < 16) {
        const int b = task / FH, h = task % FH; constexpr int EPT = SEQ / 512;
        const float* src = GT + (size_t)(8 + h) * M + (size_t)b * SEQ + tid * EPT; float* dst = WSP(float, WS_CF) + (size_t)task * SEQ + tid * EPT;
        float v[EPT]; float run = 0.f;
#pragma unroll
        for (int i = 0; i < EPT; i += 4) { const f32x4 x = *(const f32x4*)(src + i); run += x[0]; v[i] = run; run += x[1]; v[i + 1] = run; run += x[2]; v[i + 2] = run; run += x[3]; v[i + 3] = run; }
        const float wincl = wave_incl_scan(run, lane);
        if (lane == 63) scr[wave] = wincl;
        __syncthreads();
        float offs = wincl - run;
#pragma unroll
        for (int w = 0; w < 8; ++w) if (w < wave) offs += scr[w];
#pragma unroll
        for (int i = 0; i < EPT; i += 4) *(f32x4*)(dst + i) = (f32x4){(offs + v[i]) * LOG2E, (offs + v[i + 1]) * LOG2E, (offs + v[i + 2]) * LOG2E, (offs + v[i + 3]) * LOG2E};
        __syncthreads();
    } else {
        const int bh = task - 16, b = bh / MH, h = bh % MH;
        const float* lfp = GT + (size_t)(4 + h) * M + (size_t)b * SEQ; const float* lip = GT + (size_t)h * M + (size_t)b * SEQ;
        float* BL = WSP(float, WS_BL) + (size_t)bh * SEQ; float* BT = WSP(float, WS_BT) + bh * NCH; float* AK = WSP(float, WS_AK) + bh * NCH; float* MS = WSP(float, WS_MS) + bh * (NCH + 1);
        constexpr int CPW = NCH / 8;
        float lfv[CPW], liv[CPW];
#pragma unroll
        for (int i = 0; i < CPW; ++i) { const int k = wave + 8 * i; lfv[i] = lfp[k * 64 + lane]; liv[i] = lip[k * 64 + lane]; }
#pragma unroll
        for (int i = 0; i < CPW; ++i) { const int k = wave + 8 * i;
            const float bl = wave_incl_scan(lfv[i], lane); BL[k * 64 + lane] = bl;
            const float btot = __shfl(bl, 63); const float a = wave_max(btot - bl + liv[i]);
            if (lane == 0) { BT[k] = btot; AK[k] = a; scr[k] = btot; scr[NCH + k] = a; } }
        __syncthreads();
        if (wave == 0) { float* DEC = WSP(float, WS_DEC) + bh * NCH; constexpr int PL = NCH / 64;
            float f[PL], av[PL]; float run = 0.f;
#pragma unroll
            for (int i = 0; i < PL; ++i) { run += scr[lane * PL + i]; f[i] = run; av[i] = scr[NCH + lane * PL + i]; }
            const float offs = wave_incl_scan(run, lane) - run;
            float pm = -INFINITY; float c[PL];
#pragma unroll
            for (int i = 0; i < PL; ++i) { f[i] += offs; pm = fmaxf(pm, av[i] - f[i]); c[i] = pm; }
            float pin = pm;
#pragma unroll
            for (int o = 1; o < 64; o <<= 1) { const float t = __shfl_up(pin, o); if (lane >= o) pin = fmaxf(pin, t); }
            float pex = __shfl_up(pin, 1); if (lane == 0) pex = -INFINITY;
            float mprev = __shfl_up(fmaxf(0.f, pin) + f[PL - 1], 1); if (lane == 0) mprev = 0.f;
            if (lane == 0) MS[0] = 0.f;
#pragma unroll
            for (int i = 0; i < PL; ++i) { const int k = lane * PL + i; const float mn = f[i] + fmaxf(0.f, fmaxf(pex, c[i]));
                MS[k + 1] = mn; DEC[k] = __expf(scr[k] + mprev - mn); mprev = mn; } }
        __syncthreads();
    }
}
__device__ __forceinline__ void mconv_glu_vec(const Ptrs& P, int l, long gtid, long gn) {
    const bf16* T0 = WSP(const bf16, R_T0); bf16* MQK = WSP(bf16, R_MQK);
    const float* cw = P.in[I_MCW] + l * 4 * 512; const float* cb = P.in[I_MCB] + l * 512;
    for (long it0 = gtid; it0 < (long)M * 64; it0 += 4 * gn) {
        v4u w[4][4]; bool ok[4][4];
#pragma unroll
        for (int r = 0; r < 4; ++r) { const long it = it0 + r * gn; const int ch = (int)(it & 63); const long row = it >> 6; const int t = (int)(row % SEQ), c0 = ch * 8;
#pragma unroll
            for (int j = 0; j < 4; ++j) { ok[r][j] = it < (long)M * 64 && t - 3 + j >= 0; w[r][j] = (v4u){0u, 0u, 0u, 0u}; if (ok[r][j]) w[r][j] = *(const GAS v4u*)(T0 + (size_t)(row - 3 + j) * 512 + c0); } }
#pragma unroll
        for (int r = 0; r < 4; ++r) { const long it = it0 + r * gn; if (it >= (long)M * 64) continue; const int ch = (int)(it & 63); const long row = it >> 6; const int c0 = ch * 8;
            float acc[8];
#pragma unroll
            for (int i = 0; i < 8; ++i) acc[i] = cb[c0 + i];
#pragma unroll
            for (int j = 0; j < 4; ++j) { if (ok[r][j]) { float x[8]; unpack8(w[r][j], x);
#pragma unroll
                    for (int i = 0; i < 8; ++i) acc[i] += cw[j * 512 + c0 + i] * x[i]; } }
            const float sc = (c0 >= 256) ? 0.125f : 1.f; float y[8];
#pragma unroll
            for (int i = 0; i < 8; ++i) y[i] = acc[i] * __builtin_amdgcn_rcpf(1.f + __expf(-acc[i])) * sc;
            v4u o; o.x = pk2(y[0], y[1]); o.y = pk2(y[2], y[3]); o.z = pk2(y[4], y[5]); o.w = pk2(y[6], y[7]);
            *(GAS v4u*)(MQK + (size_t)row * 512 + c0) = o; }
    }
    const bf16* T2 = WSP(const bf16, R_T0 + 2 * SZ_T); bf16* GL = WSP(bf16, R_GL);
    for (long it0 = gtid; it0 < (long)M * 32; it0 += 4 * gn) {
        v4u wa[4], wg[4];
#pragma unroll
        for (int r = 0; r < 4; ++r) { const long it = it0 + r * gn; wa[r] = (v4u){0u, 0u, 0u, 0u}; wg[r] = wa[r];
            if (it < (long)M * 32) { const int c0 = (int)(it & 31) * 8; const long row = it >> 5; wa[r] = *(const GAS v4u*)(T2 + (size_t)row * 512 + c0); wg[r] = *(const GAS v4u*)(T2 + (size_t)row * 512 + 256 + c0); } }
#pragma unroll
        for (int r = 0; r < 4; ++r) { const long it = it0 + r * gn; if (it >= (long)M * 32) continue; const int c0 = (int)(it & 31) * 8; const long row = it >> 5;
            float a[8], g[8]; unpack8(wa[r], a); unpack8(wg[r], g); float y[8];
#pragma unroll
            for (int i = 0; i < 8; ++i) y[i] = a[i] * __builtin_amdgcn_rcpf(1.f + __expf(-g[i]));
            v4u o; o.x = pk2(y[0], y[1]); o.y = pk2(y[2], y[3]); o.z = pk2(y[4], y[5]); o.w = pk2(y[6], y[7]);
            *(GAS v4u*)(GL + (size_t)row * 256 + c0) = o; }
    }
}
__device__ __forceinline__ void cconv_ln_rows(const Ptrs& P, int l, int gw, int ngw, int lane) {
    const bf16* GL = WSP(const bf16, R_GL); bf16* CAT = WSP(bf16, R_CAT);
    const float* cw = P.in[I_CCW] + l * CK * 256 + 4 * lane; const int c0 = 4 * lane;
    const f32x4 cb = *(const f32x4*)(P.in[I_CCB] + l * 256 + c0), lw = *(const f32x4*)(P.in[I_CLW] + l * 256 + c0), lb = *(const f32x4*)(P.in[I_CLB] + l * 256 + c0);
    f32x4 w[CK];
#pragma unroll
    for (int j = 0; j < CK; ++j) w[j] = *(const f32x4*)(cw + j * 256);
    for (int task = gw; task < M / 8; task += ngw) {
        const int r0 = task * 8, t0 = r0 % SEQ;
        unsigned long long x[CK + 7];
#pragma unroll
        for (int i = 0; i < CK + 7; ++i) x[i] = (t0 - (CK - 1) + i >= 0) ? *(const GAS unsigned long long*)(GL + (size_t)(r0 - (CK - 1) + i) * 256 + c0) : 0ull;
        f32x4 acc[8];
#pragma unroll
        for (int o = 0; o < 8; ++o) acc[o] = cb;
#pragma unroll
        for (int i = 0; i < CK + 7; ++i) { const unsigned long long q = x[i];
            const f32x4 xf = {__uint_as_float((unsigned)(q << 16)), __uint_as_float((unsigned)q & 0xffff0000u), __uint_as_float((unsigned)(q >> 32) << 16), __uint_as_float((unsigned)(q >> 32) & 0xffff0000u)};
#pragma unroll
            for (int o = 0; o < 8; ++o) if (i - o >= 0 && i - o < CK) acc[o] += w[i - o] * xf; }
#pragma unroll
        for (int o = 0; o < 8; ++o) {
            const float mean = wave_sum((acc[o][0] + acc[o][1]) + (acc[o][2] + acc[o][3])) * (1.f / 256.f);
            const f32x4 d = acc[o] - mean; const float rstd = 1.f / sqrtf(wave_sum((d[0] * d[0] + d[1] * d[1]) + (d[2] * d[2] + d[3] * d[3])) * (1.f / 256.f) + EPS);
            f32x4 y = d * rstd * lw + lb;
#pragma unroll
            for (int i = 0; i < 4; ++i) y[i] = y[i] * __builtin_amdgcn_rcpf(1.f + __expf(-y[i]));
            *(GAS unsigned long long*)(CAT + (size_t)(r0 + o) * 1024 + 256 + c0) = (unsigned long long)pk2(y[0], y[1]) | ((unsigned long long)pk2(y[2], y[3]) << 32); }
    }
}
__device__ __forceinline__ void fox_keynorms(const Ptrs& P, int gw, int ngw, int lane) {
    const bf16* K = WSP(const bf16, R_T0 + 4 * SZ_T); float* KN2 = WSP(float, WS_KN2); constexpr int NTT = SEQ / 64;
    for (int u = gw; u < BATCH * FH * NTT; u += ngw) { const int bh = u / NTT, tile = u % NTT, b = bh / FH, h = bh % FH;
        const bf16* kr = K + ((size_t)b * SEQ + tile * 64 + lane) * 512 + h * 64; float ss = 0.f;
#pragma unroll
        for (int c = 0; c < 8; ++c) { const v4u v = *(const GAS v4u*)(kr + 8 * c); float f[8]; unpack8(v, f);
#pragma unroll
            for (int e = 0; e < 8; ++e) ss += f[e] * f[e]; }
        ss = wave_max(ss); if (lane == 0) KN2[u] = ss; }
}
__device__ __forceinline__ void moe_gather(const Ptrs& P, int gw, int ngw, int lane, int wave, int vcu, int G, LAS unsigned char* lds) {
    LAS unsigned* base = (LAS unsigned*)lds; LAS unsigned* tot = base + 1024 * 8;
    { const unsigned* BH = WSP(const unsigned, WS_BH); const int per = (G + 63) / 64; unsigned run = 0u;
      for (int k = 0; k < per; ++k) { const int blk = lane * per + k; if (blk < G) run += BH[blk * 8 + wave]; }
      unsigned incl = run;
#pragma unroll
      for (int o = 1; o < 64; o <<= 1) { const unsigned t = __shfl_up(incl, o); if (lane >= o) incl += t; }
      unsigned ex = incl - run;
      for (int k = 0; k < per; ++k) { const int blk = lane * per + k; if (blk < G) { base[blk * 8 + wave] = ex; ex += BH[blk * 8 + wave]; } }
      if (lane == 63) tot[wave] = incl; }
    __syncthreads();
    unsigned* cntg = WSP(unsigned, WS_CTL) + CW_CNT;
    if (vcu == 0 && wave == 0 && lane < 8) cntg[lane] = tot[lane];
    unsigned cnt[8];
#pragma unroll
    for (int e = 0; e < 8; ++e) cnt[e] = tot[e];
    int off[9]; { int o = 0;
#pragma unroll
        for (int e = 0; e < 8; ++e) { off[e] = o; o += ((int)cnt[e] + 255) & ~255; }
        off[8] = o; }
    const bf16* XN = WSP(const bf16, R_XN); bf16* XNS = WSP(bf16, R_XNS); unsigned char* XQ = P.ws + WS_XQ;
    for (int row0 = gw; row0 < M; row0 += 4 * ngw) {
        v4u ta[4], a[4], b[4]; unsigned rv[4];
#pragma unroll
        for (int r = 0; r < 4; ++r) { const int row = row0 + r * ngw; if (row < M) { ta[r] = *(const GAS v4u*)(WSP(unsigned, WS_TOK) + (size_t)row * 8);
                const GAS v4u* srcp = (const GAS v4u*)(XN + (size_t)row * D) + lane; a[r] = __builtin_nontemporal_load(srcp); b[r] = __builtin_nontemporal_load(srcp + 64); rv[r] = WSP(const unsigned, WS_RSS)[(size_t)4 * M + row]; } }
#pragma unroll
        for (int r = 0; r < 4; ++r) { const int row = row0 + r * ngw; if (row < M) {
                unsigned* tk = WSP(unsigned, WS_TOK) + (size_t)row * 8;
                const int e1 = (int)ta[r][0], p1 = (int)ta[r][1], e2 = (int)ta[r][2], p2 = (int)ta[r][3];
                int o1 = 0, o2 = 0;
#pragma unroll
                for (int e = 0; e < 8; ++e) { if (e == e1) o1 = off[e]; if (e == e2) o2 = off[e]; }
                const int blk = (row >> 4) % G;
                const int s1 = o1 + (int)base[blk * 8 + e1] + p1, s2 = o2 + (int)base[blk * 8 + e2] + p2;
                if (lane == 0) { tk[6] = (unsigned)s1; tk[7] = (unsigned)s2; WSP(unsigned, WS_RSTDS)[s1] = rv[r]; WSP(unsigned, WS_RSTDS)[s2] = rv[r];
                    const float g1 = __uint_as_float(tk[4]), g2 = __uint_as_float(tk[5]); WSP(float, WS_SLOTG)[s1] = g1; WSP(float, WS_SLOTG)[s2] = -g2; }
                GAS v4u* d1 = (GAS v4u*)(XNS + (size_t)s1 * D) + lane; d1[0] = a[r]; d1[64] = b[r];
                const float rs_ = rsqrtf((float)rv[r] * (1.f / (16.f * 1024.f)) + 1e-6f) * F8_SA; float fa[8], fb[8]; unpack8(a[r], fa); unpack8(b[r], fb);
                typedef unsigned v2u_ __attribute__((ext_vector_type(2)));
                int qa0 = __builtin_amdgcn_cvt_pk_fp8_f32(fa[0] * rs_, fa[1] * rs_, 0, false); qa0 = __builtin_amdgcn_cvt_pk_fp8_f32(fa[2] * rs_, fa[3] * rs_, qa0, true);
                int qa1 = __builtin_amdgcn_cvt_pk_fp8_f32(fa[4] * rs_, fa[5] * rs_, 0, false); qa1 = __builtin_amdgcn_cvt_pk_fp8_f32(fa[6] * rs_, fa[7] * rs_, qa1, true);
                int qb0 = __builtin_amdgcn_cvt_pk_fp8_f32(fb[0] * rs_, fb[1] * rs_, 0, false); qb0 = __builtin_amdgcn_cvt_pk_fp8_f32(fb[2] * rs_, fb[3] * rs_, qb0, true);
                int qb1 = __builtin_amdgcn_cvt_pk_fp8_f32(fb[4] * rs_, fb[5] * rs_, 0, false); qb1 = __builtin_amdgcn_cvt_pk_fp8_f32(fb[6] * rs_, fb[7] * rs_, qb1, true);
                const v2u_ qa = {(unsigned)qa0, (unsigned)qa1}, qb = {(unsigned)qb0, (unsigned)qb1};
                GAS v2u_* x1 = (GAS v2u_*)(XQ + (size_t)s1 * D) + lane; GAS v2u_* x2 = (GAS v2u_*)(XQ + (size_t)s2 * D) + lane;
                x1[0] = qa; x1[64] = qb; x2[0] = qa; x2[64] = qb; } }
    }
    for (int w = gw; w < 8 * 256; w += ngw) {
        const int e = w >> 8, r = w & 255; int oe = 0, oe1 = 0, ce = 0;
#pragma unroll
        for (int j = 0; j < 8; ++j) if (j == e) { oe = off[j]; oe1 = off[j + 1]; ce = (int)cnt[j]; }
        const int slot = oe + ce + r;
        if (slot < oe1) { GAS v4u* dp = (GAS v4u*)(XNS + (size_t)slot * D) + lane; const v4u z = {0u, 0u, 0u, 0u}; dp[0] = z; dp[64] = z; ((GAS v4u*)(XQ + (size_t)slot * D))[lane] = z;       if (lane == 0) { unsigned zlo = 0u; asm volatile("" : "+v"(zlo)); WSP(unsigned, WS_RSTDS)[slot] = zlo; WSP(float, WS_SLOTG)[slot] = __uint_as_float(zlo); } }
    }
}
__device__ __forceinline__ void moe_combine_final(const Ptrs& P, int gw, int ngw, int lane) {
    const bf16* Y = WSP(const bf16, R_XNS); const float* nw = P.in[I_NFIN];
    for (int row0 = gw; row0 < M; row0 += 4 * ngw) {
        int s1[4], s2[4];
#pragma unroll
        for (int r = 0; r < 4; ++r) { const int row = row0 + r * ngw; const unsigned* tk = WSP(const unsigned, WS_TOK) + (size_t)(row < M ? row : 0) * 8; s1[r] = (int)tk[6]; s2[r] = (int)tk[7]; }
        unsigned long long ya[4][4], yb[4][4];
#pragma unroll
        for (int r = 0; r < 4; ++r) { const GAS unsigned long long* y1 = (const GAS unsigned long long*)(Y + (size_t)s1[r] * D) + lane; const GAS unsigned long long* y2 = (const GAS unsigned long long*)(Y + (size_t)s2[r] * D) + lane;
#pragma unroll
            for (int j = 0; j < 4; ++j) { ya[r][j] = __builtin_nontemporal_load(y1 + 64 * j); yb[r][j] = __builtin_nontemporal_load(y2 + 64 * j); } }
#pragma unroll
        for (int r = 0; r < 4; ++r) { const int row = row0 + r * ngw; if (row < M) {
            GAS f32x4* orow = (GAS f32x4*)(P.xres + (size_t)row * D) + lane;
            f32x4 v[4]; float ssq = 0.f;
#pragma unroll
            for (int j = 0; j < 4; ++j) { const unsigned long long a = ya[r][j], b = yb[r][j];
                v[j].x = bf2f((bf16)(a & 0xffff)) + bf2f((bf16)(b & 0xffff));
                v[j].y = bf2f((bf16)((a >> 16) & 0xffff)) + bf2f((bf16)((b >> 16) & 0xffff));
                v[j].z = bf2f((bf16)((a >> 32) & 0xffff)) + bf2f((bf16)((b >> 32) & 0xffff));
                v[j].w = bf2f((bf16)((a >> 48) & 0xffff)) + bf2f((bf16)((b >> 48) & 0xffff));
                ssq += (v[j].x * v[j].x + v[j].y * v[j].y) + (v[j].z * v[j].z + v[j].w * v[j].w); }
            const float rstd = 1.f / sqrtf(wave_sum(ssq) * (1.f / D) + EPS);
#pragma unroll
            for (int j = 0; j < 4; ++j) { const f32x4 w = *((const f32x4*)nw + lane + 64 * j); __builtin_nontemporal_store(v[j] * rstd * w, orow + 64 * j); } } }
    }
}

#ifndef MK_PER_PHASE
#define MK_PER_PHASE 0
#endif
constexpr int PH_PER_LAYER = 14, N_PHASES = 1 + 2 * PH_PER_LAYER + 1;
__device__ __forceinline__ Ptrs launder(const Ptrs& a) { Ptrs p = a; asm volatile("" : "+s"(p.ws), "+s"(p.xres)); return p; }
struct Args { const float* in[N_IN]; float* xres; unsigned char* ws; int ph_lo, ph_hi; };

__global__ void __launch_bounds__(NWAVES * 64, 2) trunk_fwd(Args args) {
    extern __shared__ __attribute__((aligned(16))) unsigned char lds_raw[];
    LAS unsigned char* lds = (LAS unsigned char*)lds_raw;
    Ptrs P0; P0.in = (const float* const LAS*)(lds + PTR_OFF); P0.xres = args.xres; P0.ws = args.ws;
    const int tid = threadIdx.x, wave0 = __builtin_amdgcn_readfirstlane(tid >> 6);
    const int G0 = gridDim.x; const int bx0 = blockIdx.x; const int vcu0 = (G0 % 8 == 0) ? (bx0 % 8) * (G0 / 8) + bx0 / 8 : bx0;
    volatile LAS unsigned* MISC = (volatile LAS unsigned*)(lds + MISC_OFF);
    if (tid < 64) MISC[tid] = 0u;
    if (tid < N_IN) ((const float* LAS*)(lds + PTR_OFF))[tid] = args.in[tid];
    __syncthreads();
    unsigned* ctl = (unsigned*)(P0.ws + WS_CTL);
    XcdBarrier bar; bar.bar = ctl + CW_BAR; bar.x = 0; bar.st = nullptr;
    if (!MK_PER_PHASE) bar = xcd_barrier_post(ctl + CW_BAR, MISC + 8);
    const int lo = args.ph_lo, hi = args.ph_hi; int ph = 0;
#ifndef SITEMASK
#define SITEMASK 0xffffffffull
#endif
#define SITE(k) ((SITEMASK >> (k)) & 1ull)
#define PH_ON() (ph >= lo && ph < hi)
#define PH_IF(k) if (PH_ON() && SITE(k))
#define PH_CTX() Ptrs P = launder(P0); int tidp = threadIdx.x; asm volatile("" : "+v"(tidp)); int G = G0, bx = bx0, vcu = vcu0, wave = wave0; asm volatile("" : "+s"(G), "+s"(bx), "+s"(vcu), "+s"(wave)); const int gw = vcu * NWAVES + wave, ngw = G * NWAVES; const long gn = (long)G * (NWAVES * 64); const int lane = tidp & 63; const long gtid = (long)bx * (NWAVES * 64) + tidp; (void)lane; (void)gw; (void)gtid; (void)ngw; (void)gn
#define PH_END() do { if (PH_ON() && ph + 1 < hi) { if (!MK_PER_PHASE) { XcdBarrier b2_ = bar; asm volatile("" : "+s"(b2_.bar), "+s"(b2_.x)); xcd_barrier(b2_); } } ++ph; } while (0)

    PH_IF(0) { PH_CTX();
        LAS WJob* jobs = (LAS WJob*)(lds + JOB_OFF);
        if (tid == 0) {
            int nj = 0, item = 0;
#define ADDJOB(W0_, W1_, rs_, dst_, K_, Nsrc_, Ndst_, kind_, cs_) do { LAS WJob* j_ = jobs + nj; j_->W0 = (W0_); j_->W1 = (W1_); j_->rs = (rs_); j_->WT = WSP(bf16, (dst_)); j_->K = (K_); j_->Nsrc = (Nsrc_); \
                j_->nblk = (Ndst_) / 32; j_->pad0 = 0; j_->kind = (kind_); j_->cs = (cs_); j_->item0 = item; item += ((K_) / 64) * ((Ndst_) / 32); ++nj; } while (0)
            for (int l = 0; l < 2; ++l) {
                const size_t wl = R_WL + (size_t)l * WL_SIZE;
                ADDJOB(P.in[I_WIN] + (size_t)l * D * INW, nullptr, P.in[I_NMIX] + l * D, wl + WL_IN, D, INW, NZ, 1, 1.f);
                ADDJOB(P.in[I_WOUT] + (size_t)l * D * D, nullptr, nullptr, wl + WL_OUT, D, D, D, 0, 1.f);
                ADDJOB(P.in[I_WQ] + (size_t)l * D * 512, nullptr, P.in[I_NXA] + l * D, wl + WL_Q, D, 512, 512, 0, XAT_QS);
                ADDJOB(P.in[I_WKV] + (size_t)l * D * 1024, nullptr, P.in[I_NMEM] + l * D, wl + WL_KV, D, 1024, 1024, 0, 1.f);
                ADDJOB(P.in[I_WO] + (size_t)l * 512 * D, nullptr, nullptr, wl + WL_O, 512, D, D, 0, 1.f);
            }
            ADDJOB(P.in[I_FG], P.in[I_FU], P.in[I_NFFN], R_WGU, D, DFF, 2 * DFF, 2, 1.f);
            ADDJOB(P.in[I_FD], nullptr, nullptr, R_WDN, DFF, D, D, 0, 1.f);
            for (int e = 0; e < NE; ++e) {
                ADDJOB(P.in[I_MG] + (size_t)e * D * DFF, P.in[I_MU] + (size_t)e * D * DFF, P.in[I_NFFN] + D, WS_WMGU + (size_t)e * 2 * DFF * D, D, DFF, 2 * DFF, 2, 1.f); jobs[nj - 1].pad0 = (int)F8_SWGU;
                ADDJOB(P.in[I_MD] + (size_t)e * DFF * D, nullptr, nullptr, WS_WMD + (size_t)e * D * DFF, DFF, D, D, 0, 1.f); jobs[nj - 1].pad0 = (int)F8_SWDN;
            }
#undef ADDJOB
            MISC[16] = (unsigned)nj; MISC[17] = (unsigned)item;
        }
        __syncthreads();
        const int nj = (int)MISC[16], nitems = (int)MISC[17];
        LAS float* scr = (LAS float*)(lds + wave * 16384);
        for (int it = gw; it < nitems; it += ngw) {
            int j = 0;
            for (int q = 1; q < nj; ++q) if (jobs[q].item0 <= it) j = q;
            p0_transpose_item(jobs + j, scr, it - jobs[j].item0, lane);
        }
        norm_rows<0>(P, 0, P.in[I_MEM], WSP(bf16, WS_MEMN), BATCH * NMEM, gw, ngw, lane);
        build_gw(P, gtid, gn);
    }
    PH_END();

    for (int l = 0; l < 2; ++l) {
        const size_t wl = R_WL + (size_t)l * WL_SIZE;
        PH_IF(1) { PH_CTX(); if (l == 0) norm16<1, false>(P, l, P.in[I_X], WSP(bf16, R_XN), nullptr, vcu, G, wave, lane, (LAS float*)lds);
            else norm16<1, true>(P, l, nullptr, WSP(bf16, R_XN), WSP(const unsigned, WS_RSS) + (size_t)2 * M, vcu, G, wave, lane, (LAS float*)lds); }
        PH_END();
        PH_IF(2) { PH_CTX();
            for (int task = bx; task < 24; task += G) gate_scan_task(P, task, (LAS float*)lds, tidp);
            { pg8::Gemm g{WSP(const bf16, R_XN), WSP(const bf16, wl + WL_IN), M, NZ, D}; pg8::StaticOrder S; S.init(M, NZ, G, bx);
              pg8::EpiBf16 E{WSP(bf16, R_T0), 512, 512, (size_t)M * 512, (l == 0) ? WSP(const unsigned, WS_RSTD) : WSP(const unsigned, WS_RSS) + (size_t)2 * M};
              pg8::gemm_phase<pg8::EpiBf16, pg8::StaticOrder, true, true>(lds, g, S, E); }
        }
        PH_END();
        PH_IF(3) { PH_CTX(); mconv_glu_vec(P, l, gtid, gn); fox_keynorms(P, gw, ngw, lane); }
        PH_END();
        PH_IF(4) { PH_CTX(); for (int u = wave * G + vcu; u < 8 * NCH; u += ngw) mls::u_unit(P, u, lds + wave * 16384, lane);
            for (int u = (7 - wave) * G + vcu; u < BATCH * FH * fox::NQB; u += ngw) { const int qb = fox::NQB - 1 - u / (BATCH * FH), bh = u % (BATCH * FH);
                const int j0 = fox::unit_j0_wave(bh, qb, (const fox::bf16h*)WSP(bf16, R_T0 + 3 * SZ_T), WSP(const float, WS_KN2), WSP(const float, WS_CF) + (size_t)bh * SEQ, lane); if (lane == 0) WSP(int, WS_J0)[u] = j0; }
            cconv_ln_rows(P, l, gw, ngw, lane); }
        PH_END();
        PH_IF(5) { PH_CTX(); mls::state_scan(P, gtid, gn); }
        PH_END();
        PH_IF(7) { PH_CTX();
            { pg8::Gemm g{WSP(const bf16, WS_MEMN), WSP(const bf16, wl + WL_KV), BATCH * NMEM, 512, D}; pg8::StaticOrder S; S.init(BATCH * NMEM, 512, G, bx);
              pg8::EpiBf16 E{WSP(bf16, WS_KVX) + (size_t)l * 512 * 1024, 512, 0, 0, nullptr};
              pg8::gemm_phase<pg8::EpiBf16, pg8::StaticOrder, true, true>(lds, g, S, E); }
            { pg8::Gemm g{WSP(const bf16, wl + WL_KV) + (size_t)512 * 1024, WSP(const bf16, WS_MEMN), 512, BATCH * NMEM, D}; pg8::StaticOrder S; S.init(512, BATCH * NMEM, G, (bx + G - 4) % G);
              pg8::EpiBf16 E{WSP(bf16, WS_KVX) + (size_t)l * 512 * 1024 + 512 * 512, 512, 0, 0, nullptr};
              pg8::gemm_phase<pg8::EpiBf16, pg8::StaticOrder, true, true>(lds, g, S, E); }
            { static_assert(fox::LDS_BYTES <= RING_BYTES, "fox LDS");
              const fox::bf16h* Q = (const fox::bf16h*)WSP(bf16, R_T0 + 3 * SZ_T); const fox::bf16h* Kp = (const fox::bf16h*)WSP(bf16, R_T0 + 4 * SZ_T); const fox::bf16h* Vp = (const fox::bf16h*)WSP(bf16, R_T0 + 5 * SZ_T);
              fox::bf16h* O = (fox::bf16h*)(WSP(bf16, R_CAT) + 512); const float* CF = WSP(const float, WS_CF);
              for (int it = vcu; it < 8 * NCH / 8; it += G) mls::out_unit(P, l, it * 8 + wave, lds + wave * 16384, lane);
              __syncthreads();
              const int nitems = BATCH * FH * fox::NQB; unsigned* qhead = ctl + CW_FOXQ + 64 * l;
              for (;;) {
                  if (tidp == 0) MISC[24] = __hip_atomic_fetch_add(qhead, 1u, RLX_AGENT);
                  __syncthreads();
                  const int u = (int)MISC[24];
                  __syncthreads();
                  if (u >= nitems) break;
                  const int qb = fox::NQB - 1 - u / (BATCH * FH), bh = u % (BATCH * FH);
                  const int j0 = WSP(const int, WS_J0)[u];
                  fox::attn_unit<8>(bh / FH, bh % FH, qb, j0, Q, Kp, Vp, O, CF + (size_t)bh * SEQ, (char*)lds_raw); } }

 }
        PH_END();
        PH_IF(8) { PH_CTX(); pg8::Gemm g{WSP(const bf16, R_CAT), WSP(const bf16, wl + WL_OUT), M, D, D}; pg8::StaticOrder S; S.init(M, D, G, bx);
            pg8::EpiRes E{WSP(bf16, R_XN), D, WSP(unsigned, WS_RSS) + (size_t)(l ? 3 : 0) * M};
            pg8::gemm_phase<pg8::EpiRes, pg8::StaticOrder, true, true>(lds, g, S, E); }
        PH_END();
        PH_IF(10) { PH_CTX(); pg8::Gemm g{WSP(const bf16, R_XN), WSP(const bf16, wl + WL_Q), M, 512, D}; pg8::StaticOrder S; S.init(M, 512, G, bx);
            pg8::EpiBf16 E{WSP(bf16, R_QX), 512, 0, 0, WSP(const unsigned, WS_RSS) + (size_t)(l ? 3 : 0) * M};
            pg8::gemm_phase<pg8::EpiBf16, pg8::StaticOrder, true, true>(lds, g, S, E); }
        PH_END();
        PH_IF(11) { PH_CTX(); static_assert(xat::LDS_BYTES <= RING_BYTES, "xat LDS");
            const bf16* KXp = WSP(const bf16, WS_KVX) + (size_t)l * 512 * 1024;
            for (int L = vcu; L < BATCH * XH * (SEQ / 256); L += G) { const int qb = L % (SEQ / 256), bhd = L / (SEQ / 256);
                xat::unit(bhd / XH, bhd % XH, qb, WSP(const bf16, R_QX), KXp, KXp + 512 * 512, WSP(bf16, R_OX), lds); } }
        PH_END();
        PH_IF(12) { PH_CTX(); pg8::Gemm g{WSP(const bf16, R_OX), WSP(const bf16, wl + WL_O), M, D, 512}; pg8::StaticOrder S; S.init(M, D, G, bx);
            pg8::EpiRes E{WSP(bf16, R_XN), D, WSP(unsigned, WS_RSS) + (size_t)(l ? 4 : 1) * M};
            pg8::gemm_phase<pg8::EpiRes, pg8::StaticOrder, true, true>(lds, g, S, E); }
        PH_END();
        if (l == 0) {
            PH_IF(14) { PH_CTX(); pg8::Gemm g{WSP(const bf16, R_XN), WSP(const bf16, R_WGU), M, 2 * DFF, D}; pg8::StaticOrder S; S.init(M, 2 * DFF, G, bx);
                pg8::EpiSwiGLU E{WSP(bf16, R_HD), DFF, WSP(const unsigned, WS_RSS) + (size_t)1 * M};
                pg8::gemm_phase<pg8::EpiSwiGLU, pg8::StaticOrder, true, true>(lds, g, S, E); }
            PH_END();
            PH_IF(15) { PH_CTX(); pg8::Gemm g{WSP(const bf16, R_HD), WSP(const bf16, R_WDN), M, D, DFF}; pg8::StaticOrder S; S.init(M, D, G, bx);
                pg8::EpiRes E{WSP(bf16, R_XN), D, WSP(unsigned, WS_RSS) + (size_t)2 * M};
                pg8::gemm_phase<pg8::EpiRes, pg8::StaticOrder, true, true>(lds, g, S, E); }
            PH_END();
            ph += 2;
        } else {
            PH_IF(16) { PH_CTX(); norm16<2, true>(P, l, nullptr, WSP(bf16, R_XN), WSP(const unsigned, WS_RSS) + (size_t)4 * M, vcu, G, wave, lane, (LAS float*)lds); }
            PH_END();
            PH_IF(17) { PH_CTX(); moe_gather(P, gw, ngw, lane, wave, vcu, G, lds); }
            PH_END();
            PH_IF(18) { PH_CTX(); pg8::Gemm g{WSP(const bf16, WS_XQ), WSP(const bf16, WS_WMGU), 0, 2 * DFF, D / 2}; pg8::GroupedOrder S; S.init(2 * DFF, G, bx, ctl + CW_CNT, (size_t)2 * DFF * D);
                pg8::EpiSwiGLU8 E{WSP(unsigned char, R_HM), DFF, 1.f / (F8_SA * F8_SWGU)};
                pg8::gemm_phase<pg8::EpiSwiGLU8, pg8::GroupedOrder, true, true, true>(lds, g, S, E); }
            PH_END();
            PH_IF(19) { PH_CTX(); pg8::Gemm g{WSP(const bf16, R_HM), WSP(const bf16, WS_WMD), 0, D, DFF / 2}; pg8::GroupedTailOrder S; S.init(D, G, bx, ctl + CW_CNT, (size_t)D * DFF, DFF / (2 * pg8::BK));
                pg8::EpiMoeOutT E{WSP(bf16, R_XNS), D, WSP(const float, WS_SLOTG), WSP(float, WS_WMGU)  , ctl + CW_TAIL, 1.f / (F8_SH * F8_SWDN)};
                pg8::gemm_phase<pg8::EpiMoeOutT, pg8::GroupedTailOrder, true, true, true>(lds, g, S, E); }
            PH_END();
        }
    }
    PH_IF(20) { PH_CTX(); moe_combine_final(P, gw, ngw, lane); }
#undef PH_ON
#undef PH_END
}

extern "C" void kernel_launch(void* const* d_in, const int* in_sizes, int n_in, void* d_out, int out_size, void* d_ws, size_t ws_size, hipStream_t stream) {
    static int grid = 0;
    if (grid == 0) {
        if (n_in != N_IN || out_size != M * D || ws_size < WS_END) { fprintf(stderr, "kernel_launch: unexpected shapes (n_in %d, out %d, ws %zu < %zu); nothing launched\n", n_in, out_size, ws_size, (size_t)WS_END); grid = -1; return; }
        int dev = 0, cus = 0, per_cu = 0;
        if (hipGetDevice(&dev) != hipSuccess || hipDeviceGetAttribute(&cus, hipDeviceAttributeMultiprocessorCount, dev) != hipSuccess) { grid = -1; return; }
        if (hipFuncSetAttribute((const void*)trunk_fwd, hipFuncAttributeMaxDynamicSharedMemorySize, LDS_BYTES) != hipSuccess) { fprintf(stderr, "kernel_launch: hipFuncSetAttribute failed\n"); grid = -1; return; }
        if (hipOccupancyMaxActiveBlocksPerMultiprocessor(&per_cu, (const void*)trunk_fwd, NWAVES * 64, LDS_BYTES) != hipSuccess || per_cu < 1) { fprintf(stderr, "kernel_launch: occupancy query says %d\n", per_cu); (void)hipGetLastError(); grid = -1; return; }
        grid = cus;
    }
    if (grid < 0) return;
    (void)in_sizes;
    if (hipMemsetAsync((char*)d_ws + WS_CTL, 0, CTL_ZERO_BYTES, stream) != hipSuccess) return;
    Args a; memset(&a, 0, sizeof(a));
    for (int i = 0; i < N_IN; ++i) a.in[i] = (const float*)d_in[i];
    a.xres = (float*)d_out; a.ws = (unsigned char*)d_ws;
#if MK_PER_PHASE
    for (int p = 0; p < N_PHASES; ++p) { a.ph_lo = p; a.ph_hi = p + 1; hipLaunchKernelGGL(trunk_fwd, dim3(grid), dim3(NWAVES * 64), LDS_BYTES, stream, a); }
#else
    a.ph_lo = 0; a.ph_hi = N_PHASES;
    hipLaunchKernelGGL(trunk_fwd, dim3(grid), dim3(NWAVES * 64), LDS_BYTES, stream, a);
#endif
}
#endif
```

```cpp
#if defined(HOST_EMU)
#include <cmath>
#include <cstring>
#include <cstdint>
#include <cstddef>
#define DEVFN static inline
#define PHFN static inline
#else
#include <hip/hip_runtime.h>
#include <cstdio>
#include <cstdint>
#include <cstring>
#define DEVFN __device__ __forceinline__
#define PHFN __device__ __forceinline__
#endif

#ifndef CFG_SEQ
#define CFG_SEQ 8192
#endif
constexpr int BATCH = 2, SEQ = CFG_SEQ, D = 1024, M = BATCH * SEQ;
constexpr int MH = 4, MCH = 64, NCH = SEQ / MCH;
constexpr int CK = 31;
constexpr int FH = 8;
constexpr int XH = 4, XD = 128, NMEM = 256;
constexpr int DFF = 2816, NE = 8, INW = 3088;
constexpr int NZ = 3072;
constexpr int SLOTS_MAX = 2 * M + NE * 256;
constexpr float EPS = 1e-6f;
constexpr float LOG2E = 1.4426950408889634f;
constexpr float FOX_QS = 0.125f * LOG2E;
constexpr float XAT_QS = 0.08838834764831845f * LOG2E;

enum { I_X = 0, I_MEM, I_NMIX, I_WIN, I_MCW, I_MCB, I_MBI, I_MBF, I_MNW, I_CCW, I_CCB, I_CLW, I_CLB, I_FBF, I_WOUT, I_NXA, I_NMEM, I_WQ, I_WKV, I_WO, I_NFFN,
       I_FG, I_FU, I_FD, I_RW, I_MG, I_MU, I_MD, I_NFIN, N_IN };

typedef unsigned short bf16;
constexpr size_t al4k(size_t x) { return (x + 4095) & ~(size_t)4095; }
constexpr size_t MiB = (size_t)1 << 20;
constexpr size_t WS_CTL = 0, CTL_ZERO_BYTES = 1 * MiB;
constexpr size_t WS_GATE = 1 * MiB;
constexpr size_t WS_CF = WS_GATE + al4k((size_t)M * 16 * 4);
constexpr size_t WS_BL = WS_CF + al4k((size_t)16 * SEQ * 4);
constexpr size_t WS_BT = WS_BL + al4k((size_t)8 * SEQ * 4);
constexpr size_t WS_AK = WS_BT + al4k((size_t)8 * NCH * 4);
constexpr size_t WS_MS = WS_AK + al4k((size_t)8 * NCH * 4);
constexpr size_t WS_DEC = WS_MS + al4k((size_t)8 * (NCH + 1) * 4);
constexpr size_t WS_KN2 = WS_DEC + al4k((size_t)8 * NCH * 4);
constexpr size_t WS_J0 = WS_KN2 + al4k((size_t)16 * (SEQ / 64) * 4);
constexpr size_t WS_BH = WS_J0 + al4k((size_t)16 * (SEQ / 256) * 4);
constexpr size_t WS_NST = WS_BH + al4k((size_t)1024 * 8 * 4);
constexpr size_t WS_TOK = WS_NST + al4k((size_t)8 * NCH * 64 * 4);
constexpr size_t WS_RSTD = WS_TOK + al4k((size_t)M * 32);
constexpr size_t WS_RSTDS = WS_RSTD + al4k((size_t)M * 8);
constexpr size_t WS_SLOTG = WS_RSTDS + al4k((size_t)SLOTS_MAX * 8);
constexpr size_t WS_GW = WS_SLOTG + al4k((size_t)SLOTS_MAX * 4);
constexpr size_t WS_MEMN = WS_GW + 3 * 65536;
constexpr size_t WS_KVX = WS_MEMN + al4k((size_t)512 * 1024 * 2);
constexpr size_t WS_WMGU = WS_KVX + al4k((size_t)2 * 512 * 1024 * 2);
constexpr size_t WS_WMD = WS_WMGU + (size_t)NE * 5632 * 1024 * 2;
constexpr size_t WS_R = al4k(WS_WMD + (size_t)NE * 1024 * 2816 * 2);
constexpr size_t WL_IN = 0, WL_OUT = WL_IN + (size_t)NZ * 1024 * 2, WL_Q = WL_OUT + (size_t)1024 * 1024 * 2, WL_KV = WL_Q + (size_t)512 * 1024 * 2,
                 WL_O = WL_KV + (size_t)1024 * 1024 * 2, WL_SIZE = WL_O + (size_t)1024 * 512 * 2;
constexpr size_t R_WL = WS_R;
constexpr size_t R_WGU = R_WL + 2 * WL_SIZE;
constexpr size_t R_WDN = R_WGU + (size_t)5632 * 1024 * 2;
constexpr size_t R_XN = al4k(R_WDN + (size_t)1024 * 2816 * 2);
constexpr size_t SZ_T = (size_t)M * 512 * 2;
constexpr size_t R_T0 = R_XN + 2 * SZ_T;
constexpr size_t R_MQK = R_T0 + 6 * SZ_T;
constexpr size_t R_CAT = R_MQK + SZ_T;
constexpr size_t R_CST = R_CAT + 2 * SZ_T;
constexpr size_t R_GL = R_CST + (size_t)8 * NCH * 4096 * 4;
constexpr size_t R_HC = R_GL + (size_t)M * 256 * 2;
constexpr size_t R_END1 = R_HC + (size_t)M * 256 * 4;
constexpr size_t R_QX = R_T0, R_OX = R_T0 + SZ_T;
constexpr size_t R_HD = R_T0;
constexpr size_t R_HM = WS_R;
constexpr size_t R_XNS = R_HM + (size_t)SLOTS_MAX * 2816 * 2;
constexpr size_t R_END2 = R_XNS + (size_t)SLOTS_MAX * 1024 * 2;
constexpr size_t WS_END = R_END1 > R_END2 ? R_END1 : R_END2;
static_assert((size_t)M * 2816 * 2 <= 6 * SZ_T, "dense hidden fits T0..T5");
static_assert(R_XN + 2 * SZ_T <= R_XNS, "XN must not overlap the gathered rows");
constexpr float F8_SA = 8.f, F8_SWGU = 256.f, F8_SH = 16.f, F8_SWDN = 512.f;
constexpr size_t WS_XQ = WS_WMGU + (size_t)NE * 5632 * 1024;
constexpr int CW_TMO = 0, CW_CNT = 64  , CW_TAIL = 512  , CW_FOXQ = 128  , CW_BAR = 4096;
constexpr size_t WS_RSS = 65536;
static_assert(WS_RSS + (size_t)5 * M * 4 <= CTL_ZERO_BYTES, "RSS arrays inside the zeroed region");

#if defined(HOST_EMU)
struct Ptrs { const float* in[N_IN]; float* xres; unsigned char* ws; };
#else
struct Ptrs { const float* const __attribute__((address_space(3)))* in; float* xres; unsigned char* ws; };
#endif
#define WSP(type, off) ((type*)(P.ws + (off)))

DEVFN float bf2f(bf16 v) { unsigned u = (unsigned)v << 16; float f; memcpy(&f, &u, 4); return f; }
DEVFN bf16 f2bf(float f) { unsigned u; memcpy(&u, &f, 4); return (bf16)((u + 0x7fffu + ((u >> 16) & 1u)) >> 16); }
DEVFN float sigmoidf_(float x) { return 1.f / (1.f + expf(-x)); }
#if defined(HOST_EMU)
DEVFN float logsigmoidf_(float x) { return fminf(x, 0.f) - log1pf(expf(-fabsf(x))); }
#else
DEVFN float logsigmoidf_(float x) { return fminf(x, 0.f) - __logf(1.f + __expf(-fabsf(x))); }
#endif

DEVFN void wmap(int kind, int nb, int& which, int& col0, float& cs) {
    which = 0; cs = 1.f; const int n0 = nb * 32;
    if (kind == 0) { col0 = n0; }
    else if (kind == 1) { col0 = n0 < 1024 ? n0 : n0 + 8; if (n0 >= 1536 && n0 < 2048) cs = FOX_QS; }
    else { const int tile = nb >> 3, w = nb & 7; which = w >> 2; col0 = tile * 128 + (w & 3) * 32; }
}

#if !defined(HOST_EMU)
namespace pg8 {
#define PG8_LAS __attribute__((address_space(3)))
typedef unsigned short bf16_t;
typedef short bf16x8 __attribute__((ext_vector_type(8)));
typedef float f32x4 __attribute__((ext_vector_type(4)));
typedef unsigned u32x4 __attribute__((ext_vector_type(4)));
constexpr int BM = 256, BK = 64, HALF = 128, HTB = HALF * BK * 2, STAGE_BYTES = 8 * HTB, NXCD = 8, WGM = 4;
__host__ __device__ __forceinline__ int lds_byte(int r, int c) { const int st = (r >> 4) * 2 + (c >> 5), rr = r & 15, cc = c & 31, ob = rr * 64 + cc * 2; return st * 1024 + (ob ^ (((ob >> 9) & 1) << 5)); }
__host__ __device__ __forceinline__ void stage_rc(int b, int& R, int& C) { const int st = b / 1024, sb = b % 1024, swz = sb ^ (((sb >> 9) & 1) << 5); R = (st >> 1) * 16 + swz / 64; C = (st & 1) * 32 + (swz % 64) / 2; }
__host__ __device__ __forceinline__ int perm32(int rho) { const int n = rho >> 4, i = rho & 15; return 8 * (i >> 2) + 4 * n + (i & 3); }

struct Unit { int pm, pn; size_t bofs; int nt, ks, ti, s; size_t aofs; };
struct Gemm { const bf16_t* A; const bf16_t* Bt; int M, N, K; };

struct StaticOrder {
    static constexpr bool VAR_K = false;
    int nM, nN, nwg, G, c;
    __device__ void init(int M_, int N_, int G_, int c_) { nM = M_ / BM; nN = N_ / BM; nwg = nM * nN; G = G_; c = c_; }
    __device__ bool next(int i, Unit& u) const {
        const long L = (long)i * G + c; if (L >= nwg) return false;
        int wgid = (int)L; { const int q = nwg / NXCD, r = nwg % NXCD, xcd = wgid % NXCD, off = wgid / NXCD; wgid = (xcd < r ? xcd * (q + 1) : r * (q + 1) + (xcd - r) * q) + off; }
        const int nig = WGM * nN, gid = wgid / nig, fm = gid * WGM, gsz = (nM - fm) < WGM ? (nM - fm) : WGM;
        u.pm = fm + ((wgid % nig) % gsz); u.pn = (wgid % nig) / gsz; u.bofs = 0; return true;
    }
    __device__ __forceinline__ void a_ready(const Unit&) const {}
    __device__ __forceinline__ void done(const Unit&) const {}
};
struct GroupedOrder {
    static constexpr bool VAR_K = false;
    int nM, nN, nwg, G, c; int off[9]; size_t estride;
    __device__ void init(int N_, int G_, int c_, const unsigned* cnt, size_t estride_) {
        int o = 0;
#pragma unroll
        for (int e = 0; e < 8; ++e) { off[e] = o; o += ((int)cnt[e] + 255) & ~255; }
        off[8] = o; nM = o / BM; nN = N_ / BM; nwg = nM * nN; G = G_; c = c_; estride = estride_;
    }
    __device__ bool next(int i, Unit& u) const {
        const long L = (long)i * G + c; if (L >= nwg) return false;
        int wgid = (int)L; { const int q = nwg / NXCD, r = nwg % NXCD, xcd = wgid % NXCD, o2 = wgid / NXCD; wgid = (xcd < r ? xcd * (q + 1) : r * (q + 1) + (xcd - r) * q) + o2; }
        const int nig = WGM * nN, gid = wgid / nig, fm = gid * WGM, gsz = (nM - fm) < WGM ? (nM - fm) : WGM;
        u.pm = fm + ((wgid % nig) % gsz); u.pn = (wgid % nig) / gsz;
        int e = 0;
#pragma unroll
        for (int j = 1; j < 8; ++j) e += (off[j] <= u.pm * BM) ? 1 : 0;
        u.bofs = (size_t)e * estride; return true;
    }
    __device__ __forceinline__ void a_ready(const Unit&) const {}
    __device__ __forceinline__ void done(const Unit&) const {}
};

struct GroupedTailOrder {
    static constexpr bool VAR_K = true;
    int nM, nN, nwg, G, c, nfull, T, s, sh, ntot, NT; int off[9]; size_t estride;
    __device__ __forceinline__ void init(int N_, int G_, int c_, const unsigned* cnt, size_t estride_, int NT_) {
        int o = 0;
#pragma unroll
        for (int e = 0; e < 8; ++e) { off[e] = o; o += ((int)cnt[e] + 255) & ~255; }
        off[8] = o; nM = o / BM; nN = N_ / BM; nwg = nM * nN; G = G_; c = c_; estride = estride_; NT = NT_;
        const int rounds = nwg / G; T = nwg - rounds * G;
        s = (T == 0) ? 1 : (T * 8 <= G ? 8 : (T * 4 <= G ? 4 : (T * 2 <= G ? 2 : 1))); sh = (s == 8) ? 3 : (s >> 1);
        if (s == 1) { nfull = nwg; T = 0; } else nfull = rounds * G;
        ntot = nfull + T * s;
    }
    __device__ __forceinline__ bool next(int i, Unit& u) const {
        const long L = (long)i * G + c; if (L >= ntot) return false;
        int wgid = (int)L, ks = 0, ti = -1;
        if (wgid >= nfull) { const int mu = wgid - nfull; ti = mu >> sh; ks = mu - (ti << sh); wgid = nfull + ti; }
        { const int q = nwg / NXCD, r = nwg % NXCD, xcd = wgid % NXCD, o2 = wgid / NXCD; wgid = (xcd < r ? xcd * (q + 1) : r * (q + 1) + (xcd - r) * q) + o2; }
        const int nig = WGM * nN, gid = wgid / nig, fm = gid * WGM, gsz = (nM - fm) < WGM ? (nM - fm) : WGM;
        u.pm = fm + ((wgid % nig) % gsz); u.pn = (wgid % nig) / gsz;
        int e = 0;
#pragma unroll
        for (int j = 1; j < 8; ++j) e += (off[j] <= u.pm * BM) ? 1 : 0;
        int kt0 = 0, ntu = NT;
        if (ti >= 0) { const int base = (NT >> sh) & ~1, ex = (NT - (base << sh)) >> 1;
            ntu = base + (ks < ex ? 2 : 0); kt0 = ks * base + 2 * (ks < ex ? ks : ex); }
        u.aofs = (size_t)kt0 * BK * 2; u.bofs = (size_t)e * estride + u.aofs; u.nt = ntu; u.ks = ks; u.ti = ti; u.s = s; return true;
    }
    __device__ __forceinline__ void a_ready(const Unit&) const {}
    __device__ __forceinline__ void done(const Unit&) const {}
};

__device__ __forceinline__ unsigned cvt_pk_bf16(float lo, float hi) { unsigned r; asm volatile("v_cvt_pk_bf16_f32 %0, %1, %2" : "=v"(r) : "v"(lo), "v"(hi)); return r; }

struct EpiBf16 {
    static constexpr bool PERM = true, AFTER_DRAIN = false, HAS_PRE = true;
    __device__ __forceinline__ void preload(unsigned (&q)[8], const Unit& u, int wr, int fr) const {
        if (rs) { const __attribute__((address_space(1))) unsigned* rp = (const __attribute__((address_space(1))) unsigned*)rs + u.pm * BM + wr * 64 + fr;
#pragma unroll
            for (int i = 0; i < 8; ++i) q[i] = rp[(i >> 2) * HALF + (i & 3) * 16]; } }
    bf16_t* O; int ldc; int split_cols; size_t split_stride; const unsigned* rs;
    __device__ __forceinline__ void operator()(const f32x4 (&acc)[2][2][4][2], const Unit& u, int wr, int wc, int fr, int fq, const unsigned (&q)[8]) const {
        const int row0 = u.pm * BM + wr * 64 + fr; int colt = u.pn * BM; bf16_t* base = O;
        if (split_cols) { const int t = colt / split_cols; base += (size_t)t * split_stride; colt -= t * split_cols; }
        const int col0 = colt + wc * 32 + 8 * fq;
        float sc[2][4];
#pragma unroll
        for (int ai = 0; ai < 2; ++ai)
#pragma unroll
            for (int m = 0; m < 4; ++m) sc[ai][m] = rs ? rsqrtf((float)q[ai * 4 + m] * (1.f / (16.f * 1024.f)) + 1e-6f) : 1.f;
#pragma unroll
        for (int ai = 0; ai < 2; ++ai)
#pragma unroll
            for (int m = 0; m < 4; ++m) { bf16_t* rowp = base + (size_t)(row0 + ai * HALF + m * 16) * ldc + col0;
#pragma unroll
                for (int bj = 0; bj < 2; ++bj) { const f32x4 v0 = acc[ai][bj][m][0] * sc[ai][m], v1 = acc[ai][bj][m][1] * sc[ai][m];
                    u32x4 w; w.x = cvt_pk_bf16(v0[0], v0[1]); w.y = cvt_pk_bf16(v0[2], v0[3]); w.z = cvt_pk_bf16(v1[0], v1[1]); w.w = cvt_pk_bf16(v1[2], v1[3]);
                    *(u32x4*)(rowp + bj * HALF) = w; } }
    }
};
struct EpiRes {
    static constexpr bool PERM = true, AFTER_DRAIN = false, HAS_PRE = false;
    bf16_t* X; int ldc; unsigned* rss;
    __device__ __forceinline__ void operator()(const f32x4 (&acc)[2][2][4][2], const Unit& u, int wr, int wc, int fr, int fq) const {
        const int row0 = u.pm * BM + wr * 64 + fr, col0 = u.pn * BM + wc * 32 + 8 * fq;
        typedef __attribute__((address_space(1))) u32x4 gu32x4;
        u32x4 b[2][4][2];
#pragma unroll
        for (int ai = 0; ai < 2; ++ai)
#pragma unroll
            for (int m = 0; m < 4; ++m)
#pragma unroll
                for (int bj = 0; bj < 2; ++bj) b[ai][m][bj] = *(const gu32x4*)(X + (size_t)(row0 + ai * HALF + m * 16) * ldc + col0 + bj * HALF);
#pragma unroll
        for (int ai = 0; ai < 2; ++ai)
#pragma unroll
            for (int m = 0; m < 4; ++m) { bf16_t* rowp = X + (size_t)(row0 + ai * HALF + m * 16) * ldc + col0; float ss = 0.f;
#pragma unroll
                for (int bj = 0; bj < 2; ++bj) { float v[8];
#pragma unroll
                    for (int i = 0; i < 4; ++i) { v[2 * i] = __uint_as_float(b[ai][m][bj][i] << 16) + acc[ai][bj][m][i >> 1][(2 * i) & 3]; v[2 * i + 1] = __uint_as_float(b[ai][m][bj][i] & 0xffff0000u) + acc[ai][bj][m][i >> 1][(2 * i + 1) & 3]; }
                    u32x4 w; w.x = cvt_pk_bf16(v[0], v[1]); w.y = cvt_pk_bf16(v[2], v[3]); w.z = cvt_pk_bf16(v[4], v[5]); w.w = cvt_pk_bf16(v[6], v[7]);
                    *(gu32x4*)(rowp + bj * HALF) = w;
#pragma unroll
                    for (int i = 0; i < 8; ++i) ss += v[i] * v[i]; }
                ss += __shfl_xor(ss, 16); ss += __shfl_xor(ss, 32);
                if (fq == 0) __hip_atomic_fetch_add(rss + row0 + ai * HALF + m * 16, (unsigned)(ss * 16.f + 0.5f), __ATOMIC_RELAXED, __HIP_MEMORY_SCOPE_AGENT); }
    }
};
struct EpiMoeOut {
    static constexpr bool PERM = true, AFTER_DRAIN = false, HAS_PRE = false;
    bf16_t* Y; int ldc; const float* sg;
    __device__ __forceinline__ void operator()(const f32x4 (&acc)[2][2][4][2], const Unit& u, int wr, int wc, int fr, int fq) const {
        const int row0 = u.pm * BM + wr * 64 + fr, col0 = u.pn * BM + wc * 32 + 8 * fq;
        typedef __attribute__((address_space(1))) u32x4 gu32x4;
        float g[2][4];
        { const __attribute__((address_space(1))) float* gp = (const __attribute__((address_space(1))) float*)sg + row0;
#pragma unroll
          for (int ai = 0; ai < 2; ++ai)
#pragma unroll
              for (int m = 0; m < 4; ++m) g[ai][m] = gp[ai * HALF + m * 16]; }
        u32x4 b[2][4][2];
#pragma unroll
        for (int ai = 0; ai < 2; ++ai)
#pragma unroll
            for (int m = 0; m < 4; ++m)
#pragma unroll
                for (int bj = 0; bj < 2; ++bj) { b[ai][m][bj] = (u32x4){0u, 0u, 0u, 0u}; if (g[ai][m] > 0.f) b[ai][m][bj] = *(const gu32x4*)(Y + (size_t)(row0 + ai * HALF + m * 16) * ldc + col0 + bj * HALF); }
#pragma unroll
        for (int ai = 0; ai < 2; ++ai)
#pragma unroll
            for (int m = 0; m < 4; ++m) { bf16_t* rowp = Y + (size_t)(row0 + ai * HALF + m * 16) * ldc + col0; const float ga = fabsf(g[ai][m]);
#pragma unroll
                for (int bj = 0; bj < 2; ++bj) { float v[8];
#pragma unroll
                    for (int i = 0; i < 4; ++i) { v[2 * i] = __uint_as_float(b[ai][m][bj][i] << 16) + ga * acc[ai][bj][m][i >> 1][(2 * i) & 3]; v[2 * i + 1] = __uint_as_float(b[ai][m][bj][i] & 0xffff0000u) + ga * acc[ai][bj][m][i >> 1][(2 * i + 1) & 3]; }
                    u32x4 w; w.x = cvt_pk_bf16(v[0], v[1]); w.y = cvt_pk_bf16(v[2], v[3]); w.z = cvt_pk_bf16(v[4], v[5]); w.w = cvt_pk_bf16(v[6], v[7]);
                    *(gu32x4*)(rowp + bj * HALF) = w; } }
    }
};
struct EpiMoeOutT {
    static constexpr bool PERM = true, AFTER_DRAIN = false, HAS_PRE = false;
    bf16_t* Y; int ldc; const float* sg; float* part; unsigned* cnt; float cs;
    template <int S> __device__ __forceinline__ void tail_reduce(const Unit& u, int wr, int wc, int fr, int fq, int wid, int lane) const {
        typedef __attribute__((address_space(1))) f32x4 gf32x4;
        typedef __attribute__((address_space(1))) u32x4 gu32x4;
        constexpr int CPS = 8 / S;
        const gf32x4* base = (const gf32x4*)part + ((size_t)(u.ti * S) * 8 + wid) * 2048 + lane;
        const int row0 = u.pm * BM + wr * 64 + fr, col0 = u.pn * BM + wc * 32 + 8 * fq;
#pragma unroll
        for (int cc = 0; cc < CPS; ++cc) {
            const int c8 = u.ks * CPS + cc, ai = c8 >> 2, bj = (c8 >> 1) & 1, mh = c8 & 1;
            f32x4 t[S][4];
#pragma unroll
            for (int o = 0; o < S; ++o)
#pragma unroll
                for (int jj = 0; jj < 4; ++jj) t[o][jj] = base[(size_t)o * 16384 + (c8 * 4 + jj) * 64];
            const int r0 = row0 + ai * HALF + mh * 32;
            float g[2]; u32x4 b[2];
#pragma unroll
            for (int mm = 0; mm < 2; ++mm) g[mm] = ((const __attribute__((address_space(1))) float*)sg)[r0 + mm * 16];
#pragma unroll
            for (int mm = 0; mm < 2; ++mm) { b[mm] = (u32x4){0u, 0u, 0u, 0u}; if (g[mm] > 0.f) b[mm] = *(const gu32x4*)(Y + (size_t)(r0 + mm * 16) * ldc + col0 + bj * HALF); }
#pragma unroll
            for (int jj = 0; jj < 4; ++jj)
#pragma unroll
                for (int o = 1; o < S; ++o) t[0][jj] += t[o][jj];
#pragma unroll
            for (int mm = 0; mm < 2; ++mm) { const float ga = fabsf(g[mm]) * cs; float v[8];
#pragma unroll
                for (int i = 0; i < 4; ++i) { v[2 * i] = __uint_as_float(b[mm][i] << 16) + ga * t[0][mm * 2 + (i >> 1)][(2 * i) & 3]; v[2 * i + 1] = __uint_as_float(b[mm][i] & 0xffff0000u) + ga * t[0][mm * 2 + (i >> 1)][(2 * i + 1) & 3]; }
                u32x4 w; w.x = cvt_pk_bf16(v[0], v[1]); w.y = cvt_pk_bf16(v[2], v[3]); w.z = cvt_pk_bf16(v[4], v[5]); w.w = cvt_pk_bf16(v[6], v[7]);
                *(gu32x4*)(Y + (size_t)(r0 + mm * 16) * ldc + col0 + bj * HALF) = w; }
        }
    }
    __device__ __forceinline__ void operator()(const f32x4 (&acc)[2][2][4][2], const Unit& u, int wr, int wc, int fr, int fq) const {
        typedef __attribute__((address_space(1))) f32x4 gf32x4;
        typedef __attribute__((address_space(1))) u32x4 gu32x4;
        if (u.ti >= 0) {
            const int wid = wr * 4 + wc; int lane = fq * 16 + fr; asm volatile("" : "+v"(lane));
            gf32x4* p = (gf32x4*)part + ((size_t)(u.ti * u.s + u.ks) * 8 + wid) * 2048 + lane;
#pragma unroll
            for (int j = 0; j < 32; ++j) p[j * 64] = acc[j >> 4][(j >> 3) & 1][(j >> 1) & 3][j & 1];
            asm volatile("s_waitcnt vmcnt(0)" ::: "memory"); __builtin_amdgcn_s_barrier();
            if (wid == 0) {
                __builtin_amdgcn_fence(__ATOMIC_RELEASE, "agent");
                if (lane == 0) __hip_atomic_fetch_add(cnt + u.ti, 1u, __ATOMIC_RELAXED, __HIP_MEMORY_SCOPE_AGENT);
                while (__hip_atomic_load(cnt + u.ti, __ATOMIC_RELAXED, __HIP_MEMORY_SCOPE_AGENT) < (unsigned)u.s) __builtin_amdgcn_s_sleep(2);
                __builtin_amdgcn_fence(__ATOMIC_ACQUIRE, "agent");
            }
            __builtin_amdgcn_s_barrier();
            if (u.s == 8) tail_reduce<8>(u, wr, wc, fr, fq, wid, lane); else if (u.s == 4) tail_reduce<4>(u, wr, wc, fr, fq, wid, lane); else tail_reduce<2>(u, wr, wc, fr, fq, wid, lane);
            return;
        }
        const int row0 = u.pm * BM + wr * 64 + fr, col0 = u.pn * BM + wc * 32 + 8 * fq;
        float g[2][4];
        { const __attribute__((address_space(1))) float* gp = (const __attribute__((address_space(1))) float*)sg + row0;
#pragma unroll
          for (int ai = 0; ai < 2; ++ai)
#pragma unroll
              for (int m = 0; m < 4; ++m) g[ai][m] = gp[ai * HALF + m * 16]; }
        u32x4 b[2][4][2];
#pragma unroll
        for (int ai = 0; ai < 2; ++ai)
#pragma unroll
            for (int m = 0; m < 4; ++m)
#pragma unroll
                for (int bj = 0; bj < 2; ++bj) { b[ai][m][bj] = (u32x4){0u, 0u, 0u, 0u}; if (g[ai][m] > 0.f) b[ai][m][bj] = *(const gu32x4*)(Y + (size_t)(row0 + ai * HALF + m * 16) * ldc + col0 + bj * HALF); }
#pragma unroll
        for (int ai = 0; ai < 2; ++ai)
#pragma unroll
            for (int m = 0; m < 4; ++m) { bf16_t* rowp = Y + (size_t)(row0 + ai * HALF + m * 16) * ldc + col0; const float ga = fabsf(g[ai][m]) * cs;
#pragma unroll
                for (int bj = 0; bj < 2; ++bj) { float v[8];
#pragma unroll
                    for (int i = 0; i < 4; ++i) { v[2 * i] = __uint_as_float(b[ai][m][bj][i] << 16) + ga * acc[ai][bj][m][i >> 1][(2 * i) & 3]; v[2 * i + 1] = __uint_as_float(b[ai][m][bj][i] & 0xffff0000u) + ga * acc[ai][bj][m][i >> 1][(2 * i + 1) & 3]; }
                    u32x4 w; w.x = cvt_pk_bf16(v[0], v[1]); w.y = cvt_pk_bf16(v[2], v[3]); w.z = cvt_pk_bf16(v[4], v[5]); w.w = cvt_pk_bf16(v[6], v[7]);
                    *(gu32x4*)(rowp + bj * HALF) = w; } }
    }
};
struct EpiSwiGLU8 {
    static constexpr bool PERM = true, AFTER_DRAIN = false, HAS_PRE = false;
    unsigned char* H; int ldc; float cs;
    __device__ __forceinline__ void operator()(const f32x4 (&acc)[2][2][4][2], const Unit& u, int wr, int wc, int fr, int fq) const {
        const int row0 = u.pm * BM + wr * 64 + fr, col0 = u.pn * HALF + wc * 32 + 8 * fq;
#pragma unroll
        for (int ai = 0; ai < 2; ++ai)
#pragma unroll
            for (int m = 0; m < 4; ++m) { unsigned char* rowp = H + (size_t)(row0 + ai * HALF + m * 16) * ldc + col0; float hv[8];
#pragma unroll
                for (int n = 0; n < 2; ++n)
#pragma unroll
                    for (int i = 0; i < 4; ++i) { const float g = acc[ai][0][m][n][i] * cs, up = acc[ai][1][m][n][i] * cs;
                        hv[n * 4 + i] = __builtin_amdgcn_fmed3f(g * __builtin_amdgcn_rcpf(1.f + __builtin_amdgcn_exp2f(-g * 1.4426950408889634f)) * up * F8_SH, -448.f, 448.f); }
                int p0 = __builtin_amdgcn_cvt_pk_fp8_f32(hv[0], hv[1], 0, false); p0 = __builtin_amdgcn_cvt_pk_fp8_f32(hv[2], hv[3], p0, true);
                int p1 = __builtin_amdgcn_cvt_pk_fp8_f32(hv[4], hv[5], 0, false); p1 = __builtin_amdgcn_cvt_pk_fp8_f32(hv[6], hv[7], p1, true);
                typedef unsigned u32x2_t __attribute__((ext_vector_type(2)));
                *(u32x2_t*)rowp = (u32x2_t){(unsigned)p0, (unsigned)p1}; }
    }
};
struct EpiSwiGLU {
    static constexpr bool PERM = true, AFTER_DRAIN = false, HAS_PRE = true;
    __device__ __forceinline__ void preload(unsigned (&q)[8], const Unit& u, int wr, int fr) const {
        const __attribute__((address_space(1))) unsigned* rp = (const __attribute__((address_space(1))) unsigned*)rs + u.pm * BM + wr * 64 + fr;
#pragma unroll
        for (int i = 0; i < 8; ++i) q[i] = rp[(i >> 2) * HALF + (i & 3) * 16]; }
    bf16_t* H; int ldc; const unsigned* rs;
    __device__ __forceinline__ void operator()(const f32x4 (&acc)[2][2][4][2], const Unit& u, int wr, int wc, int fr, int fq, const unsigned (&q)[8]) const {
        const int row0 = u.pm * BM + wr * 64 + fr, col0 = u.pn * HALF + wc * 32 + 8 * fq;
        float sc[2][4];
#pragma unroll
        for (int ai = 0; ai < 2; ++ai)
#pragma unroll
            for (int m = 0; m < 4; ++m) sc[ai][m] = rsqrtf((float)q[ai * 4 + m] * (1.f / (16.f * 1024.f)) + 1e-6f);
#pragma unroll
        for (int ai = 0; ai < 2; ++ai)
#pragma unroll
            for (int m = 0; m < 4; ++m) { bf16_t* rowp = H + (size_t)(row0 + ai * HALF + m * 16) * ldc + col0; float hv[8];
#pragma unroll
                for (int n = 0; n < 2; ++n)
#pragma unroll
                    for (int i = 0; i < 4; ++i) { const float g = acc[ai][0][m][n][i] * sc[ai][m], up = acc[ai][1][m][n][i] * sc[ai][m];
                        hv[n * 4 + i] = g * __builtin_amdgcn_rcpf(1.f + __builtin_amdgcn_exp2f(-g * 1.4426950408889634f)) * up; }
                u32x4 w; w.x = cvt_pk_bf16(hv[0], hv[1]); w.y = cvt_pk_bf16(hv[2], hv[3]); w.z = cvt_pk_bf16(hv[4], hv[5]); w.w = cvt_pk_bf16(hv[6], hv[7]);
                *(u32x4*)rowp = w; }
    }
};

typedef int i32x4_t __attribute__((ext_vector_type(4)));
typedef int i32x8_t __attribute__((ext_vector_type(8)));
template <class Epi, class Sched, bool ALIGN_EPI = false, bool SP2 = false, int F8 = 0>
__device__ __forceinline__ void gemm_phase(PG8_LAS unsigned char* lds, const Gemm g, const Sched& S, const Epi& E) {
    int tid = threadIdx.x; asm volatile("" : "+v"(tid));
    const int wid = __builtin_amdgcn_readfirstlane(tid >> 6), lane = tid & 63, wr = wid >> 2, wc = wid & 3, fr = lane & 15, fq = lane >> 4;
    const int K = g.K, nt = K / BK;
    unsigned voffA[2], voffB[2];
#pragma unroll
    for (int i = 0; i < 2; ++i) { int R, C; stage_rc(tid * 16 + i * 8192, R, C); const int Rb = Epi::PERM ? ((R & ~31) + perm32(R & 31)) : R;
        voffA[i] = (unsigned)(R * K + C) * 2u; voffB[i] = (unsigned)(Rb * K + C) * 2u; }
    const size_t kstep = (size_t)(BK * 2);
    const size_t hstep = (size_t)HALF * K * 2;
    const size_t tstep = 2 * hstep;
    const unsigned ldsw = (unsigned)wid * 1024u;
    const int aoff = lds_byte(wr * 64 + fr, fq * 8), boff = lds_byte(wc * 32 + fr, fq * 8);
#define PG8_SA(b, h) (((b) * 2 + (h)) * HTB)
#define PG8_SB(b, h) ((4 + (b) * 2 + (h)) * HTB)
#define PG8_STAGE(bufoff, gbase, voff) do { _Pragma("unroll") for (int _i = 0; _i < 2; ++_i) \
        __builtin_amdgcn_global_load_lds((const unsigned*)((const char*)(gbase) + (voff)[_i]), (PG8_LAS unsigned*)(lds + (bufoff) + ldsw + _i * 8192), 16, 0, 0); } while (0)
#define PG8_LDA(dst, b, h) do { _Pragma("unroll") for (int m = 0; m < 4; ++m) _Pragma("unroll") for (int k = 0; k < 2; ++k) dst[m][k] = *(const PG8_LAS bf16x8*)(lds + PG8_SA(b, h) + aoff + m * 2048 + k * 1024); } while (0)
#define PG8_LDB(dst, b, h) do { _Pragma("unroll") for (int n = 0; n < 2; ++n) _Pragma("unroll") for (int k = 0; k < 2; ++k) dst[n][k] = *(const PG8_LAS bf16x8*)(lds + PG8_SB(b, h) + boff + n * 2048 + k * 1024); } while (0)
typedef long i64x2_t __attribute__((ext_vector_type(2)));
#define PG8_H64(x, hf) (__builtin_bit_cast(i64x2_t, x)[hf])
#define PG8_CAT8(x, y) __builtin_shufflevector(__builtin_bit_cast(i32x4_t, x), __builtin_bit_cast(i32x4_t, y), 0, 1, 2, 3, 4, 5, 6, 7)
#define PG8_MMA(ai, bj, At, Bt) do { __builtin_amdgcn_s_setprio(1); \
        if constexpr (F8 == 2) { _Pragma("unroll") for (int m = 0; m < 4; ++m) _Pragma("unroll") for (int n = 0; n < 2; ++n) \
            asm volatile("v_mfma_f32_16x16x128_f8f6f4 %0, %1, %2, %0" : "+v"(acc[ai][bj][m][n]) : "v"(PG8_CAT8(Bt[n][0], Bt[n][1])), "v"(PG8_CAT8(At[m][0], At[m][1]))); } \
        else if constexpr (F8 == 1) { _Pragma("unroll") for (int k = 0; k < 2; ++k) _Pragma("unroll") for (int hf = 0; hf < 2; ++hf) _Pragma("unroll") for (int m = 0; m < 4; ++m) _Pragma("unroll") for (int n = 0; n < 2; ++n) \
            acc[ai][bj][m][n] = __builtin_amdgcn_mfma_f32_16x16x32_fp8_fp8(PG8_H64(Bt[n][k], hf), PG8_H64(At[m][k], hf), acc[ai][bj][m][n], 0, 0, 0); } \
        else { _Pragma("unroll") for (int m = 0; m < 4; ++m) _Pragma("unroll") for (int n = 0; n < 2; ++n) _Pragma("unroll") for (int k = 0; k < 2; ++k) \
            acc[ai][bj][m][n] = __builtin_amdgcn_mfma_f32_16x16x32_bf16(Bt[n][k], At[m][k], acc[ai][bj][m][n], 0, 0, 0); } \
        __builtin_amdgcn_s_setprio(0); } while (0)
#define PG8_WAIT_V(n) asm volatile("s_waitcnt vmcnt(" #n ")" ::: "memory")
#define PG8_WAIT_L(n) asm volatile("s_waitcnt lgkmcnt(" #n ")" ::: "memory")
#define PG8_BAR __builtin_amdgcn_s_barrier()
#define PG8_SCHED __builtin_amdgcn_sched_barrier(0)
    Unit cur, nxt; int ui = 0;
    if (!S.next(0, cur)) return;
    f32x4 acc[2][2][4][2];
#pragma unroll
    for (int a = 0; a < 2; ++a)
#pragma unroll
        for (int b = 0; b < 2; ++b)
#pragma unroll
            for (int m = 0; m < 4; ++m)
#pragma unroll
                for (int n = 0; n < 2; ++n) acc[a][b][m][n] = (f32x4){0.f, 0.f, 0.f, 0.f};
    bf16x8 At[4][2], B0[2][2], B1[2][2];
    const char* cA = (const char*)g.A + (size_t)cur.pm * tstep; const char* cB = (const char*)g.Bt + cur.bofs + (size_t)cur.pn * tstep;
    if constexpr (Sched::VAR_K) cA += cur.aofs;
    S.a_ready(cur);
    if constexpr (SP2) {
        PG8_STAGE(PG8_SB(0, 0), cB, voffB); PG8_STAGE(PG8_SB(0, 1), cB + hstep, voffB); PG8_STAGE(PG8_SA(0, 0), cA, voffA); PG8_STAGE(PG8_SA(0, 1), cA + hstep, voffA);
        if (wr == 1) PG8_BAR;
        PG8_WAIT_V(2); PG8_BAR;
        PG8_STAGE(PG8_SB(1, 0), cB + kstep, voffB); PG8_STAGE(PG8_SA(1, 0), cA + kstep, voffA); PG8_STAGE(PG8_SB(1, 1), cB + hstep + kstep, voffB);
        PG8_WAIT_V(6); PG8_BAR;
    } else {
        PG8_STAGE(PG8_SB(0, 0), cB, voffB); PG8_STAGE(PG8_SA(0, 0), cA, voffA); PG8_STAGE(PG8_SB(0, 1), cB + hstep, voffB); PG8_STAGE(PG8_SA(0, 1), cA + hstep, voffA);
        if (wr == 1) PG8_BAR;
        PG8_WAIT_V(4); PG8_BAR;
        PG8_STAGE(PG8_SB(1, 0), cB + kstep, voffB); PG8_STAGE(PG8_SA(1, 0), cA + kstep, voffA); PG8_STAGE(PG8_SB(1, 1), cB + hstep + kstep, voffB);
        PG8_WAIT_V(6); PG8_BAR;
    }
    for (;;) {
        unsigned preq[8];
        if constexpr (Epi::HAS_PRE) E.preload(preq, cur, wr, fr);
        const bool has_next = S.next(ui + 1, nxt);
        const char* nA = has_next ? (const char*)g.A + (size_t)nxt.pm * tstep : cA; const char* nB = has_next ? (const char*)g.Bt + nxt.bofs + (size_t)nxt.pn * tstep : cB;
        if constexpr (Sched::VAR_K) { if (has_next) nA += nxt.aofs; }
        int ntu = nt; if constexpr (Sched::VAR_K) ntu = cur.nt;
        for (int t = 0; t < ntu; t += 2) {
            const bool last = (t == ntu - 2);
            const char* a1 = cA + (size_t)(t + 1) * kstep;
            const char* a2 = last ? nA : cA + (size_t)(t + 2) * kstep; const char* b2 = last ? nB : cB + (size_t)(t + 2) * kstep;
            const char* a3 = a2 + kstep; const char* b3 = b2 + kstep;
            if (last && has_next) S.a_ready(nxt);
            if constexpr (SP2) {
            PG8_LDB(B0, 0, 0); PG8_LDB(B1, 0, 1); PG8_SCHED; PG8_LDA(At, 0, 0); PG8_STAGE(PG8_SA(1, 1), a1 + hstep, voffA);
            PG8_WAIT_V(8); PG8_WAIT_L(0); PG8_BAR; PG8_MMA(0, 0, At, B0); PG8_MMA(0, 1, At, B1); PG8_BAR; PG8_SCHED;
            PG8_LDA(At, 0, 1); PG8_STAGE(PG8_SB(0, 0), b2, voffB); PG8_STAGE(PG8_SB(0, 1), b2 + hstep, voffB); PG8_STAGE(PG8_SA(0, 0), a2, voffA);
            PG8_WAIT_V(8); PG8_WAIT_L(0); PG8_BAR; PG8_MMA(1, 0, At, B0); PG8_MMA(1, 1, At, B1); PG8_BAR; PG8_SCHED;
            PG8_LDB(B0, 1, 0); PG8_LDB(B1, 1, 1); PG8_SCHED; PG8_LDA(At, 1, 0); PG8_STAGE(PG8_SA(0, 1), a2 + hstep, voffA);
            PG8_WAIT_V(8); PG8_WAIT_L(0); PG8_BAR; PG8_MMA(0, 0, At, B0); PG8_MMA(0, 1, At, B1); PG8_BAR; PG8_SCHED;
            PG8_LDA(At, 1, 1); PG8_STAGE(PG8_SB(1, 0), b3, voffB); PG8_STAGE(PG8_SB(1, 1), b3 + hstep, voffB); PG8_STAGE(PG8_SA(1, 0), a3, voffA);
            PG8_WAIT_V(8); PG8_WAIT_L(0); PG8_BAR; PG8_MMA(1, 0, At, B0); PG8_MMA(1, 1, At, B1); PG8_BAR; PG8_SCHED;
            } else {
            PG8_LDB(B0, 0, 0); PG8_SCHED; PG8_LDA(At, 0, 0); PG8_STAGE(PG8_SA(1, 1), a1 + hstep, voffA);
            PG8_WAIT_L(8); PG8_BAR; PG8_WAIT_L(0); PG8_MMA(0, 0, At, B0); PG8_BAR; PG8_SCHED;
            PG8_LDB(B1, 0, 1); PG8_STAGE(PG8_SB(0, 0), b2, voffB);
            PG8_BAR; PG8_WAIT_L(0); PG8_MMA(0, 1, At, B1); PG8_BAR;
            PG8_LDA(At, 0, 1); PG8_STAGE(PG8_SA(0, 0), a2, voffA);
            PG8_BAR; PG8_WAIT_L(0); PG8_MMA(1, 0, At, B0); PG8_BAR; PG8_SCHED;
            PG8_STAGE(PG8_SB(0, 1), b2 + hstep, voffB);
            PG8_WAIT_V(6); PG8_BAR; PG8_MMA(1, 1, At, B1); PG8_BAR;
            PG8_LDB(B0, 1, 0); PG8_SCHED; PG8_LDA(At, 1, 0); PG8_STAGE(PG8_SA(0, 1), a2 + hstep, voffA);
            PG8_WAIT_L(8); PG8_BAR; PG8_WAIT_L(0); PG8_MMA(0, 0, At, B0); PG8_BAR; PG8_SCHED;
            PG8_LDB(B1, 1, 1); PG8_STAGE(PG8_SB(1, 0), b3, voffB);
            PG8_BAR; PG8_WAIT_L(0); PG8_MMA(0, 1, At, B1); PG8_BAR;
            PG8_LDA(At, 1, 1); PG8_STAGE(PG8_SA(1, 0), a3, voffA);
            PG8_BAR; PG8_WAIT_L(0); PG8_MMA(1, 0, At, B0); PG8_BAR; PG8_SCHED;
            PG8_STAGE(PG8_SB(1, 1), b3 + hstep, voffB);
            PG8_WAIT_V(6); PG8_BAR; PG8_MMA(1, 1, At, B1); PG8_BAR;
            }
        }
        if constexpr (F8 == 2) asm volatile("s_nop 15\n\ts_nop 15" ::: "memory");
        if constexpr (ALIGN_EPI) { if (wr == 0) PG8_BAR; }
        if constexpr (!Epi::AFTER_DRAIN) { if constexpr (Epi::HAS_PRE) E(acc, cur, wr, wc, fr, fq, preq); else E(acc, cur, wr, wc, fr, fq); S.done(cur); }
        if (!has_next) break;
#pragma unroll
        for (int a = 0; a < 2; ++a)
#pragma unroll
            for (int b = 0; b < 2; ++b)
#pragma unroll
                for (int m = 0; m < 4; ++m)
#pragma unroll
                    for (int n = 0; n < 2; ++n) acc[a][b][m][n] = (f32x4){0.f, 0.f, 0.f, 0.f};
        cur = nxt; cA = nA; cB = nB; ++ui;
        if constexpr (ALIGN_EPI) { if (wr == 1) PG8_BAR; }
    }
    PG8_WAIT_V(0);
    if constexpr (!ALIGN_EPI) { if (wr == 0) PG8_BAR; }
    PG8_BAR;
#undef PG8_SA
#undef PG8_SB
#undef PG8_STAGE
#undef PG8_LDA
#undef PG8_LDB
#undef PG8_MMA
#undef PG8_WAIT_V
#undef PG8_WAIT_L
#undef PG8_BAR
#undef PG8_SCHED
}
}


#include <hip/hip_bf16.h>
namespace fox {
using bf16h=__hip_bfloat16;
using bf16x8=__attribute__((ext_vector_type(8)))short;
using s16x4=__attribute__((ext_vector_type(4)))short;
using f32x16=__attribute__((ext_vector_type(16)))float;
using f32x4=__attribute__((ext_vector_type(4)))float;
using u32x4=__attribute__((ext_vector_type(4)))unsigned;
constexpr int NHEAD=FH,D=64,DMI=512,DMO=1024;
constexpr int NW=8,QBLK=32,QB=QBLK*NW,KVBLK=64,NQB=SEQ/QB;
__device__ __forceinline__ int crow(int r,int hi){return (r&3)+8*(r>>2)+4*hi;}
#define SBAR() __builtin_amdgcn_sched_barrier(0)
__device__ __forceinline__ void cmask(f32x16&p0,f32x16&p1,int jb,int qrel,int hi){
  const float NEG=-INFINITY; int kb=64*jb+4*hi;
  #pragma unroll
  for(int r=0;r<16;++r){int kv=kb+(r&3)+8*(r>>2); if(kv>qrel)p0[r]=NEG; if(kv+32>qrel)p1[r]=NEG;}
}
constexpr int NSLOT=3, SLOTB=8192;
constexpr int LDS_K=0, LDS_V=NSLOT*SLOTB, LDS_WS=2*NSLOT*SLOTB, LDS_OST=LDS_WS+NW*64*4, LDS_NB=LDS_OST+NW*4096, LDS_BYTES=LDS_NB+SEQ*4;
__device__ __forceinline__ void glds16(const void*gsrc,unsigned lds_dst){unsigned keep;
  asm volatile("s_mov_b32 %0, m0\n\ts_mov_b32 m0, %2\n\ts_nop 0\n\tglobal_load_lds_dwordx4 %1, off\n\ts_mov_b32 m0, %0":"=&s"(keep):"v"(gsrc),"s"(lds_dst):"memory");}
__device__ __forceinline__ float max3f(float a,float b,float c){float r;asm("v_max3_f32 %0, %1, %2, %3":"=v"(r):"v"(a),"v"(b),"v"(c));return r;}
__device__ __forceinline__ float max2f(float a,float b){float r;asm("v_max_f32_e32 %0, %1, %2":"=v"(r):"v"(a),"v"(b));return r;}
__device__ __forceinline__ float fadd_s(float a,float b){float r;asm("v_add_f32_e32 %0, %1, %2":"=v"(r):"v"(a),"v"(b));return r;}
__device__ __forceinline__ float fsub_s(float a,float b){float r;asm("v_sub_f32_e32 %0, %1, %2":"=v"(r):"v"(a),"v"(b));return r;}
typedef float f32x2_t __attribute__((ext_vector_type(2))); typedef __bf16 bf16x2_t __attribute__((ext_vector_type(2)));
__device__ __forceinline__ unsigned cvtpk_s(float lo,float hi){f32x2_t v={lo,hi};bf16x2_t b=__builtin_convertvector(v,bf16x2_t);return __builtin_bit_cast(unsigned,b);}
#define WAIT_BAR(N) asm volatile("s_waitcnt vmcnt(" #N ") lgkmcnt(0)\n\ts_barrier":::"memory")
__device__ __forceinline__ void qkt(f32x16&p0,f32x16&p1,const char*Kslot,const bf16x8*qr,int r32,int hi){
  const char*kb=Kslot+hi*1024+r32*16;
  #pragma unroll
  for(int d0=0;d0<4;++d0){
    const bf16x8 b0=*reinterpret_cast<const bf16x8*>(kb+d0*2048);
    const bf16x8 b1=*reinterpret_cast<const bf16x8*>(kb+d0*2048+512);
    p0=__builtin_amdgcn_mfma_f32_32x32x16_bf16(b0,qr[d0],p0,0,0,0);p1=__builtin_amdgcn_mfma_f32_32x32x16_bf16(b1,qr[d0],p1,0,0,0);}
}
typedef __attribute__((address_space(3))) const char* lds_cptr;
typedef __attribute__((address_space(3))) const float* lds_fptr;
typedef short v4i16_t __attribute__((ext_vector_type(4)));
__device__ __forceinline__ void kload8(bf16x8*kf,lds_cptr kp){
  kf[0]=*(const __attribute__((address_space(3))) bf16x8*)(kp);      kf[1]=*(const __attribute__((address_space(3))) bf16x8*)(kp+512);
  kf[2]=*(const __attribute__((address_space(3))) bf16x8*)(kp+2048); kf[3]=*(const __attribute__((address_space(3))) bf16x8*)(kp+2560);
  kf[4]=*(const __attribute__((address_space(3))) bf16x8*)(kp+4096); kf[5]=*(const __attribute__((address_space(3))) bf16x8*)(kp+4608);
  kf[6]=*(const __attribute__((address_space(3))) bf16x8*)(kp+6144); kf[7]=*(const __attribute__((address_space(3))) bf16x8*)(kp+6656);
}
__device__ __forceinline__ void kload2(bf16x8*kf,lds_cptr kp,int j){ kf[2*j]=*(const __attribute__((address_space(3))) bf16x8*)(kp+j*2048); kf[2*j+1]=*(const __attribute__((address_space(3))) bf16x8*)(kp+j*2048+512); }
__device__ __forceinline__ s16x4 vtr(lds_cptr p){ return __builtin_bit_cast(s16x4,__builtin_amdgcn_ds_read_tr16_b64_v4i16((__attribute__((address_space(3))) v4i16_t*)p)); }
__device__ __forceinline__ float rowmax(const f32x16&p0,const f32x16&p1){
  float a=max3f(p0[0],p0[1],p1[0]),b=max3f(p0[2],p0[3],p1[1]);a=max3f(a,p1[2],p1[3]);
  #pragma unroll
  for(int r=4;r<16;r+=4){a=max3f(a,p0[r],p0[r+1]);b=max3f(b,p0[r+2],p0[r+3]);a=max3f(a,p1[r],p1[r+1]);b=max3f(b,p1[r+2],p1[r+3]);}
  const float m=max2f(a,b);
  auto rr=__builtin_amdgcn_permlane32_swap(__float_as_uint(m),__float_as_uint(m),false,false);
  return max2f(__uint_as_float(rr[0]),__uint_as_float(rr[1]));
}
__device__ __forceinline__ void pv(f32x16*o,int vb,bf16x8 pa0,bf16x8 pa1,bf16x8 pa2,bf16x8 pa3){
  #pragma unroll
  for(int d0=0;d0<2;++d0){s16x4 lo[4],hi[4];
    #pragma unroll
    for(int ks=0;ks<4;++ks){
      asm volatile("ds_read_b64_tr_b16 %0,%1 offset:%c2":"=&v"(lo[ks]):"v"(vb),"i"(d0*4096+ks*1024):"memory");
      asm volatile("ds_read_b64_tr_b16 %0,%1 offset:%c2":"=&v"(hi[ks]):"v"(vb),"i"(d0*4096+ks*1024+512):"memory");}
    asm volatile("s_waitcnt lgkmcnt(0)":::"memory");SBAR();
    #define PK(k) (bf16x8){lo[k][0],lo[k][1],lo[k][2],lo[k][3],hi[k][0],hi[k][1],hi[k][2],hi[k][3]}
    o[d0]=__builtin_amdgcn_mfma_f32_32x32x16_bf16(pa0,PK(0),o[d0],0,0,0);
    o[d0]=__builtin_amdgcn_mfma_f32_32x32x16_bf16(pa1,PK(1),o[d0],0,0,0);
    o[d0]=__builtin_amdgcn_mfma_f32_32x32x16_bf16(pa2,PK(2),o[d0],0,0,0);
    o[d0]=__builtin_amdgcn_mfma_f32_32x32x16_bf16(pa3,PK(3),o[d0],0,0,0);
    #undef PK
  }
}
template<int THRL> __device__ __forceinline__ void attn_unit(int b,int h,int qb,int j0,const bf16h*Q,const bf16h*__restrict__ K,const bf16h*__restrict__ V,bf16h*O,const float*CL,char*shm){
  int tid=threadIdx.x; asm volatile("":"+v"(tid));
  const int lane=tid&63,r32=lane&31,hi=lane>>5; const int wid=__builtin_amdgcn_readfirstlane(tid>>6);
  const long rowbase=(long)b*SEQ; const int q0=qb*QB; const long kvbase=rowbase+(long)j0*KVBLK;
  const bf16h*Qw=Q+(rowbase+q0+wid*QBLK)*DMI+h*D;
  const bf16h*Kh=K+kvbase*DMI+h*D,*Vh=V+kvbase*DMI+h*D;
  const unsigned lds0=(unsigned)(uintptr_t)shm;
  float*wsf=(float*)(shm+LDS_WS)+wid*64;
  const int NT=(q0+QB)/KVBLK-j0;
  { float*nbw=(float*)(shm+LDS_NB); const float*src=CL+(long)j0*KVBLK;
    for(int i=tid*4;i<NT*KVBLK;i+=512*4){ const f32x4 v=*(const f32x4*)(src+i); *(f32x4*)(nbw+i)=(f32x4){-v[0],-v[1],-v[2],-v[3]}; } }
  const bf16h*ksrc=Kh+(long)lane*DMI+wid*8;
  const bf16h*vsrc=Vh+(long)(16*(wid&3)+(lane>>2))*DMI+(wid>>2)*32+(lane&3)*8;
  const unsigned kdst=lds0+LDS_K+wid*1024, vdst=lds0+LDS_V+wid*1024;
  #define DMA_K(t,slot) glds16(ksrc+(long)(t)*KVBLK*DMI,(unsigned)__builtin_amdgcn_readfirstlane(kdst+(slot)))
  #define DMA_V(t,slot) glds16(vsrc+(long)(t)*KVBLK*DMI,(unsigned)__builtin_amdgcn_readfirstlane(vdst+(slot)))
  const int vb0=(int)(lds0+LDS_V)+((lane>>4)&1)*32+(lane&3)*8+(4*hi+((lane&15)>>2))*64;
  const char*Kbase=shm+LDS_K; bf16x8 kf[8];
  const lds_cptr shm3=(lds_cptr)shm; const lds_cptr kp0=shm3+LDS_K+hi*1024+r32*16; const lds_cptr vp0=shm3+LDS_V+((lane>>4)&1)*32+(lane&3)*8+(4*hi+((lane&15)>>2))*64;
  const lds_fptr nb0=(lds_fptr)(shm3+LDS_NB)+4*hi;
  DMA_K(0,0);DMA_V(0,0);DMA_K(1,SLOTB);
  bf16x8 qr[4];
  #pragma unroll
  for(int d0=0;d0<4;++d0)qr[d0]=*reinterpret_cast<const bf16x8*>(&Qw[(long)r32*DMI+d0*16+hi*8]);
  float mhat=0.f,l_reg=0.f;f32x16 o[2];o[0]=f32x16{};o[1]=f32x16{};
  const int qrel=wid*QBLK+r32;
  #define CMASK(P0,P1,t) do{int jb_=(t)-(NT-4); if(jb_>=0)cmask(P0,P1,jb_,qrel,hi);}while(0)
  #define PRELOAD(P0,P1,tt) do{ const lds_fptr nbp_=nb0+(tt)*KVBLK; \
    _Pragma("unroll") for(int g_=0;g_<4;++g_){ const f32x4 a_=*(const __attribute__((address_space(3))) f32x4*)(nbp_+8*g_), b_=*(const __attribute__((address_space(3))) f32x4*)(nbp_+32+8*g_); \
      P0[4*g_]=a_[0]-mhat;P0[4*g_+1]=a_[1]-mhat;P0[4*g_+2]=a_[2]-mhat;P0[4*g_+3]=a_[3]-mhat; P1[4*g_]=b_[0]-mhat;P1[4*g_+1]=b_[1]-mhat;P1[4*g_+2]=b_[2]-mhat;P1[4*g_+3]=b_[3]-mhat; } }while(0)
  bool resc=false;
  #define START(P0,P1) do{ const float rm=rowmax(P0,P1); resc=false; \
    { const float dl=rm; mhat=fadd_s(mhat,dl); \
      _Pragma("unroll") for(int r=0;r<16;++r){P0[r]=fsub_s(P0[r],dl);P1[r]=fsub_s(P1[r],dl);} } \
    _Pragma("unroll") for(int r=0;r<16;++r)P0[r]=__builtin_amdgcn_exp2f(P0[r]); }while(0)
  #define RESC() do{ if(resc){ asm volatile("s_waitcnt lgkmcnt(0)":::"memory"); \
      _Pragma("unroll") for(int d_=0;d_<2;++d_) _Pragma("unroll") for(int r=0;r<16;++r)o[d_][r]*=wsf[crow(r,hi)]; } }while(0)
  f32x16 pA0,pA1,pB0,pB1;
  int sl_prev=0,sl_cur=0,sl_next=SLOTB;
  #define ROT() do{sl_prev=sl_cur;sl_cur=sl_next;sl_next=(sl_next==(NSLOT-1)*SLOTB)?0:sl_next+SLOTB;}while(0)
  DMA_K(2,2*SLOTB);
  WAIT_BAR(3);
  PRELOAD(pA0,pA1,0);
  qkt(pA0,pA1,Kbase,qr,r32,hi);asm volatile("s_nop 15\n\ts_nop 7":"+v"(pA0),"+v"(pA1));CMASK(pA0,pA1,0);
  START(pA0,pA1);
  _Pragma("unroll") for(int r=0;r<16;++r)pA1[r]=__builtin_amdgcn_exp2f(pA1[r]);
  WAIT_BAR(0);
  DMA_K(3,0);DMA_V(1,SLOTB);
  ROT();
  kload8(kf,kp0+sl_cur);
  PRELOAD(pB0,pB1,1);
  WAIT_BAR(2);
  s16x4 vlo[8],vhi[8]; u32x4 pw0,pw1,pw2,pw3;
  #define PKW(P,B) cvtpk_s(P[B],P[B+1])
  #define PAF(k) __builtin_bit_cast(bf16x8,pw##k)
  #define VFR(i) (bf16x8){vlo[i][0],vlo[i][1],vlo[i][2],vlo[i][3],vhi[i][0],vhi[i][1],vhi[i][2],vhi[i][3]}
  #define PIN(x) asm volatile("":"+v"(x))
  #define MX3(a,b,c) __builtin_fmaxf(__builtin_fmaxf((a),(b)),(c))
  #define GAPA(MF,A0,A1,A2,A3,W0,W1,PW) do{ MF; sacc+=A0; sacc+=A1; sacc+=A2; sacc+=A3; PIN(sacc); W0; W1; PIN(PW); SBAR(); }while(0)
  #define EX(v) __builtin_amdgcn_exp2f(v)
  #define GAPB(MF,X,B) do{ MF; X[B]=EX(X[B]); X[B+1]=EX(X[B+1]); X[B+2]=EX(X[B+2]); X[B+3]=EX(X[B+3]); PIN(X); SBAR(); }while(0)
  #define VRD(i) do{ vlo[i]=vtr(vp_+(((i)>>2)*4096+((i)&3)*1024)); vhi[i]=vtr(vp_+(((i)>>2)*4096+((i)&3)*1024+512)); }while(0)
  #define KRD(G,j) do{ if(G){ kload2(kf,kp0+sl_next,j); SBAR(); } }while(0)
  #define STEP(C0,C1,P0,P1,t,GK,GV,GL) do{ SBAR(); \
    const lds_cptr vp_=vp0+sl_prev; \
    VRD(0); SBAR(); float sacc=(P0[0]+P0[1]); \
    GAPA(C0=__builtin_amdgcn_mfma_f32_32x32x16_bf16(kf[0],qr[0],C0,0,0,0), P0[2],P0[3],P0[4],P0[5],     pw0[0]=PKW(P0,0), pw0[1]=PKW(P0,2), pw0); \
    VRD(4); SBAR(); GAPA(C1=__builtin_amdgcn_mfma_f32_32x32x16_bf16(kf[1],qr[0],C1,0,0,0), P0[6],P0[7],P0[8],P0[9],     pw0[2]=PKW(P0,4), pw0[3]=PKW(P0,6), pw0); \
    VRD(1); SBAR(); GAPA(C0=__builtin_amdgcn_mfma_f32_32x32x16_bf16(kf[2],qr[1],C0,0,0,0),   P0[10],P0[11],P0[12],P0[13], pw1[0]=PKW(P0,8), pw1[1]=PKW(P0,10), pw1); \
    VRD(5); SBAR(); GAPA(C1=__builtin_amdgcn_mfma_f32_32x32x16_bf16(kf[3],qr[1],C1,0,0,0),   P0[14],P0[15],P1[0],P1[1],   pw1[2]=PKW(P0,12),pw1[3]=PKW(P0,14), pw1); \
    VRD(2); SBAR(); GAPA(C0=__builtin_amdgcn_mfma_f32_32x32x16_bf16(kf[4],qr[2],C0,0,0,0),   P1[2],P1[3],P1[4],P1[5],     pw2[0]=PKW(P1,0), pw2[1]=PKW(P1,2), pw2); \
    VRD(6); SBAR(); GAPA(C1=__builtin_amdgcn_mfma_f32_32x32x16_bf16(kf[5],qr[2],C1,0,0,0),   P1[6],P1[7],P1[8],P1[9],     pw2[2]=PKW(P1,4), pw2[3]=PKW(P1,6), pw2); \
    VRD(3); SBAR(); GAPA(C0=__builtin_amdgcn_mfma_f32_32x32x16_bf16(kf[6],qr[3],C0,0,0,0),   P1[10],P1[11],P1[12],P1[13], pw3[0]=PKW(P1,8), pw3[1]=PKW(P1,10), pw3); \
    VRD(7); SBAR(); GAPA(C1=__builtin_amdgcn_mfma_f32_32x32x16_bf16(kf[7],qr[3],C1,0,0,0),   P1[14],P1[15],0.f,0.f,       pw3[2]=PKW(P1,12),pw3[3]=PKW(P1,14), pw3); \
    l_reg+=sacc; \
    if(GK){DMA_K((t)+3,sl_cur);} if(GV){DMA_V((t)+1,sl_next);} \
    CMASK(C0,C1,t); \
    { float a=MX3(C0[0],C0[1],C1[0]),b=MX3(C0[2],C0[3],C1[1]); a=MX3(a,C1[2],C1[3]); \
      _Pragma("unroll") for(int r=4;r<16;r+=4){a=MX3(a,C0[r],C0[r+1]);b=MX3(b,C0[r+2],C0[r+3]);a=MX3(a,C1[r],C1[r+1]);b=MX3(b,C1[r+2],C1[r+3]);} \
      float rm=__builtin_fmaxf(a,b); { auto rr=__builtin_amdgcn_permlane32_swap(__float_as_uint(rm),__float_as_uint(rm),false,false); rm=__builtin_fmaxf(__uint_as_float(rr[0]),__uint_as_float(rr[1])); } \
      resc=false; \
      if(__builtin_expect(__any(rm>(float)THRL),0)){ const float dl=__builtin_fmaxf(rm,0.f); mhat+=dl; \
        _Pragma("unroll") for(int r=0;r<16;++r){C0[r]-=dl;C1[r]-=dl;} \
        const float f=__builtin_amdgcn_exp2f(-dl); l_reg*=f; if(hi==0)wsf[r32]=f; resc=true; } } \
    SBAR(); \
    GAPB(o[0]=__builtin_amdgcn_mfma_f32_32x32x16_bf16(PAF(0),VFR(0),o[0],0,0,0), C0,0); \
    GAPB(o[1]=__builtin_amdgcn_mfma_f32_32x32x16_bf16(PAF(0),VFR(4),o[1],0,0,0), C0,4); \
    KRD(GL,0); GAPB(o[0]=__builtin_amdgcn_mfma_f32_32x32x16_bf16(PAF(1),VFR(1),o[0],0,0,0), C0,8); \
    KRD(GL,1); GAPB(o[1]=__builtin_amdgcn_mfma_f32_32x32x16_bf16(PAF(1),VFR(5),o[1],0,0,0), C0,12); \
    KRD(GL,2); GAPB(o[0]=__builtin_amdgcn_mfma_f32_32x32x16_bf16(PAF(2),VFR(2),o[0],0,0,0), C1,0); \
    KRD(GL,3); GAPB(o[1]=__builtin_amdgcn_mfma_f32_32x32x16_bf16(PAF(2),VFR(6),o[1],0,0,0), C1,4); \
    GAPB(o[0]=__builtin_amdgcn_mfma_f32_32x32x16_bf16(PAF(3),VFR(3),o[0],0,0,0), C1,8); \
    GAPB(o[1]=__builtin_amdgcn_mfma_f32_32x32x16_bf16(PAF(3),VFR(7),o[1],0,0,0), C1,12); \
    if(GL){ PRELOAD(P0,P1,(t)+1); } \
    }while(0)
  int t=1;
  #undef CMASK
  #define CMASK(P0,P1,t) do{}while(0)
  for(;t+5<NT;t+=2){
    STEP(pB0,pB1,pA0,pA1,t,true,true,true);     WAIT_BAR(2); RESC(); ROT();
    STEP(pA0,pA1,pB0,pB1,t+1,true,true,true);   WAIT_BAR(2); RESC(); ROT();
  }
  #undef CMASK
  #define CMASK(P0,P1,t) do{int jb_=(t)-(NT-4); if(jb_>=0)cmask(P0,P1,jb_,qrel,hi);}while(0)
  #define ENDW(tt) do{ if((tt)+3<NT){WAIT_BAR(2);} else if((tt)+2<NT){WAIT_BAR(1);} else {WAIT_BAR(0);} }while(0)
  for(;t+1<NT;t+=2){
    STEP(pB0,pB1,pA0,pA1,t,(t+3<NT),(t+1<NT),(t+1<NT));       ENDW(t);   RESC(); ROT();
    STEP(pA0,pA1,pB0,pB1,t+1,(t+4<NT),(t+2<NT),(t+2<NT));     ENDW(t+1); RESC(); ROT();
  }
  STEP(pB0,pB1,pA0,pA1,NT-1,false,false,false); RESC();
  { float sacc=pB0[0]+pB0[1]; _Pragma("unroll") for(int r=2;r<16;++r)sacc+=pB0[r]; _Pragma("unroll") for(int r=0;r<16;++r)sacc+=pB1[r]; l_reg+=sacc;
    pw0=(u32x4){PKW(pB0,0),PKW(pB0,2),PKW(pB0,4),PKW(pB0,6)};pw1=(u32x4){PKW(pB0,8),PKW(pB0,10),PKW(pB0,12),PKW(pB0,14)};pw2=(u32x4){PKW(pB1,0),PKW(pB1,2),PKW(pB1,4),PKW(pB1,6)};pw3=(u32x4){PKW(pB1,8),PKW(pB1,10),PKW(pB1,12),PKW(pB1,14)};
    SBAR(); pv(o,vb0+sl_cur,PAF(0),PAF(1),PAF(2),PAF(3)); }
  #undef PKW
  #undef PAF
  #undef VFR
  #undef PIN
  #undef MX3
  #undef GAPA
  #undef GAPB
  #undef EX
  #undef VRD
  #undef KRD
  #undef STEP
  #undef ENDW
  {auto rr=__builtin_amdgcn_permlane32_swap(__float_as_uint(l_reg),__float_as_uint(l_reg),false,false);l_reg=__uint_as_float(rr[0])+__uint_as_float(rr[1]);}
  if(hi==0)wsf[32+r32]=l_reg;asm volatile("s_waitcnt lgkmcnt(0)":::"memory");
  float rli[16];
  #pragma unroll
  for(int r=0;r<16;++r)rli[r]=__builtin_amdgcn_rcpf(wsf[32+crow(r,hi)]);
  bf16h*Ow=O+(rowbase+q0+wid*QBLK)*DMO+h*D;
  { bf16h*stg=(bf16h*)(shm+LDS_OST)+wid*2048;
    #pragma unroll
    for(int r=0;r<16;++r){const int orow=crow(r,hi);
      #pragma unroll
      for(int d0=0;d0<2;++d0)stg[orow*64+d0*32+r32]=__float2bfloat16(o[d0][r]*rli[r]);}
    asm volatile("s_waitcnt lgkmcnt(0)":::"memory");
    #pragma unroll
    for(int i=0;i<4;++i){const int row=i*8+(lane>>3),ch=lane&7; const u32x4 v=*(const u32x4*)(stg+row*64+ch*8); *(u32x4*)(Ow+(long)row*DMO+ch*8)=v;} }
  asm volatile("s_waitcnt lgkmcnt(0)\n\ts_barrier":::"memory");
  #undef DMA_K
  #undef DMA_V
  #undef CMASK
  #undef PRELOAD
  #undef START
  #undef RESC
  #undef ROT
}

__device__ __forceinline__ int unit_j0_wave(int bh,int qb,const bf16h*Q,const float*KN2,const float*CL,int lane){
  const int b=bh/NHEAD,h=bh%NHEAD; constexpr int NTT=SEQ/KVBLK;
  float mx=0.f;
  #pragma unroll
  for(int rr=0;rr<QB/64;++rr){ const bf16h*Qw=Q+((long)b*SEQ+qb*QB+rr*64+lane)*DMI+h*D; float ss=0.f;
    #pragma unroll
    for(int c=0;c<8;++c){ const u32x4 v=*reinterpret_cast<const u32x4*>(&Qw[c*8]);
      #pragma unroll
      for(int e=0;e<4;++e){ const float f0=__uint_as_float(v[e]<<16),f1=__uint_as_float(v[e]&0xffff0000u); ss+=f0*f0+f1*f1; } }
    mx=fmaxf(mx,ss); }
  #pragma unroll
  for(int o=1;o<64;o<<=1) mx=fmaxf(mx,__shfl_xor(mx,o));
  const int nt=4*qb; const float*kn=KN2+bh*NTT;
  const float Qn=sqrtf(mx),KNd=sqrtf(fmaxf(fmaxf(kn[nt],kn[nt+1]),fmaxf(kn[nt+2],kn[nt+3])));
  const float clt0=CL[qb*QB];
  int first=nt;
  #pragma unroll
  for(int part=1;part>=0;--part){ const int i=lane+64*part; bool need=false;
    if(i<nt){ const float bound=Qn*(sqrtf(kn[i])+KNd)+clt0-CL[KVBLK*i+KVBLK-1]; need=!(bound<-40.f); }
    const unsigned long long bal=__ballot(need); if(bal) first=__ffsll((long long)bal)-1+64*part; }
  return (first<nt?first:nt)&~1;
}
#undef SBAR
#undef WAIT_BAR
}

#define GAS __attribute__((address_space(1)))
#define LAS __attribute__((address_space(3)))
typedef unsigned v4u __attribute__((ext_vector_type(4)));
typedef float f32x4 __attribute__((ext_vector_type(4)));
typedef GAS unsigned gu32;
#define RLX_AGENT __ATOMIC_RELAXED, __HIP_MEMORY_SCOPE_AGENT
#define LDS_WAIT() asm volatile("s_waitcnt lgkmcnt(0)" ::: "memory")
#define VM_WAIT() asm volatile("s_waitcnt vmcnt(0)" ::: "memory")
__device__ __forceinline__ unsigned pk2(float lo, float hi) { return (unsigned)f2bf(lo) | ((unsigned)f2bf(hi) << 16); }
__device__ __forceinline__ void unpack8(const v4u w, float* f) {
#pragma unroll
    for (int i = 0; i < 4; ++i) { f[2 * i] = __uint_as_float(w[i] << 16); f[2 * i + 1] = __uint_as_float(w[i] & 0xffff0000u); }
}

#define XB_TMO      128
#define XB_XCNT(j)  (256  + 64 * (j))
#define XB_XSUB(j)  (1280 + 64 * (j))
#define XB_XGEN(j)  (2304 + 64 * (j))
#define XB_TOP      3328
#define XB_TOPGEN   3392
#define XCD_BAR_WORDS 3456
#define XB_SPIN_CAP (1u << 18)
__device__ __forceinline__ unsigned xb_ld(unsigned* p)              { return __hip_atomic_load(p, __ATOMIC_RELAXED, __HIP_MEMORY_SCOPE_AGENT); }
__device__ __forceinline__ unsigned xb_add(unsigned* p, unsigned v) { return __hip_atomic_fetch_add(p, v, __ATOMIC_RELAXED, __HIP_MEMORY_SCOPE_AGENT); }
__device__ __forceinline__ unsigned xb_xcc_id() { return (unsigned)__builtin_amdgcn_s_getreg((3 << 11) | 20) & 0xFu; }
#define XB_SPIN(cond, bar) do { unsigned _sp = 0; while (cond) { __builtin_amdgcn_s_sleep(1); \
    if ((++_sp & 255u) == 0u) { if (xb_ld(&(bar)[XB_TMO])) break; if (_sp > XB_SPIN_CAP) { atomicAdd(&(bar)[XB_TMO], 1u); break; } } } } while (0)
struct XcdBarrier { unsigned* bar; unsigned x; volatile LAS unsigned* st; };
__device__ __forceinline__ XcdBarrier xcd_barrier_post(unsigned* bar, volatile LAS unsigned* st) {
    XcdBarrier b; b.bar = bar; b.x = xb_xcc_id(); b.st = st;
    if (threadIdx.x == 0) (void)xb_add(&bar[XB_XCNT(b.x)], 1u);
    return b;
}
__device__ __forceinline__ void xcd_barrier_complete(unsigned* bar, unsigned x, unsigned& nloc, unsigned& nx) {
    const unsigned G = gridDim.x * gridDim.y * gridDim.z;
    unsigned sum, cnt, mine, sp = 0u;
    for (;;) {
        sum = 0u; cnt = 0u; mine = 0u;
#pragma unroll
        for (unsigned j = 0; j < 16; ++j) { const unsigned c = xb_ld(&bar[XB_XCNT(j)]); sum += c; cnt += (c > 0u) ? 1u : 0u; mine = (j == x) ? c : mine; }
        if (sum == G) break;
        __builtin_amdgcn_s_sleep(1);
        if ((++sp & 255u) == 0u) { if (xb_ld(&bar[XB_TMO])) break; if (sp > XB_SPIN_CAP) { atomicAdd(&bar[XB_TMO], 1u); break; } }
    }
    nloc = mine > 0u ? mine : 1u; nx = cnt > 0u ? cnt : 1u;
}
__device__ __forceinline__ void xcd_barrier(const XcdBarrier& b) {
    asm volatile("s_waitcnt vmcnt(0)" ::: "memory");
    __syncthreads();
    if (threadIdx.x == 0) {
        unsigned* bar = b.bar;
        __builtin_amdgcn_s_waitcnt(0);
        unsigned nloc = b.st[0], nx = b.st[1];
        if (nloc == 0u) { xcd_barrier_complete(bar, b.x, nloc, nx); b.st[0] = nloc; b.st[1] = nx; }
        const unsigned old = xb_add(&bar[XB_XSUB(b.x)], 1u);
        const unsigned gen = old / nloc;
        if (old + 1u == (gen + 1u) * nloc) {
            __builtin_amdgcn_fence(__ATOMIC_RELEASE, "agent");
            asm volatile("s_waitcnt vmcnt(0)" ::: "memory");
            const unsigned og = xb_add(&bar[XB_TOP], 1u);
            const unsigned tg = og / nx;
            if (og + 1u == (tg + 1u) * nx) xb_add(&bar[XB_TOPGEN], 1u);
            else XB_SPIN(xb_ld(&bar[XB_TOPGEN]) == tg, bar);
            __builtin_amdgcn_fence(__ATOMIC_ACQUIRE, "agent");
            xb_add(&bar[XB_XGEN(b.x)], 1u);
            asm volatile("s_waitcnt vmcnt(0)" ::: "memory");
        } else {
            XB_SPIN(xb_ld(&bar[XB_XGEN(b.x)]) == gen, bar);
            __builtin_amdgcn_fence(__ATOMIC_ACQUIRE, "agent");
            asm volatile("s_waitcnt vmcnt(0)" ::: "memory");
        }
    }
    __syncthreads();
}


namespace xat {
typedef short bf16x8 __attribute__((ext_vector_type(8)));
typedef short s16x4 __attribute__((ext_vector_type(4)));
typedef float f32x16 __attribute__((ext_vector_type(16)));
constexpr int RB = 272;
constexpr int KIMG = 0, VIMG = 128 * RB, LDS_BYTES = 2 * 128 * RB;
__device__ __forceinline__ unsigned cvtpk(float lo, float hi) { typedef float f2 __attribute__((ext_vector_type(2))); typedef __bf16 b2 __attribute__((ext_vector_type(2))); f2 v = {lo, hi}; b2 b = __builtin_convertvector(v, b2); return __builtin_bit_cast(unsigned, b); }
__device__ __forceinline__ float swapmax(float m) { auto rr = __builtin_amdgcn_permlane32_swap(__float_as_uint(m), __float_as_uint(m), false, false); return fmaxf(__uint_as_float(rr[0]), __uint_as_float(rr[1])); }
__device__ __forceinline__ float swapadd(float m) { auto rr = __builtin_amdgcn_permlane32_swap(__float_as_uint(m), __float_as_uint(m), false, false); return __uint_as_float(rr[0]) + __uint_as_float(rr[1]); }
__device__ __forceinline__ void unit(int b, int head, int qb, const bf16* QX, const bf16* KX, const bf16* VT, bf16* OX, LAS unsigned char* lds) {
    int tid = threadIdx.x; asm volatile("" : "+v"(tid));
    const int lane = tid & 63, r32 = lane & 31, h = lane >> 5, wid = tid >> 6;
    const size_t qrow = (size_t)b * SEQ + (size_t)qb * 256 + wid * 32 + r32;
    bf16x8 qf[8];
#pragma unroll
    for (int d0 = 0; d0 < 8; ++d0) qf[d0] = *(const bf16x8*)(QX + qrow * 512 + head * 128 + 16 * d0 + 8 * h);
    f32x16 o[4];
#pragma unroll
    for (int db = 0; db < 4; ++db) o[db] = (f32x16){};
    float mrun = -INFINITY, lsum = 0.f;
#pragma unroll 1
    for (int half = 0; half < 2; ++half) {
        __syncthreads();
#pragma unroll
        for (int i = 0; i < 4; ++i) { const int c = tid + 512 * i, row = c >> 4, ch = c & 15;
            const v4u kv = *(const GAS v4u*)(KX + ((size_t)b * NMEM + half * 128 + row) * 512 + head * 128 + ch * 8);
            const v4u vv = *(const GAS v4u*)(VT + ((size_t)head * 128 + row) * 512 + b * NMEM + half * 128 + ch * 8);
            *(LAS v4u*)(lds + KIMG + row * RB + ch * 16) = kv; *(LAS v4u*)(lds + VIMG + row * RB + ch * 16) = vv; }
        __syncthreads();
        f32x16 st[4];
#pragma unroll
        for (int kb = 0; kb < 4; ++kb) { st[kb] = (f32x16){};
#pragma unroll
            for (int d0 = 0; d0 < 8; ++d0) { const bf16x8 a = *(const LAS bf16x8*)(lds + KIMG + (32 * kb + r32) * RB + (16 * d0 + 8 * h) * 2);
                st[kb] = __builtin_amdgcn_mfma_f32_32x32x16_bf16(a, qf[d0], st[kb], 0, 0, 0); } }
        float mloc = st[0][0];
#pragma unroll
        for (int kb = 0; kb < 4; ++kb)
#pragma unroll
            for (int i = 0; i < 16; ++i) mloc = fmaxf(mloc, st[kb][i]);
        const float mnew = fmaxf(mrun, swapmax(mloc)), alpha = __builtin_amdgcn_exp2f(mrun - mnew);
        float psum = 0.f;
#pragma unroll
        for (int kb = 0; kb < 4; ++kb)
#pragma unroll
            for (int i = 0; i < 16; ++i) { st[kb][i] = __builtin_amdgcn_exp2f(st[kb][i] - mnew); psum += st[kb][i]; }
        lsum = lsum * alpha + psum; mrun = mnew;
#pragma unroll
        for (int db = 0; db < 4; ++db)
#pragma unroll
            for (int i = 0; i < 16; ++i) o[db][i] *= alpha;
#pragma unroll
        for (int kb = 0; kb < 4; ++kb)
#pragma unroll
            for (int sp = 0; sp < 2; ++sp) {
                v4u pw; pw.x = cvtpk(st[kb][8 * sp], st[kb][8 * sp + 1]); pw.y = cvtpk(st[kb][8 * sp + 2], st[kb][8 * sp + 3]); pw.z = cvtpk(st[kb][8 * sp + 4], st[kb][8 * sp + 5]); pw.w = cvtpk(st[kb][8 * sp + 6], st[kb][8 * sp + 7]);
                const bf16x8 pb = __builtin_bit_cast(bf16x8, pw);
#pragma unroll
                for (int db = 0; db < 4; ++db) { const LAS unsigned char* vp = lds + VIMG + (32 * db + r32) * RB + (32 * kb + 16 * sp + 4 * h) * 2;
                    const s16x4 lo = *(const LAS s16x4*)vp, hi = *(const LAS s16x4*)(vp + 16);
                    const bf16x8 va = {lo[0], lo[1], lo[2], lo[3], hi[0], hi[1], hi[2], hi[3]};
                    o[db] = __builtin_amdgcn_mfma_f32_32x32x16_bf16(va, pb, o[db], 0, 0, 0); } }
    }
    const float inv = 1.f / swapadd(lsum);
    bf16* orow = OX + qrow * 512 + head * 128;
#pragma unroll
    for (int db = 0; db < 4; ++db)
#pragma unroll
        for (int g = 0; g < 4; ++g) {
            const unsigned long long w = (unsigned long long)cvtpk(o[db][4 * g] * inv, o[db][4 * g + 1] * inv) | ((unsigned long long)cvtpk(o[db][4 * g + 2] * inv, o[db][4 * g + 3] * inv) << 32);
            *(GAS unsigned long long*)(orow + 32 * db + 8 * g + 4 * h) = w; }
}
}


namespace mls {
typedef short bf16x8 __attribute__((ext_vector_type(8)));
typedef short s16x4 __attribute__((ext_vector_type(4)));
typedef float f32x16 __attribute__((ext_vector_type(16)));
constexpr int RB = 128, VIMG = 0, KIMG = 8192, ATAB = 8192, NTAB = 8448;
__device__ __forceinline__ s16x4 trd(const LAS unsigned char* p) { typedef short v4i16_t __attribute__((ext_vector_type(4))); return __builtin_bit_cast(s16x4, __builtin_amdgcn_ds_read_tr16_b64_v4i16((LAS v4i16_t*)p)); }
__device__ __forceinline__ bf16x8 cat8(s16x4 lo, s16x4 hi) { return (bf16x8){lo[0], lo[1], lo[2], lo[3], hi[0], hi[1], hi[2], hi[3]}; }
__device__ __forceinline__ unsigned cvtpk(float lo, float hi) { typedef float f2 __attribute__((ext_vector_type(2))); typedef __bf16 b2 __attribute__((ext_vector_type(2))); f2 v = {lo, hi}; b2 b = __builtin_convertvector(v, b2); return __builtin_bit_cast(unsigned, b); }
__device__ __forceinline__ bf16x8 pack8(const float* f) { v4u w; w.x = cvtpk(f[0], f[1]); w.y = cvtpk(f[2], f[3]); w.z = cvtpk(f[4], f[5]); w.w = cvtpk(f[6], f[7]); return __builtin_bit_cast(bf16x8, w); }
__device__ __forceinline__ float swapadd(float m) { auto rr = __builtin_amdgcn_permlane32_swap(__float_as_uint(m), __float_as_uint(m), false, false); return __uint_as_float(rr[0]) + __uint_as_float(rr[1]); }
__device__ __forceinline__ int crow(int r, int hi) { return (r & 3) + 8 * (r >> 2) + 4 * hi; }

__device__ __forceinline__ void u_unit(const Ptrs& P, int bhk, LAS unsigned char* wl, int lane) {
    const int bh = bhk / NCH, k = bhk % NCH, b = bh / MH, hd = bh % MH; const size_t row0 = (size_t)b * SEQ + (size_t)k * 64;
    const int r32 = lane & 31, h = lane >> 5;
    const float li = WSP(const float, WS_GATE)[(size_t)hd * M + row0 + lane], bl = WSP(const float, WS_BL)[(size_t)bh * SEQ + k * 64 + lane];
    const float wg = __expf(WSP(const float, WS_BT)[bhk] - bl + li - WSP(const float, WS_MS)[bh * (NCH + 1) + k + 1]);
    const bf16* vsrc = WSP(const bf16, R_T0 + SZ_T) + row0 * 512 + hd * 64; const bf16* ksrc = WSP(const bf16, R_MQK) + row0 * 512 + 256 + hd * 64;
#pragma unroll
    for (int i = 0; i < 8; ++i) { const int row = i * 8 + (lane >> 3), ch = lane & 7;
        *(LAS v4u*)(wl + VIMG + row * RB + ch * 16) = *(const GAS v4u*)(vsrc + (size_t)row * 512 + ch * 8);
        const v4u kk = *(const GAS v4u*)(ksrc + (size_t)row * 512 + ch * 8); float f[8]; unpack8(kk, f); const float w = __shfl(wg, row);
#pragma unroll
        for (int e = 0; e < 8; ++e) f[e] *= w;
        *(LAS bf16x8*)(wl + KIMG + row * RB + ch * 16) = pack8(f); }
    f32x16 acc[2][2];
#pragma unroll
    for (int a = 0; a < 2; ++a)
#pragma unroll
        for (int c = 0; c < 2; ++c) acc[a][c] = (f32x16){};
    const unsigned toff = (unsigned)(((lane & 15) >> 2) * RB + (16 * ((lane >> 4) & 1) + 4 * (lane & 3)) * 2);
#pragma unroll
    for (int st = 0; st < 4; ++st) { bf16x8 af[2], bf_[2];
#pragma unroll
        for (int c = 0; c < 2; ++c) { const LAS unsigned char* pv = wl + VIMG + (16 * st + 8 * h) * RB + toff + 64 * c; af[c] = cat8(trd(pv), trd(pv + 4 * RB));
                                      const LAS unsigned char* pk = wl + KIMG + (16 * st + 8 * h) * RB + toff + 64 * c; bf_[c] = cat8(trd(pk), trd(pk + 4 * RB)); }
#pragma unroll
        for (int jb = 0; jb < 2; ++jb)
#pragma unroll
            for (int ib = 0; ib < 2; ++ib) acc[jb][ib] = __builtin_amdgcn_mfma_f32_32x32x16_bf16(af[jb], bf_[ib], acc[jb][ib], 0, 0, 0); }
    float* UT = WSP(float, R_CST) + (size_t)bhk * 4096;
#pragma unroll
    for (int jb = 0; jb < 2; ++jb)
#pragma unroll
        for (int ib = 0; ib < 2; ++ib)
#pragma unroll
            for (int e = 0; e < 16; ++e) UT[(32 * jb + crow(e, h)) * 64 + 32 * ib + r32] = acc[jb][ib][e];
    float sn = 0.f;
#pragma unroll 8
    for (int r = 0; r < 64; ++r) sn += bf2f(*(const LAS bf16*)(wl + KIMG + r * RB + lane * 2));
    WSP(float, WS_NST)[(size_t)bhk * 64 + lane] = sn;
}

__device__ __forceinline__ void decay_apply(f32x16& tile, int sb, int tb, const LAS float* atab, float mx, float& dsum, int r32, int h) {
#pragma unroll
    for (int g = 0; g < 4; ++g) { const f32x4 av = *(const LAS f32x4*)(atab + 32 * sb + 8 * g + 4 * h);
#pragma unroll
        for (int c = 0; c < 4; ++c) { const int sidx = 32 * sb + 8 * g + 4 * h + c, t = 32 * tb + r32;
            const float w = (sidx <= t) ? __expf(av[c] - mx) : 0.f; tile[4 * g + c] *= w; dsum += tile[4 * g + c]; } }
}
__device__ __forceinline__ bf16x8 packstep(const f32x16& x, int st) { v4u w; w.x = cvtpk(x[8 * st], x[8 * st + 1]); w.y = cvtpk(x[8 * st + 2], x[8 * st + 3]); w.z = cvtpk(x[8 * st + 4], x[8 * st + 5]); w.w = cvtpk(x[8 * st + 6], x[8 * st + 7]); return __builtin_bit_cast(bf16x8, w); }

__device__ __forceinline__ void out_unit(const Ptrs& P, int l, int bhk, LAS unsigned char* wl, int lane) {
    const int bh = bhk / NCH, k = bhk % NCH, b = bh / MH, hd = bh % MH; const size_t row0 = (size_t)b * SEQ + (size_t)k * 64;
    const int r32 = lane & 31, h = lane >> 5;
    const bf16* T1 = WSP(const bf16, R_T0 + SZ_T); const bf16* MQK = WSP(const bf16, R_MQK);
    const bf16* vsrc = T1 + row0 * 512 + hd * 64;
    v4u vreg[8];
#pragma unroll
    for (int i = 0; i < 8; ++i) { const int row = i * 8 + (lane >> 3), ch = lane & 7; vreg[i] = *(const GAS v4u*)(vsrc + (size_t)row * 512 + ch * 8); }
    bf16x8 qf[2][4], kf[2][4];
#pragma unroll
    for (int tb = 0; tb < 2; ++tb)
#pragma unroll
        for (int d0 = 0; d0 < 4; ++d0) { qf[tb][d0] = *(const bf16x8*)(MQK + (row0 + 32 * tb + r32) * 512 + hd * 64 + 16 * d0 + 8 * h);
                                         kf[tb][d0] = *(const bf16x8*)(MQK + (row0 + 32 * tb + r32) * 512 + 256 + hd * 64 + 16 * d0 + 8 * h); }
    const float li_s = WSP(const float, WS_GATE)[(size_t)hd * M + row0 + lane], bl_s = WSP(const float, WS_BL)[(size_t)bh * SEQ + k * 64 + lane];
    const float mk = WSP(const float, WS_MS)[bh * (NCH + 1) + k]; const float nst = WSP(const float, WS_NST)[(size_t)bhk * 64 + lane];
    const float a_s = li_s - bl_s; float pm = a_s;
#pragma unroll
    for (int o = 1; o < 64; o <<= 1) { const float t = __shfl_up(pm, o); if (lane >= o) pm = fmaxf(pm, t); }
    LAS float* atab = (LAS float*)(wl + ATAB); LAS float* ntab = (LAS float*)(wl + NTAB);
    atab[lane] = a_s; ntab[lane] = nst;
    float mx[2], wi[2], blt[2];
#pragma unroll
    for (int tb = 0; tb < 2; ++tb) { const int t = 32 * tb + r32; blt[tb] = __shfl(bl_s, t); mx[tb] = fmaxf(mk, __shfl(pm, t)); wi[tb] = __expf(mk - mx[tb]); }
#pragma unroll
    for (int i = 0; i < 8; ++i) { const int row = i * 8 + (lane >> 3), ch = lane & 7; *(LAS v4u*)(wl + VIMG + row * RB + ch * 16) = vreg[i]; }
    f32x16 s00 = (f32x16){}, s01 = (f32x16){}, s11 = (f32x16){};
#pragma unroll
    for (int d0 = 0; d0 < 4; ++d0) { s00 = __builtin_amdgcn_mfma_f32_32x32x16_bf16(kf[0][d0], qf[0][d0], s00, 0, 0, 0);
        s01 = __builtin_amdgcn_mfma_f32_32x32x16_bf16(kf[0][d0], qf[1][d0], s01, 0, 0, 0); s11 = __builtin_amdgcn_mfma_f32_32x32x16_bf16(kf[1][d0], qf[1][d0], s11, 0, 0, 0); }
    float dsum[2] = {0.f, 0.f};
    decay_apply(s00, 0, 0, atab, mx[0], dsum[0], r32, h); decay_apply(s01, 0, 1, atab, mx[1], dsum[1], r32, h); decay_apply(s11, 1, 1, atab, mx[1], dsum[1], r32, h);
    f32x16 nacc[2][2];
#pragma unroll
    for (int a = 0; a < 2; ++a)
#pragma unroll
        for (int c = 0; c < 2; ++c) nacc[a][c] = (f32x16){};
    const unsigned toff = (unsigned)(((lane & 15) >> 2) * RB + (16 * ((lane >> 4) & 1) + 4 * (lane & 3)) * 2);
#pragma unroll
    for (int sb = 0; sb < 2; ++sb)
#pragma unroll
        for (int st = 0; st < 2; ++st) { bf16x8 va[2];
#pragma unroll
            for (int jb = 0; jb < 2; ++jb) { const LAS unsigned char* pv = wl + VIMG + (32 * sb + 16 * st + 4 * h) * RB + toff + 64 * jb; va[jb] = cat8(trd(pv), trd(pv + 8 * RB)); }
            if (sb == 0) { const bf16x8 p0 = packstep(s00, st), p1 = packstep(s01, st);
#pragma unroll
                for (int jb = 0; jb < 2; ++jb) { nacc[jb][0] = __builtin_amdgcn_mfma_f32_32x32x16_bf16(va[jb], p0, nacc[jb][0], 0, 0, 0); nacc[jb][1] = __builtin_amdgcn_mfma_f32_32x32x16_bf16(va[jb], p1, nacc[jb][1], 0, 0, 0); }
            } else { const bf16x8 p1 = packstep(s11, st);
#pragma unroll
                for (int jb = 0; jb < 2; ++jb) nacc[jb][1] = __builtin_amdgcn_mfma_f32_32x32x16_bf16(va[jb], p1, nacc[jb][1], 0, 0, 0); } }
    const float* CT = WSP(const float, R_CST) + (size_t)bhk * 4096;
    float dint[2] = {0.f, 0.f};
#pragma unroll
    for (int st = 0; st < 4; ++st) { bf16x8 ca[2];
#pragma unroll
        for (int jb = 0; jb < 2; ++jb) { const float* cp = CT + (32 * jb + r32) * 64 + 16 * st + 8 * h; const f32x4 c0 = *(const f32x4*)cp, c1 = *(const f32x4*)(cp + 4);
            const float f[8] = {c0[0], c0[1], c0[2], c0[3], c1[0], c1[1], c1[2], c1[3]}; ca[jb] = pack8(f); }
        const f32x4 n0 = *(const LAS f32x4*)(ntab + 16 * st + 8 * h), n1 = *(const LAS f32x4*)(ntab + 16 * st + 8 * h + 4);
#pragma unroll
        for (int tb = 0; tb < 2; ++tb) { float f[8]; unpack8(__builtin_bit_cast(v4u, qf[tb][st]), f);
            dint[tb] += (f[0] * n0[0] + f[1] * n0[1]) + (f[2] * n0[2] + f[3] * n0[3]) + (f[4] * n1[0] + f[5] * n1[1]) + (f[6] * n1[2] + f[7] * n1[3]);
#pragma unroll
            for (int e = 0; e < 8; ++e) f[e] *= wi[tb];
            const bf16x8 qw = pack8(f);
#pragma unroll
            for (int jb = 0; jb < 2; ++jb) nacc[jb][tb] = __builtin_amdgcn_mfma_f32_32x32x16_bf16(ca[jb], qw, nacc[jb][tb], 0, 0, 0); } }
    const float* nw = P.in[I_MNW] + l * 256 + hd * 64; bf16* CAT = WSP(bf16, R_CAT);
#pragma unroll
    for (int tb = 0; tb < 2; ++tb) {
        const float den = swapadd(dsum[tb]) + wi[tb] * swapadd(dint[tb]);
        const float dinv = 1.f / fmaxf(fabsf(den), __expf(-(blt[tb] + mx[tb])));
        float ss = 0.f;
#pragma unroll
        for (int jb = 0; jb < 2; ++jb)
#pragma unroll
            for (int e = 0; e < 16; ++e) { const float v = nacc[jb][tb][e] * dinv; ss += v * v; }
        const float scale = dinv / sqrtf(swapadd(ss) * (1.f / 64.f) + EPS);
        const size_t row = row0 + 32 * tb + r32;
#pragma unroll
        for (int jb = 0; jb < 2; ++jb)
#pragma unroll
            for (int g = 0; g < 4; ++g) { const int j0 = 32 * jb + 8 * g + 4 * h; const f32x4 nwv = *(const f32x4*)(nw + j0);
                const unsigned long long mo = *(const GAS unsigned long long*)(T1 + row * 512 + 256 + hd * 64 + j0);
                const float m0 = __uint_as_float((unsigned)(mo << 16)), m1 = __uint_as_float((unsigned)mo & 0xffff0000u), m2 = __uint_as_float((unsigned)(mo >> 32) << 16), m3 = __uint_as_float((unsigned)(mo >> 32) & 0xffff0000u);
                const float y0 = nacc[jb][tb][4 * g] * scale * nwv[0] * __builtin_amdgcn_rcpf(1.f + __expf(-m0)), y1 = nacc[jb][tb][4 * g + 1] * scale * nwv[1] * __builtin_amdgcn_rcpf(1.f + __expf(-m1));
                const float y2 = nacc[jb][tb][4 * g + 2] * scale * nwv[2] * __builtin_amdgcn_rcpf(1.f + __expf(-m2)), y3 = nacc[jb][tb][4 * g + 3] * scale * nwv[3] * __builtin_amdgcn_rcpf(1.f + __expf(-m3));
                *(GAS unsigned long long*)(CAT + row * 1024 + hd * 64 + j0) = (unsigned long long)cvtpk(y0, y1) | ((unsigned long long)cvtpk(y2, y3) << 32); }
    }
}
__device__ __forceinline__ void state_scan(const Ptrs& P, long gtid, long gn) {
    const float* DEC = WSP(const float, WS_DEC); float* CST = WSP(float, R_CST); float* NST = WSP(float, WS_NST);
    for (long it = gtid; it < 8 * 4160; it += gn) {
        const int bh = (int)it / 4160, e = (int)it % 4160; float run = 0.f;
        float* base = e < 4096 ? CST + (size_t)bh * NCH * 4096 + e : NST + (size_t)bh * NCH * 64 + (e - 4096); const size_t stride = e < 4096 ? 4096 : 64;
        for (int k0 = 0; k0 < NCH; k0 += 16) { float u[16], d[16];
#pragma unroll
            for (int i = 0; i < 16; ++i) { u[i] = base[(size_t)(k0 + i) * stride]; d[i] = DEC[bh * NCH + k0 + i]; }
#pragma unroll
            for (int i = 0; i < 16; ++i) { base[(size_t)(k0 + i) * stride] = run; run = d[i] * run + u[i]; } }
    }
}
}

constexpr int RING_BYTES = 131072;
constexpr int MISC_OFF = RING_BYTES;
constexpr int PTR_OFF = RING_BYTES + 256;
constexpr int JOB_OFF = RING_BYTES + 512;
constexpr int LDS_BYTES = 147456;
constexpr int NWAVES = 8;

__device__ __forceinline__ float wave_sum(float v) {
#pragma unroll
    for (int o = 1; o < 64; o <<= 1) v += __shfl_xor(v, o);
    return v;
}
struct WJob { const float* W0; const float* W1; const float* rs; bf16* WT; int K, Nsrc, nblk, kind; float cs; int item0; int pad0, pad1; };
constexpr int MAX_JOBS = 32;
__device__ __forceinline__ void p0_transpose_item(const LAS WJob* jb, LAS float* scr, int item, int lane) {
    const int K = jb->K, N = jb->Nsrc, nblk = jb->nblk, kb = item / nblk, nb = item % nblk, k0 = 64 * kb;
    int which, col0; float cs; wmap(jb->kind, nb, which, col0, cs); cs *= jb->cs;
    const float* W = which ? jb->W1 : jb->W0; const float* rs = jb->rs;
    const float* src = W + (size_t)(k0 + (lane >> 5)) * N + col0 + (lane & 31);
    float v[32];
#pragma unroll
    for (int i = 0; i < 32; ++i) v[i] = __builtin_nontemporal_load(src + (size_t)(2 * i) * N);
#pragma unroll
    for (int i = 0; i < 32; ++i) scr[(2 * i + (lane >> 5)) * 33 + (lane & 31)] = v[i];
    LDS_WAIT(); asm volatile("" ::: "memory");
    const int c = lane & 7; bf16* WT = jb->WT;
    f32x4 r0 = {cs, cs, cs, cs}, r1 = r0;
    if (rs) { r0 = *(const f32x4*)(rs + k0 + 8 * c) * cs; r1 = *(const f32x4*)(rs + k0 + 8 * c + 4) * cs; }
#pragma unroll
    for (int j = 0; j < 4; ++j) { const int n = (lane >> 3) + 8 * j; const LAS float* sp = scr + (8 * c) * 33 + n;
        if (jb->pad0) {
            const float q_ = (float)jb->pad0;
            int p0 = __builtin_amdgcn_cvt_pk_fp8_f32(sp[0 * 33] * r0[0] * q_, sp[1 * 33] * r0[1] * q_, 0, false); p0 = __builtin_amdgcn_cvt_pk_fp8_f32(sp[2 * 33] * r0[2] * q_, sp[3 * 33] * r0[3] * q_, p0, true);
            int p1 = __builtin_amdgcn_cvt_pk_fp8_f32(sp[4 * 33] * r1[0] * q_, sp[5 * 33] * r1[1] * q_, 0, false); p1 = __builtin_amdgcn_cvt_pk_fp8_f32(sp[6 * 33] * r1[2] * q_, sp[7 * 33] * r1[3] * q_, p1, true);
            typedef unsigned v2u_ __attribute__((ext_vector_type(2)));
            __builtin_nontemporal_store((v2u_){(unsigned)p0, (unsigned)p1}, (GAS v2u_*)((unsigned char*)WT + (size_t)(nb * 32 + n) * K + k0 + 8 * c));
            continue; }
        v4u o; o.x = pk2(sp[0 * 33] * r0[0], sp[1 * 33] * r0[1]); o.y = pk2(sp[2 * 33] * r0[2], sp[3 * 33] * r0[3]); o.z = pk2(sp[4 * 33] * r1[0], sp[5 * 33] * r1[1]); o.w = pk2(sp[6 * 33] * r1[2], sp[7 * 33] * r1[3]);
        __builtin_nontemporal_store(o, (GAS v4u*)(WT + (size_t)(nb * 32 + n) * K + k0 + 8 * c)); }
    LDS_WAIT(); asm volatile("" ::: "memory");
}
__device__ __forceinline__ void build_gw(const Ptrs& P, long gtid, long gn) {
    for (long it = gtid; it < 3 * 32 * 64; it += gn) {
        const int t = (int)(it / 2048), ks = (int)((it / 64) % 32), ln = (int)(it % 64), c = ln & 15, quad = ln >> 4;
        float hi[8], lo[8];
#pragma unroll
        for (int j = 0; j < 8; ++j) { const int k = 32 * ks + 8 * quad + j; float w;
            if (t < 2) w = P.in[I_NMIX][t * D + k] * P.in[I_WIN][(size_t)t * D * INW + (size_t)k * INW + (c < 8 ? 1024 + c : 3072 + c)];
            else w = (c < 8) ? P.in[I_NFFN][D + k] * P.in[I_RW][(size_t)k * 8 + c] : 0.f;
            const float h = bf2f(f2bf(w)); hi[j] = h; lo[j] = w - h; }
        v4u oh, ol; oh.x = pk2(hi[0], hi[1]); oh.y = pk2(hi[2], hi[3]); oh.z = pk2(hi[4], hi[5]); oh.w = pk2(hi[6], hi[7]); ol.x = pk2(lo[0], lo[1]); ol.y = pk2(lo[2], lo[3]); ol.z = pk2(lo[4], lo[5]); ol.w = pk2(lo[6], lo[7]);
        v4u* tab = (v4u*)(P.ws + WS_GW + (size_t)t * 65536); tab[(ks * 2 + 0) * 64 + ln] = oh; tab[(ks * 2 + 1) * 64 + ln] = ol;
    }
}
template <int MODE, bool PRE>
__device__ __forceinline__ void norm16(const Ptrs& P, int l, const float* src, bf16* XN, const unsigned* rss_in, int vcu, int G, int wave, int lane, LAS float* xch) {
    typedef short bf16x8 __attribute__((ext_vector_type(8)));
    const int r = lane & 15, quad = lane >> 4, kh = wave >> 2;
    const v4u* tab = (const v4u*)(P.ws + WS_GW + (size_t)(MODE == 2 ? 2 : l) * 65536) + lane;
    if constexpr (MODE == 2) { if (wave == 0 && lane < 8) ((LAS unsigned*)(xch + 2048))[64 * 4 + lane] = 0u; }
    for (int t0 = 0; t0 < M / 16; t0 += 4 * G) {
        const int task = t0 + (wave & 3) * G + vcu; const bool live = task < M / 16; const int r0 = (live ? task : 0) * 16;
        const float* xr = src + (size_t)(r0 + r) * D + 8 * quad; bf16* xo = XN + (size_t)(r0 + r) * D + 8 * quad;
        f32x4 acc = {0.f, 0.f, 0.f, 0.f}; float ss = 0.f;
#pragma unroll
        for (int kk = 0; kk < 16; ++kk) { const int ks = 16 * kh + kk;
            if constexpr (PRE) {
                const v4u h = *(const GAS v4u*)(xo + 32 * ks);
                const bf16x8 ah = __builtin_bit_cast(bf16x8, h);
                const bf16x8 bh = __builtin_bit_cast(bf16x8, tab[(ks * 2 + 0) * 64]), bl = __builtin_bit_cast(bf16x8, tab[(ks * 2 + 1) * 64]);
                acc = __builtin_amdgcn_mfma_f32_16x16x32_bf16(ah, bh, acc, 0, 0, 0); acc = __builtin_amdgcn_mfma_f32_16x16x32_bf16(ah, bl, acc, 0, 0, 0);
            } else {
            const f32x4 a = __builtin_nontemporal_load((const GAS f32x4*)(xr + 32 * ks)), b = __builtin_nontemporal_load((const GAS f32x4*)(xr + 32 * ks + 4));
            ss += (a[0] * a[0] + a[1] * a[1]) + (a[2] * a[2] + a[3] * a[3]) + (b[0] * b[0] + b[1] * b[1]) + (b[2] * b[2] + b[3] * b[3]);
            v4u h; h.x = pk2(a[0], a[1]); h.y = pk2(a[2], a[3]); h.z = pk2(b[0], b[1]); h.w = pk2(b[2], b[3]);
            if (live) *(GAS v4u*)(xo + 32 * ks) = h;
            if constexpr (MODE != 0) {
                float hf[8]; unpack8(h, hf);
                v4u lw; lw.x = pk2(a[0] - hf[0], a[1] - hf[1]); lw.y = pk2(a[2] - hf[2], a[3] - hf[3]); lw.z = pk2(b[0] - hf[4], b[1] - hf[5]); lw.w = pk2(b[2] - hf[6], b[3] - hf[7]);
                const bf16x8 ah = __builtin_bit_cast(bf16x8, h), al = __builtin_bit_cast(bf16x8, lw);
                const bf16x8 bh = __builtin_bit_cast(bf16x8, tab[(ks * 2 + 0) * 64]), bl = __builtin_bit_cast(bf16x8, tab[(ks * 2 + 1) * 64]);
                acc = __builtin_amdgcn_mfma_f32_16x16x32_bf16(ah, bh, acc, 0, 0, 0); acc = __builtin_amdgcn_mfma_f32_16x16x32_bf16(al, bh, acc, 0, 0, 0); acc = __builtin_amdgcn_mfma_f32_16x16x32_bf16(ah, bl, acc, 0, 0, 0);
            }
            }
        }
        { LAS float* xp = xch + ((wave & 3) * 64 + lane) * 5;
          if (kh == 1) { xp[0] = acc[0]; xp[1] = acc[1]; xp[2] = acc[2]; xp[3] = acc[3]; xp[4] = ss; }
          __syncthreads();
          if (kh == 0) { acc[0] += xp[0]; acc[1] += xp[1]; acc[2] += xp[2]; acc[3] += xp[3]; ss += xp[4]; }
          __syncthreads(); }
        if constexpr (MODE != 2) { if (kh == 1 || !live) continue; }
        if (MODE != 2 || (kh == 0 && live)) {
        unsigned sq;
        if constexpr (PRE) sq = rss_in[r0 + r]; else { ss += __shfl_xor(ss, 16); ss += __shfl_xor(ss, 32); sq = (unsigned)(ss * 16.f + 0.5f); if (lane < 16) WSP(unsigned, WS_RSTD)[r0 + lane] = sq; }
        ss = (float)sq * (1.f / 16.f);
        const float rstd = 1.f / sqrtf(ss * (1.f / D) + EPS);
        if constexpr (MODE != 0) {
            float z[4];
#pragma unroll
            for (int j = 0; j < 4; ++j) z[j] = acc[j] * __shfl(rstd, 4 * quad + j);
            if constexpr (MODE == 1) {
                const int g = r; f32x4 o;
#pragma unroll
                for (int j = 0; j < 4; ++j) { if (g < 4) o[j] = z[j] + P.in[I_MBI][l * 4 + g]; else if (g < 8) o[j] = logsigmoidf_(z[j] + P.in[I_MBF][l * 4 + g - 4]); else o[j] = logsigmoidf_(z[j] + P.in[I_FBF][l * 8 + g - 8]); }
                *(f32x4*)(WSP(float, WS_GATE) + (size_t)g * M + r0 + 4 * quad) = o;
            } else {
#pragma unroll
                for (int j = 0; j < 4; ++j) { float le[8];
#pragma unroll
                    for (int e = 0; e < 8; ++e) le[e] = __shfl(z[j], (lane & 48) + e);
                    int e1 = 0; float v1 = le[0];
#pragma unroll
                    for (int e = 1; e < 8; ++e) if (le[e] > v1) { v1 = le[e]; e1 = e; }
                    int e2 = -1; float v2 = -INFINITY;
#pragma unroll
                    for (int e = 0; e < 8; ++e) if (e != e1 && le[e] > v2) { v2 = le[e]; e2 = e; }
                    if (r == j) { const float g2 = 1.f / (1.f + expf(v1 - v2)), g1 = 1.f - g2;
                        LAS unsigned* sp = (LAS unsigned*)(xch + 2048) + ((wave & 3) * 16 + 4 * quad + j) * 4;
                        sp[0] = (unsigned)e1; sp[1] = (unsigned)e2; sp[2] = __float_as_uint(g1); sp[3] = __float_as_uint(g2); }
                }
            }
        }
        }
        if constexpr (MODE == 2) {
            LAS unsigned* selb = (LAS unsigned*)(xch + 2048); LAS unsigned* hacc = selb + 64 * 4;
            if (!(kh == 0 && live) && wave < 4 && r < 4) selb[((wave & 3) * 16 + 4 * quad + r) * 4] = 255u;
            __syncthreads();
            if (wave == 0) {
                const int w = lane >> 4, e1 = (int)selb[lane * 4], e2 = (int)selb[lane * 4 + 1]; const bool valid = e1 < 8;
                const unsigned long long below = (1ull << lane) - 1ull; int rank1 = 0, rank2 = 0; unsigned mynew = 0u;
#pragma unroll
                for (int e = 0; e < 8; ++e) { const unsigned old_ = hacc[e];
                    const unsigned long long m1 = __ballot(valid && e1 == e), m2 = __ballot(valid && e2 == e); const int c1 = __popcll(m1);
                    if (e1 == e) rank1 = (int)old_ + __popcll(m1 & below);
                    if (e2 == e) rank2 = (int)old_ + c1 + __popcll(m2 & below);
                    if (lane == e) mynew = old_ + (unsigned)(c1 + __popcll(m2)); }
                if (valid) { const int row = (t0 + w * G + vcu) * 16 + (lane & 15); unsigned* tk = WSP(unsigned, WS_TOK) + (size_t)row * 8;
                    tk[0] = (unsigned)e1; tk[1] = (unsigned)rank1; tk[2] = (unsigned)e2; tk[3] = (unsigned)rank2; tk[4] = selb[lane * 4 + 2]; tk[5] = selb[lane * 4 + 3]; }
                if (lane < 8) hacc[lane] = mynew;
            }
            __syncthreads();
        }
    }
    if constexpr (MODE == 2) { if (wave == 0 && lane < 8) WSP(unsigned, WS_BH)[vcu * 8 + lane] = ((LAS unsigned*)(xch + 2048))[64 * 4 + lane]; }
}
template <int MODE>
__device__ __forceinline__ void norm_rows(const Ptrs& P, int l, const float* src, bf16* XN, int nrows, int gw, int ngw, int lane) {
    for (int row = gw; row < nrows; row += ngw) {
        const GAS f32x4* xr = (const GAS f32x4*)(src + (size_t)row * D) + lane;
        f32x4 v[4]; float s2 = 0.f;
#pragma unroll
        for (int j = 0; j < 4; ++j) { v[j] = xr[64 * j]; s2 += (v[j].x * v[j].x + v[j].y * v[j].y) + (v[j].z * v[j].z + v[j].w * v[j].w); }
        const float rstd = 1.f / sqrtf(wave_sum(s2) * (1.f / D) + EPS);
        GAS unsigned long long* o8 = (GAS unsigned long long*)(XN + (size_t)row * D) + lane;
#pragma unroll
        for (int j = 0; j < 4; ++j) o8[64 * j] = (unsigned long long)pk2(v[j].x * rstd, v[j].y * rstd) | ((unsigned long long)pk2(v[j].z * rstd, v[j].w * rstd) << 32);
    }
}

__device__ __forceinline__ float wave_incl_scan(float v, int lane) {
#pragma unroll
    for (int o = 1; o < 64; o <<= 1) { const float t = __shfl_up(v, o); if (lane >= o) v += t; }
    return v;
}
__device__ __forceinline__ float wave_max(float v) {
#pragma unroll
    for (int o = 1; o < 64; o <<= 1) v = fmaxf(v, __shfl_xor(v, o));
    return v;
}
__device__ __forceinline__ void gate_scan_task(const Ptrs& P, int task, LAS float* scr, int tid) {
    const int lane = tid & 63, wave = tid >> 6; const float* GT = WSP(const float, WS_GATE);
    if (task < 16) {
        const int b = task / FH, h = task % FH; constexpr int EPT = SEQ / 512;
        const float* src = GT + (size_t)(8 + h) * M + (size_t)b * SEQ + tid * EPT; float* dst = WSP(float, WS_CF) + (size_t)task * SEQ + tid * EPT;
        float v[EPT]; float run = 0.f;
#pragma unroll
        for (int i = 0; i < EPT; i += 4) { const f32x4 x = *(const f32x4*)(src + i); run += x[0]; v[i] = run; run += x[1]; v[i + 1] = run; run += x[2]; v[i + 2] = run; run += x[3]; v[i + 3] = run; }
        const float wincl = wave_incl_scan(run, lane);
        if (lane == 63) scr[wave] = wincl;
        __syncthreads();
        float offs = wincl - run;
#pragma unroll
        for (int w = 0; w < 8; ++w) if (w < wave) offs += scr[w];
#pragma unroll
        for (int i = 0; i < EPT; i += 4) *(f32x4*)(dst + i) = (f32x4){(offs + v[i]) * LOG2E, (offs + v[i + 1]) * LOG2E, (offs + v[i + 2]) * LOG2E, (offs + v[i + 3]) * LOG2E};
        __syncthreads();
    } else {
        const int bh = task - 16, b = bh / MH, h = bh % MH;
        const float* lfp = GT + (size_t)(4 + h) * M + (size_t)b * SEQ; const float* lip = GT + (size_t)h * M + (size_t)b * SEQ;
        float* BL = WSP(float, WS_BL) + (size_t)bh * SEQ; float* BT = WSP(float, WS_BT) + bh * NCH; float* AK = WSP(float, WS_AK) + bh * NCH; float* MS = WSP(float, WS_MS) + bh * (NCH + 1);
        constexpr int CPW = NCH / 8;
        float lfv[CPW], liv[CPW];
#pragma unroll
        for (int i = 0; i < CPW; ++i) { const int k = wave + 8 * i; lfv[i] = lfp[k * 64 + lane]; liv[i] = lip[k * 64 + lane]; }
#pragma unroll
        for (int i = 0; i < CPW; ++i) { const int k = wave + 8 * i;
            const float bl = wave_incl_scan(lfv[i], lane); BL[k * 64 + lane] = bl;
            const float btot = __shfl(bl, 63); const float a = wave_max(btot - bl + liv[i]);
            if (lane == 0) { BT[k] = btot; AK[k] = a; scr[k] = btot; scr[NCH + k] = a; } }
        __syncthreads();
        if (wave == 0) { float* DEC = WSP(float, WS_DEC) + bh * NCH; constexpr int PL = NCH / 64;
            float f[PL], av[PL]; float run = 0.f;
#pragma unroll
            for (int i = 0; i < PL; ++i) { run += scr[lane * PL + i]; f[i] = run; av[i] = scr[NCH + lane * PL + i]; }
            const float offs = wave_incl_scan(run, lane) - run;
            float pm = -INFINITY; float c[PL];
#pragma unroll
            for (int i = 0; i < PL; ++i) { f[i] += offs; pm = fmaxf(pm, av[i] - f[i]); c[i] = pm; }
            float pin = pm;
#pragma unroll
            for (int o = 1; o < 64; o <<= 1) { const float t = __shfl_up(pin, o); if (lane >= o) pin = fmaxf(pin, t); }
            float pex = __shfl_up(pin, 1); if (lane == 0) pex = -INFINITY;
            float mprev = __shfl_up(fmaxf(0.f, pin) + f[PL - 1], 1); if (lane == 0) mprev = 0.f;
            if (lane == 0) MS[0] = 0.f;
#pragma unroll
            for (int i = 0; i < PL; ++i) { const int k = lane * PL + i; const float mn = f[i] + fmaxf(0.f, fmaxf(pex, c[i]));
                MS[k + 1] = mn; DEC[k] = __expf(scr[k] + mprev - mn); mprev = mn; } }
        __syncthreads();
    }
}
__device__ __forceinline__ void mconv_glu_vec(const Ptrs& P, int l, long gtid, long gn) {
    const bf16* T0 = WSP(const bf16, R_T0); bf16* MQK = WSP(bf16, R_MQK);
    const float* cw = P.in[I_MCW] + l * 4 * 512; const float* cb = P.in[I_MCB] + l * 512;
    for (long it0 = gtid; it0 < (long)M * 64; it0 += 4 * gn) {
        v4u w[4][4]; bool ok[4][4];
#pragma unroll
        for (int r = 0; r < 4; ++r) { const long it = it0 + r * gn; const int ch = (int)(it & 63); const long row = it >> 6; const int t = (int)(row % SEQ), c0 = ch * 8;
#pragma unroll
            for (int j = 0; j < 4; ++j) { ok[r][j] = it < (long)M * 64 && t - 3 + j >= 0; w[r][j] = (v4u){0u, 0u, 0u, 0u}; if (ok[r][j]) w[r][j] = *(const GAS v4u*)(T0 + (size_t)(row - 3 + j) * 512 + c0); } }
#pragma unroll
        for (int r = 0; r < 4; ++r) { const long it = it0 + r * gn; if (it >= (long)M * 64) continue; const int ch = (int)(it & 63); const long row = it >> 6; const int c0 = ch * 8;
            float acc[8];
#pragma unroll
            for (int i = 0; i < 8; ++i) acc[i] = cb[c0 + i];
#pragma unroll
            for (int j = 0; j < 4; ++j) { if (ok[r][j]) { float x[8]; unpack8(w[r][j], x);
#pragma unroll
                    for (int i = 0; i < 8; ++i) acc[i] += cw[j * 512 + c0 + i] * x[i]; } }
            const float sc = (c0 >= 256) ? 0.125f : 1.f; float y[8];
#pragma unroll
            for (int i = 0; i < 8; ++i) y[i] = acc[i] * __builtin_amdgcn_rcpf(1.f + __expf(-acc[i])) * sc;
            v4u o; o.x = pk2(y[0], y[1]); o.y = pk2(y[2], y[3]); o.z = pk2(y[4], y[5]); o.w = pk2(y[6], y[7]);
            *(GAS v4u*)(MQK + (size_t)row * 512 + c0) = o; }
    }
    const bf16* T2 = WSP(const bf16, R_T0 + 2 * SZ_T); bf16* GL = WSP(bf16, R_GL);
    for (long it0 = gtid; it0 < (long)M * 32; it0 += 4 * gn) {
        v4u wa[4], wg[4];
#pragma unroll
        for (int r = 0; r < 4; ++r) { const long it = it0 + r * gn; wa[r] = (v4u){0u, 0u, 0u, 0u}; wg[r] = wa[r];
            if (it < (long)M * 32) { const int c0 = (int)(it & 31) * 8; const long row = it >> 5; wa[r] = *(const GAS v4u*)(T2 + (size_t)row * 512 + c0); wg[r] = *(const GAS v4u*)(T2 + (size_t)row * 512 + 256 + c0); } }
#pragma unroll
        for (int r = 0; r < 4; ++r) { const long it = it0 + r * gn; if (it >= (long)M * 32) continue; const int c0 = (int)(it & 31) * 8; const long row = it >> 5;
            float a[8], g[8]; unpack8(wa[r], a); unpack8(wg[r], g); float y[8];
#pragma unroll
            for (int i = 0; i < 8; ++i) y[i] = a[i] * __builtin_amdgcn_rcpf(1.f + __expf(-g[i]));
            v4u o; o.x = pk2(y[0], y[1]); o.y = pk2(y[2], y[3]); o.z = pk2(y[4], y[5]); o.w = pk2(y[6], y[7]);
            *(GAS v4u*)(GL + (size_t)row * 256 + c0) = o; }
    }
}
__device__ __forceinline__ void cconv_ln_rows(const Ptrs& P, int l, int gw, int ngw, int lane) {
    const bf16* GL = WSP(const bf16, R_GL); bf16* CAT = WSP(bf16, R_CAT);
    const float* cw = P.in[I_CCW] + l * CK * 256 + 4 * lane; const int c0 = 4 * lane;
    const f32x4 cb = *(const f32x4*)(P.in[I_CCB] + l * 256 + c0), lw = *(const f32x4*)(P.in[I_CLW] + l * 256 + c0), lb = *(const f32x4*)(P.in[I_CLB] + l * 256 + c0);
    f32x4 w[CK];
#pragma unroll
    for (int j = 0; j < CK; ++j) w[j] = *(const f32x4*)(cw + j * 256);
    for (int task = gw; task < M / 8; task += ngw) {
        const int r0 = task * 8, t0 = r0 % SEQ;
        unsigned long long x[CK + 7];
#pragma unroll
        for (int i = 0; i < CK + 7; ++i) x[i] = (t0 - (CK - 1) + i >= 0) ? *(const GAS unsigned long long*)(GL + (size_t)(r0 - (CK - 1) + i) * 256 + c0) : 0ull;
        f32x4 acc[8];
#pragma unroll
        for (int o = 0; o < 8; ++o) acc[o] = cb;
#pragma unroll
        for (int i = 0; i < CK + 7; ++i) { const unsigned long long q = x[i];
            const f32x4 xf = {__uint_as_float((unsigned)(q << 16)), __uint_as_float((unsigned)q & 0xffff0000u), __uint_as_float((unsigned)(q >> 32) << 16), __uint_as_float((unsigned)(q >> 32) & 0xffff0000u)};
#pragma unroll
            for (int o = 0; o < 8; ++o) if (i - o >= 0 && i - o < CK) acc[o] += w[i - o] * xf; }
#pragma unroll
        for (int o = 0; o < 8; ++o) {
            const float mean = wave_sum((acc[o][0] + acc[o][1]) + (acc[o][2] + acc[o][3])) * (1.f / 256.f);
            const f32x4 d = acc[o] - mean; const float rstd = 1.f / sqrtf(wave_sum((d[0] * d[0] + d[1] * d[1]) + (d[2] * d[2] + d[3] * d[3])) * (1.f / 256.f) + EPS);
            f32x4 y = d * rstd * lw + lb;
#pragma unroll
            for (int i = 0; i < 4; ++i) y[i] = y[i] * __builtin_amdgcn_rcpf(1.f + __expf(-y[i]));
            *(GAS unsigned long long*)(CAT + (size_t)(r0 + o) * 1024 + 256 + c0) = (unsigned long long)pk2(y[0], y[1]) | ((unsigned long long)pk2(y[2], y[3]) << 32); }
    }
}
__device__ __forceinline__ void fox_keynorms(const Ptrs& P, int gw, int ngw, int lane) {
    const bf16* K = WSP(const bf16, R_T0 + 4 * SZ_T); float* KN2 = WSP(float, WS_KN2); constexpr int NTT = SEQ / 64;
    for (int u = gw; u < BATCH * FH * NTT; u += ngw) { const int bh = u / NTT, tile = u % NTT, b = bh / FH, h = bh % FH;
        const bf16* kr = K + ((size_t)b * SEQ + tile * 64 + lane) * 512 + h * 64; float ss = 0.f;
#pragma unroll
        for (int c = 0; c < 8; ++c) { const v4u v = *(const GAS v4u*)(kr + 8 * c); float f[8]; unpack8(v, f);
#pragma unroll
            for (int e = 0; e < 8; ++e) ss += f[e] * f[e]; }
        ss = wave_max(ss); if (lane == 0) KN2[u] = ss; }
}
__device__ __forceinline__ void moe_gather(const Ptrs& P, int gw, int ngw, int lane, int wave, int vcu, int G, LAS unsigned char* lds) {
    LAS unsigned* base = (LAS unsigned*)lds; LAS unsigned* tot = base + 1024 * 8;
    { const unsigned* BH = WSP(const unsigned, WS_BH); const int per = (G + 63) / 64; unsigned run = 0u;
      for (int k = 0; k < per; ++k) { const int blk = lane * per + k; if (blk < G) run += BH[blk * 8 + wave]; }
      unsigned incl = run;
#pragma unroll
      for (int o = 1; o < 64; o <<= 1) { const unsigned t = __shfl_up(incl, o); if (lane >= o) incl += t; }
      unsigned ex = incl - run;
      for (int k = 0; k < per; ++k) { const int blk = lane * per + k; if (blk < G) { base[blk * 8 + wave] = ex; ex += BH[blk * 8 + wave]; } }
      if (lane == 63) tot[wave] = incl; }
    __syncthreads();
    unsigned* cntg = WSP(unsigned, WS_CTL) + CW_CNT;
    if (vcu == 0 && wave == 0 && lane < 8) cntg[lane] = tot[lane];
    unsigned cnt[8];
#pragma unroll
    for (int e = 0; e < 8; ++e) cnt[e] = tot[e];
    int off[9]; { int o = 0;
#pragma unroll
        for (int e = 0; e < 8; ++e) { off[e] = o; o += ((int)cnt[e] + 255) & ~255; }
        off[8] = o; }
    const bf16* XN = WSP(const bf16, R_XN); bf16* XNS = WSP(bf16, R_XNS); unsigned char* XQ = P.ws + WS_XQ;
    for (int row0 = gw; row0 < M; row0 += 4 * ngw) {
        v4u ta[4], a[4], b[4]; unsigned rv[4];
#pragma unroll
        for (int r = 0; r < 4; ++r) { const int row = row0 + r * ngw; if (row < M) { ta[r] = *(const GAS v4u*)(WSP(unsigned, WS_TOK) + (size_t)row * 8);
                const GAS v4u* srcp = (const GAS v4u*)(XN + (size_t)row * D) + lane; a[r] = __builtin_nontemporal_load(srcp); b[r] = __builtin_nontemporal_load(srcp + 64); rv[r] = WSP(const unsigned, WS_RSS)[(size_t)4 * M + row]; } }
#pragma unroll
        for (int r = 0; r < 4; ++r) { const int row = row0 + r * ngw; if (row < M) {
                unsigned* tk = WSP(unsigned, WS_TOK) + (size_t)row * 8;
                const int e1 = (int)ta[r][0], p1 = (int)ta[r][1], e2 = (int)ta[r][2], p2 = (int)ta[r][3];
                int o1 = 0, o2 = 0;
#pragma unroll
                for (int e = 0; e < 8; ++e) { if (e == e1) o1 = off[e]; if (e == e2) o2 = off[e]; }
                const int blk = (row >> 4) % G;
                const int s1 = o1 + (int)base[blk * 8 + e1] + p1, s2 = o2 + (int)base[blk * 8 + e2] + p2;
                if (lane == 0) { tk[6] = (unsigned)s1; tk[7] = (unsigned)s2; WSP(unsigned, WS_RSTDS)[s1] = rv[r]; WSP(unsigned, WS_RSTDS)[s2] = rv[r];
                    const float g1 = __uint_as_float(tk[4]), g2 = __uint_as_float(tk[5]); WSP(float, WS_SLOTG)[s1] = g1; WSP(float, WS_SLOTG)[s2] = -g2; }
                GAS v4u* d1 = (GAS v4u*)(XNS + (size_t)s1 * D) + lane; d1[0] = a[r]; d1[64] = b[r];
                const float rs_ = rsqrtf((float)rv[r] * (1.f / (16.f * 1024.f)) + 1e-6f) * F8_SA; float fa[8], fb[8]; unpack8(a[r], fa); unpack8(b[r], fb);
                typedef unsigned v2u_ __attribute__((ext_vector_type(2)));
                int qa0 = __builtin_amdgcn_cvt_pk_fp8_f32(fa[0] * rs_, fa[1] * rs_, 0, false); qa0 = __builtin_amdgcn_cvt_pk_fp8_f32(fa[2] * rs_, fa[3] * rs_, qa0, true);
                int qa1 = __builtin_amdgcn_cvt_pk_fp8_f32(fa[4] * rs_, fa[5] * rs_, 0, false); qa1 = __builtin_amdgcn_cvt_pk_fp8_f32(fa[6] * rs_, fa[7] * rs_, qa1, true);
                int qb0 = __builtin_amdgcn_cvt_pk_fp8_f32(fb[0] * rs_, fb[1] * rs_, 0, false); qb0 = __builtin_amdgcn_cvt_pk_fp8_f32(fb[2] * rs_, fb[3] * rs_, qb0, true);
                int qb1 = __builtin_amdgcn_cvt_pk_fp8_f32(fb[4] * rs_, fb[5] * rs_, 0, false); qb1 = __builtin_amdgcn_cvt_pk_fp8_f32(fb[6] * rs_, fb[7] * rs_, qb1, true);
                const v2u_ qa = {(unsigned)qa0, (unsigned)qa1}, qb = {(unsigned)qb0, (unsigned)qb1};
                GAS v2u_* x1 = (GAS v2u_*)(XQ + (size_t)s1 * D) + lane; GAS v2u_* x2 = (GAS v2u_*)(XQ + (size_t)s2 * D) + lane;
                x1[0] = qa; x1[64] = qb; x2[0] = qa; x2[64] = qb; } }
    }
    for (int w = gw; w < 8 * 256; w += ngw) {
        const int e = w >> 8, r = w & 255; int oe = 0, oe1 = 0, ce = 0;
#pragma unroll
        for (int j = 0; j < 8; ++j) if (j == e) { oe = off[j]; oe1 = off[j + 1]; ce = (int)cnt[j]; }
        const int slot = oe + ce + r;
        if (slot < oe1) { GAS v4u* dp = (GAS v4u*)(XNS + (size_t)slot * D) + lane; const v4u z = {0u, 0u, 0u, 0u}; dp[0] = z; dp[64] = z; ((GAS v4u*)(XQ + (size_t)slot * D))[lane] = z;       if (lane == 0) { unsigned zlo = 0u; asm volatile("" : "+v"(zlo)); WSP(unsigned, WS_RSTDS)[slot] = zlo; WSP(float, WS_SLOTG)[slot] = __uint_as_float(zlo); } }
    }
}
__device__ __forceinline__ void moe_combine_final(const Ptrs& P, int gw, int ngw, int lane) {
    const bf16* Y = WSP(const bf16, R_XNS); const float* nw = P.in[I_NFIN];
    for (int row0 = gw; row0 < M; row0 += 4 * ngw) {
        int s1[4], s2[4];
#pragma unroll
        for (int r = 0; r < 4; ++r) { const int row = row0 + r * ngw; const unsigned* tk = WSP(const unsigned, WS_TOK) + (size_t)(row < M ? row : 0) * 8; s1[r] = (int)tk[6]; s2[r] = (int)tk[7]; }
        unsigned long long ya[4][4], yb[4][4];
#pragma unroll
        for (int r = 0; r < 4; ++r) { const GAS unsigned long long* y1 = (const GAS unsigned long long*)(Y + (size_t)s1[r] * D) + lane; const GAS unsigned long long* y2 = (const GAS unsigned long long*)(Y + (size_t)s2[r] * D) + lane;
#pragma unroll
            for (int j = 0; j < 4; ++j) { ya[r][j] = __builtin_nontemporal_load(y1 + 64 * j); yb[r][j] = __builtin_nontemporal_load(y2 + 64 * j); } }
#pragma unroll
        for (int r = 0; r < 4; ++r) { const int row = row0 + r * ngw; if (row < M) {
            GAS f32x4* orow = (GAS f32x4*)(P.xres + (size_t)row * D) + lane;
            f32x4 v[4]; float ssq = 0.f;
#pragma unroll
            for (int j = 0; j < 4; ++j) { const unsigned long long a = ya[r][j], b = yb[r][j];
                v[j].x = bf2f((bf16)(a & 0xffff)) + bf2f((bf16)(b & 0xffff));
                v[j].y = bf2f((bf16)((a >> 16) & 0xffff)) + bf2f((bf16)((b >> 16) & 0xffff));
                v[j].z = bf2f((bf16)((a >> 32) & 0xffff)) + bf2f((bf16)((b >> 32) & 0xffff));
                v[j].w = bf2f((bf16)((a >> 48) & 0xffff)) + bf2f((bf16)((b >> 48) & 0xffff));
                ssq += (v[j].x * v[j].x + v[j].y * v[j].y) + (v[j].z * v[j].z + v[j].w * v[j].w); }
            const float rstd = 1.f / sqrtf(wave_sum(ssq) * (1.f / D) + EPS);
#pragma unroll
            for (int j = 0; j < 4; ++j) { const f32x4 w = *((const f32x4*)nw + lane + 64 * j); __builtin_nontemporal_store(v[j] * rstd * w, orow + 64 * j); } } }
    }
}

#ifndef MK_PER_PHASE
#define MK_PER_PHASE 0
#endif
constexpr int PH_PER_LAYER = 14, N_PHASES = 1 + 2 * PH_PER_LAYER + 1;
__device__ __forceinline__ Ptrs launder(const Ptrs& a) { Ptrs p = a; asm volatile("" : "+s"(p.ws), "+s"(p.xres)); return p; }
struct Args { const float* in[N_IN]; float* xres; unsigned char* ws; int ph_lo, ph_hi; };

__global__ void __launch_bounds__(NWAVES * 64, 2) trunk_fwd(Args args) {
    extern __shared__ __attribute__((aligned(16))) unsigned char lds_raw[];
    LAS unsigned char* lds = (LAS unsigned char*)lds_raw;
    Ptrs P0; P0.in = (const float* const LAS*)(lds + PTR_OFF); P0.xres = args.xres; P0.ws = args.ws;
    const int tid = threadIdx.x, wave0 = __builtin_amdgcn_readfirstlane(tid >> 6);
    const int G0 = gridDim.x; const int bx0 = blockIdx.x; const int vcu0 = (G0 % 8 == 0) ? (bx0 % 8) * (G0 / 8) + bx0 / 8 : bx0;
    volatile LAS unsigned* MISC = (volatile LAS unsigned*)(lds + MISC_OFF);
    if (tid < 64) MISC[tid] = 0u;
    if (tid < N_IN) ((const float* LAS*)(lds + PTR_OFF))[tid] = args.in[tid];
    __syncthreads();
    unsigned* ctl = (unsigned*)(P0.ws + WS_CTL);
    XcdBarrier bar; bar.bar = ctl + CW_BAR; bar.x = 0; bar.st = nullptr;
    if (!MK_PER_PHASE) bar = xcd_barrier_post(ctl + CW_BAR, MISC + 8);
    const int lo = args.ph_lo, hi = args.ph_hi; int ph = 0;
#ifndef SITEMASK
#define SITEMASK 0xffffffffull
#endif
#define SITE(k) ((SITEMASK >> (k)) & 1ull)
#define PH_ON() (ph >= lo && ph < hi)
#define PH_IF(k) if (PH_ON() && SITE(k))
#define PH_CTX() Ptrs P = launder(P0); int tidp = threadIdx.x; asm volatile("" : "+v"(tidp)); int G = G0, bx = bx0, vcu = vcu0, wave = wave0; asm volatile("" : "+s"(G), "+s"(bx), "+s"(vcu), "+s"(wave)); const int gw = vcu * NWAVES + wave, ngw = G * NWAVES; const long gn = (long)G * (NWAVES * 64); const int lane = tidp & 63; const long gtid = (long)bx * (NWAVES * 64) + tidp; (void)lane; (void)gw; (void)gtid; (void)ngw; (void)gn
#define PH_END() do { if (PH_ON() && ph + 1 < hi) { if (!MK_PER_PHASE) { XcdBarrier b2_ = bar; asm volatile("" : "+s"(b2_.bar), "+s"(b2_.x)); xcd_barrier(b2_); } } ++ph; } while (0)

    PH_IF(0) { PH_CTX();
        LAS WJob* jobs = (LAS WJob*)(lds + JOB_OFF);
        if (tid == 0) {
            int nj = 0, item = 0;
#define ADDJOB(W0_, W1_, rs_, dst_, K_, Nsrc_, Ndst_, kind_, cs_) do { LAS WJob* j_ = jobs + nj; j_->W0 = (W0_); j_->W1 = (W1_); j_->rs = (rs_); j_->WT = WSP(bf16, (dst_)); j_->K = (K_); j_->Nsrc = (Nsrc_); \
                j_->nblk = (Ndst_) / 32; j_->pad0 = 0; j_->kind = (kind_); j_->cs = (cs_); j_->item0 = item; item += ((K_) / 64) * ((Ndst_) / 32); ++nj; } while (0)
            for (int l = 0; l < 2; ++l) {
                const size_t wl = R_WL + (size_t)l * WL_SIZE;
                ADDJOB(P.in[I_WIN] + (size_t)l * D * INW, nullptr, P.in[I_NMIX] + l * D, wl + WL_IN, D, INW, NZ, 1, 1.f);
                ADDJOB(P.in[I_WOUT] + (size_t)l * D * D, nullptr, nullptr, wl + WL_OUT, D, D, D, 0, 1.f);
                ADDJOB(P.in[I_WQ] + (size_t)l * D * 512, nullptr, P.in[I_NXA] + l * D, wl + WL_Q, D, 512, 512, 0, XAT_QS);
                ADDJOB(P.in[I_WKV] + (size_t)l * D * 1024, nullptr, P.in[I_NMEM] + l * D, wl + WL_KV, D, 1024, 1024, 0, 1.f);
                ADDJOB(P.in[I_WO] + (size_t)l * 512 * D, nullptr, nullptr, wl + WL_O, 512, D, D, 0, 1.f);
            }
            ADDJOB(P.in[I_FG], P.in[I_FU], P.in[I_NFFN], R_WGU, D, DFF, 2 * DFF, 2, 1.f);
            ADDJOB(P.in[I_FD], nullptr, nullptr, R_WDN, DFF, D, D, 0, 1.f);
            for (int e = 0; e < NE; ++e) {
                ADDJOB(P.in[I_MG] + (size_t)e * D * DFF, P.in[I_MU] + (size_t)e * D * DFF, P.in[I_NFFN] + D, WS_WMGU + (size_t)e * 2 * DFF * D, D, DFF, 2 * DFF, 2, 1.f); jobs[nj - 1].pad0 = (int)F8_SWGU;
                ADDJOB(P.in[I_MD] + (size_t)e * DFF * D, nullptr, nullptr, WS_WMD + (size_t)e * D * DFF, DFF, D, D, 0, 1.f); jobs[nj - 1].pad0 = (int)F8_SWDN;
            }
#undef ADDJOB
            MISC[16] = (unsigned)nj; MISC[17] = (unsigned)item;
        }
        __syncthreads();
        const int nj = (int)MISC[16], nitems = (int)MISC[17];
        LAS float* scr = (LAS float*)(lds + wave * 16384);
        for (int it = gw; it < nitems; it += ngw) {
            int j = 0;
            for (int q = 1; q < nj; ++q) if (jobs[q].item0 <= it) j = q;
            p0_transpose_item(jobs + j, scr, it - jobs[j].item0, lane);
        }
        norm_rows<0>(P, 0, P.in[I_MEM], WSP(bf16, WS_MEMN), BATCH * NMEM, gw, ngw, lane);
        build_gw(P, gtid, gn);
    }
    PH_END();

    for (int l = 0; l < 2; ++l) {
        const size_t wl = R_WL + (size_t)l * WL_SIZE;
        PH_IF(1) { PH_CTX(); if (l == 0) norm16<1, false>(P, l, P.in[I_X], WSP(bf16, R_XN), nullptr, vcu, G, wave, lane, (LAS float*)lds);
            else norm16<1, true>(P, l, nullptr, WSP(bf16, R_XN), WSP(const unsigned, WS_RSS) + (size_t)2 * M, vcu, G, wave, lane, (LAS float*)lds); }
        PH_END();
        PH_IF(2) { PH_CTX();
            for (int task = bx; task < 24; task += G) gate_scan_task(P, task, (LAS float*)lds, tidp);
            { pg8::Gemm g{WSP(const bf16, R_XN), WSP(const bf16, wl + WL_IN), M, NZ, D}; pg8::StaticOrder S; S.init(M, NZ, G, bx);
              pg8::EpiBf16 E{WSP(bf16, R_T0), 512, 512, (size_t)M * 512, (l == 0) ? WSP(const unsigned, WS_RSTD) : WSP(const unsigned, WS_RSS) + (size_t)2 * M};
              pg8::gemm_phase<pg8::EpiBf16, pg8::StaticOrder, true, true>(lds, g, S, E); }
        }
        PH_END();
        PH_IF(3) { PH_CTX(); mconv_glu_vec(P, l, gtid, gn); fox_keynorms(P, gw, ngw, lane); }
        PH_END();
        PH_IF(4) { PH_CTX(); for (int u = wave * G + vcu; u < 8 * NCH; u += ngw) mls::u_unit(P, u, lds + wave * 16384, lane);
            for (int u = (7 - wave) * G + vcu; u < BATCH * FH * fox::NQB; u += ngw) { const int qb = fox::NQB - 1 - u / (BATCH * FH), bh = u % (BATCH * FH);
                const int j0 = fox::unit_j0_wave(bh, qb, (const fox::bf16h*)WSP(bf16, R_T0 + 3 * SZ_T), WSP(const float, WS_KN2), WSP(const float, WS_CF) + (size_t)bh * SEQ, lane); if (lane == 0) WSP(int, WS_J0)[u] = j0; }
            cconv_ln_rows(P, l, gw, ngw, lane); }
        PH_END();
        PH_IF(5) { PH_CTX(); mls::state_scan(P, gtid, gn); }
        PH_END();
        PH_IF(7) { PH_CTX();
            { pg8::Gemm g{WSP(const bf16, WS_MEMN), WSP(const bf16, wl + WL_KV), BATCH * NMEM, 512, D}; pg8::StaticOrder S; S.init(BATCH * NMEM, 512, G, bx);
              pg8::EpiBf16 E{WSP(bf16, WS_KVX) + (size_t)l * 512 * 1024, 512, 0, 0, nullptr};
              pg8::gemm_phase<pg8::EpiBf16, pg8::StaticOrder, true, true>(lds, g, S, E); }
            { pg8::Gemm g{WSP(const bf16, wl + WL_KV) + (size_t)512 * 1024, WSP(const bf16, WS_MEMN), 512, BATCH * NMEM, D}; pg8::StaticOrder S; S.init(512, BATCH * NMEM, G, (bx + G - 4) % G);
              pg8::EpiBf16 E{WSP(bf16, WS_KVX) + (size_t)l * 512 * 1024 + 512 * 512, 512, 0, 0, nullptr};
              pg8::gemm_phase<pg8::EpiBf16, pg8::StaticOrder, true, true>(lds, g, S, E); }
            { static_assert(fox::LDS_BYTES <= RING_BYTES, "fox LDS");
              const fox::bf16h* Q = (const fox::bf16h*)WSP(bf16, R_T0 + 3 * SZ_T); const fox::bf16h* Kp = (const fox::bf16h*)WSP(bf16, R_T0 + 4 * SZ_T); const fox::bf16h* Vp = (const fox::bf16h*)WSP(bf16, R_T0 + 5 * SZ_T);
              fox::bf16h* O = (fox::bf16h*)(WSP(bf16, R_CAT) + 512); const float* CF = WSP(const float, WS_CF);
              for (int it = vcu; it < 8 * NCH / 8; it += G) mls::out_unit(P, l, it * 8 + wave, lds + wave * 16384, lane);
              __syncthreads();
              const int nitems = BATCH * FH * fox::NQB; unsigned* qhead = ctl + CW_FOXQ + 64 * l;
              for (;;) {
                  if (tidp == 0) MISC[24] = __hip_atomic_fetch_add(qhead, 1u, RLX_AGENT);
                  __syncthreads();
                  const int u = (int)MISC[24];
                  __syncthreads();
                  if (u >= nitems) break;
                  const int qb = fox::NQB - 1 - u / (BATCH * FH), bh = u % (BATCH * FH);
                  const int j0 = WSP(const int, WS_J0)[u];
                  fox::attn_unit<8>(bh / FH, bh % FH, qb, j0, Q, Kp, Vp, O, CF + (size_t)bh * SEQ, (char*)lds_raw); } }

 }
        PH_END();
        PH_IF(8) { PH_CTX(); pg8::Gemm g{WSP(const bf16, R_CAT), WSP(const bf16, wl + WL_OUT), M, D, D}; pg8::StaticOrder S; S.init(M, D, G, bx);
            pg8::EpiRes E{WSP(bf16, R_XN), D, WSP(unsigned, WS_RSS) + (size_t)(l ? 3 : 0) * M};
            pg8::gemm_phase<pg8::EpiRes, pg8::StaticOrder, true, true>(lds, g, S, E); }
        PH_END();
        PH_IF(10) { PH_CTX(); pg8::Gemm g{WSP(const bf16, R_XN), WSP(const bf16, wl + WL_Q), M, 512, D}; pg8::StaticOrder S; S.init(M, 512, G, bx);
            pg8::EpiBf16 E{WSP(bf16, R_QX), 512, 0, 0, WSP(const unsigned, WS_RSS) + (size_t)(l ? 3 : 0) * M};
            pg8::gemm_phase<pg8::EpiBf16, pg8::StaticOrder, true, true>(lds, g, S, E); }
        PH_END();
        PH_IF(11) { PH_CTX(); static_assert(xat::LDS_BYTES <= RING_BYTES, "xat LDS");
            const bf16* KXp = WSP(const bf16, WS_KVX) + (size_t)l * 512 * 1024;
            for (int L = vcu; L < BATCH * XH * (SEQ / 256); L += G) { const int qb = L % (SEQ / 256), bhd = L / (SEQ / 256);
                xat::unit(bhd / XH, bhd % XH, qb, WSP(const bf16, R_QX), KXp, KXp + 512 * 512, WSP(bf16, R_OX), lds); } }
        PH_END();
        PH_IF(12) { PH_CTX(); pg8::Gemm g{WSP(const bf16, R_OX), WSP(const bf16, wl + WL_O), M, D, 512}; pg8::StaticOrder S; S.init(M, D, G, bx);
            pg8::EpiRes E{WSP(bf16, R_XN), D, WSP(unsigned, WS_RSS) + (size_t)(l ? 4 : 1) * M};
            pg8::gemm_phase<pg8::EpiRes, pg8::StaticOrder, true, true>(lds, g, S, E); }
        PH_END();
        if (l == 0) {
            PH_IF(14) { PH_CTX(); pg8::Gemm g{WSP(const bf16, R_XN), WSP(const bf16, R_WGU), M, 2 * DFF, D}; pg8::StaticOrder S; S.init(M, 2 * DFF, G, bx);
                pg8::EpiSwiGLU E{WSP(bf16, R_HD), DFF, WSP(const unsigned, WS_RSS) + (size_t)1 * M};
                pg8::gemm_phase<pg8::EpiSwiGLU, pg8::StaticOrder, true, true>(lds, g, S, E); }
            PH_END();
            PH_IF(15) { PH_CTX(); pg8::Gemm g{WSP(const bf16, R_HD), WSP(const bf16, R_WDN), M, D, DFF}; pg8::StaticOrder S; S.init(M, D, G, bx);
                pg8::EpiRes E{WSP(bf16, R_XN), D, WSP(unsigned, WS_RSS) + (size_t)2 * M};
                pg8::gemm_phase<pg8::EpiRes, pg8::StaticOrder, true, true>(lds, g, S, E); }
            PH_END();
            ph += 2;
        } else {
            PH_IF(16) { PH_CTX(); norm16<2, true>(P, l, nullptr, WSP(bf16, R_XN), WSP(const unsigned, WS_RSS) + (size_t)4 * M, vcu, G, wave, lane, (LAS float*)lds); }
            PH_END();
            PH_IF(17) { PH_CTX(); moe_gather(P, gw, ngw, lane, wave, vcu, G, lds); }
            PH_END();
            PH_IF(18) { PH_CTX(); pg8::Gemm g{WSP(const bf16, WS_XQ), WSP(const bf16, WS_WMGU), 0, 2 * DFF, D / 2}; pg8::GroupedOrder S; S.init(2 * DFF, G, bx, ctl + CW_CNT, (size_t)2 * DFF * D);
                pg8::EpiSwiGLU8 E{WSP(unsigned char, R_HM), DFF, 1.f / (F8_SA * F8_SWGU)};
                pg8::gemm_phase<pg8::EpiSwiGLU8, pg8::GroupedOrder, true, true, 2>(lds, g, S, E); }
            PH_END();
            PH_IF(19) { PH_CTX(); pg8::Gemm g{WSP(const bf16, R_HM), WSP(const bf16, WS_WMD), 0, D, DFF / 2}; pg8::GroupedTailOrder S; S.init(D, G, bx, ctl + CW_CNT, (size_t)D * DFF, DFF / (2 * pg8::BK));
                pg8::EpiMoeOutT E{WSP(bf16, R_XNS), D, WSP(const float, WS_SLOTG), WSP(float, WS_WMGU)  , ctl + CW_TAIL, 1.f / (F8_SH * F8_SWDN)};
                pg8::gemm_phase<pg8::EpiMoeOutT, pg8::GroupedTailOrder, true, true, 1>(lds, g, S, E); }
            PH_END();
        }
    }
    PH_IF(20) { PH_CTX(); moe_combine_final(P, gw, ngw, lane); }
#undef PH_ON
#undef PH_END
}

extern "C" void kernel_launch(void* const* d_in, const int* in_sizes, int n_in, void* d_out, int out_size, void* d_ws, size_t ws_size, hipStream_t stream) {
    static int grid = 0;
    if (grid == 0) {
        if (n_in != N_IN || out_size != M * D || ws_size < WS_END) { fprintf(stderr, "kernel_launch: unexpected shapes (n_in %d, out %d, ws %zu < %zu); nothing launched\n", n_in, out_size, ws_size, (size_t)WS_END); grid = -1; return; }
        int dev = 0, cus = 0, per_cu = 0;
        if (hipGetDevice(&dev) != hipSuccess || hipDeviceGetAttribute(&cus, hipDeviceAttributeMultiprocessorCount, dev) != hipSuccess) { grid = -1; return; }
        if (hipFuncSetAttribute((const void*)trunk_fwd, hipFuncAttributeMaxDynamicSharedMemorySize, LDS_BYTES) != hipSuccess) { fprintf(stderr, "kernel_launch: hipFuncSetAttribute failed\n"); grid = -1; return; }
        if (hipOccupancyMaxActiveBlocksPerMultiprocessor(&per_cu, (const void*)trunk_fwd, NWAVES * 64, LDS_BYTES) != hipSuccess || per_cu < 1) { fprintf(stderr, "kernel_launch: occupancy query says %d\n", per_cu); (void)hipGetLastError(); grid = -1; return; }
        grid = cus;
    }
    if (grid < 0) return;
    (void)in_sizes;
    if (hipMemsetAsync((char*)d_ws + WS_CTL, 0, CTL_ZERO_BYTES, stream) != hipSuccess) return;
    Args a; memset(&a, 0, sizeof(a));
    for (int i = 0; i < N_IN; ++i) a.in[i] = (const float*)d_in[i];
    a.xres = (float*)d_out; a.ws = (unsigned char*)d_ws;
#if MK_PER_PHASE
    for (int p = 0; p < N_PHASES; ++p) { a.ph_lo = p; a.ph_hi = p + 1; hipLaunchKernelGGL(trunk_fwd, dim3(grid), dim3(NWAVES * 64), LDS_BYTES, stream, a); }
#else
    a.ph_lo = 0; a.ph_hi = N_PHASES;
    hipLaunchKernelGGL(trunk_fwd, dim3(grid), dim3(NWAVES * 64), LDS_BYTES, stream, a);
#endif
}
#endif
```

```cpp
#if defined(HOST_EMU)
#include <cmath>
#include <cstring>
#include <cstdint>
#include <cstddef>
#define DEVFN static inline
#define PHFN static inline
#else
#include <hip/hip_runtime.h>
#include <cstdio>
#include <cstdint>
#include <cstring>
#define DEVFN __device__ __forceinline__
#define PHFN __device__ __forceinline__
#endif

#ifndef CFG_SEQ
#define CFG_SEQ 8192
#endif
constexpr int BATCH = 2, SEQ = CFG_SEQ, D = 1024, M = BATCH * SEQ;
constexpr int MH = 4, MCH = 64, NCH = SEQ / MCH;
constexpr int CK = 31;
constexpr int FH = 8;
constexpr int XH = 4, XD = 128, NMEM = 256;
constexpr int DFF = 2816, NE = 8, INW = 3088;
constexpr int NZ = 3072;
constexpr int SLOTS_MAX = 2 * M + NE * 256;
constexpr float EPS = 1e-6f;
constexpr float LOG2E = 1.4426950408889634f;
constexpr float FOX_QS = 0.125f * LOG2E;
constexpr float XAT_QS = 0.08838834764831845f * LOG2E;

enum { I_X = 0, I_MEM, I_NMIX, I_WIN, I_MCW, I_MCB, I_MBI, I_MBF, I_MNW, I_CCW, I_CCB, I_CLW, I_CLB, I_FBF, I_WOUT, I_NXA, I_NMEM, I_WQ, I_WKV, I_WO, I_NFFN,
       I_FG, I_FU, I_FD, I_RW, I_MG, I_MU, I_MD, I_NFIN, N_IN };

typedef unsigned short bf16;
constexpr size_t al4k(size_t x) { return (x + 4095) & ~(size_t)4095; }
constexpr size_t MiB = (size_t)1 << 20;
constexpr size_t WS_CTL = 0, CTL_ZERO_BYTES = 1 * MiB;
constexpr size_t WS_GATE = 1 * MiB;
constexpr size_t WS_CF = WS_GATE + al4k((size_t)M * 16 * 4);
constexpr size_t WS_BL = WS_CF + al4k((size_t)16 * SEQ * 4);
constexpr size_t WS_BT = WS_BL + al4k((size_t)8 * SEQ * 4);
constexpr size_t WS_AK = WS_BT + al4k((size_t)8 * NCH * 4);
constexpr size_t WS_MS = WS_AK + al4k((size_t)8 * NCH * 4);
constexpr size_t WS_DEC = WS_MS + al4k((size_t)8 * (NCH + 1) * 4);
constexpr size_t WS_KN2 = WS_DEC + al4k((size_t)8 * NCH * 4);
constexpr size_t WS_J0 = WS_KN2 + al4k((size_t)16 * (SEQ / 64) * 4);
constexpr size_t WS_BH = WS_J0 + al4k((size_t)16 * (SEQ / 256) * 4);
constexpr size_t WS_NST = WS_BH + al4k((size_t)1024 * 8 * 4);
constexpr size_t WS_TOK = WS_NST + al4k((size_t)8 * NCH * 64 * 4);
constexpr size_t WS_RSTD = WS_TOK + al4k((size_t)M * 32);
constexpr size_t WS_RSTDS = WS_RSTD + al4k((size_t)M * 8);
constexpr size_t WS_SLOTG = WS_RSTDS + al4k((size_t)SLOTS_MAX * 8);
constexpr size_t WS_GW = WS_SLOTG + al4k((size_t)SLOTS_MAX * 4);
constexpr size_t WS_MEMN = WS_GW + 3 * 65536;
constexpr size_t WS_KVX = WS_MEMN + al4k((size_t)512 * 1024 * 2);
constexpr size_t WS_WMGU = WS_KVX + al4k((size_t)2 * 512 * 1024 * 2);
constexpr size_t WS_WMD = WS_WMGU + (size_t)NE * 5632 * 1024 * 2;
constexpr size_t WS_R = al4k(WS_WMD + (size_t)NE * 1024 * 2816 * 2);
constexpr size_t WL_IN = 0, WL_OUT = WL_IN + (size_t)NZ * 1024 * 2, WL_Q = WL_OUT + (size_t)1024 * 1024 * 2, WL_KV = WL_Q + (size_t)512 * 1024 * 2,
                 WL_O = WL_KV + (size_t)1024 * 1024 * 2, WL_SIZE = WL_O + (size_t)1024 * 512 * 2;
constexpr size_t R_WL = WS_R;
constexpr size_t R_WGU = R_WL + 2 * WL_SIZE;
constexpr size_t R_WDN = R_WGU + (size_t)5632 * 1024 * 2;
constexpr size_t R_XN = al4k(R_WDN + (size_t)1024 * 2816 * 2);
constexpr size_t SZ_T = (size_t)M * 512 * 2;
constexpr size_t R_T0 = R_XN + 2 * SZ_T;
constexpr size_t R_MQK = R_T0 + 6 * SZ_T;
constexpr size_t R_CAT = R_MQK + SZ_T;
constexpr size_t R_CST = R_CAT + 2 * SZ_T;
constexpr size_t R_GL = R_CST + (size_t)8 * NCH * 4096 * 4;
constexpr size_t R_HC = R_GL + (size_t)M * 256 * 2;
constexpr size_t R_END1 = R_HC + (size_t)M * 256 * 4;
constexpr size_t R_QX = R_T0, R_OX = R_T0 + SZ_T;
constexpr size_t R_HD = R_T0;
constexpr size_t R_HM = WS_R;
constexpr size_t R_XNS = R_HM + (size_t)SLOTS_MAX * 2816 * 2;
constexpr size_t R_END2 = R_XNS + (size_t)SLOTS_MAX * 1024 * 2;
constexpr size_t WS_END = R_END1 > R_END2 ? R_END1 : R_END2;
static_assert((size_t)M * 2816 * 2 <= 6 * SZ_T, "dense hidden fits T0..T5");
static_assert(R_XN + 2 * SZ_T <= R_XNS, "XN must not overlap the gathered rows");
constexpr float F8_SA = 8.f, F8_SWGU = 256.f, F8_SH = 16.f, F8_SWDN = 512.f;
constexpr size_t WS_XQ = WS_WMGU + (size_t)NE * 5632 * 1024;
constexpr int CW_TMO = 0, CW_CNT = 64  , CW_TAIL = 512  , CW_FOXQ = 128  , CW_BAR = 4096;
constexpr size_t WS_RSS = 65536;
static_assert(WS_RSS + (size_t)5 * M * 4 <= CTL_ZERO_BYTES, "RSS arrays inside the zeroed region");

#if defined(HOST_EMU)
struct Ptrs { const float* in[N_IN]; float* xres; unsigned char* ws; };
#else
struct Ptrs { const float* const __attribute__((address_space(3)))* in; float* xres; unsigned char* ws; };
#endif
#define WSP(type, off) ((type*)(P.ws + (off)))

DEVFN float bf2f(bf16 v) { unsigned u = (unsigned)v << 16; float f; memcpy(&f, &u, 4); return f; }
DEVFN bf16 f2bf(float f) { unsigned u; memcpy(&u, &f, 4); return (bf16)((u + 0x7fffu + ((u >> 16) & 1u)) >> 16); }
DEVFN float sigmoidf_(float x) { return 1.f / (1.f + expf(-x)); }
#if defined(HOST_EMU)
DEVFN float logsigmoidf_(float x) { return fminf(x, 0.f) - log1pf(expf(-fabsf(x))); }
#else
DEVFN float logsigmoidf_(float x) { return fminf(x, 0.f) - __logf(1.f + __expf(-fabsf(x))); }
#endif

DEVFN void wmap(int kind, int nb, int& which, int& col0, float& cs) {
    which = 0; cs = 1.f; const int n0 = nb * 32;
    if (kind == 0) { col0 = n0; }
    else if (kind == 1) { col0 = n0 < 1024 ? n0 : n0 + 8; if (n0 >= 1536 && n0 < 2048) cs = FOX_QS; }
    else { const int tile = nb >> 3, w = nb & 7; which = w >> 2; col0 = tile * 128 + (w & 3) * 32; }
}

#if !defined(HOST_EMU)
namespace pg8 {
#define PG8_LAS __attribute__((address_space(3)))
typedef unsigned short bf16_t;
typedef short bf16x8 __attribute__((ext_vector_type(8)));
typedef float f32x4 __attribute__((ext_vector_type(4)));
typedef unsigned u32x4 __attribute__((ext_vector_type(4)));
constexpr int BM = 256, BK = 64, HALF = 128, HTB = HALF * BK * 2, STAGE_BYTES = 8 * HTB, NXCD = 8, WGM = 4;
__host__ __device__ __forceinline__ int lds_byte(int r, int c) { const int st = (r >> 4) * 2 + (c >> 5), rr = r & 15, cc = c & 31, ob = rr * 64 + cc * 2; return st * 1024 + (ob ^ (((ob >> 9) & 1) << 5)); }
__host__ __device__ __forceinline__ void stage_rc(int b, int& R, int& C) { const int st = b / 1024, sb = b % 1024, swz = sb ^ (((sb >> 9) & 1) << 5); R = (st >> 1) * 16 + swz / 64; C = (st & 1) * 32 + (swz % 64) / 2; }
__host__ __device__ __forceinline__ int perm32(int rho) { const int n = rho >> 4, i = rho & 15; return 8 * (i >> 2) + 4 * n + (i & 3); }

struct Unit { int pm, pn; size_t bofs; int nt, ks, ti, s; size_t aofs; };
struct Gemm { const bf16_t* A; const bf16_t* Bt; int M, N, K; };

struct StaticOrder {
    static constexpr bool VAR_K = false;
    int nM, nN, nwg, G, c;
    __device__ void init(int M_, int N_, int G_, int c_) { nM = M_ / BM; nN = N_ / BM; nwg = nM * nN; G = G_; c = c_; }
    __device__ bool next(int i, Unit& u) const {
        const long L = (long)i * G + c; if (L >= nwg) return false;
        int wgid = (int)L; { const int q = nwg / NXCD, r = nwg % NXCD, xcd = wgid % NXCD, off = wgid / NXCD; wgid = (xcd < r ? xcd * (q + 1) : r * (q + 1) + (xcd - r) * q) + off; }
        const int nig = WGM * nN, gid = wgid / nig, fm = gid * WGM, gsz = (nM - fm) < WGM ? (nM - fm) : WGM;
        u.pm = fm + ((wgid % nig) % gsz); u.pn = (wgid % nig) / gsz; u.bofs = 0; return true;
    }
    __device__ __forceinline__ void a_ready(const Unit&) const {}
    __device__ __forceinline__ void done(const Unit&) const {}
};
struct GroupedOrder {
    static constexpr bool VAR_K = false;
    int nM, nN, nwg, G, c; int off[9]; size_t estride;
    __device__ void init(int N_, int G_, int c_, const unsigned* cnt, size_t estride_) {
        int o = 0;
#pragma unroll
        for (int e = 0; e < 8; ++e) { off[e] = o; o += ((int)cnt[e] + 255) & ~255; }
        off[8] = o; nM = o / BM; nN = N_ / BM; nwg = nM * nN; G = G_; c = c_; estride = estride_;
    }
    __device__ bool next(int i, Unit& u) const {
        const long L = (long)i * G + c; if (L >= nwg) return false;
        int wgid = (int)L; { const int q = nwg / NXCD, r = nwg % NXCD, xcd = wgid % NXCD, o2 = wgid / NXCD; wgid = (xcd < r ? xcd * (q + 1) : r * (q + 1) + (xcd - r) * q) + o2; }
        const int nig = WGM * nN, gid = wgid / nig, fm = gid * WGM, gsz = (nM - fm) < WGM ? (nM - fm) : WGM;
        u.pm = fm + ((wgid % nig) % gsz); u.pn = (wgid % nig) / gsz;
        int e = 0;
#pragma unroll
        for (int j = 1; j < 8; ++j) e += (off[j] <= u.pm * BM) ? 1 : 0;
        u.bofs = (size_t)e * estride; return true;
    }
    __device__ __forceinline__ void a_ready(const Unit&) const {}
    __device__ __forceinline__ void done(const Unit&) const {}
};

struct GroupedTailOrder {
    static constexpr bool VAR_K = true;
    int nM, nN, nwg, G, c, nfull, T, s, sh, ntot, NT; int off[9]; size_t estride;
    __device__ __forceinline__ void init(int N_, int G_, int c_, const unsigned* cnt, size_t estride_, int NT_) {
        int o = 0;
#pragma unroll
        for (int e = 0; e < 8; ++e) { off[e] = o; o += ((int)cnt[e] + 255) & ~255; }
        off[8] = o; nM = o / BM; nN = N_ / BM; nwg = nM * nN; G = G_; c = c_; estride = estride_; NT = NT_;
        const int rounds = nwg / G; T = nwg - rounds * G;
        s = (T == 0) ? 1 : (T * 8 <= G ? 8 : (T * 4 <= G ? 4 : (T * 2 <= G ? 2 : 1))); sh = (s == 8) ? 3 : (s >> 1);
        if (s == 1) { nfull = nwg; T = 0; } else nfull = rounds * G;
        ntot = nfull + T * s;
    }
    __device__ __forceinline__ bool next(int i, Unit& u) const {
        const long L = (long)i * G + c; if (L >= ntot) return false;
        int wgid = (int)L, ks = 0, ti = -1;
        if (wgid >= nfull) { const int mu = wgid - nfull; ti = mu >> sh; ks = mu - (ti << sh); wgid = nfull + ti; }
        { const int q = nwg / NXCD, r = nwg % NXCD, xcd = wgid % NXCD, o2 = wgid / NXCD; wgid = (xcd < r ? xcd * (q + 1) : r * (q + 1) + (xcd - r) * q) + o2; }
        const int nig = WGM * nN, gid = wgid / nig, fm = gid * WGM, gsz = (nM - fm) < WGM ? (nM - fm) : WGM;
        u.pm = fm + ((wgid % nig) % gsz); u.pn = (wgid % nig) / gsz;
        int e = 0;
#pragma unroll
        for (int j = 1; j < 8; ++j) e += (off[j] <= u.pm * BM) ? 1 : 0;
        int kt0 = 0, ntu = NT;
        if (ti >= 0) { const int base = (NT >> sh) & ~1, ex = (NT - (base << sh)) >> 1;
            ntu = base + (ks < ex ? 2 : 0); kt0 = ks * base + 2 * (ks < ex ? ks : ex); }
        u.aofs = (size_t)kt0 * BK * 2; u.bofs = (size_t)e * estride + u.aofs; u.nt = ntu; u.ks = ks; u.ti = ti; u.s = s; return true;
    }
    __device__ __forceinline__ void a_ready(const Unit&) const {}
    __device__ __forceinline__ void done(const Unit&) const {}
};

__device__ __forceinline__ unsigned cvt_pk_bf16(float lo, float hi) { unsigned r; asm volatile("v_cvt_pk_bf16_f32 %0, %1, %2" : "=v"(r) : "v"(lo), "v"(hi)); return r; }

struct EpiBf16 {
    static constexpr bool PERM = true, AFTER_DRAIN = false, HAS_PRE = true;
    __device__ __forceinline__ void preload(unsigned (&q)[8], const Unit& u, int wr, int fr) const {
        if (rs) { const __attribute__((address_space(1))) unsigned* rp = (const __attribute__((address_space(1))) unsigned*)rs + u.pm * BM + wr * 64 + fr;
#pragma unroll
            for (int i = 0; i < 8; ++i) q[i] = rp[(i >> 2) * HALF + (i & 3) * 16]; } }
    bf16_t* O; int ldc; int split_cols; size_t split_stride; const unsigned* rs;
    __device__ __forceinline__ void operator()(const f32x4 (&acc)[2][2][4][2], const Unit& u, int wr, int wc, int fr, int fq, const unsigned (&q)[8]) const {
        const int row0 = u.pm * BM + wr * 64 + fr; int colt = u.pn * BM; bf16_t* base = O;
        if (split_cols) { const int t = colt / split_cols; base += (size_t)t * split_stride; colt -= t * split_cols; }
        const int col0 = colt + wc * 32 + 8 * fq;
        float sc[2][4];
#pragma unroll
        for (int ai = 0; ai < 2; ++ai)
#pragma unroll
            for (int m = 0; m < 4; ++m) sc[ai][m] = rs ? rsqrtf((float)q[ai * 4 + m] * (1.f / (16.f * 1024.f)) + 1e-6f) : 1.f;
#pragma unroll
        for (int ai = 0; ai < 2; ++ai)
#pragma unroll
            for (int m = 0; m < 4; ++m) { bf16_t* rowp = base + (size_t)(row0 + ai * HALF + m * 16) * ldc + col0;
#pragma unroll
                for (int bj = 0; bj < 2; ++bj) { const f32x4 v0 = acc[ai][bj][m][0] * sc[ai][m], v1 = acc[ai][bj][m][1] * sc[ai][m];
                    u32x4 w; w.x = cvt_pk_bf16(v0[0], v0[1]); w.y = cvt_pk_bf16(v0[2], v0[3]); w.z = cvt_pk_bf16(v1[0], v1[1]); w.w = cvt_pk_bf16(v1[2], v1[3]);
                    *(u32x4*)(rowp + bj * HALF) = w; } }
    }
};
struct EpiRes {
    static constexpr bool PERM = true, AFTER_DRAIN = false, HAS_PRE = false;
    bf16_t* X; int ldc; unsigned* rss;
    __device__ __forceinline__ void operator()(const f32x4 (&acc)[2][2][4][2], const Unit& u, int wr, int wc, int fr, int fq) const {
        const int row0 = u.pm * BM + wr * 64 + fr, col0 = u.pn * BM + wc * 32 + 8 * fq;
        typedef __attribute__((address_space(1))) u32x4 gu32x4;
        u32x4 b[2][4][2];
#pragma unroll
        for (int ai = 0; ai < 2; ++ai)
#pragma unroll
            for (int m = 0; m < 4; ++m)
#pragma unroll
                for (int bj = 0; bj < 2; ++bj) b[ai][m][bj] = *(const gu32x4*)(X + (size_t)(row0 + ai * HALF + m * 16) * ldc + col0 + bj * HALF);
#pragma unroll
        for (int ai = 0; ai < 2; ++ai)
#pragma unroll
            for (int m = 0; m < 4; ++m) { bf16_t* rowp = X + (size_t)(row0 + ai * HALF + m * 16) * ldc + col0; float ss = 0.f;
#pragma unroll
                for (int bj = 0; bj < 2; ++bj) { float v[8];
#pragma unroll
                    for (int i = 0; i < 4; ++i) { v[2 * i] = __uint_as_float(b[ai][m][bj][i] << 16) + acc[ai][bj][m][i >> 1][(2 * i) & 3]; v[2 * i + 1] = __uint_as_float(b[ai][m][bj][i] & 0xffff0000u) + acc[ai][bj][m][i >> 1][(2 * i + 1) & 3]; }
                    u32x4 w; w.x = cvt_pk_bf16(v[0], v[1]); w.y = cvt_pk_bf16(v[2], v[3]); w.z = cvt_pk_bf16(v[4], v[5]); w.w = cvt_pk_bf16(v[6], v[7]);
                    *(gu32x4*)(rowp + bj * HALF) = w;
#pragma unroll
                    for (int i = 0; i < 8; ++i) ss += v[i] * v[i]; }
                ss += __shfl_xor(ss, 16); ss += __shfl_xor(ss, 32);
                if (fq == 0) __hip_atomic_fetch_add(rss + row0 + ai * HALF + m * 16, (unsigned)(ss * 16.f + 0.5f), __ATOMIC_RELAXED, __HIP_MEMORY_SCOPE_AGENT); }
    }
};
struct EpiMoeOut {
    static constexpr bool PERM = true, AFTER_DRAIN = false, HAS_PRE = false;
    bf16_t* Y; int ldc; const float* sg;
    __device__ __forceinline__ void operator()(const f32x4 (&acc)[2][2][4][2], const Unit& u, int wr, int wc, int fr, int fq) const {
        const int row0 = u.pm * BM + wr * 64 + fr, col0 = u.pn * BM + wc * 32 + 8 * fq;
        typedef __attribute__((address_space(1))) u32x4 gu32x4;
        float g[2][4];
        { const __attribute__((address_space(1))) float* gp = (const __attribute__((address_space(1))) float*)sg + row0;
#pragma unroll
          for (int ai = 0; ai < 2; ++ai)
#pragma unroll
              for (int m = 0; m < 4; ++m) g[ai][m] = gp[ai * HALF + m * 16]; }
        u32x4 b[2][4][2];
#pragma unroll
        for (int ai = 0; ai < 2; ++ai)
#pragma unroll
            for (int m = 0; m < 4; ++m)
#pragma unroll
                for (int bj = 0; bj < 2; ++bj) { b[ai][m][bj] = (u32x4){0u, 0u, 0u, 0u}; if (g[ai][m] > 0.f) b[ai][m][bj] = *(const gu32x4*)(Y + (size_t)(row0 + ai * HALF + m * 16) * ldc + col0 + bj * HALF); }
#pragma unroll
        for (int ai = 0; ai < 2; ++ai)
#pragma unroll
            for (int m = 0; m < 4; ++m) { bf16_t* rowp = Y + (size_t)(row0 + ai * HALF + m * 16) * ldc + col0; const float ga = fabsf(g[ai][m]);
#pragma unroll
                for (int bj = 0; bj < 2; ++bj) { float v[8];
#pragma unroll
                    for (int i = 0; i < 4; ++i) { v[2 * i] = __uint_as_float(b[ai][m][bj][i] << 16) + ga * acc[ai][bj][m][i >> 1][(2 * i) & 3]; v[2 * i + 1] = __uint_as_float(b[ai][m][bj][i] & 0xffff0000u) + ga * acc[ai][bj][m][i >> 1][(2 * i + 1) & 3]; }
                    u32x4 w; w.x = cvt_pk_bf16(v[0], v[1]); w.y = cvt_pk_bf16(v[2], v[3]); w.z = cvt_pk_bf16(v[4], v[5]); w.w = cvt_pk_bf16(v[6], v[7]);
                    *(gu32x4*)(rowp + bj * HALF) = w; } }
    }
};
struct EpiMoeOutT {
    static constexpr bool PERM = true, AFTER_DRAIN = false, HAS_PRE = false;
    bf16_t* Y; int ldc; const float* sg; float* part; unsigned* cnt; float cs;
    template <int S> __device__ __forceinline__ void tail_reduce(const Unit& u, int wr, int wc, int fr, int fq, int wid, int lane) const {
        typedef __attribute__((address_space(1))) f32x4 gf32x4;
        typedef __attribute__((address_space(1))) u32x4 gu32x4;
        constexpr int CPS = 8 / S;
        const gf32x4* base = (const gf32x4*)part + ((size_t)(u.ti * S) * 8 + wid) * 2048 + lane;
        const int row0 = u.pm * BM + wr * 64 + fr, col0 = u.pn * BM + wc * 32 + 8 * fq;
#pragma unroll
        for (int cc = 0; cc < CPS; ++cc) {
            const int c8 = u.ks * CPS + cc, ai = c8 >> 2, bj = (c8 >> 1) & 1, mh = c8 & 1;
            f32x4 t[S][4];
#pragma unroll
            for (int o = 0; o < S; ++o)
#pragma unroll
                for (int jj = 0; jj < 4; ++jj) t[o][jj] = base[(size_t)o * 16384 + (c8 * 4 + jj) * 64];
            const int r0 = row0 + ai * HALF + mh * 32;
            float g[2]; u32x4 b[2];
#pragma unroll
            for (int mm = 0; mm < 2; ++mm) g[mm] = ((const __attribute__((address_space(1))) float*)sg)[r0 + mm * 16];
#pragma unroll
            for (int mm = 0; mm < 2; ++mm) { b[mm] = (u32x4){0u, 0u, 0u, 0u}; if (g[mm] > 0.f) b[mm] = *(const gu32x4*)(Y + (size_t)(r0 + mm * 16) * ldc + col0 + bj * HALF); }
#pragma unroll
            for (int jj = 0; jj < 4; ++jj)
#pragma unroll
                for (int o = 1; o < S; ++o) t[0][jj] += t[o][jj];
#pragma unroll
            for (int mm = 0; mm < 2; ++mm) { const float ga = fabsf(g[mm]) * cs; float v[8];
#pragma unroll
                for (int i = 0; i < 4; ++i) { v[2 * i] = __uint_as_float(b[mm][i] << 16) + ga * t[0][mm * 2 + (i >> 1)][(2 * i) & 3]; v[2 * i + 1] = __uint_as_float(b[mm][i] & 0xffff0000u) + ga * t[0][mm * 2 + (i >> 1)][(2 * i + 1) & 3]; }
                u32x4 w; w.x = cvt_pk_bf16(v[0], v[1]); w.y = cvt_pk_bf16(v[2], v[3]); w.z = cvt_pk_bf16(v[4], v[5]); w.w = cvt_pk_bf16(v[6], v[7]);
                *(gu32x4*)(Y + (size_t)(r0 + mm * 16) * ldc + col0 + bj * HALF) = w; }
        }
    }
    __device__ __forceinline__ void operator()(const f32x4 (&acc)[2][2][4][2], const Unit& u, int wr, int wc, int fr, int fq) const {
        typedef __attribute__((address_space(1))) f32x4 gf32x4;
        typedef __attribute__((address_space(1))) u32x4 gu32x4;
        if (u.ti >= 0) {
            const int wid = wr * 4 + wc; int lane = fq * 16 + fr; asm volatile("" : "+v"(lane));
            gf32x4* p = (gf32x4*)part + ((size_t)(u.ti * u.s + u.ks) * 8 + wid) * 2048 + lane;
#pragma unroll
            for (int j = 0; j < 32; ++j) p[j * 64] = acc[j >> 4][(j >> 3) & 1][(j >> 1) & 3][j & 1];
            asm volatile("s_waitcnt vmcnt(0)" ::: "memory"); __builtin_amdgcn_s_barrier();
            if (wid == 0) {
                __builtin_amdgcn_fence(__ATOMIC_RELEASE, "agent");
                if (lane == 0) __hip_atomic_fetch_add(cnt + u.ti, 1u, __ATOMIC_RELAXED, __HIP_MEMORY_SCOPE_AGENT);
                while (__hip_atomic_load(cnt + u.ti, __ATOMIC_RELAXED, __HIP_MEMORY_SCOPE_AGENT) < (unsigned)u.s) __builtin_amdgcn_s_sleep(2);
                __builtin_amdgcn_fence(__ATOMIC_ACQUIRE, "agent");
            }
            __builtin_amdgcn_s_barrier();
            if (u.s == 8) tail_reduce<8>(u, wr, wc, fr, fq, wid, lane); else if (u.s == 4) tail_reduce<4>(u, wr, wc, fr, fq, wid, lane); else tail_reduce<2>(u, wr, wc, fr, fq, wid, lane);
            return;
        }
        const int row0 = u.pm * BM + wr * 64 + fr, col0 = u.pn * BM + wc * 32 + 8 * fq;
        float g[2][4];
        { const __attribute__((address_space(1))) float* gp = (const __attribute__((address_space(1))) float*)sg + row0;
#pragma unroll
          for (int ai = 0; ai < 2; ++ai)
#pragma unroll
              for (int m = 0; m < 4; ++m) g[ai][m] = gp[ai * HALF + m * 16]; }
        u32x4 b[2][4][2];
#pragma unroll
        for (int ai = 0; ai < 2; ++ai)
#pragma unroll
            for (int m = 0; m < 4; ++m)
#pragma unroll
                for (int bj = 0; bj < 2; ++bj) { b[ai][m][bj] = (u32x4){0u, 0u, 0u, 0u}; if (g[ai][m] > 0.f) b[ai][m][bj] = *(const gu32x4*)(Y + (size_t)(row0 + ai * HALF + m * 16) * ldc + col0 + bj * HALF); }
#pragma unroll
        for (int ai = 0; ai < 2; ++ai)
#pragma unroll
            for (int m = 0; m < 4; ++m) { bf16_t* rowp = Y + (size_t)(row0 + ai * HALF + m * 16) * ldc + col0; const float ga = fabsf(g[ai][m]) * cs;
#pragma unroll
                for (int bj = 0; bj < 2; ++bj) { float v[8];
#pragma unroll
                    for (int i = 0; i < 4; ++i) { v[2 * i] = __uint_as_float(b[ai][m][bj][i] << 16) + ga * acc[ai][bj][m][i >> 1][(2 * i) & 3]; v[2 * i + 1] = __uint_as_float(b[ai][m][bj][i] & 0xffff0000u) + ga * acc[ai][bj][m][i >> 1][(2 * i + 1) & 3]; }
                    u32x4 w; w.x = cvt_pk_bf16(v[0], v[1]); w.y = cvt_pk_bf16(v[2], v[3]); w.z = cvt_pk_bf16(v[4], v[5]); w.w = cvt_pk_bf16(v[6], v[7]);
                    *(gu32x4*)(rowp + bj * HALF) = w; } }
    }
};
struct EpiSwiGLU8 {
    static constexpr bool PERM = true, AFTER_DRAIN = false, HAS_PRE = false;
    unsigned char* H; int ldc; float cs;
    __device__ __forceinline__ void operator()(const f32x4 (&acc)[2][2][4][2], const Unit& u, int wr, int wc, int fr, int fq) const {
        const int row0 = u.pm * BM + wr * 64 + fr, col0 = u.pn * HALF + wc * 32 + 8 * fq;
#pragma unroll
        for (int ai = 0; ai < 2; ++ai)
#pragma unroll
            for (int m = 0; m < 4; ++m) { unsigned char* rowp = H + (size_t)(row0 + ai * HALF + m * 16) * ldc + col0; float hv[8];
#pragma unroll
                for (int n = 0; n < 2; ++n)
#pragma unroll
                    for (int i = 0; i < 4; ++i) { const float g = acc[ai][0][m][n][i] * cs, up = acc[ai][1][m][n][i] * cs;
                        hv[n * 4 + i] = __builtin_amdgcn_fmed3f(g * __builtin_amdgcn_rcpf(1.f + __builtin_amdgcn_exp2f(-g * 1.4426950408889634f)) * up * F8_SH, -448.f, 448.f); }
                int p0 = __builtin_amdgcn_cvt_pk_fp8_f32(hv[0], hv[1], 0, false); p0 = __builtin_amdgcn_cvt_pk_fp8_f32(hv[2], hv[3], p0, true);
                int p1 = __builtin_amdgcn_cvt_pk_fp8_f32(hv[4], hv[5], 0, false); p1 = __builtin_amdgcn_cvt_pk_fp8_f32(hv[6], hv[7], p1, true);
                typedef unsigned u32x2_t __attribute__((ext_vector_type(2)));
                *(u32x2_t*)rowp = (u32x2_t){(unsigned)p0, (unsigned)p1}; }
    }
};
struct EpiSwiGLU {
    static constexpr bool PERM = true, AFTER_DRAIN = false, HAS_PRE = true;
    __device__ __forceinline__ void preload(unsigned (&q)[8], const Unit& u, int wr, int fr) const {
        const __attribute__((address_space(1))) unsigned* rp = (const __attribute__((address_space(1))) unsigned*)rs + u.pm * BM + wr * 64 + fr;
#pragma unroll
        for (int i = 0; i < 8; ++i) q[i] = rp[(i >> 2) * HALF + (i & 3) * 16]; }
    bf16_t* H; int ldc; const unsigned* rs;
    __device__ __forceinline__ void operator()(const f32x4 (&acc)[2][2][4][2], const Unit& u, int wr, int wc, int fr, int fq, const unsigned (&q)[8]) const {
        const int row0 = u.pm * BM + wr * 64 + fr, col0 = u.pn * HALF + wc * 32 + 8 * fq;
        float sc[2][4];
#pragma unroll
        for (int ai = 0; ai < 2; ++ai)
#pragma unroll
            for (int m = 0; m < 4; ++m) sc[ai][m] = rsqrtf((float)q[ai * 4 + m] * (1.f / (16.f * 1024.f)) + 1e-6f);
#pragma unroll
        for (int ai = 0; ai < 2; ++ai)
#pragma unroll
            for (int m = 0; m < 4; ++m) { bf16_t* rowp = H + (size_t)(row0 + ai * HALF + m * 16) * ldc + col0; float hv[8];
#pragma unroll
                for (int n = 0; n < 2; ++n)
#pragma unroll
                    for (int i = 0; i < 4; ++i) { const float g = acc[ai][0][m][n][i] * sc[ai][m], up = acc[ai][1][m][n][i] * sc[ai][m];
                        hv[n * 4 + i] = g * __builtin_amdgcn_rcpf(1.f + __builtin_amdgcn_exp2f(-g * 1.4426950408889634f)) * up; }
                u32x4 w; w.x = cvt_pk_bf16(hv[0], hv[1]); w.y = cvt_pk_bf16(hv[2], hv[3]); w.z = cvt_pk_bf16(hv[4], hv[5]); w.w = cvt_pk_bf16(hv[6], hv[7]);
                *(u32x4*)rowp = w; }
    }
};

typedef int i32x4_t __attribute__((ext_vector_type(4)));
typedef int i32x8_t __attribute__((ext_vector_type(8)));
template <class Epi, class Sched, bool ALIGN_EPI = false, bool SP2 = false, int F8 = 0>
__device__ __forceinline__ void gemm_phase(PG8_LAS unsigned char* lds, const Gemm g, const Sched& S, const Epi& E) {
    int tid = threadIdx.x; asm volatile("" : "+v"(tid));
    const int wid = __builtin_amdgcn_readfirstlane(tid >> 6), lane = tid & 63, wr = wid >> 2, wc = wid & 3, fr = lane & 15, fq = lane >> 4;
    const int K = g.K, nt = K / BK;
    unsigned voffA[2], voffB[2];
#pragma unroll
    for (int i = 0; i < 2; ++i) { int R, C; stage_rc(tid * 16 + i * 8192, R, C); const int Rb = Epi::PERM ? ((R & ~31) + perm32(R & 31)) : R;
        voffA[i] = (unsigned)(R * K + C) * 2u; voffB[i] = (unsigned)(Rb * K + C) * 2u; }
    const size_t kstep = (size_t)(BK * 2);
    const size_t hstep = (size_t)HALF * K * 2;
    const size_t tstep = 2 * hstep;
    const unsigned ldsw = (unsigned)wid * 1024u;
    const int aoff = lds_byte(wr * 64 + fr, fq * 8), boff = lds_byte(wc * 32 + fr, fq * 8);
#define PG8_SA(b, h) (((b) * 2 + (h)) * HTB)
#define PG8_SB(b, h) ((4 + (b) * 2 + (h)) * HTB)
#define PG8_STAGE(bufoff, gbase, voff) do { _Pragma("unroll") for (int _i = 0; _i < 2; ++_i) \
        __builtin_amdgcn_global_load_lds((const unsigned*)((const char*)(gbase) + (voff)[_i]), (PG8_LAS unsigned*)(lds + (bufoff) + ldsw + _i * 8192), 16, 0, 0); } while (0)
#define PG8_LDA(dst, b, h) do { _Pragma("unroll") for (int m = 0; m < 4; ++m) _Pragma("unroll") for (int k = 0; k < 2; ++k) dst[m][k] = *(const PG8_LAS bf16x8*)(lds + PG8_SA(b, h) + aoff + m * 2048 + k * 1024); } while (0)
#define PG8_LDB(dst, b, h) do { _Pragma("unroll") for (int n = 0; n < 2; ++n) _Pragma("unroll") for (int k = 0; k < 2; ++k) dst[n][k] = *(const PG8_LAS bf16x8*)(lds + PG8_SB(b, h) + boff + n * 2048 + k * 1024); } while (0)
typedef long i64x2_t __attribute__((ext_vector_type(2)));
#define PG8_H64(x, hf) (__builtin_bit_cast(i64x2_t, x)[hf])
#define PG8_CAT8(x, y) __builtin_shufflevector(__builtin_bit_cast(i32x4_t, x), __builtin_bit_cast(i32x4_t, y), 0, 1, 2, 3, 4, 5, 6, 7)
#define PG8_MMA(ai, bj, At, Bt) do { __builtin_amdgcn_s_setprio(1); \
        if constexpr (F8 == 2) { _Pragma("unroll") for (int m = 0; m < 4; ++m) _Pragma("unroll") for (int n = 0; n < 2; ++n) \
            asm volatile("v_mfma_f32_16x16x128_f8f6f4 %0, %1, %2, %0" : "+v"(acc[ai][bj][m][n]) : "v"(PG8_CAT8(Bt[n][0], Bt[n][1])), "v"(PG8_CAT8(At[m][0], At[m][1]))); } \
        else if constexpr (F8 == 1) { _Pragma("unroll") for (int k = 0; k < 2; ++k) _Pragma("unroll") for (int hf = 0; hf < 2; ++hf) _Pragma("unroll") for (int m = 0; m < 4; ++m) _Pragma("unroll") for (int n = 0; n < 2; ++n) \
            acc[ai][bj][m][n] = __builtin_amdgcn_mfma_f32_16x16x32_fp8_fp8(PG8_H64(Bt[n][k], hf), PG8_H64(At[m][k], hf), acc[ai][bj][m][n], 0, 0, 0); } \
        else { _Pragma("unroll") for (int m = 0; m < 4; ++m) _Pragma("unroll") for (int n = 0; n < 2; ++n) _Pragma("unroll") for (int k = 0; k < 2; ++k) \
            acc[ai][bj][m][n] = __builtin_amdgcn_mfma_f32_16x16x32_bf16(Bt[n][k], At[m][k], acc[ai][bj][m][n], 0, 0, 0); } \
        __builtin_amdgcn_s_setprio(0); } while (0)
#define PG8_WAIT_V(n) asm volatile("s_waitcnt vmcnt(" #n ")" ::: "memory")
#define PG8_WAIT_L(n) asm volatile("s_waitcnt lgkmcnt(" #n ")" ::: "memory")
#define PG8_BAR __builtin_amdgcn_s_barrier()
#define PG8_SCHED __builtin_amdgcn_sched_barrier(0)
    Unit cur, nxt; int ui = 0;
    if (!S.next(0, cur)) return;
    f32x4 acc[2][2][4][2];
#pragma unroll
    for (int a = 0; a < 2; ++a)
#pragma unroll
        for (int b = 0; b < 2; ++b)
#pragma unroll
            for (int m = 0; m < 4; ++m)
#pragma unroll
                for (int n = 0; n < 2; ++n) acc[a][b][m][n] = (f32x4){0.f, 0.f, 0.f, 0.f};
    bf16x8 At[4][2], B0[2][2], B1[2][2];
    const char* cA = (const char*)g.A + (size_t)cur.pm * tstep; const char* cB = (const char*)g.Bt + cur.bofs + (size_t)cur.pn * tstep;
    if constexpr (Sched::VAR_K) cA += cur.aofs;
    S.a_ready(cur);
    if constexpr (SP2) {
        PG8_STAGE(PG8_SB(0, 0), cB, voffB); PG8_STAGE(PG8_SB(0, 1), cB + hstep, voffB); PG8_STAGE(PG8_SA(0, 0), cA, voffA); PG8_STAGE(PG8_SA(0, 1), cA + hstep, voffA);
        if (wr == 1) PG8_BAR;
        PG8_WAIT_V(2); PG8_BAR;
        PG8_STAGE(PG8_SB(1, 0), cB + kstep, voffB); PG8_STAGE(PG8_SA(1, 0), cA + kstep, voffA); PG8_STAGE(PG8_SB(1, 1), cB + hstep + kstep, voffB);
        PG8_WAIT_V(6); PG8_BAR;
    } else {
        PG8_STAGE(PG8_SB(0, 0), cB, voffB); PG8_STAGE(PG8_SA(0, 0), cA, voffA); PG8_STAGE(PG8_SB(0, 1), cB + hstep, voffB); PG8_STAGE(PG8_SA(0, 1), cA + hstep, voffA);
        if (wr == 1) PG8_BAR;
        PG8_WAIT_V(4); PG8_BAR;
        PG8_STAGE(PG8_SB(1, 0), cB + kstep, voffB); PG8_STAGE(PG8_SA(1, 0), cA + kstep, voffA); PG8_STAGE(PG8_SB(1, 1), cB + hstep + kstep, voffB);
        PG8_WAIT_V(6); PG8_BAR;
    }
    for (;;) {
        unsigned preq[8];
        if constexpr (Epi::HAS_PRE) E.preload(preq, cur, wr, fr);
        const bool has_next = S.next(ui + 1, nxt);
        const char* nA = has_next ? (const char*)g.A + (size_t)nxt.pm * tstep : cA; const char* nB = has_next ? (const char*)g.Bt + nxt.bofs + (size_t)nxt.pn * tstep : cB;
        if constexpr (Sched::VAR_K) { if (has_next) nA += nxt.aofs; }
        int ntu = nt; if constexpr (Sched::VAR_K) ntu = cur.nt;
        for (int t = 0; t < ntu; t += 2) {
            const bool last = (t == ntu - 2);
            const char* a1 = cA + (size_t)(t + 1) * kstep;
            const char* a2 = last ? nA : cA + (size_t)(t + 2) * kstep; const char* b2 = last ? nB : cB + (size_t)(t + 2) * kstep;
            const char* a3 = a2 + kstep; const char* b3 = b2 + kstep;
            if (last && has_next) S.a_ready(nxt);
            if constexpr (SP2) {
            PG8_LDB(B0, 0, 0); PG8_LDB(B1, 0, 1); PG8_SCHED; PG8_LDA(At, 0, 0); PG8_STAGE(PG8_SA(1, 1), a1 + hstep, voffA);
            PG8_WAIT_V(8); PG8_WAIT_L(0); PG8_BAR; PG8_MMA(0, 0, At, B0); PG8_MMA(0, 1, At, B1); PG8_BAR; PG8_SCHED;
            PG8_LDA(At, 0, 1); PG8_STAGE(PG8_SB(0, 0), b2, voffB); PG8_STAGE(PG8_SB(0, 1), b2 + hstep, voffB); PG8_STAGE(PG8_SA(0, 0), a2, voffA);
            PG8_WAIT_V(8); PG8_WAIT_L(0); PG8_BAR; PG8_MMA(1, 0, At, B0); PG8_MMA(1, 1, At, B1); PG8_BAR; PG8_SCHED;
            PG8_LDB(B0, 1, 0); PG8_LDB(B1, 1, 1); PG8_SCHED; PG8_LDA(At, 1, 0); PG8_STAGE(PG8_SA(0, 1), a2 + hstep, voffA);
            PG8_WAIT_V(8); PG8_WAIT_L(0); PG8_BAR; PG8_MMA(0, 0, At, B0); PG8_MMA(0, 1, At, B1); PG8_BAR; PG8_SCHED;
            PG8_LDA(At, 1, 1); PG8_STAGE(PG8_SB(1, 0), b3, voffB); PG8_STAGE(PG8_SB(1, 1), b3 + hstep, voffB); PG8_STAGE(PG8_SA(1, 0), a3, voffA);
            PG8_WAIT_V(8); PG8_WAIT_L(0); PG8_BAR; PG8_MMA(1, 0, At, B0); PG8_MMA(1, 1, At, B1); PG8_BAR; PG8_SCHED;
            } else {
            PG8_LDB(B0, 0, 0); PG8_SCHED; PG8_LDA(At, 0, 0); PG8_STAGE(PG8_SA(1, 1), a1 + hstep, voffA);
            PG8_WAIT_L(8); PG8_BAR; PG8_WAIT_L(0); PG8_MMA(0, 0, At, B0); PG8_BAR; PG8_SCHED;
            PG8_LDB(B1, 0, 1); PG8_STAGE(PG8_SB(0, 0), b2, voffB);
            PG8_BAR; PG8_WAIT_L(0); PG8_MMA(0, 1, At, B1); PG8_BAR;
            PG8_LDA(At, 0, 1); PG8_STAGE(PG8_SA(0, 0), a2, voffA);
            PG8_BAR; PG8_WAIT_L(0); PG8_MMA(1, 0, At, B0); PG8_BAR; PG8_SCHED;
            PG8_STAGE(PG8_SB(0, 1), b2 + hstep, voffB);
            PG8_WAIT_V(6); PG8_BAR; PG8_MMA(1, 1, At, B1); PG8_BAR;
            PG8_LDB(B0, 1, 0); PG8_SCHED; PG8_LDA(At, 1, 0); PG8_STAGE(PG8_SA(0, 1), a2 + hstep, voffA);
            PG8_WAIT_L(8); PG8_BAR; PG8_WAIT_L(0); PG8_MMA(0, 0, At, B0); PG8_BAR; PG8_SCHED;
            PG8_LDB(B1, 1, 1); PG8_STAGE(PG8_SB(1, 0), b3, voffB);
            PG8_BAR; PG8_WAIT_L(0); PG8_MMA(0, 1, At, B1); PG8_BAR;
            PG8_LDA(At, 1, 1); PG8_STAGE(PG8_SA(1, 0), a3, voffA);
            PG8_BAR; PG8_WAIT_L(0); PG8_MMA(1, 0, At, B0); PG8_BAR; PG8_SCHED;
            PG8_STAGE(PG8_SB(1, 1), b3 + hstep, voffB);
            PG8_WAIT_V(6); PG8_BAR; PG8_MMA(1, 1, At, B1); PG8_BAR;
            }
        }
        if constexpr (F8 == 2) asm volatile("s_nop 15\n\ts_nop 15" ::: "memory");
        if constexpr (ALIGN_EPI) { if (wr == 0) PG8_BAR; }
        if constexpr (!Epi::AFTER_DRAIN) { if constexpr (Epi::HAS_PRE) E(acc, cur, wr, wc, fr, fq, preq); else E(acc, cur, wr, wc, fr, fq); S.done(cur); }
        if (!has_next) break;
#pragma unroll
        for (int a = 0; a < 2; ++a)
#pragma unroll
            for (int b = 0; b < 2; ++b)
#pragma unroll
                for (int m = 0; m < 4; ++m)
#pragma unroll
                    for (int n = 0; n < 2; ++n) acc[a][b][m][n] = (f32x4){0.f, 0.f, 0.f, 0.f};
        cur = nxt; cA = nA; cB = nB; ++ui;
        if constexpr (ALIGN_EPI) { if (wr == 1) PG8_BAR; }
    }
    PG8_WAIT_V(0);
    if constexpr (!ALIGN_EPI) { if (wr == 0) PG8_BAR; }
    PG8_BAR;
#undef PG8_SA
#undef PG8_SB
#undef PG8_STAGE
#undef PG8_LDA
#undef PG8_LDB
#undef PG8_MMA
#undef PG8_WAIT_V
#undef PG8_WAIT_L
#undef PG8_BAR
#undef PG8_SCHED
}
}


#include <hip/hip_bf16.h>
namespace fox {
using bf16h=__hip_bfloat16;
using bf16x8=__attribute__((ext_vector_type(8)))short;
using s16x4=__attribute__((ext_vector_type(4)))short;
using f32x16=__attribute__((ext_vector_type(16)))float;
using f32x4=__attribute__((ext_vector_type(4)))float;
using u32x4=__attribute__((ext_vector_type(4)))unsigned;
constexpr int NHEAD=FH,D=64,DMI=512,DMO=1024;
constexpr int NW=8,QBLK=32,QB=QBLK*NW,KVBLK=64,NQB=SEQ/QB;
__device__ __forceinline__ int crow(int r,int hi){return (r&3)+8*(r>>2)+4*hi;}
#define SBAR() __builtin_amdgcn_sched_barrier(0)
__device__ __forceinline__ void cmask(f32x16&p0,f32x16&p1,int jb,int qrel,int hi){
  const float NEG=-INFINITY; int kb=64*jb+4*hi;
  #pragma unroll
  for(int r=0;r<16;++r){int kv=kb+(r&3)+8*(r>>2); if(kv>qrel)p0[r]=NEG; if(kv+32>qrel)p1[r]=NEG;}
}
constexpr int NSLOT=3, SLOTB=8192;
constexpr int LDS_K=0, LDS_V=NSLOT*SLOTB, LDS_WS=2*NSLOT*SLOTB, LDS_OST=LDS_WS+NW*64*4, LDS_NB=LDS_OST+NW*4096, LDS_BYTES=LDS_NB+SEQ*4;
__device__ __forceinline__ void glds16(const void*gsrc,unsigned lds_dst){unsigned keep;
  asm volatile("s_mov_b32 %0, m0\n\ts_mov_b32 m0, %2\n\ts_nop 0\n\tglobal_load_lds_dwordx4 %1, off\n\ts_mov_b32 m0, %0":"=&s"(keep):"v"(gsrc),"s"(lds_dst):"memory");}
__device__ __forceinline__ float max3f(float a,float b,float c){float r;asm("v_max3_f32 %0, %1, %2, %3":"=v"(r):"v"(a),"v"(b),"v"(c));return r;}
__device__ __forceinline__ float max2f(float a,float b){float r;asm("v_max_f32_e32 %0, %1, %2":"=v"(r):"v"(a),"v"(b));return r;}
__device__ __forceinline__ float fadd_s(float a,float b){float r;asm("v_add_f32_e32 %0, %1, %2":"=v"(r):"v"(a),"v"(b));return r;}
__device__ __forceinline__ float fsub_s(float a,float b){float r;asm("v_sub_f32_e32 %0, %1, %2":"=v"(r):"v"(a),"v"(b));return r;}
typedef float f32x2_t __attribute__((ext_vector_type(2))); typedef __bf16 bf16x2_t __attribute__((ext_vector_type(2)));
__device__ __forceinline__ unsigned cvtpk_s(float lo,float hi){f32x2_t v={lo,hi};bf16x2_t b=__builtin_convertvector(v,bf16x2_t);return __builtin_bit_cast(unsigned,b);}
#define WAIT_BAR(N) asm volatile("s_waitcnt vmcnt(" #N ") lgkmcnt(0)\n\ts_barrier":::"memory")
__device__ __forceinline__ void qkt(f32x16&p0,f32x16&p1,const char*Kslot,const bf16x8*qr,int r32,int hi){
  const char*kb=Kslot+hi*1024+r32*16;
  #pragma unroll
  for(int d0=0;d0<4;++d0){
    const bf16x8 b0=*reinterpret_cast<const bf16x8*>(kb+d0*2048);
    const bf16x8 b1=*reinterpret_cast<const bf16x8*>(kb+d0*2048+512);
    p0=__builtin_amdgcn_mfma_f32_32x32x16_bf16(b0,qr[d0],p0,0,0,0);p1=__builtin_amdgcn_mfma_f32_32x32x16_bf16(b1,qr[d0],p1,0,0,0);}
}
typedef __attribute__((address_space(3))) const char* lds_cptr;
typedef __attribute__((address_space(3))) const float* lds_fptr;
typedef short v4i16_t __attribute__((ext_vector_type(4)));
__device__ __forceinline__ void kload8(bf16x8*kf,lds_cptr kp){
  kf[0]=*(const __attribute__((address_space(3))) bf16x8*)(kp);      kf[1]=*(const __attribute__((address_space(3))) bf16x8*)(kp+512);
  kf[2]=*(const __attribute__((address_space(3))) bf16x8*)(kp+2048); kf[3]=*(const __attribute__((address_space(3))) bf16x8*)(kp+2560);
  kf[4]=*(const __attribute__((address_space(3))) bf16x8*)(kp+4096); kf[5]=*(const __attribute__((address_space(3))) bf16x8*)(kp+4608);
  kf[6]=*(const __attribute__((address_space(3))) bf16x8*)(kp+6144); kf[7]=*(const __attribute__((address_space(3))) bf16x8*)(kp+6656);
}
__device__ __forceinline__ void kload2(bf16x8*kf,lds_cptr kp,int j){ kf[2*j]=*(const __attribute__((address_space(3))) bf16x8*)(kp+j*2048); kf[2*j+1]=*(const __attribute__((address_space(3))) bf16x8*)(kp+j*2048+512); }
__device__ __forceinline__ s16x4 vtr(lds_cptr p){ return __builtin_bit_cast(s16x4,__builtin_amdgcn_ds_read_tr16_b64_v4i16((__attribute__((address_space(3))) v4i16_t*)p)); }
__device__ __forceinline__ float rowmax(const f32x16&p0,const f32x16&p1){
  float a=max3f(p0[0],p0[1],p1[0]),b=max3f(p0[2],p0[3],p1[1]);a=max3f(a,p1[2],p1[3]);
  #pragma unroll
  for(int r=4;r<16;r+=4){a=max3f(a,p0[r],p0[r+1]);b=max3f(b,p0[r+2],p0[r+3]);a=max3f(a,p1[r],p1[r+1]);b=max3f(b,p1[r+2],p1[r+3]);}
  const float m=max2f(a,b);
  auto rr=__builtin_amdgcn_permlane32_swap(__float_as_uint(m),__float_as_uint(m),false,false);
  return max2f(__uint_as_float(rr[0]),__uint_as_float(rr[1]));
}
__device__ __forceinline__ void pv(f32x16*o,int vb,bf16x8 pa0,bf16x8 pa1,bf16x8 pa2,bf16x8 pa3){
  #pragma unroll
  for(int d0=0;d0<2;++d0){s16x4 lo[4],hi[4];
    #pragma unroll
    for(int ks=0;ks<4;++ks){
      asm volatile("ds_read_b64_tr_b16 %0,%1 offset:%c2":"=&v"(lo[ks]):"v"(vb),"i"(d0*4096+ks*1024):"memory");
      asm volatile("ds_read_b64_tr_b16 %0,%1 offset:%c2":"=&v"(hi[ks]):"v"(vb),"i"(d0*4096+ks*1024+512):"memory");}
    asm volatile("s_waitcnt lgkmcnt(0)":::"memory");SBAR();
    #define PK(k) (bf16x8){lo[k][0],lo[k][1],lo[k][2],lo[k][3],hi[k][0],hi[k][1],hi[k][2],hi[k][3]}
    o[d0]=__builtin_amdgcn_mfma_f32_32x32x16_bf16(pa0,PK(0),o[d0],0,0,0);
    o[d0]=__builtin_amdgcn_mfma_f32_32x32x16_bf16(pa1,PK(1),o[d0],0,0,0);
    o[d0]=__builtin_amdgcn_mfma_f32_32x32x16_bf16(pa2,PK(2),o[d0],0,0,0);
    o[d0]=__builtin_amdgcn_mfma_f32_32x32x16_bf16(pa3,PK(3),o[d0],0,0,0);
    #undef PK
  }
}
template<int THRL> __device__ __forceinline__ void attn_unit(int b,int h,int qb,int j0,const bf16h*Q,const bf16h*__restrict__ K,const bf16h*__restrict__ V,bf16h*O,const float*CL,char*shm){
  int tid=threadIdx.x; asm volatile("":"+v"(tid));
  const int lane=tid&63,r32=lane&31,hi=lane>>5; const int wid=__builtin_amdgcn_readfirstlane(tid>>6);
  const long rowbase=(long)b*SEQ; const int q0=qb*QB; const long kvbase=rowbase+(long)j0*KVBLK;
  const bf16h*Qw=Q+(rowbase+q0+wid*QBLK)*DMI+h*D;
  const bf16h*Kh=K+kvbase*DMI+h*D,*Vh=V+kvbase*DMI+h*D;
  const unsigned lds0=(unsigned)(uintptr_t)shm;
  float*wsf=(float*)(shm+LDS_WS)+wid*64;
  const int NT=(q0+QB)/KVBLK-j0;
  { float*nbw=(float*)(shm+LDS_NB); const float*src=CL+(long)j0*KVBLK;
    for(int i=tid*4;i<NT*KVBLK;i+=512*4){ const f32x4 v=*(const f32x4*)(src+i); *(f32x4*)(nbw+i)=(f32x4){-v[0],-v[1],-v[2],-v[3]}; } }
  const bf16h*ksrc=Kh+(long)lane*DMI+wid*8;
  const bf16h*vsrc=Vh+(long)(16*(wid&3)+(lane>>2))*DMI+(wid>>2)*32+(lane&3)*8;
  const unsigned kdst=lds0+LDS_K+wid*1024, vdst=lds0+LDS_V+wid*1024;
  #define DMA_K(t,slot) glds16(ksrc+(long)(t)*KVBLK*DMI,(unsigned)__builtin_amdgcn_readfirstlane(kdst+(slot)))
  #define DMA_V(t,slot) glds16(vsrc+(long)(t)*KVBLK*DMI,(unsigned)__builtin_amdgcn_readfirstlane(vdst+(slot)))
  const int vb0=(int)(lds0+LDS_V)+((lane>>4)&1)*32+(lane&3)*8+(4*hi+((lane&15)>>2))*64;
  const char*Kbase=shm+LDS_K; bf16x8 kf[8];
  const lds_cptr shm3=(lds_cptr)shm; const lds_cptr kp0=shm3+LDS_K+hi*1024+r32*16; const lds_cptr vp0=shm3+LDS_V+((lane>>4)&1)*32+(lane&3)*8+(4*hi+((lane&15)>>2))*64;
  const lds_fptr nb0=(lds_fptr)(shm3+LDS_NB)+4*hi;
  DMA_K(0,0);DMA_V(0,0);DMA_K(1,SLOTB);
  bf16x8 qr[4];
  #pragma unroll
  for(int d0=0;d0<4;++d0)qr[d0]=*reinterpret_cast<const bf16x8*>(&Qw[(long)r32*DMI+d0*16+hi*8]);
  float mhat=0.f,l_reg=0.f;f32x16 o[2];o[0]=f32x16{};o[1]=f32x16{};
  const int qrel=wid*QBLK+r32;
  #define CMASK(P0,P1,t) do{int jb_=(t)-(NT-4); if(jb_>=0)cmask(P0,P1,jb_,qrel,hi);}while(0)
  #define PRELOAD(P0,P1,tt) do{ const lds_fptr nbp_=nb0+(tt)*KVBLK; \
    _Pragma("unroll") for(int g_=0;g_<4;++g_){ const f32x4 a_=*(const __attribute__((address_space(3))) f32x4*)(nbp_+8*g_), b_=*(const __attribute__((address_space(3))) f32x4*)(nbp_+32+8*g_); \
      P0[4*g_]=a_[0]-mhat;P0[4*g_+1]=a_[1]-mhat;P0[4*g_+2]=a_[2]-mhat;P0[4*g_+3]=a_[3]-mhat; P1[4*g_]=b_[0]-mhat;P1[4*g_+1]=b_[1]-mhat;P1[4*g_+2]=b_[2]-mhat;P1[4*g_+3]=b_[3]-mhat; } }while(0)
  bool resc=false;
  #define START(P0,P1) do{ const float rm=rowmax(P0,P1); resc=false; \
    { const float dl=rm; mhat=fadd_s(mhat,dl); \
      _Pragma("unroll") for(int r=0;r<16;++r){P0[r]=fsub_s(P0[r],dl);P1[r]=fsub_s(P1[r],dl);} } \
    _Pragma("unroll") for(int r=0;r<16;++r)P0[r]=__builtin_amdgcn_exp2f(P0[r]); }while(0)
  #define RESC() do{ if(resc){ asm volatile("s_waitcnt lgkmcnt(0)":::"memory"); \
      _Pragma("unroll") for(int d_=0;d_<2;++d_) _Pragma("unroll") for(int r=0;r<16;++r)o[d_][r]*=wsf[crow(r,hi)]; } }while(0)
  f32x16 pA0,pA1,pB0,pB1;
  int sl_prev=0,sl_cur=0,sl_next=SLOTB;
  #define ROT() do{sl_prev=sl_cur;sl_cur=sl_next;sl_next=(sl_next==(NSLOT-1)*SLOTB)?0:sl_next+SLOTB;}while(0)
  DMA_K(2,2*SLOTB);
  WAIT_BAR(3);
  PRELOAD(pA0,pA1,0);
  qkt(pA0,pA1,Kbase,qr,r32,hi);asm volatile("s_nop 15\n\ts_nop 7":"+v"(pA0),"+v"(pA1));CMASK(pA0,pA1,0);
  START(pA0,pA1);
  _Pragma("unroll") for(int r=0;r<16;++r)pA1[r]=__builtin_amdgcn_exp2f(pA1[r]);
  WAIT_BAR(0);
  DMA_K(3,0);DMA_V(1,SLOTB);
  ROT();
  kload8(kf,kp0+sl_cur);
  PRELOAD(pB0,pB1,1);
  WAIT_BAR(2);
  s16x4 vlo[8],vhi[8]; u32x4 pw0,pw1,pw2,pw3;
  #define PKW(P,B) cvtpk_s(P[B],P[B+1])
  #define PAF(k) __builtin_bit_cast(bf16x8,pw##k)
  #define VFR(i) (bf16x8){vlo[i][0],vlo[i][1],vlo[i][2],vlo[i][3],vhi[i][0],vhi[i][1],vhi[i][2],vhi[i][3]}
  #define PIN(x) asm volatile("":"+v"(x))
  #define MX3(a,b,c) __builtin_fmaxf(__builtin_fmaxf((a),(b)),(c))
  #define GAPA(MF,A0,A1,A2,A3,W0,W1,PW) do{ MF; sacc+=A0; sacc+=A1; sacc+=A2; sacc+=A3; PIN(sacc); W0; W1; PIN(PW); SBAR(); }while(0)
  #define EX(v) __builtin_amdgcn_exp2f(v)
  #define GAPB(MF,X,B) do{ MF; X[B]=EX(X[B]); X[B+1]=EX(X[B+1]); X[B+2]=EX(X[B+2]); X[B+3]=EX(X[B+3]); PIN(X); SBAR(); }while(0)
  #define VRD(i) do{ vlo[i]=vtr(vp_+(((i)>>2)*4096+((i)&3)*1024)); vhi[i]=vtr(vp_+(((i)>>2)*4096+((i)&3)*1024+512)); }while(0)
  #define KRD(G,j) do{ if(G){ kload2(kf,kp0+sl_next,j); SBAR(); } }while(0)
  #define STEP(C0,C1,P0,P1,t,GK,GV,GL) do{ SBAR(); \
    const lds_cptr vp_=vp0+sl_prev; \
    VRD(0); SBAR(); float sacc=(P0[0]+P0[1]); \
    GAPA(C0=__builtin_amdgcn_mfma_f32_32x32x16_bf16(kf[0],qr[0],C0,0,0,0), P0[2],P0[3],P0[4],P0[5],     pw0[0]=PKW(P0,0), pw0[1]=PKW(P0,2), pw0); \
    VRD(4); SBAR(); GAPA(C1=__builtin_amdgcn_mfma_f32_32x32x16_bf16(kf[1],qr[0],C1,0,0,0), P0[6],P0[7],P0[8],P0[9],     pw0[2]=PKW(P0,4), pw0[3]=PKW(P0,6), pw0); \
    VRD(1); SBAR(); GAPA(C0=__builtin_amdgcn_mfma_f32_32x32x16_bf16(kf[2],qr[1],C0,0,0,0),   P0[10],P0[11],P0[12],P0[13], pw1[0]=PKW(P0,8), pw1[1]=PKW(P0,10), pw1); \
    VRD(5); SBAR(); GAPA(C1=__builtin_amdgcn_mfma_f32_32x32x16_bf16(kf[3],qr[1],C1,0,0,0),   P0[14],P0[15],P1[0],P1[1],   pw1[2]=PKW(P0,12),pw1[3]=PKW(P0,14), pw1); \
    VRD(2); SBAR(); GAPA(C0=__builtin_amdgcn_mfma_f32_32x32x16_bf16(kf[4],qr[2],C0,0,0,0),   P1[2],P1[3],P1[4],P1[5],     pw2[0]=PKW(P1,0), pw2[1]=PKW(P1,2), pw2); \
    VRD(6); SBAR(); GAPA(C1=__builtin_amdgcn_mfma_f32_32x32x16_bf16(kf[5],qr[2],C1,0,0,0),   P1[6],P1[7],P1[8],P1[9],     pw2[2]=PKW(P1,4), pw2[3]=PKW(P1,6), pw2); \
    VRD(3); SBAR(); GAPA(C0=__builtin_amdgcn_mfma_f32_32x32x16_bf16(kf[6],qr[3],C0,0,0,0),   P1[10],P1[11],P1[12],P1[13], pw3[0]=PKW(P1,8), pw3[1]=PKW(P1,10), pw3); \
    VRD(7); SBAR(); GAPA(C1=__builtin_amdgcn_mfma_f32_32x32x16_bf16(kf[7],qr[3],C1,0,0,0),   P1[14],P1[15],0.f,0.f,       pw3[2]=PKW(P1,12),pw3[3]=PKW(P1,14), pw3); \
    l_reg+=sacc; \
    if(GK){DMA_K((t)+3,sl_cur);} if(GV){DMA_V((t)+1,sl_next);} \
    CMASK(C0,C1,t); \
    { float a=MX3(C0[0],C0[1],C1[0]),b=MX3(C0[2],C0[3],C1[1]); a=MX3(a,C1[2],C1[3]); \
      _Pragma("unroll") for(int r=4;r<16;r+=4){a=MX3(a,C0[r],C0[r+1]);b=MX3(b,C0[r+2],C0[r+3]);a=MX3(a,C1[r],C1[r+1]);b=MX3(b,C1[r+2],C1[r+3]);} \
      float rm=__builtin_fmaxf(a,b); { auto rr=__builtin_amdgcn_permlane32_swap(__float_as_uint(rm),__float_as_uint(rm),false,false); rm=__builtin_fmaxf(__uint_as_float(rr[0]),__uint_as_float(rr[1])); } \
      resc=false; \
      if(__builtin_expect(__any(rm>(float)THRL),0)){ const float dl=__builtin_fmaxf(rm,0.f); mhat+=dl; \
        _Pragma("unroll") for(int r=0;r<16;++r){C0[r]-=dl;C1[r]-=dl;} \
        const float f=__builtin_amdgcn_exp2f(-dl); l_reg*=f; if(hi==0)wsf[r32]=f; resc=true; } } \
    SBAR(); \
    GAPB(o[0]=__builtin_amdgcn_mfma_f32_32x32x16_bf16(PAF(0),VFR(0),o[0],0,0,0), C0,0); \
    GAPB(o[1]=__builtin_amdgcn_mfma_f32_32x32x16_bf16(PAF(0),VFR(4),o[1],0,0,0), C0,4); \
    KRD(GL,0); GAPB(o[0]=__builtin_amdgcn_mfma_f32_32x32x16_bf16(PAF(1),VFR(1),o[0],0,0,0), C0,8); \
    KRD(GL,1); GAPB(o[1]=__builtin_amdgcn_mfma_f32_32x32x16_bf16(PAF(1),VFR(5),o[1],0,0,0), C0,12); \
    KRD(GL,2); GAPB(o[0]=__builtin_amdgcn_mfma_f32_32x32x16_bf16(PAF(2),VFR(2),o[0],0,0,0), C1,0); \
    KRD(GL,3); GAPB(o[1]=__builtin_amdgcn_mfma_f32_32x32x16_bf16(PAF(2),VFR(6),o[1],0,0,0), C1,4); \
    GAPB(o[0]=__builtin_amdgcn_mfma_f32_32x32x16_bf16(PAF(3),VFR(3),o[0],0,0,0), C1,8); \
    GAPB(o[1]=__builtin_amdgcn_mfma_f32_32x32x16_bf16(PAF(3),VFR(7),o[1],0,0,0), C1,12); \
    if(GL){ PRELOAD(P0,P1,(t)+1); } \
    }while(0)
  int t=1;
  #undef CMASK
  #define CMASK(P0,P1,t) do{}while(0)
  for(;t+5<NT;t+=2){
    STEP(pB0,pB1,pA0,pA1,t,true,true,true);     WAIT_BAR(2); RESC(); ROT();
    STEP(pA0,pA1,pB0,pB1,t+1,true,true,true);   WAIT_BAR(2); RESC(); ROT();
  }
  #undef CMASK
  #define CMASK(P0,P1,t) do{int jb_=(t)-(NT-4); if(jb_>=0)cmask(P0,P1,jb_,qrel,hi);}while(0)
  #define ENDW(tt) do{ if((tt)+3<NT){WAIT_BAR(2);} else if((tt)+2<NT){WAIT_BAR(1);} else {WAIT_BAR(0);} }while(0)
  for(;t+1<NT;t+=2){
    STEP(pB0,pB1,pA0,pA1,t,(t+3<NT),(t+1<NT),(t+1<NT));       ENDW(t);   RESC(); ROT();
    STEP(pA0,pA1,pB0,pB1,t+1,(t+4<NT),(t+2<NT),(t+2<NT));     ENDW(t+1); RESC(); ROT();
  }
  STEP(pB0,pB1,pA0,pA1,NT-1,false,false,false); RESC();
  { float sacc=pB0[0]+pB0[1]; _Pragma("unroll") for(int r=2;r<16;++r)sacc+=pB0[r]; _Pragma("unroll") for(int r=0;r<16;++r)sacc+=pB1[r]; l_reg+=sacc;
    pw0=(u32x4){PKW(pB0,0),PKW(pB0,2),PKW(pB0,4),PKW(pB0,6)};pw1=(u32x4){PKW(pB0,8),PKW(pB0,10),PKW(pB0,12),PKW(pB0,14)};pw2=(u32x4){PKW(pB1,0),PKW(pB1,2),PKW(pB1,4),PKW(pB1,6)};pw3=(u32x4){PKW(pB1,8),PKW(pB1,10),PKW(pB1,12),PKW(pB1,14)};
    SBAR(); pv(o,vb0+sl_cur,PAF(0),PAF(1),PAF(2),PAF(3)); }
  #undef PKW
  #undef PAF
  #undef VFR
  #undef PIN
  #undef MX3
  #undef GAPA
  #undef GAPB
  #undef EX
  #undef VRD
  #undef KRD
  #undef STEP
  #undef ENDW
  {auto rr=__builtin_amdgcn_permlane32_swap(__float_as_uint(l_reg),__float_as_uint(l_reg),false,false);l_reg=__uint_as_float(rr[0])+__uint_as_float(rr[1]);}
  if(hi==0)wsf[32+r32]=l_reg;asm volatile("s_waitcnt lgkmcnt(0)":::"memory");
  float rli[16];
  #pragma unroll
  for(int r=0;r<16;++r)rli[r]=__builtin_amdgcn_rcpf(wsf[32+crow(r,hi)]);
  bf16h*Ow=O+(rowbase+q0+wid*QBLK)*DMO+h*D;
  { bf16h*stg=(bf16h*)(shm+LDS_OST)+wid*2048;
    #pragma unroll
    for(int r=0;r<16;++r){const int orow=crow(r,hi);
      #pragma unroll
      for(int d0=0;d0<2;++d0)stg[orow*64+d0*32+r32]=__float2bfloat16(o[d0][r]*rli[r]);}
    asm volatile("s_waitcnt lgkmcnt(0)":::"memory");
    #pragma unroll
    for(int i=0;i<4;++i){const int row=i*8+(lane>>3),ch=lane&7; const u32x4 v=*(const u32x4*)(stg+row*64+ch*8); *(u32x4*)(Ow+(long)row*DMO+ch*8)=v;} }
  asm volatile("s_waitcnt lgkmcnt(0)\n\ts_barrier":::"memory");
  #undef DMA_K
  #undef DMA_V
  #undef CMASK
  #undef PRELOAD
  #undef START
  #undef RESC
  #undef ROT
}

__device__ __forceinline__ int unit_j0_wave(int bh,int qb,const bf16h*Q,const float*KN2,const float*CL,int lane){
  const int b=bh/NHEAD,h=bh%NHEAD; constexpr int NTT=SEQ/KVBLK;
  float mx=0.f;
  #pragma unroll
  for(int rr=0;rr<QB/64;++rr){ const bf16h*Qw=Q+((long)b*SEQ+qb*QB+rr*64+lane)*DMI+h*D; float ss=0.f;
    #pragma unroll
    for(int c=0;c<8;++c){ const u32x4 v=*reinterpret_cast<const u32x4*>(&Qw[c*8]);
      #pragma unroll
      for(int e=0;e<4;++e){ const float f0=__uint_as_float(v[e]<<16),f1=__uint_as_float(v[e]&0xffff0000u); ss+=f0*f0+f1*f1; } }
    mx=fmaxf(mx,ss); }
  #pragma unroll
  for(int o=1;o<64;o<<=1) mx=fmaxf(mx,__shfl_xor(mx,o));
  const int nt=4*qb; const float*kn=KN2+bh*NTT;
  const float Qn=sqrtf(mx),KNd=sqrtf(fmaxf(fmaxf(kn[nt],kn[nt+1]),fmaxf(kn[nt+2],kn[nt+3])));
  const float clt0=CL[qb*QB];
  int first=nt;
  #pragma unroll
  for(int part=1;part>=0;--part){ const int i=lane+64*part; bool need=false;
    if(i<nt){ const float bound=Qn*(sqrtf(kn[i])+KNd)+clt0-CL[KVBLK*i+KVBLK-1]; need=!(bound<-40.f); }
    const unsigned long long bal=__ballot(need); if(bal) first=__ffsll((long long)bal)-1+64*part; }
  return (first<nt?first:nt)&~1;
}
#undef SBAR
#undef WAIT_BAR
}

#define GAS __attribute__((address_space(1)))
#define LAS __attribute__((address_space(3)))
typedef unsigned v4u __attribute__((ext_vector_type(4)));
typedef float f32x4 __attribute__((ext_vector_type(4)));
typedef GAS unsigned gu32;
#define RLX_AGENT __ATOMIC_RELAXED, __HIP_MEMORY_SCOPE_AGENT
#define LDS_WAIT() asm volatile("s_waitcnt lgkmcnt(0)" ::: "memory")
#define VM_WAIT() asm volatile("s_waitcnt vmcnt(0)" ::: "memory")
__device__ __forceinline__ unsigned pk2(float lo, float hi) { return (unsigned)f2bf(lo) | ((unsigned)f2bf(hi) << 16); }
__device__ __forceinline__ void unpack8(const v4u w, float* f) {
#pragma unroll
    for (int i = 0; i < 4; ++i) { f[2 * i] = __uint_as_float(w[i] << 16); f[2 * i + 1] = __uint_as_float(w[i] & 0xffff0000u); }
}

#define XB_TMO      128
#define XB_XCNT(j)  (256  + 64 * (j))
#define XB_XSUB(j)  (1280 + 64 * (j))
#define XB_XGEN(j)  (2304 + 64 * (j))
#define XB_TOP      3328
#define XB_TOPGEN   3392
#define XCD_BAR_WORDS 3456
#define XB_SPIN_CAP (1u << 18)
__device__ __forceinline__ unsigned xb_ld(unsigned* p)              { return __hip_atomic_load(p, __ATOMIC_RELAXED, __HIP_MEMORY_SCOPE_AGENT); }
__device__ __forceinline__ unsigned xb_add(unsigned* p, unsigned v) { return __hip_atomic_fetch_add(p, v, __ATOMIC_RELAXED, __HIP_MEMORY_SCOPE_AGENT); }
__device__ __forceinline__ unsigned xb_xcc_id() { return (unsigned)__builtin_amdgcn_s_getreg((3 << 11) | 20) & 0xFu; }
#define XB_SPIN(cond, bar) do { unsigned _sp = 0; while (cond) { __builtin_amdgcn_s_sleep(1); \
    if ((++_sp & 255u) == 0u) { if (xb_ld(&(bar)[XB_TMO])) break; if (_sp > XB_SPIN_CAP) { atomicAdd(&(bar)[XB_TMO], 1u); break; } } } } while (0)
struct XcdBarrier { unsigned* bar; unsigned x; volatile LAS unsigned* st; };
__device__ __forceinline__ XcdBarrier xcd_barrier_post(unsigned* bar, volatile LAS unsigned* st) {
    XcdBarrier b; b.bar = bar; b.x = xb_xcc_id(); b.st = st;
    if (threadIdx.x == 0) (void)xb_add(&bar[XB_XCNT(b.x)], 1u);
    return b;
}
__device__ __forceinline__ void xcd_barrier_complete(unsigned* bar, unsigned x, unsigned& nloc, unsigned& nx) {
    const unsigned G = gridDim.x * gridDim.y * gridDim.z;
    unsigned sum, cnt, mine, sp = 0u;
    for (;;) {
        sum = 0u; cnt = 0u; mine = 0u;
#pragma unroll
        for (unsigned j = 0; j < 16; ++j) { const unsigned c = xb_ld(&bar[XB_XCNT(j)]); sum += c; cnt += (c > 0u) ? 1u : 0u; mine = (j == x) ? c : mine; }
        if (sum == G) break;
        __builtin_amdgcn_s_sleep(1);
        if ((++sp & 255u) == 0u) { if (xb_ld(&bar[XB_TMO])) break; if (sp > XB_SPIN_CAP) { atomicAdd(&bar[XB_TMO], 1u); break; } }
    }
    nloc = mine > 0u ? mine : 1u; nx = cnt > 0u ? cnt : 1u;
}
__device__ __forceinline__ void xcd_barrier(const XcdBarrier& b) {
    asm volatile("s_waitcnt vmcnt(0)" ::: "memory");
    __syncthreads();
    if (threadIdx.x == 0) {
        unsigned* bar = b.bar;
        __builtin_amdgcn_s_waitcnt(0);
        unsigned nloc = b.st[0], nx = b.st[1];
        if (nloc == 0u) { xcd_barrier_complete(bar, b.x, nloc, nx); b.st[0] = nloc; b.st[1] = nx; }
        const unsigned old = xb_add(&bar[XB_XSUB(b.x)], 1u);
        const unsigned gen = old / nloc;
        if (old + 1u == (gen + 1u) * nloc) {
            __builtin_amdgcn_fence(__ATOMIC_RELEASE, "agent");
            asm volatile("s_waitcnt vmcnt(0)" ::: "memory");
            const unsigned og = xb_add(&bar[XB_TOP], 1u);
            const unsigned tg = og / nx;
            if (og + 1u == (tg + 1u) * nx) xb_add(&bar[XB_TOPGEN], 1u);
            else XB_SPIN(xb_ld(&bar[XB_TOPGEN]) == tg, bar);
            __builtin_amdgcn_fence(__ATOMIC_ACQUIRE, "agent");
            xb_add(&bar[XB_XGEN(b.x)], 1u);
            asm volatile("s_waitcnt vmcnt(0)" ::: "memory");
        } else {
            XB_SPIN(xb_ld(&bar[XB_XGEN(b.x)]) == gen, bar);
            __builtin_amdgcn_fence(__ATOMIC_ACQUIRE, "agent");
            asm volatile("s_waitcnt vmcnt(0)" ::: "memory");
        }
    }
    __syncthreads();
}


namespace xat {
typedef short bf16x8 __attribute__((ext_vector_type(8)));
typedef short s16x4 __attribute__((ext_vector_type(4)));
typedef float f32x16 __attribute__((ext_vector_type(16)));
constexpr int RB = 272;
constexpr int KIMG = 0, VIMG = 128 * RB, LDS_BYTES = 2 * 128 * RB;
__device__ __forceinline__ unsigned cvtpk(float lo, float hi) { typedef float f2 __attribute__((ext_vector_type(2))); typedef __bf16 b2 __attribute__((ext_vector_type(2))); f2 v = {lo, hi}; b2 b = __builtin_convertvector(v, b2); return __builtin_bit_cast(unsigned, b); }
__device__ __forceinline__ float swapmax(float m) { auto rr = __builtin_amdgcn_permlane32_swap(__float_as_uint(m), __float_as_uint(m), false, false); return fmaxf(__uint_as_float(rr[0]), __uint_as_float(rr[1])); }
__device__ __forceinline__ float swapadd(float m) { auto rr = __builtin_amdgcn_permlane32_swap(__float_as_uint(m), __float_as_uint(m), false, false); return __uint_as_float(rr[0]) + __uint_as_float(rr[1]); }
__device__ __forceinline__ void unit(int b, int head, int qb, const bf16* QX, const bf16* KX, const bf16* VT, bf16* OX, LAS unsigned char* lds) {
    int tid = threadIdx.x; asm volatile("" : "+v"(tid));
    const int lane = tid & 63, r32 = lane & 31, h = lane >> 5, wid = tid >> 6;
    const size_t qrow = (size_t)b * SEQ + (size_t)qb * 256 + wid * 32 + r32;
    bf16x8 qf[8];
#pragma unroll
    for (int d0 = 0; d0 < 8; ++d0) qf[d0] = *(const bf16x8*)(QX + qrow * 512 + head * 128 + 16 * d0 + 8 * h);
    f32x16 o[4];
#pragma unroll
    for (int db = 0; db < 4; ++db) o[db] = (f32x16){};
    float mrun = -INFINITY, lsum = 0.f;
#pragma unroll 1
    for (int half = 0; half < 2; ++half) {
        __syncthreads();
#pragma unroll
        for (int i = 0; i < 4; ++i) { const int c = tid + 512 * i, row = c >> 4, ch = c & 15;
            const v4u kv = *(const GAS v4u*)(KX + ((size_t)b * NMEM + half * 128 + row) * 512 + head * 128 + ch * 8);
            const v4u vv = *(const GAS v4u*)(VT + ((size_t)head * 128 + row) * 512 + b * NMEM + half * 128 + ch * 8);
            *(LAS v4u*)(lds + KIMG + row * RB + ch * 16) = kv; *(LAS v4u*)(lds + VIMG + row * RB + ch * 16) = vv; }
        __syncthreads();
        f32x16 st[4];
#pragma unroll
        for (int kb = 0; kb < 4; ++kb) { st[kb] = (f32x16){};
#pragma unroll
            for (int d0 = 0; d0 < 8; ++d0) { const bf16x8 a = *(const LAS bf16x8*)(lds + KIMG + (32 * kb + r32) * RB + (16 * d0 + 8 * h) * 2);
                st[kb] = __builtin_amdgcn_mfma_f32_32x32x16_bf16(a, qf[d0], st[kb], 0, 0, 0); } }
        float mloc = st[0][0];
#pragma unroll
        for (int kb = 0; kb < 4; ++kb)
#pragma unroll
            for (int i = 0; i < 16; ++i) mloc = fmaxf(mloc, st[kb][i]);
        const float mnew = fmaxf(mrun, swapmax(mloc)), alpha = __builtin_amdgcn_exp2f(mrun - mnew);
        float psum = 0.f;
#pragma unroll
        for (int kb = 0; kb < 4; ++kb)
#pragma unroll
            for (int i = 0; i < 16; ++i) { st[kb][i] = __builtin_amdgcn_exp2f(st[kb][i] - mnew); psum += st[kb][i]; }
        lsum = lsum * alpha + psum; mrun = mnew;
#pragma unroll
        for (int db = 0; db < 4; ++db)
#pragma unroll
            for (int i = 0; i < 16; ++i) o[db][i] *= alpha;
#pragma unroll
        for (int kb = 0; kb < 4; ++kb)
#pragma unroll
            for (int sp = 0; sp < 2; ++sp) {
                v4u pw; pw.x = cvtpk(st[kb][8 * sp], st[kb][8 * sp + 1]); pw.y = cvtpk(st[kb][8 * sp + 2], st[kb][8 * sp + 3]); pw.z = cvtpk(st[kb][8 * sp + 4], st[kb][8 * sp + 5]); pw.w = cvtpk(st[kb][8 * sp + 6], st[kb][8 * sp + 7]);
                const bf16x8 pb = __builtin_bit_cast(bf16x8, pw);
#pragma unroll
                for (int db = 0; db < 4; ++db) { const LAS unsigned char* vp = lds + VIMG + (32 * db + r32) * RB + (32 * kb + 16 * sp + 4 * h) * 2;
                    const s16x4 lo = *(const LAS s16x4*)vp, hi = *(const LAS s16x4*)(vp + 16);
                    const bf16x8 va = {lo[0], lo[1], lo[2], lo[3], hi[0], hi[1], hi[2], hi[3]};
                    o[db] = __builtin_amdgcn_mfma_f32_32x32x16_bf16(va, pb, o[db], 0, 0, 0); } }
    }
    const float inv = 1.f / swapadd(lsum);
    bf16* orow = OX + qrow * 512 + head * 128;
#pragma unroll
    for (int db = 0; db < 4; ++db)
#pragma unroll
        for (int g = 0; g < 4; ++g) {
            const unsigned long long w = (unsigned long long)cvtpk(o[db][4 * g] * inv, o[db][4 * g + 1] * inv) | ((unsigned long long)cvtpk(o[db][4 * g + 2] * inv, o[db][4 * g + 3] * inv) << 32);
            *(GAS unsigned long long*)(orow + 32 * db + 8 * g + 4 * h) = w; }
}
}


namespace mls {
typedef short bf16x8 __attribute__((ext_vector_type(8)));
typedef short s16x4 __attribute__((ext_vector_type(4)));
typedef float f32x16 __attribute__((ext_vector_type(16)));
constexpr int RB = 128, VIMG = 0, KIMG = 8192, ATAB = 8192, NTAB = 8448;
__device__ __forceinline__ s16x4 trd(const LAS unsigned char* p) { typedef short v4i16_t __attribute__((ext_vector_type(4))); return __builtin_bit_cast(s16x4, __builtin_amdgcn_ds_read_tr16_b64_v4i16((LAS v4i16_t*)p)); }
__device__ __forceinline__ bf16x8 cat8(s16x4 lo, s16x4 hi) { return (bf16x8){lo[0], lo[1], lo[2], lo[3], hi[0], hi[1], hi[2], hi[3]}; }
__device__ __forceinline__ unsigned cvtpk(float lo, float hi) { typedef float f2 __attribute__((ext_vector_type(2))); typedef __bf16 b2 __attribute__((ext_vector_type(2))); f2 v = {lo, hi}; b2 b = __builtin_convertvector(v, b2); return __builtin_bit_cast(unsigned, b); }
__device__ __forceinline__ bf16x8 pack8(const float* f) { v4u w; w.x = cvtpk(f[0], f[1]); w.y = cvtpk(f[2], f[3]); w.z = cvtpk(f[4], f[5]); w.w = cvtpk(f[6], f[7]); return __builtin_bit_cast(bf16x8, w); }
__device__ __forceinline__ float swapadd(float m) { auto rr = __builtin_amdgcn_permlane32_swap(__float_as_uint(m), __float_as_uint(m), false, false); return __uint_as_float(rr[0]) + __uint_as_float(rr[1]); }
__device__ __forceinline__ int crow(int r, int hi) { return (r & 3) + 8 * (r >> 2) + 4 * hi; }

__device__ __forceinline__ void u_unit(const Ptrs& P, int bhk, LAS unsigned char* wl, int lane) {
    const int bh = bhk / NCH, k = bhk % NCH, b = bh / MH, hd = bh % MH; const size_t row0 = (size_t)b * SEQ + (size_t)k * 64;
    const int r32 = lane & 31, h = lane >> 5;
    const float li = WSP(const float, WS_GATE)[(size_t)hd * M + row0 + lane], bl = WSP(const float, WS_BL)[(size_t)bh * SEQ + k * 64 + lane];
    const float wg = __expf(WSP(const float, WS_BT)[bhk] - bl + li - WSP(const float, WS_MS)[bh * (NCH + 1) + k + 1]);
    const bf16* vsrc = WSP(const bf16, R_T0 + SZ_T) + row0 * 512 + hd * 64; const bf16* ksrc = WSP(const bf16, R_MQK) + row0 * 512 + 256 + hd * 64;
#pragma unroll
    for (int i = 0; i < 8; ++i) { const int row = i * 8 + (lane >> 3), ch = lane & 7;
        *(LAS v4u*)(wl + VIMG + row * RB + ch * 16) = *(const GAS v4u*)(vsrc + (size_t)row * 512 + ch * 8);
        const v4u kk = *(const GAS v4u*)(ksrc + (size_t)row * 512 + ch * 8); float f[8]; unpack8(kk, f); const float w = __shfl(wg, row);
#pragma unroll
        for (int e = 0; e < 8; ++e) f[e] *= w;
        *(LAS bf16x8*)(wl + KIMG + row * RB + ch * 16) = pack8(f); }
    f32x16 acc[2][2];
#pragma unroll
    for (int a = 0; a < 2; ++a)
#pragma unroll
        for (int c = 0; c < 2; ++c) acc[a][c] = (f32x16){};
    const unsigned toff = (unsigned)(((lane & 15) >> 2) * RB + (16 * ((lane >> 4) & 1) + 4 * (lane & 3)) * 2);
#pragma unroll
    for (int st = 0; st < 4; ++st) { bf16x8 af[2], bf_[2];
#pragma unroll
        for (int c = 0; c < 2; ++c) { const LAS unsigned char* pv = wl + VIMG + (16 * st + 8 * h) * RB + toff + 64 * c; af[c] = cat8(trd(pv), trd(pv + 4 * RB));
                                      const LAS unsigned char* pk = wl + KIMG + (16 * st + 8 * h) * RB + toff + 64 * c; bf_[c] = cat8(trd(pk), trd(pk + 4 * RB)); }
#pragma unroll
        for (int jb = 0; jb < 2; ++jb)
#pragma unroll
            for (int ib = 0; ib < 2; ++ib) acc[jb][ib] = __builtin_amdgcn_mfma_f32_32x32x16_bf16(af[jb], bf_[ib], acc[jb][ib], 0, 0, 0); }
    float* UT = WSP(float, R_CST) + (size_t)bhk * 4096;
#pragma unroll
    for (int jb = 0; jb < 2; ++jb)
#pragma unroll
        for (int ib = 0; ib < 2; ++ib)
#pragma unroll
            for (int e = 0; e < 16; ++e) UT[(32 * jb + crow(e, h)) * 64 + 32 * ib + r32] = acc[jb][ib][e];
    float sn = 0.f;
#pragma unroll 8
    for (int r = 0; r < 64; ++r) sn += bf2f(*(const LAS bf16*)(wl + KIMG + r * RB + lane * 2));
    WSP(float, WS_NST)[(size_t)bhk * 64 + lane] = sn;
}

__device__ __forceinline__ void decay_apply(f32x16& tile, int sb, int tb, const LAS float* atab, float mx, float& dsum, int r32, int h) {
#pragma unroll
    for (int g = 0; g < 4; ++g) { const f32x4 av = *(const LAS f32x4*)(atab + 32 * sb + 8 * g + 4 * h);
#pragma unroll
        for (int c = 0; c < 4; ++c) { const int sidx = 32 * sb + 8 * g + 4 * h + c, t = 32 * tb + r32;
            const float w = (sidx <= t) ? __expf(av[c] - mx) : 0.f; tile[4 * g + c] *= w; dsum += tile[4 * g + c]; } }
}
__device__ __forceinline__ bf16x8 packstep(const f32x16& x, int st) { v4u w; w.x = cvtpk(x[8 * st], x[8 * st + 1]); w.y = cvtpk(x[8 * st + 2], x[8 * st + 3]); w.z = cvtpk(x[8 * st + 4], x[8 * st + 5]); w.w = cvtpk(x[8 * st + 6], x[8 * st + 7]); return __builtin_bit_cast(bf16x8, w); }

__device__ __forceinline__ void out_unit(const Ptrs& P, int l, int bhk, LAS unsigned char* wl, int lane) {
    const int bh = bhk / NCH, k = bhk % NCH, b = bh / MH, hd = bh % MH; const size_t row0 = (size_t)b * SEQ + (size_t)k * 64;
    const int r32 = lane & 31, h = lane >> 5;
    const bf16* T1 = WSP(const bf16, R_T0 + SZ_T); const bf16* MQK = WSP(const bf16, R_MQK);
    const bf16* vsrc = T1 + row0 * 512 + hd * 64;
    v4u vreg[8];
#pragma unroll
    for (int i = 0; i < 8; ++i) { const int row = i * 8 + (lane >> 3), ch = lane & 7; vreg[i] = *(const GAS v4u*)(vsrc + (size_t)row * 512 + ch * 8); }
    bf16x8 qf[2][4], kf[2][4];
#pragma unroll
    for (int tb = 0; tb < 2; ++tb)
#pragma unroll
        for (int d0 = 0; d0 < 4; ++d0) { qf[tb][d0] = *(const bf16x8*)(MQK + (row0 + 32 * tb + r32) * 512 + hd * 64 + 16 * d0 + 8 * h);
                                         kf[tb][d0] = *(const bf16x8*)(MQK + (row0 + 32 * tb + r32) * 512 + 256 + hd * 64 + 16 * d0 + 8 * h); }
    const float li_s = WSP(const float, WS_GATE)[(size_t)hd * M + row0 + lane], bl_s = WSP(const float, WS_BL)[(size_t)bh * SEQ + k * 64 + lane];
    const float mk = WSP(const float, WS_MS)[bh * (NCH + 1) + k]; const float nst = WSP(const float, WS_NST)[(size_t)bhk * 64 + lane];
    const float a_s = li_s - bl_s; float pm = a_s;
#pragma unroll
    for (int o = 1; o < 64; o <<= 1) { const float t = __shfl_up(pm, o); if (lane >= o) pm = fmaxf(pm, t); }
    LAS float* atab = (LAS float*)(wl + ATAB); LAS float* ntab = (LAS float*)(wl + NTAB);
    atab[lane] = a_s; ntab[lane] = nst;
    float mx[2], wi[2], blt[2];
#pragma unroll
    for (int tb = 0; tb < 2; ++tb) { const int t = 32 * tb + r32; blt[tb] = __shfl(bl_s, t); mx[tb] = fmaxf(mk, __shfl(pm, t)); wi[tb] = __expf(mk - mx[tb]); }
#pragma unroll
    for (int i = 0; i < 8; ++i) { const int row = i * 8 + (lane >> 3), ch = lane & 7; *(LAS v4u*)(wl + VIMG + row * RB + ch * 16) = vreg[i]; }
    f32x16 s00 = (f32x16){}, s01 = (f32x16){}, s11 = (f32x16){};
#pragma unroll
    for (int d0 = 0; d0 < 4; ++d0) { s00 = __builtin_amdgcn_mfma_f32_32x32x16_bf16(kf[0][d0], qf[0][d0], s00, 0, 0, 0);
        s01 = __builtin_amdgcn_mfma_f32_32x32x16_bf16(kf[0][d0], qf[1][d0], s01, 0, 0, 0); s11 = __builtin_amdgcn_mfma_f32_32x32x16_bf16(kf[1][d0], qf[1][d0], s11, 0, 0, 0); }
    float dsum[2] = {0.f, 0.f};
    decay_apply(s00, 0, 0, atab, mx[0], dsum[0], r32, h); decay_apply(s01, 0, 1, atab, mx[1], dsum[1], r32, h); decay_apply(s11, 1, 1, atab, mx[1], dsum[1], r32, h);
    f32x16 nacc[2][2];
#pragma unroll
    for (int a = 0; a < 2; ++a)
#pragma unroll
        for (int c = 0; c < 2; ++c) nacc[a][c] = (f32x16){};
    const unsigned toff = (unsigned)(((lane & 15) >> 2) * RB + (16 * ((lane >> 4) & 1) + 4 * (lane & 3)) * 2);
#pragma unroll
    for (int sb = 0; sb < 2; ++sb)
#pragma unroll
        for (int st = 0; st < 2; ++st) { bf16x8 va[2];
#pragma unroll
            for (int jb = 0; jb < 2; ++jb) { const LAS unsigned char* pv = wl + VIMG + (32 * sb + 16 * st + 4 * h) * RB + toff + 64 * jb; va[jb] = cat8(trd(pv), trd(pv + 8 * RB)); }
            if (sb == 0) { const bf16x8 p0 = packstep(s00, st), p1 = packstep(s01, st);
#pragma unroll
                for (int jb = 0; jb < 2; ++jb) { nacc[jb][0] = __builtin_amdgcn_mfma_f32_32x32x16_bf16(va[jb], p0, nacc[jb][0], 0, 0, 0); nacc[jb][1] = __builtin_amdgcn_mfma_f32_32x32x16_bf16(va[jb], p1, nacc[jb][1], 0, 0, 0); }
            } else { const bf16x8 p1 = packstep(s11, st);
#pragma unroll
                for (int jb = 0; jb < 2; ++jb) nacc[jb][1] = __builtin_amdgcn_mfma_f32_32x32x16_bf16(va[jb], p1, nacc[jb][1], 0, 0, 0); } }
    const float* CT = WSP(const float, R_CST) + (size_t)bhk * 4096;
    float dint[2] = {0.f, 0.f};
#pragma unroll
    for (int st = 0; st < 4; ++st) { bf16x8 ca[2];
#pragma unroll
        for (int jb = 0; jb < 2; ++jb) { const float* cp = CT + (32 * jb + r32) * 64 + 16 * st + 8 * h; const f32x4 c0 = *(const f32x4*)cp, c1 = *(const f32x4*)(cp + 4);
            const float f[8] = {c0[0], c0[1], c0[2], c0[3], c1[0], c1[1], c1[2], c1[3]}; ca[jb] = pack8(f); }
        const f32x4 n0 = *(const LAS f32x4*)(ntab + 16 * st + 8 * h), n1 = *(const LAS f32x4*)(ntab + 16 * st + 8 * h + 4);
#pragma unroll
        for (int tb = 0; tb < 2; ++tb) { float f[8]; unpack8(__builtin_bit_cast(v4u, qf[tb][st]), f);
            dint[tb] += (f[0] * n0[0] + f[1] * n0[1]) + (f[2] * n0[2] + f[3] * n0[3]) + (f[4] * n1[0] + f[5] * n1[1]) + (f[6] * n1[2] + f[7] * n1[3]);
#pragma unroll
            for (int e = 0; e < 8; ++e) f[e] *= wi[tb];
            const bf16x8 qw = pack8(f);
#pragma unroll
            for (int jb = 0; jb < 2; ++jb) nacc[jb][tb] = __builtin_amdgcn_mfma_f32_32x32x16_bf16(ca[jb], qw, nacc[jb][tb], 0, 0, 0); } }
    const float* nw = P.in[I_MNW] + l * 256 + hd * 64; bf16* CAT = WSP(bf16, R_CAT);
#pragma unroll
    for (int tb = 0; tb < 2; ++tb) {
        const float den = swapadd(dsum[tb]) + wi[tb] * swapadd(dint[tb]);
        const float dinv = 1.f / fmaxf(fabsf(den), __expf(-(blt[tb] + mx[tb])));
        float ss = 0.f;
#pragma unroll
        for (int jb = 0; jb < 2; ++jb)
#pragma unroll
            for (int e = 0; e < 16; ++e) { const float v = nacc[jb][tb][e] * dinv; ss += v * v; }
        const float scale = dinv / sqrtf(swapadd(ss) * (1.f / 64.f) + EPS);
        const size_t row = row0 + 32 * tb + r32;
#pragma unroll
        for (int jb = 0; jb < 2; ++jb)
#pragma unroll
            for (int g = 0; g < 4; ++g) { const int j0 = 32 * jb + 8 * g + 4 * h; const f32x4 nwv = *(const f32x4*)(nw + j0);
                const unsigned long long mo = *(const GAS unsigned long long*)(T1 + row * 512 + 256 + hd * 64 + j0);
                const float m0 = __uint_as_float((unsigned)(mo << 16)), m1 = __uint_as_float((unsigned)mo & 0xffff0000u), m2 = __uint_as_float((unsigned)(mo >> 32) << 16), m3 = __uint_as_float((unsigned)(mo >> 32) & 0xffff0000u);
                const float y0 = nacc[jb][tb][4 * g] * scale * nwv[0] * __builtin_amdgcn_rcpf(1.f + __expf(-m0)), y1 = nacc[jb][tb][4 * g + 1] * scale * nwv[1] * __builtin_amdgcn_rcpf(1.f + __expf(-m1));
                const float y2 = nacc[jb][tb][4 * g + 2] * scale * nwv[2] * __builtin_amdgcn_rcpf(1.f + __expf(-m2)), y3 = nacc[jb][tb][4 * g + 3] * scale * nwv[3] * __builtin_amdgcn_rcpf(1.f + __expf(-m3));
                *(GAS unsigned long long*)(CAT + row * 1024 + hd * 64 + j0) = (unsigned long long)cvtpk(y0, y1) | ((unsigned long long)cvtpk(y2, y3) << 32); }
    }
}
__device__ __forceinline__ void state_scan(const Ptrs& P, long gtid, long gn) {
    const float* DEC = WSP(const float, WS_DEC); float* CST = WSP(float, R_CST); float* NST = WSP(float, WS_NST);
    for (long it = gtid; it < 8 * 4160; it += gn) {
        const int bh = (int)it / 4160, e = (int)it % 4160; float run = 0.f;
        float* base = e < 4096 ? CST + (size_t)bh * NCH * 4096 + e : NST + (size_t)bh * NCH * 64 + (e - 4096); const size_t stride = e < 4096 ? 4096 : 64;
        for (int k0 = 0; k0 < NCH; k0 += 16) { float u[16], d[16];
#pragma unroll
            for (int i = 0; i < 16; ++i) { u[i] = base[(size_t)(k0 + i) * stride]; d[i] = DEC[bh * NCH + k0 + i]; }
#pragma unroll
            for (int i = 0; i < 16; ++i) { base[(size_t)(k0 + i) * stride] = run; run = d[i] * run + u[i]; } }
    }
}
}

constexpr int RING_BYTES = 131072;
constexpr int MISC_OFF = RING_BYTES;
constexpr int PTR_OFF = RING_BYTES + 256;
constexpr int JOB_OFF = RING_BYTES + 512;
constexpr int LDS_BYTES = 147456;
constexpr int NWAVES = 8;

__device__ __forceinline__ float wave_sum(float v) {
#pragma unroll
    for (int o = 1; o < 64; o <<= 1) v += __shfl_xor(v, o);
    return v;
}
struct WJob { const float* W0; const float* W1; const float* rs; bf16* WT; int K, Nsrc, nblk, kind; float cs; int item0; int pad0, pad1; };
constexpr int MAX_JOBS = 32;
__device__ __forceinline__ void p0_transpose_item(const LAS WJob* jb, LAS float* scr, int item, int lane) {
    const int K = jb->K, N = jb->Nsrc, nblk = jb->nblk, kb = item / nblk, nb = item % nblk, k0 = 64 * kb;
    int which, col0; float cs; wmap(jb->kind, nb, which, col0, cs); cs *= jb->cs;
    const float* W = which ? jb->W1 : jb->W0; const float* rs = jb->rs;
    const float* src = W + (size_t)(k0 + (lane >> 5)) * N + col0 + (lane & 31);
    float v[32];
#pragma unroll
    for (int i = 0; i < 32; ++i) v[i] = __builtin_nontemporal_load(src + (size_t)(2 * i) * N);
#pragma unroll
    for (int i = 0; i < 32; ++i) scr[(2 * i + (lane >> 5)) * 33 + (lane & 31)] = v[i];
    LDS_WAIT(); asm volatile("" ::: "memory");
    const int c = lane & 7; bf16* WT = jb->WT;
    f32x4 r0 = {cs, cs, cs, cs}, r1 = r0;
    if (rs) { r0 = *(const f32x4*)(rs + k0 + 8 * c) * cs; r1 = *(const f32x4*)(rs + k0 + 8 * c + 4) * cs; }
#pragma unroll
    for (int j = 0; j < 4; ++j) { const int n = (lane >> 3) + 8 * j; const LAS float* sp = scr + (8 * c) * 33 + n;
        if (jb->pad0) {
            const float q_ = (float)jb->pad0;
            int p0 = __builtin_amdgcn_cvt_pk_fp8_f32(sp[0 * 33] * r0[0] * q_, sp[1 * 33] * r0[1] * q_, 0, false); p0 = __builtin_amdgcn_cvt_pk_fp8_f32(sp[2 * 33] * r0[2] * q_, sp[3 * 33] * r0[3] * q_, p0, true);
            int p1 = __builtin_amdgcn_cvt_pk_fp8_f32(sp[4 * 33] * r1[0] * q_, sp[5 * 33] * r1[1] * q_, 0, false); p1 = __builtin_amdgcn_cvt_pk_fp8_f32(sp[6 * 33] * r1[2] * q_, sp[7 * 33] * r1[3] * q_, p1, true);
            typedef unsigned v2u_ __attribute__((ext_vector_type(2)));
            __builtin_nontemporal_store((v2u_){(unsigned)p0, (unsigned)p1}, (GAS v2u_*)((unsigned char*)WT + (size_t)(nb * 32 + n) * K + k0 + 8 * c));
            continue; }
        v4u o; o.x = pk2(sp[0 * 33] * r0[0], sp[1 * 33] * r0[1]); o.y = pk2(sp[2 * 33] * r0[2], sp[3 * 33] * r0[3]); o.z = pk2(sp[4 * 33] * r1[0], sp[5 * 33] * r1[1]); o.w = pk2(sp[6 * 33] * r1[2], sp[7 * 33] * r1[3]);
        __builtin_nontemporal_store(o, (GAS v4u*)(WT + (size_t)(nb * 32 + n) * K + k0 + 8 * c)); }
    LDS_WAIT(); asm volatile("" ::: "memory");
}
__device__ __forceinline__ void build_gw(const Ptrs& P, long gtid, long gn) {
    for (long it = gtid; it < 3 * 32 * 64; it += gn) {
        const int t = (int)(it / 2048), ks = (int)((it / 64) % 32), ln = (int)(it % 64), c = ln & 15, quad = ln >> 4;
        float hi[8], lo[8];
#pragma unroll
        for (int j = 0; j < 8; ++j) { const int k = 32 * ks + 8 * quad + j; float w;
            if (t < 2) w = P.in[I_NMIX][t * D + k] * P.in[I_WIN][(size_t)t * D * INW + (size_t)k * INW + (c < 8 ? 1024 + c : 3072 + c)];
            else w = (c < 8) ? P.in[I_NFFN][D + k] * P.in[I_RW][(size_t)k * 8 + c] : 0.f;
            const float h = bf2f(f2bf(w)); hi[j] = h; lo[j] = w - h; }
        v4u oh, ol; oh.x = pk2(hi[0], hi[1]); oh.y = pk2(hi[2], hi[3]); oh.z = pk2(hi[4], hi[5]); oh.w = pk2(hi[6], hi[7]); ol.x = pk2(lo[0], lo[1]); ol.y = pk2(lo[2], lo[3]); ol.z = pk2(lo[4], lo[5]); ol.w = pk2(lo[6], lo[7]);
        v4u* tab = (v4u*)(P.ws + WS_GW + (size_t)t * 65536); tab[(ks * 2 + 0) * 64 + ln] = oh; tab[(ks * 2 + 1) * 64 + ln] = ol;
    }
}
template <int MODE, bool PRE>
__device__ __forceinline__ void norm16(const Ptrs& P, int l, const float* src, bf16* XN, const unsigned* rss_in, int vcu, int G, int wave, int lane, LAS float* xch) {
    typedef short bf16x8 __attribute__((ext_vector_type(8)));
    const int r = lane & 15, quad = lane >> 4, kh = wave >> 2;
    const v4u* tab = (const v4u*)(P.ws + WS_GW + (size_t)(MODE == 2 ? 2 : l) * 65536) + lane;
    if constexpr (MODE == 2) { if (wave == 0 && lane < 8) ((LAS unsigned*)(xch + 2048))[64 * 4 + lane] = 0u; }
    for (int t0 = 0; t0 < M / 16; t0 += 4 * G) {
        const int task = t0 + (wave & 3) * G + vcu; const bool live = task < M / 16; const int r0 = (live ? task : 0) * 16;
        const float* xr = src + (size_t)(r0 + r) * D + 8 * quad; bf16* xo = XN + (size_t)(r0 + r) * D + 8 * quad;
        f32x4 acc = {0.f, 0.f, 0.f, 0.f}; float ss = 0.f;
#pragma unroll
        for (int kk = 0; kk < 16; ++kk) { const int ks = 16 * kh + kk;
            if constexpr (PRE) {
                const v4u h = *(const GAS v4u*)(xo + 32 * ks);
                const bf16x8 ah = __builtin_bit_cast(bf16x8, h);
                const bf16x8 bh = __builtin_bit_cast(bf16x8, tab[(ks * 2 + 0) * 64]), bl = __builtin_bit_cast(bf16x8, tab[(ks * 2 + 1) * 64]);
                acc = __builtin_amdgcn_mfma_f32_16x16x32_bf16(ah, bh, acc, 0, 0, 0); acc = __builtin_amdgcn_mfma_f32_16x16x32_bf16(ah, bl, acc, 0, 0, 0);
            } else {
            const f32x4 a = __builtin_nontemporal_load((const GAS f32x4*)(xr + 32 * ks)), b = __builtin_nontemporal_load((const GAS f32x4*)(xr + 32 * ks + 4));
            ss += (a[0] * a[0] + a[1] * a[1]) + (a[2] * a[2] + a[3] * a[3]) + (b[0] * b[0] + b[1] * b[1]) + (b[2] * b[2] + b[3] * b[3]);
            v4u h; h.x = pk2(a[0], a[1]); h.y = pk2(a[2], a[3]); h.z = pk2(b[0], b[1]); h.w = pk2(b[2], b[3]);
            if (live) *(GAS v4u*)(xo + 32 * ks) = h;
            if constexpr (MODE != 0) {
                float hf[8]; unpack8(h, hf);
                v4u lw; lw.x = pk2(a[0] - hf[0], a[1] - hf[1]); lw.y = pk2(a[2] - hf[2], a[3] - hf[3]); lw.z = pk2(b[0] - hf[4], b[1] - hf[5]); lw.w = pk2(b[2] - hf[6], b[3] - hf[7]);
                const bf16x8 ah = __builtin_bit_cast(bf16x8, h), al = __builtin_bit_cast(bf16x8, lw);
                const bf16x8 bh = __builtin_bit_cast(bf16x8, tab[(ks * 2 + 0) * 64]), bl = __builtin_bit_cast(bf16x8, tab[(ks * 2 + 1) * 64]);
                acc = __builtin_amdgcn_mfma_f32_16x16x32_bf16(ah, bh, acc, 0, 0, 0); acc = __builtin_amdgcn_mfma_f32_16x16x32_bf16(al, bh, acc, 0, 0, 0); acc = __builtin_amdgcn_mfma_f32_16x16x32_bf16(ah, bl, acc, 0, 0, 0);
            }
            }
        }
        { LAS float* xp = xch + ((wave & 3) * 64 + lane) * 5;
          if (kh == 1) { xp[0] = acc[0]; xp[1] = acc[1]; xp[2] = acc[2]; xp[3] = acc[3]; xp[4] = ss; }
          __syncthreads();
          if (kh == 0) { acc[0] += xp[0]; acc[1] += xp[1]; acc[2] += xp[2]; acc[3] += xp[3]; ss += xp[4]; }
          __syncthreads(); }
        if constexpr (MODE != 2) { if (kh == 1 || !live) continue; }
        if (MODE != 2 || (kh == 0 && live)) {
        unsigned sq;
        if constexpr (PRE) sq = rss_in[r0 + r]; else { ss += __shfl_xor(ss, 16); ss += __shfl_xor(ss, 32); sq = (unsigned)(ss * 16.f + 0.5f); if (lane < 16) WSP(unsigned, WS_RSTD)[r0 + lane] = sq; }
        ss = (float)sq * (1.f / 16.f);
        const float rstd = 1.f / sqrtf(ss * (1.f / D) + EPS);
        if constexpr (MODE != 0) {
            float z[4];
#pragma unroll
            for (int j = 0; j < 4; ++j) z[j] = acc[j] * __shfl(rstd, 4 * quad + j);
            if constexpr (MODE == 1) {
                const int g = r; f32x4 o;
#pragma unroll
                for (int j = 0; j < 4; ++j) { if (g < 4) o[j] = z[j] + P.in[I_MBI][l * 4 + g]; else if (g < 8) o[j] = logsigmoidf_(z[j] + P.in[I_MBF][l * 4 + g - 4]); else o[j] = logsigmoidf_(z[j] + P.in[I_FBF][l * 8 + g - 8]); }
                *(f32x4*)(WSP(float, WS_GATE) + (size_t)g * M + r0 + 4 * quad) = o;
            } else {
#pragma unroll
                for (int j = 0; j < 4; ++j) { float le[8];
#pragma unroll
                    for (int e = 0; e < 8; ++e) le[e] = __shfl(z[j], (lane & 48) + e);
                    int e1 = 0; float v1 = le[0];
#pragma unroll
                    for (int e = 1; e < 8; ++e) if (le[e] > v1) { v1 = le[e]; e1 = e; }
                    int e2 = -1; float v2 = -INFINITY;
#pragma unroll
                    for (int e = 0; e < 8; ++e) if (e != e1 && le[e] > v2) { v2 = le[e]; e2 = e; }
                    if (r == j) { const float g2 = 1.f / (1.f + expf(v1 - v2)), g1 = 1.f - g2;
                        LAS unsigned* sp = (LAS unsigned*)(xch + 2048) + ((wave & 3) * 16 + 4 * quad + j) * 4;
                        sp[0] = (unsigned)e1; sp[1] = (unsigned)e2; sp[2] = __float_as_uint(g1); sp[3] = __float_as_uint(g2); }
                }
            }
        }
        }
        if constexpr (MODE == 2) {
            LAS unsigned* selb = (LAS unsigned*)(xch + 2048); LAS unsigned* hacc = selb + 64 * 4;
            if (!(kh == 0 && live) && wave < 4 && r < 4) selb[((wave & 3) * 16 + 4 * quad + r) * 4] = 255u;
            __syncthreads();
            if (wave == 0) {
                const int w = lane >> 4, e1 = (int)selb[lane * 4], e2 = (int)selb[lane * 4 + 1]; const bool valid = e1 < 8;
                const unsigned long long below = (1ull << lane) - 1ull; int rank1 = 0, rank2 = 0; unsigned mynew = 0u;
#pragma unroll
                for (int e = 0; e < 8; ++e) { const unsigned old_ = hacc[e];
                    const unsigned long long m1 = __ballot(valid && e1 == e), m2 = __ballot(valid && e2 == e); const int c1 = __popcll(m1);
                    if (e1 == e) rank1 = (int)old_ + __popcll(m1 & below);
                    if (e2 == e) rank2 = (int)old_ + c1 + __popcll(m2 & below);
                    if (lane == e) mynew = old_ + (unsigned)(c1 + __popcll(m2)); }
                if (valid) { const int row = (t0 + w * G + vcu) * 16 + (lane & 15); unsigned* tk = WSP(unsigned, WS_TOK) + (size_t)row * 8;
                    tk[0] = (unsigned)e1; tk[1] = (unsigned)rank1; tk[2] = (unsigned)e2; tk[3] = (unsigned)rank2; tk[4] = selb[lane * 4 + 2]; tk[5] = selb[lane * 4 + 3]; }
                if (lane < 8) hacc[lane] = mynew;
            }
            __syncthreads();
        }
    }
    if constexpr (MODE == 2) { if (wave == 0 && lane < 8) WSP(unsigned, WS_BH)[vcu * 8 + lane] = ((LAS unsigned*)(xch + 2048))[64 * 4 + lane]; }
}
template <int MODE>
__device__ __forceinline__ void norm_rows(const Ptrs& P, int l, const float* src, bf16* XN, int nrows, int gw, int ngw, int lane) {
    for (int row = gw; row < nrows; row += ngw) {
        const GAS f32x4* xr = (const GAS f32x4*)(src + (size_t)row * D) + lane;
        f32x4 v[4]; float s2 = 0.f;
#pragma unroll
        for (int j = 0; j < 4; ++j) { v[j] = xr[64 * j]; s2 += (v[j].x * v[j].x + v[j].y * v[j].y) + (v[j].z * v[j].z + v[j].w * v[j].w); }
        const float rstd = 1.f / sqrtf(wave_sum(s2) * (1.f / D) + EPS);
        GAS unsigned long long* o8 = (GAS unsigned long long*)(XN + (size_t)row * D) + lane;
#pragma unroll
        for (int j = 0; j < 4; ++j) o8[64 * j] = (unsigned long long)pk2(v[j].x * rstd, v[j].y * rstd) | ((unsigned long long)pk2(v[j].z * rstd, v[j].w * rstd) << 32);
    }
}

__device__ __forceinline__ float wave_incl_scan(float v, int lane) {
#pragma unroll
    for (int o = 1; o < 64; o <<= 1) { const float t = __shfl_up(v, o); if (lane >= o) v += t; }
    return v;
}
__device__ __forceinline__ float wave_max(float v) {
#pragma unroll
    for (int o = 1; o < 64; o <<= 1) v = fmaxf(v, __shfl_xor(v, o));
    return v;
}
__device__ __forceinline__ void gate_scan_task(const Ptrs& P, int task, LAS float* scr, int tid) {
    const int lane = tid & 63, wave = tid >> 6; const float* GT = WSP(const float, WS_GATE);
    if (task < 16) {
        const int b = task / FH, h = task % FH; constexpr int EPT = SEQ / 512;
        const float* src = GT + (size_t)(8 + h) * M + (size_t)b * SEQ + tid * EPT; float* dst = WSP(float, WS_CF) + (size_t)task * SEQ + tid * EPT;
        float v[EPT]; float run = 0.f;
#pragma unroll
        for (int i = 0; i < EPT; i += 4) { const f32x4 x = *(const f32x4*)(src + i); run += x[0]; v[i] = run; run += x[1]; v[i + 1] = run; run += x[2]; v[i + 2] = run; run += x[3]; v[i + 3] = run; }
        const float wincl = wave_incl_scan(run, lane);
        if (lane == 63) scr[wave] = wincl;
        __syncthreads();
        float offs = wincl - run;
#pragma unroll
        for (int w = 0; w < 8; ++w) if (w < wave) offs += scr[w];
#pragma unroll
        for (int i = 0; i < EPT; i += 4) *(f32x4*)(dst + i) = (f32x4){(offs + v[i]) * LOG2E, (offs + v[i + 1]) * LOG2E, (offs + v[i + 2]) * LOG2E, (offs + v[i + 3]) * LOG2E};
        __syncthreads();
    } else {
        const int bh = task - 16, b = bh / MH, h = bh % MH;
        const float* lfp = GT + (size_t)(4 + h) * M + (size_t)b * SEQ; const float* lip = GT + (size_t)h * M + (size_t)b * SEQ;
        float* BL = WSP(float, WS_BL) + (size_t)bh * SEQ; float* BT = WSP(float, WS_BT) + bh * NCH; float* AK = WSP(float, WS_AK) + bh * NCH; float* MS = WSP(float, WS_MS) + bh * (NCH + 1);
        constexpr int CPW = NCH / 8;
        float lfv[CPW], liv[CPW];
#pragma unroll
        for (int i = 0; i < CPW; ++i) { const int k = wave + 8 * i; lfv[i] = lfp[k * 64 + lane]; liv[i] = lip[k * 64 + lane]; }
#pragma unroll
        for (int i = 0; i < CPW; ++i) { const int k = wave + 8 * i;
            const float bl = wave_incl_scan(lfv[i], lane); BL[k * 64 + lane] = bl;
            const float btot = __shfl(bl, 63); const float a = wave_max(btot - bl + liv[i]);
            if (lane == 0) { BT[k] = btot; AK[k] = a; scr[k] = btot; scr[NCH + k] = a; } }
        __syncthreads();
        if (wave == 0) { float* DEC = WSP(float, WS_DEC) + bh * NCH; constexpr int PL = NCH / 64;
            float f[PL], av[PL]; float run = 0.f;
#pragma unroll
            for (int i = 0; i < PL; ++i) { run += scr[lane * PL + i]; f[i] = run; av[i] = scr[NCH + lane * PL + i]; }
            const float offs = wave_incl_scan(run, lane) - run;
            float pm = -INFINITY; float c[PL];
#pragma unroll
            for (int i = 0; i < PL; ++i) { f[i] += offs; pm = fmaxf(pm, av[i] - f[i]); c[i] = pm; }
            float pin = pm;
#pragma unroll
            for (int o = 1; o < 64; o <<= 1) { const float t = __shfl_up(pin, o); if (lane >= o) pin = fmaxf(pin, t); }
            float pex = __shfl_up(pin, 1); if (lane == 0) pex = -INFINITY;
            float mprev = __shfl_up(fmaxf(0.f, pin) + f[PL - 1], 1); if (lane == 0) mprev = 0.f;
            if (lane == 0) MS[0] = 0.f;
#pragma unroll
            for (int i = 0; i < PL; ++i) { const int k = lane * PL + i; const float mn = f[i] + fmaxf(0.f, fmaxf(pex, c[i]));
                MS[k + 1] = mn; DEC[k] = __expf(scr[k] + mprev - mn); mprev = mn; } }
        __syncthreads();
    }
}
__device__ __forceinline__ void mconv_glu_vec(const Ptrs& P, int l, long gtid, long gn) {
    const bf16* T0 = WSP(const bf16, R_T0); bf16* MQK = WSP(bf16, R_MQK);
    const float* cw = P.in[I_MCW] + l * 4 * 512; const float* cb = P.in[I_MCB] + l * 512;
    for (long it0 = gtid; it0 < (long)M * 64; it0 += 4 * gn) {
        v4u w[4][4]; bool ok[4][4];
#pragma unroll
        for (int r = 0; r < 4; ++r) { const long it = it0 + r * gn; const int ch = (int)(it & 63); const long row = it >> 6; const int t = (int)(row % SEQ), c0 = ch * 8;
#pragma unroll
            for (int j = 0; j < 4; ++j) { ok[r][j] = it < (long)M * 64 && t - 3 + j >= 0; w[r][j] = (v4u){0u, 0u, 0u, 0u}; if (ok[r][j]) w[r][j] = *(const GAS v4u*)(T0 + (size_t)(row - 3 + j) * 512 + c0); } }
#pragma unroll
        for (int r = 0; r < 4; ++r) { const long it = it0 + r * gn; if (it >= (long)M * 64) continue; const int ch = (int)(it & 63); const long row = it >> 6; const int c0 = ch * 8;
            float acc[8];
#pragma unroll
            for (int i = 0; i < 8; ++i) acc[i] = cb[c0 + i];
#pragma unroll
            for (int j = 0; j < 4; ++j) { if (ok[r][j]) { float x[8]; unpack8(w[r][j], x);
#pragma unroll
                    for (int i = 0; i < 8; ++i) acc[i] += cw[j * 512 + c0 + i] * x[i]; } }
            const float sc = (c0 >= 256) ? 0.125f : 1.f; float y[8];
#pragma unroll
            for (int i = 0; i < 8; ++i) y[i] = acc[i] * __builtin_amdgcn_rcpf(1.f + __expf(-acc[i])) * sc;
            v4u o; o.x = pk2(y[0], y[1]); o.y = pk2(y[2], y[3]); o.z = pk2(y[4], y[5]); o.w = pk2(y[6], y[7]);
            *(GAS v4u*)(MQK + (size_t)row * 512 + c0) = o; }
    }
    const bf16* T2 = WSP(const bf16, R_T0 + 2 * SZ_T); bf16* GL = WSP(bf16, R_GL);
    for (long it0 = gtid; it0 < (long)M * 32; it0 += 4 * gn) {
        v4u wa[4], wg[4];
#pragma unroll
        for (int r = 0; r < 4; ++r) { const long it = it0 + r * gn; wa[r] = (v4u){0u, 0u, 0u, 0u}; wg[r] = wa[r];
            if (it < (long)M * 32) { const int c0 = (int)(it & 31) * 8; const long row = it >> 5; wa[r] = *(const GAS v4u*)(T2 + (size_t)row * 512 + c0); wg[r] = *(const GAS v4u*)(T2 + (size_t)row * 512 + 256 + c0); } }
#pragma unroll
        for (int r = 0; r < 4; ++r) { const long it = it0 + r * gn; if (it >= (long)M * 32) continue; const int c0 = (int)(it & 31) * 8; const long row = it >> 5;
            float a[8], g[8]; unpack8(wa[r], a); unpack8(wg[r], g); float y[8];
#pragma unroll
            for (int i = 0; i < 8; ++i) y[i] = a[i] * __builtin_amdgcn_rcpf(1.f + __expf(-g[i]));
            v4u o; o.x = pk2(y[0], y[1]); o.y = pk2(y[2], y[3]); o.z = pk2(y[4], y[5]); o.w = pk2(y[6], y[7]);
            *(GAS v4u*)(GL + (size_t)row * 256 + c0) = o; }
    }
}
__device__ __forceinline__ void cconv_ln_rows(const Ptrs& P, int l, int gw, int ngw, int lane) {
    const bf16* GL = WSP(const bf16, R_GL); bf16* CAT = WSP(bf16, R_CAT);
    const float* cw = P.in[I_CCW] + l * CK * 256 + 4 * lane; const int c0 = 4 * lane;
    const f32x4 cb = *(const f32x4*)(P.in[I_CCB] + l * 256 + c0), lw = *(const f32x4*)(P.in[I_CLW] + l * 256 + c0), lb = *(const f32x4*)(P.in[I_CLB] + l * 256 + c0);
    f32x4 w[CK];
#pragma unroll
    for (int j = 0; j < CK; ++j) w[j] = *(const f32x4*)(cw + j * 256);
    for (int task = gw; task < M / 8; task += ngw) {
        const int r0 = task * 8, t0 = r0 % SEQ;
        unsigned long long x[CK + 7];
#pragma unroll
        for (int i = 0; i < CK + 7; ++i) x[i] = (t0 - (CK - 1) + i >= 0) ? *(const GAS unsigned long long*)(GL + (size_t)(r0 - (CK - 1) + i) * 256 + c0) : 0ull;
        f32x4 acc[8];
#pragma unroll
        for (int o = 0; o < 8; ++o) acc[o] = cb;
#pragma unroll
        for (int i = 0; i < CK + 7; ++i) { const unsigned long long q = x[i];
            const f32x4 xf = {__uint_as_float((unsigned)(q << 16)), __uint_as_float((unsigned)q & 0xffff0000u), __uint_as_float((unsigned)(q >> 32) << 16), __uint_as_float((unsigned)(q >> 32) & 0xffff0000u)};
#pragma unroll
            for (int o = 0; o < 8; ++o) if (i - o >= 0 && i - o < CK) acc[o] += w[i - o] * xf; }
#pragma unroll
        for (int o = 0; o < 8; ++o) {
            const float mean = wave_sum((acc[o][0] + acc[o][1]) + (acc[o][2] + acc[o][3])) * (1.f / 256.f);
            const f32x4 d = acc[o] - mean; const float rstd = 1.f / sqrtf(wave_sum((d[0] * d[0] + d[1] * d[1]) + (d[2] * d[2] + d[3] * d[3])) * (1.f / 256.f) + EPS);
            f32x4 y = d * rstd * lw + lb;
#pragma unroll
            for (int i = 0; i < 4; ++i) y[i] = y[i] * __builtin_amdgcn_rcpf(1.f + __expf(-y[i]));
            *(GAS unsigned long long*)(CAT + (size_t)(r0 + o) * 1024 + 256 + c0) = (unsigned long long)pk2(y[0], y[1]) | ((unsigned long long)pk2(y[2], y[3]) << 32); }
    }
}
__device__ __forceinline__ void fox_keynorms(const Ptrs& P, int gw, int ngw, int lane) {
    const bf16* K = WSP(const bf16, R_T0 + 4 * SZ_T); float* KN2 = WSP(float, WS_KN2); constexpr int NTT = SEQ / 64;
    for (int u = gw; u < BATCH * FH * NTT; u += ngw) { const int bh = u / NTT, tile = u % NTT, b = bh / FH, h = bh % FH;
        const bf16* kr = K + ((size_t)b * SEQ + tile * 64 + lane) * 512 + h * 64; float ss = 0.f;
#pragma unroll
        for (int c = 0; c < 8; ++c) { const v4u v = *(const GAS v4u*)(kr + 8 * c); float f[8]; unpack8(v, f);
#pragma unroll
            for (int e = 0; e < 8; ++e) ss += f[e] * f[e]; }
        ss = wave_max(ss); if (lane == 0) KN2[u] = ss; }
}
__device__ __forceinline__ void moe_gather(const Ptrs& P, int gw, int ngw, int lane, int wave, int vcu, int G, LAS unsigned char* lds) {
    LAS unsigned* base = (LAS unsigned*)lds; LAS unsigned* tot = base + 1024 * 8;
    { const unsigned* BH = WSP(const unsigned, WS_BH); const int per = (G + 63) / 64; unsigned run = 0u;
      for (int k = 0; k < per; ++k) { const int blk = lane * per + k; if (blk < G) run += BH[blk * 8 + wave]; }
      unsigned incl = run;
#pragma unroll
      for (int o = 1; o < 64; o <<= 1) { const unsigned t = __shfl_up(incl, o); if (lane >= o) incl += t; }
      unsigned ex = incl - run;
      for (int k = 0; k < per; ++k) { const int blk = lane * per + k; if (blk < G) { base[blk * 8 + wave] = ex; ex += BH[blk * 8 + wave]; } }
      if (lane == 63) tot[wave] = incl; }
    __syncthreads();
    unsigned* cntg = WSP(unsigned, WS_CTL) + CW_CNT;
    if (vcu == 0 && wave == 0 && lane < 8) cntg[lane] = tot[lane];
    unsigned cnt[8];
#pragma unroll
    for (int e = 0; e < 8; ++e) cnt[e] = tot[e];
    int off[9]; { int o = 0;
#pragma unroll
        for (int e = 0; e < 8; ++e) { off[e] = o; o += ((int)cnt[e] + 255) & ~255; }
        off[8] = o; }
    const bf16* XN = WSP(const bf16, R_XN); bf16* XNS = WSP(bf16, R_XNS); unsigned char* XQ = P.ws + WS_XQ;
    for (int row0 = gw; row0 < M; row0 += 4 * ngw) {
        v4u ta[4], a[4], b[4]; unsigned rv[4];
#pragma unroll
        for (int r = 0; r < 4; ++r) { const int row = row0 + r * ngw; if (row < M) { ta[r] = *(const GAS v4u*)(WSP(unsigned, WS_TOK) + (size_t)row * 8);
                const GAS v4u* srcp = (const GAS v4u*)(XN + (size_t)row * D) + lane; a[r] = __builtin_nontemporal_load(srcp); b[r] = __builtin_nontemporal_load(srcp + 64); rv[r] = WSP(const unsigned, WS_RSS)[(size_t)4 * M + row]; } }
#pragma unroll
        for (int r = 0; r < 4; ++r) { const int row = row0 + r * ngw; if (row < M) {
                unsigned* tk = WSP(unsigned, WS_TOK) + (size_t)row * 8;
                const int e1 = (int)ta[r][0], p1 = (int)ta[r][1], e2 = (int)ta[r][2], p2 = (int)ta[r][3];
                int o1 = 0, o2 = 0;
#pragma unroll
                for (int e = 0; e < 8; ++e) { if (e == e1) o1 = off[e]; if (e == e2) o2 = off[e]; }
                const int blk = (row >> 4) % G;
                const int s1 = o1 + (int)base[blk * 8 + e1] + p1, s2 = o2 + (int)base[blk * 8 + e2] + p2;
                if (lane == 0) { tk[6] = (unsigned)s1; tk[7] = (unsigned)s2; WSP(unsigned, WS_RSTDS)[s1] = rv[r]; WSP(unsigned, WS_RSTDS)[s2] = rv[r];
                    const float g1 = __uint_as_float(tk[4]), g2 = __uint_as_float(tk[5]); WSP(float, WS_SLOTG)[s1] = g1; WSP(float, WS_SLOTG)[s2] = -g2; }
                GAS v4u* d1 = (GAS v4u*)(XNS + (size_t)s1 * D) + lane; d1[0] = a[r]; d1[64] = b[r];
                const float rs_ = rsqrtf((float)rv[r] * (1.f / (16.f * 1024.f)) + 1e-6f) * F8_SA; float fa[8], fb[8]; unpack8(a[r], fa); unpack8(b[r], fb);
                typedef unsigned v2u_ __attribute__((ext_vector_type(2)));
                int qa0 = __builtin_amdgcn_cvt_pk_fp8_f32(fa[0] * rs_, fa[1] * rs_, 0, false); qa0 = __builtin_amdgcn_cvt_pk_fp8_f32(fa[2] * rs_, fa[3] * rs_, qa0, true);
                int qa1 = __builtin_amdgcn_cvt_pk_fp8_f32(fa[4] * rs_, fa[5] * rs_, 0, false); qa1 = __builtin_amdgcn_cvt_pk_fp8_f32(fa[6] * rs_, fa[7] * rs_, qa1, true);
                int qb0 = __builtin_amdgcn_cvt_pk_fp8_f32(fb[0] * rs_, fb[1] * rs_, 0, false); qb0 = __builtin_amdgcn_cvt_pk_fp8_f32(fb[2] * rs_, fb[3] * rs_, qb0, true);
                int qb1 = __builtin_amdgcn_cvt_pk_fp8_f32(fb[4] * rs_, fb[5] * rs_, 0, false); qb1 = __builtin_amdgcn_cvt_pk_fp8_f32(fb[6] * rs_, fb[7] * rs_, qb1, true);
                const v2u_ qa = {(unsigned)qa0, (unsigned)qa1}, qb = {(unsigned)qb0, (unsigned)qb1};
                GAS v2u_* x1 = (GAS v2u_*)(XQ + (size_t)s1 * D) + lane; GAS v2u_* x2 = (GAS v2u_*)(XQ + (size_t)s2 * D) + lane;
                x1[0] = qa; x1[64] = qb; x2[0] = qa; x2[64] = qb; } }
    }
    for (int w = gw; w < 8 * 256; w += ngw) {
        const int e = w >> 8, r = w & 255; int oe = 0, oe1 = 0, ce = 0;
#pragma unroll
        for (int j = 0; j < 8; ++j) if (j == e) { oe = off[j]; oe1 = off[j + 1]; ce = (int)cnt[j]; }
        const int slot = oe + ce + r;
        if (slot < oe1) { GAS v4u* dp = (GAS v4u*)(XNS + (size_t)slot * D) + lane; const v4u z = {0u, 0u, 0u, 0u}; dp[0] = z; dp[64] = z; ((GAS v4u*)(XQ + (size_t)slot * D))[lane] = z;       if (lane == 0) { unsigned zlo = 0u; asm volatile("" : "+v"(zlo)); WSP(unsigned, WS_RSTDS)[slot] = zlo; WSP(float, WS_SLOTG)[slot] = __uint_as_float(zlo); } }
    }
}
__device__ __forceinline__ void moe_combine_final(const Ptrs& P, int gw, int ngw, int lane) {
    const bf16* Y = WSP(const bf16, R_XNS); const float* nw = P.in[I_NFIN];
    for (int row0 = gw; row0 < M; row0 += 4 * ngw) {
        int s1[4], s2[4];
#pragma unroll
        for (int r = 0; r < 4; ++r) { const int row = row0 + r * ngw; const unsigned* tk = WSP(const unsigned, WS_TOK) + (size_t)(row < M ? row : 0) * 8; s1[r] = (int)tk[6]; s2[r] = (int)tk[7]; }
        unsigned long long ya[4][4], yb[4][4];
#pragma unroll
        for (int r = 0; r < 4; ++r) { const GAS unsigned long long* y1 = (const GAS unsigned long long*)(Y + (size_t)s1[r] * D) + lane; const GAS unsigned long long* y2 = (const GAS unsigned long long*)(Y + (size_t)s2[r] * D) + lane;
#pragma unroll
            for (int j = 0; j < 4; ++j) { ya[r][j] = __builtin_nontemporal_load(y1 + 64 * j); yb[r][j] = __builtin_nontemporal_load(y2 + 64 * j); } }
#pragma unroll
        for (int r = 0; r < 4; ++r) { const int row = row0 + r * ngw; if (row < M) {
            GAS f32x4* orow = (GAS f32x4*)(P.xres + (size_t)row * D) + lane;
            f32x4 v[4]; float ssq = 0.f;
#pragma unroll
            for (int j = 0; j < 4; ++j) { const unsigned long long a = ya[r][j], b = yb[r][j];
                v[j].x = bf2f((bf16)(a & 0xffff)) + bf2f((bf16)(b & 0xffff));
                v[j].y = bf2f((bf16)((a >> 16) & 0xffff)) + bf2f((bf16)((b >> 16) & 0xffff));
                v[j].z = bf2f((bf16)((a >> 32) & 0xffff)) + bf2f((bf16)((b >> 32) & 0xffff));
                v[j].w = bf2f((bf16)((a >> 48) & 0xffff)) + bf2f((bf16)((b >> 48) & 0xffff));
                ssq += (v[j].x * v[j].x + v[j].y * v[j].y) + (v[j].z * v[j].z + v[j].w * v[j].w); }
            const float rstd = 1.f / sqrtf(wave_sum(ssq) * (1.f / D) + EPS);
#pragma unroll
            for (int j = 0; j < 4; ++j) { const f32x4 w = *((const f32x4*)nw + lane + 64 * j); __builtin_nontemporal_store(v[j] * rstd * w, orow + 64 * j); } } }
    }
}

#ifndef MK_PER_PHASE
#define MK_PER_PHASE 0
#endif
constexpr int PH_PER_LAYER = 14, N_PHASES = 1 + 2 * PH_PER_LAYER + 1;
__device__ __forceinline__ Ptrs launder(const Ptrs& a) { Ptrs p = a; asm volatile("" : "+s"(p.ws), "+s"(p.xres)); return p; }
struct Args { const float* in[N_IN]; float* xres; unsigned char* ws; int ph_lo, ph_hi; };

__global__ void __launch_bounds__(NWAVES * 64, 2) trunk_fwd(Args args) {
    extern __shared__ __attribute__((aligned(16))) unsigned char lds_raw[];
    LAS unsigned char* lds = (LAS unsigned char*)lds_raw;
    Ptrs P0; P0.in = (const float* const LAS*)(lds + PTR_OFF); P0.xres = args.xres; P0.ws = args.ws;
    const int tid = threadIdx.x, wave0 = __builtin_amdgcn_readfirstlane(tid >> 6);
    const int G0 = gridDim.x; const int bx0 = blockIdx.x; const int vcu0 = (G0 % 8 == 0) ? (bx0 % 8) * (G0 / 8) + bx0 / 8 : bx0;
    volatile LAS unsigned* MISC = (volatile LAS unsigned*)(lds + MISC_OFF);
    if (tid < 64) MISC[tid] = 0u;
    if (tid < N_IN) ((const float* LAS*)(lds + PTR_OFF))[tid] = args.in[tid];
    __syncthreads();
    unsigned* ctl = (unsigned*)(P0.ws + WS_CTL);
    XcdBarrier bar; bar.bar = ctl + CW_BAR; bar.x = 0; bar.st = nullptr;
    if (!MK_PER_PHASE) bar = xcd_barrier_post(ctl + CW_BAR, MISC + 8);
    const int lo = args.ph_lo, hi = args.ph_hi; int ph = 0;
#ifndef SITEMASK
#define SITEMASK 0xffffffffull
#endif
#define SITE(k) ((SITEMASK >> (k)) & 1ull)
#define PH_ON() (ph >= lo && ph < hi)
#define PH_IF(k) if (PH_ON() && SITE(k))
#define PH_CTX() Ptrs P = launder(P0); int tidp = threadIdx.x; asm volatile("" : "+v"(tidp)); int G = G0, bx = bx0, vcu = vcu0, wave = wave0; asm volatile("" : "+s"(G), "+s"(bx), "+s"(vcu), "+s"(wave)); const int gw = vcu * NWAVES + wave, ngw = G * NWAVES; const long gn = (long)G * (NWAVES * 64); const int lane = tidp & 63; const long gtid = (long)bx * (NWAVES * 64) + tidp; (void)lane; (void)gw; (void)gtid; (void)ngw; (void)gn
#define PH_END() do { if (PH_ON() && ph + 1 < hi) { if (!MK_PER_PHASE) { XcdBarrier b2_ = bar; asm volatile("" : "+s"(b2_.bar), "+s"(b2_.x)); xcd_barrier(b2_); } } ++ph; } while (0)

    PH_IF(0) { PH_CTX();
        LAS WJob* jobs = (LAS WJob*)(lds + JOB_OFF);
        if (tid == 0) {
            int nj = 0, item = 0;
#define ADDJOB(W0_, W1_, rs_, dst_, K_, Nsrc_, Ndst_, kind_, cs_) do { LAS WJob* j_ = jobs + nj; j_->W0 = (W0_); j_->W1 = (W1_); j_->rs = (rs_); j_->WT = WSP(bf16, (dst_)); j_->K = (K_); j_->Nsrc = (Nsrc_); \
                j_->nblk = (Ndst_) / 32; j_->pad0 = 0; j_->kind = (kind_); j_->cs = (cs_); j_->item0 = item; item += ((K_) / 64) * ((Ndst_) / 32); ++nj; } while (0)
            for (int l = 0; l < 2; ++l) {
                const size_t wl = R_WL + (size_t)l * WL_SIZE;
                ADDJOB(P.in[I_WIN] + (size_t)l * D * INW, nullptr, P.in[I_NMIX] + l * D, wl + WL_IN, D, INW, NZ, 1, 1.f);
                ADDJOB(P.in[I_WOUT] + (size_t)l * D * D, nullptr, nullptr, wl + WL_OUT, D, D, D, 0, 1.f);
                ADDJOB(P.in[I_WQ] + (size_t)l * D * 512, nullptr, P.in[I_NXA] + l * D, wl + WL_Q, D, 512, 512, 0, XAT_QS);
                ADDJOB(P.in[I_WKV] + (size_t)l * D * 1024, nullptr, P.in[I_NMEM] + l * D, wl + WL_KV, D, 1024, 1024, 0, 1.f);
                ADDJOB(P.in[I_WO] + (size_t)l * 512 * D, nullptr, nullptr, wl + WL_O, 512, D, D, 0, 1.f);
            }
            ADDJOB(P.in[I_FG], P.in[I_FU], P.in[I_NFFN], R_WGU, D, DFF, 2 * DFF, 2, 1.f);
            ADDJOB(P.in[I_FD], nullptr, nullptr, R_WDN, DFF, D, D, 0, 1.f);
            for (int e = 0; e < NE; ++e) {
                ADDJOB(P.in[I_MG] + (size_t)e * D * DFF, P.in[I_MU] + (size_t)e * D * DFF, P.in[I_NFFN] + D, WS_WMGU + (size_t)e * 2 * DFF * D, D, DFF, 2 * DFF, 2, 1.f); jobs[nj - 1].pad0 = (int)F8_SWGU;
                ADDJOB(P.in[I_MD] + (size_t)e * DFF * D, nullptr, nullptr, WS_WMD + (size_t)e * D * DFF, DFF, D, D, 0, 1.f); jobs[nj - 1].pad0 = (int)F8_SWDN;
            }
#undef ADDJOB
            MISC[16] = (unsigned)nj; MISC[17] = (unsigned)item;
        }
        __syncthreads();
        const int nj = (int)MISC[16], nitems = (int)MISC[17];
        LAS float* scr = (LAS float*)(lds + wave * 16384);
        for (int it = gw; it < nitems; it += ngw) {
            int j = 0;
            for (int q = 1; q < nj; ++q) if (jobs[q].item0 <= it) j = q;
            p0_transpose_item(jobs + j, scr, it - jobs[j].item0, lane);
        }
        norm_rows<0>(P, 0, P.in[I_MEM], WSP(bf16, WS_MEMN), BATCH * NMEM, gw, ngw, lane);
        build_gw(P, gtid, gn);
    }
    PH_END();

    for (int l = 0; l < 2; ++l) {
        const size_t wl = R_WL + (size_t)l * WL_SIZE;
        PH_IF(1) { PH_CTX(); if (l == 0) norm16<1, false>(P, l, P.in[I_X], WSP(bf16, R_XN), nullptr, vcu, G, wave, lane, (LAS float*)lds);
            else norm16<1, true>(P, l, nullptr, WSP(bf16, R_XN), WSP(const unsigned, WS_RSS) + (size_t)2 * M, vcu, G, wave, lane, (LAS float*)lds); }
        PH_END();
        PH_IF(2) { PH_CTX();
            for (int task = bx; task < 24; task += G) gate_scan_task(P, task, (LAS float*)lds, tidp);
            { pg8::Gemm g{WSP(const bf16, R_XN), WSP(const bf16, wl + WL_IN), M, NZ, D}; pg8::StaticOrder S; S.init(M, NZ, G, bx);
              pg8::EpiBf16 E{WSP(bf16, R_T0), 512, 512, (size_t)M * 512, (l == 0) ? WSP(const unsigned, WS_RSTD) : WSP(const unsigned, WS_RSS) + (size_t)2 * M};
              pg8::gemm_phase<pg8::EpiBf16, pg8::StaticOrder, true, true>(lds, g, S, E); }
        }
        PH_END();
        PH_IF(3) { PH_CTX(); mconv_glu_vec(P, l, gtid, gn); fox_keynorms(P, gw, ngw, lane); }
        PH_END();
        PH_IF(4) { PH_CTX(); for (int u = wave * G + vcu; u < 8 * NCH; u += ngw) mls::u_unit(P, u, lds + wave * 16384, lane);
            for (int u = (7 - wave) * G + vcu; u < BATCH * FH * fox::NQB; u += ngw) { const int qb = fox::NQB - 1 - u / (BATCH * FH), bh = u % (BATCH * FH);
                const int j0 = fox::unit_j0_wave(bh, qb, (const fox::bf16h*)WSP(bf16, R_T0 + 3 * SZ_T), WSP(const float, WS_KN2), WSP(const float, WS_CF) + (size_t)bh * SEQ, lane); if (lane == 0) WSP(int, WS_J0)[u] = j0; }
            cconv_ln_rows(P, l, gw, ngw, lane); }
        PH_END();
        PH_IF(5) { PH_CTX(); mls::state_scan(P, gtid, gn); }
        PH_END();
        PH_IF(7) { PH_CTX();
            { pg8::Gemm g{WSP(const bf16, WS_MEMN), WSP(const bf16, wl + WL_KV), BATCH * NMEM, 512, D}; pg8::StaticOrder S; S.init(BATCH * NMEM, 512, G, bx);
              pg8::EpiBf16 E{WSP(bf16, WS_KVX) + (size_t)l * 512 * 1024, 512, 0, 0, nullptr};
              pg8::gemm_phase<pg8::EpiBf16, pg8::StaticOrder, true, true>(lds, g, S, E); }
            { pg8::Gemm g{WSP(const bf16, wl + WL_KV) + (size_t)512 * 1024, WSP(const bf16, WS_MEMN), 512, BATCH * NMEM, D}; pg8::StaticOrder S; S.init(512, BATCH * NMEM, G, (bx + G - 4) % G);
              pg8::EpiBf16 E{WSP(bf16, WS_KVX) + (size_t)l * 512 * 1024 + 512 * 512, 512, 0, 0, nullptr};
              pg8::gemm_phase<pg8::EpiBf16, pg8::StaticOrder, true, true>(lds, g, S, E); }
            { static_assert(fox::LDS_BYTES <= RING_BYTES, "fox LDS");
              const fox::bf16h* Q = (const fox::bf16h*)WSP(bf16, R_T0 + 3 * SZ_T); const fox::bf16h* Kp = (const fox::bf16h*)WSP(bf16, R_T0 + 4 * SZ_T); const fox::bf16h* Vp = (const fox::bf16h*)WSP(bf16, R_T0 + 5 * SZ_T);
              fox::bf16h* O = (fox::bf16h*)(WSP(bf16, R_CAT) + 512); const float* CF = WSP(const float, WS_CF);
              for (int it = vcu; it < 8 * NCH / 8; it += G) mls::out_unit(P, l, it * 8 + wave, lds + wave * 16384, lane);
              __syncthreads();
              const int nitems = BATCH * FH * fox::NQB; unsigned* qhead = ctl + CW_FOXQ + 64 * l;
              for (;;) {
                  if (tidp == 0) MISC[24] = __hip_atomic_fetch_add(qhead, 1u, RLX_AGENT);
                  __syncthreads();
                  const int u = (int)MISC[24];
                  __syncthreads();
                  if (u >= nitems) break;
                  const int qb = fox::NQB - 1 - u / (BATCH * FH), bh = u % (BATCH * FH);
                  const int j0 = WSP(const int, WS_J0)[u];
                  fox::attn_unit<8>(bh / FH, bh % FH, qb, j0, Q, Kp, Vp, O, CF + (size_t)bh * SEQ, (char*)lds_raw); } }

 }
        PH_END();
        PH_IF(8) { PH_CTX(); pg8::Gemm g{WSP(const bf16, R_CAT), WSP(const bf16, wl + WL_OUT), M, D, D}; pg8::StaticOrder S; S.init(M, D, G, bx);
            pg8::EpiRes E{WSP(bf16, R_XN), D, WSP(unsigned, WS_RSS) + (size_t)(l ? 3 : 0) * M};
            pg8::gemm_phase<pg8::EpiRes, pg8::StaticOrder, true, true>(lds, g, S, E); }
        PH_END();
        PH_IF(10) { PH_CTX(); pg8::Gemm g{WSP(const bf16, R_XN), WSP(const bf16, wl + WL_Q), M, 512, D}; pg8::StaticOrder S; S.init(M, 512, G, bx);
            pg8::EpiBf16 E{WSP(bf16, R_QX), 512, 0, 0, WSP(const unsigned, WS_RSS) + (size_t)(l ? 3 : 0) * M};
            pg8::gemm_phase<pg8::EpiBf16, pg8::StaticOrder, true, true>(lds, g, S, E); }
        PH_END();
        PH_IF(11) { PH_CTX(); static_assert(xat::LDS_BYTES <= RING_BYTES, "xat LDS");
            const bf16* KXp = WSP(const bf16, WS_KVX) + (size_t)l * 512 * 1024;
            for (int L = vcu; L < BATCH * XH * (SEQ / 256); L += G) { const int qb = L % (SEQ / 256), bhd = L / (SEQ / 256);
                xat::unit(bhd / XH, bhd % XH, qb, WSP(const bf16, R_QX), KXp, KXp + 512 * 512, WSP(bf16, R_OX), lds); } }
        PH_END();
        PH_IF(12) { PH_CTX(); pg8::Gemm g{WSP(const bf16, R_OX), WSP(const bf16, wl + WL_O), M, D, 512}; pg8::StaticOrder S; S.init(M, D, G, bx);
            pg8::EpiRes E{WSP(bf16, R_XN), D, WSP(unsigned, WS_RSS) + (size_t)(l ? 4 : 1) * M};
            pg8::gemm_phase<pg8::EpiRes, pg8::StaticOrder, true, true>(lds, g, S, E); }
        PH_END();
        if (l == 0) {
            PH_IF(14) { PH_CTX(); pg8::Gemm g{WSP(const bf16, R_XN), WSP(const bf16, R_WGU), M, 2 * DFF, D}; pg8::StaticOrder S; S.init(M, 2 * DFF, G, bx);
                pg8::EpiSwiGLU E{WSP(bf16, R_HD), DFF, WSP(const unsigned, WS_RSS) + (size_t)1 * M};
                pg8::gemm_phase<pg8::EpiSwiGLU, pg8::StaticOrder, true, true>(lds, g, S, E); }
            PH_END();
            PH_IF(15) { PH_CTX(); pg8::Gemm g{WSP(const bf16, R_HD), WSP(const bf16, R_WDN), M, D, DFF}; pg8::StaticOrder S; S.init(M, D, G, bx);
                pg8::EpiRes E{WSP(bf16, R_XN), D, WSP(unsigned, WS_RSS) + (size_t)2 * M};
                pg8::gemm_phase<pg8::EpiRes, pg8::StaticOrder, true, true>(lds, g, S, E); }
            PH_END();
            ph += 2;
        } else {
            PH_IF(16) { PH_CTX(); norm16<2, true>(P, l, nullptr, WSP(bf16, R_XN), WSP(const unsigned, WS_RSS) + (size_t)4 * M, vcu, G, wave, lane, (LAS float*)lds); }
            PH_END();
            PH_IF(17) { PH_CTX(); moe_gather(P, gw, ngw, lane, wave, vcu, G, lds); }
            PH_END();
            PH_IF(18) { PH_CTX(); pg8::Gemm g{WSP(const bf16, WS_XQ), WSP(const bf16, WS_WMGU), 0, 2 * DFF, D / 2}; pg8::GroupedOrder S; S.init(2 * DFF, G, bx, ctl + CW_CNT, (size_t)2 * DFF * D);
                pg8::EpiSwiGLU8 E{WSP(unsigned char, R_HM), DFF, 1.f / (F8_SA * F8_SWGU)};
                pg8::gemm_phase<pg8::EpiSwiGLU8, pg8::GroupedOrder, true, true, 2>(lds, g, S, E); }
            PH_END();
            PH_IF(19) { PH_CTX(); pg8::Gemm g{WSP(const bf16, R_HM), WSP(const bf16, WS_WMD), 0, D, DFF / 2}; pg8::GroupedTailOrder S; S.init(D, G, bx, ctl + CW_CNT, (size_t)D * DFF, DFF / (2 * pg8::BK));
                pg8::EpiMoeOutT E{WSP(bf16, R_XNS), D, WSP(const float, WS_SLOTG), WSP(float, WS_WMGU)  , ctl + CW_TAIL, 1.f / (F8_SH * F8_SWDN)};
                pg8::gemm_phase<pg8::EpiMoeOutT, pg8::GroupedTailOrder, true, true, 2>(lds, g, S, E); }
            PH_END();
        }
    }
    PH_IF(20) { PH_CTX(); moe_combine_final(P, gw, ngw, lane); }
#undef PH_ON
#undef PH_END
}

extern "C" void kernel_launch(void* const* d_in, const int* in_sizes, int n_in, void* d_out, int out_size, void* d_ws, size_t ws_size, hipStream_t stream) {
    static int grid = 0;
    if (grid == 0) {
        if (n_in != N_IN || out_size != M * D || ws_size < WS_END) { fprintf(stderr, "kernel_launch: unexpected shapes (n_in %d, out %d, ws %zu < %zu); nothing launched\n", n_in, out_size, ws_size, (size_t)WS_END); grid = -1; return; }
        int dev = 0, cus = 0, per_cu = 0;
        if (hipGetDevice(&dev) != hipSuccess || hipDeviceGetAttribute(&cus, hipDeviceAttributeMultiprocessorCount, dev) != hipSuccess) { grid = -1; return; }
        if (hipFuncSetAttribute((const void*)trunk_fwd, hipFuncAttributeMaxDynamicSharedMemorySize, LDS_BYTES) != hipSuccess) { fprintf(stderr, "kernel_launch: hipFuncSetAttribute failed\n"); grid = -1; return; }
        if (hipOccupancyMaxActiveBlocksPerMultiprocessor(&per_cu, (const void*)trunk_fwd, NWAVES * 64, LDS_BYTES) != hipSuccess || per_cu < 1) { fprintf(stderr, "kernel_launch: occupancy query says %d\n", per_cu); (void)hipGetLastError(); grid = -1; return; }
        grid = cus;
    }
    if (grid < 0) return;
    (void)in_sizes;
    if (hipMemsetAsync((char*)d_ws + WS_CTL, 0, CTL_ZERO_BYTES, stream) != hipSuccess) return;
    Args a; memset(&a, 0, sizeof(a));
    for (int i = 0; i < N_IN; ++i) a.in[i] = (const float*)d_in[i];
    a.xres = (float*)d_out; a.ws = (unsigned char*)d_ws;
#if MK_PER_PHASE
    for (int p = 0; p < N_PHASES; ++p) { a.ph_lo = p; a.ph_hi = p + 1; hipLaunchKernelGGL(trunk_fwd, dim3(grid), dim3(NWAVES * 64), LDS_BYTES, stream, a); }
#else
    a.ph_lo = 0; a.ph_hi = N_PHASES;
    hipLaunchKernelGGL(trunk_fwd, dim3(grid), dim3(NWAVES * 64), LDS_BYTES, stream, a);
#endif
}
#endif
```

```cpp
#if defined(HOST_EMU)
#include <cmath>
#include <cstring>
#include <cstdint>
#include <cstddef>
#define DEVFN static inline
#define PHFN static inline
#else
#include <hip/hip_runtime.h>
#include <cstdio>
#include <cstdint>
#include <cstring>
#define DEVFN __device__ __forceinline__
#define PHFN __device__ __forceinline__
#endif

#ifndef CFG_SEQ
#define CFG_SEQ 8192
#endif
constexpr int BATCH = 2, SEQ = CFG_SEQ, D = 1024, M = BATCH * SEQ;
constexpr int MH = 4, MCH = 64, NCH = SEQ / MCH;
constexpr int CK = 31;
constexpr int FH = 8;
constexpr int XH = 4, XD = 128, NMEM = 256;
constexpr int DFF = 2816, NE = 8, INW = 3088;
constexpr int NZ = 3072;
constexpr int SLOTS_MAX = 2 * M + NE * 256;
constexpr float EPS = 1e-6f;
constexpr float LOG2E = 1.4426950408889634f;
constexpr float FOX_QS = 0.125f * LOG2E;
constexpr float XAT_QS = 0.08838834764831845f * LOG2E;

enum { I_X = 0, I_MEM, I_NMIX, I_WIN, I_MCW, I_MCB, I_MBI, I_MBF, I_MNW, I_CCW, I_CCB, I_CLW, I_CLB, I_FBF, I_WOUT, I_NXA, I_NMEM, I_WQ, I_WKV, I_WO, I_NFFN,
       I_FG, I_FU, I_FD, I_RW, I_MG, I_MU, I_MD, I_NFIN, N_IN };

typedef unsigned short bf16;
constexpr size_t al4k(size_t x) { return (x + 4095) & ~(size_t)4095; }
constexpr size_t MiB = (size_t)1 << 20;
constexpr size_t WS_CTL = 0, CTL_ZERO_BYTES = 1 * MiB;
constexpr size_t WS_GATE = 1 * MiB;
constexpr size_t WS_CF = WS_GATE + al4k((size_t)M * 16 * 4);
constexpr size_t WS_BL = WS_CF + al4k((size_t)16 * SEQ * 4);
constexpr size_t WS_BT = WS_BL + al4k((size_t)8 * SEQ * 4);
constexpr size_t WS_AK = WS_BT + al4k((size_t)8 * NCH * 4);
constexpr size_t WS_MS = WS_AK + al4k((size_t)8 * NCH * 4);
constexpr size_t WS_DEC = WS_MS + al4k((size_t)8 * (NCH + 1) * 4);
constexpr size_t WS_KN2 = WS_DEC + al4k((size_t)8 * NCH * 4);
constexpr size_t WS_J0 = WS_KN2 + al4k((size_t)16 * (SEQ / 64) * 4);
constexpr size_t WS_BH = WS_J0 + al4k((size_t)16 * (SEQ / 256) * 4);
constexpr size_t WS_NST = WS_BH + al4k((size_t)1024 * 8 * 4);
constexpr size_t WS_TOK = WS_NST + al4k((size_t)8 * NCH * 64 * 4);
constexpr size_t WS_RSTD = WS_TOK + al4k((size_t)M * 32);
constexpr size_t WS_RSTDS = WS_RSTD + al4k((size_t)M * 8);
constexpr size_t WS_SLOTG = WS_RSTDS + al4k((size_t)SLOTS_MAX * 8);
constexpr size_t WS_GW = WS_SLOTG + al4k((size_t)SLOTS_MAX * 4);
constexpr size_t WS_MEMN = WS_GW + 3 * 65536;
constexpr size_t WS_KVX = WS_MEMN + al4k((size_t)512 * 1024 * 2);
constexpr size_t WS_WMGU = WS_KVX + al4k((size_t)2 * 512 * 1024 * 2);
constexpr size_t WS_WMD = WS_WMGU + (size_t)NE * 5632 * 1024 * 2;
constexpr size_t WS_R = al4k(WS_WMD + (size_t)NE * 1024 * 2816 * 2);
constexpr size_t WL_IN = 0, WL_OUT = WL_IN + (size_t)NZ * 1024 * 2, WL_Q = WL_OUT + (size_t)1024 * 1024 * 2, WL_KV = WL_Q + (size_t)512 * 1024 * 2,
                 WL_O = WL_KV + (size_t)1024 * 1024 * 2, WL_SIZE = WL_O + (size_t)1024 * 512 * 2;
constexpr size_t R_WL = WS_R;
constexpr size_t R_WGU = R_WL + 2 * WL_SIZE;
constexpr size_t R_WDN = R_WGU + (size_t)5632 * 1024 * 2;
constexpr size_t R_XN = al4k(R_WDN + (size_t)1024 * 2816 * 2);
constexpr size_t SZ_T = (size_t)M * 512 * 2;
constexpr size_t R_T0 = R_XN + 2 * SZ_T;
constexpr size_t R_MQK = R_T0 + 6 * SZ_T;
constexpr size_t R_CAT = R_MQK + SZ_T;
constexpr size_t R_CST = R_CAT + 2 * SZ_T;
constexpr size_t R_GL = R_CST + (size_t)8 * NCH * 4096 * 4;
constexpr size_t R_HC = R_GL + (size_t)M * 256 * 2;
constexpr size_t R_END1 = R_HC + (size_t)M * 256 * 4;
constexpr size_t R_QX = R_T0, R_OX = R_T0 + SZ_T;
constexpr size_t R_HD = R_T0;
constexpr size_t R_HM = WS_R;
constexpr size_t R_XNS = R_HM + (size_t)SLOTS_MAX * 2816 * 2;
constexpr size_t R_END2 = R_XNS + (size_t)SLOTS_MAX * 1024 * 2;
constexpr size_t WS_END = R_END1 > R_END2 ? R_END1 : R_END2;
static_assert((size_t)M * 2816 * 2 <= 6 * SZ_T, "dense hidden fits T0..T5");
static_assert(R_XN + 2 * SZ_T <= R_XNS, "XN must not overlap the gathered rows");
constexpr float F8_SA = 8.f, F8_SWGU = 256.f, F8_SH = 16.f, F8_SWDN = 512.f;
constexpr size_t WS_XQ = WS_WMGU + (size_t)NE * 5632 * 1024;
constexpr int CW_TMO = 0, CW_CNT = 64  , CW_TAIL = 512  , CW_FOXQ = 128  , CW_BAR = 4096;
constexpr size_t WS_RSS = 65536;
static_assert(WS_RSS + (size_t)5 * M * 4 <= CTL_ZERO_BYTES, "RSS arrays inside the zeroed region");

#if defined(HOST_EMU)
struct Ptrs { const float* in[N_IN]; float* xres; unsigned char* ws; };
#else
struct Ptrs { const float* const __attribute__((address_space(3)))* in; float* xres; unsigned char* ws; };
#endif
#define WSP(type, off) ((type*)(P.ws + (off)))

DEVFN float bf2f(bf16 v) { unsigned u = (unsigned)v << 16; float f; memcpy(&f, &u, 4); return f; }
DEVFN bf16 f2bf(float f) { unsigned u; memcpy(&u, &f, 4); return (bf16)((u + 0x7fffu + ((u >> 16) & 1u)) >> 16); }
DEVFN float sigmoidf_(float x) { return 1.f / (1.f + expf(-x)); }
#if defined(HOST_EMU)
DEVFN float logsigmoidf_(float x) { return fminf(x, 0.f) - log1pf(expf(-fabsf(x))); }
#else
DEVFN float logsigmoidf_(float x) { return fminf(x, 0.f) - __logf(1.f + __expf(-fabsf(x))); }
#endif

DEVFN void wmap(int kind, int nb, int& which, int& col0, float& cs) {
    which = 0; cs = 1.f; const int n0 = nb * 32;
    if (kind == 0) { col0 = n0; }
    else if (kind == 1) { col0 = n0 < 1024 ? n0 : n0 + 8; if (n0 >= 1536 && n0 < 2048) cs = FOX_QS; }
    else { const int tile = nb >> 3, w = nb & 7; which = w >> 2; col0 = tile * 128 + (w & 3) * 32; }
}

#if !defined(HOST_EMU)
namespace pg8 {
#define PG8_LAS __attribute__((address_space(3)))
typedef unsigned short bf16_t;
typedef short bf16x8 __attribute__((ext_vector_type(8)));
typedef float f32x4 __attribute__((ext_vector_type(4)));
typedef unsigned u32x4 __attribute__((ext_vector_type(4)));
constexpr int BM = 256, BK = 64, HALF = 128, HTB = HALF * BK * 2, STAGE_BYTES = 8 * HTB, NXCD = 8, WGM = 4;
__host__ __device__ __forceinline__ int lds_byte(int r, int c) { const int st = (r >> 4) * 2 + (c >> 5), rr = r & 15, cc = c & 31, ob = rr * 64 + cc * 2; return st * 1024 + (ob ^ (((ob >> 9) & 1) << 5)); }
__host__ __device__ __forceinline__ void stage_rc(int b, int& R, int& C) { const int st = b / 1024, sb = b % 1024, swz = sb ^ (((sb >> 9) & 1) << 5); R = (st >> 1) * 16 + swz / 64; C = (st & 1) * 32 + (swz % 64) / 2; }
__host__ __device__ __forceinline__ int perm32(int rho) { const int n = rho >> 4, i = rho & 15; return 8 * (i >> 2) + 4 * n + (i & 3); }

struct Unit { int pm, pn; size_t bofs; int nt, ks, ti, s; size_t aofs; };
struct Gemm { const bf16_t* A; const bf16_t* Bt; int M, N, K; };

struct StaticOrder {
    static constexpr bool VAR_K = false;
    int nM, nN, nwg, G, c;
    __device__ void init(int M_, int N_, int G_, int c_) { nM = M_ / BM; nN = N_ / BM; nwg = nM * nN; G = G_; c = c_; }
    __device__ bool next(int i, Unit& u) const {
        const long L = (long)i * G + c; if (L >= nwg) return false;
        int wgid = (int)L; { const int q = nwg / NXCD, r = nwg % NXCD, xcd = wgid % NXCD, off = wgid / NXCD; wgid = (xcd < r ? xcd * (q + 1) : r * (q + 1) + (xcd - r) * q) + off; }
        const int nig = WGM * nN, gid = wgid / nig, fm = gid * WGM, gsz = (nM - fm) < WGM ? (nM - fm) : WGM;
        u.pm = fm + ((wgid % nig) % gsz); u.pn = (wgid % nig) / gsz; u.bofs = 0; return true;
    }
    __device__ __forceinline__ void a_ready(const Unit&) const {}
    __device__ __forceinline__ void done(const Unit&) const {}
};
struct GroupedOrder {
    static constexpr bool VAR_K = false;
    int nM, nN, nwg, G, c; int off[9]; size_t estride;
    __device__ void init(int N_, int G_, int c_, const unsigned* cnt, size_t estride_) {
        int o = 0;
#pragma unroll
        for (int e = 0; e < 8; ++e) { off[e] = o; o += ((int)cnt[e] + 255) & ~255; }
        off[8] = o; nM = o / BM; nN = N_ / BM; nwg = nM * nN; G = G_; c = c_; estride = estride_;
    }
    __device__ bool next(int i, Unit& u) const {
        const long L = (long)i * G + c; if (L >= nwg) return false;
        int wgid = (int)L; { const int q = nwg / NXCD, r = nwg % NXCD, xcd = wgid % NXCD, o2 = wgid / NXCD; wgid = (xcd < r ? xcd * (q + 1) : r * (q + 1) + (xcd - r) * q) + o2; }
        const int nig = WGM * nN, gid = wgid / nig, fm = gid * WGM, gsz = (nM - fm) < WGM ? (nM - fm) : WGM;
        u.pm = fm + ((wgid % nig) % gsz); u.pn = (wgid % nig) / gsz;
        int e = 0;
#pragma unroll
        for (int j = 1; j < 8; ++j) e += (off[j] <= u.pm * BM) ? 1 : 0;
        u.bofs = (size_t)e * estride; return true;
    }
    __device__ __forceinline__ void a_ready(const Unit&) const {}
    __device__ __forceinline__ void done(const Unit&) const {}
};

struct GroupedTailOrder {
    static constexpr bool VAR_K = true;
    int nM, nN, nwg, G, c, nfull, T, s, sh, ntot, NT; int off[9]; size_t estride;
    __device__ __forceinline__ void init(int N_, int G_, int c_, const unsigned* cnt, size_t estride_, int NT_) {
        int o = 0;
#pragma unroll
        for (int e = 0; e < 8; ++e) { off[e] = o; o += ((int)cnt[e] + 255) & ~255; }
        off[8] = o; nM = o / BM; nN = N_ / BM; nwg = nM * nN; G = G_; c = c_; estride = estride_; NT = NT_;
        const int rounds = nwg / G; T = nwg - rounds * G;
        s = (T == 0) ? 1 : (T * 8 <= G ? 8 : (T * 4 <= G ? 4 : (T * 2 <= G ? 2 : 1))); sh = (s == 8) ? 3 : (s >> 1);
        if (s == 1) { nfull = nwg; T = 0; } else nfull = rounds * G;
        ntot = nfull + T * s;
    }
    __device__ __forceinline__ bool next(int i, Unit& u) const {
        const long L = (long)i * G + c; if (L >= ntot) return false;
        int wgid = (int)L, ks = 0, ti = -1;
        if (wgid >= nfull) { const int mu = wgid - nfull; ti = mu >> sh; ks = mu - (ti << sh); wgid = nfull + ti; }
        { const int q = nwg / NXCD, r = nwg % NXCD, xcd = wgid % NXCD, o2 = wgid / NXCD; wgid = (xcd < r ? xcd * (q + 1) : r * (q + 1) + (xcd - r) * q) + o2; }
        const int nig = WGM * nN, gid = wgid / nig, fm = gid * WGM, gsz = (nM - fm) < WGM ? (nM - fm) : WGM;
        u.pm = fm + ((wgid % nig) % gsz); u.pn = (wgid % nig) / gsz;
        int e = 0;
#pragma unroll
        for (int j = 1; j < 8; ++j) e += (off[j] <= u.pm * BM) ? 1 : 0;
        int kt0 = 0, ntu = NT;
        if (ti >= 0) { const int base = (NT >> sh) & ~1, ex = (NT - (base << sh)) >> 1;
            ntu = base + (ks < ex ? 2 : 0); kt0 = ks * base + 2 * (ks < ex ? ks : ex); }
        u.aofs = (size_t)kt0 * BK * 2; u.bofs = (size_t)e * estride + u.aofs; u.nt = ntu; u.ks = ks; u.ti = ti; u.s = s; return true;
    }
    __device__ __forceinline__ void a_ready(const Unit&) const {}
    __device__ __forceinline__ void done(const Unit&) const {}
};

__device__ __forceinline__ unsigned cvt_pk_bf16(float lo, float hi) { unsigned r; asm volatile("v_cvt_pk_bf16_f32 %0, %1, %2" : "=v"(r) : "v"(lo), "v"(hi)); return r; }

struct EpiBf16 {
    static constexpr bool PERM = true, AFTER_DRAIN = false, HAS_PRE = true;
    __device__ __forceinline__ void preload(unsigned (&q)[8], const Unit& u, int wr, int fr) const {
        if (rs) { const __attribute__((address_space(1))) unsigned* rp = (const __attribute__((address_space(1))) unsigned*)rs + u.pm * BM + wr * 64 + fr;
#pragma unroll
            for (int i = 0; i < 8; ++i) q[i] = rp[(i >> 2) * HALF + (i & 3) * 16]; } }
    bf16_t* O; int ldc; int split_cols; size_t split_stride; const unsigned* rs;
    __device__ __forceinline__ void operator()(const f32x4 (&acc)[2][2][4][2], const Unit& u, int wr, int wc, int fr, int fq, const unsigned (&q)[8]) const {
        const int row0 = u.pm * BM + wr * 64 + fr; int colt = u.pn * BM; bf16_t* base = O;
        if (split_cols) { const int t = colt / split_cols; base += (size_t)t * split_stride; colt -= t * split_cols; }
        const int col0 = colt + wc * 32 + 8 * fq;
        float sc[2][4];
#pragma unroll
        for (int ai = 0; ai < 2; ++ai)
#pragma unroll
            for (int m = 0; m < 4; ++m) sc[ai][m] = rs ? rsqrtf((float)q[ai * 4 + m] * (1.f / (16.f * 1024.f)) + 1e-6f) : 1.f;
#pragma unroll
        for (int ai = 0; ai < 2; ++ai)
#pragma unroll
            for (int m = 0; m < 4; ++m) { bf16_t* rowp = base + (size_t)(row0 + ai * HALF + m * 16) * ldc + col0;
#pragma unroll
                for (int bj = 0; bj < 2; ++bj) { const f32x4 v0 = acc[ai][bj][m][0] * sc[ai][m], v1 = acc[ai][bj][m][1] * sc[ai][m];
                    u32x4 w; w.x = cvt_pk_bf16(v0[0], v0[1]); w.y = cvt_pk_bf16(v0[2], v0[3]); w.z = cvt_pk_bf16(v1[0], v1[1]); w.w = cvt_pk_bf16(v1[2], v1[3]);
                    *(u32x4*)(rowp + bj * HALF) = w; } }
    }
};
struct EpiRes {
    static constexpr bool PERM = true, AFTER_DRAIN = false, HAS_PRE = false;
    bf16_t* X; int ldc; unsigned* rss;
    __device__ __forceinline__ void operator()(const f32x4 (&acc)[2][2][4][2], const Unit& u, int wr, int wc, int fr, int fq) const {
        const int row0 = u.pm * BM + wr * 64 + fr, col0 = u.pn * BM + wc * 32 + 8 * fq;
        typedef __attribute__((address_space(1))) u32x4 gu32x4;
        u32x4 b[2][4][2];
#pragma unroll
        for (int ai = 0; ai < 2; ++ai)
#pragma unroll
            for (int m = 0; m < 4; ++m)
#pragma unroll
                for (int bj = 0; bj < 2; ++bj) b[ai][m][bj] = *(const gu32x4*)(X + (size_t)(row0 + ai * HALF + m * 16) * ldc + col0 + bj * HALF);
#pragma unroll
        for (int ai = 0; ai < 2; ++ai)
#pragma unroll
            for (int m = 0; m < 4; ++m) { bf16_t* rowp = X + (size_t)(row0 + ai * HALF + m * 16) * ldc + col0; float ss = 0.f;
#pragma unroll
                for (int bj = 0; bj < 2; ++bj) { float v[8];
#pragma unroll
                    for (int i = 0; i < 4; ++i) { v[2 * i] = __uint_as_float(b[ai][m][bj][i] << 16) + acc[ai][bj][m][i >> 1][(2 * i) & 3]; v[2 * i + 1] = __uint_as_float(b[ai][m][bj][i] & 0xffff0000u) + acc[ai][bj][m][i >> 1][(2 * i + 1) & 3]; }
                    u32x4 w; w.x = cvt_pk_bf16(v[0], v[1]); w.y = cvt_pk_bf16(v[2], v[3]); w.z = cvt_pk_bf16(v[4], v[5]); w.w = cvt_pk_bf16(v[6], v[7]);
                    *(gu32x4*)(rowp + bj * HALF) = w;
#pragma unroll
                    for (int i = 0; i < 8; ++i) ss += v[i] * v[i]; }
                ss += __shfl_xor(ss, 16); ss += __shfl_xor(ss, 32);
                if (fq == 0) __hip_atomic_fetch_add(rss + row0 + ai * HALF + m * 16, (unsigned)(ss * 16.f + 0.5f), __ATOMIC_RELAXED, __HIP_MEMORY_SCOPE_AGENT); }
    }
};
struct EpiMoeOut {
    static constexpr bool PERM = true, AFTER_DRAIN = false, HAS_PRE = false;
    bf16_t* Y; int ldc; const float* sg;
    __device__ __forceinline__ void operator()(const f32x4 (&acc)[2][2][4][2], const Unit& u, int wr, int wc, int fr, int fq) const {
        const int row0 = u.pm * BM + wr * 64 + fr, col0 = u.pn * BM + wc * 32 + 8 * fq;
        typedef __attribute__((address_space(1))) u32x4 gu32x4;
        float g[2][4];
        { const __attribute__((address_space(1))) float* gp = (const __attribute__((address_space(1))) float*)sg + row0;
#pragma unroll
          for (int ai = 0; ai < 2; ++ai)
#pragma unroll
              for (int m = 0; m < 4; ++m) g[ai][m] = gp[ai * HALF + m * 16]; }
        u32x4 b[2][4][2];
#pragma unroll
        for (int ai = 0; ai < 2; ++ai)
#pragma unroll
            for (int m = 0; m < 4; ++m)
#pragma unroll
                for (int bj = 0; bj < 2; ++bj) { b[ai][m][bj] = (u32x4){0u, 0u, 0u, 0u}; if (g[ai][m] > 0.f) b[ai][m][bj] = *(const gu32x4*)(Y + (size_t)(row0 + ai * HALF + m * 16) * ldc + col0 + bj * HALF); }
#pragma unroll
        for (int ai = 0; ai < 2; ++ai)
#pragma unroll
            for (int m = 0; m < 4; ++m) { bf16_t* rowp = Y + (size_t)(row0 + ai * HALF + m * 16) * ldc + col0; const float ga = fabsf(g[ai][m]);
#pragma unroll
                for (int bj = 0; bj < 2; ++bj) { float v[8];
#pragma unroll
                    for (int i = 0; i < 4; ++i) { v[2 * i] = __uint_as_float(b[ai][m][bj][i] << 16) + ga * acc[ai][bj][m][i >> 1][(2 * i) & 3]; v[2 * i + 1] = __uint_as_float(b[ai][m][bj][i] & 0xffff0000u) + ga * acc[ai][bj][m][i >> 1][(2 * i + 1) & 3]; }
                    u32x4 w; w.x = cvt_pk_bf16(v[0], v[1]); w.y = cvt_pk_bf16(v[2], v[3]); w.z = cvt_pk_bf16(v[4], v[5]); w.w = cvt_pk_bf16(v[6], v[7]);
                    *(gu32x4*)(rowp + bj * HALF) = w; } }
    }
};
struct EpiMoeOutT {
    static constexpr bool PERM = true, AFTER_DRAIN = false, HAS_PRE = false;
    bf16_t* Y; int ldc; const float* sg; float* part; unsigned* cnt; float cs;
    template <int S> __device__ __forceinline__ void tail_reduce(const Unit& u, int wr, int wc, int fr, int fq, int wid, int lane) const {
        typedef __attribute__((address_space(1))) f32x4 gf32x4;
        typedef __attribute__((address_space(1))) u32x4 gu32x4;
        constexpr int CPS = 8 / S;
        const gf32x4* base = (const gf32x4*)part + ((size_t)(u.ti * S) * 8 + wid) * 2048 + lane;
        const int row0 = u.pm * BM + wr * 64 + fr, col0 = u.pn * BM + wc * 32 + 8 * fq;
#pragma unroll
        for (int cc = 0; cc < CPS; ++cc) {
            const int c8 = u.ks * CPS + cc, ai = c8 >> 2, bj = (c8 >> 1) & 1, mh = c8 & 1;
            f32x4 t[S][4];
#pragma unroll
            for (int o = 0; o < S; ++o)
#pragma unroll
                for (int jj = 0; jj < 4; ++jj) t[o][jj] = base[(size_t)o * 16384 + (c8 * 4 + jj) * 64];
            const int r0 = row0 + ai * HALF + mh * 32;
            float g[2]; u32x4 b[2];
#pragma unroll
            for (int mm = 0; mm < 2; ++mm) g[mm] = ((const __attribute__((address_space(1))) float*)sg)[r0 + mm * 16];
#pragma unroll
            for (int mm = 0; mm < 2; ++mm) { b[mm] = (u32x4){0u, 0u, 0u, 0u}; if (g[mm] > 0.f) b[mm] = *(const gu32x4*)(Y + (size_t)(r0 + mm * 16) * ldc + col0 + bj * HALF); }
#pragma unroll
            for (int jj = 0; jj < 4; ++jj)
#pragma unroll
                for (int o = 1; o < S; ++o) t[0][jj] += t[o][jj];
#pragma unroll
            for (int mm = 0; mm < 2; ++mm) { const float ga = fabsf(g[mm]) * cs; float v[8];
#pragma unroll
                for (int i = 0; i < 4; ++i) { v[2 * i] = __uint_as_float(b[mm][i] << 16) + ga * t[0][mm * 2 + (i >> 1)][(2 * i) & 3]; v[2 * i + 1] = __uint_as_float(b[mm][i] & 0xffff0000u) + ga * t[0][mm * 2 + (i >> 1)][(2 * i + 1) & 3]; }
                u32x4 w; w.x = cvt_pk_bf16(v[0], v[1]); w.y = cvt_pk_bf16(v[2], v[3]); w.z = cvt_pk_bf16(v[4], v[5]); w.w = cvt_pk_bf16(v[6], v[7]);
                *(gu32x4*)(Y + (size_t)(r0 + mm * 16) * ldc + col0 + bj * HALF) = w; }
        }
    }
    __device__ __forceinline__ void operator()(const f32x4 (&acc)[2][2][4][2], const Unit& u, int wr, int wc, int fr, int fq) const {
        typedef __attribute__((address_space(1))) f32x4 gf32x4;
        typedef __attribute__((address_space(1))) u32x4 gu32x4;
        if (u.ti >= 0) {
            const int wid = wr * 4 + wc; int lane = fq * 16 + fr; asm volatile("" : "+v"(lane));
            gf32x4* p = (gf32x4*)part + ((size_t)(u.ti * u.s + u.ks) * 8 + wid) * 2048 + lane;
#pragma unroll
            for (int j = 0; j < 32; ++j) p[j * 64] = acc[j >> 4][(j >> 3) & 1][(j >> 1) & 3][j & 1];
            asm volatile("s_waitcnt vmcnt(0)" ::: "memory"); __builtin_amdgcn_s_barrier();
            if (wid == 0) {
                __builtin_amdgcn_fence(__ATOMIC_RELEASE, "agent");
                if (lane == 0) __hip_atomic_fetch_add(cnt + u.ti, 1u, __ATOMIC_RELAXED, __HIP_MEMORY_SCOPE_AGENT);
                while (__hip_atomic_load(cnt + u.ti, __ATOMIC_RELAXED, __HIP_MEMORY_SCOPE_AGENT) < (unsigned)u.s) __builtin_amdgcn_s_sleep(2);
                __builtin_amdgcn_fence(__ATOMIC_ACQUIRE, "agent");
            }
            __builtin_amdgcn_s_barrier();
            if (u.s == 8) tail_reduce<8>(u, wr, wc, fr, fq, wid, lane); else if (u.s == 4) tail_reduce<4>(u, wr, wc, fr, fq, wid, lane); else tail_reduce<2>(u, wr, wc, fr, fq, wid, lane);
            return;
        }
        const int row0 = u.pm * BM + wr * 64 + fr, col0 = u.pn * BM + wc * 32 + 8 * fq;
        float g[2][4];
        { const __attribute__((address_space(1))) float* gp = (const __attribute__((address_space(1))) float*)sg + row0;
#pragma unroll
          for (int ai = 0; ai < 2; ++ai)
#pragma unroll
              for (int m = 0; m < 4; ++m) g[ai][m] = gp[ai * HALF + m * 16]; }
        u32x4 b[2][4][2];
#pragma unroll
        for (int ai = 0; ai < 2; ++ai)
#pragma unroll
            for (int m = 0; m < 4; ++m)
#pragma unroll
                for (int bj = 0; bj < 2; ++bj) { b[ai][m][bj] = (u32x4){0u, 0u, 0u, 0u}; if (g[ai][m] > 0.f) b[ai][m][bj] = *(const gu32x4*)(Y + (size_t)(row0 + ai * HALF + m * 16) * ldc + col0 + bj * HALF); }
#pragma unroll
        for (int ai = 0; ai < 2; ++ai)
#pragma unroll
            for (int m = 0; m < 4; ++m) { bf16_t* rowp = Y + (size_t)(row0 + ai * HALF + m * 16) * ldc + col0; const float ga = fabsf(g[ai][m]) * cs;
#pragma unroll
                for (int bj = 0; bj < 2; ++bj) { float v[8];
#pragma unroll
                    for (int i = 0; i < 4; ++i) { v[2 * i] = __uint_as_float(b[ai][m][bj][i] << 16) + ga * acc[ai][bj][m][i >> 1][(2 * i) & 3]; v[2 * i + 1] = __uint_as_float(b[ai][m][bj][i] & 0xffff0000u) + ga * acc[ai][bj][m][i >> 1][(2 * i + 1) & 3]; }
                    u32x4 w; w.x = cvt_pk_bf16(v[0], v[1]); w.y = cvt_pk_bf16(v[2], v[3]); w.z = cvt_pk_bf16(v[4], v[5]); w.w = cvt_pk_bf16(v[6], v[7]);
                    *(gu32x4*)(rowp + bj * HALF) = w; } }
    }
};
struct EpiSwiGLU8 {
    static constexpr bool PERM = true, AFTER_DRAIN = false, HAS_PRE = false;
    unsigned char* H; int ldc; float cs;
    __device__ __forceinline__ void operator()(const f32x4 (&acc)[2][2][4][2], const Unit& u, int wr, int wc, int fr, int fq) const {
        const int row0 = u.pm * BM + wr * 64 + fr, col0 = u.pn * HALF + wc * 32 + 8 * fq;
#pragma unroll
        for (int ai = 0; ai < 2; ++ai)
#pragma unroll
            for (int m = 0; m < 4; ++m) { unsigned char* rowp = H + (size_t)(row0 + ai * HALF + m * 16) * ldc + col0; float hv[8];
#pragma unroll
                for (int n = 0; n < 2; ++n)
#pragma unroll
                    for (int i = 0; i < 4; ++i) { const float g = acc[ai][0][m][n][i] * cs, up = acc[ai][1][m][n][i] * cs;
                        hv[n * 4 + i] = __builtin_amdgcn_fmed3f(g * __builtin_amdgcn_rcpf(1.f + __builtin_amdgcn_exp2f(-g * 1.4426950408889634f)) * up * F8_SH, -448.f, 448.f); }
                int p0 = __builtin_amdgcn_cvt_pk_fp8_f32(hv[0], hv[1], 0, false); p0 = __builtin_amdgcn_cvt_pk_fp8_f32(hv[2], hv[3], p0, true);
                int p1 = __builtin_amdgcn_cvt_pk_fp8_f32(hv[4], hv[5], 0, false); p1 = __builtin_amdgcn_cvt_pk_fp8_f32(hv[6], hv[7], p1, true);
                typedef unsigned u32x2_t __attribute__((ext_vector_type(2)));
                *(u32x2_t*)rowp = (u32x2_t){(unsigned)p0, (unsigned)p1}; }
    }
};
struct EpiSwiGLU {
    static constexpr bool PERM = true, AFTER_DRAIN = false, HAS_PRE = true;
    __device__ __forceinline__ void preload(unsigned (&q)[8], const Unit& u, int wr, int fr) const {
        const __attribute__((address_space(1))) unsigned* rp = (const __attribute__((address_space(1))) unsigned*)rs + u.pm * BM + wr * 64 + fr;
#pragma unroll
        for (int i = 0; i < 8; ++i) q[i] = rp[(i >> 2) * HALF + (i & 3) * 16]; }
    bf16_t* H; int ldc; const unsigned* rs;
    __device__ __forceinline__ void operator()(const f32x4 (&acc)[2][2][4][2], const Unit& u, int wr, int wc, int fr, int fq, const unsigned (&q)[8]) const {
        const int row0 = u.pm * BM + wr * 64 + fr, col0 = u.pn * HALF + wc * 32 + 8 * fq;
        float sc[2][4];
#pragma unroll
        for (int ai = 0; ai < 2; ++ai)
#pragma unroll
            for (int m = 0; m < 4; ++m) sc[ai][m] = rsqrtf((float)q[ai * 4 + m] * (1.f / (16.f * 1024.f)) + 1e-6f);
#pragma unroll
        for (int ai = 0; ai < 2; ++ai)
#pragma unroll
            for (int m = 0; m < 4; ++m) { bf16_t* rowp = H + (size_t)(row0 + ai * HALF + m * 16) * ldc + col0; float hv[8];
#pragma unroll
                for (int n = 0; n < 2; ++n)
#pragma unroll
                    for (int i = 0; i < 4; ++i) { const float g = acc[ai][0][m][n][i] * sc[ai][m], up = acc[ai][1][m][n][i] * sc[ai][m];
                        hv[n * 4 + i] = g * __builtin_amdgcn_rcpf(1.f + __builtin_amdgcn_exp2f(-g * 1.4426950408889634f)) * up; }
                u32x4 w; w.x = cvt_pk_bf16(hv[0], hv[1]); w.y = cvt_pk_bf16(hv[2], hv[3]); w.z = cvt_pk_bf16(hv[4], hv[5]); w.w = cvt_pk_bf16(hv[6], hv[7]);
                *(u32x4*)rowp = w; }
    }
};

typedef int i32x4_t __attribute__((ext_vector_type(4)));
typedef int i32x8_t __attribute__((ext_vector_type(8)));
template <class Epi, class Sched, bool ALIGN_EPI = false, bool SP2 = false, int F8 = 0>
__device__ __forceinline__ void gemm_phase(PG8_LAS unsigned char* lds, const Gemm g, const Sched& S, const Epi& E) {
    int tid = threadIdx.x; asm volatile("" : "+v"(tid));
    const int wid = __builtin_amdgcn_readfirstlane(tid >> 6), lane = tid & 63, wr = wid >> 2, wc = wid & 3, fr = lane & 15, fq = lane >> 4;
    const int K = g.K, nt = K / BK;
    unsigned voffA[2], voffB[2];
#pragma unroll
    for (int i = 0; i < 2; ++i) { int R, C; stage_rc(tid * 16 + i * 8192, R, C); const int Rb = Epi::PERM ? ((R & ~31) + perm32(R & 31)) : R;
        voffA[i] = (unsigned)(R * K + C) * 2u; voffB[i] = (unsigned)(Rb * K + C) * 2u; }
    const size_t kstep = (size_t)(BK * 2);
    const size_t hstep = (size_t)HALF * K * 2;
    const size_t tstep = 2 * hstep;
    const unsigned ldsw = (unsigned)wid * 1024u;
    const int aoff = lds_byte(wr * 64 + fr, fq * 8), boff = lds_byte(wc * 32 + fr, fq * 8);
#define PG8_SA(b, h) (((b) * 2 + (h)) * HTB)
#define PG8_SB(b, h) ((4 + (b) * 2 + (h)) * HTB)
#define PG8_STAGE(bufoff, gbase, voff) do { _Pragma("unroll") for (int _i = 0; _i < 2; ++_i) \
        __builtin_amdgcn_global_load_lds((const unsigned*)((const char*)(gbase) + (voff)[_i]), (PG8_LAS unsigned*)(lds + (bufoff) + ldsw + _i * 8192), 16, 0, 0); } while (0)
#define PG8_LDA(dst, b, h) do { _Pragma("unroll") for (int m = 0; m < 4; ++m) _Pragma("unroll") for (int k = 0; k < 2; ++k) dst[m][k] = *(const PG8_LAS bf16x8*)(lds + PG8_SA(b, h) + aoff + m * 2048 + k * 1024); } while (0)
#define PG8_LDB(dst, b, h) do { _Pragma("unroll") for (int n = 0; n < 2; ++n) _Pragma("unroll") for (int k = 0; k < 2; ++k) dst[n][k] = *(const PG8_LAS bf16x8*)(lds + PG8_SB(b, h) + boff + n * 2048 + k * 1024); } while (0)
typedef long i64x2_t __attribute__((ext_vector_type(2)));
#define PG8_H64(x, hf) (__builtin_bit_cast(i64x2_t, x)[hf])
#define PG8_CAT8(x, y) __builtin_shufflevector(__builtin_bit_cast(i32x4_t, x), __builtin_bit_cast(i32x4_t, y), 0, 1, 2, 3, 4, 5, 6, 7)
#define PG8_MMA(ai, bj, At, Bt) do { __builtin_amdgcn_s_setprio(1); \
        if constexpr (F8 == 2) { _Pragma("unroll") for (int m = 0; m < 4; ++m) _Pragma("unroll") for (int n = 0; n < 2; ++n) \
            asm volatile("v_mfma_f32_16x16x128_f8f6f4 %0, %1, %2, %0" : "+v"(acc[ai][bj][m][n]) : "v"(PG8_CAT8(Bt[n][0], Bt[n][1])), "v"(PG8_CAT8(At[m][0], At[m][1]))); } \
        else if constexpr (F8 == 1) { _Pragma("unroll") for (int k = 0; k < 2; ++k) _Pragma("unroll") for (int hf = 0; hf < 2; ++hf) _Pragma("unroll") for (int m = 0; m < 4; ++m) _Pragma("unroll") for (int n = 0; n < 2; ++n) \
            acc[ai][bj][m][n] = __builtin_amdgcn_mfma_f32_16x16x32_fp8_fp8(PG8_H64(Bt[n][k], hf), PG8_H64(At[m][k], hf), acc[ai][bj][m][n], 0, 0, 0); } \
        else { _Pragma("unroll") for (int m = 0; m < 4; ++m) _Pragma("unroll") for (int n = 0; n < 2; ++n) _Pragma("unroll") for (int k = 0; k < 2; ++k) \
            acc[ai][bj][m][n] = __builtin_amdgcn_mfma_f32_16x16x32_bf16(Bt[n][k], At[m][k], acc[ai][bj][m][n], 0, 0, 0); } \
        __builtin_amdgcn_s_setprio(0); } while (0)
#define PG8_WAIT_V(n) asm volatile("s_waitcnt vmcnt(" #n ")" ::: "memory")
#define PG8_WAIT_L(n) asm volatile("s_waitcnt lgkmcnt(" #n ")" ::: "memory")
#define PG8_BAR __builtin_amdgcn_s_barrier()
#define PG8_SCHED __builtin_amdgcn_sched_barrier(0)
    Unit cur, nxt; int ui = 0;
    if (!S.next(0, cur)) return;
    f32x4 acc[2][2][4][2];
#pragma unroll
    for (int a = 0; a < 2; ++a)
#pragma unroll
        for (int b = 0; b < 2; ++b)
#pragma unroll
            for (int m = 0; m < 4; ++m)
#pragma unroll
                for (int n = 0; n < 2; ++n) acc[a][b][m][n] = (f32x4){0.f, 0.f, 0.f, 0.f};
    bf16x8 At[4][2], B0[2][2], B1[2][2];
    const char* cA = (const char*)g.A + (size_t)cur.pm * tstep; const char* cB = (const char*)g.Bt + cur.bofs + (size_t)cur.pn * tstep;
    if constexpr (Sched::VAR_K) cA += cur.aofs;
    S.a_ready(cur);
    if constexpr (SP2) {
        PG8_STAGE(PG8_SB(0, 0), cB, voffB); PG8_STAGE(PG8_SB(0, 1), cB + hstep, voffB); PG8_STAGE(PG8_SA(0, 0), cA, voffA); PG8_STAGE(PG8_SA(0, 1), cA + hstep, voffA);
        if (wr == 1) PG8_BAR;
        PG8_WAIT_V(2); PG8_BAR;
        PG8_STAGE(PG8_SB(1, 0), cB + kstep, voffB); PG8_STAGE(PG8_SA(1, 0), cA + kstep, voffA); PG8_STAGE(PG8_SB(1, 1), cB + hstep + kstep, voffB);
        PG8_WAIT_V(6); PG8_BAR;
    } else {
        PG8_STAGE(PG8_SB(0, 0), cB, voffB); PG8_STAGE(PG8_SA(0, 0), cA, voffA); PG8_STAGE(PG8_SB(0, 1), cB + hstep, voffB); PG8_STAGE(PG8_SA(0, 1), cA + hstep, voffA);
        if (wr == 1) PG8_BAR;
        PG8_WAIT_V(4); PG8_BAR;
        PG8_STAGE(PG8_SB(1, 0), cB + kstep, voffB); PG8_STAGE(PG8_SA(1, 0), cA + kstep, voffA); PG8_STAGE(PG8_SB(1, 1), cB + hstep + kstep, voffB);
        PG8_WAIT_V(6); PG8_BAR;
    }
    for (;;) {
        unsigned preq[8];
        if constexpr (Epi::HAS_PRE) E.preload(preq, cur, wr, fr);
        const bool has_next = S.next(ui + 1, nxt);
        const char* nA = has_next ? (const char*)g.A + (size_t)nxt.pm * tstep : cA; const char* nB = has_next ? (const char*)g.Bt + nxt.bofs + (size_t)nxt.pn * tstep : cB;
        if constexpr (Sched::VAR_K) { if (has_next) nA += nxt.aofs; }
        int ntu = nt; if constexpr (Sched::VAR_K) ntu = cur.nt;
        for (int t = 0; t < ntu; t += 2) {
            const bool last = (t == ntu - 2);
            const char* a1 = cA + (size_t)(t + 1) * kstep;
            const char* a2 = last ? nA : cA + (size_t)(t + 2) * kstep; const char* b2 = last ? nB : cB + (size_t)(t + 2) * kstep;
            const char* a3 = a2 + kstep; const char* b3 = b2 + kstep;
            if (last && has_next) S.a_ready(nxt);
            if constexpr (SP2) {
            PG8_LDB(B0, 0, 0); PG8_LDB(B1, 0, 1); PG8_SCHED; PG8_LDA(At, 0, 0); PG8_STAGE(PG8_SA(1, 1), a1 + hstep, voffA);
            PG8_WAIT_V(8); PG8_WAIT_L(0); PG8_BAR; PG8_MMA(0, 0, At, B0); PG8_MMA(0, 1, At, B1); PG8_BAR; PG8_SCHED;
            PG8_LDA(At, 0, 1); PG8_STAGE(PG8_SB(0, 0), b2, voffB); PG8_STAGE(PG8_SB(0, 1), b2 + hstep, voffB); PG8_STAGE(PG8_SA(0, 0), a2, voffA);
            PG8_WAIT_V(8); PG8_WAIT_L(0); PG8_BAR; PG8_MMA(1, 0, At, B0); PG8_MMA(1, 1, At, B1); PG8_BAR; PG8_SCHED;
            PG8_LDB(B0, 1, 0); PG8_LDB(B1, 1, 1); PG8_SCHED; PG8_LDA(At, 1, 0); PG8_STAGE(PG8_SA(0, 1), a2 + hstep, voffA);
            PG8_WAIT_V(8); PG8_WAIT_L(0); PG8_BAR; PG8_MMA(0, 0, At, B0); PG8_MMA(0, 1, At, B1); PG8_BAR; PG8_SCHED;
            PG8_LDA(At, 1, 1); PG8_STAGE(PG8_SB(1, 0), b3, voffB); PG8_STAGE(PG8_SB(1, 1), b3 + hstep, voffB); PG8_STAGE(PG8_SA(1, 0), a3, voffA);
            PG8_WAIT_V(8); PG8_WAIT_L(0); PG8_BAR; PG8_MMA(1, 0, At, B0); PG8_MMA(1, 1, At, B1); PG8_BAR; PG8_SCHED;
            } else {
            PG8_LDB(B0, 0, 0); PG8_SCHED; PG8_LDA(At, 0, 0); PG8_STAGE(PG8_SA(1, 1), a1 + hstep, voffA);
            PG8_WAIT_L(8); PG8_BAR; PG8_WAIT_L(0); PG8_MMA(0, 0, At, B0); PG8_BAR; PG8_SCHED;
            PG8_LDB(B1, 0, 1); PG8_STAGE(PG8_SB(0, 0), b2, voffB);
            PG8_BAR; PG8_WAIT_L(0); PG8_MMA(0, 1, At, B1); PG8_BAR;
            PG8_LDA(At, 0, 1); PG8_STAGE(PG8_SA(0, 0), a2, voffA);
            PG8_BAR; PG8_WAIT_L(0); PG8_MMA(1, 0, At, B0); PG8_BAR; PG8_SCHED;
            PG8_STAGE(PG8_SB(0, 1), b2 + hstep, voffB);
            PG8_WAIT_V(6); PG8_BAR; PG8_MMA(1, 1, At, B1); PG8_BAR;
            PG8_LDB(B0, 1, 0); PG8_SCHED; PG8_LDA(At, 1, 0); PG8_STAGE(PG8_SA(0, 1), a2 + hstep, voffA);
            PG8_WAIT_L(8); PG8_BAR; PG8_WAIT_L(0); PG8_MMA(0, 0, At, B0); PG8_BAR; PG8_SCHED;
            PG8_LDB(B1, 1, 1); PG8_STAGE(PG8_SB(1, 0), b3, voffB);
            PG8_BAR; PG8_WAIT_L(0); PG8_MMA(0, 1, At, B1); PG8_BAR;
            PG8_LDA(At, 1, 1); PG8_STAGE(PG8_SA(1, 0), a3, voffA);
            PG8_BAR; PG8_WAIT_L(0); PG8_MMA(1, 0, At, B0); PG8_BAR; PG8_SCHED;
            PG8_STAGE(PG8_SB(1, 1), b3 + hstep, voffB);
            PG8_WAIT_V(6); PG8_BAR; PG8_MMA(1, 1, At, B1); PG8_BAR;
            }
        }
        if constexpr (F8 == 2) asm volatile("s_nop 15\n\ts_nop 15" ::: "memory");
        if constexpr (ALIGN_EPI) { if (wr == 0) PG8_BAR; }
        if constexpr (!Epi::AFTER_DRAIN) { if constexpr (Epi::HAS_PRE) E(acc, cur, wr, wc, fr, fq, preq); else E(acc, cur, wr, wc, fr, fq); S.done(cur); }
        if (!has_next) break;
#pragma unroll
        for (int a = 0; a < 2; ++a)
#pragma unroll
            for (int b = 0; b < 2; ++b)
#pragma unroll
                for (int m = 0; m < 4; ++m)
#pragma unroll
                    for (int n = 0; n < 2; ++n) acc[a][b][m][n] = (f32x4){0.f, 0.f, 0.f, 0.f};
        cur = nxt; cA = nA; cB = nB; ++ui;
        if constexpr (ALIGN_EPI) { if (wr == 1) PG8_BAR; }
    }
    PG8_WAIT_V(0);
    if constexpr (!ALIGN_EPI) { if (wr == 0) PG8_BAR; }
    PG8_BAR;
#undef PG8_SA
#undef PG8_SB
#undef PG8_STAGE
#undef PG8_LDA
#undef PG8_LDB
#undef PG8_MMA
#undef PG8_WAIT_V
#undef PG8_WAIT_L
#undef PG8_BAR
#undef PG8_SCHED
}
}


#include <hip/hip_bf16.h>
namespace fox {
using bf16h=__hip_bfloat16;
using bf16x8=__attribute__((ext_vector_type(8)))short;
using s16x4=__attribute__((ext_vector_type(4)))short;
using f32x16=__attribute__((ext_vector_type(16)))float;
using f32x4=__attribute__((ext_vector_type(4)))float;
using u32x4=__attribute__((ext_vector_type(4)))unsigned;
constexpr int NHEAD=FH,D=64,DMI=512,DMO=1024;
constexpr int NW=8,QBLK=32,QB=QBLK*NW,KVBLK=64,NQB=SEQ/QB;
__device__ __forceinline__ int crow(int r,int hi){return (r&3)+8*(r>>2)+4*hi;}
#define SBAR() __builtin_amdgcn_sched_barrier(0)
__device__ __forceinline__ void cmask(f32x16&p0,f32x16&p1,int jb,int qrel,int hi){
  const float NEG=-INFINITY; int kb=64*jb+4*hi;
  #pragma unroll
  for(int r=0;r<16;++r){int kv=kb+(r&3)+8*(r>>2); if(kv>qrel)p0[r]=NEG; if(kv+32>qrel)p1[r]=NEG;}
}
constexpr int NSLOT=3, SLOTB=8192;
constexpr int LDS_K=0, LDS_V=NSLOT*SLOTB, LDS_WS=2*NSLOT*SLOTB, LDS_OST=LDS_WS+NW*64*4, LDS_NB=LDS_OST+NW*4096, LDS_BYTES=LDS_NB+SEQ*4;
__device__ __forceinline__ void glds16(const void*gsrc,unsigned lds_dst){unsigned keep;
  asm volatile("s_mov_b32 %0, m0\n\ts_mov_b32 m0, %2\n\ts_nop 0\n\tglobal_load_lds_dwordx4 %1, off\n\ts_mov_b32 m0, %0":"=&s"(keep):"v"(gsrc),"s"(lds_dst):"memory");}
__device__ __forceinline__ float max3f(float a,float b,float c){float r;asm("v_max3_f32 %0, %1, %2, %3":"=v"(r):"v"(a),"v"(b),"v"(c));return r;}
__device__ __forceinline__ float max2f(float a,float b){float r;asm("v_max_f32_e32 %0, %1, %2":"=v"(r):"v"(a),"v"(b));return r;}
__device__ __forceinline__ float fadd_s(float a,float b){float r;asm("v_add_f32_e32 %0, %1, %2":"=v"(r):"v"(a),"v"(b));return r;}
__device__ __forceinline__ float fsub_s(float a,float b){float r;asm("v_sub_f32_e32 %0, %1, %2":"=v"(r):"v"(a),"v"(b));return r;}
typedef float f32x2_t __attribute__((ext_vector_type(2))); typedef __bf16 bf16x2_t __attribute__((ext_vector_type(2)));
__device__ __forceinline__ unsigned cvtpk_s(float lo,float hi){f32x2_t v={lo,hi};bf16x2_t b=__builtin_convertvector(v,bf16x2_t);return __builtin_bit_cast(unsigned,b);}
#define WAIT_BAR(N) asm volatile("s_waitcnt vmcnt(" #N ") lgkmcnt(0)\n\ts_barrier":::"memory")
__device__ __forceinline__ void qkt(f32x16&p0,f32x16&p1,const char*Kslot,const bf16x8*qr,int r32,int hi){
  const char*kb=Kslot+hi*1024+r32*16;
  #pragma unroll
  for(int d0=0;d0<4;++d0){
    const bf16x8 b0=*reinterpret_cast<const bf16x8*>(kb+d0*2048);
    const bf16x8 b1=*reinterpret_cast<const bf16x8*>(kb+d0*2048+512);
    p0=__builtin_amdgcn_mfma_f32_32x32x16_bf16(b0,qr[d0],p0,0,0,0);p1=__builtin_amdgcn_mfma_f32_32x32x16_bf16(b1,qr[d0],p1,0,0,0);}
}
typedef __attribute__((address_space(3))) const char* lds_cptr;
typedef __attribute__((address_space(3))) const float* lds_fptr;
typedef short v4i16_t __attribute__((ext_vector_type(4)));
__device__ __forceinline__ void kload8(bf16x8*kf,lds_cptr kp){
  kf[0]=*(const __attribute__((address_space(3))) bf16x8*)(kp);      kf[1]=*(const __attribute__((address_space(3))) bf16x8*)(kp+512);
  kf[2]=*(const __attribute__((address_space(3))) bf16x8*)(kp+2048); kf[3]=*(const __attribute__((address_space(3))) bf16x8*)(kp+2560);
  kf[4]=*(const __attribute__((address_space(3))) bf16x8*)(kp+4096); kf[5]=*(const __attribute__((address_space(3))) bf16x8*)(kp+4608);
  kf[6]=*(const __attribute__((address_space(3))) bf16x8*)(kp+6144); kf[7]=*(const __attribute__((address_space(3))) bf16x8*)(kp+6656);
}
__device__ __forceinline__ void kload2(bf16x8*kf,lds_cptr kp,int j){ kf[2*j]=*(const __attribute__((address_space(3))) bf16x8*)(kp+j*2048); kf[2*j+1]=*(const __attribute__((address_space(3))) bf16x8*)(kp+j*2048+512); }
__device__ __forceinline__ s16x4 vtr(lds_cptr p){ return __builtin_bit_cast(s16x4,__builtin_amdgcn_ds_read_tr16_b64_v4i16((__attribute__((address_space(3))) v4i16_t*)p)); }
__device__ __forceinline__ float rowmax(const f32x16&p0,const f32x16&p1){
  float a=max3f(p0[0],p0[1],p1[0]),b=max3f(p0[2],p0[3],p1[1]);a=max3f(a,p1[2],p1[3]);
  #pragma unroll
  for(int r=4;r<16;r+=4){a=max3f(a,p0[r],p0[r+1]);b=max3f(b,p0[r+2],p0[r+3]);a=max3f(a,p1[r],p1[r+1]);b=max3f(b,p1[r+2],p1[r+3]);}
  const float m=max2f(a,b);
  auto rr=__builtin_amdgcn_permlane32_swap(__float_as_uint(m),__float_as_uint(m),false,false);
  return max2f(__uint_as_float(rr[0]),__uint_as_float(rr[1]));
}
__device__ __forceinline__ void pv(f32x16*o,int vb,bf16x8 pa0,bf16x8 pa1,bf16x8 pa2,bf16x8 pa3){
  #pragma unroll
  for(int d0=0;d0<2;++d0){s16x4 lo[4],hi[4];
    #pragma unroll
    for(int ks=0;ks<4;++ks){
      asm volatile("ds_read_b64_tr_b16 %0,%1 offset:%c2":"=&v"(lo[ks]):"v"(vb),"i"(d0*4096+ks*1024):"memory");
      asm volatile("ds_read_b64_tr_b16 %0,%1 offset:%c2":"=&v"(hi[ks]):"v"(vb),"i"(d0*4096+ks*1024+512):"memory");}
    asm volatile("s_waitcnt lgkmcnt(0)":::"memory");SBAR();
    #define PK(k) (bf16x8){lo[k][0],lo[k][1],lo[k][2],lo[k][3],hi[k][0],hi[k][1],hi[k][2],hi[k][3]}
    o[d0]=__builtin_amdgcn_mfma_f32_32x32x16_bf16(pa0,PK(0),o[d0],0,0,0);
    o[d0]=__builtin_amdgcn_mfma_f32_32x32x16_bf16(pa1,PK(1),o[d0],0,0,0);
    o[d0]=__builtin_amdgcn_mfma_f32_32x32x16_bf16(pa2,PK(2),o[d0],0,0,0);
    o[d0]=__builtin_amdgcn_mfma_f32_32x32x16_bf16(pa3,PK(3),o[d0],0,0,0);
    #undef PK
  }
}
template<int THRL> __device__ __forceinline__ void attn_unit(int b,int h,int qb,int j0,const bf16h*Q,const bf16h*__restrict__ K,const bf16h*__restrict__ V,bf16h*O,const float*CL,char*shm){
  int tid=threadIdx.x; asm volatile("":"+v"(tid));
  const int lane=tid&63,r32=lane&31,hi=lane>>5; const int wid=__builtin_amdgcn_readfirstlane(tid>>6);
  const long rowbase=(long)b*SEQ; const int q0=qb*QB; const long kvbase=rowbase+(long)j0*KVBLK;
  const bf16h*Qw=Q+(rowbase+q0+wid*QBLK)*DMI+h*D;
  const bf16h*Kh=K+kvbase*DMI+h*D,*Vh=V+kvbase*DMI+h*D;
  const unsigned lds0=(unsigned)(uintptr_t)shm;
  float*wsf=(float*)(shm+LDS_WS)+wid*64;
  const int NT=(q0+QB)/KVBLK-j0;
  { float*nbw=(float*)(shm+LDS_NB); const float*src=CL+(long)j0*KVBLK;
    for(int i=tid*4;i<NT*KVBLK;i+=512*4){ const f32x4 v=*(const f32x4*)(src+i); *(f32x4*)(nbw+i)=(f32x4){-v[0],-v[1],-v[2],-v[3]}; } }
  const bf16h*ksrc=Kh+(long)lane*DMI+wid*8;
  const bf16h*vsrc=Vh+(long)(16*(wid&3)+(lane>>2))*DMI+(wid>>2)*32+(lane&3)*8;
  const unsigned kdst=lds0+LDS_K+wid*1024, vdst=lds0+LDS_V+wid*1024;
  #define DMA_K(t,slot) glds16(ksrc+(long)(t)*KVBLK*DMI,(unsigned)__builtin_amdgcn_readfirstlane(kdst+(slot)))
  #define DMA_V(t,slot) glds16(vsrc+(long)(t)*KVBLK*DMI,(unsigned)__builtin_amdgcn_readfirstlane(vdst+(slot)))
  const int vb0=(int)(lds0+LDS_V)+((lane>>4)&1)*32+(lane&3)*8+(4*hi+((lane&15)>>2))*64;
  const char*Kbase=shm+LDS_K; bf16x8 kf[8];
  const lds_cptr shm3=(lds_cptr)shm; const lds_cptr kp0=shm3+LDS_K+hi*1024+r32*16; const lds_cptr vp0=shm3+LDS_V+((lane>>4)&1)*32+(lane&3)*8+(4*hi+((lane&15)>>2))*64;
  const lds_fptr nb0=(lds_fptr)(shm3+LDS_NB)+4*hi;
  DMA_K(0,0);DMA_V(0,0);DMA_K(1,SLOTB);
  bf16x8 qr[4];
  #pragma unroll
  for(int d0=0;d0<4;++d0)qr[d0]=*reinterpret_cast<const bf16x8*>(&Qw[(long)r32*DMI+d0*16+hi*8]);
  float mhat=0.f,l_reg=0.f;f32x16 o[2];o[0]=f32x16{};o[1]=f32x16{};
  const int qrel=wid*QBLK+r32;
  #define CMASK(P0,P1,t) do{int jb_=(t)-(NT-4); if(jb_>=0)cmask(P0,P1,jb_,qrel,hi);}while(0)
  #define PRELOAD(P0,P1,tt) do{ const lds_fptr nbp_=nb0+(tt)*KVBLK; \
    _Pragma("unroll") for(int g_=0;g_<4;++g_){ const f32x4 a_=*(const __attribute__((address_space(3))) f32x4*)(nbp_+8*g_), b_=*(const __attribute__((address_space(3))) f32x4*)(nbp_+32+8*g_); \
      P0[4*g_]=a_[0]-mhat;P0[4*g_+1]=a_[1]-mhat;P0[4*g_+2]=a_[2]-mhat;P0[4*g_+3]=a_[3]-mhat; P1[4*g_]=b_[0]-mhat;P1[4*g_+1]=b_[1]-mhat;P1[4*g_+2]=b_[2]-mhat;P1[4*g_+3]=b_[3]-mhat; } }while(0)
  bool resc=false;
  #define START(P0,P1) do{ const float rm=rowmax(P0,P1); resc=false; \
    { const float dl=rm; mhat=fadd_s(mhat,dl); \
      _Pragma("unroll") for(int r=0;r<16;++r){P0[r]=fsub_s(P0[r],dl);P1[r]=fsub_s(P1[r],dl);} } \
    _Pragma("unroll") for(int r=0;r<16;++r)P0[r]=__builtin_amdgcn_exp2f(P0[r]); }while(0)
  #define RESC() do{ if(resc){ asm volatile("s_waitcnt lgkmcnt(0)":::"memory"); \
      _Pragma("unroll") for(int d_=0;d_<2;++d_) _Pragma("unroll") for(int r=0;r<16;++r)o[d_][r]*=wsf[crow(r,hi)]; } }while(0)
  f32x16 pA0,pA1,pB0,pB1;
  int sl_prev=0,sl_cur=0,sl_next=SLOTB;
  #define ROT() do{sl_prev=sl_cur;sl_cur=sl_next;sl_next=(sl_next==(NSLOT-1)*SLOTB)?0:sl_next+SLOTB;}while(0)
  DMA_K(2,2*SLOTB);
  WAIT_BAR(3);
  PRELOAD(pA0,pA1,0);
  qkt(pA0,pA1,Kbase,qr,r32,hi);asm volatile("s_nop 15\n\ts_nop 7":"+v"(pA0),"+v"(pA1));CMASK(pA0,pA1,0);
  START(pA0,pA1);
  _Pragma("unroll") for(int r=0;r<16;++r)pA1[r]=__builtin_amdgcn_exp2f(pA1[r]);
  WAIT_BAR(0);
  DMA_K(3,0);DMA_V(1,SLOTB);
  ROT();
  kload8(kf,kp0+sl_cur);
  PRELOAD(pB0,pB1,1);
  WAIT_BAR(2);
  s16x4 vlo[8],vhi[8]; u32x4 pw0,pw1,pw2,pw3;
  #define PKW(P,B) cvtpk_s(P[B],P[B+1])
  #define PAF(k) __builtin_bit_cast(bf16x8,pw##k)
  #define VFR(i) (bf16x8){vlo[i][0],vlo[i][1],vlo[i][2],vlo[i][3],vhi[i][0],vhi[i][1],vhi[i][2],vhi[i][3]}
  #define PIN(x) asm volatile("":"+v"(x))
  #define MX3(a,b,c) __builtin_fmaxf(__builtin_fmaxf((a),(b)),(c))
  #define GAPA(MF,A0,A1,A2,A3,W0,W1,PW) do{ MF; sacc+=A0; sacc+=A1; sacc+=A2; sacc+=A3; PIN(sacc); W0; W1; PIN(PW); SBAR(); }while(0)
  #define EX(v) __builtin_amdgcn_exp2f(v)
  #define GAPB(MF,X,B) do{ MF; X[B]=EX(X[B]); X[B+1]=EX(X[B+1]); X[B+2]=EX(X[B+2]); X[B+3]=EX(X[B+3]); PIN(X); SBAR(); }while(0)
  #define VRD(i) do{ vlo[i]=vtr(vp_+(((i)>>2)*4096+((i)&3)*1024)); vhi[i]=vtr(vp_+(((i)>>2)*4096+((i)&3)*1024+512)); }while(0)
  #define KRD(G,j) do{ if(G){ kload2(kf,kp0+sl_next,j); SBAR(); } }while(0)
  #define STEP(C0,C1,P0,P1,t,GK,GV,GL) do{ SBAR(); \
    const lds_cptr vp_=vp0+sl_prev; \
    VRD(0); SBAR(); float sacc=(P0[0]+P0[1]); \
    GAPA(C0=__builtin_amdgcn_mfma_f32_32x32x16_bf16(kf[0],qr[0],C0,0,0,0), P0[2],P0[3],P0[4],P0[5],     pw0[0]=PKW(P0,0), pw0[1]=PKW(P0,2), pw0); \
    VRD(4); SBAR(); GAPA(C1=__builtin_amdgcn_mfma_f32_32x32x16_bf16(kf[1],qr[0],C1,0,0,0), P0[6],P0[7],P0[8],P0[9],     pw0[2]=PKW(P0,4), pw0[3]=PKW(P0,6), pw0); \
    VRD(1); SBAR(); GAPA(C0=__builtin_amdgcn_mfma_f32_32x32x16_bf16(kf[2],qr[1],C0,0,0,0),   P0[10],P0[11],P0[12],P0[13], pw1[0]=PKW(P0,8), pw1[1]=PKW(P0,10), pw1); \
    VRD(5); SBAR(); GAPA(C1=__builtin_amdgcn_mfma_f32_32x32x16_bf16(kf[3],qr[1],C1,0,0,0),   P0[14],P0[15],P1[0],P1[1],   pw1[2]=PKW(P0,12),pw1[3]=PKW(P0,14), pw1); \
    VRD(2); SBAR(); GAPA(C0=__builtin_amdgcn_mfma_f32_32x32x16_bf16(kf[4],qr[2],C0,0,0,0),   P1[2],P1[3],P1[4],P1[5],     pw2[0]=PKW(P1,0), pw2[1]=PKW(P1,2), pw2); \
    VRD(6); SBAR(); GAPA(C1=__builtin_amdgcn_mfma_f32_32x32x16_bf16(kf[5],qr[2],C1,0,0,0),   P1[6],P1[7],P1[8],P1[9],     pw2[2]=PKW(P1,4), pw2[3]=PKW(P1,6), pw2); \
    VRD(3); SBAR(); GAPA(C0=__builtin_amdgcn_mfma_f32_32x32x16_bf16(kf[6],qr[3],C0,0,0,0),   P1[10],P1[11],P1[12],P1[13], pw3[0]=PKW(P1,8), pw3[1]=PKW(P1,10), pw3); \
    VRD(7); SBAR(); GAPA(C1=__builtin_amdgcn_mfma_f32_32x32x16_bf16(kf[7],qr[3],C1,0,0,0),   P1[14],P1[15],0.f,0.f,       pw3[2]=PKW(P1,12),pw3[3]=PKW(P1,14), pw3); \
    l_reg+=sacc; \
    if(GK){DMA_K((t)+3,sl_cur);} if(GV){DMA_V((t)+1,sl_next);} \
    CMASK(C0,C1,t); \
    { float a=MX3(C0[0],C0[1],C1[0]),b=MX3(C0[2],C0[3],C1[1]); a=MX3(a,C1[2],C1[3]); \
      _Pragma("unroll") for(int r=4;r<16;r+=4){a=MX3(a,C0[r],C0[r+1]);b=MX3(b,C0[r+2],C0[r+3]);a=MX3(a,C1[r],C1[r+1]);b=MX3(b,C1[r+2],C1[r+3]);} \
      float rm=__builtin_fmaxf(a,b); { auto rr=__builtin_amdgcn_permlane32_swap(__float_as_uint(rm),__float_as_uint(rm),false,false); rm=__builtin_fmaxf(__uint_as_float(rr[0]),__uint_as_float(rr[1])); } \
      resc=false; \
      if(__builtin_expect(__any(rm>(float)THRL),0)){ const float dl=__builtin_fmaxf(rm,0.f); mhat+=dl; \
        _Pragma("unroll") for(int r=0;r<16;++r){C0[r]-=dl;C1[r]-=dl;} \
        const float f=__builtin_amdgcn_exp2f(-dl); l_reg*=f; if(hi==0)wsf[r32]=f; resc=true; } } \
    SBAR(); \
    GAPB(o[0]=__builtin_amdgcn_mfma_f32_32x32x16_bf16(PAF(0),VFR(0),o[0],0,0,0), C0,0); \
    GAPB(o[1]=__builtin_amdgcn_mfma_f32_32x32x16_bf16(PAF(0),VFR(4),o[1],0,0,0), C0,4); \
    KRD(GL,0); GAPB(o[0]=__builtin_amdgcn_mfma_f32_32x32x16_bf16(PAF(1),VFR(1),o[0],0,0,0), C0,8); \
    KRD(GL,1); GAPB(o[1]=__builtin_amdgcn_mfma_f32_32x32x16_bf16(PAF(1),VFR(5),o[1],0,0,0), C0,12); \
    KRD(GL,2); GAPB(o[0]=__builtin_amdgcn_mfma_f32_32x32x16_bf16(PAF(2),VFR(2),o[0],0,0,0), C1,0); \
    KRD(GL,3); GAPB(o[1]=__builtin_amdgcn_mfma_f32_32x32x16_bf16(PAF(2),VFR(6),o[1],0,0,0), C1,4); \
    GAPB(o[0]=__builtin_amdgcn_mfma_f32_32x32x16_bf16(PAF(3),VFR(3),o[0],0,0,0), C1,8); \
    GAPB(o[1]=__builtin_amdgcn_mfma_f32_32x32x16_bf16(PAF(3),VFR(7),o[1],0,0,0), C1,12); \
    if(GL){ PRELOAD(P0,P1,(t)+1); } \
    }while(0)
  int t=1;
  #undef CMASK
  #define CMASK(P0,P1,t) do{}while(0)
  for(;t+5<NT;t+=2){
    STEP(pB0,pB1,pA0,pA1,t,true,true,true);     WAIT_BAR(2); RESC(); ROT();
    STEP(pA0,pA1,pB0,pB1,t+1,true,true,true);   WAIT_BAR(2); RESC(); ROT();
  }
  #undef CMASK
  #define CMASK(P0,P1,t) do{int jb_=(t)-(NT-4); if(jb_>=0)cmask(P0,P1,jb_,qrel,hi);}while(0)
  #define ENDW(tt) do{ if((tt)+3<NT){WAIT_BAR(2);} else if((tt)+2<NT){WAIT_BAR(1);} else {WAIT_BAR(0);} }while(0)
  for(;t+1<NT;t+=2){
    STEP(pB0,pB1,pA0,pA1,t,(t+3<NT),(t+1<NT),(t+1<NT));       ENDW(t);   RESC(); ROT();
    STEP(pA0,pA1,pB0,pB1,t+1,(t+4<NT),(t+2<NT),(t+2<NT));     ENDW(t+1); RESC(); ROT();
  }
  STEP(pB0,pB1,pA0,pA1,NT-1,false,false,false); RESC();
  { float sacc=pB0[0]+pB0[1]; _Pragma("unroll") for(int r=2;r<16;++r)sacc+=pB0[r]; _Pragma("unroll") for(int r=0;r<16;++r)sacc+=pB1[r]; l_reg+=sacc;
    pw0=(u32x4){PKW(pB0,0),PKW(pB0,2),PKW(pB0,4),PKW(pB0,6)};pw1=(u32x4){PKW(pB0,8),PKW(pB0,10),PKW(pB0,12),PKW(pB0,14)};pw2=(u32x4){PKW(pB1,0),PKW(pB1,2),PKW(pB1,4),PKW(pB1,6)};pw3=(u32x4){PKW(pB1,8),PKW(pB1,10),PKW(pB1,12),PKW(pB1,14)};
    SBAR(); pv(o,vb0+sl_cur,PAF(0),PAF(1),PAF(2),PAF(3)); }
  #undef PKW
  #undef PAF
  #undef VFR
  #undef PIN
  #undef MX3
  #undef GAPA
  #undef GAPB
  #undef EX
  #undef VRD
  #undef KRD
  #undef STEP
  #undef ENDW
  {auto rr=__builtin_amdgcn_permlane32_swap(__float_as_uint(l_reg),__float_as_uint(l_reg),false,false);l_reg=__uint_as_float(rr[0])+__uint_as_float(rr[1]);}
  if(hi==0)wsf[32+r32]=l_reg;asm volatile("s_waitcnt lgkmcnt(0)":::"memory");
  float rli[16];
  #pragma unroll
  for(int r=0;r<16;++r)rli[r]=__builtin_amdgcn_rcpf(wsf[32+crow(r,hi)]);
  bf16h*Ow=O+(rowbase+q0+wid*QBLK)*DMO+h*D;
  { bf16h*stg=(bf16h*)(shm+LDS_OST)+wid*2048;
    #pragma unroll
    for(int r=0;r<16;++r){const int orow=crow(r,hi);
      #pragma unroll
      for(int d0=0;d0<2;++d0)stg[orow*64+d0*32+r32]=__float2bfloat16(o[d0][r]*rli[r]);}
    asm volatile("s_waitcnt lgkmcnt(0)":::"memory");
    #pragma unroll
    for(int i=0;i<4;++i){const int row=i*8+(lane>>3),ch=lane&7; const u32x4 v=*(const u32x4*)(stg+row*64+ch*8); *(u32x4*)(Ow+(long)row*DMO+ch*8)=v;} }
  asm volatile("s_waitcnt lgkmcnt(0)\n\ts_barrier":::"memory");
  #undef DMA_K
  #undef DMA_V
  #undef CMASK
  #undef PRELOAD
  #undef START
  #undef RESC
  #undef ROT
}

__device__ __forceinline__ int unit_j0_wave(int bh,int qb,const bf16h*Q,const float*KN2,const float*CL,int lane){
  const int b=bh/NHEAD,h=bh%NHEAD; constexpr int NTT=SEQ/KVBLK;
  float mx=0.f;
  #pragma unroll
  for(int rr=0;rr<QB/64;++rr){ const bf16h*Qw=Q+((long)b*SEQ+qb*QB+rr*64+lane)*DMI+h*D; float ss=0.f;
    #pragma unroll
    for(int c=0;c<8;++c){ const u32x4 v=*reinterpret_cast<const u32x4*>(&Qw[c*8]);
      #pragma unroll
      for(int e=0;e<4;++e){ const float f0=__uint_as_float(v[e]<<16),f1=__uint_as_float(v[e]&0xffff0000u); ss+=f0*f0+f1*f1; } }
    mx=fmaxf(mx,ss); }
  #pragma unroll
  for(int o=1;o<64;o<<=1) mx=fmaxf(mx,__shfl_xor(mx,o));
  const int nt=4*qb; const float*kn=KN2+bh*NTT;
  const float Qn=sqrtf(mx),KNd=sqrtf(fmaxf(fmaxf(kn[nt],kn[nt+1]),fmaxf(kn[nt+2],kn[nt+3])));
  const float clt0=CL[qb*QB];
  int first=nt;
  #pragma unroll
  for(int part=1;part>=0;--part){ const int i=lane+64*part; bool need=false;
    if(i<nt){ const float bound=Qn*(sqrtf(kn[i])+KNd)+clt0-CL[KVBLK*i+KVBLK-1]; need=!(bound<-40.f); }
    const unsigned long long bal=__ballot(need); if(bal) first=__ffsll((long long)bal)-1+64*part; }
  return (first<nt?first:nt)&~1;
}
#undef SBAR
#undef WAIT_BAR
}

#define GAS __attribute__((address_space(1)))
#define LAS __attribute__((address_space(3)))
typedef unsigned v4u __attribute__((ext_vector_type(4)));
typedef float f32x4 __attribute__((ext_vector_type(4)));
typedef GAS unsigned gu32;
#define RLX_AGENT __ATOMIC_RELAXED, __HIP_MEMORY_SCOPE_AGENT
#define LDS_WAIT() asm volatile("s_waitcnt lgkmcnt(0)" ::: "memory")
#define VM_WAIT() asm volatile("s_waitcnt vmcnt(0)" ::: "memory")
__device__ __forceinline__ unsigned pk2(float lo, float hi) { return (unsigned)f2bf(lo) | ((unsigned)f2bf(hi) << 16); }
__device__ __forceinline__ void unpack8(const v4u w, float* f) {
#pragma unroll
    for (int i = 0; i < 4; ++i) { f[2 * i] = __uint_as_float(w[i] << 16); f[2 * i + 1] = __uint_as_float(w[i] & 0xffff0000u); }
}

#define XB_TMO      128
#define XB_XCNT(j)  (256  + 64 * (j))
#define XB_XSUB(j)  (1280 + 64 * (j))
#define XB_XGEN(j)  (2304 + 64 * (j))
#define XB_TOP      3328
#define XB_TOPGEN   3392
#define XCD_BAR_WORDS 3456
#define XB_SPIN_CAP (1u << 18)
__device__ __forceinline__ unsigned xb_ld(unsigned* p)              { return __hip_atomic_load(p, __ATOMIC_RELAXED, __HIP_MEMORY_SCOPE_AGENT); }
__device__ __forceinline__ unsigned xb_add(unsigned* p, unsigned v) { return __hip_atomic_fetch_add(p, v, __ATOMIC_RELAXED, __HIP_MEMORY_SCOPE_AGENT); }
__device__ __forceinline__ unsigned xb_xcc_id() { return (unsigned)__builtin_amdgcn_s_getreg((3 << 11) | 20) & 0xFu; }
#define XB_SPIN(cond, bar) do { unsigned _sp = 0; while (cond) { __builtin_amdgcn_s_sleep(1); \
    if ((++_sp & 255u) == 0u) { if (xb_ld(&(bar)[XB_TMO])) break; if (_sp > XB_SPIN_CAP) { atomicAdd(&(bar)[XB_TMO], 1u); break; } } } } while (0)
struct XcdBarrier { unsigned* bar; unsigned x; volatile LAS unsigned* st; };
__device__ __forceinline__ XcdBarrier xcd_barrier_post(unsigned* bar, volatile LAS unsigned* st) {
    XcdBarrier b; b.bar = bar; b.x = xb_xcc_id(); b.st = st;
    if (threadIdx.x == 0) (void)xb_add(&bar[XB_XCNT(b.x)], 1u);
    return b;
}
__device__ __forceinline__ void xcd_barrier_complete(unsigned* bar, unsigned x, unsigned& nloc, unsigned& nx) {
    const unsigned G = gridDim.x * gridDim.y * gridDim.z;
    unsigned sum, cnt, mine, sp = 0u;
    for (;;) {
        sum = 0u; cnt = 0u; mine = 0u;
#pragma unroll
        for (unsigned j = 0; j < 16; ++j) { const unsigned c = xb_ld(&bar[XB_XCNT(j)]); sum += c; cnt += (c > 0u) ? 1u : 0u; mine = (j == x) ? c : mine; }
        if (sum == G) break;
        __builtin_amdgcn_s_sleep(1);
        if ((++sp & 255u) == 0u) { if (xb_ld(&bar[XB_TMO])) break; if (sp > XB_SPIN_CAP) { atomicAdd(&bar[XB_TMO], 1u); break; } }
    }
    nloc = mine > 0u ? mine : 1u; nx = cnt > 0u ? cnt : 1u;
}
__device__ __forceinline__ void xcd_barrier(const XcdBarrier& b) {
    asm volatile("s_waitcnt vmcnt(0)" ::: "memory");
    __syncthreads();
    if (threadIdx.x == 0) {
        unsigned* bar = b.bar;
        __builtin_amdgcn_s_waitcnt(0);
        unsigned nloc = b.st[0], nx = b.st[1];
        if (nloc == 0u) { xcd_barrier_complete(bar, b.x, nloc, nx); b.st[0] = nloc; b.st[1] = nx; }
        const unsigned old = xb_add(&bar[XB_XSUB(b.x)], 1u);
        const unsigned gen = old / nloc;
        if (old + 1u == (gen + 1u) * nloc) {
            __builtin_amdgcn_fence(__ATOMIC_RELEASE, "agent");
            asm volatile("s_waitcnt vmcnt(0)" ::: "memory");
            const unsigned og = xb_add(&bar[XB_TOP], 1u);
            const unsigned tg = og / nx;
            if (og + 1u == (tg + 1u) * nx) xb_add(&bar[XB_TOPGEN], 1u);
            else XB_SPIN(xb_ld(&bar[XB_TOPGEN]) == tg, bar);
            __builtin_amdgcn_fence(__ATOMIC_ACQUIRE, "agent");
            xb_add(&bar[XB_XGEN(b.x)], 1u);
            asm volatile("s_waitcnt vmcnt(0)" ::: "memory");
        } else {
            XB_SPIN(xb_ld(&bar[XB_XGEN(b.x)]) == gen, bar);
            __builtin_amdgcn_fence(__ATOMIC_ACQUIRE, "agent");
            asm volatile("s_waitcnt vmcnt(0)" ::: "memory");
        }
    }
    __syncthreads();
}


namespace xat {
typedef short bf16x8 __attribute__((ext_vector_type(8)));
typedef short s16x4 __attribute__((ext_vector_type(4)));
typedef float f32x16 __attribute__((ext_vector_type(16)));
constexpr int RB = 272;
constexpr int KIMG = 0, VIMG = 128 * RB, LDS_BYTES = 2 * 128 * RB;
__device__ __forceinline__ unsigned cvtpk(float lo, float hi) { typedef float f2 __attribute__((ext_vector_type(2))); typedef __bf16 b2 __attribute__((ext_vector_type(2))); f2 v = {lo, hi}; b2 b = __builtin_convertvector(v, b2); return __builtin_bit_cast(unsigned, b); }
__device__ __forceinline__ float swapmax(float m) { auto rr = __builtin_amdgcn_permlane32_swap(__float_as_uint(m), __float_as_uint(m), false, false); return fmaxf(__uint_as_float(rr[0]), __uint_as_float(rr[1])); }
__device__ __forceinline__ float swapadd(float m) { auto rr = __builtin_amdgcn_permlane32_swap(__float_as_uint(m), __float_as_uint(m), false, false); return __uint_as_float(rr[0]) + __uint_as_float(rr[1]); }
__device__ __forceinline__ void unit(int b, int head, int qb, const bf16* QX, const bf16* KX, const bf16* VT, bf16* OX, LAS unsigned char* lds) {
    int tid = threadIdx.x; asm volatile("" : "+v"(tid));
    const int lane = tid & 63, r32 = lane & 31, h = lane >> 5, wid = tid >> 6;
    const size_t qrow = (size_t)b * SEQ + (size_t)qb * 256 + wid * 32 + r32;
    bf16x8 qf[8];
#pragma unroll
    for (int d0 = 0; d0 < 8; ++d0) qf[d0] = *(const bf16x8*)(QX + qrow * 512 + head * 128 + 16 * d0 + 8 * h);
    f32x16 o[4];
#pragma unroll
    for (int db = 0; db < 4; ++db) o[db] = (f32x16){};
    float mrun = -INFINITY, lsum = 0.f;
#pragma unroll 1
    for (int half = 0; half < 2; ++half) {
        __syncthreads();
#pragma unroll
        for (int i = 0; i < 4; ++i) { const int c = tid + 512 * i, row = c >> 4, ch = c & 15;
            const v4u kv = *(const GAS v4u*)(KX + ((size_t)b * NMEM + half * 128 + row) * 512 + head * 128 + ch * 8);
            const v4u vv = *(const GAS v4u*)(VT + ((size_t)head * 128 + row) * 512 + b * NMEM + half * 128 + ch * 8);
            *(LAS v4u*)(lds + KIMG + row * RB + ch * 16) = kv; *(LAS v4u*)(lds + VIMG + row * RB + ch * 16) = vv; }
        __syncthreads();
        f32x16 st[4];
#pragma unroll
        for (int kb = 0; kb < 4; ++kb) { st[kb] = (f32x16){};
#pragma unroll
            for (int d0 = 0; d0 < 8; ++d0) { const bf16x8 a = *(const LAS bf16x8*)(lds + KIMG + (32 * kb + r32) * RB + (16 * d0 + 8 * h) * 2);
                st[kb] = __builtin_amdgcn_mfma_f32_32x32x16_bf16(a, qf[d0], st[kb], 0, 0, 0); } }
        float mloc = st[0][0];
#pragma unroll
        for (int kb = 0; kb < 4; ++kb)
#pragma unroll
            for (int i = 0; i < 16; ++i) mloc = fmaxf(mloc, st[kb][i]);
        const float mnew = fmaxf(mrun, swapmax(mloc)), alpha = __builtin_amdgcn_exp2f(mrun - mnew);
        float psum = 0.f;
#pragma unroll
        for (int kb = 0; kb < 4; ++kb)
#pragma unroll
            for (int i = 0; i < 16; ++i) { st[kb][i] = __builtin_amdgcn_exp2f(st[kb][i] - mnew); psum += st[kb][i]; }
        lsum = lsum * alpha + psum; mrun = mnew;
#pragma unroll
        for (int db = 0; db < 4; ++db)
#pragma unroll
            for (int i = 0; i < 16; ++i) o[db][i] *= alpha;
#pragma unroll
        for (int kb = 0; kb < 4; ++kb)
#pragma unroll
            for (int sp = 0; sp < 2; ++sp) {
                v4u pw; pw.x = cvtpk(st[kb][8 * sp], st[kb][8 * sp + 1]); pw.y = cvtpk(st[kb][8 * sp + 2], st[kb][8 * sp + 3]); pw.z = cvtpk(st[kb][8 * sp + 4], st[kb][8 * sp + 5]); pw.w = cvtpk(st[kb][8 * sp + 6], st[kb][8 * sp + 7]);
                const bf16x8 pb = __builtin_bit_cast(bf16x8, pw);
#pragma unroll
                for (int db = 0; db < 4; ++db) { const LAS unsigned char* vp = lds + VIMG + (32 * db + r32) * RB + (32 * kb + 16 * sp + 4 * h) * 2;
                    const s16x4 lo = *(const LAS s16x4*)vp, hi = *(const LAS s16x4*)(vp + 16);
                    const bf16x8 va = {lo[0], lo[1], lo[2], lo[3], hi[0], hi[1], hi[2], hi[3]};
                    o[db] = __builtin_amdgcn_mfma_f32_32x32x16_bf16(va, pb, o[db], 0, 0, 0); } }
    }
    const float inv = 1.f / swapadd(lsum);
    bf16* orow = OX + qrow * 512 + head * 128;
#pragma unroll
    for (int db = 0; db < 4; ++db)
#pragma unroll
        for (int g = 0; g < 4; ++g) {
            const unsigned long long w = (unsigned long long)cvtpk(o[db][4 * g] * inv, o[db][4 * g + 1] * inv) | ((unsigned long long)cvtpk(o[db][4 * g + 2] * inv, o[db][4 * g + 3] * inv) << 32);
            *(GAS unsigned long long*)(orow + 32 * db + 8 * g + 4 * h) = w; }
}
}


namespace mls {
typedef short bf16x8 __attribute__((ext_vector_type(8)));
typedef short s16x4 __attribute__((ext_vector_type(4)));
typedef float f32x16 __attribute__((ext_vector_type(16)));
constexpr int RB = 128, VIMG = 0, KIMG = 8192, ATAB = 8192, NTAB = 8448;
__device__ __forceinline__ s16x4 trd(const LAS unsigned char* p) { typedef short v4i16_t __attribute__((ext_vector_type(4))); return __builtin_bit_cast(s16x4, __builtin_amdgcn_ds_read_tr16_b64_v4i16((LAS v4i16_t*)p)); }
__device__ __forceinline__ bf16x8 cat8(s16x4 lo, s16x4 hi) { return (bf16x8){lo[0], lo[1], lo[2], lo[3], hi[0], hi[1], hi[2], hi[3]}; }
__device__ __forceinline__ unsigned cvtpk(float lo, float hi) { typedef float f2 __attribute__((ext_vector_type(2))); typedef __bf16 b2 __attribute__((ext_vector_type(2))); f2 v = {lo, hi}; b2 b = __builtin_convertvector(v, b2); return __builtin_bit_cast(unsigned, b); }
__device__ __forceinline__ bf16x8 pack8(const float* f) { v4u w; w.x = cvtpk(f[0], f[1]); w.y = cvtpk(f[2], f[3]); w.z = cvtpk(f[4], f[5]); w.w = cvtpk(f[6], f[7]); return __builtin_bit_cast(bf16x8, w); }
__device__ __forceinline__ float swapadd(float m) { auto rr = __builtin_amdgcn_permlane32_swap(__float_as_uint(m), __float_as_uint(m), false, false); return __uint_as_float(rr[0]) + __uint_as_float(rr[1]); }
__device__ __forceinline__ int crow(int r, int hi) { return (r & 3) + 8 * (r >> 2) + 4 * hi; }

__device__ __forceinline__ void u_unit(const Ptrs& P, int bhk, LAS unsigned char* wl, int lane) {
    const int bh = bhk / NCH, k = bhk % NCH, b = bh / MH, hd = bh % MH; const size_t row0 = (size_t)b * SEQ + (size_t)k * 64;
    const int r32 = lane & 31, h = lane >> 5;
    const float li = WSP(const float, WS_GATE)[(size_t)hd * M + row0 + lane], bl = WSP(const float, WS_BL)[(size_t)bh * SEQ + k * 64 + lane];
    const float wg = __expf(WSP(const float, WS_BT)[bhk] - bl + li - WSP(const float, WS_MS)[bh * (NCH + 1) + k + 1]);
    const bf16* vsrc = WSP(const bf16, R_T0 + SZ_T) + row0 * 512 + hd * 64; const bf16* ksrc = WSP(const bf16, R_MQK) + row0 * 512 + 256 + hd * 64;
#pragma unroll
    for (int i = 0; i < 8; ++i) { const int row = i * 8 + (lane >> 3), ch = lane & 7;
        *(LAS v4u*)(wl + VIMG + row * RB + ch * 16) = *(const GAS v4u*)(vsrc + (size_t)row * 512 + ch * 8);
        const v4u kk = *(const GAS v4u*)(ksrc + (size_t)row * 512 + ch * 8); float f[8]; unpack8(kk, f); const float w = __shfl(wg, row);
#pragma unroll
        for (int e = 0; e < 8; ++e) f[e] *= w;
        *(LAS bf16x8*)(wl + KIMG + row * RB + ch * 16) = pack8(f); }
    f32x16 acc[2][2];
#pragma unroll
    for (int a = 0; a < 2; ++a)
#pragma unroll
        for (int c = 0; c < 2; ++c) acc[a][c] = (f32x16){};
    const unsigned toff = (unsigned)(((lane & 15) >> 2) * RB + (16 * ((lane >> 4) & 1) + 4 * (lane & 3)) * 2);
#pragma unroll
    for (int st = 0; st < 4; ++st) { bf16x8 af[2], bf_[2];
#pragma unroll
        for (int c = 0; c < 2; ++c) { const LAS unsigned char* pv = wl + VIMG + (16 * st + 8 * h) * RB + toff + 64 * c; af[c] = cat8(trd(pv), trd(pv + 4 * RB));
                                      const LAS unsigned char* pk = wl + KIMG + (16 * st + 8 * h) * RB + toff + 64 * c; bf_[c] = cat8(trd(pk), trd(pk + 4 * RB)); }
#pragma unroll
        for (int jb = 0; jb < 2; ++jb)
#pragma unroll
            for (int ib = 0; ib < 2; ++ib) acc[jb][ib] = __builtin_amdgcn_mfma_f32_32x32x16_bf16(af[jb], bf_[ib], acc[jb][ib], 0, 0, 0); }
    float* UT = WSP(float, R_CST) + (size_t)bhk * 4096;
#pragma unroll
    for (int jb = 0; jb < 2; ++jb)
#pragma unroll
        for (int ib = 0; ib < 2; ++ib)
#pragma unroll
            for (int e = 0; e < 16; ++e) UT[(32 * jb + crow(e, h)) * 64 + 32 * ib + r32] = acc[jb][ib][e];
    float sn = 0.f;
#pragma unroll 8
    for (int r = 0; r < 64; ++r) sn += bf2f(*(const LAS bf16*)(wl + KIMG + r * RB + lane * 2));
    WSP(float, WS_NST)[(size_t)bhk * 64 + lane] = sn;
}

__device__ __forceinline__ void decay_apply(f32x16& tile, int sb, int tb, const LAS float* atab, float mx, float& dsum, int r32, int h) {
#pragma unroll
    for (int g = 0; g < 4; ++g) { const f32x4 av = *(const LAS f32x4*)(atab + 32 * sb + 8 * g + 4 * h);
#pragma unroll
        for (int c = 0; c < 4; ++c) { const int sidx = 32 * sb + 8 * g + 4 * h + c, t = 32 * tb + r32;
            const float w = (sidx <= t) ? __expf(av[c] - mx) : 0.f; tile[4 * g + c] *= w; dsum += tile[4 * g + c]; } }
}
__device__ __forceinline__ bf16x8 packstep(const f32x16& x, int st) { v4u w; w.x = cvtpk(x[8 * st], x[8 * st + 1]); w.y = cvtpk(x[8 * st + 2], x[8 * st + 3]); w.z = cvtpk(x[8 * st + 4], x[8 * st + 5]); w.w = cvtpk(x[8 * st + 6], x[8 * st + 7]); return __builtin_bit_cast(bf16x8, w); }

__device__ __forceinline__ void out_unit(const Ptrs& P, int l, int bhk, LAS unsigned char* wl, int lane) {
    const int bh = bhk / NCH, k = bhk % NCH, b = bh / MH, hd = bh % MH; const size_t row0 = (size_t)b * SEQ + (size_t)k * 64;
    const int r32 = lane & 31, h = lane >> 5;
    const bf16* T1 = WSP(const bf16, R_T0 + SZ_T); const bf16* MQK = WSP(const bf16, R_MQK);
    const bf16* vsrc = T1 + row0 * 512 + hd * 64;
    v4u vreg[8];
#pragma unroll
    for (int i = 0; i < 8; ++i) { const int row = i * 8 + (lane >> 3), ch = lane & 7; vreg[i] = *(const GAS v4u*)(vsrc + (size_t)row * 512 + ch * 8); }
    bf16x8 qf[2][4], kf[2][4];
#pragma unroll
    for (int tb = 0; tb < 2; ++tb)
#pragma unroll
        for (int d0 = 0; d0 < 4; ++d0) { qf[tb][d0] = *(const bf16x8*)(MQK + (row0 + 32 * tb + r32) * 512 + hd * 64 + 16 * d0 + 8 * h);
                                         kf[tb][d0] = *(const bf16x8*)(MQK + (row0 + 32 * tb + r32) * 512 + 256 + hd * 64 + 16 * d0 + 8 * h); }
    const float li_s = WSP(const float, WS_GATE)[(size_t)hd * M + row0 + lane], bl_s = WSP(const float, WS_BL)[(size_t)bh * SEQ + k * 64 + lane];
    const float mk = WSP(const float, WS_MS)[bh * (NCH + 1) + k]; const float nst = WSP(const float, WS_NST)[(size_t)bhk * 64 + lane];
    const float a_s = li_s - bl_s; float pm = a_s;
#pragma unroll
    for (int o = 1; o < 64; o <<= 1) { const float t = __shfl_up(pm, o); if (lane >= o) pm = fmaxf(pm, t); }
    LAS float* atab = (LAS float*)(wl + ATAB); LAS float* ntab = (LAS float*)(wl + NTAB);
    atab[lane] = a_s; ntab[lane] = nst;
    float mx[2], wi[2], blt[2];
#pragma unroll
    for (int tb = 0; tb < 2; ++tb) { const int t = 32 * tb + r32; blt[tb] = __shfl(bl_s, t); mx[tb] = fmaxf(mk, __shfl(pm, t)); wi[tb] = __expf(mk - mx[tb]); }
#pragma unroll
    for (int i = 0; i < 8; ++i) { const int row = i * 8 + (lane >> 3), ch = lane & 7; *(LAS v4u*)(wl + VIMG + row * RB + ch * 16) = vreg[i]; }
    f32x16 s00 = (f32x16){}, s01 = (f32x16){}, s11 = (f32x16){};
#pragma unroll
    for (int d0 = 0; d0 < 4; ++d0) { s00 = __builtin_amdgcn_mfma_f32_32x32x16_bf16(kf[0][d0], qf[0][d0], s00, 0, 0, 0);
        s01 = __builtin_amdgcn_mfma_f32_32x32x16_bf16(kf[0][d0], qf[1][d0], s01, 0, 0, 0); s11 = __builtin_amdgcn_mfma_f32_32x32x16_bf16(kf[1][d0], qf[1][d0], s11, 0, 0, 0); }
    float dsum[2] = {0.f, 0.f};
    decay_apply(s00, 0, 0, atab, mx[0], dsum[0], r32, h); decay_apply(s01, 0, 1, atab, mx[1], dsum[1], r32, h); decay_apply(s11, 1, 1, atab, mx[1], dsum[1], r32, h);
    f32x16 nacc[2][2];
#pragma unroll
    for (int a = 0; a < 2; ++a)
#pragma unroll
        for (int c = 0; c < 2; ++c) nacc[a][c] = (f32x16){};
    const unsigned toff = (unsigned)(((lane & 15) >> 2) * RB + (16 * ((lane >> 4) & 1) + 4 * (lane & 3)) * 2);
#pragma unroll
    for (int sb = 0; sb < 2; ++sb)
#pragma unroll
        for (int st = 0; st < 2; ++st) { bf16x8 va[2];
#pragma unroll
            for (int jb = 0; jb < 2; ++jb) { const LAS unsigned char* pv = wl + VIMG + (32 * sb + 16 * st + 4 * h) * RB + toff + 64 * jb; va[jb] = cat8(trd(pv), trd(pv + 8 * RB)); }
            if (sb == 0) { const bf16x8 p0 = packstep(s00, st), p1 = packstep(s01, st);
#pragma unroll
                for (int jb = 0; jb < 2; ++jb) { nacc[jb][0] = __builtin_amdgcn_mfma_f32_32x32x16_bf16(va[jb], p0, nacc[jb][0], 0, 0, 0); nacc[jb][1] = __builtin_amdgcn_mfma_f32_32x32x16_bf16(va[jb], p1, nacc[jb][1], 0, 0, 0); }
            } else { const bf16x8 p1 = packstep(s11, st);
#pragma unroll
                for (int jb = 0; jb < 2; ++jb) nacc[jb][1] = __builtin_amdgcn_mfma_f32_32x32x16_bf16(va[jb], p1, nacc[jb][1], 0, 0, 0); } }
    const float* CT = WSP(const float, R_CST) + (size_t)bhk * 4096;
    float dint[2] = {0.f, 0.f};
#pragma unroll
    for (int st = 0; st < 4; ++st) { bf16x8 ca[2];
#pragma unroll
        for (int jb = 0; jb < 2; ++jb) { const float* cp = CT + (32 * jb + r32) * 64 + 16 * st + 8 * h; const f32x4 c0 = *(const f32x4*)cp, c1 = *(const f32x4*)(cp + 4);
            const float f[8] = {c0[0], c0[1], c0[2], c0[3], c1[0], c1[1], c1[2], c1[3]}; ca[jb] = pack8(f); }
        const f32x4 n0 = *(const LAS f32x4*)(ntab + 16 * st + 8 * h), n1 = *(const LAS f32x4*)(ntab + 16 * st + 8 * h + 4);
#pragma unroll
        for (int tb = 0; tb < 2; ++tb) { float f[8]; unpack8(__builtin_bit_cast(v4u, qf[tb][st]), f);
            dint[tb] += (f[0] * n0[0] + f[1] * n0[1]) + (f[2] * n0[2] + f[3] * n0[3]) + (f[4] * n1[0] + f[5] * n1[1]) + (f[6] * n1[2] + f[7] * n1[3]);
#pragma unroll
            for (int e = 0; e < 8; ++e) f[e] *= wi[tb];
            const bf16x8 qw = pack8(f);
#pragma unroll
            for (int jb = 0; jb < 2; ++jb) nacc[jb][tb] = __builtin_amdgcn_mfma_f32_32x32x16_bf16(ca[jb], qw, nacc[jb][tb], 0, 0, 0); } }
    const float* nw = P.in[I_MNW] + l * 256 + hd * 64; bf16* CAT = WSP(bf16, R_CAT);
#pragma unroll
    for (int tb = 0; tb < 2; ++tb) {
        const float den = swapadd(dsum[tb]) + wi[tb] * swapadd(dint[tb]);
        const float dinv = 1.f / fmaxf(fabsf(den), __expf(-(blt[tb] + mx[tb])));
        float ss = 0.f;
#pragma unroll
        for (int jb = 0; jb < 2; ++jb)
#pragma unroll
            for (int e = 0; e < 16; ++e) { const float v = nacc[jb][tb][e] * dinv; ss += v * v; }
        const float scale = dinv / sqrtf(swapadd(ss) * (1.f / 64.f) + EPS);
        const size_t row = row0 + 32 * tb + r32;
#pragma unroll
        for (int jb = 0; jb < 2; ++jb)
#pragma unroll
            for (int g = 0; g < 4; ++g) { const int j0 = 32 * jb + 8 * g + 4 * h; const f32x4 nwv = *(const f32x4*)(nw + j0);
                const unsigned long long mo = *(const GAS unsigned long long*)(T1 + row * 512 + 256 + hd * 64 + j0);
                const float m0 = __uint_as_float((unsigned)(mo << 16)), m1 = __uint_as_float((unsigned)mo & 0xffff0000u), m2 = __uint_as_float((unsigned)(mo >> 32) << 16), m3 = __uint_as_float((unsigned)(mo >> 32) & 0xffff0000u);
                const float y0 = nacc[jb][tb][4 * g] * scale * nwv[0] * __builtin_amdgcn_rcpf(1.f + __expf(-m0)), y1 = nacc[jb][tb][4 * g + 1] * scale * nwv[1] * __builtin_amdgcn_rcpf(1.f + __expf(-m1));
                const float y2 = nacc[jb][tb][4 * g + 2] * scale * nwv[2] * __builtin_amdgcn_rcpf(1.f + __expf(-m2)), y3 = nacc[jb][tb][4 * g + 3] * scale * nwv[3] * __builtin_amdgcn_rcpf(1.f + __expf(-m3));
                *(GAS unsigned long long*)(CAT + row * 1024 + hd * 64 + j0) = (unsigned long long)cvtpk(y0, y1) | ((unsigned long long)cvtpk(y2, y3) << 32); }
    }
}
template <int SEG, int STRIDE> struct SegScan {
    static constexpr int CH = 128 / SEG, EL = 64 / SEG;
    float u[CH], d[CH];
    __device__ __forceinline__ void load(const float* base, const float* dec, int lane) { const int seg = lane / EL;
#pragma unroll
        for (int i = 0; i < CH; ++i) { u[i] = base[(size_t)(seg * CH + i) * STRIDE]; d[i] = dec[seg * CH + i]; } }
    __device__ __forceinline__ void finish(float* base, int lane) { const int seg = lane / EL;
        float Pm = 1.f, Um = 0.f;
#pragma unroll
        for (int i = 0; i < CH; ++i) { Um = d[i] * Um + u[i]; Pm *= d[i]; }
        float c = 0.f;
#pragma unroll
        for (int j = 0; j < SEG - 1; ++j) { const float pj = __shfl(Pm, j * EL + (lane % EL)), uj = __shfl(Um, j * EL + (lane % EL)); if (j < seg) c = pj * c + uj; }
        float run = c;
#pragma unroll
        for (int i = 0; i < CH; ++i) { base[(size_t)(seg * CH + i) * STRIDE] = run; run = d[i] * run + u[i]; } }
};
__device__ __forceinline__ void state_scan(const Ptrs& P, int gw, int ngw, int lane) {
    static_assert(NCH == 128, "SegScan assumes 128 chunks");
    const float* DEC = WSP(const float, WS_DEC); float* CST = WSP(float, R_CST); float* NST = WSP(float, WS_NST);
    for (int w = gw; w < 8 * 256; w += ngw) {
        const int bh = w >> 8, e = (w & 255) * 16 + (lane & 15); float* cb = CST + (size_t)bh * NCH * 4096 + e;
        SegScan<4, 4096> a; a.load(cb, DEC + bh * NCH, lane);
        if (w < 64) { const int bh2 = w >> 3, e2 = (w & 7) * 8 + (lane & 7); float* nb = NST + (size_t)bh2 * NCH * 64 + e2;
            SegScan<8, 64> b; b.load(nb, DEC + bh2 * NCH, lane); a.finish(cb, lane); b.finish(nb, lane); }
        else a.finish(cb, lane);
    }
}
}

constexpr int RING_BYTES = 131072;
constexpr int MISC_OFF = RING_BYTES;
constexpr int PTR_OFF = RING_BYTES + 256;
constexpr int JOB_OFF = RING_BYTES + 512;
constexpr int LDS_BYTES = 147456;
constexpr int NWAVES = 8;

__device__ __forceinline__ float wave_sum(float v) {
#pragma unroll
    for (int o = 1; o < 64; o <<= 1) v += __shfl_xor(v, o);
    return v;
}
struct WJob { const float* W0; const float* W1; const float* rs; bf16* WT; int K, Nsrc, nblk, kind; float cs; int item0; int pad0, pad1; };
constexpr int MAX_JOBS = 32;
__device__ __forceinline__ void p0_transpose_item(const LAS WJob* jb, LAS float* scr, int item, int lane) {
    const int K = jb->K, N = jb->Nsrc, nblk = jb->nblk, kb = item / nblk, nb = item % nblk, k0 = 64 * kb;
    int which, col0; float cs; wmap(jb->kind, nb, which, col0, cs); cs *= jb->cs;
    const float* W = which ? jb->W1 : jb->W0; const float* rs = jb->rs;
    const float* src = W + (size_t)(k0 + (lane >> 5)) * N + col0 + (lane & 31);
    float v[32];
#pragma unroll
    for (int i = 0; i < 32; ++i) v[i] = __builtin_nontemporal_load(src + (size_t)(2 * i) * N);
#pragma unroll
    for (int i = 0; i < 32; ++i) scr[(2 * i + (lane >> 5)) * 33 + (lane & 31)] = v[i];
    LDS_WAIT(); asm volatile("" ::: "memory");
    const int c = lane & 7; bf16* WT = jb->WT;
    f32x4 r0 = {cs, cs, cs, cs}, r1 = r0;
    if (rs) { r0 = *(const f32x4*)(rs + k0 + 8 * c) * cs; r1 = *(const f32x4*)(rs + k0 + 8 * c + 4) * cs; }
#pragma unroll
    for (int j = 0; j < 4; ++j) { const int n = (lane >> 3) + 8 * j; const LAS float* sp = scr + (8 * c) * 33 + n;
        if (jb->pad0) {
            const float q_ = (float)jb->pad0;
            int p0 = __builtin_amdgcn_cvt_pk_fp8_f32(sp[0 * 33] * r0[0] * q_, sp[1 * 33] * r0[1] * q_, 0, false); p0 = __builtin_amdgcn_cvt_pk_fp8_f32(sp[2 * 33] * r0[2] * q_, sp[3 * 33] * r0[3] * q_, p0, true);
            int p1 = __builtin_amdgcn_cvt_pk_fp8_f32(sp[4 * 33] * r1[0] * q_, sp[5 * 33] * r1[1] * q_, 0, false); p1 = __builtin_amdgcn_cvt_pk_fp8_f32(sp[6 * 33] * r1[2] * q_, sp[7 * 33] * r1[3] * q_, p1, true);
            typedef unsigned v2u_ __attribute__((ext_vector_type(2)));
            __builtin_nontemporal_store((v2u_){(unsigned)p0, (unsigned)p1}, (GAS v2u_*)((unsigned char*)WT + (size_t)(nb * 32 + n) * K + k0 + 8 * c));
            continue; }
        v4u o; o.x = pk2(sp[0 * 33] * r0[0], sp[1 * 33] * r0[1]); o.y = pk2(sp[2 * 33] * r0[2], sp[3 * 33] * r0[3]); o.z = pk2(sp[4 * 33] * r1[0], sp[5 * 33] * r1[1]); o.w = pk2(sp[6 * 33] * r1[2], sp[7 * 33] * r1[3]);
        __builtin_nontemporal_store(o, (GAS v4u*)(WT + (size_t)(nb * 32 + n) * K + k0 + 8 * c)); }
    LDS_WAIT(); asm volatile("" ::: "memory");
}
__device__ __forceinline__ void build_gw(const Ptrs& P, long gtid, long gn) {
    for (long it = gtid; it < 3 * 32 * 64; it += gn) {
        const int t = (int)(it / 2048), ks = (int)((it / 64) % 32), ln = (int)(it % 64), c = ln & 15, quad = ln >> 4;
        float hi[8], lo[8];
#pragma unroll
        for (int j = 0; j < 8; ++j) { const int k = 32 * ks + 8 * quad + j; float w;
            if (t < 2) w = P.in[I_NMIX][t * D + k] * P.in[I_WIN][(size_t)t * D * INW + (size_t)k * INW + (c < 8 ? 1024 + c : 3072 + c)];
            else w = (c < 8) ? P.in[I_NFFN][D + k] * P.in[I_RW][(size_t)k * 8 + c] : 0.f;
            const float h = bf2f(f2bf(w)); hi[j] = h; lo[j] = w - h; }
        v4u oh, ol; oh.x = pk2(hi[0], hi[1]); oh.y = pk2(hi[2], hi[3]); oh.z = pk2(hi[4], hi[5]); oh.w = pk2(hi[6], hi[7]); ol.x = pk2(lo[0], lo[1]); ol.y = pk2(lo[2], lo[3]); ol.z = pk2(lo[4], lo[5]); ol.w = pk2(lo[6], lo[7]);
        v4u* tab = (v4u*)(P.ws + WS_GW + (size_t)t * 65536); tab[(ks * 2 + 0) * 64 + ln] = oh; tab[(ks * 2 + 1) * 64 + ln] = ol;
    }
}
template <int MODE, bool PRE>
__device__ __forceinline__ void norm16(const Ptrs& P, int l, const float* src, bf16* XN, const unsigned* rss_in, int vcu, int G, int wave, int lane, LAS float* xch) {
    typedef short bf16x8 __attribute__((ext_vector_type(8)));
    const int r = lane & 15, quad = lane >> 4, kh = wave >> 2;
    const v4u* tab = (const v4u*)(P.ws + WS_GW + (size_t)(MODE == 2 ? 2 : l) * 65536) + lane;
    if constexpr (MODE == 2) { if (wave == 0 && lane < 8) ((LAS unsigned*)(xch + 2048))[64 * 4 + lane] = 0u; }
    for (int t0 = 0; t0 < M / 16; t0 += 4 * G) {
        const int task = t0 + (wave & 3) * G + vcu; const bool live = task < M / 16; const int r0 = (live ? task : 0) * 16;
        const float* xr = src + (size_t)(r0 + r) * D + 8 * quad; bf16* xo = XN + (size_t)(r0 + r) * D + 8 * quad;
        f32x4 acc = {0.f, 0.f, 0.f, 0.f}; float ss = 0.f;
#pragma unroll
        for (int kk = 0; kk < 16; ++kk) { const int ks = 16 * kh + kk;
            if constexpr (PRE) {
                const v4u h = *(const GAS v4u*)(xo + 32 * ks);
                const bf16x8 ah = __builtin_bit_cast(bf16x8, h);
                const bf16x8 bh = __builtin_bit_cast(bf16x8, tab[(ks * 2 + 0) * 64]), bl = __builtin_bit_cast(bf16x8, tab[(ks * 2 + 1) * 64]);
                acc = __builtin_amdgcn_mfma_f32_16x16x32_bf16(ah, bh, acc, 0, 0, 0); acc = __builtin_amdgcn_mfma_f32_16x16x32_bf16(ah, bl, acc, 0, 0, 0);
            } else {
            const f32x4 a = __builtin_nontemporal_load((const GAS f32x4*)(xr + 32 * ks)), b = __builtin_nontemporal_load((const GAS f32x4*)(xr + 32 * ks + 4));
            ss += (a[0] * a[0] + a[1] * a[1]) + (a[2] * a[2] + a[3] * a[3]) + (b[0] * b[0] + b[1] * b[1]) + (b[2] * b[2] + b[3] * b[3]);
            v4u h; h.x = pk2(a[0], a[1]); h.y = pk2(a[2], a[3]); h.z = pk2(b[0], b[1]); h.w = pk2(b[2], b[3]);
            if (live) *(GAS v4u*)(xo + 32 * ks) = h;
            if constexpr (MODE != 0) {
                float hf[8]; unpack8(h, hf);
                v4u lw; lw.x = pk2(a[0] - hf[0], a[1] - hf[1]); lw.y = pk2(a[2] - hf[2], a[3] - hf[3]); lw.z = pk2(b[0] - hf[4], b[1] - hf[5]); lw.w = pk2(b[2] - hf[6], b[3] - hf[7]);
                const bf16x8 ah = __builtin_bit_cast(bf16x8, h), al = __builtin_bit_cast(bf16x8, lw);
                const bf16x8 bh = __builtin_bit_cast(bf16x8, tab[(ks * 2 + 0) * 64]), bl = __builtin_bit_cast(bf16x8, tab[(ks * 2 + 1) * 64]);
                acc = __builtin_amdgcn_mfma_f32_16x16x32_bf16(ah, bh, acc, 0, 0, 0); acc = __builtin_amdgcn_mfma_f32_16x16x32_bf16(al, bh, acc, 0, 0, 0); acc = __builtin_amdgcn_mfma_f32_16x16x32_bf16(ah, bl, acc, 0, 0, 0);
            }
            }
        }
        { LAS float* xp = xch + ((wave & 3) * 64 + lane) * 5;
          if (kh == 1) { xp[0] = acc[0]; xp[1] = acc[1]; xp[2] = acc[2]; xp[3] = acc[3]; xp[4] = ss; }
          __syncthreads();
          if (kh == 0) { acc[0] += xp[0]; acc[1] += xp[1]; acc[2] += xp[2]; acc[3] += xp[3]; ss += xp[4]; }
          __syncthreads(); }
        if constexpr (MODE != 2) { if (kh == 1 || !live) continue; }
        if (MODE != 2 || (kh == 0 && live)) {
        unsigned sq;
        if constexpr (PRE) sq = rss_in[r0 + r]; else { ss += __shfl_xor(ss, 16); ss += __shfl_xor(ss, 32); sq = (unsigned)(ss * 16.f + 0.5f); if (lane < 16) WSP(unsigned, WS_RSTD)[r0 + lane] = sq; }
        ss = (float)sq * (1.f / 16.f);
        const float rstd = 1.f / sqrtf(ss * (1.f / D) + EPS);
        if constexpr (MODE != 0) {
            float z[4];
#pragma unroll
            for (int j = 0; j < 4; ++j) z[j] = acc[j] * __shfl(rstd, 4 * quad + j);
            if constexpr (MODE == 1) {
                const int g = r; f32x4 o;
#pragma unroll
                for (int j = 0; j < 4; ++j) { if (g < 4) o[j] = z[j] + P.in[I_MBI][l * 4 + g]; else if (g < 8) o[j] = logsigmoidf_(z[j] + P.in[I_MBF][l * 4 + g - 4]); else o[j] = logsigmoidf_(z[j] + P.in[I_FBF][l * 8 + g - 8]); }
                *(f32x4*)(WSP(float, WS_GATE) + (size_t)g * M + r0 + 4 * quad) = o;
            } else {
#pragma unroll
                for (int j = 0; j < 4; ++j) { float le[8];
#pragma unroll
                    for (int e = 0; e < 8; ++e) le[e] = __shfl(z[j], (lane & 48) + e);
                    int e1 = 0; float v1 = le[0];
#pragma unroll
                    for (int e = 1; e < 8; ++e) if (le[e] > v1) { v1 = le[e]; e1 = e; }
                    int e2 = -1; float v2 = -INFINITY;
#pragma unroll
                    for (int e = 0; e < 8; ++e) if (e != e1 && le[e] > v2) { v2 = le[e]; e2 = e; }
                    if (r == j) { const float g2 = 1.f / (1.f + expf(v1 - v2)), g1 = 1.f - g2;
                        LAS unsigned* sp = (LAS unsigned*)(xch + 2048) + ((wave & 3) * 16 + 4 * quad + j) * 4;
                        sp[0] = (unsigned)e1; sp[1] = (unsigned)e2; sp[2] = __float_as_uint(g1); sp[3] = __float_as_uint(g2); }
                }
            }
        }
        }
        if constexpr (MODE == 2) {
            LAS unsigned* selb = (LAS unsigned*)(xch + 2048); LAS unsigned* hacc = selb + 64 * 4;
            if (!(kh == 0 && live) && wave < 4 && r < 4) selb[((wave & 3) * 16 + 4 * quad + r) * 4] = 255u;
            __syncthreads();
            if (wave == 0) {
                const int w = lane >> 4, e1 = (int)selb[lane * 4], e2 = (int)selb[lane * 4 + 1]; const bool valid = e1 < 8;
                const unsigned long long below = (1ull << lane) - 1ull; int rank1 = 0, rank2 = 0; unsigned mynew = 0u;
#pragma unroll
                for (int e = 0; e < 8; ++e) { const unsigned old_ = hacc[e];
                    const unsigned long long m1 = __ballot(valid && e1 == e), m2 = __ballot(valid && e2 == e); const int c1 = __popcll(m1);
                    if (e1 == e) rank1 = (int)old_ + __popcll(m1 & below);
                    if (e2 == e) rank2 = (int)old_ + c1 + __popcll(m2 & below);
                    if (lane == e) mynew = old_ + (unsigned)(c1 + __popcll(m2)); }
                if (valid) { const int row = (t0 + w * G + vcu) * 16 + (lane & 15); unsigned* tk = WSP(unsigned, WS_TOK) + (size_t)row * 8;
                    tk[0] = (unsigned)e1; tk[1] = (unsigned)rank1; tk[2] = (unsigned)e2; tk[3] = (unsigned)rank2; tk[4] = selb[lane * 4 + 2]; tk[5] = selb[lane * 4 + 3]; }
                if (lane < 8) hacc[lane] = mynew;
            }
            __syncthreads();
        }
    }
    if constexpr (MODE == 2) { if (wave == 0 && lane < 8) WSP(unsigned, WS_BH)[vcu * 8 + lane] = ((LAS unsigned*)(xch + 2048))[64 * 4 + lane]; }
}
template <int MODE>
__device__ __forceinline__ void norm_rows(const Ptrs& P, int l, const float* src, bf16* XN, int nrows, int gw, int ngw, int lane) {
    for (int row = gw; row < nrows; row += ngw) {
        const GAS f32x4* xr = (const GAS f32x4*)(src + (size_t)row * D) + lane;
        f32x4 v[4]; float s2 = 0.f;
#pragma unroll
        for (int j = 0; j < 4; ++j) { v[j] = xr[64 * j]; s2 += (v[j].x * v[j].x + v[j].y * v[j].y) + (v[j].z * v[j].z + v[j].w * v[j].w); }
        const float rstd = 1.f / sqrtf(wave_sum(s2) * (1.f / D) + EPS);
        GAS unsigned long long* o8 = (GAS unsigned long long*)(XN + (size_t)row * D) + lane;
#pragma unroll
        for (int j = 0; j < 4; ++j) o8[64 * j] = (unsigned long long)pk2(v[j].x * rstd, v[j].y * rstd) | ((unsigned long long)pk2(v[j].z * rstd, v[j].w * rstd) << 32);
    }
}

__device__ __forceinline__ float wave_incl_scan(float v, int lane) {
#pragma unroll
    for (int o = 1; o < 64; o <<= 1) { const float t = __shfl_up(v, o); if (lane >= o) v += t; }
    return v;
}
__device__ __forceinline__ float wave_max(float v) {
#pragma unroll
    for (int o = 1; o < 64; o <<= 1) v = fmaxf(v, __shfl_xor(v, o));
    return v;
}
__device__ __forceinline__ void gate_scan_task(const Ptrs& P, int task, LAS float* scr, int tid) {
    const int lane = tid & 63, wave = tid >> 6; const float* GT = WSP(const float, WS_GATE);
    if (task < 16) {
        const int b = task / FH, h = task % FH; constexpr int EPT = SEQ / 512;
        const float* src = GT + (size_t)(8 + h) * M + (size_t)b * SEQ + tid * EPT; float* dst = WSP(float, WS_CF) + (size_t)task * SEQ + tid * EPT;
        float v[EPT]; float run = 0.f;
#pragma unroll
        for (int i = 0; i < EPT; i += 4) { const f32x4 x = *(const f32x4*)(src + i); run += x[0]; v[i] = run; run += x[1]; v[i + 1] = run; run += x[2]; v[i + 2] = run; run += x[3]; v[i + 3] = run; }
        const float wincl = wave_incl_scan(run, lane);
        if (lane == 63) scr[wave] = wincl;
        __syncthreads();
        float offs = wincl - run;
#pragma unroll
        for (int w = 0; w < 8; ++w) if (w < wave) offs += scr[w];
#pragma unroll
        for (int i = 0; i < EPT; i += 4) *(f32x4*)(dst + i) = (f32x4){(offs + v[i]) * LOG2E, (offs + v[i + 1]) * LOG2E, (offs + v[i + 2]) * LOG2E, (offs + v[i + 3]) * LOG2E};
        __syncthreads();
    } else {
        const int bh = task - 16, b = bh / MH, h = bh % MH;
        const float* lfp = GT + (size_t)(4 + h) * M + (size_t)b * SEQ; const float* lip = GT + (size_t)h * M + (size_t)b * SEQ;
        float* BL = WSP(float, WS_BL) + (size_t)bh * SEQ; float* BT = WSP(float, WS_BT) + bh * NCH; float* AK = WSP(float, WS_AK) + bh * NCH; float* MS = WSP(float, WS_MS) + bh * (NCH + 1);
        constexpr int CPW = NCH / 8;
        float lfv[CPW], liv[CPW];
#pragma unroll
        for (int i = 0; i < CPW; ++i) { const int k = wave + 8 * i; lfv[i] = lfp[k * 64 + lane]; liv[i] = lip[k * 64 + lane]; }
#pragma unroll
        for (int i = 0; i < CPW; ++i) { const int k = wave + 8 * i;
            const float bl = wave_incl_scan(lfv[i], lane); BL[k * 64 + lane] = bl;
            const float btot = __shfl(bl, 63); const float a = wave_max(btot - bl + liv[i]);
            if (lane == 0) { BT[k] = btot; AK[k] = a; scr[k] = btot; scr[NCH + k] = a; } }
        __syncthreads();
        if (wave == 0) { float* DEC = WSP(float, WS_DEC) + bh * NCH; constexpr int PL = NCH / 64;
            float f[PL], av[PL]; float run = 0.f;
#pragma unroll
            for (int i = 0; i < PL; ++i) { run += scr[lane * PL + i]; f[i] = run; av[i] = scr[NCH + lane * PL + i]; }
            const float offs = wave_incl_scan(run, lane) - run;
            float pm = -INFINITY; float c[PL];
#pragma unroll
            for (int i = 0; i < PL; ++i) { f[i] += offs; pm = fmaxf(pm, av[i] - f[i]); c[i] = pm; }
            float pin = pm;
#pragma unroll
            for (int o = 1; o < 64; o <<= 1) { const float t = __shfl_up(pin, o); if (lane >= o) pin = fmaxf(pin, t); }
            float pex = __shfl_up(pin, 1); if (lane == 0) pex = -INFINITY;
            float mprev = __shfl_up(fmaxf(0.f, pin) + f[PL - 1], 1); if (lane == 0) mprev = 0.f;
            if (lane == 0) MS[0] = 0.f;
#pragma unroll
            for (int i = 0; i < PL; ++i) { const int k = lane * PL + i; const float mn = f[i] + fmaxf(0.f, fmaxf(pex, c[i]));
                MS[k + 1] = mn; DEC[k] = __expf(scr[k] + mprev - mn); mprev = mn; } }
        __syncthreads();
    }
}
__device__ __forceinline__ void mconv_glu_vec(const Ptrs& P, int l, long gtid, long gn) {
    const bf16* T0 = WSP(const bf16, R_T0); bf16* MQK = WSP(bf16, R_MQK);
    const float* cw = P.in[I_MCW] + l * 4 * 512; const float* cb = P.in[I_MCB] + l * 512;
    for (long it0 = gtid; it0 < (long)M * 64; it0 += 4 * gn) {
        v4u w[4][4]; bool ok[4][4];
#pragma unroll
        for (int r = 0; r < 4; ++r) { const long it = it0 + r * gn; const int ch = (int)(it & 63); const long row = it >> 6; const int t = (int)(row % SEQ), c0 = ch * 8;
#pragma unroll
            for (int j = 0; j < 4; ++j) { ok[r][j] = it < (long)M * 64 && t - 3 + j >= 0; w[r][j] = (v4u){0u, 0u, 0u, 0u}; if (ok[r][j]) w[r][j] = *(const GAS v4u*)(T0 + (size_t)(row - 3 + j) * 512 + c0); } }
#pragma unroll
        for (int r = 0; r < 4; ++r) { const long it = it0 + r * gn; if (it >= (long)M * 64) continue; const int ch = (int)(it & 63); const long row = it >> 6; const int c0 = ch * 8;
            float acc[8];
#pragma unroll
            for (int i = 0; i < 8; ++i) acc[i] = cb[c0 + i];
#pragma unroll
            for (int j = 0; j < 4; ++j) { if (ok[r][j]) { float x[8]; unpack8(w[r][j], x);
#pragma unroll
                    for (int i = 0; i < 8; ++i) acc[i] += cw[j * 512 + c0 + i] * x[i]; } }
            const float sc = (c0 >= 256) ? 0.125f : 1.f; float y[8];
#pragma unroll
            for (int i = 0; i < 8; ++i) y[i] = acc[i] * __builtin_amdgcn_rcpf(1.f + __expf(-acc[i])) * sc;
            v4u o; o.x = pk2(y[0], y[1]); o.y = pk2(y[2], y[3]); o.z = pk2(y[4], y[5]); o.w = pk2(y[6], y[7]);
            *(GAS v4u*)(MQK + (size_t)row * 512 + c0) = o; }
    }
    const bf16* T2 = WSP(const bf16, R_T0 + 2 * SZ_T); bf16* GL = WSP(bf16, R_GL);
    for (long it0 = gtid; it0 < (long)M * 32; it0 += 4 * gn) {
        v4u wa[4], wg[4];
#pragma unroll
        for (int r = 0; r < 4; ++r) { const long it = it0 + r * gn; wa[r] = (v4u){0u, 0u, 0u, 0u}; wg[r] = wa[r];
            if (it < (long)M * 32) { const int c0 = (int)(it & 31) * 8; const long row = it >> 5; wa[r] = *(const GAS v4u*)(T2 + (size_t)row * 512 + c0); wg[r] = *(const GAS v4u*)(T2 + (size_t)row * 512 + 256 + c0); } }
#pragma unroll
        for (int r = 0; r < 4; ++r) { const long it = it0 + r * gn; if (it >= (long)M * 32) continue; const int c0 = (int)(it & 31) * 8; const long row = it >> 5;
            float a[8], g[8]; unpack8(wa[r], a); unpack8(wg[r], g); float y[8];
#pragma unroll
            for (int i = 0; i < 8; ++i) y[i] = a[i] * __builtin_amdgcn_rcpf(1.f + __expf(-g[i]));
            v4u o; o.x = pk2(y[0], y[1]); o.y = pk2(y[2], y[3]); o.z = pk2(y[4], y[5]); o.w = pk2(y[6], y[7]);
            *(GAS v4u*)(GL + (size_t)row * 256 + c0) = o; }
    }
}
__device__ __forceinline__ void cconv_ln_rows(const Ptrs& P, int l, int gw, int ngw, int lane) {
    const bf16* GL = WSP(const bf16, R_GL); bf16* CAT = WSP(bf16, R_CAT);
    const float* cw = P.in[I_CCW] + l * CK * 256 + 4 * lane; const int c0 = 4 * lane;
    const f32x4 cb = *(const f32x4*)(P.in[I_CCB] + l * 256 + c0), lw = *(const f32x4*)(P.in[I_CLW] + l * 256 + c0), lb = *(const f32x4*)(P.in[I_CLB] + l * 256 + c0);
    f32x4 w[CK];
#pragma unroll
    for (int j = 0; j < CK; ++j) w[j] = *(const f32x4*)(cw + j * 256);
    for (int task = gw; task < M / 8; task += ngw) {
        const int r0 = task * 8, t0 = r0 % SEQ;
        unsigned long long x[CK + 7];
#pragma unroll
        for (int i = 0; i < CK + 7; ++i) x[i] = (t0 - (CK - 1) + i >= 0) ? *(const GAS unsigned long long*)(GL + (size_t)(r0 - (CK - 1) + i) * 256 + c0) : 0ull;
        f32x4 acc[8];
#pragma unroll
        for (int o = 0; o < 8; ++o) acc[o] = cb;
#pragma unroll
        for (int i = 0; i < CK + 7; ++i) { const unsigned long long q = x[i];
            const f32x4 xf = {__uint_as_float((unsigned)(q << 16)), __uint_as_float((unsigned)q & 0xffff0000u), __uint_as_float((unsigned)(q >> 32) << 16), __uint_as_float((unsigned)(q >> 32) & 0xffff0000u)};
#pragma unroll
            for (int o = 0; o < 8; ++o) if (i - o >= 0 && i - o < CK) acc[o] += w[i - o] * xf; }
#pragma unroll
        for (int o = 0; o < 8; ++o) {
            const float mean = wave_sum((acc[o][0] + acc[o][1]) + (acc[o][2] + acc[o][3])) * (1.f / 256.f);
            const f32x4 d = acc[o] - mean; const float rstd = 1.f / sqrtf(wave_sum((d[0] * d[0] + d[1] * d[1]) + (d[2] * d[2] + d[3] * d[3])) * (1.f / 256.f) + EPS);
            f32x4 y = d * rstd * lw + lb;
#pragma unroll
            for (int i = 0; i < 4; ++i) y[i] = y[i] * __builtin_amdgcn_rcpf(1.f + __expf(-y[i]));
            *(GAS unsigned long long*)(CAT + (size_t)(r0 + o) * 1024 + 256 + c0) = (unsigned long long)pk2(y[0], y[1]) | ((unsigned long long)pk2(y[2], y[3]) << 32); }
    }
}
__device__ __forceinline__ void fox_keynorms(const Ptrs& P, int gw, int ngw, int lane) {
    const bf16* K = WSP(const bf16, R_T0 + 4 * SZ_T); float* KN2 = WSP(float, WS_KN2); constexpr int NTT = SEQ / 64;
    for (int u = gw; u < BATCH * FH * NTT; u += ngw) { const int bh = u / NTT, tile = u % NTT, b = bh / FH, h = bh % FH;
        const bf16* kr = K + ((size_t)b * SEQ + tile * 64 + lane) * 512 + h * 64; float ss = 0.f;
#pragma unroll
        for (int c = 0; c < 8; ++c) { const v4u v = *(const GAS v4u*)(kr + 8 * c); float f[8]; unpack8(v, f);
#pragma unroll
            for (int e = 0; e < 8; ++e) ss += f[e] * f[e]; }
        ss = wave_max(ss); if (lane == 0) KN2[u] = ss; }
}
__device__ __forceinline__ void moe_gather(const Ptrs& P, int gw, int ngw, int lane, int wave, int vcu, int G, LAS unsigned char* lds) {
    LAS unsigned* base = (LAS unsigned*)lds; LAS unsigned* tot = base + 1024 * 8;
    { const unsigned* BH = WSP(const unsigned, WS_BH); const int per = (G + 63) / 64; unsigned run = 0u;
      for (int k = 0; k < per; ++k) { const int blk = lane * per + k; if (blk < G) run += BH[blk * 8 + wave]; }
      unsigned incl = run;
#pragma unroll
      for (int o = 1; o < 64; o <<= 1) { const unsigned t = __shfl_up(incl, o); if (lane >= o) incl += t; }
      unsigned ex = incl - run;
      for (int k = 0; k < per; ++k) { const int blk = lane * per + k; if (blk < G) { base[blk * 8 + wave] = ex; ex += BH[blk * 8 + wave]; } }
      if (lane == 63) tot[wave] = incl; }
    __syncthreads();
    unsigned* cntg = WSP(unsigned, WS_CTL) + CW_CNT;
    if (vcu == 0 && wave == 0 && lane < 8) cntg[lane] = tot[lane];
    unsigned cnt[8];
#pragma unroll
    for (int e = 0; e < 8; ++e) cnt[e] = tot[e];
    int off[9]; { int o = 0;
#pragma unroll
        for (int e = 0; e < 8; ++e) { off[e] = o; o += ((int)cnt[e] + 255) & ~255; }
        off[8] = o; }
    const bf16* XN = WSP(const bf16, R_XN); bf16* XNS = WSP(bf16, R_XNS); unsigned char* XQ = P.ws + WS_XQ;
    for (int row0 = gw; row0 < M; row0 += 4 * ngw) {
        v4u ta[4], a[4], b[4]; unsigned rv[4];
#pragma unroll
        for (int r = 0; r < 4; ++r) { const int row = row0 + r * ngw; if (row < M) { ta[r] = *(const GAS v4u*)(WSP(unsigned, WS_TOK) + (size_t)row * 8);
                const GAS v4u* srcp = (const GAS v4u*)(XN + (size_t)row * D) + lane; a[r] = __builtin_nontemporal_load(srcp); b[r] = __builtin_nontemporal_load(srcp + 64); rv[r] = WSP(const unsigned, WS_RSS)[(size_t)4 * M + row]; } }
#pragma unroll
        for (int r = 0; r < 4; ++r) { const int row = row0 + r * ngw; if (row < M) {
                unsigned* tk = WSP(unsigned, WS_TOK) + (size_t)row * 8;
                const int e1 = (int)ta[r][0], p1 = (int)ta[r][1], e2 = (int)ta[r][2], p2 = (int)ta[r][3];
                int o1 = 0, o2 = 0;
#pragma unroll
                for (int e = 0; e < 8; ++e) { if (e == e1) o1 = off[e]; if (e == e2) o2 = off[e]; }
                const int blk = (row >> 4) % G;
                const int s1 = o1 + (int)base[blk * 8 + e1] + p1, s2 = o2 + (int)base[blk * 8 + e2] + p2;
                if (lane == 0) { tk[6] = (unsigned)s1; tk[7] = (unsigned)s2; WSP(unsigned, WS_RSTDS)[s1] = rv[r]; WSP(unsigned, WS_RSTDS)[s2] = rv[r];
                    const float g1 = __uint_as_float(tk[4]), g2 = __uint_as_float(tk[5]); WSP(float, WS_SLOTG)[s1] = g1; WSP(float, WS_SLOTG)[s2] = -g2; }
                GAS v4u* d1 = (GAS v4u*)(XNS + (size_t)s1 * D) + lane; d1[0] = a[r]; d1[64] = b[r];
                const float rs_ = rsqrtf((float)rv[r] * (1.f / (16.f * 1024.f)) + 1e-6f) * F8_SA; float fa[8], fb[8]; unpack8(a[r], fa); unpack8(b[r], fb);
                typedef unsigned v2u_ __attribute__((ext_vector_type(2)));
                int qa0 = __builtin_amdgcn_cvt_pk_fp8_f32(fa[0] * rs_, fa[1] * rs_, 0, false); qa0 = __builtin_amdgcn_cvt_pk_fp8_f32(fa[2] * rs_, fa[3] * rs_, qa0, true);
                int qa1 = __builtin_amdgcn_cvt_pk_fp8_f32(fa[4] * rs_, fa[5] * rs_, 0, false); qa1 = __builtin_amdgcn_cvt_pk_fp8_f32(fa[6] * rs_, fa[7] * rs_, qa1, true);
                int qb0 = __builtin_amdgcn_cvt_pk_fp8_f32(fb[0] * rs_, fb[1] * rs_, 0, false); qb0 = __builtin_amdgcn_cvt_pk_fp8_f32(fb[2] * rs_, fb[3] * rs_, qb0, true);
                int qb1 = __builtin_amdgcn_cvt_pk_fp8_f32(fb[4] * rs_, fb[5] * rs_, 0, false); qb1 = __builtin_amdgcn_cvt_pk_fp8_f32(fb[6] * rs_, fb[7] * rs_, qb1, true);
                const v2u_ qa = {(unsigned)qa0, (unsigned)qa1}, qb = {(unsigned)qb0, (unsigned)qb1};
                GAS v2u_* x1 = (GAS v2u_*)(XQ + (size_t)s1 * D) + lane; GAS v2u_* x2 = (GAS v2u_*)(XQ + (size_t)s2 * D) + lane;
                x1[0] = qa; x1[64] = qb; x2[0] = qa; x2[64] = qb; } }
    }
    for (int w = gw; w < 8 * 256; w += ngw) {
        const int e = w >> 8, r = w & 255; int oe = 0, oe1 = 0, ce = 0;
#pragma unroll
        for (int j = 0; j < 8; ++j) if (j == e) { oe = off[j]; oe1 = off[j + 1]; ce = (int)cnt[j]; }
        const int slot = oe + ce + r;
        if (slot < oe1) { GAS v4u* dp = (GAS v4u*)(XNS + (size_t)slot * D) + lane; const v4u z = {0u, 0u, 0u, 0u}; dp[0] = z; dp[64] = z; ((GAS v4u*)(XQ + (size_t)slot * D))[lane] = z;       if (lane == 0) { unsigned zlo = 0u; asm volatile("" : "+v"(zlo)); WSP(unsigned, WS_RSTDS)[slot] = zlo; WSP(float, WS_SLOTG)[slot] = __uint_as_float(zlo); } }
    }
}
__device__ __forceinline__ void moe_combine_final(const Ptrs& P, int gw, int ngw, int lane) {
    const bf16* Y = WSP(const bf16, R_XNS); const float* nw = P.in[I_NFIN];
    for (int row0 = gw; row0 < M; row0 += 4 * ngw) {
        int s1[4], s2[4];
#pragma unroll
        for (int r = 0; r < 4; ++r) { const int row = row0 + r * ngw; const unsigned* tk = WSP(const unsigned, WS_TOK) + (size_t)(row < M ? row : 0) * 8; s1[r] = (int)tk[6]; s2[r] = (int)tk[7]; }
        unsigned long long ya[4][4], yb[4][4];
#pragma unroll
        for (int r = 0; r < 4; ++r) { const GAS unsigned long long* y1 = (const GAS unsigned long long*)(Y + (size_t)s1[r] * D) + lane; const GAS unsigned long long* y2 = (const GAS unsigned long long*)(Y + (size_t)s2[r] * D) + lane;
#pragma unroll
            for (int j = 0; j < 4; ++j) { ya[r][j] = __builtin_nontemporal_load(y1 + 64 * j); yb[r][j] = __builtin_nontemporal_load(y2 + 64 * j); } }
#pragma unroll
        for (int r = 0; r < 4; ++r) { const int row = row0 + r * ngw; if (row < M) {
            GAS f32x4* orow = (GAS f32x4*)(P.xres + (size_t)row * D) + lane;
            f32x4 v[4]; float ssq = 0.f;
#pragma unroll
            for (int j = 0; j < 4; ++j) { const unsigned long long a = ya[r][j], b = yb[r][j];
                v[j].x = bf2f((bf16)(a & 0xffff)) + bf2f((bf16)(b & 0xffff));
                v[j].y = bf2f((bf16)((a >> 16) & 0xffff)) + bf2f((bf16)((b >> 16) & 0xffff));
                v[j].z = bf2f((bf16)((a >> 32) & 0xffff)) + bf2f((bf16)((b >> 32) & 0xffff));
                v[j].w = bf2f((bf16)((a >> 48) & 0xffff)) + bf2f((bf16)((b >> 48) & 0xffff));
                ssq += (v[j].x * v[j].x + v[j].y * v[j].y) + (v[j].z * v[j].z + v[j].w * v[j].w); }
            const float rstd = 1.f / sqrtf(wave_sum(ssq) * (1.f / D) + EPS);
#pragma unroll
            for (int j = 0; j < 4; ++j) { const f32x4 w = *((const f32x4*)nw + lane + 64 * j); __builtin_nontemporal_store(v[j] * rstd * w, orow + 64 * j); } } }
    }
}

#ifndef MK_PER_PHASE
#define MK_PER_PHASE 0
#endif
constexpr int PH_PER_LAYER = 14, N_PHASES = 1 + 2 * PH_PER_LAYER + 1;
__device__ __forceinline__ Ptrs launder(const Ptrs& a) { Ptrs p = a; asm volatile("" : "+s"(p.ws), "+s"(p.xres)); return p; }
struct Args { const float* in[N_IN]; float* xres; unsigned char* ws; int ph_lo, ph_hi; };

__global__ void __launch_bounds__(NWAVES * 64, 2) trunk_fwd(Args args) {
    extern __shared__ __attribute__((aligned(16))) unsigned char lds_raw[];
    LAS unsigned char* lds = (LAS unsigned char*)lds_raw;
    Ptrs P0; P0.in = (const float* const LAS*)(lds + PTR_OFF); P0.xres = args.xres; P0.ws = args.ws;
    const int tid = threadIdx.x, wave0 = __builtin_amdgcn_readfirstlane(tid >> 6);
    const int G0 = gridDim.x; const int bx0 = blockIdx.x; const int vcu0 = (G0 % 8 == 0) ? (bx0 % 8) * (G0 / 8) + bx0 / 8 : bx0;
    volatile LAS unsigned* MISC = (volatile LAS unsigned*)(lds + MISC_OFF);
    if (tid < 64) MISC[tid] = 0u;
    if (tid < N_IN) ((const float* LAS*)(lds + PTR_OFF))[tid] = args.in[tid];
    __syncthreads();
    unsigned* ctl = (unsigned*)(P0.ws + WS_CTL);
    XcdBarrier bar; bar.bar = ctl + CW_BAR; bar.x = 0; bar.st = nullptr;
    if (!MK_PER_PHASE) bar = xcd_barrier_post(ctl + CW_BAR, MISC + 8);
    const int lo = args.ph_lo, hi = args.ph_hi; int ph = 0;
#ifndef SITEMASK
#define SITEMASK 0xffffffffull
#endif
#define SITE(k) ((SITEMASK >> (k)) & 1ull)
#define PH_ON() (ph >= lo && ph < hi)
#define PH_IF(k) if (PH_ON() && SITE(k))
#define PH_CTX() Ptrs P = launder(P0); int tidp = threadIdx.x; asm volatile("" : "+v"(tidp)); int G = G0, bx = bx0, vcu = vcu0, wave = wave0; asm volatile("" : "+s"(G), "+s"(bx), "+s"(vcu), "+s"(wave)); const int gw = vcu * NWAVES + wave, ngw = G * NWAVES; const long gn = (long)G * (NWAVES * 64); const int lane = tidp & 63; const long gtid = (long)bx * (NWAVES * 64) + tidp; (void)lane; (void)gw; (void)gtid; (void)ngw; (void)gn
#define PH_END() do { if (PH_ON() && ph + 1 < hi) { if (!MK_PER_PHASE) { XcdBarrier b2_ = bar; asm volatile("" : "+s"(b2_.bar), "+s"(b2_.x)); xcd_barrier(b2_); } } ++ph; } while (0)

    PH_IF(0) { PH_CTX();
        LAS WJob* jobs = (LAS WJob*)(lds + JOB_OFF);
        if (tid == 0) {
            int nj = 0, item = 0;
#define ADDJOB(W0_, W1_, rs_, dst_, K_, Nsrc_, Ndst_, kind_, cs_) do { LAS WJob* j_ = jobs + nj; j_->W0 = (W0_); j_->W1 = (W1_); j_->rs = (rs_); j_->WT = WSP(bf16, (dst_)); j_->K = (K_); j_->Nsrc = (Nsrc_); \
                j_->nblk = (Ndst_) / 32; j_->pad0 = 0; j_->kind = (kind_); j_->cs = (cs_); j_->item0 = item; item += ((K_) / 64) * ((Ndst_) / 32); ++nj; } while (0)
            for (int l = 0; l < 2; ++l) {
                const size_t wl = R_WL + (size_t)l * WL_SIZE;
                ADDJOB(P.in[I_WIN] + (size_t)l * D * INW, nullptr, P.in[I_NMIX] + l * D, wl + WL_IN, D, INW, NZ, 1, 1.f);
                ADDJOB(P.in[I_WOUT] + (size_t)l * D * D, nullptr, nullptr, wl + WL_OUT, D, D, D, 0, 1.f);
                ADDJOB(P.in[I_WQ] + (size_t)l * D * 512, nullptr, P.in[I_NXA] + l * D, wl + WL_Q, D, 512, 512, 0, XAT_QS);
                ADDJOB(P.in[I_WKV] + (size_t)l * D * 1024, nullptr, P.in[I_NMEM] + l * D, wl + WL_KV, D, 1024, 1024, 0, 1.f);
                ADDJOB(P.in[I_WO] + (size_t)l * 512 * D, nullptr, nullptr, wl + WL_O, 512, D, D, 0, 1.f);
            }
            ADDJOB(P.in[I_FG], P.in[I_FU], P.in[I_NFFN], R_WGU, D, DFF, 2 * DFF, 2, 1.f);
            ADDJOB(P.in[I_FD], nullptr, nullptr, R_WDN, DFF, D, D, 0, 1.f);
            for (int e = 0; e < NE; ++e) {
                ADDJOB(P.in[I_MG] + (size_t)e * D * DFF, P.in[I_MU] + (size_t)e * D * DFF, P.in[I_NFFN] + D, WS_WMGU + (size_t)e * 2 * DFF * D, D, DFF, 2 * DFF, 2, 1.f); jobs[nj - 1].pad0 = (int)F8_SWGU;
                ADDJOB(P.in[I_MD] + (size_t)e * DFF * D, nullptr, nullptr, WS_WMD + (size_t)e * D * DFF, DFF, D, D, 0, 1.f); jobs[nj - 1].pad0 = (int)F8_SWDN;
            }
#undef ADDJOB
            MISC[16] = (unsigned)nj; MISC[17] = (unsigned)item;
        }
        __syncthreads();
        const int nj = (int)MISC[16], nitems = (int)MISC[17];
        LAS float* scr = (LAS float*)(lds + wave * 16384);
        for (int it = gw; it < nitems; it += ngw) {
            int j = 0;
            for (int q = 1; q < nj; ++q) if (jobs[q].item0 <= it) j = q;
            p0_transpose_item(jobs + j, scr, it - jobs[j].item0, lane);
        }
        norm_rows<0>(P, 0, P.in[I_MEM], WSP(bf16, WS_MEMN), BATCH * NMEM, gw, ngw, lane);
        build_gw(P, gtid, gn);
    }
    PH_END();

    for (int l = 0; l < 2; ++l) {
        const size_t wl = R_WL + (size_t)l * WL_SIZE;
        PH_IF(1) { PH_CTX(); if (l == 0) norm16<1, false>(P, l, P.in[I_X], WSP(bf16, R_XN), nullptr, vcu, G, wave, lane, (LAS float*)lds);
            else norm16<1, true>(P, l, nullptr, WSP(bf16, R_XN), WSP(const unsigned, WS_RSS) + (size_t)2 * M, vcu, G, wave, lane, (LAS float*)lds); }
        PH_END();
        PH_IF(2) { PH_CTX();
            for (int task = bx; task < 24; task += G) gate_scan_task(P, task, (LAS float*)lds, tidp);
            { pg8::Gemm g{WSP(const bf16, R_XN), WSP(const bf16, wl + WL_IN), M, NZ, D}; pg8::StaticOrder S; S.init(M, NZ, G, bx);
              pg8::EpiBf16 E{WSP(bf16, R_T0), 512, 512, (size_t)M * 512, (l == 0) ? WSP(const unsigned, WS_RSTD) : WSP(const unsigned, WS_RSS) + (size_t)2 * M};
              pg8::gemm_phase<pg8::EpiBf16, pg8::StaticOrder, true, true>(lds, g, S, E); }
        }
        PH_END();
        PH_IF(3) { PH_CTX(); mconv_glu_vec(P, l, gtid, gn); fox_keynorms(P, gw, ngw, lane); }
        PH_END();
        PH_IF(4) { PH_CTX(); for (int u = wave * G + vcu; u < 8 * NCH; u += ngw) mls::u_unit(P, u, lds + wave * 16384, lane);
            for (int u = (7 - wave) * G + vcu; u < BATCH * FH * fox::NQB; u += ngw) { const int qb = fox::NQB - 1 - u / (BATCH * FH), bh = u % (BATCH * FH);
                const int j0 = fox::unit_j0_wave(bh, qb, (const fox::bf16h*)WSP(bf16, R_T0 + 3 * SZ_T), WSP(const float, WS_KN2), WSP(const float, WS_CF) + (size_t)bh * SEQ, lane); if (lane == 0) WSP(int, WS_J0)[u] = j0; }
            cconv_ln_rows(P, l, gw, ngw, lane); }
        PH_END();
        PH_IF(5) { PH_CTX(); mls::state_scan(P, gw, ngw, lane); }
        PH_END();
        PH_IF(7) { PH_CTX();
            { pg8::Gemm g{WSP(const bf16, WS_MEMN), WSP(const bf16, wl + WL_KV), BATCH * NMEM, 512, D}; pg8::StaticOrder S; S.init(BATCH * NMEM, 512, G, bx);
              pg8::EpiBf16 E{WSP(bf16, WS_KVX) + (size_t)l * 512 * 1024, 512, 0, 0, nullptr};
              pg8::gemm_phase<pg8::EpiBf16, pg8::StaticOrder, true, true>(lds, g, S, E); }
            { pg8::Gemm g{WSP(const bf16, wl + WL_KV) + (size_t)512 * 1024, WSP(const bf16, WS_MEMN), 512, BATCH * NMEM, D}; pg8::StaticOrder S; S.init(512, BATCH * NMEM, G, (bx + G - 4) % G);
              pg8::EpiBf16 E{WSP(bf16, WS_KVX) + (size_t)l * 512 * 1024 + 512 * 512, 512, 0, 0, nullptr};
              pg8::gemm_phase<pg8::EpiBf16, pg8::StaticOrder, true, true>(lds, g, S, E); }
            { static_assert(fox::LDS_BYTES <= RING_BYTES, "fox LDS");
              const fox::bf16h* Q = (const fox::bf16h*)WSP(bf16, R_T0 + 3 * SZ_T); const fox::bf16h* Kp = (const fox::bf16h*)WSP(bf16, R_T0 + 4 * SZ_T); const fox::bf16h* Vp = (const fox::bf16h*)WSP(bf16, R_T0 + 5 * SZ_T);
              fox::bf16h* O = (fox::bf16h*)(WSP(bf16, R_CAT) + 512); const float* CF = WSP(const float, WS_CF);
              for (int it = vcu; it < 8 * NCH / 8; it += G) mls::out_unit(P, l, it * 8 + wave, lds + wave * 16384, lane);
              __syncthreads();
              const int nitems = BATCH * FH * fox::NQB; unsigned* qhead = ctl + CW_FOXQ + 64 * l;
              for (;;) {
                  if (tidp == 0) MISC[24] = __hip_atomic_fetch_add(qhead, 1u, RLX_AGENT);
                  __syncthreads();
                  const int u = (int)MISC[24];
                  __syncthreads();
                  if (u >= nitems) break;
                  const int qb = fox::NQB - 1 - u / (BATCH * FH), bh = u % (BATCH * FH);
                  const int j0 = WSP(const int, WS_J0)[u];
                  fox::attn_unit<8>(bh / FH, bh % FH, qb, j0, Q, Kp, Vp, O, CF + (size_t)bh * SEQ, (char*)lds_raw); } }

 }
        PH_END();
        PH_IF(8) { PH_CTX(); pg8::Gemm g{WSP(const bf16, R_CAT), WSP(const bf16, wl + WL_OUT), M, D, D}; pg8::StaticOrder S; S.init(M, D, G, bx);
            pg8::EpiRes E{WSP(bf16, R_XN), D, WSP(unsigned, WS_RSS) + (size_t)(l ? 3 : 0) * M};
            pg8::gemm_phase<pg8::EpiRes, pg8::StaticOrder, true, true>(lds, g, S, E); }
        PH_END();
        PH_IF(10) { PH_CTX(); pg8::Gemm g{WSP(const bf16, R_XN), WSP(const bf16, wl + WL_Q), M, 512, D}; pg8::StaticOrder S; S.init(M, 512, G, bx);
            pg8::EpiBf16 E{WSP(bf16, R_QX), 512, 0, 0, WSP(const unsigned, WS_RSS) + (size_t)(l ? 3 : 0) * M};
            pg8::gemm_phase<pg8::EpiBf16, pg8::StaticOrder, true, true>(lds, g, S, E); }
        PH_END();
        PH_IF(11) { PH_CTX(); static_assert(xat::LDS_BYTES <= RING_BYTES, "xat LDS");
            const bf16* KXp = WSP(const bf16, WS_KVX) + (size_t)l * 512 * 1024;
            for (int L = vcu; L < BATCH * XH * (SEQ / 256); L += G) { const int qb = L % (SEQ / 256), bhd = L / (SEQ / 256);
                xat::unit(bhd / XH, bhd % XH, qb, WSP(const bf16, R_QX), KXp, KXp + 512 * 512, WSP(bf16, R_OX), lds); } }
        PH_END();
        PH_IF(12) { PH_CTX(); pg8::Gemm g{WSP(const bf16, R_OX), WSP(const bf16, wl + WL_O), M, D, 512}; pg8::StaticOrder S; S.init(M, D, G, bx);
            pg8::EpiRes E{WSP(bf16, R_XN), D, WSP(unsigned, WS_RSS) + (size_t)(l ? 4 : 1) * M};
            pg8::gemm_phase<pg8::EpiRes, pg8::StaticOrder, true, true>(lds, g, S, E); }
        PH_END();
        if (l == 0) {
            PH_IF(14) { PH_CTX(); pg8::Gemm g{WSP(const bf16, R_XN), WSP(const bf16, R_WGU), M, 2 * DFF, D}; pg8::StaticOrder S; S.init(M, 2 * DFF, G, bx);
                pg8::EpiSwiGLU E{WSP(bf16, R_HD), DFF, WSP(const unsigned, WS_RSS) + (size_t)1 * M};
                pg8::gemm_phase<pg8::EpiSwiGLU, pg8::StaticOrder, true, true>(lds, g, S, E); }
            PH_END();
            PH_IF(15) { PH_CTX(); pg8::Gemm g{WSP(const bf16, R_HD), WSP(const bf16, R_WDN), M, D, DFF}; pg8::StaticOrder S; S.init(M, D, G, bx);
                pg8::EpiRes E{WSP(bf16, R_XN), D, WSP(unsigned, WS_RSS) + (size_t)2 * M};
                pg8::gemm_phase<pg8::EpiRes, pg8::StaticOrder, true, true>(lds, g, S, E); }
            PH_END();
            ph += 2;
        } else {
            PH_IF(16) { PH_CTX(); norm16<2, true>(P, l, nullptr, WSP(bf16, R_XN), WSP(const unsigned, WS_RSS) + (size_t)4 * M, vcu, G, wave, lane, (LAS float*)lds); }
            PH_END();
            PH_IF(17) { PH_CTX(); moe_gather(P, gw, ngw, lane, wave, vcu, G, lds); }
            PH_END();
            PH_IF(18) { PH_CTX(); pg8::Gemm g{WSP(const bf16, WS_XQ), WSP(const bf16, WS_WMGU), 0, 2 * DFF, D / 2}; pg8::GroupedOrder S; S.init(2 * DFF, G, bx, ctl + CW_CNT, (size_t)2 * DFF * D);
                pg8::EpiSwiGLU8 E{WSP(unsigned char, R_HM), DFF, 1.f / (F8_SA * F8_SWGU)};
                pg8::gemm_phase<pg8::EpiSwiGLU8, pg8::GroupedOrder, true, true, 2>(lds, g, S, E); }
            PH_END();
            PH_IF(19) { PH_CTX(); pg8::Gemm g{WSP(const bf16, R_HM), WSP(const bf16, WS_WMD), 0, D, DFF / 2}; pg8::GroupedTailOrder S; S.init(D, G, bx, ctl + CW_CNT, (size_t)D * DFF, DFF / (2 * pg8::BK));
                pg8::EpiMoeOutT E{WSP(bf16, R_XNS), D, WSP(const float, WS_SLOTG), WSP(float, WS_WMGU)  , ctl + CW_TAIL, 1.f / (F8_SH * F8_SWDN)};
                pg8::gemm_phase<pg8::EpiMoeOutT, pg8::GroupedTailOrder, true, true, 2>(lds, g, S, E); }
            PH_END();
        }
    }
    PH_IF(20) { PH_CTX(); moe_combine_final(P, gw, ngw, lane); }
#undef PH_ON
#undef PH_END
}

extern "C" void kernel_launch(void* const* d_in, const int* in_sizes, int n_in, void* d_out, int out_size, void* d_ws, size_t ws_size, hipStream_t stream) {
    static int grid = 0;
    if (grid == 0) {
        if (n_in != N_IN || out_size != M * D || ws_size < WS_END) { fprintf(stderr, "kernel_launch: unexpected shapes (n_in %d, out %d, ws %zu < %zu); nothing launched\n", n_in, out_size, ws_size, (size_t)WS_END); grid = -1; return; }
        int dev = 0, cus = 0, per_cu = 0;
        if (hipGetDevice(&dev) != hipSuccess || hipDeviceGetAttribute(&cus, hipDeviceAttributeMultiprocessorCount, dev) != hipSuccess) { grid = -1; return; }
        if (hipFuncSetAttribute((const void*)trunk_fwd, hipFuncAttributeMaxDynamicSharedMemorySize, LDS_BYTES) != hipSuccess) { fprintf(stderr, "kernel_launch: hipFuncSetAttribute failed\n"); grid = -1; return; }
        if (hipOccupancyMaxActiveBlocksPerMultiprocessor(&per_cu, (const void*)trunk_fwd, NWAVES * 64, LDS_BYTES) != hipSuccess || per_cu < 1) { fprintf(stderr, "kernel_launch: occupancy query says %d\n", per_cu); (void)hipGetLastError(); grid = -1; return; }
        grid = cus;
    }
    if (grid < 0) return;
    (void)in_sizes;
    if (hipMemsetAsync((char*)d_ws + WS_CTL, 0, CTL_ZERO_BYTES, stream) != hipSuccess) return;
    Args a; memset(&a, 0, sizeof(a));
    for (int i = 0; i < N_IN; ++i) a.in[i] = (const float*)d_in[i];
    a.xres = (float*)d_out; a.ws = (unsigned char*)d_ws;
#if MK_PER_PHASE
    for (int p = 0; p < N_PHASES; ++p) { a.ph_lo = p; a.ph_hi = p + 1; hipLaunchKernelGGL(trunk_fwd, dim3(grid), dim3(NWAVES * 64), LDS_BYTES, stream, a); }
#else
    a.ph_lo = 0; a.ph_hi = N_PHASES;
    hipLaunchKernelGGL(trunk_fwd, dim3(grid), dim3(NWAVES * 64), LDS_BYTES, stream, a);
#endif
}
#endif
```

```cpp
#if defined(HOST_EMU)
#include <cmath>
#include <cstring>
#include <cstdint>
#include <cstddef>
#define DEVFN static inline
#define PHFN static inline
#else
#include <hip/hip_runtime.h>
#include <cstdio>
#include <cstdint>
#include <cstring>
#define DEVFN __device__ __forceinline__
#define PHFN __device__ __forceinline__
#endif

#ifndef CFG_SEQ
#define CFG_SEQ 8192
#endif
constexpr int BATCH = 2, SEQ = CFG_SEQ, D = 1024, M = BATCH * SEQ;
constexpr int MH = 4, MCH = 64, NCH = SEQ / MCH;
constexpr int CK = 31;
constexpr int FH = 8;
constexpr int XH = 4, XD = 128, NMEM = 256;
constexpr int DFF = 2816, NE = 8, INW = 3088;
constexpr int NZ = 3072;
constexpr int SLOTS_MAX = 2 * M + NE * 256;
constexpr float EPS = 1e-6f;
constexpr float LOG2E = 1.4426950408889634f;
constexpr float FOX_QS = 0.125f * LOG2E;
constexpr float XAT_QS = 0.08838834764831845f * LOG2E;

enum { I_X = 0, I_MEM, I_NMIX, I_WIN, I_MCW, I_MCB, I_MBI, I_MBF, I_MNW, I_CCW, I_CCB, I_CLW, I_CLB, I_FBF, I_WOUT, I_NXA, I_NMEM, I_WQ, I_WKV, I_WO, I_NFFN,
       I_FG, I_FU, I_FD, I_RW, I_MG, I_MU, I_MD, I_NFIN, N_IN };

typedef unsigned short bf16;
constexpr size_t al4k(size_t x) { return (x + 4095) & ~(size_t)4095; }
constexpr size_t MiB = (size_t)1 << 20;
constexpr size_t WS_CTL = 0, CTL_ZERO_BYTES = 1 * MiB;
constexpr size_t WS_GATE = 1 * MiB;
constexpr size_t WS_CF = WS_GATE + al4k((size_t)M * 16 * 4);
constexpr size_t WS_BL = WS_CF + al4k((size_t)16 * SEQ * 4);
constexpr size_t WS_BT = WS_BL + al4k((size_t)8 * SEQ * 4);
constexpr size_t WS_AK = WS_BT + al4k((size_t)8 * NCH * 4);
constexpr size_t WS_MS = WS_AK + al4k((size_t)8 * NCH * 4);
constexpr size_t WS_DEC = WS_MS + al4k((size_t)8 * (NCH + 1) * 4);
constexpr size_t WS_KN2 = WS_DEC + al4k((size_t)8 * NCH * 4);
constexpr size_t WS_J0 = WS_KN2 + al4k((size_t)16 * (SEQ / 64) * 4);
constexpr size_t WS_BH = WS_J0 + al4k((size_t)16 * (SEQ / 256) * 4);
constexpr size_t WS_NST = WS_BH + al4k((size_t)1024 * 8 * 4);
constexpr size_t WS_TOK = WS_NST + al4k((size_t)8 * NCH * 64 * 4);
constexpr size_t WS_RSTD = WS_TOK + al4k((size_t)M * 32);
constexpr size_t WS_RSTDS = WS_RSTD + al4k((size_t)M * 8);
constexpr size_t WS_SLOTG = WS_RSTDS + al4k((size_t)SLOTS_MAX * 8);
constexpr size_t WS_GW = WS_SLOTG + al4k((size_t)SLOTS_MAX * 4);
constexpr size_t WS_MEMN = WS_GW + 3 * 65536;
constexpr size_t WS_KVX = WS_MEMN + al4k((size_t)512 * 1024 * 2);
constexpr size_t WS_WMGU = WS_KVX + al4k((size_t)2 * 512 * 1024 * 2);
constexpr size_t WS_WMD = WS_WMGU + (size_t)NE * 5632 * 1024 * 2;
constexpr size_t WS_R = al4k(WS_WMD + (size_t)NE * 1024 * 2816 * 2);
constexpr size_t WL_IN = 0, WL_OUT = WL_IN + (size_t)NZ * 1024 * 2, WL_Q = WL_OUT + (size_t)1024 * 1024 * 2, WL_KV = WL_Q + (size_t)512 * 1024 * 2,
                 WL_O = WL_KV + (size_t)1024 * 1024 * 2, WL_SIZE = WL_O + (size_t)1024 * 512 * 2;
constexpr size_t R_WL = WS_R;
constexpr size_t R_WGU = R_WL + 2 * WL_SIZE;
constexpr size_t R_WDN = R_WGU + (size_t)5632 * 1024 * 2;
constexpr size_t R_XN = al4k(R_WDN + (size_t)1024 * 2816 * 2);
constexpr size_t SZ_T = (size_t)M * 512 * 2;
constexpr size_t R_T0 = R_XN + 2 * SZ_T;
constexpr size_t R_MQK = R_T0 + 6 * SZ_T;
constexpr size_t R_CAT = R_MQK + SZ_T;
constexpr size_t R_CST = R_CAT + 2 * SZ_T;
constexpr size_t R_GL = R_CST + (size_t)8 * NCH * 4096 * 4;
constexpr size_t R_HC = R_GL + (size_t)M * 256 * 2;
constexpr size_t R_END1 = R_HC + (size_t)M * 256 * 4;
constexpr size_t R_QX = R_T0, R_OX = R_T0 + SZ_T;
constexpr size_t R_HD = R_T0;
constexpr size_t R_HM = WS_R;
constexpr size_t R_XNS = R_HM + (size_t)SLOTS_MAX * 2816 * 2;
constexpr size_t R_END2 = R_XNS + (size_t)SLOTS_MAX * 1024 * 2;
constexpr size_t WS_END = R_END1 > R_END2 ? R_END1 : R_END2;
static_assert((size_t)M * 2816 * 2 <= 6 * SZ_T, "dense hidden fits T0..T5");
static_assert(R_XN + 2 * SZ_T <= R_XNS, "XN must not overlap the gathered rows");
constexpr float F8_SA = 8.f, F8_SWGU = 256.f, F8_SH = 16.f, F8_SWDN = 512.f;
constexpr size_t WS_XQ = WS_WMGU + (size_t)NE * 5632 * 1024;
constexpr int CW_TMO = 0, CW_CNT = 64  , CW_TAIL = 512  , CW_FOXQ = 128  , CW_BAR = 4096;
constexpr size_t WS_RSS = 65536;
static_assert(WS_RSS + (size_t)5 * M * 4 <= CTL_ZERO_BYTES, "RSS arrays inside the zeroed region");

#if defined(HOST_EMU)
struct Ptrs { const float* in[N_IN]; float* xres; unsigned char* ws; };
#else
struct Ptrs { const float* const __attribute__((address_space(3)))* in; float* xres; unsigned char* ws; };
#endif
#define WSP(type, off) ((type*)(P.ws + (off)))

DEVFN float bf2f(bf16 v) { unsigned u = (unsigned)v << 16; float f; memcpy(&f, &u, 4); return f; }
DEVFN bf16 f2bf(float f) { unsigned u; memcpy(&u, &f, 4); return (bf16)((u + 0x7fffu + ((u >> 16) & 1u)) >> 16); }
DEVFN float sigmoidf_(float x) { return 1.f / (1.f + expf(-x)); }
#if defined(HOST_EMU)
DEVFN float logsigmoidf_(float x) { return fminf(x, 0.f) - log1pf(expf(-fabsf(x))); }
#else
DEVFN float logsigmoidf_(float x) { return fminf(x, 0.f) - __logf(1.f + __expf(-fabsf(x))); }
#endif

DEVFN void wmap(int kind, int nb, int& which, int& col0, float& cs) {
    which = 0; cs = 1.f; const int n0 = nb * 32;
    if (kind == 0) { col0 = n0; }
    else if (kind == 1) { col0 = n0 < 1024 ? n0 : n0 + 8; if (n0 >= 1536 && n0 < 2048) cs = FOX_QS; }
    else { const int tile = nb >> 3, w = nb & 7; which = w >> 2; col0 = tile * 128 + (w & 3) * 32; }
}

#if !defined(HOST_EMU)
namespace pg8 {
#define PG8_LAS __attribute__((address_space(3)))
typedef unsigned short bf16_t;
typedef short bf16x8 __attribute__((ext_vector_type(8)));
typedef float f32x4 __attribute__((ext_vector_type(4)));
typedef unsigned u32x4 __attribute__((ext_vector_type(4)));
constexpr int BM = 256, BK = 64, HALF = 128, HTB = HALF * BK * 2, STAGE_BYTES = 8 * HTB, NXCD = 8, WGM = 4;
__host__ __device__ __forceinline__ int lds_byte(int r, int c) { const int st = (r >> 4) * 2 + (c >> 5), rr = r & 15, cc = c & 31, ob = rr * 64 + cc * 2; return st * 1024 + (ob ^ (((ob >> 9) & 1) << 5)); }
__host__ __device__ __forceinline__ void stage_rc(int b, int& R, int& C) { const int st = b / 1024, sb = b % 1024, swz = sb ^ (((sb >> 9) & 1) << 5); R = (st >> 1) * 16 + swz / 64; C = (st & 1) * 32 + (swz % 64) / 2; }
__host__ __device__ __forceinline__ int perm32(int rho) { const int n = rho >> 4, i = rho & 15; return 8 * (i >> 2) + 4 * n + (i & 3); }

struct Unit { int pm, pn; size_t bofs; int nt, ks, ti, s; size_t aofs; };
struct Gemm { const bf16_t* A; const bf16_t* Bt; int M, N, K; };

struct StaticOrder {
    static constexpr bool VAR_K = false;
    int nM, nN, nwg, G, c;
    __device__ void init(int M_, int N_, int G_, int c_) { nM = M_ / BM; nN = N_ / BM; nwg = nM * nN; G = G_; c = c_; }
    __device__ bool next(int i, Unit& u) const {
        const long L = (long)i * G + c; if (L >= nwg) return false;
        int wgid = (int)L; { const int q = nwg / NXCD, r = nwg % NXCD, xcd = wgid % NXCD, off = wgid / NXCD; wgid = (xcd < r ? xcd * (q + 1) : r * (q + 1) + (xcd - r) * q) + off; }
        const int nig = WGM * nN, gid = wgid / nig, fm = gid * WGM, gsz = (nM - fm) < WGM ? (nM - fm) : WGM;
        u.pm = fm + ((wgid % nig) % gsz); u.pn = (wgid % nig) / gsz; u.bofs = 0; return true;
    }
    __device__ __forceinline__ void a_ready(const Unit&) const {}
    __device__ __forceinline__ void done(const Unit&) const {}
};
struct GroupedOrder {
    static constexpr bool VAR_K = false;
    int nM, nN, nwg, G, c; int off[9]; size_t estride;
    __device__ void init(int N_, int G_, int c_, const unsigned* cnt, size_t estride_) {
        int o = 0;
#pragma unroll
        for (int e = 0; e < 8; ++e) { off[e] = o; o += ((int)cnt[e] + 255) & ~255; }
        off[8] = o; nM = o / BM; nN = N_ / BM; nwg = nM * nN; G = G_; c = c_; estride = estride_;
    }
    __device__ bool next(int i, Unit& u) const {
        const long L = (long)i * G + c; if (L >= nwg) return false;
        int wgid = (int)L; { const int q = nwg / NXCD, r = nwg % NXCD, xcd = wgid % NXCD, o2 = wgid / NXCD; wgid = (xcd < r ? xcd * (q + 1) : r * (q + 1) + (xcd - r) * q) + o2; }
        const int nig = WGM * nN, gid = wgid / nig, fm = gid * WGM, gsz = (nM - fm) < WGM ? (nM - fm) : WGM;
        u.pm = fm + ((wgid % nig) % gsz); u.pn = (wgid % nig) / gsz;
        int e = 0;
#pragma unroll
        for (int j = 1; j < 8; ++j) e += (off[j] <= u.pm * BM) ? 1 : 0;
        u.bofs = (size_t)e * estride; return true;
    }
    __device__ __forceinline__ void a_ready(const Unit&) const {}
    __device__ __forceinline__ void done(const Unit&) const {}
};

struct GroupedTailOrder {
    static constexpr bool VAR_K = true;
    int nM, nN, nwg, G, c, nfull, T, s, sh, ntot, NT; int off[9]; size_t estride;
    __device__ __forceinline__ void init(int N_, int G_, int c_, const unsigned* cnt, size_t estride_, int NT_) {
        int o = 0;
#pragma unroll
        for (int e = 0; e < 8; ++e) { off[e] = o; o += ((int)cnt[e] + 255) & ~255; }
        off[8] = o; nM = o / BM; nN = N_ / BM; nwg = nM * nN; G = G_; c = c_; estride = estride_; NT = NT_;
        const int rounds = nwg / G; T = nwg - rounds * G;
        s = (T == 0) ? 1 : (T * 8 <= G ? 8 : (T * 4 <= G ? 4 : (T * 2 <= G ? 2 : 1))); sh = (s == 8) ? 3 : (s >> 1);
        if (s == 1) { nfull = nwg; T = 0; } else nfull = rounds * G;
        ntot = nfull + T * s;
    }
    __device__ __forceinline__ bool next(int i, Unit& u) const {
        const long L = (long)i * G + c; if (L >= ntot) return false;
        int wgid = (int)L, ks = 0, ti = -1;
        if (wgid >= nfull) { const int mu = wgid - nfull; ti = mu >> sh; ks = mu - (ti << sh); wgid = nfull + ti; }
        { const int q = nwg / NXCD, r = nwg % NXCD, xcd = wgid % NXCD, o2 = wgid / NXCD; wgid = (xcd < r ? xcd * (q + 1) : r * (q + 1) + (xcd - r) * q) + o2; }
        const int nig = WGM * nN, gid = wgid / nig, fm = gid * WGM, gsz = (nM - fm) < WGM ? (nM - fm) : WGM;
        u.pm = fm + ((wgid % nig) % gsz); u.pn = (wgid % nig) / gsz;
        int e = 0;
#pragma unroll
        for (int j = 1; j < 8; ++j) e += (off[j] <= u.pm * BM) ? 1 : 0;
        int kt0 = 0, ntu = NT;
        if (ti >= 0) { const int base = (NT >> sh) & ~1, ex = (NT - (base << sh)) >> 1;
            ntu = base + (ks < ex ? 2 : 0); kt0 = ks * base + 2 * (ks < ex ? ks : ex); }
        u.aofs = (size_t)kt0 * BK * 2; u.bofs = (size_t)e * estride + u.aofs; u.nt = ntu; u.ks = ks; u.ti = ti; u.s = s; return true;
    }
    __device__ __forceinline__ void a_ready(const Unit&) const {}
    __device__ __forceinline__ void done(const Unit&) const {}
};

__device__ __forceinline__ unsigned cvt_pk_bf16(float lo, float hi) { unsigned r; asm volatile("v_cvt_pk_bf16_f32 %0, %1, %2" : "=v"(r) : "v"(lo), "v"(hi)); return r; }

struct EpiBf16 {
    static constexpr bool PERM = true, AFTER_DRAIN = false, HAS_PRE = true;
    __device__ __forceinline__ void preload(unsigned (&q)[8], const Unit& u, int wr, int fr) const {
        if (rs) { const __attribute__((address_space(1))) unsigned* rp = (const __attribute__((address_space(1))) unsigned*)rs + u.pm * BM + wr * 64 + fr;
#pragma unroll
            for (int i = 0; i < 8; ++i) q[i] = rp[(i >> 2) * HALF + (i & 3) * 16]; } }
    bf16_t* O; int ldc; int split_cols; size_t split_stride; const unsigned* rs;
    __device__ __forceinline__ void operator()(const f32x4 (&acc)[2][2][4][2], const Unit& u, int wr, int wc, int fr, int fq, const unsigned (&q)[8]) const {
        const int row0 = u.pm * BM + wr * 64 + fr; int colt = u.pn * BM; bf16_t* base = O;
        if (split_cols) { const int t = colt / split_cols; base += (size_t)t * split_stride; colt -= t * split_cols; }
        const int col0 = colt + wc * 32 + 8 * fq;
        float sc[2][4];
#pragma unroll
        for (int ai = 0; ai < 2; ++ai)
#pragma unroll
            for (int m = 0; m < 4; ++m) sc[ai][m] = rs ? rsqrtf((float)q[ai * 4 + m] * (1.f / (16.f * 1024.f)) + 1e-6f) : 1.f;
#pragma unroll
        for (int ai = 0; ai < 2; ++ai)
#pragma unroll
            for (int m = 0; m < 4; ++m) { bf16_t* rowp = base + (size_t)(row0 + ai * HALF + m * 16) * ldc + col0;
#pragma unroll
                for (int bj = 0; bj < 2; ++bj) { const f32x4 v0 = acc[ai][bj][m][0] * sc[ai][m], v1 = acc[ai][bj][m][1] * sc[ai][m];
                    u32x4 w; w.x = cvt_pk_bf16(v0[0], v0[1]); w.y = cvt_pk_bf16(v0[2], v0[3]); w.z = cvt_pk_bf16(v1[0], v1[1]); w.w = cvt_pk_bf16(v1[2], v1[3]);
                    *(u32x4*)(rowp + bj * HALF) = w; } }
    }
};
template <bool S8> struct EpiResT {
    static constexpr bool PERM = true, AFTER_DRAIN = false, HAS_PRE = false;
    bf16_t* X; int ldc; unsigned* rss;
    __device__ __forceinline__ void operator()(const f32x4 (&acc)[2][2][4][2], const Unit& u, int wr, int wc, int fr, int fq) const {
        const int row0 = u.pm * BM + wr * 64 + fr, col0 = u.pn * BM + wc * 32 + 8 * fq;
        typedef __attribute__((address_space(1))) u32x4 gu32x4; constexpr float c8 = S8 ? 1.f / (F8_SH * F8_SWDN) : 1.f;
        u32x4 b[2][4][2];
#pragma unroll
        for (int ai = 0; ai < 2; ++ai)
#pragma unroll
            for (int m = 0; m < 4; ++m)
#pragma unroll
                for (int bj = 0; bj < 2; ++bj) b[ai][m][bj] = *(const gu32x4*)(X + (size_t)(row0 + ai * HALF + m * 16) * ldc + col0 + bj * HALF);
#pragma unroll
        for (int ai = 0; ai < 2; ++ai)
#pragma unroll
            for (int m = 0; m < 4; ++m) { bf16_t* rowp = X + (size_t)(row0 + ai * HALF + m * 16) * ldc + col0; float ss = 0.f;
#pragma unroll
                for (int bj = 0; bj < 2; ++bj) { float v[8];
#pragma unroll
                    for (int i = 0; i < 4; ++i) { v[2 * i] = __uint_as_float(b[ai][m][bj][i] << 16) + acc[ai][bj][m][i >> 1][(2 * i) & 3] * c8; v[2 * i + 1] = __uint_as_float(b[ai][m][bj][i] & 0xffff0000u) + acc[ai][bj][m][i >> 1][(2 * i + 1) & 3] * c8; }
                    u32x4 w; w.x = cvt_pk_bf16(v[0], v[1]); w.y = cvt_pk_bf16(v[2], v[3]); w.z = cvt_pk_bf16(v[4], v[5]); w.w = cvt_pk_bf16(v[6], v[7]);
                    *(gu32x4*)(rowp + bj * HALF) = w;
#pragma unroll
                    for (int i = 0; i < 8; ++i) ss += v[i] * v[i]; }
                ss += __shfl_xor(ss, 16); ss += __shfl_xor(ss, 32);
                if (fq == 0) __hip_atomic_fetch_add(rss + row0 + ai * HALF + m * 16, (unsigned)(ss * 16.f + 0.5f), __ATOMIC_RELAXED, __HIP_MEMORY_SCOPE_AGENT); }
    }
};
typedef EpiResT<false> EpiRes;
struct EpiMoeOut {
    static constexpr bool PERM = true, AFTER_DRAIN = false, HAS_PRE = false;
    bf16_t* Y; int ldc; const float* sg;
    __device__ __forceinline__ void operator()(const f32x4 (&acc)[2][2][4][2], const Unit& u, int wr, int wc, int fr, int fq) const {
        const int row0 = u.pm * BM + wr * 64 + fr, col0 = u.pn * BM + wc * 32 + 8 * fq;
        typedef __attribute__((address_space(1))) u32x4 gu32x4;
        float g[2][4];
        { const __attribute__((address_space(1))) float* gp = (const __attribute__((address_space(1))) float*)sg + row0;
#pragma unroll
          for (int ai = 0; ai < 2; ++ai)
#pragma unroll
              for (int m = 0; m < 4; ++m) g[ai][m] = gp[ai * HALF + m * 16]; }
        u32x4 b[2][4][2];
#pragma unroll
        for (int ai = 0; ai < 2; ++ai)
#pragma unroll
            for (int m = 0; m < 4; ++m)
#pragma unroll
                for (int bj = 0; bj < 2; ++bj) { b[ai][m][bj] = (u32x4){0u, 0u, 0u, 0u}; if (g[ai][m] > 0.f) b[ai][m][bj] = *(const gu32x4*)(Y + (size_t)(row0 + ai * HALF + m * 16) * ldc + col0 + bj * HALF); }
#pragma unroll
        for (int ai = 0; ai < 2; ++ai)
#pragma unroll
            for (int m = 0; m < 4; ++m) { bf16_t* rowp = Y + (size_t)(row0 + ai * HALF + m * 16) * ldc + col0; const float ga = fabsf(g[ai][m]);
#pragma unroll
                for (int bj = 0; bj < 2; ++bj) { float v[8];
#pragma unroll
                    for (int i = 0; i < 4; ++i) { v[2 * i] = __uint_as_float(b[ai][m][bj][i] << 16) + ga * acc[ai][bj][m][i >> 1][(2 * i) & 3]; v[2 * i + 1] = __uint_as_float(b[ai][m][bj][i] & 0xffff0000u) + ga * acc[ai][bj][m][i >> 1][(2 * i + 1) & 3]; }
                    u32x4 w; w.x = cvt_pk_bf16(v[0], v[1]); w.y = cvt_pk_bf16(v[2], v[3]); w.z = cvt_pk_bf16(v[4], v[5]); w.w = cvt_pk_bf16(v[6], v[7]);
                    *(gu32x4*)(rowp + bj * HALF) = w; } }
    }
};
struct EpiMoeOutT {
    static constexpr bool PERM = true, AFTER_DRAIN = false, HAS_PRE = false;
    bf16_t* Y; int ldc; const float* sg; float* part; unsigned* cnt; float cs;
    template <int S> __device__ __forceinline__ void tail_reduce(const Unit& u, int wr, int wc, int fr, int fq, int wid, int lane) const {
        typedef __attribute__((address_space(1))) f32x4 gf32x4;
        typedef __attribute__((address_space(1))) u32x4 gu32x4;
        constexpr int CPS = 8 / S;
        const gf32x4* base = (const gf32x4*)part + ((size_t)(u.ti * S) * 8 + wid) * 2048 + lane;
        const int row0 = u.pm * BM + wr * 64 + fr, col0 = u.pn * BM + wc * 32 + 8 * fq;
#pragma unroll
        for (int cc = 0; cc < CPS; ++cc) {
            const int c8 = u.ks * CPS + cc, ai = c8 >> 2, bj = (c8 >> 1) & 1, mh = c8 & 1;
            f32x4 t[S][4];
#pragma unroll
            for (int o = 0; o < S; ++o)
#pragma unroll
                for (int jj = 0; jj < 4; ++jj) t[o][jj] = base[(size_t)o * 16384 + (c8 * 4 + jj) * 64];
            const int r0 = row0 + ai * HALF + mh * 32;
            float g[2]; u32x4 b[2];
#pragma unroll
            for (int mm = 0; mm < 2; ++mm) g[mm] = ((const __attribute__((address_space(1))) float*)sg)[r0 + mm * 16];
#pragma unroll
            for (int mm = 0; mm < 2; ++mm) { b[mm] = (u32x4){0u, 0u, 0u, 0u}; if (g[mm] > 0.f) b[mm] = *(const gu32x4*)(Y + (size_t)(r0 + mm * 16) * ldc + col0 + bj * HALF); }
#pragma unroll
            for (int jj = 0; jj < 4; ++jj)
#pragma unroll
                for (int o = 1; o < S; ++o) t[0][jj] += t[o][jj];
#pragma unroll
            for (int mm = 0; mm < 2; ++mm) { const float ga = fabsf(g[mm]) * cs; float v[8];
#pragma unroll
                for (int i = 0; i < 4; ++i) { v[2 * i] = __uint_as_float(b[mm][i] << 16) + ga * t[0][mm * 2 + (i >> 1)][(2 * i) & 3]; v[2 * i + 1] = __uint_as_float(b[mm][i] & 0xffff0000u) + ga * t[0][mm * 2 + (i >> 1)][(2 * i + 1) & 3]; }
                u32x4 w; w.x = cvt_pk_bf16(v[0], v[1]); w.y = cvt_pk_bf16(v[2], v[3]); w.z = cvt_pk_bf16(v[4], v[5]); w.w = cvt_pk_bf16(v[6], v[7]);
                *(gu32x4*)(Y + (size_t)(r0 + mm * 16) * ldc + col0 + bj * HALF) = w; }
        }
    }
    __device__ __forceinline__ void operator()(const f32x4 (&acc)[2][2][4][2], const Unit& u, int wr, int wc, int fr, int fq) const {
        typedef __attribute__((address_space(1))) f32x4 gf32x4;
        typedef __attribute__((address_space(1))) u32x4 gu32x4;
        if (u.ti >= 0) {
            const int wid = wr * 4 + wc; int lane = fq * 16 + fr; asm volatile("" : "+v"(lane));
            gf32x4* p = (gf32x4*)part + ((size_t)(u.ti * u.s + u.ks) * 8 + wid) * 2048 + lane;
#pragma unroll
            for (int j = 0; j < 32; ++j) p[j * 64] = acc[j >> 4][(j >> 3) & 1][(j >> 1) & 3][j & 1];
            asm volatile("s_waitcnt vmcnt(0)" ::: "memory"); __builtin_amdgcn_s_barrier();
            if (wid == 0) {
                __builtin_amdgcn_fence(__ATOMIC_RELEASE, "agent");
                if (lane == 0) __hip_atomic_fetch_add(cnt + u.ti, 1u, __ATOMIC_RELAXED, __HIP_MEMORY_SCOPE_AGENT);
                while (__hip_atomic_load(cnt + u.ti, __ATOMIC_RELAXED, __HIP_MEMORY_SCOPE_AGENT) < (unsigned)u.s) __builtin_amdgcn_s_sleep(2);
                __builtin_amdgcn_fence(__ATOMIC_ACQUIRE, "agent");
            }
            __builtin_amdgcn_s_barrier();
            if (u.s == 8) tail_reduce<8>(u, wr, wc, fr, fq, wid, lane); else if (u.s == 4) tail_reduce<4>(u, wr, wc, fr, fq, wid, lane); else tail_reduce<2>(u, wr, wc, fr, fq, wid, lane);
            return;
        }
        const int row0 = u.pm * BM + wr * 64 + fr, col0 = u.pn * BM + wc * 32 + 8 * fq;
        float g[2][4];
        { const __attribute__((address_space(1))) float* gp = (const __attribute__((address_space(1))) float*)sg + row0;
#pragma unroll
          for (int ai = 0; ai < 2; ++ai)
#pragma unroll
              for (int m = 0; m < 4; ++m) g[ai][m] = gp[ai * HALF + m * 16]; }
        u32x4 b[2][4][2];
#pragma unroll
        for (int ai = 0; ai < 2; ++ai)
#pragma unroll
            for (int m = 0; m < 4; ++m)
#pragma unroll
                for (int bj = 0; bj < 2; ++bj) { b[ai][m][bj] = (u32x4){0u, 0u, 0u, 0u}; if (g[ai][m] > 0.f) b[ai][m][bj] = *(const gu32x4*)(Y + (size_t)(row0 + ai * HALF + m * 16) * ldc + col0 + bj * HALF); }
#pragma unroll
        for (int ai = 0; ai < 2; ++ai)
#pragma unroll
            for (int m = 0; m < 4; ++m) { bf16_t* rowp = Y + (size_t)(row0 + ai * HALF + m * 16) * ldc + col0; const float ga = fabsf(g[ai][m]) * cs;
#pragma unroll
                for (int bj = 0; bj < 2; ++bj) { float v[8];
#pragma unroll
                    for (int i = 0; i < 4; ++i) { v[2 * i] = __uint_as_float(b[ai][m][bj][i] << 16) + ga * acc[ai][bj][m][i >> 1][(2 * i) & 3]; v[2 * i + 1] = __uint_as_float(b[ai][m][bj][i] & 0xffff0000u) + ga * acc[ai][bj][m][i >> 1][(2 * i + 1) & 3]; }
                    u32x4 w; w.x = cvt_pk_bf16(v[0], v[1]); w.y = cvt_pk_bf16(v[2], v[3]); w.z = cvt_pk_bf16(v[4], v[5]); w.w = cvt_pk_bf16(v[6], v[7]);
                    *(gu32x4*)(rowp + bj * HALF) = w; } }
    }
};
struct EpiSwiGLU8 {
    static constexpr bool PERM = true, AFTER_DRAIN = false, HAS_PRE = false;
    unsigned char* H; int ldc; float cs;
    __device__ __forceinline__ void operator()(const f32x4 (&acc)[2][2][4][2], const Unit& u, int wr, int wc, int fr, int fq) const {
        const int row0 = u.pm * BM + wr * 64 + fr, col0 = u.pn * HALF + wc * 32 + 8 * fq;
#pragma unroll
        for (int ai = 0; ai < 2; ++ai)
#pragma unroll
            for (int m = 0; m < 4; ++m) { unsigned char* rowp = H + (size_t)(row0 + ai * HALF + m * 16) * ldc + col0; float hv[8];
#pragma unroll
                for (int n = 0; n < 2; ++n)
#pragma unroll
                    for (int i = 0; i < 4; ++i) { const float g = acc[ai][0][m][n][i] * cs, up = acc[ai][1][m][n][i] * cs;
                        hv[n * 4 + i] = __builtin_amdgcn_fmed3f(g * __builtin_amdgcn_rcpf(1.f + __builtin_amdgcn_exp2f(-g * 1.4426950408889634f)) * up * F8_SH, -448.f, 448.f); }
                int p0 = __builtin_amdgcn_cvt_pk_fp8_f32(hv[0], hv[1], 0, false); p0 = __builtin_amdgcn_cvt_pk_fp8_f32(hv[2], hv[3], p0, true);
                int p1 = __builtin_amdgcn_cvt_pk_fp8_f32(hv[4], hv[5], 0, false); p1 = __builtin_amdgcn_cvt_pk_fp8_f32(hv[6], hv[7], p1, true);
                typedef unsigned u32x2_t __attribute__((ext_vector_type(2)));
                *(u32x2_t*)rowp = (u32x2_t){(unsigned)p0, (unsigned)p1}; }
    }
};
struct EpiSwiGLUo8 {
    static constexpr bool PERM = true, AFTER_DRAIN = false, HAS_PRE = true;
    __device__ __forceinline__ void preload(unsigned (&q)[8], const Unit& u, int wr, int fr) const {
        const __attribute__((address_space(1))) unsigned* rp = (const __attribute__((address_space(1))) unsigned*)rs + u.pm * BM + wr * 64 + fr;
#pragma unroll
        for (int i = 0; i < 8; ++i) q[i] = rp[(i >> 2) * HALF + (i & 3) * 16]; }
    unsigned char* H; int ldc; const unsigned* rs;
    __device__ __forceinline__ void operator()(const f32x4 (&acc)[2][2][4][2], const Unit& u, int wr, int wc, int fr, int fq, const unsigned (&q)[8]) const {
        const int row0 = u.pm * BM + wr * 64 + fr, col0 = u.pn * HALF + wc * 32 + 8 * fq;
        float sc[2][4];
#pragma unroll
        for (int ai = 0; ai < 2; ++ai)
#pragma unroll
            for (int m = 0; m < 4; ++m) sc[ai][m] = rsqrtf((float)q[ai * 4 + m] * (1.f / (16.f * 1024.f)) + 1e-6f);
#pragma unroll
        for (int ai = 0; ai < 2; ++ai)
#pragma unroll
            for (int m = 0; m < 4; ++m) { unsigned char* rowp = H + (size_t)(row0 + ai * HALF + m * 16) * ldc + col0; float hv[8];
#pragma unroll
                for (int n = 0; n < 2; ++n)
#pragma unroll
                    for (int i = 0; i < 4; ++i) { const float g = acc[ai][0][m][n][i] * sc[ai][m], up = acc[ai][1][m][n][i] * sc[ai][m];
                        hv[n * 4 + i] = __builtin_amdgcn_fmed3f(g * __builtin_amdgcn_rcpf(1.f + __builtin_amdgcn_exp2f(-g * 1.4426950408889634f)) * up * F8_SH, -448.f, 448.f); }
                int p0 = __builtin_amdgcn_cvt_pk_fp8_f32(hv[0], hv[1], 0, false); p0 = __builtin_amdgcn_cvt_pk_fp8_f32(hv[2], hv[3], p0, true);
                int p1 = __builtin_amdgcn_cvt_pk_fp8_f32(hv[4], hv[5], 0, false); p1 = __builtin_amdgcn_cvt_pk_fp8_f32(hv[6], hv[7], p1, true);
                typedef unsigned u32x2_t __attribute__((ext_vector_type(2)));
                *(u32x2_t*)rowp = (u32x2_t){(unsigned)p0, (unsigned)p1}; }
    }
};
struct EpiSwiGLU {
    static constexpr bool PERM = true, AFTER_DRAIN = false, HAS_PRE = true;
    __device__ __forceinline__ void preload(unsigned (&q)[8], const Unit& u, int wr, int fr) const {
        const __attribute__((address_space(1))) unsigned* rp = (const __attribute__((address_space(1))) unsigned*)rs + u.pm * BM + wr * 64 + fr;
#pragma unroll
        for (int i = 0; i < 8; ++i) q[i] = rp[(i >> 2) * HALF + (i & 3) * 16]; }
    bf16_t* H; int ldc; const unsigned* rs;
    __device__ __forceinline__ void operator()(const f32x4 (&acc)[2][2][4][2], const Unit& u, int wr, int wc, int fr, int fq, const unsigned (&q)[8]) const {
        const int row0 = u.pm * BM + wr * 64 + fr, col0 = u.pn * HALF + wc * 32 + 8 * fq;
        float sc[2][4];
#pragma unroll
        for (int ai = 0; ai < 2; ++ai)
#pragma unroll
            for (int m = 0; m < 4; ++m) sc[ai][m] = rsqrtf((float)q[ai * 4 + m] * (1.f / (16.f * 1024.f)) + 1e-6f);
#pragma unroll
        for (int ai = 0; ai < 2; ++ai)
#pragma unroll
            for (int m = 0; m < 4; ++m) { bf16_t* rowp = H + (size_t)(row0 + ai * HALF + m * 16) * ldc + col0; float hv[8];
#pragma unroll
                for (int n = 0; n < 2; ++n)
#pragma unroll
                    for (int i = 0; i < 4; ++i) { const float g = acc[ai][0][m][n][i] * sc[ai][m], up = acc[ai][1][m][n][i] * sc[ai][m];
                        hv[n * 4 + i] = g * __builtin_amdgcn_rcpf(1.f + __builtin_amdgcn_exp2f(-g * 1.4426950408889634f)) * up; }
                u32x4 w; w.x = cvt_pk_bf16(hv[0], hv[1]); w.y = cvt_pk_bf16(hv[2], hv[3]); w.z = cvt_pk_bf16(hv[4], hv[5]); w.w = cvt_pk_bf16(hv[6], hv[7]);
                *(u32x4*)rowp = w; }
    }
};

typedef int i32x4_t __attribute__((ext_vector_type(4)));
typedef int i32x8_t __attribute__((ext_vector_type(8)));
template <class Epi, class Sched, bool ALIGN_EPI = false, bool SP2 = false, int F8 = 0>
__device__ __forceinline__ void gemm_phase(PG8_LAS unsigned char* lds, const Gemm g, const Sched& S, const Epi& E) {
    int tid = threadIdx.x; asm volatile("" : "+v"(tid));
    const int wid = __builtin_amdgcn_readfirstlane(tid >> 6), lane = tid & 63, wr = wid >> 2, wc = wid & 3, fr = lane & 15, fq = lane >> 4;
    const int K = g.K, nt = K / BK;
    unsigned voffA[2], voffB[2];
#pragma unroll
    for (int i = 0; i < 2; ++i) { int R, C; stage_rc(tid * 16 + i * 8192, R, C); const int Rb = Epi::PERM ? ((R & ~31) + perm32(R & 31)) : R;
        voffA[i] = (unsigned)(R * K + C) * 2u; voffB[i] = (unsigned)(Rb * K + C) * 2u; }
    const size_t kstep = (size_t)(BK * 2);
    const size_t hstep = (size_t)HALF * K * 2;
    const size_t tstep = 2 * hstep;
    const unsigned ldsw = (unsigned)wid * 1024u;
    const int aoff = lds_byte(wr * 64 + fr, fq * 8), boff = lds_byte(wc * 32 + fr, fq * 8);
#define PG8_SA(b, h) (((b) * 2 + (h)) * HTB)
#define PG8_SB(b, h) ((4 + (b) * 2 + (h)) * HTB)
#define PG8_STAGE(bufoff, gbase, voff) do { _Pragma("unroll") for (int _i = 0; _i < 2; ++_i) \
        __builtin_amdgcn_global_load_lds((const unsigned*)((const char*)(gbase) + (voff)[_i]), (PG8_LAS unsigned*)(lds + (bufoff) + ldsw + _i * 8192), 16, 0, 0); } while (0)
#define PG8_LDA(dst, b, h) do { _Pragma("unroll") for (int m = 0; m < 4; ++m) _Pragma("unroll") for (int k = 0; k < 2; ++k) dst[m][k] = *(const PG8_LAS bf16x8*)(lds + PG8_SA(b, h) + aoff + m * 2048 + k * 1024); } while (0)
#define PG8_LDB(dst, b, h) do { _Pragma("unroll") for (int n = 0; n < 2; ++n) _Pragma("unroll") for (int k = 0; k < 2; ++k) dst[n][k] = *(const PG8_LAS bf16x8*)(lds + PG8_SB(b, h) + boff + n * 2048 + k * 1024); } while (0)
typedef long i64x2_t __attribute__((ext_vector_type(2)));
#define PG8_H64(x, hf) (__builtin_bit_cast(i64x2_t, x)[hf])
#define PG8_CAT8(x, y) __builtin_shufflevector(__builtin_bit_cast(i32x4_t, x), __builtin_bit_cast(i32x4_t, y), 0, 1, 2, 3, 4, 5, 6, 7)
#define PG8_MMA(ai, bj, At, Bt) do { __builtin_amdgcn_s_setprio(1); \
        if constexpr (F8 == 2) { _Pragma("unroll") for (int m = 0; m < 4; ++m) _Pragma("unroll") for (int n = 0; n < 2; ++n) \
            asm volatile("v_mfma_f32_16x16x128_f8f6f4 %0, %1, %2, %0" : "+v"(acc[ai][bj][m][n]) : "v"(PG8_CAT8(Bt[n][0], Bt[n][1])), "v"(PG8_CAT8(At[m][0], At[m][1]))); } \
        else if constexpr (F8 == 1) { _Pragma("unroll") for (int k = 0; k < 2; ++k) _Pragma("unroll") for (int hf = 0; hf < 2; ++hf) _Pragma("unroll") for (int m = 0; m < 4; ++m) _Pragma("unroll") for (int n = 0; n < 2; ++n) \
            acc[ai][bj][m][n] = __builtin_amdgcn_mfma_f32_16x16x32_fp8_fp8(PG8_H64(Bt[n][k], hf), PG8_H64(At[m][k], hf), acc[ai][bj][m][n], 0, 0, 0); } \
        else { _Pragma("unroll") for (int m = 0; m < 4; ++m) _Pragma("unroll") for (int n = 0; n < 2; ++n) _Pragma("unroll") for (int k = 0; k < 2; ++k) \
            acc[ai][bj][m][n] = __builtin_amdgcn_mfma_f32_16x16x32_bf16(Bt[n][k], At[m][k], acc[ai][bj][m][n], 0, 0, 0); } \
        __builtin_amdgcn_s_setprio(0); } while (0)
#define PG8_WAIT_V(n) asm volatile("s_waitcnt vmcnt(" #n ")" ::: "memory")
#define PG8_WAIT_L(n) asm volatile("s_waitcnt lgkmcnt(" #n ")" ::: "memory")
#define PG8_BAR __builtin_amdgcn_s_barrier()
#define PG8_SCHED __builtin_amdgcn_sched_barrier(0)
    Unit cur, nxt; int ui = 0;
    if (!S.next(0, cur)) return;
    f32x4 acc[2][2][4][2];
#pragma unroll
    for (int a = 0; a < 2; ++a)
#pragma unroll
        for (int b = 0; b < 2; ++b)
#pragma unroll
            for (int m = 0; m < 4; ++m)
#pragma unroll
                for (int n = 0; n < 2; ++n) acc[a][b][m][n] = (f32x4){0.f, 0.f, 0.f, 0.f};
    bf16x8 At[4][2], B0[2][2], B1[2][2];
    const char* cA = (const char*)g.A + (size_t)cur.pm * tstep; const char* cB = (const char*)g.Bt + cur.bofs + (size_t)cur.pn * tstep;
    if constexpr (Sched::VAR_K) cA += cur.aofs;
    S.a_ready(cur);
    if constexpr (SP2) {
        PG8_STAGE(PG8_SB(0, 0), cB, voffB); PG8_STAGE(PG8_SB(0, 1), cB + hstep, voffB); PG8_STAGE(PG8_SA(0, 0), cA, voffA); PG8_STAGE(PG8_SA(0, 1), cA + hstep, voffA);
        if (wr == 1) PG8_BAR;
        PG8_WAIT_V(2); PG8_BAR;
        PG8_STAGE(PG8_SB(1, 0), cB + kstep, voffB); PG8_STAGE(PG8_SA(1, 0), cA + kstep, voffA); PG8_STAGE(PG8_SB(1, 1), cB + hstep + kstep, voffB);
        PG8_WAIT_V(6); PG8_BAR;
    } else {
        PG8_STAGE(PG8_SB(0, 0), cB, voffB); PG8_STAGE(PG8_SA(0, 0), cA, voffA); PG8_STAGE(PG8_SB(0, 1), cB + hstep, voffB); PG8_STAGE(PG8_SA(0, 1), cA + hstep, voffA);
        if (wr == 1) PG8_BAR;
        PG8_WAIT_V(4); PG8_BAR;
        PG8_STAGE(PG8_SB(1, 0), cB + kstep, voffB); PG8_STAGE(PG8_SA(1, 0), cA + kstep, voffA); PG8_STAGE(PG8_SB(1, 1), cB + hstep + kstep, voffB);
        PG8_WAIT_V(6); PG8_BAR;
    }
    for (;;) {
        unsigned preq[8];
        if constexpr (Epi::HAS_PRE) E.preload(preq, cur, wr, fr);
        const bool has_next = S.next(ui + 1, nxt);
        const char* nA = has_next ? (const char*)g.A + (size_t)nxt.pm * tstep : cA; const char* nB = has_next ? (const char*)g.Bt + nxt.bofs + (size_t)nxt.pn * tstep : cB;
        if constexpr (Sched::VAR_K) { if (has_next) nA += nxt.aofs; }
        int ntu = nt; if constexpr (Sched::VAR_K) ntu = cur.nt;
        for (int t = 0; t < ntu; t += 2) {
            const bool last = (t == ntu - 2);
            const char* a1 = cA + (size_t)(t + 1) * kstep;
            const char* a2 = last ? nA : cA + (size_t)(t + 2) * kstep; const char* b2 = last ? nB : cB + (size_t)(t + 2) * kstep;
            const char* a3 = a2 + kstep; const char* b3 = b2 + kstep;
            if (last && has_next) S.a_ready(nxt);
            if constexpr (SP2) {
            PG8_LDB(B0, 0, 0); PG8_LDB(B1, 0, 1); PG8_SCHED; PG8_LDA(At, 0, 0); PG8_STAGE(PG8_SA(1, 1), a1 + hstep, voffA);
            PG8_WAIT_V(8); PG8_WAIT_L(0); PG8_BAR; PG8_MMA(0, 0, At, B0); PG8_MMA(0, 1, At, B1); PG8_BAR; PG8_SCHED;
            PG8_LDA(At, 0, 1); PG8_STAGE(PG8_SB(0, 0), b2, voffB); PG8_STAGE(PG8_SB(0, 1), b2 + hstep, voffB); PG8_STAGE(PG8_SA(0, 0), a2, voffA);
            PG8_WAIT_V(8); PG8_WAIT_L(0); PG8_BAR; PG8_MMA(1, 0, At, B0); PG8_MMA(1, 1, At, B1); PG8_BAR; PG8_SCHED;
            PG8_LDB(B0, 1, 0); PG8_LDB(B1, 1, 1); PG8_SCHED; PG8_LDA(At, 1, 0); PG8_STAGE(PG8_SA(0, 1), a2 + hstep, voffA);
            PG8_WAIT_V(8); PG8_WAIT_L(0); PG8_BAR; PG8_MMA(0, 0, At, B0); PG8_MMA(0, 1, At, B1); PG8_BAR; PG8_SCHED;
            PG8_LDA(At, 1, 1); PG8_STAGE(PG8_SB(1, 0), b3, voffB); PG8_STAGE(PG8_SB(1, 1), b3 + hstep, voffB); PG8_STAGE(PG8_SA(1, 0), a3, voffA);
            PG8_WAIT_V(8); PG8_WAIT_L(0); PG8_BAR; PG8_MMA(1, 0, At, B0); PG8_MMA(1, 1, At, B1); PG8_BAR; PG8_SCHED;
            } else {
            PG8_LDB(B0, 0, 0); PG8_SCHED; PG8_LDA(At, 0, 0); PG8_STAGE(PG8_SA(1, 1), a1 + hstep, voffA);
            PG8_WAIT_L(8); PG8_BAR; PG8_WAIT_L(0); PG8_MMA(0, 0, At, B0); PG8_BAR; PG8_SCHED;
            PG8_LDB(B1, 0, 1); PG8_STAGE(PG8_SB(0, 0), b2, voffB);
            PG8_BAR; PG8_WAIT_L(0); PG8_MMA(0, 1, At, B1); PG8_BAR;
            PG8_LDA(At, 0, 1); PG8_STAGE(PG8_SA(0, 0), a2, voffA);
            PG8_BAR; PG8_WAIT_L(0); PG8_MMA(1, 0, At, B0); PG8_BAR; PG8_SCHED;
            PG8_STAGE(PG8_SB(0, 1), b2 + hstep, voffB);
            PG8_WAIT_V(6); PG8_BAR; PG8_MMA(1, 1, At, B1); PG8_BAR;
            PG8_LDB(B0, 1, 0); PG8_SCHED; PG8_LDA(At, 1, 0); PG8_STAGE(PG8_SA(0, 1), a2 + hstep, voffA);
            PG8_WAIT_L(8); PG8_BAR; PG8_WAIT_L(0); PG8_MMA(0, 0, At, B0); PG8_BAR; PG8_SCHED;
            PG8_LDB(B1, 1, 1); PG8_STAGE(PG8_SB(1, 0), b3, voffB);
            PG8_BAR; PG8_WAIT_L(0); PG8_MMA(0, 1, At, B1); PG8_BAR;
            PG8_LDA(At, 1, 1); PG8_STAGE(PG8_SA(1, 0), a3, voffA);
            PG8_BAR; PG8_WAIT_L(0); PG8_MMA(1, 0, At, B0); PG8_BAR; PG8_SCHED;
            PG8_STAGE(PG8_SB(1, 1), b3 + hstep, voffB);
            PG8_WAIT_V(6); PG8_BAR; PG8_MMA(1, 1, At, B1); PG8_BAR;
            }
        }
        if constexpr (F8 == 2) asm volatile("s_nop 15\n\ts_nop 15" ::: "memory");
        if constexpr (ALIGN_EPI) { if (wr == 0) PG8_BAR; }
        if constexpr (!Epi::AFTER_DRAIN) { if constexpr (Epi::HAS_PRE) E(acc, cur, wr, wc, fr, fq, preq); else E(acc, cur, wr, wc, fr, fq); S.done(cur); }
        if (!has_next) break;
#pragma unroll
        for (int a = 0; a < 2; ++a)
#pragma unroll
            for (int b = 0; b < 2; ++b)
#pragma unroll
                for (int m = 0; m < 4; ++m)
#pragma unroll
                    for (int n = 0; n < 2; ++n) acc[a][b][m][n] = (f32x4){0.f, 0.f, 0.f, 0.f};
        cur = nxt; cA = nA; cB = nB; ++ui;
        if constexpr (ALIGN_EPI) { if (wr == 1) PG8_BAR; }
    }
    PG8_WAIT_V(0);
    if constexpr (!ALIGN_EPI) { if (wr == 0) PG8_BAR; }
    PG8_BAR;
#undef PG8_SA
#undef PG8_SB
#undef PG8_STAGE
#undef PG8_LDA
#undef PG8_LDB
#undef PG8_MMA
#undef PG8_WAIT_V
#undef PG8_WAIT_L
#undef PG8_BAR
#undef PG8_SCHED
}
}


#include <hip/hip_bf16.h>
namespace fox {
using bf16h=__hip_bfloat16;
using bf16x8=__attribute__((ext_vector_type(8)))short;
using s16x4=__attribute__((ext_vector_type(4)))short;
using f32x16=__attribute__((ext_vector_type(16)))float;
using f32x4=__attribute__((ext_vector_type(4)))float;
using u32x4=__attribute__((ext_vector_type(4)))unsigned;
constexpr int NHEAD=FH,D=64,DMI=512,DMO=1024;
constexpr int NW=8,QBLK=32,QB=QBLK*NW,KVBLK=64,NQB=SEQ/QB;
__device__ __forceinline__ int crow(int r,int hi){return (r&3)+8*(r>>2)+4*hi;}
#define SBAR() __builtin_amdgcn_sched_barrier(0)
__device__ __forceinline__ void cmask(f32x16&p0,f32x16&p1,int jb,int qrel,int hi){
  const float NEG=-INFINITY; int kb=64*jb+4*hi;
  #pragma unroll
  for(int r=0;r<16;++r){int kv=kb+(r&3)+8*(r>>2); if(kv>qrel)p0[r]=NEG; if(kv+32>qrel)p1[r]=NEG;}
}
constexpr int NSLOT=3, SLOTB=8192;
constexpr int LDS_K=0, LDS_V=NSLOT*SLOTB, LDS_WS=2*NSLOT*SLOTB, LDS_OST=LDS_WS+NW*64*4, LDS_NB=LDS_OST+NW*4096, LDS_BYTES=LDS_NB+SEQ*4;
__device__ __forceinline__ void glds16(const void*gsrc,unsigned lds_dst){unsigned keep;
  asm volatile("s_mov_b32 %0, m0\n\ts_mov_b32 m0, %2\n\ts_nop 0\n\tglobal_load_lds_dwordx4 %1, off\n\ts_mov_b32 m0, %0":"=&s"(keep):"v"(gsrc),"s"(lds_dst):"memory");}
__device__ __forceinline__ float max3f(float a,float b,float c){float r;asm("v_max3_f32 %0, %1, %2, %3":"=v"(r):"v"(a),"v"(b),"v"(c));return r;}
__device__ __forceinline__ float max2f(float a,float b){float r;asm("v_max_f32_e32 %0, %1, %2":"=v"(r):"v"(a),"v"(b));return r;}
__device__ __forceinline__ float fadd_s(float a,float b){float r;asm("v_add_f32_e32 %0, %1, %2":"=v"(r):"v"(a),"v"(b));return r;}
__device__ __forceinline__ float fsub_s(float a,float b){float r;asm("v_sub_f32_e32 %0, %1, %2":"=v"(r):"v"(a),"v"(b));return r;}
typedef float f32x2_t __attribute__((ext_vector_type(2))); typedef __bf16 bf16x2_t __attribute__((ext_vector_type(2)));
__device__ __forceinline__ unsigned cvtpk_s(float lo,float hi){f32x2_t v={lo,hi};bf16x2_t b=__builtin_convertvector(v,bf16x2_t);return __builtin_bit_cast(unsigned,b);}
#define WAIT_BAR(N) asm volatile("s_waitcnt vmcnt(" #N ") lgkmcnt(0)\n\ts_barrier":::"memory")
__device__ __forceinline__ void qkt(f32x16&p0,f32x16&p1,const char*Kslot,const bf16x8*qr,int r32,int hi){
  const char*kb=Kslot+hi*1024+r32*16;
  #pragma unroll
  for(int d0=0;d0<4;++d0){
    const bf16x8 b0=*reinterpret_cast<const bf16x8*>(kb+d0*2048);
    const bf16x8 b1=*reinterpret_cast<const bf16x8*>(kb+d0*2048+512);
    p0=__builtin_amdgcn_mfma_f32_32x32x16_bf16(b0,qr[d0],p0,0,0,0);p1=__builtin_amdgcn_mfma_f32_32x32x16_bf16(b1,qr[d0],p1,0,0,0);}
}
typedef __attribute__((address_space(3))) const char* lds_cptr;
typedef __attribute__((address_space(3))) const float* lds_fptr;
typedef short v4i16_t __attribute__((ext_vector_type(4)));
__device__ __forceinline__ void kload8(bf16x8*kf,lds_cptr kp){
  kf[0]=*(const __attribute__((address_space(3))) bf16x8*)(kp);      kf[1]=*(const __attribute__((address_space(3))) bf16x8*)(kp+512);
  kf[2]=*(const __attribute__((address_space(3))) bf16x8*)(kp+2048); kf[3]=*(const __attribute__((address_space(3))) bf16x8*)(kp+2560);
  kf[4]=*(const __attribute__((address_space(3))) bf16x8*)(kp+4096); kf[5]=*(const __attribute__((address_space(3))) bf16x8*)(kp+4608);
  kf[6]=*(const __attribute__((address_space(3))) bf16x8*)(kp+6144); kf[7]=*(const __attribute__((address_space(3))) bf16x8*)(kp+6656);
}
__device__ __forceinline__ void kload2(bf16x8*kf,lds_cptr kp,int j){ kf[2*j]=*(const __attribute__((address_space(3))) bf16x8*)(kp+j*2048); kf[2*j+1]=*(const __attribute__((address_space(3))) bf16x8*)(kp+j*2048+512); }
__device__ __forceinline__ s16x4 vtr(lds_cptr p){ return __builtin_bit_cast(s16x4,__builtin_amdgcn_ds_read_tr16_b64_v4i16((__attribute__((address_space(3))) v4i16_t*)p)); }
__device__ __forceinline__ float rowmax(const f32x16&p0,const f32x16&p1){
  float a=max3f(p0[0],p0[1],p1[0]),b=max3f(p0[2],p0[3],p1[1]);a=max3f(a,p1[2],p1[3]);
  #pragma unroll
  for(int r=4;r<16;r+=4){a=max3f(a,p0[r],p0[r+1]);b=max3f(b,p0[r+2],p0[r+3]);a=max3f(a,p1[r],p1[r+1]);b=max3f(b,p1[r+2],p1[r+3]);}
  const float m=max2f(a,b);
  auto rr=__builtin_amdgcn_permlane32_swap(__float_as_uint(m),__float_as_uint(m),false,false);
  return max2f(__uint_as_float(rr[0]),__uint_as_float(rr[1]));
}
__device__ __forceinline__ void pv(f32x16*o,int vb,bf16x8 pa0,bf16x8 pa1,bf16x8 pa2,bf16x8 pa3){
  #pragma unroll
  for(int d0=0;d0<2;++d0){s16x4 lo[4],hi[4];
    #pragma unroll
    for(int ks=0;ks<4;++ks){
      asm volatile("ds_read_b64_tr_b16 %0,%1 offset:%c2":"=&v"(lo[ks]):"v"(vb),"i"(d0*4096+ks*1024):"memory");
      asm volatile("ds_read_b64_tr_b16 %0,%1 offset:%c2":"=&v"(hi[ks]):"v"(vb),"i"(d0*4096+ks*1024+512):"memory");}
    asm volatile("s_waitcnt lgkmcnt(0)":::"memory");SBAR();
    #define PK(k) (bf16x8){lo[k][0],lo[k][1],lo[k][2],lo[k][3],hi[k][0],hi[k][1],hi[k][2],hi[k][3]}
    o[d0]=__builtin_amdgcn_mfma_f32_32x32x16_bf16(pa0,PK(0),o[d0],0,0,0);
    o[d0]=__builtin_amdgcn_mfma_f32_32x32x16_bf16(pa1,PK(1),o[d0],0,0,0);
    o[d0]=__builtin_amdgcn_mfma_f32_32x32x16_bf16(pa2,PK(2),o[d0],0,0,0);
    o[d0]=__builtin_amdgcn_mfma_f32_32x32x16_bf16(pa3,PK(3),o[d0],0,0,0);
    #undef PK
  }
}
template<int THRL> __device__ __forceinline__ void attn_unit(int b,int h,int qb,int j0,const bf16h*Q,const bf16h*__restrict__ K,const bf16h*__restrict__ V,bf16h*O,const float*CL,char*shm){
  int tid=threadIdx.x; asm volatile("":"+v"(tid));
  const int lane=tid&63,r32=lane&31,hi=lane>>5; const int wid=__builtin_amdgcn_readfirstlane(tid>>6);
  const long rowbase=(long)b*SEQ; const int q0=qb*QB; const long kvbase=rowbase+(long)j0*KVBLK;
  const bf16h*Qw=Q+(rowbase+q0+wid*QBLK)*DMI+h*D;
  const bf16h*Kh=K+kvbase*DMI+h*D,*Vh=V+kvbase*DMI+h*D;
  const unsigned lds0=(unsigned)(uintptr_t)shm;
  float*wsf=(float*)(shm+LDS_WS)+wid*64;
  const int NT=(q0+QB)/KVBLK-j0;
  { float*nbw=(float*)(shm+LDS_NB); const float*src=CL+(long)j0*KVBLK;
    for(int i=tid*4;i<NT*KVBLK;i+=512*4){ const f32x4 v=*(const f32x4*)(src+i); *(f32x4*)(nbw+i)=(f32x4){-v[0],-v[1],-v[2],-v[3]}; } }
  const bf16h*ksrc=Kh+(long)lane*DMI+wid*8;
  const bf16h*vsrc=Vh+(long)(16*(wid&3)+(lane>>2))*DMI+(wid>>2)*32+(lane&3)*8;
  const unsigned kdst=lds0+LDS_K+wid*1024, vdst=lds0+LDS_V+wid*1024;
  #define DMA_K(t,slot) glds16(ksrc+(long)(t)*KVBLK*DMI,(unsigned)__builtin_amdgcn_readfirstlane(kdst+(slot)))
  #define DMA_V(t,slot) glds16(vsrc+(long)(t)*KVBLK*DMI,(unsigned)__builtin_amdgcn_readfirstlane(vdst+(slot)))
  const int vb0=(int)(lds0+LDS_V)+((lane>>4)&1)*32+(lane&3)*8+(4*hi+((lane&15)>>2))*64;
  const char*Kbase=shm+LDS_K; bf16x8 kf[8];
  const lds_cptr shm3=(lds_cptr)shm; const lds_cptr kp0=shm3+LDS_K+hi*1024+r32*16; const lds_cptr vp0=shm3+LDS_V+((lane>>4)&1)*32+(lane&3)*8+(4*hi+((lane&15)>>2))*64;
  const lds_fptr nb0=(lds_fptr)(shm3+LDS_NB)+4*hi;
  DMA_K(0,0);DMA_V(0,0);DMA_K(1,SLOTB);
  bf16x8 qr[4];
  #pragma unroll
  for(int d0=0;d0<4;++d0)qr[d0]=*reinterpret_cast<const bf16x8*>(&Qw[(long)r32*DMI+d0*16+hi*8]);
  float mhat=0.f,l_reg=0.f;f32x16 o[2];o[0]=f32x16{};o[1]=f32x16{};
  const int qrel=wid*QBLK+r32;
  #define CMASK(P0,P1,t) do{int jb_=(t)-(NT-4); if(jb_>=0)cmask(P0,P1,jb_,qrel,hi);}while(0)
  #define PRELOAD(P0,P1,tt) do{ const lds_fptr nbp_=nb0+(tt)*KVBLK; \
    _Pragma("unroll") for(int g_=0;g_<4;++g_){ const f32x4 a_=*(const __attribute__((address_space(3))) f32x4*)(nbp_+8*g_), b_=*(const __attribute__((address_space(3))) f32x4*)(nbp_+32+8*g_); \
      P0[4*g_]=a_[0]-mhat;P0[4*g_+1]=a_[1]-mhat;P0[4*g_+2]=a_[2]-mhat;P0[4*g_+3]=a_[3]-mhat; P1[4*g_]=b_[0]-mhat;P1[4*g_+1]=b_[1]-mhat;P1[4*g_+2]=b_[2]-mhat;P1[4*g_+3]=b_[3]-mhat; } }while(0)
  bool resc=false;
  #define START(P0,P1) do{ const float rm=rowmax(P0,P1); resc=false; \
    { const float dl=rm; mhat=fadd_s(mhat,dl); \
      _Pragma("unroll") for(int r=0;r<16;++r){P0[r]=fsub_s(P0[r],dl);P1[r]=fsub_s(P1[r],dl);} } \
    _Pragma("unroll") for(int r=0;r<16;++r)P0[r]=__builtin_amdgcn_exp2f(P0[r]); }while(0)
  #define RESC() do{ if(resc){ asm volatile("s_waitcnt lgkmcnt(0)":::"memory"); \
      _Pragma("unroll") for(int d_=0;d_<2;++d_) _Pragma("unroll") for(int r=0;r<16;++r)o[d_][r]*=wsf[crow(r,hi)]; } }while(0)
  f32x16 pA0,pA1,pB0,pB1;
  int sl_prev=0,sl_cur=0,sl_next=SLOTB;
  #define ROT() do{sl_prev=sl_cur;sl_cur=sl_next;sl_next=(sl_next==(NSLOT-1)*SLOTB)?0:sl_next+SLOTB;}while(0)
  DMA_K(2,2*SLOTB);
  WAIT_BAR(3);
  PRELOAD(pA0,pA1,0);
  qkt(pA0,pA1,Kbase,qr,r32,hi);asm volatile("s_nop 15\n\ts_nop 7":"+v"(pA0),"+v"(pA1));CMASK(pA0,pA1,0);
  START(pA0,pA1);
  _Pragma("unroll") for(int r=0;r<16;++r)pA1[r]=__builtin_amdgcn_exp2f(pA1[r]);
  WAIT_BAR(0);
  DMA_K(3,0);DMA_V(1,SLOTB);
  ROT();
  kload8(kf,kp0+sl_cur);
  PRELOAD(pB0,pB1,1);
  WAIT_BAR(2);
  s16x4 vlo[8],vhi[8]; u32x4 pw0,pw1,pw2,pw3;
  #define PKW(P,B) cvtpk_s(P[B],P[B+1])
  #define PAF(k) __builtin_bit_cast(bf16x8,pw##k)
  #define VFR(i) (bf16x8){vlo[i][0],vlo[i][1],vlo[i][2],vlo[i][3],vhi[i][0],vhi[i][1],vhi[i][2],vhi[i][3]}
  #define PIN(x) asm volatile("":"+v"(x))
  #define MX3(a,b,c) __builtin_fmaxf(__builtin_fmaxf((a),(b)),(c))
  #define GAPA(MF,A0,A1,A2,A3,W0,W1,PW) do{ MF; sacc+=A0; sacc+=A1; sacc+=A2; sacc+=A3; PIN(sacc); W0; W1; PIN(PW); SBAR(); }while(0)
  #define EX(v) __builtin_amdgcn_exp2f(v)
  #define GAPB(MF,X,B) do{ MF; X[B]=EX(X[B]); X[B+1]=EX(X[B+1]); X[B+2]=EX(X[B+2]); X[B+3]=EX(X[B+3]); PIN(X); SBAR(); }while(0)
  #define VRD(i) do{ vlo[i]=vtr(vp_+(((i)>>2)*4096+((i)&3)*1024)); vhi[i]=vtr(vp_+(((i)>>2)*4096+((i)&3)*1024+512)); }while(0)
  #define KRD(G,j) do{ if(G){ kload2(kf,kp0+sl_next,j); SBAR(); } }while(0)
  #define STEP(C0,C1,P0,P1,t,GK,GV,GL) do{ SBAR(); \
    const lds_cptr vp_=vp0+sl_prev; \
    VRD(0); SBAR(); float sacc=(P0[0]+P0[1]); \
    GAPA(C0=__builtin_amdgcn_mfma_f32_32x32x16_bf16(kf[0],qr[0],C0,0,0,0), P0[2],P0[3],P0[4],P0[5],     pw0[0]=PKW(P0,0), pw0[1]=PKW(P0,2), pw0); \
    VRD(4); SBAR(); GAPA(C1=__builtin_amdgcn_mfma_f32_32x32x16_bf16(kf[1],qr[0],C1,0,0,0), P0[6],P0[7],P0[8],P0[9],     pw0[2]=PKW(P0,4), pw0[3]=PKW(P0,6), pw0); \
    VRD(1); SBAR(); GAPA(C0=__builtin_amdgcn_mfma_f32_32x32x16_bf16(kf[2],qr[1],C0,0,0,0),   P0[10],P0[11],P0[12],P0[13], pw1[0]=PKW(P0,8), pw1[1]=PKW(P0,10), pw1); \
    VRD(5); SBAR(); GAPA(C1=__builtin_amdgcn_mfma_f32_32x32x16_bf16(kf[3],qr[1],C1,0,0,0),   P0[14],P0[15],P1[0],P1[1],   pw1[2]=PKW(P0,12),pw1[3]=PKW(P0,14), pw1); \
    VRD(2); SBAR(); GAPA(C0=__builtin_amdgcn_mfma_f32_32x32x16_bf16(kf[4],qr[2],C0,0,0,0),   P1[2],P1[3],P1[4],P1[5],     pw2[0]=PKW(P1,0), pw2[1]=PKW(P1,2), pw2); \
    VRD(6); SBAR(); GAPA(C1=__builtin_amdgcn_mfma_f32_32x32x16_bf16(kf[5],qr[2],C1,0,0,0),   P1[6],P1[7],P1[8],P1[9],     pw2[2]=PKW(P1,4), pw2[3]=PKW(P1,6), pw2); \
    VRD(3); SBAR(); GAPA(C0=__builtin_amdgcn_mfma_f32_32x32x16_bf16(kf[6],qr[3],C0,0,0,0),   P1[10],P1[11],P1[12],P1[13], pw3[0]=PKW(P1,8), pw3[1]=PKW(P1,10), pw3); \
    VRD(7); SBAR(); GAPA(C1=__builtin_amdgcn_mfma_f32_32x32x16_bf16(kf[7],qr[3],C1,0,0,0),   P1[14],P1[15],0.f,0.f,       pw3[2]=PKW(P1,12),pw3[3]=PKW(P1,14), pw3); \
    l_reg+=sacc; \
    if(GK){DMA_K((t)+3,sl_cur);} if(GV){DMA_V((t)+1,sl_next);} \
    CMASK(C0,C1,t); \
    { float a=MX3(C0[0],C0[1],C1[0]),b=MX3(C0[2],C0[3],C1[1]); a=MX3(a,C1[2],C1[3]); \
      _Pragma("unroll") for(int r=4;r<16;r+=4){a=MX3(a,C0[r],C0[r+1]);b=MX3(b,C0[r+2],C0[r+3]);a=MX3(a,C1[r],C1[r+1]);b=MX3(b,C1[r+2],C1[r+3]);} \
      float rm=__builtin_fmaxf(a,b); { auto rr=__builtin_amdgcn_permlane32_swap(__float_as_uint(rm),__float_as_uint(rm),false,false); rm=__builtin_fmaxf(__uint_as_float(rr[0]),__uint_as_float(rr[1])); } \
      resc=false; \
      if(__builtin_expect(__any(rm>(float)THRL),0)){ const float dl=__builtin_fmaxf(rm,0.f); mhat+=dl; \
        _Pragma("unroll") for(int r=0;r<16;++r){C0[r]-=dl;C1[r]-=dl;} \
        const float f=__builtin_amdgcn_exp2f(-dl); l_reg*=f; if(hi==0)wsf[r32]=f; resc=true; } } \
    SBAR(); \
    GAPB(o[0]=__builtin_amdgcn_mfma_f32_32x32x16_bf16(PAF(0),VFR(0),o[0],0,0,0), C0,0); \
    GAPB(o[1]=__builtin_amdgcn_mfma_f32_32x32x16_bf16(PAF(0),VFR(4),o[1],0,0,0), C0,4); \
    KRD(GL,0); GAPB(o[0]=__builtin_amdgcn_mfma_f32_32x32x16_bf16(PAF(1),VFR(1),o[0],0,0,0), C0,8); \
    KRD(GL,1); GAPB(o[1]=__builtin_amdgcn_mfma_f32_32x32x16_bf16(PAF(1),VFR(5),o[1],0,0,0), C0,12); \
    KRD(GL,2); GAPB(o[0]=__builtin_amdgcn_mfma_f32_32x32x16_bf16(PAF(2),VFR(2),o[0],0,0,0), C1,0); \
    KRD(GL,3); GAPB(o[1]=__builtin_amdgcn_mfma_f32_32x32x16_bf16(PAF(2),VFR(6),o[1],0,0,0), C1,4); \
    GAPB(o[0]=__builtin_amdgcn_mfma_f32_32x32x16_bf16(PAF(3),VFR(3),o[0],0,0,0), C1,8); \
    GAPB(o[1]=__builtin_amdgcn_mfma_f32_32x32x16_bf16(PAF(3),VFR(7),o[1],0,0,0), C1,12); \
    if(GL){ PRELOAD(P0,P1,(t)+1); } \
    }while(0)
  int t=1;
  #undef CMASK
  #define CMASK(P0,P1,t) do{}while(0)
  for(;t+5<NT;t+=2){
    STEP(pB0,pB1,pA0,pA1,t,true,true,true);     WAIT_BAR(2); RESC(); ROT();
    STEP(pA0,pA1,pB0,pB1,t+1,true,true,true);   WAIT_BAR(2); RESC(); ROT();
  }
  #undef CMASK
  #define CMASK(P0,P1,t) do{int jb_=(t)-(NT-4); if(jb_>=0)cmask(P0,P1,jb_,qrel,hi);}while(0)
  #define ENDW(tt) do{ if((tt)+3<NT){WAIT_BAR(2);} else if((tt)+2<NT){WAIT_BAR(1);} else {WAIT_BAR(0);} }while(0)
  for(;t+1<NT;t+=2){
    STEP(pB0,pB1,pA0,pA1,t,(t+3<NT),(t+1<NT),(t+1<NT));       ENDW(t);   RESC(); ROT();
    STEP(pA0,pA1,pB0,pB1,t+1,(t+4<NT),(t+2<NT),(t+2<NT));     ENDW(t+1); RESC(); ROT();
  }
  STEP(pB0,pB1,pA0,pA1,NT-1,false,false,false); RESC();
  { float sacc=pB0[0]+pB0[1]; _Pragma("unroll") for(int r=2;r<16;++r)sacc+=pB0[r]; _Pragma("unroll") for(int r=0;r<16;++r)sacc+=pB1[r]; l_reg+=sacc;
    pw0=(u32x4){PKW(pB0,0),PKW(pB0,2),PKW(pB0,4),PKW(pB0,6)};pw1=(u32x4){PKW(pB0,8),PKW(pB0,10),PKW(pB0,12),PKW(pB0,14)};pw2=(u32x4){PKW(pB1,0),PKW(pB1,2),PKW(pB1,4),PKW(pB1,6)};pw3=(u32x4){PKW(pB1,8),PKW(pB1,10),PKW(pB1,12),PKW(pB1,14)};
    SBAR(); pv(o,vb0+sl_cur,PAF(0),PAF(1),PAF(2),PAF(3)); }
  #undef PKW
  #undef PAF
  #undef VFR
  #undef PIN
  #undef MX3
  #undef GAPA
  #undef GAPB
  #undef EX
  #undef VRD
  #undef KRD
  #undef STEP
  #undef ENDW
  {auto rr=__builtin_amdgcn_permlane32_swap(__float_as_uint(l_reg),__float_as_uint(l_reg),false,false);l_reg=__uint_as_float(rr[0])+__uint_as_float(rr[1]);}
  if(hi==0)wsf[32+r32]=l_reg;asm volatile("s_waitcnt lgkmcnt(0)":::"memory");
  float rli[16];
  #pragma unroll
  for(int r=0;r<16;++r)rli[r]=__builtin_amdgcn_rcpf(wsf[32+crow(r,hi)]);
  bf16h*Ow=O+(rowbase+q0+wid*QBLK)*DMO+h*D;
  { bf16h*stg=(bf16h*)(shm+LDS_OST)+wid*2048;
    #pragma unroll
    for(int r=0;r<16;++r){const int orow=crow(r,hi);
      #pragma unroll
      for(int d0=0;d0<2;++d0)stg[orow*64+d0*32+r32]=__float2bfloat16(o[d0][r]*rli[r]);}
    asm volatile("s_waitcnt lgkmcnt(0)":::"memory");
    #pragma unroll
    for(int i=0;i<4;++i){const int row=i*8+(lane>>3),ch=lane&7; const u32x4 v=*(const u32x4*)(stg+row*64+ch*8); *(u32x4*)(Ow+(long)row*DMO+ch*8)=v;} }
  asm volatile("s_waitcnt lgkmcnt(0)\n\ts_barrier":::"memory");
  #undef DMA_K
  #undef DMA_V
  #undef CMASK
  #undef PRELOAD
  #undef START
  #undef RESC
  #undef ROT
}

__device__ __forceinline__ int unit_j0_wave(int bh,int qb,const bf16h*Q,const float*KN2,const float*CL,int lane){
  const int b=bh/NHEAD,h=bh%NHEAD; constexpr int NTT=SEQ/KVBLK;
  float mx=0.f;
  #pragma unroll
  for(int rr=0;rr<QB/64;++rr){ const bf16h*Qw=Q+((long)b*SEQ+qb*QB+rr*64+lane)*DMI+h*D; float ss=0.f;
    #pragma unroll
    for(int c=0;c<8;++c){ const u32x4 v=*reinterpret_cast<const u32x4*>(&Qw[c*8]);
      #pragma unroll
      for(int e=0;e<4;++e){ const float f0=__uint_as_float(v[e]<<16),f1=__uint_as_float(v[e]&0xffff0000u); ss+=f0*f0+f1*f1; } }
    mx=fmaxf(mx,ss); }
  #pragma unroll
  for(int o=1;o<64;o<<=1) mx=fmaxf(mx,__shfl_xor(mx,o));
  const int nt=4*qb; const float*kn=KN2+bh*NTT;
  const float Qn=sqrtf(mx),KNd=sqrtf(fmaxf(fmaxf(kn[nt],kn[nt+1]),fmaxf(kn[nt+2],kn[nt+3])));
  const float clt0=CL[qb*QB];
  int first=nt;
  #pragma unroll
  for(int part=1;part>=0;--part){ const int i=lane+64*part; bool need=false;
    if(i<nt){ const float bound=Qn*(sqrtf(kn[i])+KNd)+clt0-CL[KVBLK*i+KVBLK-1]; need=!(bound<-40.f); }
    const unsigned long long bal=__ballot(need); if(bal) first=__ffsll((long long)bal)-1+64*part; }
  return (first<nt?first:nt)&~1;
}
#undef SBAR
#undef WAIT_BAR
}

#define GAS __attribute__((address_space(1)))
#define LAS __attribute__((address_space(3)))
typedef unsigned v4u __attribute__((ext_vector_type(4)));
typedef float f32x4 __attribute__((ext_vector_type(4)));
typedef GAS unsigned gu32;
#define RLX_AGENT __ATOMIC_RELAXED, __HIP_MEMORY_SCOPE_AGENT
#define LDS_WAIT() asm volatile("s_waitcnt lgkmcnt(0)" ::: "memory")
#define VM_WAIT() asm volatile("s_waitcnt vmcnt(0)" ::: "memory")
__device__ __forceinline__ unsigned pk2(float lo, float hi) { return (unsigned)f2bf(lo) | ((unsigned)f2bf(hi) << 16); }
__device__ __forceinline__ void unpack8(const v4u w, float* f) {
#pragma unroll
    for (int i = 0; i < 4; ++i) { f[2 * i] = __uint_as_float(w[i] << 16); f[2 * i + 1] = __uint_as_float(w[i] & 0xffff0000u); }
}

#define XB_TMO      128
#define XB_XCNT(j)  (256  + 64 * (j))
#define XB_XSUB(j)  (1280 + 64 * (j))
#define XB_XGEN(j)  (2304 + 64 * (j))
#define XB_TOP      3328
#define XB_TOPGEN   3392
#define XCD_BAR_WORDS 3456
#define XB_SPIN_CAP (1u << 18)
__device__ __forceinline__ unsigned xb_ld(unsigned* p)              { return __hip_atomic_load(p, __ATOMIC_RELAXED, __HIP_MEMORY_SCOPE_AGENT); }
__device__ __forceinline__ unsigned xb_add(unsigned* p, unsigned v) { return __hip_atomic_fetch_add(p, v, __ATOMIC_RELAXED, __HIP_MEMORY_SCOPE_AGENT); }
__device__ __forceinline__ unsigned xb_xcc_id() { return (unsigned)__builtin_amdgcn_s_getreg((3 << 11) | 20) & 0xFu; }
#define XB_SPIN(cond, bar) do { unsigned _sp = 0; while (cond) { __builtin_amdgcn_s_sleep(1); \
    if ((++_sp & 255u) == 0u) { if (xb_ld(&(bar)[XB_TMO])) break; if (_sp > XB_SPIN_CAP) { atomicAdd(&(bar)[XB_TMO], 1u); break; } } } } while (0)
struct XcdBarrier { unsigned* bar; unsigned x; volatile LAS unsigned* st; };
__device__ __forceinline__ XcdBarrier xcd_barrier_post(unsigned* bar, volatile LAS unsigned* st) {
    XcdBarrier b; b.bar = bar; b.x = xb_xcc_id(); b.st = st;
    if (threadIdx.x == 0) (void)xb_add(&bar[XB_XCNT(b.x)], 1u);
    return b;
}
__device__ __forceinline__ void xcd_barrier_complete(unsigned* bar, unsigned x, unsigned& nloc, unsigned& nx) {
    const unsigned G = gridDim.x * gridDim.y * gridDim.z;
    unsigned sum, cnt, mine, sp = 0u;
    for (;;) {
        sum = 0u; cnt = 0u; mine = 0u;
#pragma unroll
        for (unsigned j = 0; j < 16; ++j) { const unsigned c = xb_ld(&bar[XB_XCNT(j)]); sum += c; cnt += (c > 0u) ? 1u : 0u; mine = (j == x) ? c : mine; }
        if (sum == G) break;
        __builtin_amdgcn_s_sleep(1);
        if ((++sp & 255u) == 0u) { if (xb_ld(&bar[XB_TMO])) break; if (sp > XB_SPIN_CAP) { atomicAdd(&bar[XB_TMO], 1u); break; } }
    }
    nloc = mine > 0u ? mine : 1u; nx = cnt > 0u ? cnt : 1u;
}
__device__ __forceinline__ void xcd_barrier(const XcdBarrier& b) {
    asm volatile("s_waitcnt vmcnt(0)" ::: "memory");
    __syncthreads();
    if (threadIdx.x == 0) {
        unsigned* bar = b.bar;
        __builtin_amdgcn_s_waitcnt(0);
        unsigned nloc = b.st[0], nx = b.st[1];
        if (nloc == 0u) { xcd_barrier_complete(bar, b.x, nloc, nx); b.st[0] = nloc; b.st[1] = nx; }
        const unsigned old = xb_add(&bar[XB_XSUB(b.x)], 1u);
        const unsigned gen = old / nloc;
        if (old + 1u == (gen + 1u) * nloc) {
            __builtin_amdgcn_fence(__ATOMIC_RELEASE, "agent");
            asm volatile("s_waitcnt vmcnt(0)" ::: "memory");
            const unsigned og = xb_add(&bar[XB_TOP], 1u);
            const unsigned tg = og / nx;
            if (og + 1u == (tg + 1u) * nx) xb_add(&bar[XB_TOPGEN], 1u);
            else XB_SPIN(xb_ld(&bar[XB_TOPGEN]) == tg, bar);
            __builtin_amdgcn_fence(__ATOMIC_ACQUIRE, "agent");
            xb_add(&bar[XB_XGEN(b.x)], 1u);
            asm volatile("s_waitcnt vmcnt(0)" ::: "memory");
        } else {
            XB_SPIN(xb_ld(&bar[XB_XGEN(b.x)]) == gen, bar);
            __builtin_amdgcn_fence(__ATOMIC_ACQUIRE, "agent");
            asm volatile("s_waitcnt vmcnt(0)" ::: "memory");
        }
    }
    __syncthreads();
}


namespace xat {
typedef short bf16x8 __attribute__((ext_vector_type(8)));
typedef short s16x4 __attribute__((ext_vector_type(4)));
typedef float f32x16 __attribute__((ext_vector_type(16)));
constexpr int RB = 272;
constexpr int KIMG = 0, VIMG = 128 * RB, LDS_BYTES = 2 * 128 * RB;
__device__ __forceinline__ unsigned cvtpk(float lo, float hi) { typedef float f2 __attribute__((ext_vector_type(2))); typedef __bf16 b2 __attribute__((ext_vector_type(2))); f2 v = {lo, hi}; b2 b = __builtin_convertvector(v, b2); return __builtin_bit_cast(unsigned, b); }
__device__ __forceinline__ float swapmax(float m) { auto rr = __builtin_amdgcn_permlane32_swap(__float_as_uint(m), __float_as_uint(m), false, false); return fmaxf(__uint_as_float(rr[0]), __uint_as_float(rr[1])); }
__device__ __forceinline__ float swapadd(float m) { auto rr = __builtin_amdgcn_permlane32_swap(__float_as_uint(m), __float_as_uint(m), false, false); return __uint_as_float(rr[0]) + __uint_as_float(rr[1]); }
__device__ __forceinline__ void unit(int b, int head, int qb, const bf16* QX, const bf16* KX, const bf16* VT, bf16* OX, LAS unsigned char* lds) {
    int tid = threadIdx.x; asm volatile("" : "+v"(tid));
    const int lane = tid & 63, r32 = lane & 31, h = lane >> 5, wid = tid >> 6;
    const size_t qrow = (size_t)b * SEQ + (size_t)qb * 256 + wid * 32 + r32;
    bf16x8 qf[8];
#pragma unroll
    for (int d0 = 0; d0 < 8; ++d0) qf[d0] = *(const bf16x8*)(QX + qrow * 512 + head * 128 + 16 * d0 + 8 * h);
    f32x16 o[4];
#pragma unroll
    for (int db = 0; db < 4; ++db) o[db] = (f32x16){};
    float mrun = -INFINITY, lsum = 0.f;
#pragma unroll 1
    for (int half = 0; half < 2; ++half) {
        __syncthreads();
#pragma unroll
        for (int i = 0; i < 4; ++i) { const int c = tid + 512 * i, row = c >> 4, ch = c & 15;
            const v4u kv = *(const GAS v4u*)(KX + ((size_t)b * NMEM + half * 128 + row) * 512 + head * 128 + ch * 8);
            const v4u vv = *(const GAS v4u*)(VT + ((size_t)head * 128 + row) * 512 + b * NMEM + half * 128 + ch * 8);
            *(LAS v4u*)(lds + KIMG + row * RB + ch * 16) = kv; *(LAS v4u*)(lds + VIMG + row * RB + ch * 16) = vv; }
        __syncthreads();
        f32x16 st[4];
#pragma unroll
        for (int kb = 0; kb < 4; ++kb) { st[kb] = (f32x16){};
#pragma unroll
            for (int d0 = 0; d0 < 8; ++d0) { const bf16x8 a = *(const LAS bf16x8*)(lds + KIMG + (32 * kb + r32) * RB + (16 * d0 + 8 * h) * 2);
                st[kb] = __builtin_amdgcn_mfma_f32_32x32x16_bf16(a, qf[d0], st[kb], 0, 0, 0); } }
        float mloc = st[0][0];
#pragma unroll
        for (int kb = 0; kb < 4; ++kb)
#pragma unroll
            for (int i = 0; i < 16; ++i) mloc = fmaxf(mloc, st[kb][i]);
        const float mnew = fmaxf(mrun, swapmax(mloc)), alpha = __builtin_amdgcn_exp2f(mrun - mnew);
        float psum = 0.f;
#pragma unroll
        for (int kb = 0; kb < 4; ++kb)
#pragma unroll
            for (int i = 0; i < 16; ++i) { st[kb][i] = __builtin_amdgcn_exp2f(st[kb][i] - mnew); psum += st[kb][i]; }
        lsum = lsum * alpha + psum; mrun = mnew;
#pragma unroll
        for (int db = 0; db < 4; ++db)
#pragma unroll
            for (int i = 0; i < 16; ++i) o[db][i] *= alpha;
#pragma unroll
        for (int kb = 0; kb < 4; ++kb)
#pragma unroll
            for (int sp = 0; sp < 2; ++sp) {
                v4u pw; pw.x = cvtpk(st[kb][8 * sp], st[kb][8 * sp + 1]); pw.y = cvtpk(st[kb][8 * sp + 2], st[kb][8 * sp + 3]); pw.z = cvtpk(st[kb][8 * sp + 4], st[kb][8 * sp + 5]); pw.w = cvtpk(st[kb][8 * sp + 6], st[kb][8 * sp + 7]);
                const bf16x8 pb = __builtin_bit_cast(bf16x8, pw);
#pragma unroll
                for (int db = 0; db < 4; ++db) { const LAS unsigned char* vp = lds + VIMG + (32 * db + r32) * RB + (32 * kb + 16 * sp + 4 * h) * 2;
                    const s16x4 lo = *(const LAS s16x4*)vp, hi = *(const LAS s16x4*)(vp + 16);
                    const bf16x8 va = {lo[0], lo[1], lo[2], lo[3], hi[0], hi[1], hi[2], hi[3]};
                    o[db] = __builtin_amdgcn_mfma_f32_32x32x16_bf16(va, pb, o[db], 0, 0, 0); } }
    }
    const float inv = 1.f / swapadd(lsum);
    bf16* orow = OX + qrow * 512 + head * 128;
#pragma unroll
    for (int db = 0; db < 4; ++db)
#pragma unroll
        for (int g = 0; g < 4; ++g) {
            const unsigned long long w = (unsigned long long)cvtpk(o[db][4 * g] * inv, o[db][4 * g + 1] * inv) | ((unsigned long long)cvtpk(o[db][4 * g + 2] * inv, o[db][4 * g + 3] * inv) << 32);
            *(GAS unsigned long long*)(orow + 32 * db + 8 * g + 4 * h) = w; }
}
}


namespace mls {
typedef short bf16x8 __attribute__((ext_vector_type(8)));
typedef short s16x4 __attribute__((ext_vector_type(4)));
typedef float f32x16 __attribute__((ext_vector_type(16)));
constexpr int RB = 128, VIMG = 0, KIMG = 8192, ATAB = 8192, NTAB = 8448;
__device__ __forceinline__ s16x4 trd(const LAS unsigned char* p) { typedef short v4i16_t __attribute__((ext_vector_type(4))); return __builtin_bit_cast(s16x4, __builtin_amdgcn_ds_read_tr16_b64_v4i16((LAS v4i16_t*)p)); }
__device__ __forceinline__ bf16x8 cat8(s16x4 lo, s16x4 hi) { return (bf16x8){lo[0], lo[1], lo[2], lo[3], hi[0], hi[1], hi[2], hi[3]}; }
__device__ __forceinline__ unsigned cvtpk(float lo, float hi) { typedef float f2 __attribute__((ext_vector_type(2))); typedef __bf16 b2 __attribute__((ext_vector_type(2))); f2 v = {lo, hi}; b2 b = __builtin_convertvector(v, b2); return __builtin_bit_cast(unsigned, b); }
__device__ __forceinline__ bf16x8 pack8(const float* f) { v4u w; w.x = cvtpk(f[0], f[1]); w.y = cvtpk(f[2], f[3]); w.z = cvtpk(f[4], f[5]); w.w = cvtpk(f[6], f[7]); return __builtin_bit_cast(bf16x8, w); }
__device__ __forceinline__ float swapadd(float m) { auto rr = __builtin_amdgcn_permlane32_swap(__float_as_uint(m), __float_as_uint(m), false, false); return __uint_as_float(rr[0]) + __uint_as_float(rr[1]); }
__device__ __forceinline__ int crow(int r, int hi) { return (r & 3) + 8 * (r >> 2) + 4 * hi; }

__device__ __forceinline__ void u_unit(const Ptrs& P, int bhk, LAS unsigned char* wl, int lane) {
    const int bh = bhk / NCH, k = bhk % NCH, b = bh / MH, hd = bh % MH; const size_t row0 = (size_t)b * SEQ + (size_t)k * 64;
    const int r32 = lane & 31, h = lane >> 5;
    const float li = WSP(const float, WS_GATE)[(size_t)hd * M + row0 + lane], bl = WSP(const float, WS_BL)[(size_t)bh * SEQ + k * 64 + lane];
    const float wg = __expf(WSP(const float, WS_BT)[bhk] - bl + li - WSP(const float, WS_MS)[bh * (NCH + 1) + k + 1]);
    const bf16* vsrc = WSP(const bf16, R_T0 + SZ_T) + row0 * 512 + hd * 64; const bf16* ksrc = WSP(const bf16, R_MQK) + row0 * 512 + 256 + hd * 64;
#pragma unroll
    for (int i = 0; i < 8; ++i) { const int row = i * 8 + (lane >> 3), ch = lane & 7;
        *(LAS v4u*)(wl + VIMG + row * RB + ch * 16) = *(const GAS v4u*)(vsrc + (size_t)row * 512 + ch * 8);
        const v4u kk = *(const GAS v4u*)(ksrc + (size_t)row * 512 + ch * 8); float f[8]; unpack8(kk, f); const float w = __shfl(wg, row);
#pragma unroll
        for (int e = 0; e < 8; ++e) f[e] *= w;
        *(LAS bf16x8*)(wl + KIMG + row * RB + ch * 16) = pack8(f); }
    f32x16 acc[2][2];
#pragma unroll
    for (int a = 0; a < 2; ++a)
#pragma unroll
        for (int c = 0; c < 2; ++c) acc[a][c] = (f32x16){};
    const unsigned toff = (unsigned)(((lane & 15) >> 2) * RB + (16 * ((lane >> 4) & 1) + 4 * (lane & 3)) * 2);
#pragma unroll
    for (int st = 0; st < 4; ++st) { bf16x8 af[2], bf_[2];
#pragma unroll
        for (int c = 0; c < 2; ++c) { const LAS unsigned char* pv = wl + VIMG + (16 * st + 8 * h) * RB + toff + 64 * c; af[c] = cat8(trd(pv), trd(pv + 4 * RB));
                                      const LAS unsigned char* pk = wl + KIMG + (16 * st + 8 * h) * RB + toff + 64 * c; bf_[c] = cat8(trd(pk), trd(pk + 4 * RB)); }
#pragma unroll
        for (int jb = 0; jb < 2; ++jb)
#pragma unroll
            for (int ib = 0; ib < 2; ++ib) acc[jb][ib] = __builtin_amdgcn_mfma_f32_32x32x16_bf16(af[jb], bf_[ib], acc[jb][ib], 0, 0, 0); }
    float* UT = WSP(float, R_CST) + (size_t)bhk * 4096;
#pragma unroll
    for (int jb = 0; jb < 2; ++jb)
#pragma unroll
        for (int ib = 0; ib < 2; ++ib)
#pragma unroll
            for (int e = 0; e < 16; ++e) UT[(32 * jb + crow(e, h)) * 64 + 32 * ib + r32] = acc[jb][ib][e];
    float sn = 0.f;
#pragma unroll 8
    for (int r = 0; r < 64; ++r) sn += bf2f(*(const LAS bf16*)(wl + KIMG + r * RB + lane * 2));
    WSP(float, WS_NST)[(size_t)bhk * 64 + lane] = sn;
}

__device__ __forceinline__ void decay_apply(f32x16& tile, int sb, int tb, const LAS float* atab, float mx, float& dsum, int r32, int h) {
#pragma unroll
    for (int g = 0; g < 4; ++g) { const f32x4 av = *(const LAS f32x4*)(atab + 32 * sb + 8 * g + 4 * h);
#pragma unroll
        for (int c = 0; c < 4; ++c) { const int sidx = 32 * sb + 8 * g + 4 * h + c, t = 32 * tb + r32;
            const float w = (sidx <= t) ? __expf(av[c] - mx) : 0.f; tile[4 * g + c] *= w; dsum += tile[4 * g + c]; } }
}
__device__ __forceinline__ bf16x8 packstep(const f32x16& x, int st) { v4u w; w.x = cvtpk(x[8 * st], x[8 * st + 1]); w.y = cvtpk(x[8 * st + 2], x[8 * st + 3]); w.z = cvtpk(x[8 * st + 4], x[8 * st + 5]); w.w = cvtpk(x[8 * st + 6], x[8 * st + 7]); return __builtin_bit_cast(bf16x8, w); }

__device__ __forceinline__ void out_unit(const Ptrs& P, int l, int bhk, LAS unsigned char* wl, int lane) {
    const int bh = bhk / NCH, k = bhk % NCH, b = bh / MH, hd = bh % MH; const size_t row0 = (size_t)b * SEQ + (size_t)k * 64;
    const int r32 = lane & 31, h = lane >> 5;
    const bf16* T1 = WSP(const bf16, R_T0 + SZ_T); const bf16* MQK = WSP(const bf16, R_MQK);
    const bf16* vsrc = T1 + row0 * 512 + hd * 64;
    v4u vreg[8];
#pragma unroll
    for (int i = 0; i < 8; ++i) { const int row = i * 8 + (lane >> 3), ch = lane & 7; vreg[i] = *(const GAS v4u*)(vsrc + (size_t)row * 512 + ch * 8); }
    bf16x8 qf[2][4], kf[2][4];
#pragma unroll
    for (int tb = 0; tb < 2; ++tb)
#pragma unroll
        for (int d0 = 0; d0 < 4; ++d0) { qf[tb][d0] = *(const bf16x8*)(MQK + (row0 + 32 * tb + r32) * 512 + hd * 64 + 16 * d0 + 8 * h);
                                         kf[tb][d0] = *(const bf16x8*)(MQK + (row0 + 32 * tb + r32) * 512 + 256 + hd * 64 + 16 * d0 + 8 * h); }
    const float li_s = WSP(const float, WS_GATE)[(size_t)hd * M + row0 + lane], bl_s = WSP(const float, WS_BL)[(size_t)bh * SEQ + k * 64 + lane];
    const float mk = WSP(const float, WS_MS)[bh * (NCH + 1) + k]; const float nst = WSP(const float, WS_NST)[(size_t)bhk * 64 + lane];
    const float a_s = li_s - bl_s; float pm = a_s;
#pragma unroll
    for (int o = 1; o < 64; o <<= 1) { const float t = __shfl_up(pm, o); if (lane >= o) pm = fmaxf(pm, t); }
    LAS float* atab = (LAS float*)(wl + ATAB); LAS float* ntab = (LAS float*)(wl + NTAB);
    atab[lane] = a_s; ntab[lane] = nst;
    float mx[2], wi[2], blt[2];
#pragma unroll
    for (int tb = 0; tb < 2; ++tb) { const int t = 32 * tb + r32; blt[tb] = __shfl(bl_s, t); mx[tb] = fmaxf(mk, __shfl(pm, t)); wi[tb] = __expf(mk - mx[tb]); }
#pragma unroll
    for (int i = 0; i < 8; ++i) { const int row = i * 8 + (lane >> 3), ch = lane & 7; *(LAS v4u*)(wl + VIMG + row * RB + ch * 16) = vreg[i]; }
    f32x16 s00 = (f32x16){}, s01 = (f32x16){}, s11 = (f32x16){};
#pragma unroll
    for (int d0 = 0; d0 < 4; ++d0) { s00 = __builtin_amdgcn_mfma_f32_32x32x16_bf16(kf[0][d0], qf[0][d0], s00, 0, 0, 0);
        s01 = __builtin_amdgcn_mfma_f32_32x32x16_bf16(kf[0][d0], qf[1][d0], s01, 0, 0, 0); s11 = __builtin_amdgcn_mfma_f32_32x32x16_bf16(kf[1][d0], qf[1][d0], s11, 0, 0, 0); }
    float dsum[2] = {0.f, 0.f};
    decay_apply(s00, 0, 0, atab, mx[0], dsum[0], r32, h); decay_apply(s01, 0, 1, atab, mx[1], dsum[1], r32, h); decay_apply(s11, 1, 1, atab, mx[1], dsum[1], r32, h);
    f32x16 nacc[2][2];
#pragma unroll
    for (int a = 0; a < 2; ++a)
#pragma unroll
        for (int c = 0; c < 2; ++c) nacc[a][c] = (f32x16){};
    const unsigned toff = (unsigned)(((lane & 15) >> 2) * RB + (16 * ((lane >> 4) & 1) + 4 * (lane & 3)) * 2);
#pragma unroll
    for (int sb = 0; sb < 2; ++sb)
#pragma unroll
        for (int st = 0; st < 2; ++st) { bf16x8 va[2];
#pragma unroll
            for (int jb = 0; jb < 2; ++jb) { const LAS unsigned char* pv = wl + VIMG + (32 * sb + 16 * st + 4 * h) * RB + toff + 64 * jb; va[jb] = cat8(trd(pv), trd(pv + 8 * RB)); }
            if (sb == 0) { const bf16x8 p0 = packstep(s00, st), p1 = packstep(s01, st);
#pragma unroll
                for (int jb = 0; jb < 2; ++jb) { nacc[jb][0] = __builtin_amdgcn_mfma_f32_32x32x16_bf16(va[jb], p0, nacc[jb][0], 0, 0, 0); nacc[jb][1] = __builtin_amdgcn_mfma_f32_32x32x16_bf16(va[jb], p1, nacc[jb][1], 0, 0, 0); }
            } else { const bf16x8 p1 = packstep(s11, st);
#pragma unroll
                for (int jb = 0; jb < 2; ++jb) nacc[jb][1] = __builtin_amdgcn_mfma_f32_32x32x16_bf16(va[jb], p1, nacc[jb][1], 0, 0, 0); } }
    const float* CT = WSP(const float, R_CST) + (size_t)bhk * 4096;
    float dint[2] = {0.f, 0.f};
#pragma unroll
    for (int st = 0; st < 4; ++st) { bf16x8 ca[2];
#pragma unroll
        for (int jb = 0; jb < 2; ++jb) { const float* cp = CT + (32 * jb + r32) * 64 + 16 * st + 8 * h; const f32x4 c0 = *(const f32x4*)cp, c1 = *(const f32x4*)(cp + 4);
            const float f[8] = {c0[0], c0[1], c0[2], c0[3], c1[0], c1[1], c1[2], c1[3]}; ca[jb] = pack8(f); }
        const f32x4 n0 = *(const LAS f32x4*)(ntab + 16 * st + 8 * h), n1 = *(const LAS f32x4*)(ntab + 16 * st + 8 * h + 4);
#pragma unroll
        for (int tb = 0; tb < 2; ++tb) { float f[8]; unpack8(__builtin_bit_cast(v4u, qf[tb][st]), f);
            dint[tb] += (f[0] * n0[0] + f[1] * n0[1]) + (f[2] * n0[2] + f[3] * n0[3]) + (f[4] * n1[0] + f[5] * n1[1]) + (f[6] * n1[2] + f[7] * n1[3]);
#pragma unroll
            for (int e = 0; e < 8; ++e) f[e] *= wi[tb];
            const bf16x8 qw = pack8(f);
#pragma unroll
            for (int jb = 0; jb < 2; ++jb) nacc[jb][tb] = __builtin_amdgcn_mfma_f32_32x32x16_bf16(ca[jb], qw, nacc[jb][tb], 0, 0, 0); } }
    const float* nw = P.in[I_MNW] + l * 256 + hd * 64; bf16* CAT = WSP(bf16, R_CAT);
#pragma unroll
    for (int tb = 0; tb < 2; ++tb) {
        const float den = swapadd(dsum[tb]) + wi[tb] * swapadd(dint[tb]);
        const float dinv = 1.f / fmaxf(fabsf(den), __expf(-(blt[tb] + mx[tb])));
        float ss = 0.f;
#pragma unroll
        for (int jb = 0; jb < 2; ++jb)
#pragma unroll
            for (int e = 0; e < 16; ++e) { const float v = nacc[jb][tb][e] * dinv; ss += v * v; }
        const float scale = dinv / sqrtf(swapadd(ss) * (1.f / 64.f) + EPS);
        const size_t row = row0 + 32 * tb + r32;
#pragma unroll
        for (int jb = 0; jb < 2; ++jb)
#pragma unroll
            for (int g = 0; g < 4; ++g) { const int j0 = 32 * jb + 8 * g + 4 * h; const f32x4 nwv = *(const f32x4*)(nw + j0);
                const unsigned long long mo = *(const GAS unsigned long long*)(T1 + row * 512 + 256 + hd * 64 + j0);
                const float m0 = __uint_as_float((unsigned)(mo << 16)), m1 = __uint_as_float((unsigned)mo & 0xffff0000u), m2 = __uint_as_float((unsigned)(mo >> 32) << 16), m3 = __uint_as_float((unsigned)(mo >> 32) & 0xffff0000u);
                const float y0 = nacc[jb][tb][4 * g] * scale * nwv[0] * __builtin_amdgcn_rcpf(1.f + __expf(-m0)), y1 = nacc[jb][tb][4 * g + 1] * scale * nwv[1] * __builtin_amdgcn_rcpf(1.f + __expf(-m1));
                const float y2 = nacc[jb][tb][4 * g + 2] * scale * nwv[2] * __builtin_amdgcn_rcpf(1.f + __expf(-m2)), y3 = nacc[jb][tb][4 * g + 3] * scale * nwv[3] * __builtin_amdgcn_rcpf(1.f + __expf(-m3));
                *(GAS unsigned long long*)(CAT + row * 1024 + hd * 64 + j0) = (unsigned long long)cvtpk(y0, y1) | ((unsigned long long)cvtpk(y2, y3) << 32); }
    }
}
template <int SEG, int STRIDE> struct SegScan {
    static constexpr int CH = 128 / SEG, EL = 64 / SEG;
    float u[CH], d[CH];
    __device__ __forceinline__ void load(const float* base, const float* dec, int lane) { const int seg = lane / EL;
#pragma unroll
        for (int i = 0; i < CH; ++i) { u[i] = base[(size_t)(seg * CH + i) * STRIDE]; d[i] = dec[seg * CH + i]; } }
    __device__ __forceinline__ void finish(float* base, int lane) { const int seg = lane / EL;
        float Pm = 1.f, Um = 0.f;
#pragma unroll
        for (int i = 0; i < CH; ++i) { Um = d[i] * Um + u[i]; Pm *= d[i]; }
        float c = 0.f;
#pragma unroll
        for (int j = 0; j < SEG - 1; ++j) { const float pj = __shfl(Pm, j * EL + (lane % EL)), uj = __shfl(Um, j * EL + (lane % EL)); if (j < seg) c = pj * c + uj; }
        float run = c;
#pragma unroll
        for (int i = 0; i < CH; ++i) { base[(size_t)(seg * CH + i) * STRIDE] = run; run = d[i] * run + u[i]; } }
};
__device__ __forceinline__ void state_scan(const Ptrs& P, int gw, int ngw, int lane) {
    static_assert(NCH == 128, "SegScan assumes 128 chunks");
    const float* DEC = WSP(const float, WS_DEC); float* CST = WSP(float, R_CST); float* NST = WSP(float, WS_NST);
    for (int w = gw; w < 8 * 256; w += ngw) {
        const int bh = w >> 8, e = (w & 255) * 16 + (lane & 15); float* cb = CST + (size_t)bh * NCH * 4096 + e;
        SegScan<4, 4096> a; a.load(cb, DEC + bh * NCH, lane);
        if (w < 64) { const int bh2 = w >> 3, e2 = (w & 7) * 8 + (lane & 7); float* nb = NST + (size_t)bh2 * NCH * 64 + e2;
            SegScan<8, 64> b; b.load(nb, DEC + bh2 * NCH, lane); a.finish(cb, lane); b.finish(nb, lane); }
        else a.finish(cb, lane);
    }
}
}

constexpr int RING_BYTES = 131072;
constexpr int MISC_OFF = RING_BYTES;
constexpr int PTR_OFF = RING_BYTES + 256;
constexpr int JOB_OFF = RING_BYTES + 512;
constexpr int LDS_BYTES = 147456;
constexpr int NWAVES = 8;

__device__ __forceinline__ float wave_sum(float v) {
#pragma unroll
    for (int o = 1; o < 64; o <<= 1) v += __shfl_xor(v, o);
    return v;
}
struct WJob { const float* W0; const float* W1; const float* rs; bf16* WT; int K, Nsrc, nblk, kind; float cs; int item0; int pad0, pad1; };
constexpr int MAX_JOBS = 32;
__device__ __forceinline__ void p0_transpose_item(const LAS WJob* jb, LAS float* scr, int item, int lane) {
    const int K = jb->K, N = jb->Nsrc, nblk = jb->nblk, kb = item / nblk, nb = item % nblk, k0 = 64 * kb;
    int which, col0; float cs; wmap(jb->kind, nb, which, col0, cs); cs *= jb->cs;
    const float* W = which ? jb->W1 : jb->W0; const float* rs = jb->rs;
    const float* src = W + (size_t)(k0 + (lane >> 5)) * N + col0 + (lane & 31);
    float v[32];
#pragma unroll
    for (int i = 0; i < 32; ++i) v[i] = __builtin_nontemporal_load(src + (size_t)(2 * i) * N);
#pragma unroll
    for (int i = 0; i < 32; ++i) scr[(2 * i + (lane >> 5)) * 33 + (lane & 31)] = v[i];
    LDS_WAIT(); asm volatile("" ::: "memory");
    const int c = lane & 7; bf16* WT = jb->WT;
    f32x4 r0 = {cs, cs, cs, cs}, r1 = r0;
    if (rs) { r0 = *(const f32x4*)(rs + k0 + 8 * c) * cs; r1 = *(const f32x4*)(rs + k0 + 8 * c + 4) * cs; }
#pragma unroll
    for (int j = 0; j < 4; ++j) { const int n = (lane >> 3) + 8 * j; const LAS float* sp = scr + (8 * c) * 33 + n;
        if (jb->pad0) {
            const float q_ = (float)jb->pad0;
            int p0 = __builtin_amdgcn_cvt_pk_fp8_f32(sp[0 * 33] * r0[0] * q_, sp[1 * 33] * r0[1] * q_, 0, false); p0 = __builtin_amdgcn_cvt_pk_fp8_f32(sp[2 * 33] * r0[2] * q_, sp[3 * 33] * r0[3] * q_, p0, true);
            int p1 = __builtin_amdgcn_cvt_pk_fp8_f32(sp[4 * 33] * r1[0] * q_, sp[5 * 33] * r1[1] * q_, 0, false); p1 = __builtin_amdgcn_cvt_pk_fp8_f32(sp[6 * 33] * r1[2] * q_, sp[7 * 33] * r1[3] * q_, p1, true);
            typedef unsigned v2u_ __attribute__((ext_vector_type(2)));
            __builtin_nontemporal_store((v2u_){(unsigned)p0, (unsigned)p1}, (GAS v2u_*)((unsigned char*)WT + (size_t)(nb * 32 + n) * K + k0 + 8 * c));
            continue; }
        v4u o; o.x = pk2(sp[0 * 33] * r0[0], sp[1 * 33] * r0[1]); o.y = pk2(sp[2 * 33] * r0[2], sp[3 * 33] * r0[3]); o.z = pk2(sp[4 * 33] * r1[0], sp[5 * 33] * r1[1]); o.w = pk2(sp[6 * 33] * r1[2], sp[7 * 33] * r1[3]);
        __builtin_nontemporal_store(o, (GAS v4u*)(WT + (size_t)(nb * 32 + n) * K + k0 + 8 * c)); }
    LDS_WAIT(); asm volatile("" ::: "memory");
}
__device__ __forceinline__ void build_gw(const Ptrs& P, long gtid, long gn) {
    for (long it = gtid; it < 3 * 32 * 64; it += gn) {
        const int t = (int)(it / 2048), ks = (int)((it / 64) % 32), ln = (int)(it % 64), c = ln & 15, quad = ln >> 4;
        float hi[8], lo[8];
#pragma unroll
        for (int j = 0; j < 8; ++j) { const int k = 32 * ks + 8 * quad + j; float w;
            if (t < 2) w = P.in[I_NMIX][t * D + k] * P.in[I_WIN][(size_t)t * D * INW + (size_t)k * INW + (c < 8 ? 1024 + c : 3072 + c)];
            else w = (c < 8) ? P.in[I_NFFN][D + k] * P.in[I_RW][(size_t)k * 8 + c] : 0.f;
            const float h = bf2f(f2bf(w)); hi[j] = h; lo[j] = w - h; }
        v4u oh, ol; oh.x = pk2(hi[0], hi[1]); oh.y = pk2(hi[2], hi[3]); oh.z = pk2(hi[4], hi[5]); oh.w = pk2(hi[6], hi[7]); ol.x = pk2(lo[0], lo[1]); ol.y = pk2(lo[2], lo[3]); ol.z = pk2(lo[4], lo[5]); ol.w = pk2(lo[6], lo[7]);
        v4u* tab = (v4u*)(P.ws + WS_GW + (size_t)t * 65536); tab[(ks * 2 + 0) * 64 + ln] = oh; tab[(ks * 2 + 1) * 64 + ln] = ol;
    }
}
template <int MODE, bool PRE>
__device__ __forceinline__ void norm16(const Ptrs& P, int l, const float* src, bf16* XN, const unsigned* rss_in, int vcu, int G, int wave, int lane, LAS float* xch) {
    typedef short bf16x8 __attribute__((ext_vector_type(8)));
    const int r = lane & 15, quad = lane >> 4, kh = wave >> 2;
    const v4u* tab = (const v4u*)(P.ws + WS_GW + (size_t)(MODE == 2 ? 2 : l) * 65536) + lane;
    if constexpr (MODE == 2) { if (wave == 0 && lane < 8) ((LAS unsigned*)(xch + 2048))[64 * 4 + lane] = 0u; }
    for (int t0 = 0; t0 < M / 16; t0 += 4 * G) {
        const int task = t0 + (wave & 3) * G + vcu; const bool live = task < M / 16; const int r0 = (live ? task : 0) * 16;
        const float* xr = src + (size_t)(r0 + r) * D + 8 * quad; bf16* xo = XN + (size_t)(r0 + r) * D + 8 * quad;
        f32x4 acc = {0.f, 0.f, 0.f, 0.f}; float ss = 0.f;
#pragma unroll
        for (int kk = 0; kk < 16; ++kk) { const int ks = 16 * kh + kk;
            if constexpr (PRE) {
                const v4u h = *(const GAS v4u*)(xo + 32 * ks);
                const bf16x8 ah = __builtin_bit_cast(bf16x8, h);
                const bf16x8 bh = __builtin_bit_cast(bf16x8, tab[(ks * 2 + 0) * 64]), bl = __builtin_bit_cast(bf16x8, tab[(ks * 2 + 1) * 64]);
                acc = __builtin_amdgcn_mfma_f32_16x16x32_bf16(ah, bh, acc, 0, 0, 0); acc = __builtin_amdgcn_mfma_f32_16x16x32_bf16(ah, bl, acc, 0, 0, 0);
            } else {
            const f32x4 a = __builtin_nontemporal_load((const GAS f32x4*)(xr + 32 * ks)), b = __builtin_nontemporal_load((const GAS f32x4*)(xr + 32 * ks + 4));
            ss += (a[0] * a[0] + a[1] * a[1]) + (a[2] * a[2] + a[3] * a[3]) + (b[0] * b[0] + b[1] * b[1]) + (b[2] * b[2] + b[3] * b[3]);
            v4u h; h.x = pk2(a[0], a[1]); h.y = pk2(a[2], a[3]); h.z = pk2(b[0], b[1]); h.w = pk2(b[2], b[3]);
            if (live) *(GAS v4u*)(xo + 32 * ks) = h;
            if constexpr (MODE != 0) {
                float hf[8]; unpack8(h, hf);
                v4u lw; lw.x = pk2(a[0] - hf[0], a[1] - hf[1]); lw.y = pk2(a[2] - hf[2], a[3] - hf[3]); lw.z = pk2(b[0] - hf[4], b[1] - hf[5]); lw.w = pk2(b[2] - hf[6], b[3] - hf[7]);
                const bf16x8 ah = __builtin_bit_cast(bf16x8, h), al = __builtin_bit_cast(bf16x8, lw);
                const bf16x8 bh = __builtin_bit_cast(bf16x8, tab[(ks * 2 + 0) * 64]), bl = __builtin_bit_cast(bf16x8, tab[(ks * 2 + 1) * 64]);
                acc = __builtin_amdgcn_mfma_f32_16x16x32_bf16(ah, bh, acc, 0, 0, 0); acc = __builtin_amdgcn_mfma_f32_16x16x32_bf16(al, bh, acc, 0, 0, 0); acc = __builtin_amdgcn_mfma_f32_16x16x32_bf16(ah, bl, acc, 0, 0, 0);
            }
            }
        }
        { LAS float* xp = xch + ((wave & 3) * 64 + lane) * 5;
          if (kh == 1) { xp[0] = acc[0]; xp[1] = acc[1]; xp[2] = acc[2]; xp[3] = acc[3]; xp[4] = ss; }
          __syncthreads();
          if (kh == 0) { acc[0] += xp[0]; acc[1] += xp[1]; acc[2] += xp[2]; acc[3] += xp[3]; ss += xp[4]; }
          __syncthreads(); }
        if constexpr (MODE != 2) { if (kh == 1 || !live) continue; }
        if (MODE != 2 || (kh == 0 && live)) {
        unsigned sq;
        if constexpr (PRE) sq = rss_in[r0 + r]; else { ss += __shfl_xor(ss, 16); ss += __shfl_xor(ss, 32); sq = (unsigned)(ss * 16.f + 0.5f); if (lane < 16) WSP(unsigned, WS_RSTD)[r0 + lane] = sq; }
        ss = (float)sq * (1.f / 16.f);
        const float rstd = 1.f / sqrtf(ss * (1.f / D) + EPS);
        if constexpr (MODE != 0) {
            float z[4];
#pragma unroll
            for (int j = 0; j < 4; ++j) z[j] = acc[j] * __shfl(rstd, 4 * quad + j);
            if constexpr (MODE == 1) {
                const int g = r; f32x4 o;
#pragma unroll
                for (int j = 0; j < 4; ++j) { if (g < 4) o[j] = z[j] + P.in[I_MBI][l * 4 + g]; else if (g < 8) o[j] = logsigmoidf_(z[j] + P.in[I_MBF][l * 4 + g - 4]); else o[j] = logsigmoidf_(z[j] + P.in[I_FBF][l * 8 + g - 8]); }
                *(f32x4*)(WSP(float, WS_GATE) + (size_t)g * M + r0 + 4 * quad) = o;
            } else {
#pragma unroll
                for (int j = 0; j < 4; ++j) { float le[8];
#pragma unroll
                    for (int e = 0; e < 8; ++e) le[e] = __shfl(z[j], (lane & 48) + e);
                    int e1 = 0; float v1 = le[0];
#pragma unroll
                    for (int e = 1; e < 8; ++e) if (le[e] > v1) { v1 = le[e]; e1 = e; }
                    int e2 = -1; float v2 = -INFINITY;
#pragma unroll
                    for (int e = 0; e < 8; ++e) if (e != e1 && le[e] > v2) { v2 = le[e]; e2 = e; }
                    if (r == j) { const float g2 = 1.f / (1.f + expf(v1 - v2)), g1 = 1.f - g2;
                        LAS unsigned* sp = (LAS unsigned*)(xch + 2048) + ((wave & 3) * 16 + 4 * quad + j) * 4;
                        sp[0] = (unsigned)e1; sp[1] = (unsigned)e2; sp[2] = __float_as_uint(g1); sp[3] = __float_as_uint(g2); }
                }
            }
        }
        }
        if constexpr (MODE == 2) {
            LAS unsigned* selb = (LAS unsigned*)(xch + 2048); LAS unsigned* hacc = selb + 64 * 4;
            if (!(kh == 0 && live) && wave < 4 && r < 4) selb[((wave & 3) * 16 + 4 * quad + r) * 4] = 255u;
            __syncthreads();
            if (wave == 0) {
                const int w = lane >> 4, e1 = (int)selb[lane * 4], e2 = (int)selb[lane * 4 + 1]; const bool valid = e1 < 8;
                const unsigned long long below = (1ull << lane) - 1ull; int rank1 = 0, rank2 = 0; unsigned mynew = 0u;
#pragma unroll
                for (int e = 0; e < 8; ++e) { const unsigned old_ = hacc[e];
                    const unsigned long long m1 = __ballot(valid && e1 == e), m2 = __ballot(valid && e2 == e); const int c1 = __popcll(m1);
                    if (e1 == e) rank1 = (int)old_ + __popcll(m1 & below);
                    if (e2 == e) rank2 = (int)old_ + c1 + __popcll(m2 & below);
                    if (lane == e) mynew = old_ + (unsigned)(c1 + __popcll(m2)); }
                if (valid) { const int row = (t0 + w * G + vcu) * 16 + (lane & 15); unsigned* tk = WSP(unsigned, WS_TOK) + (size_t)row * 8;
                    tk[0] = (unsigned)e1; tk[1] = (unsigned)rank1; tk[2] = (unsigned)e2; tk[3] = (unsigned)rank2; tk[4] = selb[lane * 4 + 2]; tk[5] = selb[lane * 4 + 3]; }
                if (lane < 8) hacc[lane] = mynew;
            }
            __syncthreads();
        }
    }
    if constexpr (MODE == 2) { if (wave == 0 && lane < 8) WSP(unsigned, WS_BH)[vcu * 8 + lane] = ((LAS unsigned*)(xch + 2048))[64 * 4 + lane]; }
}
template <int MODE>
__device__ __forceinline__ void norm_rows(const Ptrs& P, int l, const float* src, bf16* XN, int nrows, int gw, int ngw, int lane) {
    for (int row = gw; row < nrows; row += ngw) {
        const GAS f32x4* xr = (const GAS f32x4*)(src + (size_t)row * D) + lane;
        f32x4 v[4]; float s2 = 0.f;
#pragma unroll
        for (int j = 0; j < 4; ++j) { v[j] = xr[64 * j]; s2 += (v[j].x * v[j].x + v[j].y * v[j].y) + (v[j].z * v[j].z + v[j].w * v[j].w); }
        const float rstd = 1.f / sqrtf(wave_sum(s2) * (1.f / D) + EPS);
        GAS unsigned long long* o8 = (GAS unsigned long long*)(XN + (size_t)row * D) + lane;
#pragma unroll
        for (int j = 0; j < 4; ++j) o8[64 * j] = (unsigned long long)pk2(v[j].x * rstd, v[j].y * rstd) | ((unsigned long long)pk2(v[j].z * rstd, v[j].w * rstd) << 32);
    }
}

__device__ __forceinline__ float wave_incl_scan(float v, int lane) {
#pragma unroll
    for (int o = 1; o < 64; o <<= 1) { const float t = __shfl_up(v, o); if (lane >= o) v += t; }
    return v;
}
__device__ __forceinline__ float wave_max(float v) {
#pragma unroll
    for (int o = 1; o < 64; o <<= 1) v = fmaxf(v, __shfl_xor(v, o));
    return v;
}
__device__ __forceinline__ void gate_scan_task(const Ptrs& P, int task, LAS float* scr, int tid) {
    const int lane = tid & 63, wave = tid >> 6; const float* GT = WSP(const float, WS_GATE);
    if (task < 16) {
        const int b = task / FH, h = task % FH; constexpr int EPT = SEQ / 512;
        const float* src = GT + (size_t)(8 + h) * M + (size_t)b * SEQ + tid * EPT; float* dst = WSP(float, WS_CF) + (size_t)task * SEQ + tid * EPT;
        float v[EPT]; float run = 0.f;
#pragma unroll
        for (int i = 0; i < EPT; i += 4) { const f32x4 x = *(const f32x4*)(src + i); run += x[0]; v[i] = run; run += x[1]; v[i + 1] = run; run += x[2]; v[i + 2] = run; run += x[3]; v[i + 3] = run; }
        const float wincl = wave_incl_scan(run, lane);
        if (lane == 63) scr[wave] = wincl;
        __syncthreads();
        float offs = wincl - run;
#pragma unroll
        for (int w = 0; w < 8; ++w) if (w < wave) offs += scr[w];
#pragma unroll
        for (int i = 0; i < EPT; i += 4) *(f32x4*)(dst + i) = (f32x4){(offs + v[i]) * LOG2E, (offs + v[i + 1]) * LOG2E, (offs + v[i + 2]) * LOG2E, (offs + v[i + 3]) * LOG2E};
        __syncthreads();
    } else {
        const int bh = task - 16, b = bh / MH, h = bh % MH;
        const float* lfp = GT + (size_t)(4 + h) * M + (size_t)b * SEQ; const float* lip = GT + (size_t)h * M + (size_t)b * SEQ;
        float* BL = WSP(float, WS_BL) + (size_t)bh * SEQ; float* BT = WSP(float, WS_BT) + bh * NCH; float* AK = WSP(float, WS_AK) + bh * NCH; float* MS = WSP(float, WS_MS) + bh * (NCH + 1);
        constexpr int CPW = NCH / 8;
        float lfv[CPW], liv[CPW];
#pragma unroll
        for (int i = 0; i < CPW; ++i) { const int k = wave + 8 * i; lfv[i] = lfp[k * 64 + lane]; liv[i] = lip[k * 64 + lane]; }
#pragma unroll
        for (int i = 0; i < CPW; ++i) { const int k = wave + 8 * i;
            const float bl = wave_incl_scan(lfv[i], lane); BL[k * 64 + lane] = bl;
            const float btot = __shfl(bl, 63); const float a = wave_max(btot - bl + liv[i]);
            if (lane == 0) { BT[k] = btot; AK[k] = a; scr[k] = btot; scr[NCH + k] = a; } }
        __syncthreads();
        if (wave == 0) { float* DEC = WSP(float, WS_DEC) + bh * NCH; constexpr int PL = NCH / 64;
            float f[PL], av[PL]; float run = 0.f;
#pragma unroll
            for (int i = 0; i < PL; ++i) { run += scr[lane * PL + i]; f[i] = run; av[i] = scr[NCH + lane * PL + i]; }
            const float offs = wave_incl_scan(run, lane) - run;
            float pm = -INFINITY; float c[PL];
#pragma unroll
            for (int i = 0; i < PL; ++i) { f[i] += offs; pm = fmaxf(pm, av[i] - f[i]); c[i] = pm; }
            float pin = pm;
#pragma unroll
            for (int o = 1; o < 64; o <<= 1) { const float t = __shfl_up(pin, o); if (lane >= o) pin = fmaxf(pin, t); }
            float pex = __shfl_up(pin, 1); if (lane == 0) pex = -INFINITY;
            float mprev = __shfl_up(fmaxf(0.f, pin) + f[PL - 1], 1); if (lane == 0) mprev = 0.f;
            if (lane == 0) MS[0] = 0.f;
#pragma unroll
            for (int i = 0; i < PL; ++i) { const int k = lane * PL + i; const float mn = f[i] + fmaxf(0.f, fmaxf(pex, c[i]));
                MS[k + 1] = mn; DEC[k] = __expf(scr[k] + mprev - mn); mprev = mn; } }
        __syncthreads();
    }
}
__device__ __forceinline__ void mconv_glu_vec(const Ptrs& P, int l, long gtid, long gn) {
    const bf16* T0 = WSP(const bf16, R_T0); bf16* MQK = WSP(bf16, R_MQK);
    const float* cw = P.in[I_MCW] + l * 4 * 512; const float* cb = P.in[I_MCB] + l * 512;
    for (long it0 = gtid; it0 < (long)M * 64; it0 += 4 * gn) {
        v4u w[4][4]; bool ok[4][4];
#pragma unroll
        for (int r = 0; r < 4; ++r) { const long it = it0 + r * gn; const int ch = (int)(it & 63); const long row = it >> 6; const int t = (int)(row % SEQ), c0 = ch * 8;
#pragma unroll
            for (int j = 0; j < 4; ++j) { ok[r][j] = it < (long)M * 64 && t - 3 + j >= 0; w[r][j] = (v4u){0u, 0u, 0u, 0u}; if (ok[r][j]) w[r][j] = *(const GAS v4u*)(T0 + (size_t)(row - 3 + j) * 512 + c0); } }
#pragma unroll
        for (int r = 0; r < 4; ++r) { const long it = it0 + r * gn; if (it >= (long)M * 64) continue; const int ch = (int)(it & 63); const long row = it >> 6; const int c0 = ch * 8;
            float acc[8];
#pragma unroll
            for (int i = 0; i < 8; ++i) acc[i] = cb[c0 + i];
#pragma unroll
            for (int j = 0; j < 4; ++j) { if (ok[r][j]) { float x[8]; unpack8(w[r][j], x);
#pragma unroll
                    for (int i = 0; i < 8; ++i) acc[i] += cw[j * 512 + c0 + i] * x[i]; } }
            const float sc = (c0 >= 256) ? 0.125f : 1.f; float y[8];
#pragma unroll
            for (int i = 0; i < 8; ++i) y[i] = acc[i] * __builtin_amdgcn_rcpf(1.f + __expf(-acc[i])) * sc;
            v4u o; o.x = pk2(y[0], y[1]); o.y = pk2(y[2], y[3]); o.z = pk2(y[4], y[5]); o.w = pk2(y[6], y[7]);
            *(GAS v4u*)(MQK + (size_t)row * 512 + c0) = o; }
    }
    const bf16* T2 = WSP(const bf16, R_T0 + 2 * SZ_T); bf16* GL = WSP(bf16, R_GL);
    for (long it0 = gtid; it0 < (long)M * 32; it0 += 4 * gn) {
        v4u wa[4], wg[4];
#pragma unroll
        for (int r = 0; r < 4; ++r) { const long it = it0 + r * gn; wa[r] = (v4u){0u, 0u, 0u, 0u}; wg[r] = wa[r];
            if (it < (long)M * 32) { const int c0 = (int)(it & 31) * 8; const long row = it >> 5; wa[r] = *(const GAS v4u*)(T2 + (size_t)row * 512 + c0); wg[r] = *(const GAS v4u*)(T2 + (size_t)row * 512 + 256 + c0); } }
#pragma unroll
        for (int r = 0; r < 4; ++r) { const long it = it0 + r * gn; if (it >= (long)M * 32) continue; const int c0 = (int)(it & 31) * 8; const long row = it >> 5;
            float a[8], g[8]; unpack8(wa[r], a); unpack8(wg[r], g); float y[8];
#pragma unroll
            for (int i = 0; i < 8; ++i) y[i] = a[i] * __builtin_amdgcn_rcpf(1.f + __expf(-g[i]));
            v4u o; o.x = pk2(y[0], y[1]); o.y = pk2(y[2], y[3]); o.z = pk2(y[4], y[5]); o.w = pk2(y[6], y[7]);
            *(GAS v4u*)(GL + (size_t)row * 256 + c0) = o; }
    }
}
__device__ __forceinline__ void cconv_ln_rows(const Ptrs& P, int l, int gw, int ngw, int lane) {
    const bf16* GL = WSP(const bf16, R_GL); bf16* CAT = WSP(bf16, R_CAT);
    const float* cw = P.in[I_CCW] + l * CK * 256 + 4 * lane; const int c0 = 4 * lane;
    const f32x4 cb = *(const f32x4*)(P.in[I_CCB] + l * 256 + c0), lw = *(const f32x4*)(P.in[I_CLW] + l * 256 + c0), lb = *(const f32x4*)(P.in[I_CLB] + l * 256 + c0);
    f32x4 w[CK];
#pragma unroll
    for (int j = 0; j < CK; ++j) w[j] = *(const f32x4*)(cw + j * 256);
    for (int task = gw; task < M / 8; task += ngw) {
        const int r0 = task * 8, t0 = r0 % SEQ;
        unsigned long long x[CK + 7];
#pragma unroll
        for (int i = 0; i < CK + 7; ++i) x[i] = (t0 - (CK - 1) + i >= 0) ? *(const GAS unsigned long long*)(GL + (size_t)(r0 - (CK - 1) + i) * 256 + c0) : 0ull;
        f32x4 acc[8];
#pragma unroll
        for (int o = 0; o < 8; ++o) acc[o] = cb;
#pragma unroll
        for (int i = 0; i < CK + 7; ++i) { const unsigned long long q = x[i];
            const f32x4 xf = {__uint_as_float((unsigned)(q << 16)), __uint_as_float((unsigned)q & 0xffff0000u), __uint_as_float((unsigned)(q >> 32) << 16), __uint_as_float((unsigned)(q >> 32) & 0xffff0000u)};
#pragma unroll
            for (int o = 0; o < 8; ++o) if (i - o >= 0 && i - o < CK) acc[o] += w[i - o] * xf; }
#pragma unroll
        for (int o = 0; o < 8; ++o) {
            const float mean = wave_sum((acc[o][0] + acc[o][1]) + (acc[o][2] + acc[o][3])) * (1.f / 256.f);
            const f32x4 d = acc[o] - mean; const float rstd = 1.f / sqrtf(wave_sum((d[0] * d[0] + d[1] * d[1]) + (d[2] * d[2] + d[3] * d[3])) * (1.f / 256.f) + EPS);
            f32x4 y = d * rstd * lw + lb;
#pragma unroll
            for (int i = 0; i < 4; ++i) y[i] = y[i] * __builtin_amdgcn_rcpf(1.f + __expf(-y[i]));
            *(GAS unsigned long long*)(CAT + (size_t)(r0 + o) * 1024 + 256 + c0) = (unsigned long long)pk2(y[0], y[1]) | ((unsigned long long)pk2(y[2], y[3]) << 32); }
    }
}
__device__ __forceinline__ void fox_keynorms(const Ptrs& P, int gw, int ngw, int lane) {
    const bf16* K = WSP(const bf16, R_T0 + 4 * SZ_T); float* KN2 = WSP(float, WS_KN2); constexpr int NTT = SEQ / 64;
    for (int u = gw; u < BATCH * FH * NTT; u += ngw) { const int bh = u / NTT, tile = u % NTT, b = bh / FH, h = bh % FH;
        const bf16* kr = K + ((size_t)b * SEQ + tile * 64 + lane) * 512 + h * 64; float ss = 0.f;
#pragma unroll
        for (int c = 0; c < 8; ++c) { const v4u v = *(const GAS v4u*)(kr + 8 * c); float f[8]; unpack8(v, f);
#pragma unroll
            for (int e = 0; e < 8; ++e) ss += f[e] * f[e]; }
        ss = wave_max(ss); if (lane == 0) KN2[u] = ss; }
}
__device__ __forceinline__ void moe_gather(const Ptrs& P, int gw, int ngw, int lane, int wave, int vcu, int G, LAS unsigned char* lds) {
    LAS unsigned* base = (LAS unsigned*)lds; LAS unsigned* tot = base + 1024 * 8;
    { const unsigned* BH = WSP(const unsigned, WS_BH); const int per = (G + 63) / 64; unsigned run = 0u;
      for (int k = 0; k < per; ++k) { const int blk = lane * per + k; if (blk < G) run += BH[blk * 8 + wave]; }
      unsigned incl = run;
#pragma unroll
      for (int o = 1; o < 64; o <<= 1) { const unsigned t = __shfl_up(incl, o); if (lane >= o) incl += t; }
      unsigned ex = incl - run;
      for (int k = 0; k < per; ++k) { const int blk = lane * per + k; if (blk < G) { base[blk * 8 + wave] = ex; ex += BH[blk * 8 + wave]; } }
      if (lane == 63) tot[wave] = incl; }
    __syncthreads();
    unsigned* cntg = WSP(unsigned, WS_CTL) + CW_CNT;
    if (vcu == 0 && wave == 0 && lane < 8) cntg[lane] = tot[lane];
    unsigned cnt[8];
#pragma unroll
    for (int e = 0; e < 8; ++e) cnt[e] = tot[e];
    int off[9]; { int o = 0;
#pragma unroll
        for (int e = 0; e < 8; ++e) { off[e] = o; o += ((int)cnt[e] + 255) & ~255; }
        off[8] = o; }
    const bf16* XN = WSP(const bf16, R_XN); bf16* XNS = WSP(bf16, R_XNS); unsigned char* XQ = P.ws + WS_XQ;
    for (int row0 = gw; row0 < M; row0 += 4 * ngw) {
        v4u ta[4], a[4], b[4]; unsigned rv[4];
#pragma unroll
        for (int r = 0; r < 4; ++r) { const int row = row0 + r * ngw; if (row < M) { ta[r] = *(const GAS v4u*)(WSP(unsigned, WS_TOK) + (size_t)row * 8);
                const GAS v4u* srcp = (const GAS v4u*)(XN + (size_t)row * D) + lane; a[r] = __builtin_nontemporal_load(srcp); b[r] = __builtin_nontemporal_load(srcp + 64); rv[r] = WSP(const unsigned, WS_RSS)[(size_t)4 * M + row]; } }
#pragma unroll
        for (int r = 0; r < 4; ++r) { const int row = row0 + r * ngw; if (row < M) {
                unsigned* tk = WSP(unsigned, WS_TOK) + (size_t)row * 8;
                const int e1 = (int)ta[r][0], p1 = (int)ta[r][1], e2 = (int)ta[r][2], p2 = (int)ta[r][3];
                int o1 = 0, o2 = 0;
#pragma unroll
                for (int e = 0; e < 8; ++e) { if (e == e1) o1 = off[e]; if (e == e2) o2 = off[e]; }
                const int blk = (row >> 4) % G;
                const int s1 = o1 + (int)base[blk * 8 + e1] + p1, s2 = o2 + (int)base[blk * 8 + e2] + p2;
                if (lane == 0) { tk[6] = (unsigned)s1; tk[7] = (unsigned)s2; WSP(unsigned, WS_RSTDS)[s1] = rv[r]; WSP(unsigned, WS_RSTDS)[s2] = rv[r];
                    const float g1 = __uint_as_float(tk[4]), g2 = __uint_as_float(tk[5]); WSP(float, WS_SLOTG)[s1] = g1; WSP(float, WS_SLOTG)[s2] = -g2; }
                GAS v4u* d1 = (GAS v4u*)(XNS + (size_t)s1 * D) + lane; d1[0] = a[r]; d1[64] = b[r];
                const float rs_ = rsqrtf((float)rv[r] * (1.f / (16.f * 1024.f)) + 1e-6f) * F8_SA; float fa[8], fb[8]; unpack8(a[r], fa); unpack8(b[r], fb);
                typedef unsigned v2u_ __attribute__((ext_vector_type(2)));
                int qa0 = __builtin_amdgcn_cvt_pk_fp8_f32(fa[0] * rs_, fa[1] * rs_, 0, false); qa0 = __builtin_amdgcn_cvt_pk_fp8_f32(fa[2] * rs_, fa[3] * rs_, qa0, true);
                int qa1 = __builtin_amdgcn_cvt_pk_fp8_f32(fa[4] * rs_, fa[5] * rs_, 0, false); qa1 = __builtin_amdgcn_cvt_pk_fp8_f32(fa[6] * rs_, fa[7] * rs_, qa1, true);
                int qb0 = __builtin_amdgcn_cvt_pk_fp8_f32(fb[0] * rs_, fb[1] * rs_, 0, false); qb0 = __builtin_amdgcn_cvt_pk_fp8_f32(fb[2] * rs_, fb[3] * rs_, qb0, true);
                int qb1 = __builtin_amdgcn_cvt_pk_fp8_f32(fb[4] * rs_, fb[5] * rs_, 0, false); qb1 = __builtin_amdgcn_cvt_pk_fp8_f32(fb[6] * rs_, fb[7] * rs_, qb1, true);
                const v2u_ qa = {(unsigned)qa0, (unsigned)qa1}, qb = {(unsigned)qb0, (unsigned)qb1};
                GAS v2u_* x1 = (GAS v2u_*)(XQ + (size_t)s1 * D) + lane; GAS v2u_* x2 = (GAS v2u_*)(XQ + (size_t)s2 * D) + lane;
                x1[0] = qa; x1[64] = qb; x2[0] = qa; x2[64] = qb; } }
    }
    for (int w = gw; w < 8 * 256; w += ngw) {
        const int e = w >> 8, r = w & 255; int oe = 0, oe1 = 0, ce = 0;
#pragma unroll
        for (int j = 0; j < 8; ++j) if (j == e) { oe = off[j]; oe1 = off[j + 1]; ce = (int)cnt[j]; }
        const int slot = oe + ce + r;
        if (slot < oe1) { GAS v4u* dp = (GAS v4u*)(XNS + (size_t)slot * D) + lane; const v4u z = {0u, 0u, 0u, 0u}; dp[0] = z; dp[64] = z; ((GAS v4u*)(XQ + (size_t)slot * D))[lane] = z;       if (lane == 0) { unsigned zlo = 0u; asm volatile("" : "+v"(zlo)); WSP(unsigned, WS_RSTDS)[slot] = zlo; WSP(float, WS_SLOTG)[slot] = __uint_as_float(zlo); } }
    }
}
__device__ __forceinline__ void moe_combine_final(const Ptrs& P, int gw, int ngw, int lane) {
    const bf16* Y = WSP(const bf16, R_XNS); const float* nw = P.in[I_NFIN];
    for (int row0 = gw; row0 < M; row0 += 4 * ngw) {
        int s1[4], s2[4];
#pragma unroll
        for (int r = 0; r < 4; ++r) { const int row = row0 + r * ngw; const unsigned* tk = WSP(const unsigned, WS_TOK) + (size_t)(row < M ? row : 0) * 8; s1[r] = (int)tk[6]; s2[r] = (int)tk[7]; }
        unsigned long long ya[4][4], yb[4][4];
#pragma unroll
        for (int r = 0; r < 4; ++r) { const GAS unsigned long long* y1 = (const GAS unsigned long long*)(Y + (size_t)s1[r] * D) + lane; const GAS unsigned long long* y2 = (const GAS unsigned long long*)(Y + (size_t)s2[r] * D) + lane;
#pragma unroll
            for (int j = 0; j < 4; ++j) { ya[r][j] = __builtin_nontemporal_load(y1 + 64 * j); yb[r][j] = __builtin_nontemporal_load(y2 + 64 * j); } }
#pragma unroll
        for (int r = 0; r < 4; ++r) { const int row = row0 + r * ngw; if (row < M) {
            GAS f32x4* orow = (GAS f32x4*)(P.xres + (size_t)row * D) + lane;
            f32x4 v[4]; float ssq = 0.f;
#pragma unroll
            for (int j = 0; j < 4; ++j) { const unsigned long long a = ya[r][j], b = yb[r][j];
                v[j].x = bf2f((bf16)(a & 0xffff)) + bf2f((bf16)(b & 0xffff));
                v[j].y = bf2f((bf16)((a >> 16) & 0xffff)) + bf2f((bf16)((b >> 16) & 0xffff));
                v[j].z = bf2f((bf16)((a >> 32) & 0xffff)) + bf2f((bf16)((b >> 32) & 0xffff));
                v[j].w = bf2f((bf16)((a >> 48) & 0xffff)) + bf2f((bf16)((b >> 48) & 0xffff));
                ssq += (v[j].x * v[j].x + v[j].y * v[j].y) + (v[j].z * v[j].z + v[j].w * v[j].w); }
            const float rstd = 1.f / sqrtf(wave_sum(ssq) * (1.f / D) + EPS);
#pragma unroll
            for (int j = 0; j < 4; ++j) { const f32x4 w = *((const f32x4*)nw + lane + 64 * j); __builtin_nontemporal_store(v[j] * rstd * w, orow + 64 * j); } } }
    }
}

#ifndef MK_PER_PHASE
#define MK_PER_PHASE 0
#endif
constexpr int PH_PER_LAYER = 14, N_PHASES = 1 + 2 * PH_PER_LAYER + 1;
__device__ __forceinline__ Ptrs launder(const Ptrs& a) { Ptrs p = a; asm volatile("" : "+s"(p.ws), "+s"(p.xres)); return p; }
struct Args { const float* in[N_IN]; float* xres; unsigned char* ws; int ph_lo, ph_hi; };

__global__ void __launch_bounds__(NWAVES * 64, 2) trunk_fwd(Args args) {
    extern __shared__ __attribute__((aligned(16))) unsigned char lds_raw[];
    LAS unsigned char* lds = (LAS unsigned char*)lds_raw;
    Ptrs P0; P0.in = (const float* const LAS*)(lds + PTR_OFF); P0.xres = args.xres; P0.ws = args.ws;
    const int tid = threadIdx.x, wave0 = __builtin_amdgcn_readfirstlane(tid >> 6);
    const int G0 = gridDim.x; const int bx0 = blockIdx.x; const int vcu0 = (G0 % 8 == 0) ? (bx0 % 8) * (G0 / 8) + bx0 / 8 : bx0;
    volatile LAS unsigned* MISC = (volatile LAS unsigned*)(lds + MISC_OFF);
    if (tid < 64) MISC[tid] = 0u;
    if (tid < N_IN) ((const float* LAS*)(lds + PTR_OFF))[tid] = args.in[tid];
    __syncthreads();
    unsigned* ctl = (unsigned*)(P0.ws + WS_CTL);
    XcdBarrier bar; bar.bar = ctl + CW_BAR; bar.x = 0; bar.st = nullptr;
    if (!MK_PER_PHASE) bar = xcd_barrier_post(ctl + CW_BAR, MISC + 8);
    const int lo = args.ph_lo, hi = args.ph_hi; int ph = 0;
#ifndef SITEMASK
#define SITEMASK 0xffffffffull
#endif
#define SITE(k) ((SITEMASK >> (k)) & 1ull)
#define PH_ON() (ph >= lo && ph < hi)
#define PH_IF(k) if (PH_ON() && SITE(k))
#define PH_CTX() Ptrs P = launder(P0); int tidp = threadIdx.x; asm volatile("" : "+v"(tidp)); int G = G0, bx = bx0, vcu = vcu0, wave = wave0; asm volatile("" : "+s"(G), "+s"(bx), "+s"(vcu), "+s"(wave)); const int gw = vcu * NWAVES + wave, ngw = G * NWAVES; const long gn = (long)G * (NWAVES * 64); const int lane = tidp & 63; const long gtid = (long)bx * (NWAVES * 64) + tidp; (void)lane; (void)gw; (void)gtid; (void)ngw; (void)gn
#define PH_END() do { if (PH_ON() && ph + 1 < hi) { if (!MK_PER_PHASE) { XcdBarrier b2_ = bar; asm volatile("" : "+s"(b2_.bar), "+s"(b2_.x)); xcd_barrier(b2_); } } ++ph; } while (0)

    PH_IF(0) { PH_CTX();
        LAS WJob* jobs = (LAS WJob*)(lds + JOB_OFF);
        if (tid == 0) {
            int nj = 0, item = 0;
#define ADDJOB(W0_, W1_, rs_, dst_, K_, Nsrc_, Ndst_, kind_, cs_) do { LAS WJob* j_ = jobs + nj; j_->W0 = (W0_); j_->W1 = (W1_); j_->rs = (rs_); j_->WT = WSP(bf16, (dst_)); j_->K = (K_); j_->Nsrc = (Nsrc_); \
                j_->nblk = (Ndst_) / 32; j_->pad0 = 0; j_->kind = (kind_); j_->cs = (cs_); j_->item0 = item; item += ((K_) / 64) * ((Ndst_) / 32); ++nj; } while (0)
            for (int l = 0; l < 2; ++l) {
                const size_t wl = R_WL + (size_t)l * WL_SIZE;
                ADDJOB(P.in[I_WIN] + (size_t)l * D * INW, nullptr, P.in[I_NMIX] + l * D, wl + WL_IN, D, INW, NZ, 1, 1.f);
                ADDJOB(P.in[I_WOUT] + (size_t)l * D * D, nullptr, nullptr, wl + WL_OUT, D, D, D, 0, 1.f);
                ADDJOB(P.in[I_WQ] + (size_t)l * D * 512, nullptr, P.in[I_NXA] + l * D, wl + WL_Q, D, 512, 512, 0, XAT_QS);
                ADDJOB(P.in[I_WKV] + (size_t)l * D * 1024, nullptr, P.in[I_NMEM] + l * D, wl + WL_KV, D, 1024, 1024, 0, 1.f);
                ADDJOB(P.in[I_WO] + (size_t)l * 512 * D, nullptr, nullptr, wl + WL_O, 512, D, D, 0, 1.f);
            }
            ADDJOB(P.in[I_FG], P.in[I_FU], P.in[I_NFFN], R_WGU, D, DFF, 2 * DFF, 2, 1.f);
            ADDJOB(P.in[I_FD], nullptr, nullptr, R_WDN, DFF, D, D, 0, 1.f); jobs[nj - 1].pad0 = (int)F8_SWDN;
            for (int e = 0; e < NE; ++e) {
                ADDJOB(P.in[I_MG] + (size_t)e * D * DFF, P.in[I_MU] + (size_t)e * D * DFF, P.in[I_NFFN] + D, WS_WMGU + (size_t)e * 2 * DFF * D, D, DFF, 2 * DFF, 2, 1.f); jobs[nj - 1].pad0 = (int)F8_SWGU;
                ADDJOB(P.in[I_MD] + (size_t)e * DFF * D, nullptr, nullptr, WS_WMD + (size_t)e * D * DFF, DFF, D, D, 0, 1.f); jobs[nj - 1].pad0 = (int)F8_SWDN;
            }
#undef ADDJOB
            MISC[16] = (unsigned)nj; MISC[17] = (unsigned)item;
        }
        __syncthreads();
        const int nj = (int)MISC[16], nitems = (int)MISC[17];
        LAS float* scr = (LAS float*)(lds + wave * 16384);
        for (int it = gw; it < nitems; it += ngw) {
            int j = 0;
            for (int q = 1; q < nj; ++q) if (jobs[q].item0 <= it) j = q;
            p0_transpose_item(jobs + j, scr, it - jobs[j].item0, lane);
        }
        norm_rows<0>(P, 0, P.in[I_MEM], WSP(bf16, WS_MEMN), BATCH * NMEM, gw, ngw, lane);
        build_gw(P, gtid, gn);
    }
    PH_END();

    for (int l = 0; l < 2; ++l) {
        const size_t wl = R_WL + (size_t)l * WL_SIZE;
        PH_IF(1) { PH_CTX(); if (l == 0) norm16<1, false>(P, l, P.in[I_X], WSP(bf16, R_XN), nullptr, vcu, G, wave, lane, (LAS float*)lds);
            else norm16<1, true>(P, l, nullptr, WSP(bf16, R_XN), WSP(const unsigned, WS_RSS) + (size_t)2 * M, vcu, G, wave, lane, (LAS float*)lds); }
        PH_END();
        PH_IF(2) { PH_CTX();
            for (int task = bx; task < 24; task += G) gate_scan_task(P, task, (LAS float*)lds, tidp);
            { pg8::Gemm g{WSP(const bf16, R_XN), WSP(const bf16, wl + WL_IN), M, NZ, D}; pg8::StaticOrder S; S.init(M, NZ, G, bx);
              pg8::EpiBf16 E{WSP(bf16, R_T0), 512, 512, (size_t)M * 512, (l == 0) ? WSP(const unsigned, WS_RSTD) : WSP(const unsigned, WS_RSS) + (size_t)2 * M};
              pg8::gemm_phase<pg8::EpiBf16, pg8::StaticOrder, true, true>(lds, g, S, E); }
        }
        PH_END();
        PH_IF(3) { PH_CTX(); mconv_glu_vec(P, l, gtid, gn); fox_keynorms(P, gw, ngw, lane); }
        PH_END();
        PH_IF(4) { PH_CTX(); for (int u = wave * G + vcu; u < 8 * NCH; u += ngw) mls::u_unit(P, u, lds + wave * 16384, lane);
            for (int u = (7 - wave) * G + vcu; u < BATCH * FH * fox::NQB; u += ngw) { const int qb = fox::NQB - 1 - u / (BATCH * FH), bh = u % (BATCH * FH);
                const int j0 = fox::unit_j0_wave(bh, qb, (const fox::bf16h*)WSP(bf16, R_T0 + 3 * SZ_T), WSP(const float, WS_KN2), WSP(const float, WS_CF) + (size_t)bh * SEQ, lane); if (lane == 0) WSP(int, WS_J0)[u] = j0; }
            cconv_ln_rows(P, l, gw, ngw, lane); }
        PH_END();
        PH_IF(5) { PH_CTX(); mls::state_scan(P, gw, ngw, lane); }
        PH_END();
        PH_IF(7) { PH_CTX();
            { pg8::Gemm g{WSP(const bf16, WS_MEMN), WSP(const bf16, wl + WL_KV), BATCH * NMEM, 512, D}; pg8::StaticOrder S; S.init(BATCH * NMEM, 512, G, bx);
              pg8::EpiBf16 E{WSP(bf16, WS_KVX) + (size_t)l * 512 * 1024, 512, 0, 0, nullptr};
              pg8::gemm_phase<pg8::EpiBf16, pg8::StaticOrder, true, true>(lds, g, S, E); }
            { pg8::Gemm g{WSP(const bf16, wl + WL_KV) + (size_t)512 * 1024, WSP(const bf16, WS_MEMN), 512, BATCH * NMEM, D}; pg8::StaticOrder S; S.init(512, BATCH * NMEM, G, (bx + G - 4) % G);
              pg8::EpiBf16 E{WSP(bf16, WS_KVX) + (size_t)l * 512 * 1024 + 512 * 512, 512, 0, 0, nullptr};
              pg8::gemm_phase<pg8::EpiBf16, pg8::StaticOrder, true, true>(lds, g, S, E); }
            { static_assert(fox::LDS_BYTES <= RING_BYTES, "fox LDS");
              const fox::bf16h* Q = (const fox::bf16h*)WSP(bf16, R_T0 + 3 * SZ_T); const fox::bf16h* Kp = (const fox::bf16h*)WSP(bf16, R_T0 + 4 * SZ_T); const fox::bf16h* Vp = (const fox::bf16h*)WSP(bf16, R_T0 + 5 * SZ_T);
              fox::bf16h* O = (fox::bf16h*)(WSP(bf16, R_CAT) + 512); const float* CF = WSP(const float, WS_CF);
              for (int it = vcu; it < 8 * NCH / 8; it += G) mls::out_unit(P, l, it * 8 + wave, lds + wave * 16384, lane);
              __syncthreads();
              const int nitems = BATCH * FH * fox::NQB; unsigned* qhead = ctl + CW_FOXQ + 64 * l;
              for (;;) {
                  if (tidp == 0) MISC[24] = __hip_atomic_fetch_add(qhead, 1u, RLX_AGENT);
                  __syncthreads();
                  const int u = (int)MISC[24];
                  __syncthreads();
                  if (u >= nitems) break;
                  const int qb = fox::NQB - 1 - u / (BATCH * FH), bh = u % (BATCH * FH);
                  const int j0 = WSP(const int, WS_J0)[u];
                  fox::attn_unit<8>(bh / FH, bh % FH, qb, j0, Q, Kp, Vp, O, CF + (size_t)bh * SEQ, (char*)lds_raw); } }

 }
        PH_END();
        PH_IF(8) { PH_CTX(); pg8::Gemm g{WSP(const bf16, R_CAT), WSP(const bf16, wl + WL_OUT), M, D, D}; pg8::StaticOrder S; S.init(M, D, G, bx);
            pg8::EpiRes E{WSP(bf16, R_XN), D, WSP(unsigned, WS_RSS) + (size_t)(l ? 3 : 0) * M};
            pg8::gemm_phase<pg8::EpiRes, pg8::StaticOrder, true, true>(lds, g, S, E); }
        PH_END();
        PH_IF(10) { PH_CTX(); pg8::Gemm g{WSP(const bf16, R_XN), WSP(const bf16, wl + WL_Q), M, 512, D}; pg8::StaticOrder S; S.init(M, 512, G, bx);
            pg8::EpiBf16 E{WSP(bf16, R_QX), 512, 0, 0, WSP(const unsigned, WS_RSS) + (size_t)(l ? 3 : 0) * M};
            pg8::gemm_phase<pg8::EpiBf16, pg8::StaticOrder, true, true>(lds, g, S, E); }
        PH_END();
        PH_IF(11) { PH_CTX(); static_assert(xat::LDS_BYTES <= RING_BYTES, "xat LDS");
            const bf16* KXp = WSP(const bf16, WS_KVX) + (size_t)l * 512 * 1024;
            for (int L = vcu; L < BATCH * XH * (SEQ / 256); L += G) { const int qb = L % (SEQ / 256), bhd = L / (SEQ / 256);
                xat::unit(bhd / XH, bhd % XH, qb, WSP(const bf16, R_QX), KXp, KXp + 512 * 512, WSP(bf16, R_OX), lds); } }
        PH_END();
        PH_IF(12) { PH_CTX(); pg8::Gemm g{WSP(const bf16, R_OX), WSP(const bf16, wl + WL_O), M, D, 512}; pg8::StaticOrder S; S.init(M, D, G, bx);
            pg8::EpiRes E{WSP(bf16, R_XN), D, WSP(unsigned, WS_RSS) + (size_t)(l ? 4 : 1) * M};
            pg8::gemm_phase<pg8::EpiRes, pg8::StaticOrder, true, true>(lds, g, S, E); }
        PH_END();
        if (l == 0) {
            PH_IF(14) { PH_CTX(); pg8::Gemm g{WSP(const bf16, R_XN), WSP(const bf16, R_WGU), M, 2 * DFF, D}; pg8::StaticOrder S; S.init(M, 2 * DFF, G, bx);
                pg8::EpiSwiGLUo8 E{WSP(unsigned char, R_HD), DFF, WSP(const unsigned, WS_RSS) + (size_t)1 * M};
                pg8::gemm_phase<pg8::EpiSwiGLUo8, pg8::StaticOrder, true, true>(lds, g, S, E); }
            PH_END();
            PH_IF(15) { PH_CTX(); pg8::Gemm g{WSP(const bf16, R_HD), WSP(const bf16, R_WDN), M, D, DFF / 2}; pg8::StaticOrder S; S.init(M, D, G, bx);
                pg8::EpiResT<true> E{WSP(bf16, R_XN), D, WSP(unsigned, WS_RSS) + (size_t)2 * M};
                pg8::gemm_phase<pg8::EpiResT<true>, pg8::StaticOrder, true, true, 2>(lds, g, S, E); }
            PH_END();
            ph += 2;
        } else {
            PH_IF(16) { PH_CTX(); norm16<2, true>(P, l, nullptr, WSP(bf16, R_XN), WSP(const unsigned, WS_RSS) + (size_t)4 * M, vcu, G, wave, lane, (LAS float*)lds); }
            PH_END();
            PH_IF(17) { PH_CTX(); moe_gather(P, gw, ngw, lane, wave, vcu, G, lds); }
            PH_END();
            PH_IF(18) { PH_CTX(); pg8::Gemm g{WSP(const bf16, WS_XQ), WSP(const bf16, WS_WMGU), 0, 2 * DFF, D / 2}; pg8::GroupedOrder S; S.init(2 * DFF, G, bx, ctl + CW_CNT, (size_t)2 * DFF * D);
                pg8::EpiSwiGLU8 E{WSP(unsigned char, R_HM), DFF, 1.f / (F8_SA * F8_SWGU)};
                pg8::gemm_phase<pg8::EpiSwiGLU8, pg8::GroupedOrder, true, true, 2>(lds, g, S, E); }
            PH_END();
            PH_IF(19) { PH_CTX(); pg8::Gemm g{WSP(const bf16, R_HM), WSP(const bf16, WS_WMD), 0, D, DFF / 2}; pg8::GroupedTailOrder S; S.init(D, G, bx, ctl + CW_CNT, (size_t)D * DFF, DFF / (2 * pg8::BK));
                pg8::EpiMoeOutT E{WSP(bf16, R_XNS), D, WSP(const float, WS_SLOTG), WSP(float, WS_WMGU)  , ctl + CW_TAIL, 1.f / (F8_SH * F8_SWDN)};
                pg8::gemm_phase<pg8::EpiMoeOutT, pg8::GroupedTailOrder, true, true, 2>(lds, g, S, E); }
            PH_END();
        }
    }
    PH_IF(20) { PH_CTX(); moe_combine_final(P, gw, ngw, lane); }
#undef PH_ON
#undef PH_END
}

extern "C" void kernel_launch(void* const* d_in, const int* in_sizes, int n_in, void* d_out, int out_size, void* d_ws, size_t ws_size, hipStream_t stream) {
    static int grid = 0;
    if (grid == 0) {
        if (n_in != N_IN || out_size != M * D || ws_size < WS_END) { fprintf(stderr, "kernel_launch: unexpected shapes (n_in %d, out %d, ws %zu < %zu); nothing launched\n", n_in, out_size, ws_size, (size_t)WS_END); grid = -1; return; }
        int dev = 0, cus = 0, per_cu = 0;
        if (hipGetDevice(&dev) != hipSuccess || hipDeviceGetAttribute(&cus, hipDeviceAttributeMultiprocessorCount, dev) != hipSuccess) { grid = -1; return; }
        if (hipFuncSetAttribute((const void*)trunk_fwd, hipFuncAttributeMaxDynamicSharedMemorySize, LDS_BYTES) != hipSuccess) { fprintf(stderr, "kernel_launch: hipFuncSetAttribute failed\n"); grid = -1; return; }
        if (hipOccupancyMaxActiveBlocksPerMultiprocessor(&per_cu, (const void*)trunk_fwd, NWAVES * 64, LDS_BYTES) != hipSuccess || per_cu < 1) { fprintf(stderr, "kernel_launch: occupancy query says %d\n", per_cu); (void)hipGetLastError(); grid = -1; return; }
        grid = cus;
    }
    if (grid < 0) return;
    (void)in_sizes;
    if (hipMemsetAsync((char*)d_ws + WS_CTL, 0, CTL_ZERO_BYTES, stream) != hipSuccess) return;
    Args a; memset(&a, 0, sizeof(a));
    for (int i = 0; i < N_IN; ++i) a.in[i] = (const float*)d_in[i];
    a.xres = (float*)d_out; a.ws = (unsigned char*)d_ws;
#if MK_PER_PHASE
    for (int p = 0; p < N_PHASES; ++p) { a.ph_lo = p; a.ph_hi = p + 1; hipLaunchKernelGGL(trunk_fwd, dim3(grid), dim3(NWAVES * 64), LDS_BYTES, stream, a); }
#else
    a.ph_lo = 0; a.ph_hi = N_PHASES;
    hipLaunchKernelGGL(trunk_fwd, dim3(grid), dim3(NWAVES * 64), LDS_BYTES, stream, a);
#endif
}
#endif
```
